# Optimizing an MI355X kernel written in HIP

```python
import jax, jax.numpy as jnp
from jax import lax
import numpy as np

D_MODEL = 1024
BATCH = 2
SEQ = 8192
DEPTH = 1

HEAD_DIM = 64
N_Q_HEADS = 8
N_KV_HEADS = 2
Q_REP = N_Q_HEADS // N_KV_HEADS
ATTN_WIDTH = N_Q_HEADS * HEAD_DIM
KV_WIDTH = N_KV_HEADS * HEAD_DIM
WINDOW = 128
ATTN_BLOCK = 128
N_GMLP_GROUPS = 8
GMLP_WIDTH = D_MODEL - ATTN_WIDTH
GMLP_GROUP_DIM = GMLP_WIDTH // N_GMLP_GROUPS
CHUNK = 128
MIX_WIDTH = ATTN_WIDTH + GMLP_WIDTH
IN_WIDTH = ATTN_WIDTH + 2 * KV_WIDTH + 2 * GMLP_WIDTH
N_EXPERTS = 32
TOP_K = 4
D_FF = D_MODEL
SWIGLU_LIMIT = 7.0
SWIGLU_ALPHA = 1.702
MOE_BLOCK = 128
LN_EPS = 1e-5
DEEPNORM_ALPHA = (2.0 * DEPTH) ** 0.25
DEEPNORM_BETA = (8.0 * DEPTH) ** -0.25
NEG_INF = -1e30

kernel_name = "hybrid_swa_sink_gmlp_moe_deepnorm"


def layer_norm(x, g, b):
    xf = x.astype(jnp.float32)
    mu = jnp.mean(xf, axis=-1, keepdims=True)
    xc = xf - mu
    var = jnp.mean(xc * xc, axis=-1, keepdims=True)
    return (xc * lax.rsqrt(var + LN_EPS)).astype(x.dtype) * g + b


def sliding_window_attention(q, k, v, sinks):
    B, S = q.shape[:2]
    nb = S // ATTN_BLOCK
    q = q.reshape(B, nb, ATTN_BLOCK, N_KV_HEADS, Q_REP, HEAD_DIM)
    k = k.reshape(B, nb, ATTN_BLOCK, N_KV_HEADS, HEAD_DIM)
    v = v.reshape(B, nb, ATTN_BLOCK, N_KV_HEADS, HEAD_DIM)

    def band(t):
        prev = jnp.pad(t[:, :-1], ((0, 0), (1, 0), (0, 0), (0, 0), (0, 0)))
        return jnp.concatenate([prev, t], axis=2)

    kb, vb = band(k), band(v)
    scores = jnp.einsum('bnqgrd,bnkgd->bngrqk', q, kb).astype(jnp.float32) * (HEAD_DIM ** -0.5)
    t_idx = jnp.arange(ATTN_BLOCK)[:, None]
    s_idx = jnp.arange(2 * ATTN_BLOCK)[None, :]
    diff = t_idx + ATTN_BLOCK - s_idx
    in_band = (diff >= 0) & (diff < WINDOW)
    blk = jnp.arange(nb)[:, None, None]
    valid = in_band[None] & ((blk * ATTN_BLOCK - ATTN_BLOCK + s_idx[None]) >= 0)
    scores = jnp.where(valid[None, :, None, None], scores, NEG_INF)
    sink = sinks.astype(jnp.float32).reshape(N_KV_HEADS, Q_REP)[None, None, :, :, None, None]
    sink = jnp.broadcast_to(sink, scores.shape[:-1] + (1,))
    probs = jax.nn.softmax(jnp.concatenate([scores, sink], axis=-1), axis=-1)[..., :-1]
    out = jnp.einsum('bngrqk,bnkgd->bnqgrd', probs.astype(v.dtype), vb)
    return out.reshape(B, S, ATTN_WIDTH)


def chunked_spatial_gating(u, g, ln_g, ln_b, w_s, b_s):
    B, S = u.shape[:2]
    nc = S // CHUNK
    u = jax.nn.gelu(u)
    g = jax.nn.gelu(g).reshape(B, S, N_GMLP_GROUPS, GMLP_GROUP_DIM)
    g = layer_norm(g, ln_g.reshape(N_GMLP_GROUPS, GMLP_GROUP_DIM), ln_b.reshape(N_GMLP_GROUPS, GMLP_GROUP_DIM))
    g = g.reshape(B, nc, CHUNK, N_GMLP_GROUPS, GMLP_GROUP_DIM)
    causal = jnp.tril(jnp.ones((CHUNK, CHUNK), dtype=bool))
    w = jnp.where(causal[None], w_s, jnp.zeros_like(w_s))
    mixed = jnp.einsum('gts,bcsgd->bctgd', w, g) + b_s.T[None, None, :, :, None]
    return u * mixed.reshape(B, S, GMLP_WIDTH)


def token_mixer(x, w_in, b_in, sinks, ln_v_g, ln_v_b, w_spatial, b_spatial, w_out, b_out):
    proj = x @ w_in + b_in
    o1 = ATTN_WIDTH
    o2 = o1 + KV_WIDTH
    o3 = o2 + KV_WIDTH
    o4 = o3 + GMLP_WIDTH
    q, k, v = proj[..., :o1], proj[..., o1:o2], proj[..., o2:o3]
    u, g = proj[..., o3:o4], proj[..., o4:]
    attn = sliding_window_attention(q, k, v, sinks)
    sgu = chunked_spatial_gating(u, g, ln_v_g, ln_v_b, w_spatial, b_spatial)
    return jnp.concatenate([attn, sgu], axis=-1) @ w_out + b_out


def routed_experts(x, w_router, b_router, w_gate, b_gate, w_up, b_up, w_down, b_down):
    B, S, D = x.shape
    T = B * S
    TK = T * TOP_K
    xt = x.reshape(T, D)
    logits = (xt @ w_router + b_router).astype(jnp.float32)
    top_vals, top_idx = lax.top_k(logits, TOP_K)
    gates = jax.nn.softmax(top_vals, axis=-1).astype(x.dtype)
    flat_e = top_idx.reshape(-1)
    flat_tok = jnp.arange(TK, dtype=jnp.int32) // TOP_K
    order = jnp.argsort(flat_e)
    sorted_e = flat_e[order]
    counts = jnp.bincount(flat_e, length=N_EXPERTS)
    start = jnp.cumsum(counts) - counts
    padded = (counts + MOE_BLOCK - 1) // MOE_BLOCK * MOE_BLOCK
    padded_end = jnp.cumsum(padded)
    padded_start = padded_end - padded
    dest = padded_start[sorted_e] + jnp.arange(TK, dtype=jnp.int32) - start[sorted_e]
    n_blocks = TK // MOE_BLOCK + N_EXPERTS
    n_rows = n_blocks * MOE_BLOCK
    row_tok = jnp.full((n_rows,), T, dtype=jnp.int32).at[dest].set(flat_tok[order])
    row_gate = jnp.zeros((n_rows,), x.dtype).at[dest].set(gates.reshape(-1)[order])
    block_e = jnp.minimum(
        jnp.searchsorted(padded_end, jnp.arange(n_blocks, dtype=padded_end.dtype) * MOE_BLOCK, side='right'),
        N_EXPERTS - 1)
    x_rows = jnp.concatenate([xt, jnp.zeros((1, D), xt.dtype)], axis=0)[row_tok]
    x_rows = x_rows.reshape(n_blocks, MOE_BLOCK, D)

    def expert_block(args):
        xb, e = args
        gt = jnp.minimum(xb @ w_gate[e] + b_gate[e], SWIGLU_LIMIT)
        up = jnp.clip(xb @ w_up[e] + b_up[e], -SWIGLU_LIMIT, SWIGLU_LIMIT)
        hid = gt * jax.nn.sigmoid(SWIGLU_ALPHA * gt) * (up + 1.0)
        return hid @ w_down[e] + b_down[e]

    y_rows = lax.map(expert_block, (x_rows, block_e)).reshape(n_rows, D)
    out = jnp.zeros((T + 1, D), x.dtype).at[row_tok].add(y_rows * row_gate[:, None])[:T]
    return out.reshape(B, S, D)


def setup_inputs(seed: int = 0) -> dict:
    key = jax.random.key(seed)
    ks = jax.random.split(key, 24)
    f32 = jnp.float32

    def nrm(k, shape, scale):
        return jax.random.normal(k, (DEPTH,) + shape, f32) * scale

    x = jax.random.normal(ks[0], (BATCH, SEQ, D_MODEL), f32)
    col_scale = jnp.concatenate([
        jnp.ones((ATTN_WIDTH + KV_WIDTH,), f32),
        jnp.full((KV_WIDTH,), DEEPNORM_BETA, f32),
        jnp.full((GMLP_WIDTH,), DEEPNORM_BETA, f32),
        jnp.ones((GMLP_WIDTH,), f32)])
    w_in = nrm(ks[1], (D_MODEL, IN_WIDTH), D_MODEL ** -0.5) * col_scale
    b_in = nrm(ks[2], (IN_WIDTH,), 0.02)
    sinks = nrm(ks[3], (N_Q_HEADS,), 0.5)
    ln_v_g = 1.0 + nrm(ks[4], (GMLP_WIDTH,), 0.05)
    ln_v_b = nrm(ks[5], (GMLP_WIDTH,), 0.02)
    w_spatial = nrm(ks[6], (N_GMLP_GROUPS, CHUNK, CHUNK), CHUNK ** -0.5)
    b_spatial = 1.0 + nrm(ks[7], (N_GMLP_GROUPS, CHUNK), 0.05)
    w_out = nrm(ks[8], (MIX_WIDTH, D_MODEL), MIX_WIDTH ** -0.5 * DEEPNORM_BETA)
    b_out = nrm(ks[9], (D_MODEL,), 0.02)
    ln1_g = 1.0 + nrm(ks[10], (D_MODEL,), 0.05)
    ln1_b = nrm(ks[11], (D_MODEL,), 0.02)
    w_router = nrm(ks[12], (D_MODEL, N_EXPERTS), D_MODEL ** -0.5)
    b_router = nrm(ks[13], (N_EXPERTS,), 0.01)
    w_gate = nrm(ks[14], (N_EXPERTS, D_MODEL, D_FF), D_MODEL ** -0.5)
    b_gate = nrm(ks[15], (N_EXPERTS, D_FF), 0.02)
    w_up = nrm(ks[16], (N_EXPERTS, D_MODEL, D_FF), D_MODEL ** -0.5 * DEEPNORM_BETA)
    b_up = nrm(ks[17], (N_EXPERTS, D_FF), 0.02)
    w_down = nrm(ks[18], (N_EXPERTS, D_FF, D_MODEL), D_FF ** -0.5 * DEEPNORM_BETA)
    b_down = nrm(ks[19], (N_EXPERTS, D_MODEL), 0.02)
    ln2_g = 1.0 + nrm(ks[20], (D_MODEL,), 0.05)
    ln2_b = nrm(ks[21], (D_MODEL,), 0.02)
    return {"x": x, "w_in": w_in, "b_in": b_in, "sinks": sinks, "ln_v_g": ln_v_g, "ln_v_b": ln_v_b,
            "w_spatial": w_spatial, "b_spatial": b_spatial, "w_out": w_out, "b_out": b_out,
            "ln1_g": ln1_g, "ln1_b": ln1_b, "w_router": w_router, "b_router": b_router,
            "w_gate": w_gate, "b_gate": b_gate, "w_up": w_up, "b_up": b_up,
            "w_down": w_down, "b_down": b_down, "ln2_g": ln2_g, "ln2_b": ln2_b}


def reference(x, w_in, b_in, sinks, ln_v_g, ln_v_b, w_spatial, b_spatial, w_out, b_out,
              ln1_g, ln1_b, w_router, b_router, w_gate, b_gate, w_up, b_up,
              w_down, b_down, ln2_g, ln2_b):
    for l in range(DEPTH):
        mix = token_mixer(x, w_in[l], b_in[l], sinks[l], ln_v_g[l], ln_v_b[l],
                          w_spatial[l], b_spatial[l], w_out[l], b_out[l])
        h = layer_norm(DEEPNORM_ALPHA * x + mix, ln1_g[l], ln1_b[l])
        ffn = routed_experts(h, w_router[l], b_router[l], w_gate[l], b_gate[l],
                             w_up[l], b_up[l], w_down[l], b_down[l])
        x = layer_norm(DEEPNORM_ALPHA * h + ffn, ln2_g[l], ln2_b[l])
    return x
```

```cpp
#include <hip/hip_runtime.h>
#include <cstdio>
#include <cstdint>

typedef unsigned short bf16;
typedef float f32x4 __attribute__((ext_vector_type(4)));
typedef unsigned u32x4 __attribute__((ext_vector_type(4)));
typedef unsigned u32x2 __attribute__((ext_vector_type(2)));

constexpr int BATCH = 2, SEQ = 8192, D = 1024, T = BATCH * SEQ;
constexpr int NQH = 8, NKVH = 2, HD = 64, QREP = 4, AW = 512, KVW = 128, GW = 512, INW = 1792;
constexpr int NEXP = 32, TOPK = 4, DFF = 1024;
constexpr int NT_MAX = T * TOPK / 256 + NEXP;
constexpr int NROWS_MAX = NT_MAX * 256;
constexpr float LN_EPS = 1e-5f;
constexpr float ALPHA = 1.189207115002721f;
constexpr float C2 = 0.125f * 1.4426950408889634f;
constexpr float LOG2E = 1.4426950408889634f;

constexpr size_t MiB = 1u << 20;
constexpr size_t WS_CTL = 0;
constexpr size_t WS_META = 1 * MiB;
constexpr size_t WS_XB = 3 * MiB;
constexpr size_t WS_QB = WS_XB + 32 * MiB;
constexpr size_t WS_KB = WS_QB + 16 * MiB;
constexpr size_t WS_VT = WS_KB + 4 * MiB;
constexpr size_t WS_UB = WS_VT + 4 * MiB;
constexpr size_t WS_GB = WS_UB + 16 * MiB;
constexpr size_t WS_CAT = WS_GB + 16 * MiB;
constexpr size_t WS_HB = WS_CAT + 32 * MiB;
constexpr size_t WS_Y = WS_XB;
constexpr size_t WS_HID = WS_HB + 32 * MiB;
constexpr size_t WS_END_NAIVE = WS_HID + 144 * MiB;
static_assert(WS_Y + 144 * MiB <= WS_HID, "Y overlay");

constexpr int CW_CNT = 64;
constexpr int MT_NT = 0;
constexpr int MT_TSTART = 16;
constexpr int MT_TILE_E = 64;
constexpr int MT_SEL_E = 1024;
constexpr int MT_SEL_POS = MT_SEL_E + T * 4;
constexpr int MT_SEL_G = MT_SEL_POS + T * 4;
constexpr int MT_SLOT_ROW = MT_SEL_G + T * 4;
constexpr int MT_ROW_TOK = MT_SLOT_ROW + T * 4;
constexpr int MT_ROW_GATE = MT_ROW_TOK + NROWS_MAX;
static_assert((size_t)(MT_ROW_GATE + NROWS_MAX) * 4 <= 2 * MiB, "meta");

__device__ __forceinline__ float bf2f(bf16 v) { return __uint_as_float((unsigned)v << 16); }
__device__ __forceinline__ unsigned f2bf(float f) { unsigned u = __float_as_uint(f); return (u + 0x7fffu + ((u >> 16) & 1u)) >> 16; }
__device__ __forceinline__ unsigned pk2(float lo, float hi) { return f2bf(lo) | (f2bf(hi) << 16); }
__device__ __forceinline__ float gelu_tanh(float x) {
    const float k2 = 2.0f * 0.7978845608028654f;
    const float u = k2 * (x + 0.044715f * x * x * x);
    return x / (1.0f + __expf(-u));
}
__device__ __forceinline__ float wave_sum(float v) {
#pragma unroll
    for (int o = 1; o < 64; o <<= 1) v += __shfl_xor(v, o);
    return v;
}
__device__ __forceinline__ float wave_max(float v) {
#pragma unroll
    for (int o = 1; o < 64; o <<= 1) v = fmaxf(v, __shfl_xor(v, o));
    return v;
}

__global__ void k_cvt_x(const float* __restrict__ x, bf16* __restrict__ xb, int n4) {
    for (int i = blockIdx.x * blockDim.x + threadIdx.x; i < n4; i += gridDim.x * blockDim.x) {
        const f32x4 v = ((const f32x4*)x)[i];
        u32x2 o; o.x = pk2(v.x, v.y); o.y = pk2(v.z, v.w);
        ((u32x2*)xb)[i] = o;
    }
}

template <int NB, class Epi>
__device__ __forceinline__ void naive_gemm_tile(const bf16* A, int lda, const int* rowidx, int m0, const float* B0, const float* B1, int ldb, int n0, int K, const Epi& epi) {
    __shared__ float As[16][68];
    __shared__ float Bs[NB][16][64];
    const int tid = threadIdx.x, ty = tid >> 4, tx = tid & 15;
    float acc[NB][4][4];
#pragma unroll
    for (int b = 0; b < NB; ++b)
#pragma unroll
        for (int i = 0; i < 4; ++i)
#pragma unroll
            for (int j = 0; j < 4; ++j) acc[b][i][j] = 0.f;
    const int ar = tid >> 2, ac = (tid & 3) * 4;
    const int arow = rowidx ? rowidx[m0 + ar] : (m0 + ar);
    const bf16* ap = A + (size_t)arow * lda + ac;
    const int br = tid >> 4, bc = (tid & 15) * 4;
    for (int k0 = 0; k0 < K; k0 += 16) {
        const u32x2 av = *(const u32x2*)(ap + k0);
        As[ac + 0][ar] = __uint_as_float(av.x << 16); As[ac + 1][ar] = __uint_as_float(av.x & 0xffff0000u);
        As[ac + 2][ar] = __uint_as_float(av.y << 16); As[ac + 3][ar] = __uint_as_float(av.y & 0xffff0000u);
        *(f32x4*)&Bs[0][br][bc] = *(const f32x4*)(B0 + (size_t)(k0 + br) * ldb + n0 + bc);
        if (NB == 2) *(f32x4*)&Bs[NB - 1][br][bc] = *(const f32x4*)(B1 + (size_t)(k0 + br) * ldb + n0 + bc);
        __syncthreads();
#pragma unroll
        for (int k = 0; k < 16; ++k) {
            const f32x4 a = *(const f32x4*)&As[k][ty * 4];
#pragma unroll
            for (int b = 0; b < NB; ++b) {
                const f32x4 bv = *(const f32x4*)&Bs[b][k][tx * 4];
#pragma unroll
                for (int i = 0; i < 4; ++i)
#pragma unroll
                    for (int j = 0; j < 4; ++j) acc[b][i][j] += a[i] * bv[j];
            }
        }
        __syncthreads();
    }
#pragma unroll
    for (int i = 0; i < 4; ++i)
#pragma unroll
        for (int j = 0; j < 4; ++j) {
            if (NB == 2) epi(m0 + ty * 4 + i, n0 + tx * 4 + j, acc[0][i][j], acc[NB - 1][i][j]);
            else epi(m0 + ty * 4 + i, n0 + tx * 4 + j, acc[0][i][j], 0.f);
        }
}

struct EpiInProjN {
    const float* b_in; bf16 *QB, *KB, *VT, *UB, *GB;
    __device__ __forceinline__ void operator()(int row, int c, float a, float) const {
        const float v = a + b_in[c];
        if (c < 512) QB[(size_t)row * 512 + c] = (bf16)f2bf(v * C2);
        else if (c < 640) KB[(size_t)row * 128 + (c - 512)] = (bf16)f2bf(v);
        else if (c < 768) { const int cv = c - 640, g = cv >> 6, d = cv & 63, b = row / SEQ, s = row % SEQ; VT[((size_t)((b * 2 + g) * 64 + d)) * SEQ + s] = (bf16)f2bf(v); }
        else if (c < 1280) UB[(size_t)row * 512 + (c - 768)] = (bf16)f2bf(gelu_tanh(v));
        else GB[(size_t)row * 512 + (c - 1280)] = (bf16)f2bf(gelu_tanh(v));
    }
};
__global__ void __launch_bounds__(256) k_inproj_naive(const bf16* XB, const float* w_in, EpiInProjN epi) {
    naive_gemm_tile<1>(XB, D, nullptr, blockIdx.x * 64, w_in, nullptr, INW, blockIdx.y * 64, D, epi);
}

__global__ void __launch_bounds__(256) k_attn_naive(const bf16* QB, const bf16* KB, const bf16* VT, const float* sinks, bf16* CAT) {
    __shared__ float pl[4][128];
    const int w = threadIdx.x >> 6, lane = threadIdx.x & 63;
    const int wu = blockIdx.x * 4 + w;
    const int tok = wu >> 3, h = wu & 7, g = h >> 2, b = tok / SEQ, t = tok % SEQ;
    const float qv = bf2f(QB[(size_t)tok * 512 + h * 64 + lane]);
    float s[2];
    {
        const int kp0 = t - 127 + lane, kp1 = kp0 + 64;
        const bf16* kr0 = KB + (size_t)(b * SEQ + (kp0 < 0 ? 0 : kp0)) * 128 + g * 64;
        const bf16* kr1 = KB + (size_t)(b * SEQ + (kp1 < 0 ? 0 : kp1)) * 128 + g * 64;
        float a0 = 0.f, a1 = 0.f;
        for (int d = 0; d < 64; ++d) { const float qd = __shfl(qv, d); a0 += qd * bf2f(kr0[d]); a1 += qd * bf2f(kr1[d]); }
        s[0] = (kp0 >= 0) ? a0 : -1e30f; s[1] = (kp1 >= 0) ? a1 : -1e30f;
    }
    const float sk = sinks[h] * LOG2E;
    const float m = fmaxf(wave_max(fmaxf(s[0], s[1])), sk);
    const float p0 = exp2f(s[0] - m), p1 = exp2f(s[1] - m);
    const float l = wave_sum(p0 + p1) + exp2f(sk - m);
    pl[w][lane] = p0; pl[w][64 + lane] = p1;
    __syncthreads();
    const bf16* vr = VT + ((size_t)((b * 2 + g) * 64 + lane)) * SEQ;
    float o = 0.f;
    for (int j = 0; j < 128; ++j) { const int kp = t - 127 + j; if (kp >= 0) o += pl[w][j] * bf2f(vr[kp]); }
    CAT[(size_t)tok * 1024 + h * 64 + lane] = (bf16)f2bf(o / l);
}

__global__ void __launch_bounds__(256) k_sgu_naive(const bf16* UB, const bf16* GB, const float* ln_g, const float* ln_b, const float* w_s, const float* b_s, bf16* CAT) {
    __shared__ float G[128][65];
    const int u = blockIdx.x, gi = u & 7, ch = u >> 3;
    const int tid = threadIdx.x, s = tid >> 1, half = tid & 1;
    const size_t tok = (size_t)ch * 128 + s;
    float v[32]; float sum = 0.f;
#pragma unroll
    for (int i = 0; i < 32; ++i) { v[i] = bf2f(GB[tok * 512 + gi * 64 + half * 32 + i]); sum += v[i]; }
    sum += __shfl_xor(sum, 1);
    const float mu = sum * (1.f / 64.f); float q = 0.f;
#pragma unroll
    for (int i = 0; i < 32; ++i) { v[i] -= mu; q += v[i] * v[i]; }
    q += __shfl_xor(q, 1);
    const float rstd = rsqrtf(q * (1.f / 64.f) + LN_EPS);
#pragma unroll
    for (int i = 0; i < 32; ++i) { const int d = half * 32 + i; G[s][d] = v[i] * rstd * ln_g[gi * 64 + d] + ln_b[gi * 64 + d]; }
    __syncthreads();
    const int t = s;
    float acc[32];
#pragma unroll
    for (int i = 0; i < 32; ++i) acc[i] = 0.f;
    const float* wr = w_s + ((size_t)gi * 128 + t) * 128;
    for (int ss = 0; ss <= t; ++ss) {
        const float w = wr[ss];
#pragma unroll
        for (int i = 0; i < 32; ++i) acc[i] += w * G[ss][half * 32 + i];
    }
    const float bb = b_s[gi * 128 + t];
#pragma unroll
    for (int i = 0; i < 32; ++i) { const int d = half * 32 + i; const float uu = bf2f(UB[tok * 512 + gi * 64 + d]); CAT[tok * 1024 + 512 + gi * 64 + d] = (bf16)f2bf(uu * (acc[i] + bb)); }
}

struct EpiOutProjN {
    const float* b_out; const float* x; float* Z;
    __device__ __forceinline__ void operator()(int row, int c, float a, float) const { Z[(size_t)row * D + c] = ALPHA * x[(size_t)row * D + c] + a + b_out[c]; }
};
__global__ void __launch_bounds__(256) k_outproj_naive(const bf16* CAT, const float* w_out, EpiOutProjN epi) {
    naive_gemm_tile<1>(CAT, D, nullptr, blockIdx.x * 64, w_out, nullptr, D, blockIdx.y * 64, D, epi);
}

__global__ void __launch_bounds__(256) k_router_naive(float* ZH, bf16* HB, const float* ln1_g, const float* ln1_b, const float* w_r, const float* b_r, unsigned* cnt, int* meta) {
    const int w = threadIdx.x >> 6, lane = threadIdx.x & 63;
    const int tok = blockIdx.x * 4 + w;
    f32x4* zr = (f32x4*)(ZH + (size_t)tok * D) + lane;
    f32x4 v[4]; float s = 0.f;
#pragma unroll
    for (int j = 0; j < 4; ++j) { v[j] = zr[64 * j]; s += (v[j].x + v[j].y) + (v[j].z + v[j].w); }
    const float mean = wave_sum(s) * (1.f / D); float s2 = 0.f;
#pragma unroll
    for (int j = 0; j < 4; ++j) { v[j] = v[j] - mean; s2 += (v[j].x * v[j].x + v[j].y * v[j].y) + (v[j].z * v[j].z + v[j].w * v[j].w); }
    const float rstd = rsqrtf(wave_sum(s2) * (1.f / D) + LN_EPS);
    float lg[32];
#pragma unroll
    for (int e = 0; e < 32; ++e) lg[e] = 0.f;
#pragma unroll
    for (int j = 0; j < 4; ++j) {
        const int c0 = 4 * lane + 256 * j;
        const f32x4 gg = *(const f32x4*)(ln1_g + c0), bb = *(const f32x4*)(ln1_b + c0);
        v[j] = v[j] * rstd * gg + bb;
        zr[64 * j] = v[j];
        u32x2 o; o.x = pk2(v[j].x, v[j].y); o.y = pk2(v[j].z, v[j].w);
        *((u32x2*)(HB + (size_t)tok * D + c0)) = o;
#pragma unroll
        for (int i = 0; i < 4; ++i) {
            const float hv = v[j][i];
            const f32x4* wr = (const f32x4*)(w_r + (size_t)(c0 + i) * 32);
#pragma unroll
            for (int e4 = 0; e4 < 8; ++e4) { const f32x4 ww = wr[e4]; lg[e4 * 4 + 0] += hv * ww.x; lg[e4 * 4 + 1] += hv * ww.y; lg[e4 * 4 + 2] += hv * ww.z; lg[e4 * 4 + 3] += hv * ww.w; }
        }
    }
#pragma unroll
    for (int e = 0; e < 32; ++e) lg[e] = wave_sum(lg[e]) + b_r[e];
    int bi[4]; float bv[4];
#pragma unroll
    for (int k = 0; k < 4; ++k) {
        float best = -INFINITY; int b = 0;
#pragma unroll
        for (int e = 0; e < 32; ++e) if (lg[e] > best) { best = lg[e]; b = e; }
#pragma unroll
        for (int e = 0; e < 32; ++e) if (e == b) lg[e] = -INFINITY;
        bi[k] = b; bv[k] = best;
    }
    float ex[4], es = 0.f;
#pragma unroll
    for (int k = 0; k < 4; ++k) { ex[k] = __expf(bv[k] - bv[0]); es += ex[k]; }
    if (lane == 0) {
#pragma unroll
        for (int k = 0; k < 4; ++k) {
            const unsigned pos = atomicAdd(&cnt[bi[k]], 1u);
            meta[MT_SEL_E + tok * 4 + k] = bi[k]; meta[MT_SEL_POS + tok * 4 + k] = (int)pos;
            ((float*)meta)[MT_SEL_G + tok * 4 + k] = ex[k] / es;
        }
    }
}

__global__ void k_dispatch1(const unsigned* cnt, int* meta) {
    __shared__ int ts[33];
    if (threadIdx.x == 0) { int acc = 0; for (int e = 0; e < 32; ++e) { ts[e] = acc; acc += ((int)cnt[e] + 255) >> 8; } ts[32] = acc; meta[MT_NT] = acc; }
    __syncthreads();
    if (threadIdx.x < 33) meta[MT_TSTART + threadIdx.x] = ts[threadIdx.x];
    for (int t = threadIdx.x; t < NT_MAX; t += blockDim.x) { int e = 0; for (int j = 1; j < 32; ++j) if (t >= ts[j]) e = j; meta[MT_TILE_E + t] = e; }
}
__global__ void k_rowinit(int* meta) {
    const int i = blockIdx.x * blockDim.x + threadIdx.x;
    if (i < NROWS_MAX) { meta[MT_ROW_TOK + i] = 0; ((float*)meta)[MT_ROW_GATE + i] = 0.f; }
}
__global__ void k_scatter(int* meta) {
    const int i = blockIdx.x * blockDim.x + threadIdx.x;
    if (i < T * 4) {
        const int e = meta[MT_SEL_E + i], row = meta[MT_TSTART + e] * 256 + meta[MT_SEL_POS + i];
        meta[MT_ROW_TOK + row] = i >> 2; ((float*)meta)[MT_ROW_GATE + row] = ((const float*)meta)[MT_SEL_G + i]; meta[MT_SLOT_ROW + i] = row;
    }
}

struct EpiGateUpN {
    const float* bg; const float* bu; bf16* HID;
    __device__ __forceinline__ void operator()(int row, int c, float a, float b) const {
        const float gt = fminf(a + bg[c], 7.0f), up = fminf(fmaxf(b + bu[c], -7.0f), 7.0f);
        const float hid = gt / (1.0f + __expf(-1.702f * gt)) * (up + 1.0f);
        HID[(size_t)row * DFF + c] = (bf16)f2bf(hid);
    }
};
__global__ void __launch_bounds__(256) k_gateup_naive(const bf16* HB, const int* meta, const float* w_gate, const float* b_gate, const float* w_up, const float* b_up, bf16* HID) {
    const int tile = blockIdx.x >> 2, sub = blockIdx.x & 3;
    if (tile >= meta[MT_NT]) return;
    const int e = meta[MT_TILE_E + tile];
    EpiGateUpN epi{b_gate + (size_t)e * DFF, b_up + (size_t)e * DFF, HID};
    naive_gemm_tile<2>(HB, D, meta + MT_ROW_TOK, tile * 256 + sub * 64, w_gate + (size_t)e * D * DFF, w_up + (size_t)e * D * DFF, DFF, blockIdx.y * 64, D, epi);
}
struct EpiDownN {
    const float* bd; const float* row_gate; bf16* Y;
    __device__ __forceinline__ void operator()(int row, int c, float a, float) const { Y[(size_t)row * D + c] = (bf16)f2bf((a + bd[c]) * row_gate[row]); }
};
__global__ void __launch_bounds__(256) k_down_naive(const bf16* HID, const int* meta, const float* w_down, const float* b_down, bf16* Y) {
    const int tile = blockIdx.x >> 2, sub = blockIdx.x & 3;
    if (tile >= meta[MT_NT]) return;
    const int e = meta[MT_TILE_E + tile];
    EpiDownN epi{b_down + (size_t)e * D, (const float*)meta + MT_ROW_GATE, Y};
    naive_gemm_tile<1>(HID, DFF, nullptr, tile * 256 + sub * 64, w_down + (size_t)e * DFF * D, nullptr, D, blockIdx.y * 64, DFF, epi);
}

__global__ void __launch_bounds__(256) k_final_naive(float* HO, const bf16* Y, const int* meta, const float* ln2_g, const float* ln2_b) {
    const int w = threadIdx.x >> 6, lane = threadIdx.x & 63;
    const int tok = blockIdx.x * 4 + w;
    f32x4* hr = (f32x4*)(HO + (size_t)tok * D) + lane;
    f32x4 v[4]; float s = 0.f;
#pragma unroll
    for (int j = 0; j < 4; ++j) v[j] = hr[64 * j] * ALPHA;
#pragma unroll
    for (int k = 0; k < 4; ++k) {
        const int row = meta[MT_SLOT_ROW + tok * 4 + k];
        const u32x2* yr = (const u32x2*)(Y + (size_t)row * D) + lane;
#pragma unroll
        for (int j = 0; j < 4; ++j) { const u32x2 y = yr[64 * j]; v[j].x += __uint_as_float(y.x << 16); v[j].y += __uint_as_float(y.x & 0xffff0000u); v[j].z += __uint_as_float(y.y << 16); v[j].w += __uint_as_float(y.y & 0xffff0000u); }
    }
#pragma unroll
    for (int j = 0; j < 4; ++j) s += (v[j].x + v[j].y) + (v[j].z + v[j].w);
    const float mean = wave_sum(s) * (1.f / D); float s2 = 0.f;
#pragma unroll
    for (int j = 0; j < 4; ++j) { v[j] = v[j] - mean; s2 += (v[j].x * v[j].x + v[j].y * v[j].y) + (v[j].z * v[j].z + v[j].w * v[j].w); }
    const float rstd = rsqrtf(wave_sum(s2) * (1.f / D) + LN_EPS);
#pragma unroll
    for (int j = 0; j < 4; ++j) { const int c0 = 4 * lane + 256 * j; const f32x4 gg = *(const f32x4*)(ln2_g + c0), bb = *(const f32x4*)(ln2_b + c0); hr[64 * j] = v[j] * rstd * gg + bb; }
}

extern "C" void kernel_launch(void* const* d_in, const int* in_sizes, int n_in, void* d_out, int out_size, void* d_ws, size_t ws_size, hipStream_t stream) {
    if (n_in != 22 || in_sizes[0] != T * D || out_size != T * D || ws_size < WS_END_NAIVE) { fprintf(stderr, "kernel_launch: unexpected shapes (n_in %d, in0 %d, out %d, ws %zu)\n", n_in, n_in > 0 ? in_sizes[0] : -1, out_size, ws_size); return; }
    const float* x = (const float*)d_in[0]; const float* w_in = (const float*)d_in[1]; const float* b_in = (const float*)d_in[2]; const float* sinks = (const float*)d_in[3];
    const float* ln_v_g = (const float*)d_in[4]; const float* ln_v_b = (const float*)d_in[5]; const float* w_sp = (const float*)d_in[6]; const float* b_sp = (const float*)d_in[7];
    const float* w_out = (const float*)d_in[8]; const float* b_out = (const float*)d_in[9]; const float* ln1_g = (const float*)d_in[10]; const float* ln1_b = (const float*)d_in[11];
    const float* w_r = (const float*)d_in[12]; const float* b_r = (const float*)d_in[13]; const float* w_gate = (const float*)d_in[14]; const float* b_gate = (const float*)d_in[15];
    const float* w_up = (const float*)d_in[16]; const float* b_up = (const float*)d_in[17]; const float* w_down = (const float*)d_in[18]; const float* b_down = (const float*)d_in[19];
    const float* ln2_g = (const float*)d_in[20]; const float* ln2_b = (const float*)d_in[21];
    unsigned char* ws = (unsigned char*)d_ws; float* out = (float*)d_out;
    unsigned* ctl = (unsigned*)(ws + WS_CTL); int* meta = (int*)(ws + WS_META);
    bf16 *XB = (bf16*)(ws + WS_XB), *QB = (bf16*)(ws + WS_QB), *KB = (bf16*)(ws + WS_KB), *VT = (bf16*)(ws + WS_VT), *UB = (bf16*)(ws + WS_UB), *GB = (bf16*)(ws + WS_GB);
    bf16 *CAT = (bf16*)(ws + WS_CAT), *HB = (bf16*)(ws + WS_HB), *Y = (bf16*)(ws + WS_Y), *HID = (bf16*)(ws + WS_HID);
    (void)hipMemsetAsync(ws + WS_CTL, 0, 1 * MiB, stream);
    k_cvt_x<<<2048, 256, 0, stream>>>(x, XB, T * D / 4);
    k_inproj_naive<<<dim3(T / 64, INW / 64), 256, 0, stream>>>(XB, w_in, EpiInProjN{b_in, QB, KB, VT, UB, GB});
    k_attn_naive<<<T * NQH / 4, 256, 0, stream>>>(QB, KB, VT, sinks, CAT);
    k_sgu_naive<<<T / 128 * 8, 256, 0, stream>>>(UB, GB, ln_v_g, ln_v_b, w_sp, b_sp, CAT);
    k_outproj_naive<<<dim3(T / 64, D / 64), 256, 0, stream>>>(CAT, w_out, EpiOutProjN{b_out, x, out});
    k_router_naive<<<T / 4, 256, 0, stream>>>(out, HB, ln1_g, ln1_b, w_r, b_r, ctl + CW_CNT, meta);
    k_dispatch1<<<1, 64, 0, stream>>>(ctl + CW_CNT, meta);
    k_rowinit<<<(NROWS_MAX + 255) / 256, 256, 0, stream>>>(meta);
    k_scatter<<<T * 4 / 256, 256, 0, stream>>>(meta);
    k_gateup_naive<<<dim3(NT_MAX * 4, DFF / 64), 256, 0, stream>>>(HB, meta, w_gate, b_gate, w_up, b_up, HID);
    k_down_naive<<<dim3(NT_MAX * 4, D / 64), 256, 0, stream>>>(HID, meta, w_down, b_down, Y);
    k_final_naive<<<T / 4, 256, 0, stream>>>(out, Y, meta, ln2_g, ln2_b);
}
```

```cpp
#include <hip/hip_runtime.h>
#include <cstdio>
#include <cstdint>

typedef unsigned short bf16;
typedef float f32x4 __attribute__((ext_vector_type(4)));
typedef unsigned u32x4 __attribute__((ext_vector_type(4)));
typedef unsigned u32x2 __attribute__((ext_vector_type(2)));

constexpr int BATCH = 2, SEQ = 8192, D = 1024, T = BATCH * SEQ;
constexpr int NQH = 8, NKVH = 2, HD = 64, QREP = 4, AW = 512, KVW = 128, GW = 512, INW = 1792;
constexpr int NEXP = 32, TOPK = 4, DFF = 1024;
constexpr int NT_MAX = T * TOPK / 256 + NEXP;
constexpr int NROWS_MAX = NT_MAX * 256;
constexpr float LN_EPS = 1e-5f;
constexpr float ALPHA = 1.189207115002721f;
constexpr float C2 = 0.125f * 1.4426950408889634f;
constexpr float LOG2E = 1.4426950408889634f;

constexpr size_t MiB = 1u << 20;
constexpr size_t WS_CTL = 0;
constexpr size_t WS_META = 1 * MiB;
constexpr size_t WS_XB = 3 * MiB;
constexpr size_t WS_QB = WS_XB + 32 * MiB;
constexpr size_t WS_KB = WS_QB + 16 * MiB;
constexpr size_t WS_VT = WS_KB + 4 * MiB;
constexpr size_t WS_UB = WS_VT + 4 * MiB;
constexpr size_t WS_GB = WS_UB + 16 * MiB;
constexpr size_t WS_CAT = WS_GB + 16 * MiB;
constexpr size_t WS_HB = WS_CAT + 32 * MiB;
constexpr size_t WS_Y = WS_XB;
constexpr size_t WS_HID = WS_HB + 32 * MiB;
constexpr size_t WS_END_NAIVE = WS_HID + 144 * MiB;
static_assert(WS_Y + 144 * MiB <= WS_HID, "Y overlay");

constexpr int CW_CNT = 64;
constexpr int MT_NT = 0;
constexpr int MT_TSTART = 16;
constexpr int MT_TILE_E = 64;
constexpr int MT_SEL_E = 1024;
constexpr int MT_SEL_POS = MT_SEL_E + T * 4;
constexpr int MT_SEL_G = MT_SEL_POS + T * 4;
constexpr int MT_SLOT_ROW = MT_SEL_G + T * 4;
constexpr int MT_ROW_TOK = MT_SLOT_ROW + T * 4;
constexpr int MT_ROW_GATE = MT_ROW_TOK + NROWS_MAX;
static_assert((size_t)(MT_ROW_GATE + NROWS_MAX) * 4 <= 2 * MiB, "meta");

__device__ __forceinline__ float bf2f(bf16 v) { return __uint_as_float((unsigned)v << 16); }
__device__ __forceinline__ unsigned f2bf(float f) { unsigned u = __float_as_uint(f); return (u + 0x7fffu + ((u >> 16) & 1u)) >> 16; }
__device__ __forceinline__ unsigned pk2(float lo, float hi) { return f2bf(lo) | (f2bf(hi) << 16); }
__device__ __forceinline__ float gelu_tanh(float x) {
    const float k2 = 2.0f * 0.7978845608028654f;
    const float u = k2 * (x + 0.044715f * x * x * x);
    return x / (1.0f + __expf(-u));
}
__device__ __forceinline__ float wave_sum(float v) {
#pragma unroll
    for (int o = 1; o < 64; o <<= 1) v += __shfl_xor(v, o);
    return v;
}
__device__ __forceinline__ float wave_max(float v) {
#pragma unroll
    for (int o = 1; o < 64; o <<= 1) v = fmaxf(v, __shfl_xor(v, o));
    return v;
}

__global__ void k_cvt_x(const float* __restrict__ x, bf16* __restrict__ xb, int n4) {
    for (int i = blockIdx.x * blockDim.x + threadIdx.x; i < n4; i += gridDim.x * blockDim.x) {
        const f32x4 v = ((const f32x4*)x)[i];
        u32x2 o; o.x = pk2(v.x, v.y); o.y = pk2(v.z, v.w);
        ((u32x2*)xb)[i] = o;
    }
}

template <int NB, class Epi>
__device__ __forceinline__ void naive_gemm_tile(const bf16* A, int lda, const int* rowidx, int m0, const float* B0, const float* B1, int ldb, int n0, int K, const Epi& epi) {
    __shared__ float As[16][68];
    __shared__ float Bs[NB][16][64];
    const int tid = threadIdx.x, ty = tid >> 4, tx = tid & 15;
    float acc[NB][4][4];
#pragma unroll
    for (int b = 0; b < NB; ++b)
#pragma unroll
        for (int i = 0; i < 4; ++i)
#pragma unroll
            for (int j = 0; j < 4; ++j) acc[b][i][j] = 0.f;
    const int ar = tid >> 2, ac = (tid & 3) * 4;
    const int arow = rowidx ? rowidx[m0 + ar] : (m0 + ar);
    const bf16* ap = A + (size_t)arow * lda + ac;
    const int br = tid >> 4, bc = (tid & 15) * 4;
    for (int k0 = 0; k0 < K; k0 += 16) {
        const u32x2 av = *(const u32x2*)(ap + k0);
        As[ac + 0][ar] = __uint_as_float(av.x << 16); As[ac + 1][ar] = __uint_as_float(av.x & 0xffff0000u);
        As[ac + 2][ar] = __uint_as_float(av.y << 16); As[ac + 3][ar] = __uint_as_float(av.y & 0xffff0000u);
        *(f32x4*)&Bs[0][br][bc] = *(const f32x4*)(B0 + (size_t)(k0 + br) * ldb + n0 + bc);
        if (NB == 2) *(f32x4*)&Bs[NB - 1][br][bc] = *(const f32x4*)(B1 + (size_t)(k0 + br) * ldb + n0 + bc);
        __syncthreads();
#pragma unroll
        for (int k = 0; k < 16; ++k) {
            const f32x4 a = *(const f32x4*)&As[k][ty * 4];
#pragma unroll
            for (int b = 0; b < NB; ++b) {
                const f32x4 bv = *(const f32x4*)&Bs[b][k][tx * 4];
#pragma unroll
                for (int i = 0; i < 4; ++i)
#pragma unroll
                    for (int j = 0; j < 4; ++j) acc[b][i][j] += a[i] * bv[j];
            }
        }
        __syncthreads();
    }
#pragma unroll
    for (int i = 0; i < 4; ++i)
#pragma unroll
        for (int j = 0; j < 4; ++j) {
            if (NB == 2) epi(m0 + ty * 4 + i, n0 + tx * 4 + j, acc[0][i][j], acc[NB - 1][i][j]);
            else epi(m0 + ty * 4 + i, n0 + tx * 4 + j, acc[0][i][j], 0.f);
        }
}

struct EpiInProjN {
    const float* b_in; bf16 *QB, *KB, *VT, *UB, *GB;
    __device__ __forceinline__ void operator()(int row, int c, float a, float) const {
        const float v = a + b_in[c];
        if (c < 512) QB[(size_t)row * 512 + c] = (bf16)f2bf(v * C2);
        else if (c < 640) KB[(size_t)row * 128 + (c - 512)] = (bf16)f2bf(v);
        else if (c < 768) { const int cv = c - 640, g = cv >> 6, d = cv & 63, b = row / SEQ, s = row % SEQ; VT[((size_t)((b * 2 + g) * 64 + d)) * SEQ + s] = (bf16)f2bf(v); }
        else if (c < 1280) UB[(size_t)row * 512 + (c - 768)] = (bf16)f2bf(gelu_tanh(v));
        else GB[(size_t)row * 512 + (c - 1280)] = (bf16)f2bf(gelu_tanh(v));
    }
};
__global__ void __launch_bounds__(256) k_inproj_naive(const bf16* XB, const float* w_in, EpiInProjN epi) {
    naive_gemm_tile<1>(XB, D, nullptr, blockIdx.x * 64, w_in, nullptr, INW, blockIdx.y * 64, D, epi);
}

__global__ void __launch_bounds__(256) k_attn_naive(const bf16* QB, const bf16* KB, const bf16* VT, const float* sinks, bf16* CAT) {
    __shared__ float pl[4][128];
    const int w = threadIdx.x >> 6, lane = threadIdx.x & 63;
    const int wu = blockIdx.x * 4 + w;
    const int tok = wu >> 3, h = wu & 7, g = h >> 2, b = tok / SEQ, t = tok % SEQ;
    const float qv = bf2f(QB[(size_t)tok * 512 + h * 64 + lane]);
    float s[2];
    {
        const int kp0 = t - 127 + lane, kp1 = kp0 + 64;
        const bf16* kr0 = KB + (size_t)(b * SEQ + (kp0 < 0 ? 0 : kp0)) * 128 + g * 64;
        const bf16* kr1 = KB + (size_t)(b * SEQ + (kp1 < 0 ? 0 : kp1)) * 128 + g * 64;
        float a0 = 0.f, a1 = 0.f;
        for (int d = 0; d < 64; ++d) { const float qd = __shfl(qv, d); a0 += qd * bf2f(kr0[d]); a1 += qd * bf2f(kr1[d]); }
        s[0] = (kp0 >= 0) ? a0 : -1e30f; s[1] = (kp1 >= 0) ? a1 : -1e30f;
    }
    const float sk = sinks[h] * LOG2E;
    const float m = fmaxf(wave_max(fmaxf(s[0], s[1])), sk);
    const float p0 = exp2f(s[0] - m), p1 = exp2f(s[1] - m);
    const float l = wave_sum(p0 + p1) + exp2f(sk - m);
    pl[w][lane] = p0; pl[w][64 + lane] = p1;
    __syncthreads();
    const bf16* vr = VT + ((size_t)((b * 2 + g) * 64 + lane)) * SEQ;
    float o = 0.f;
    for (int j = 0; j < 128; ++j) { const int kp = t - 127 + j; if (kp >= 0) o += pl[w][j] * bf2f(vr[kp]); }
    CAT[(size_t)tok * 1024 + h * 64 + lane] = (bf16)f2bf(o / l);
}

__global__ void __launch_bounds__(256) k_sgu_naive(const bf16* UB, const bf16* GB, const float* ln_g, const float* ln_b, const float* w_s, const float* b_s, bf16* CAT) {
    __shared__ float G[128][65];
    const int u = blockIdx.x, gi = u & 7, ch = u >> 3;
    const int tid = threadIdx.x, s = tid >> 1, half = tid & 1;
    const size_t tok = (size_t)ch * 128 + s;
    float v[32]; float sum = 0.f;
#pragma unroll
    for (int i = 0; i < 32; ++i) { v[i] = bf2f(GB[tok * 512 + gi * 64 + half * 32 + i]); sum += v[i]; }
    sum += __shfl_xor(sum, 1);
    const float mu = sum * (1.f / 64.f); float q = 0.f;
#pragma unroll
    for (int i = 0; i < 32; ++i) { v[i] -= mu; q += v[i] * v[i]; }
    q += __shfl_xor(q, 1);
    const float rstd = rsqrtf(q * (1.f / 64.f) + LN_EPS);
#pragma unroll
    for (int i = 0; i < 32; ++i) { const int d = half * 32 + i; G[s][d] = v[i] * rstd * ln_g[gi * 64 + d] + ln_b[gi * 64 + d]; }
    __syncthreads();
    const int t = s;
    float acc[32];
#pragma unroll
    for (int i = 0; i < 32; ++i) acc[i] = 0.f;
    const float* wr = w_s + ((size_t)gi * 128 + t) * 128;
    for (int ss = 0; ss <= t; ++ss) {
        const float w = wr[ss];
#pragma unroll
        for (int i = 0; i < 32; ++i) acc[i] += w * G[ss][half * 32 + i];
    }
    const float bb = b_s[gi * 128 + t];
#pragma unroll
    for (int i = 0; i < 32; ++i) { const int d = half * 32 + i; const float uu = bf2f(UB[tok * 512 + gi * 64 + d]); CAT[tok * 1024 + 512 + gi * 64 + d] = (bf16)f2bf(uu * (acc[i] + bb)); }
}

struct EpiOutProjN {
    const float* b_out; const float* x; float* Z;
    __device__ __forceinline__ void operator()(int row, int c, float a, float) const { Z[(size_t)row * D + c] = ALPHA * x[(size_t)row * D + c] + a + b_out[c]; }
};
__global__ void __launch_bounds__(256) k_outproj_naive(const bf16* CAT, const float* w_out, EpiOutProjN epi) {
    naive_gemm_tile<1>(CAT, D, nullptr, blockIdx.x * 64, w_out, nullptr, D, blockIdx.y * 64, D, epi);
}

__global__ void __launch_bounds__(256) k_router_naive(float* ZH, bf16* HB, const float* ln1_g, const float* ln1_b, const float* w_r, const float* b_r, unsigned* cnt, int* meta) {
    const int w = threadIdx.x >> 6, lane = threadIdx.x & 63;
    const int tok = blockIdx.x * 4 + w;
    f32x4* zr = (f32x4*)(ZH + (size_t)tok * D) + lane;
    f32x4 v[4]; float s = 0.f;
#pragma unroll
    for (int j = 0; j < 4; ++j) { v[j] = zr[64 * j]; s += (v[j].x + v[j].y) + (v[j].z + v[j].w); }
    const float mean = wave_sum(s) * (1.f / D); float s2 = 0.f;
#pragma unroll
    for (int j = 0; j < 4; ++j) { v[j] = v[j] - mean; s2 += (v[j].x * v[j].x + v[j].y * v[j].y) + (v[j].z * v[j].z + v[j].w * v[j].w); }
    const float rstd = rsqrtf(wave_sum(s2) * (1.f / D) + LN_EPS);
    float lg[32];
#pragma unroll
    for (int e = 0; e < 32; ++e) lg[e] = 0.f;
#pragma unroll
    for (int j = 0; j < 4; ++j) {
        const int c0 = 4 * lane + 256 * j;
        const f32x4 gg = *(const f32x4*)(ln1_g + c0), bb = *(const f32x4*)(ln1_b + c0);
        v[j] = v[j] * rstd * gg + bb;
        zr[64 * j] = v[j];
        u32x2 o; o.x = pk2(v[j].x, v[j].y); o.y = pk2(v[j].z, v[j].w);
        *((u32x2*)(HB + (size_t)tok * D + c0)) = o;
#pragma unroll
        for (int i = 0; i < 4; ++i) {
            const float hv = v[j][i];
            const f32x4* wr = (const f32x4*)(w_r + (size_t)(c0 + i) * 32);
#pragma unroll
            for (int e4 = 0; e4 < 8; ++e4) { const f32x4 ww = wr[e4]; lg[e4 * 4 + 0] += hv * ww.x; lg[e4 * 4 + 1] += hv * ww.y; lg[e4 * 4 + 2] += hv * ww.z; lg[e4 * 4 + 3] += hv * ww.w; }
        }
    }
#pragma unroll
    for (int e = 0; e < 32; ++e) lg[e] = wave_sum(lg[e]) + b_r[e];
    int bi[4]; float bv[4];
#pragma unroll
    for (int k = 0; k < 4; ++k) {
        float best = -INFINITY; int b = 0;
#pragma unroll
        for (int e = 0; e < 32; ++e) if (lg[e] > best) { best = lg[e]; b = e; }
#pragma unroll
        for (int e = 0; e < 32; ++e) if (e == b) lg[e] = -INFINITY;
        bi[k] = b; bv[k] = best;
    }
    float ex[4], es = 0.f;
#pragma unroll
    for (int k = 0; k < 4; ++k) { ex[k] = __expf(bv[k] - bv[0]); es += ex[k]; }
    if (lane == 0) {
#pragma unroll
        for (int k = 0; k < 4; ++k) {
            const unsigned pos = atomicAdd(&cnt[bi[k]], 1u);
            meta[MT_SEL_E + tok * 4 + k] = bi[k]; meta[MT_SEL_POS + tok * 4 + k] = (int)pos;
            ((float*)meta)[MT_SEL_G + tok * 4 + k] = ex[k] / es;
        }
    }
}

__global__ void k_dispatch1(const unsigned* cnt, int* meta) {
    __shared__ int ts[33];
    if (threadIdx.x == 0) { int acc = 0; for (int e = 0; e < 32; ++e) { ts[e] = acc; acc += ((int)cnt[e] + 255) >> 8; } ts[32] = acc; meta[MT_NT] = acc; }
    __syncthreads();
    if (threadIdx.x < 33) meta[MT_TSTART + threadIdx.x] = ts[threadIdx.x];
    for (int t = threadIdx.x; t < NT_MAX; t += blockDim.x) { int e = 0; for (int j = 1; j < 32; ++j) if (t >= ts[j]) e = j; meta[MT_TILE_E + t] = e; }
}
__global__ void k_rowinit(int* meta) {
    const int i = blockIdx.x * blockDim.x + threadIdx.x;
    if (i < NROWS_MAX) { meta[MT_ROW_TOK + i] = 0; ((float*)meta)[MT_ROW_GATE + i] = 0.f; }
}
__global__ void k_scatter(int* meta) {
    const int i = blockIdx.x * blockDim.x + threadIdx.x;
    if (i < T * 4) {
        const int e = meta[MT_SEL_E + i], row = meta[MT_TSTART + e] * 256 + meta[MT_SEL_POS + i];
        meta[MT_ROW_TOK + row] = i >> 2; ((float*)meta)[MT_ROW_GATE + row] = ((const float*)meta)[MT_SEL_G + i]; meta[MT_SLOT_ROW + i] = row;
    }
}

struct EpiGateUpN {
    const float* bg; const float* bu; bf16* HID;
    __device__ __forceinline__ void operator()(int row, int c, float a, float b) const {
        const float gt = fminf(a + bg[c], 7.0f), up = fminf(fmaxf(b + bu[c], -7.0f), 7.0f);
        const float hid = gt / (1.0f + __expf(-1.702f * gt)) * (up + 1.0f);
        HID[(size_t)row * DFF + c] = (bf16)f2bf(hid);
    }
};
__global__ void __launch_bounds__(256) k_gateup_naive(const bf16* HB, const int* meta, const float* w_gate, const float* b_gate, const float* w_up, const float* b_up, bf16* HID) {
    const int tile = blockIdx.x >> 2, sub = blockIdx.x & 3;
    if (tile >= meta[MT_NT]) return;
    const int e = meta[MT_TILE_E + tile];
    EpiGateUpN epi{b_gate + (size_t)e * DFF, b_up + (size_t)e * DFF, HID};
    naive_gemm_tile<2>(HB, D, meta + MT_ROW_TOK, tile * 256 + sub * 64, w_gate + (size_t)e * D * DFF, w_up + (size_t)e * D * DFF, DFF, blockIdx.y * 64, D, epi);
}
struct EpiDownN {
    const float* bd; const float* row_gate; bf16* Y;
    __device__ __forceinline__ void operator()(int row, int c, float a, float) const { Y[(size_t)row * D + c] = (bf16)f2bf((a + bd[c]) * row_gate[row]); }
};
__global__ void __launch_bounds__(256) k_down_naive(const bf16* HID, const int* meta, const float* w_down, const float* b_down, bf16* Y) {
    const int tile = blockIdx.x >> 2, sub = blockIdx.x & 3;
    if (tile >= meta[MT_NT]) return;
    const int e = meta[MT_TILE_E + tile];
    EpiDownN epi{b_down + (size_t)e * D, (const float*)meta + MT_ROW_GATE, Y};
    naive_gemm_tile<1>(HID, DFF, nullptr, tile * 256 + sub * 64, w_down + (size_t)e * DFF * D, nullptr, D, blockIdx.y * 64, DFF, epi);
}

__global__ void __launch_bounds__(256) k_final_naive(float* HO, const bf16* Y, const int* meta, const float* ln2_g, const float* ln2_b) {
    const int w = threadIdx.x >> 6, lane = threadIdx.x & 63;
    const int tok = blockIdx.x * 4 + w;
    f32x4* hr = (f32x4*)(HO + (size_t)tok * D) + lane;
    f32x4 v[4]; float s = 0.f;
#pragma unroll
    for (int j = 0; j < 4; ++j) v[j] = hr[64 * j] * ALPHA;
#pragma unroll
    for (int k = 0; k < 4; ++k) {
        const int row = meta[MT_SLOT_ROW + tok * 4 + k];
        const u32x2* yr = (const u32x2*)(Y + (size_t)row * D) + lane;
#pragma unroll
        for (int j = 0; j < 4; ++j) { const u32x2 y = yr[64 * j]; v[j].x += __uint_as_float(y.x << 16); v[j].y += __uint_as_float(y.x & 0xffff0000u); v[j].z += __uint_as_float(y.y << 16); v[j].w += __uint_as_float(y.y & 0xffff0000u); }
    }
#pragma unroll
    for (int j = 0; j < 4; ++j) s += (v[j].x + v[j].y) + (v[j].z + v[j].w);
    const float mean = wave_sum(s) * (1.f / D); float s2 = 0.f;
#pragma unroll
    for (int j = 0; j < 4; ++j) { v[j] = v[j] - mean; s2 += (v[j].x * v[j].x + v[j].y * v[j].y) + (v[j].z * v[j].z + v[j].w * v[j].w); }
    const float rstd = rsqrtf(wave_sum(s2) * (1.f / D) + LN_EPS);
#pragma unroll
    for (int j = 0; j < 4; ++j) { const int c0 = 4 * lane + 256 * j; const f32x4 gg = *(const f32x4*)(ln2_g + c0), bb = *(const f32x4*)(ln2_b + c0); hr[64 * j] = v[j] * rstd * gg + bb; }
}

#define LAS __attribute__((address_space(3)))
#define GAS __attribute__((address_space(1)))
typedef short bf16x8 __attribute__((ext_vector_type(8)));
typedef float f32x16 __attribute__((ext_vector_type(16)));
typedef float f32x2 __attribute__((ext_vector_type(2)));
__device__ __forceinline__ unsigned cvt_pk_bf16(float lo, float hi) { unsigned r; asm volatile("v_cvt_pk_bf16_f32 %0, %1, %2" : "=v"(r) : "v"(lo), "v"(hi)); return r; }
__device__ __forceinline__ float fast_gelu(float x) {
    const float u = -2.0f * 0.7978845608028654f * LOG2E * (x + 0.044715f * x * x * x);
    return x * __builtin_amdgcn_rcpf(1.0f + __builtin_amdgcn_exp2f(u));
}
namespace pg8 {
constexpr int BM = 256, BK = 64, HALF = 128, HTB = HALF * BK * 2  , STAGE_BYTES = 8 * HTB, NXCD = 8, WGM = 8;
__host__ __device__ __forceinline__ int lds_byte(int r, int c) { const int st = (r >> 4) * 2 + (c >> 5), rr = r & 15, cc = c & 31, ob = rr * 64 + cc * 2; return st * 1024 + (ob ^ (((ob >> 9) & 1) << 5)); }
__host__ __device__ __forceinline__ void stage_rc(int b, int& R, int& C) { const int st = b / 1024, sb = b % 1024, swz = sb ^ (((sb >> 9) & 1) << 5); R = (st >> 1) * 16 + swz / 64; C = (st & 1) * 32 + (swz % 64) / 2; }
__host__ __device__ __forceinline__ int perm32(int rho) { const int n = rho >> 4, i = rho & 15; return 8 * (i >> 2) + 4 * n + (i & 3); }

struct Unit { int pm, pn; };
struct Gemm { const bf16* A; const bf16* Bt; int K; const int* tile_e; unsigned e_stride; };

struct StaticOrder {
    int nM, nN, nwg, G, c;
    __device__ void init(int nM_, int nN_, int G_, int c_) { nM = nM_; nN = nN_; nwg = nM * nN; G = G_; c = c_; }
    __device__ bool next(int i, Unit& u) const {
        const long L = (long)i * G + c; if (L >= nwg) return false;
        int wgid = (int)L; { const int q = nwg / NXCD, r = nwg % NXCD, xcd = wgid % NXCD, off = wgid / NXCD; wgid = (xcd < r ? xcd * (q + 1) : r * (q + 1) + (xcd - r) * q) + off; }
        const int nig = WGM * nN, gid = wgid / nig, fm = gid * WGM, gsz = (nM - fm) < WGM ? (nM - fm) : WGM;
        u.pm = fm + ((wgid % nig) % gsz); u.pn = (wgid % nig) / gsz; return true;
    }
};

template <class Epi, bool GATHER, bool ALIGN_EPI>
__device__ __forceinline__ void gemm_phase(LAS unsigned char* lds, const LAS int* rtab, const Gemm g, const StaticOrder& S, const Epi& E) {
    const int tid = threadIdx.x, wid = __builtin_amdgcn_readfirstlane(tid >> 6), lane = tid & 63, wr = wid >> 2, wc = wid & 3, fr = lane & 15, fq = lane >> 4;
    const int K = g.K, nt = K / BK;
    int Rs[2], Cs[2]; unsigned voffB[2];
#pragma unroll
    for (int i = 0; i < 2; ++i) { int R, C; stage_rc(tid * 16 + i * 8192, R, C); const int Rb = Epi::PERM ? ((R & ~31) + perm32(R & 31)) : R; Rs[i] = R; Cs[i] = C; voffB[i] = (unsigned)(Rb * K + C) * 2u; }
    const size_t kstep = (size_t)(BK * 2);
    const size_t hstep = (size_t)HALF * K * 2;
    const size_t tstep = 2 * hstep;
    const unsigned ldsw = (unsigned)wid * 1024u;
    const int aoff = lds_byte(wr * 64 + fr, fq * 8), boff = lds_byte(wc * 32 + fr, fq * 8);
#define PG8_SA(b, h) (((b) * 2 + (h)) * HTB)
#define PG8_SB(b, h) ((4 + (b) * 2 + (h)) * HTB)
#define PG8_STAGE(bufoff, gbase, voff) do { _Pragma("unroll") for (int _i = 0; _i < 2; ++_i) \
        __builtin_amdgcn_global_load_lds((const unsigned*)((const char*)(gbase) + (voff)[_i]), (LAS unsigned*)(lds + (bufoff) + ldsw + _i * 8192), 16, 0, 0); } while (0)
#define PG8_LDA(dst, b, h) do { _Pragma("unroll") for (int m = 0; m < 4; ++m) _Pragma("unroll") for (int k = 0; k < 2; ++k) dst[m][k] = *(const LAS bf16x8*)(lds + PG8_SA(b, h) + aoff + m * 2048 + k * 1024); } while (0)
#define PG8_LDB(dst, b, h) do { _Pragma("unroll") for (int n = 0; n < 2; ++n) _Pragma("unroll") for (int k = 0; k < 2; ++k) dst[n][k] = *(const LAS bf16x8*)(lds + PG8_SB(b, h) + boff + n * 2048 + k * 1024); } while (0)
#define PG8_MMA(ai, bj, At, Bt) do { __builtin_amdgcn_s_setprio(1); _Pragma("unroll") for (int m = 0; m < 4; ++m) _Pragma("unroll") for (int n = 0; n < 2; ++n) _Pragma("unroll") for (int k = 0; k < 2; ++k) \
        acc[ai][bj][m][n] = __builtin_amdgcn_mfma_f32_16x16x32_bf16(Bt[n][k], At[m][k], acc[ai][bj][m][n], 0, 0, 0); __builtin_amdgcn_s_setprio(0); } while (0)
#define PG8_WAIT_V(n) asm volatile("s_waitcnt vmcnt(" #n ")" ::: "memory")
#define PG8_WAIT_L(n) asm volatile("s_waitcnt lgkmcnt(" #n ")" ::: "memory")
#define PG8_BAR __builtin_amdgcn_s_barrier()
#define PG8_SCHED __builtin_amdgcn_sched_barrier(0)
#define PG8_VOFFA(vo, ui_, u_) do { _Pragma("unroll") for (int h_ = 0; h_ < 2; ++h_) _Pragma("unroll") for (int i_ = 0; i_ < 2; ++i_) { \
        const int row_ = GATHER ? rtab[(ui_) * 256 + h_ * 128 + Rs[i_]] : ((u_).pm * 256 + h_ * 128 + Rs[i_]); \
        vo[h_][i_] = (unsigned)(row_ * K + Cs[i_]) * 2u; } } while (0)
#define PG8_BBASE(u_) ((const char*)g.Bt + (g.tile_e ? (size_t)g.tile_e[(u_).pm] * g.e_stride : (size_t)0) + (size_t)(u_).pn * tstep)
    Unit cur, nxt; int ui = 0;
    if (!S.next(0, cur)) return;
    f32x4 acc[2][2][4][2];
#pragma unroll
    for (int a = 0; a < 2; ++a)
#pragma unroll
        for (int b = 0; b < 2; ++b)
#pragma unroll
            for (int m = 0; m < 4; ++m)
#pragma unroll
                for (int n = 0; n < 2; ++n) acc[a][b][m][n] = (f32x4){0.f, 0.f, 0.f, 0.f};
    bf16x8 At[4][2], B0[2][2], B1[2][2];
    unsigned vAc[2][2], vAn[2][2];
    PG8_VOFFA(vAc, 0, cur);
    const char* const gA = (const char*)g.A;
    const char* cB = PG8_BBASE(cur);
    PG8_STAGE(PG8_SB(0, 0), cB, voffB); PG8_STAGE(PG8_SB(0, 1), cB + hstep, voffB); PG8_STAGE(PG8_SA(0, 0), gA, vAc[0]); PG8_STAGE(PG8_SA(0, 1), gA, vAc[1]);
    if (wr == 1) PG8_BAR;
    PG8_WAIT_V(2); PG8_BAR;
    PG8_STAGE(PG8_SB(1, 0), cB + kstep, voffB); PG8_STAGE(PG8_SA(1, 0), gA + kstep, vAc[0]); PG8_STAGE(PG8_SB(1, 1), cB + hstep + kstep, voffB);
    PG8_WAIT_V(6); PG8_BAR;
    for (;;) {
        const bool has_next = S.next(ui + 1, nxt);
        const char* nB = cB;
        if (has_next) { nB = PG8_BBASE(nxt); PG8_VOFFA(vAn, ui + 1, nxt); }
        else {
#pragma unroll
            for (int h = 0; h < 2; ++h)
#pragma unroll
                for (int i = 0; i < 2; ++i) vAn[h][i] = vAc[h][i];
        }
        for (int t = 0; t < nt; t += 2) {
            const bool last = (t == nt - 2);
            const char* a1 = gA + (size_t)(t + 1) * kstep;
            const char* a2 = last ? gA : gA + (size_t)(t + 2) * kstep; const char* b2 = last ? nB : cB + (size_t)(t + 2) * kstep;
            const char* a3 = a2 + kstep; const char* b3 = b2 + kstep;
            unsigned v2[2][2];
#pragma unroll
            for (int h = 0; h < 2; ++h)
#pragma unroll
                for (int i = 0; i < 2; ++i) v2[h][i] = last ? vAn[h][i] : vAc[h][i];
            PG8_LDB(B0, 0, 0); PG8_LDB(B1, 0, 1); PG8_SCHED; PG8_LDA(At, 0, 0); PG8_STAGE(PG8_SA(1, 1), a1, vAc[1]);
            PG8_WAIT_V(8); PG8_WAIT_L(0); PG8_BAR; PG8_MMA(0, 0, At, B0); PG8_MMA(0, 1, At, B1); PG8_BAR; PG8_SCHED;
            PG8_LDA(At, 0, 1); PG8_STAGE(PG8_SB(0, 0), b2, voffB); PG8_STAGE(PG8_SB(0, 1), b2 + hstep, voffB); PG8_STAGE(PG8_SA(0, 0), a2, v2[0]);
            PG8_WAIT_V(8); PG8_WAIT_L(0); PG8_BAR; PG8_MMA(1, 0, At, B0); PG8_MMA(1, 1, At, B1); PG8_BAR; PG8_SCHED;
            PG8_LDB(B0, 1, 0); PG8_LDB(B1, 1, 1); PG8_SCHED; PG8_LDA(At, 1, 0); PG8_STAGE(PG8_SA(0, 1), a2, v2[1]);
            PG8_WAIT_V(8); PG8_WAIT_L(0); PG8_BAR; PG8_MMA(0, 0, At, B0); PG8_MMA(0, 1, At, B1); PG8_BAR; PG8_SCHED;
            PG8_LDA(At, 1, 1); PG8_STAGE(PG8_SB(1, 0), b3, voffB); PG8_STAGE(PG8_SB(1, 1), b3 + hstep, voffB); PG8_STAGE(PG8_SA(1, 0), a3, v2[0]);
            PG8_WAIT_V(8); PG8_WAIT_L(0); PG8_BAR; PG8_MMA(1, 0, At, B0); PG8_MMA(1, 1, At, B1); PG8_BAR; PG8_SCHED;
        }
        if constexpr (ALIGN_EPI) { if (wr == 0) PG8_BAR; }
        E(acc, cur, wr, wc, fr, fq);
        if (!has_next) break;
#pragma unroll
        for (int a = 0; a < 2; ++a)
#pragma unroll
            for (int b = 0; b < 2; ++b)
#pragma unroll
                for (int m = 0; m < 4; ++m)
#pragma unroll
                    for (int n = 0; n < 2; ++n) acc[a][b][m][n] = (f32x4){0.f, 0.f, 0.f, 0.f};
        cur = nxt; cB = nB; ++ui;
#pragma unroll
        for (int h = 0; h < 2; ++h)
#pragma unroll
            for (int i = 0; i < 2; ++i) vAc[h][i] = vAn[h][i];
        if constexpr (ALIGN_EPI) { if (wr == 1) PG8_BAR; }
    }
    PG8_WAIT_V(0);
    if constexpr (!ALIGN_EPI) { if (wr == 0) PG8_BAR; }
    PG8_BAR;
#undef PG8_SA
#undef PG8_SB
#undef PG8_STAGE
#undef PG8_LDA
#undef PG8_LDB
#undef PG8_MMA
#undef PG8_WAIT_V
#undef PG8_WAIT_L
#undef PG8_BAR
#undef PG8_SCHED
#undef PG8_VOFFA
#undef PG8_BBASE
}

struct EpiInProj {
    static constexpr bool PERM = true;
    const float* b_in; bf16 *QB, *KB, *VT, *UB, *GB;
    __device__ __forceinline__ void operator()(const f32x4 (&acc)[2][2][4][2], const Unit& u, int wr, int wc, int fr, int fq) const {
        const int row0 = u.pm * BM + wr * 64 + fr;
#pragma unroll
        for (int bj = 0; bj < 2; ++bj) {
            const int reg = u.pn * BM + bj * HALF;
            const int c0 = reg + wc * 32 + 8 * fq;
            const f32x4 bv0 = *(const f32x4*)(b_in + c0), bv1 = *(const f32x4*)(b_in + c0 + 4);
#pragma unroll
            for (int ai = 0; ai < 2; ++ai)
#pragma unroll
                for (int m = 0; m < 4; ++m) {
                    const int row = row0 + ai * HALF + m * 16;
                    f32x4 v0 = acc[ai][bj][m][0] + bv0, v1 = acc[ai][bj][m][1] + bv1;
                    if (reg >= 640 && reg < 768) {
                        const int cv = c0 - 640, gg = cv >> 6, d = cv & 63, b = row / SEQ, s = row % SEQ;
                        bf16* vp = VT + ((size_t)((b * 2 + gg) * 64 + d)) * SEQ + s;
#pragma unroll
                        for (int j = 0; j < 4; ++j) { vp[(size_t)j * SEQ] = (bf16)f2bf(v0[j]); vp[(size_t)(j + 4) * SEQ] = (bf16)f2bf(v1[j]); }
                    } else {
                        bf16* dst;
                        if (reg < 512) { v0 = v0 * C2; v1 = v1 * C2; dst = QB + (size_t)row * 512 + c0; }
                        else if (reg < 640) { dst = KB + (size_t)row * 128 + (c0 - 512); }
                        else {
#pragma unroll
                            for (int j = 0; j < 4; ++j) { v0[j] = fast_gelu(v0[j]); v1[j] = fast_gelu(v1[j]); }
                            dst = (reg < 1280) ? (UB + (size_t)row * 512 + (c0 - 768)) : (GB + (size_t)row * 512 + (c0 - 1280));
                        }
                        u32x4 w; w.x = cvt_pk_bf16(v0[0], v0[1]); w.y = cvt_pk_bf16(v0[2], v0[3]); w.z = cvt_pk_bf16(v1[0], v1[1]); w.w = cvt_pk_bf16(v1[2], v1[3]);
                        *(u32x4*)dst = w;
                    }
                }
        }
    }
};
struct EpiOutProj {
    static constexpr bool PERM = false;
    const float* x; const float* b_out; float* Z;
    __device__ __forceinline__ void operator()(const f32x4 (&acc)[2][2][4][2], const Unit& u, int wr, int wc, int fr, int fq) const {
        const int col0 = u.pn * BM + wc * 32 + 4 * fq;
#pragma unroll
        for (int ai = 0; ai < 2; ++ai)
#pragma unroll
            for (int m = 0; m < 4; ++m) {
                const size_t off = (size_t)(u.pm * BM + ai * HALF + wr * 64 + m * 16 + fr) * D + col0;
#pragma unroll
                for (int bj = 0; bj < 2; ++bj)
#pragma unroll
                    for (int n = 0; n < 2; ++n) {
                        const f32x4 xv = *(const f32x4*)(x + off + bj * HALF + n * 16), bv = *(const f32x4*)(b_out + col0 + bj * HALF + n * 16);
                        *(f32x4*)(Z + off + bj * HALF + n * 16) = xv * ALPHA + acc[ai][bj][m][n] + bv;
                    }
            }
    }
};
struct EpiSwiglu {
    static constexpr bool PERM = true;
    const int* tile_e; const float* b_gate; const float* b_up; bf16* HID;
    __device__ __forceinline__ void operator()(const f32x4 (&acc)[2][2][4][2], const Unit& u, int wr, int wc, int fr, int fq) const {
        const int e = tile_e[u.pm];
        const int fc0 = u.pn * HALF + wc * 32 + 8 * fq;
        const f32x4 g0 = *(const f32x4*)(b_gate + e * DFF + fc0), g1 = *(const f32x4*)(b_gate + e * DFF + fc0 + 4);
        const f32x4 u0 = *(const f32x4*)(b_up + e * DFF + fc0), u1 = *(const f32x4*)(b_up + e * DFF + fc0 + 4);
#pragma unroll
        for (int ai = 0; ai < 2; ++ai)
#pragma unroll
            for (int m = 0; m < 4; ++m) {
                const int row = u.pm * BM + ai * HALF + wr * 64 + m * 16 + fr;
                float hv[8];
#pragma unroll
                for (int j = 0; j < 8; ++j) {
                    const float ga = (j < 4 ? acc[ai][0][m][0][j & 3] + g0[j & 3] : acc[ai][0][m][1][j & 3] + g1[j & 3]);
                    const float ua = (j < 4 ? acc[ai][1][m][0][j & 3] + u0[j & 3] : acc[ai][1][m][1][j & 3] + u1[j & 3]);
                    const float gt = fminf(ga, 7.0f), up = fminf(fmaxf(ua, -7.0f), 7.0f);
                    hv[j] = gt * __builtin_amdgcn_rcpf(1.0f + __builtin_amdgcn_exp2f(-1.702f * LOG2E * gt)) * (up + 1.0f);
                }
                u32x4 w; w.x = cvt_pk_bf16(hv[0], hv[1]); w.y = cvt_pk_bf16(hv[2], hv[3]); w.z = cvt_pk_bf16(hv[4], hv[5]); w.w = cvt_pk_bf16(hv[6], hv[7]);
                *(u32x4*)(HID + (size_t)row * DFF + fc0) = w;
            }
    }
};
struct EpiDown {
    static constexpr bool PERM = true;
    const int* tile_e; const float* b_down; const float* row_gate; bf16* Y;
    __device__ __forceinline__ void operator()(const f32x4 (&acc)[2][2][4][2], const Unit& u, int wr, int wc, int fr, int fq) const {
        const int e = tile_e[u.pm];
#pragma unroll
        for (int bj = 0; bj < 2; ++bj) {
            const int c0 = u.pn * BM + bj * HALF + wc * 32 + 8 * fq;
            const f32x4 bv0 = *(const f32x4*)(b_down + e * D + c0), bv1 = *(const f32x4*)(b_down + e * D + c0 + 4);
#pragma unroll
            for (int ai = 0; ai < 2; ++ai)
#pragma unroll
                for (int m = 0; m < 4; ++m) {
                    const int row = u.pm * BM + ai * HALF + wr * 64 + m * 16 + fr;
                    const float gt = row_gate[row];
                    const f32x4 v0 = (acc[ai][bj][m][0] + bv0) * gt, v1 = (acc[ai][bj][m][1] + bv1) * gt;
                    u32x4 w; w.x = cvt_pk_bf16(v0[0], v0[1]); w.y = cvt_pk_bf16(v0[2], v0[3]); w.z = cvt_pk_bf16(v1[0], v1[1]); w.w = cvt_pk_bf16(v1[2], v1[3]);
                    *(u32x4*)(Y + (size_t)row * D + c0) = w;
                }
        }
    }
};
}
constexpr int NWAVES = 8;
constexpr int NPHASES = 9;
constexpr size_t WS_WIN = WS_HID + 144 * MiB;
constexpr size_t WS_WOUT = WS_WIN + 4 * MiB;
constexpr size_t WS_WGU = WS_WOUT + 2 * MiB;
constexpr size_t WS_WD = WS_WGU + 128 * MiB;
constexpr size_t WS_END = WS_WD + 64 * MiB;
constexpr int CW_BAR = 4096;
constexpr int RING_BYTES = 131072;
constexpr int RTAB_OFF = RING_BYTES;
constexpr int RTAB_UNITS = 12;
constexpr int RW_BYTES = 1024 * 144;
constexpr int RSCR_OFF = RW_BYTES;
constexpr int LDS_BYTES = 163840;
constexpr int MISC_OFF = LDS_BYTES - 256;
static_assert(RTAB_OFF + RTAB_UNITS * 1024 <= MISC_OFF && RSCR_OFF + 4096 <= MISC_OFF, "LDS map");

typedef GAS unsigned gu32;
#define RLX_AGENT __ATOMIC_RELAXED, __HIP_MEMORY_SCOPE_AGENT
#define LDS_WAIT() asm volatile("s_waitcnt lgkmcnt(0)" ::: "memory")
#define VM_WAIT() asm volatile("s_waitcnt vmcnt(0)" ::: "memory")

#define XB_TMO      128
#define XB_XCNT(j)  (256  + 64 * (j))
#define XB_XSUB(j)  (1280 + 64 * (j))
#define XB_XGEN(j)  (2304 + 64 * (j))
#define XB_TOP      3328
#define XB_TOPGEN   3392
#define XCD_BAR_WORDS 3456
#define XB_SPIN_CAP (1u << 18)
__device__ __forceinline__ unsigned xb_ld(unsigned* p)              { return __hip_atomic_load(p, __ATOMIC_RELAXED, __HIP_MEMORY_SCOPE_AGENT); }
__device__ __forceinline__ unsigned xb_add(unsigned* p, unsigned v) { return __hip_atomic_fetch_add(p, v, __ATOMIC_RELAXED, __HIP_MEMORY_SCOPE_AGENT); }
__device__ __forceinline__ unsigned xb_xcc_id() { return (unsigned)__builtin_amdgcn_s_getreg((3 << 11) | 20) & 0xFu; }
#define XB_SPIN(cond, bar) do { unsigned _sp = 0; while (cond) { __builtin_amdgcn_s_sleep(1); \
    if ((++_sp & 255u) == 0u) { if (xb_ld(&(bar)[XB_TMO])) break; if (_sp > XB_SPIN_CAP) { atomicAdd(&(bar)[XB_TMO], 1u); break; } } } } while (0)
struct XcdBarrier { unsigned* bar; unsigned x; volatile LAS unsigned* st; };
__device__ __forceinline__ XcdBarrier xcd_barrier_post(unsigned* bar, volatile LAS unsigned* st) {
    XcdBarrier b; b.bar = bar; b.x = xb_xcc_id(); b.st = st;
    if (threadIdx.x == 0) (void)xb_add(&bar[XB_XCNT(b.x)], 1u);
    return b;
}
__device__ __forceinline__ void xcd_barrier_complete(unsigned* bar, unsigned x, unsigned& nloc, unsigned& nx) {
    const unsigned G = gridDim.x * gridDim.y * gridDim.z;
    unsigned sum, cnt, mine, sp = 0u;
    for (;;) {
        sum = 0u; cnt = 0u; mine = 0u;
#pragma unroll
        for (unsigned j = 0; j < 16; ++j) { const unsigned c = xb_ld(&bar[XB_XCNT(j)]); sum += c; cnt += (c > 0u) ? 1u : 0u; mine = (j == x) ? c : mine; }
        if (sum == G) break;
        __builtin_amdgcn_s_sleep(1);
        if ((++sp & 255u) == 0u) { if (xb_ld(&bar[XB_TMO])) break; if (sp > XB_SPIN_CAP) { atomicAdd(&bar[XB_TMO], 1u); break; } }
    }
    nloc = mine > 0u ? mine : 1u; nx = cnt > 0u ? cnt : 1u;
}
__device__ __forceinline__ void xcd_barrier(const XcdBarrier& b) {
    asm volatile("s_waitcnt vmcnt(0)" ::: "memory");
    __syncthreads();
    if (threadIdx.x == 0) {
        unsigned* bar = b.bar;
        __builtin_amdgcn_s_waitcnt(0);
        unsigned nloc = b.st[0], nx = b.st[1];
        if (nloc == 0u) { xcd_barrier_complete(bar, b.x, nloc, nx); b.st[0] = nloc; b.st[1] = nx; }
        const unsigned old = xb_add(&bar[XB_XSUB(b.x)], 1u);
        const unsigned gen = old / nloc;
        if (old + 1u == (gen + 1u) * nloc) {
            __builtin_amdgcn_fence(__ATOMIC_RELEASE, "agent");
            asm volatile("s_waitcnt vmcnt(0)" ::: "memory");
            const unsigned og = xb_add(&bar[XB_TOP], 1u);
            const unsigned tg = og / nx;
            if (og + 1u == (tg + 1u) * nx) xb_add(&bar[XB_TOPGEN], 1u);
            else XB_SPIN(xb_ld(&bar[XB_TOPGEN]) == tg, bar);
            __builtin_amdgcn_fence(__ATOMIC_ACQUIRE, "agent");
            xb_add(&bar[XB_XGEN(b.x)], 1u);
            asm volatile("s_waitcnt vmcnt(0)" ::: "memory");
        } else {
            XB_SPIN(xb_ld(&bar[XB_XGEN(b.x)]) == gen, bar);
            __builtin_amdgcn_fence(__ATOMIC_ACQUIRE, "agent");
            asm volatile("s_waitcnt vmcnt(0)" ::: "memory");
        }
    }
    __syncthreads();
}

struct Args {
    const float* in[22]; float* out; unsigned char* ws; int ph_lo, ph_hi, li, pad;
};
struct Frame {
    LAS unsigned char* lds;
    int tid, lane, wave, vcu, G;
};
__device__ __forceinline__ void p0_item(const float* W, int N, bf16* WT, int K, int dst_row0, int k0, int n0, LAS float* scr, int lane) {
    f32x4 v[8];
#pragma unroll
    for (int i = 0; i < 8; ++i) v[i] = *(const f32x4*)(W + (size_t)(k0 + (lane >> 3) + 8 * i) * N + n0 + 4 * (lane & 7));
#pragma unroll
    for (int i = 0; i < 8; ++i) { LAS float* s = scr + ((lane >> 3) + 8 * i) * 33 + 4 * (lane & 7); s[0] = v[i].x; s[1] = v[i].y; s[2] = v[i].z; s[3] = v[i].w; }
    LDS_WAIT(); asm volatile("" ::: "memory");
    const int c = lane & 7;
#pragma unroll
    for (int j = 0; j < 4; ++j) { const int n = (lane >> 3) + 8 * j; const LAS float* s = scr + (8 * c) * 33 + n;
        u32x4 o; o.x = pk2(s[0 * 33], s[1 * 33]); o.y = pk2(s[2 * 33], s[3 * 33]); o.z = pk2(s[4 * 33], s[5 * 33]); o.w = pk2(s[6 * 33], s[7 * 33]);
        *(u32x4*)(WT + (size_t)(dst_row0 + n) * K + k0 + 8 * c) = o; }
    LDS_WAIT(); asm volatile("" ::: "memory");
}
__device__ __forceinline__ void p0_prologue(const Frame& F, const Args& a) {
    LAS float* scr = (LAS float*)(F.lds + F.wave * 8448);
    const int gw = F.vcu * NWAVES + F.wave, NGW = F.G * NWAVES;
    unsigned char* ws = a.ws;
    bf16* Win_t = (bf16*)(ws + WS_WIN); bf16* Wout_t = (bf16*)(ws + WS_WOUT); bf16* Wgu_t = (bf16*)(ws + WS_WGU); bf16* Wd_t = (bf16*)(ws + WS_WD);
    constexpr int I_IN = 16 * 56, I_OUT = 16 * 32, I_E = 512, NITEMS = I_IN + I_OUT + 96 * I_E;
    for (int it = gw; it < NITEMS; it += NGW) {
        int r = it;
        if (r < I_IN) { const int kb = r / 56, nb = r % 56; p0_item(a.in[1], INW, Win_t, D, nb * 32, kb * 64, nb * 32, scr, F.lane); continue; } r -= I_IN;
        if (r < I_OUT) { const int kb = r / 32, nb = r % 32; p0_item(a.in[8], D, Wout_t, D, nb * 32, kb * 64, nb * 32, scr, F.lane); continue; } r -= I_OUT;
        const int mat = r / I_E, idx = r % I_E, kind = mat >> 5, e = mat & 31, kb = idx >> 5, nb = idx & 31, n0 = nb * 32;
        if (kind == 0) p0_item(a.in[14] + (size_t)e * D * DFF, DFF, Wgu_t + (size_t)e * 2048 * D, D, (n0 >> 7) * 256 + (n0 & 127), kb * 64, n0, scr, F.lane);
        else if (kind == 1) p0_item(a.in[16] + (size_t)e * D * DFF, DFF, Wgu_t + (size_t)e * 2048 * D, D, (n0 >> 7) * 256 + 128 + (n0 & 127), kb * 64, n0, scr, F.lane);
        else p0_item(a.in[18] + (size_t)e * DFF * D, D, Wd_t + (size_t)e * D * DFF, DFF, n0, kb * 64, n0, scr, F.lane);
    }
    const float* x = a.in[0]; bf16* XB = (bf16*)(ws + WS_XB);
    for (int m = gw; m < T; m += NGW) {
        const f32x4* xr = (const f32x4*)(x + (size_t)m * D) + F.lane; u32x2* o = (u32x2*)(XB + (size_t)m * D) + F.lane;
        f32x4 v[4];
#pragma unroll
        for (int j = 0; j < 4; ++j) v[j] = xr[64 * j];
#pragma unroll
        for (int j = 0; j < 4; ++j) { u32x2 w; w.x = pk2(v[j].x, v[j].y); w.y = pk2(v[j].z, v[j].w); o[64 * j] = w; }
    }
}

__device__ __forceinline__ int crow(int r, int hi) { return (r & 3) + 8 * (r >> 2) + 4 * hi; }
__device__ __forceinline__ void attn_wave_unit(const bf16* QB, const bf16* KB, const bf16* VT, const float* sinks, bf16* CAT, int q32, int h, int lane) {
    const int r32 = lane & 31, hi = lane >> 5;
    const int tok0 = q32 * 32, b = tok0 / SEQ, t0 = tok0 % SEQ, g = h >> 2;
    bf16x8 qf[4];
#pragma unroll
    for (int d0 = 0; d0 < 4; ++d0) qf[d0] = *(const bf16x8*)(QB + (size_t)(tok0 + r32) * 512 + h * 64 + d0 * 16 + hi * 8);
    f32x16 p[5];
    const float NEG = -INFINITY;
#pragma unroll
    for (int j = 0; j < 5; ++j) {
        const int kb = t0 - 128 + 32 * j;
        f32x16 s;
#pragma unroll
        for (int r = 0; r < 16; ++r) s[r] = 0.f;
        if (kb >= 0) {
            const bf16* kr = KB + (size_t)(b * SEQ + kb + r32) * 128 + g * 64 + hi * 8;
            bf16x8 kf[4];
#pragma unroll
            for (int d0 = 0; d0 < 4; ++d0) kf[d0] = *(const bf16x8*)(kr + d0 * 16);
#pragma unroll
            for (int d0 = 0; d0 < 4; ++d0) s = __builtin_amdgcn_mfma_f32_32x32x16_bf16(kf[d0], qf[d0], s, 0, 0, 0);
            if (j == 0) {
#pragma unroll
                for (int r = 0; r < 16; ++r) if (!(crow(r, hi) > r32)) s[r] = NEG;
            }
            if (j == 4) {
#pragma unroll
                for (int r = 0; r < 16; ++r) if (!(crow(r, hi) <= r32)) s[r] = NEG;
            }
        } else {
#pragma unroll
            for (int r = 0; r < 16; ++r) s[r] = NEG;
        }
        p[j] = s;
    }
    const float sk = sinks[h] * LOG2E;
    float m = sk;
#pragma unroll
    for (int j = 0; j < 5; ++j)
#pragma unroll
        for (int r = 0; r < 16; ++r) m = fmaxf(m, p[j][r]);
    m = fmaxf(m, __shfl_xor(m, 32));
    float l = 0.f;
#pragma unroll
    for (int j = 0; j < 5; ++j)
#pragma unroll
        for (int r = 0; r < 16; ++r) { const float e = __builtin_amdgcn_exp2f(p[j][r] - m); p[j][r] = e; l += e; }
    l += __shfl_xor(l, 32);
    l += __builtin_amdgcn_exp2f(sk - m);
    const float inv = 1.0f / l;
    u32x4 pb[5][2];
#pragma unroll
    for (int j = 0; j < 5; ++j)
#pragma unroll
        for (int s = 0; s < 2; ++s) { pb[j][s].x = cvt_pk_bf16(p[j][8 * s + 0], p[j][8 * s + 1]); pb[j][s].y = cvt_pk_bf16(p[j][8 * s + 2], p[j][8 * s + 3]); pb[j][s].z = cvt_pk_bf16(p[j][8 * s + 4], p[j][8 * s + 5]); pb[j][s].w = cvt_pk_bf16(p[j][8 * s + 6], p[j][8 * s + 7]); }
#pragma unroll
    for (int db = 0; db < 2; ++db) {
        f32x16 o;
#pragma unroll
        for (int r = 0; r < 16; ++r) o[r] = 0.f;
        const bf16* vr = VT + ((size_t)((b * 2 + g) * 64 + db * 32 + r32)) * SEQ + 4 * hi;
#pragma unroll
        for (int j = 0; j < 5; ++j) {
            const int kb = t0 - 128 + 32 * j;
            if (kb >= 0) {
#pragma unroll
                for (int s = 0; s < 2; ++s) {
                    const u32x2 lo = *(const u32x2*)(vr + kb + 16 * s), hh = *(const u32x2*)(vr + kb + 16 * s + 8);
                    u32x4 av; av.x = lo.x; av.y = lo.y; av.z = hh.x; av.w = hh.y;
                    o = __builtin_amdgcn_mfma_f32_32x32x16_bf16(__builtin_bit_cast(bf16x8, av), __builtin_bit_cast(bf16x8, pb[j][s]), o, 0, 0, 0);
                }
            }
        }
        bf16* op = CAT + (size_t)(tok0 + r32) * 1024 + h * 64 + db * 32 + 4 * hi;
#pragma unroll
        for (int gq = 0; gq < 4; ++gq) { u32x2 w; w.x = cvt_pk_bf16(o[4 * gq] * inv, o[4 * gq + 1] * inv); w.y = cvt_pk_bf16(o[4 * gq + 2] * inv, o[4 * gq + 3] * inv); *(u32x2*)(op + 8 * gq) = w; }
    }
}
__device__ __forceinline__ void sgu_unit(const Frame& F, const bf16* UB, const bf16* GB, const float* ln_g, const float* ln_b, const float* w_s, const float* b_s, bf16* CAT, int ch, int gi) {
    LAS bf16* GT = (LAS bf16*)F.lds;
    {
        const int s = F.tid >> 2, q4 = F.tid & 3; const size_t tok = (size_t)ch * 128 + s;
        const u32x4* gp = (const u32x4*)(GB + tok * 512 + gi * 64 + q4 * 16);
        const u32x4 a = gp[0], c = gp[1];
        float v[16];
        v[0] = __uint_as_float(a.x << 16); v[1] = __uint_as_float(a.x & 0xffff0000u); v[2] = __uint_as_float(a.y << 16); v[3] = __uint_as_float(a.y & 0xffff0000u);
        v[4] = __uint_as_float(a.z << 16); v[5] = __uint_as_float(a.z & 0xffff0000u); v[6] = __uint_as_float(a.w << 16); v[7] = __uint_as_float(a.w & 0xffff0000u);
        v[8] = __uint_as_float(c.x << 16); v[9] = __uint_as_float(c.x & 0xffff0000u); v[10] = __uint_as_float(c.y << 16); v[11] = __uint_as_float(c.y & 0xffff0000u);
        v[12] = __uint_as_float(c.z << 16); v[13] = __uint_as_float(c.z & 0xffff0000u); v[14] = __uint_as_float(c.w << 16); v[15] = __uint_as_float(c.w & 0xffff0000u);
        float sum = 0.f;
#pragma unroll
        for (int i = 0; i < 16; ++i) sum += v[i];
        sum += __shfl_xor(sum, 1); sum += __shfl_xor(sum, 2);
        const float mu = sum * (1.f / 64.f); float q = 0.f;
#pragma unroll
        for (int i = 0; i < 16; ++i) { v[i] -= mu; q += v[i] * v[i]; }
        q += __shfl_xor(q, 1); q += __shfl_xor(q, 2);
        const float rstd = rsqrtf(q * (1.f / 64.f) + LN_EPS);
#pragma unroll
        for (int i = 0; i < 16; ++i) { const int d = q4 * 16 + i; GT[d * 136 + s] = (bf16)f2bf(v[i] * rstd * ln_g[gi * 64 + d] + ln_b[gi * 64 + d]); }
    }
    __syncthreads();
    {
        const int r32 = F.lane & 31, hi = F.lane >> 5, tb = F.wave >> 1, db = F.wave & 1, t = tb * 32 + r32;
        f32x16 acc;
#pragma unroll
        for (int r = 0; r < 16; ++r) acc[r] = 0.f;
        const float* wrow = w_s + ((size_t)gi * 128 + t) * 128;
        const LAS bf16* arow = GT + (db * 32 + r32) * 136 + hi * 8;
        const int nks = 2 * (tb + 1);
        for (int ks = 0; ks < nks; ++ks) {
            const bf16x8 af = *(const LAS bf16x8*)(arow + ks * 16);
            const int s0 = ks * 16 + hi * 8;
            f32x4 w0 = *(const f32x4*)(wrow + s0), w1 = *(const f32x4*)(wrow + s0 + 4);
#pragma unroll
            for (int j = 0; j < 4; ++j) { if (s0 + j > t) w0[j] = 0.f; if (s0 + 4 + j > t) w1[j] = 0.f; }
            u32x4 bw; bw.x = cvt_pk_bf16(w0[0], w0[1]); bw.y = cvt_pk_bf16(w0[2], w0[3]); bw.z = cvt_pk_bf16(w1[0], w1[1]); bw.w = cvt_pk_bf16(w1[2], w1[3]);
            acc = __builtin_amdgcn_mfma_f32_32x32x16_bf16(af, __builtin_bit_cast(bf16x8, bw), acc, 0, 0, 0);
        }
        const float bb = b_s[gi * 128 + t];
        const size_t tokt = (size_t)ch * 128 + t;
        const bf16* up = UB + tokt * 512 + gi * 64 + db * 32 + 4 * hi;
        bf16* op = CAT + tokt * 1024 + 512 + gi * 64 + db * 32 + 4 * hi;
#pragma unroll
        for (int gq = 0; gq < 4; ++gq) {
            const u32x2 uu = *(const u32x2*)(up + 8 * gq);
            const float u0 = __uint_as_float(uu.x << 16), u1 = __uint_as_float(uu.x & 0xffff0000u), u2 = __uint_as_float(uu.y << 16), u3 = __uint_as_float(uu.y & 0xffff0000u);
            u32x2 w; w.x = cvt_pk_bf16(u0 * (acc[4 * gq] + bb), u1 * (acc[4 * gq + 1] + bb)); w.y = cvt_pk_bf16(u2 * (acc[4 * gq + 2] + bb), u3 * (acc[4 * gq + 3] + bb));
            *(u32x2*)(op + 8 * gq) = w;
        }
    }
    __syncthreads();
}
__device__ __forceinline__ void p2_mixers(const Frame& F, const Args& a) {
    unsigned char* ws = a.ws;
    const bf16 *QB = (const bf16*)(ws + WS_QB), *KB = (const bf16*)(ws + WS_KB), *VT = (const bf16*)(ws + WS_VT), *UB = (const bf16*)(ws + WS_UB), *GB = (const bf16*)(ws + WS_GB);
    bf16* CAT = (bf16*)(ws + WS_CAT);
    for (int qq = F.vcu; qq < T / 64; qq += F.G) {
        attn_wave_unit(QB, KB, VT, a.in[3], CAT, 2 * qq, F.wave, F.lane);
        attn_wave_unit(QB, KB, VT, a.in[3], CAT, 2 * qq + 1, F.wave, F.lane);
    }
    for (int u = F.vcu; u < (T / 128) * 8; u += F.G) sgu_unit(F, UB, GB, a.in[4], a.in[5], a.in[6], a.in[7], CAT, u >> 3, u & 7);
}

__device__ __forceinline__ void p4_router(const Frame& F, const Args& a) {
    float* ZH = a.out; bf16* HB = (bf16*)(a.ws + WS_HB); int* meta = (int*)(a.ws + WS_META); unsigned* cnt = (unsigned*)(a.ws + WS_CTL) + CW_CNT;
    const float* ln1_g = a.in[10]; const float* ln1_b = a.in[11]; const float* w_r = a.in[12]; const float* b_r = a.in[13];
    LAS float* W = (LAS float*)F.lds;
    LAS unsigned* hist = (LAS unsigned*)(F.lds + RSCR_OFF);
    LAS unsigned* base = hist + 32;
    LAS int* tmp_e = (LAS int*)(hist + 64);
    LAS int* tmp_p = tmp_e + 256;
    LAS float* tmp_g = (LAS float*)(tmp_p + 256);
    for (int i = F.tid; i < 1024 * 8; i += NWAVES * 64) { const int c = i >> 3, e4 = i & 7; *(LAS f32x4*)(W + c * 36 + e4 * 4) = *(const f32x4*)(w_r + c * 32 + e4 * 4); }
    { const int gt = F.vcu * (NWAVES * 64) + F.tid, NGT = F.G * NWAVES * 64;
      for (int i = gt; i < NROWS_MAX; i += NGT) { meta[MT_ROW_TOK + i] = 0; ((float*)meta)[MT_ROW_GATE + i] = 0.f; } }
    const int lane = F.lane, half = lane >> 5, el = lane & 31;
    for (int tb = F.vcu; tb < T / 64; tb += F.G) {
        if (F.tid < 32) hist[F.tid] = 0u;
        __syncthreads();
        for (int pp = 0; pp < 4; ++pp) {
            const int tl0 = 8 * F.wave + 2 * pp;
            const int tok0 = tb * 64 + tl0;
            float h0[16], h1[16];
            {
                float* z0 = ZH + (size_t)tok0 * D + lane; float* z1 = z0 + D;
                float s0 = 0.f, s1 = 0.f;
#pragma unroll
                for (int i = 0; i < 16; ++i) { h0[i] = z0[64 * i]; h1[i] = z1[64 * i]; s0 += h0[i]; s1 += h1[i]; }
                const float m0 = wave_sum(s0) * (1.f / D), m1 = wave_sum(s1) * (1.f / D);
                float q0 = 0.f, q1 = 0.f;
#pragma unroll
                for (int i = 0; i < 16; ++i) { h0[i] -= m0; h1[i] -= m1; q0 += h0[i] * h0[i]; q1 += h1[i] * h1[i]; }
                const float r0 = rsqrtf(wave_sum(q0) * (1.f / D) + LN_EPS), r1 = rsqrtf(wave_sum(q1) * (1.f / D) + LN_EPS);
                bf16* hb0 = HB + (size_t)tok0 * D + lane; bf16* hb1 = hb0 + D;
#pragma unroll
                for (int i = 0; i < 16; ++i) {
                    const float gg = ln1_g[64 * i + lane], bb = ln1_b[64 * i + lane];
                    h0[i] = h0[i] * r0 * gg + bb; h1[i] = h1[i] * r1 * gg + bb;
                    z0[64 * i] = h0[i]; z1[64 * i] = h1[i];
                    hb0[64 * i] = (bf16)f2bf(h0[i]); hb1[64 * i] = (bf16)f2bf(h1[i]);
                }
            }
            float lg0[32], lg1[32];
#pragma unroll
            for (int e = 0; e < 32; ++e) { lg0[e] = 0.f; lg1[e] = 0.f; }
#pragma unroll
            for (int i = 0; i < 16; ++i) {
                const LAS f32x4* wr = (const LAS f32x4*)(W + (64 * i + lane) * 36);
#pragma unroll
                for (int e4 = 0; e4 < 8; ++e4) {
                    const f32x4 ww = wr[e4];
                    lg0[4 * e4 + 0] += h0[i] * ww.x; lg0[4 * e4 + 1] += h0[i] * ww.y; lg0[4 * e4 + 2] += h0[i] * ww.z; lg0[4 * e4 + 3] += h0[i] * ww.w;
                    lg1[4 * e4 + 0] += h1[i] * ww.x; lg1[4 * e4 + 1] += h1[i] * ww.y; lg1[4 * e4 + 2] += h1[i] * ww.z; lg1[4 * e4 + 3] += h1[i] * ww.w;
                }
            }
            float v32[32];
#pragma unroll
            for (int e = 0; e < 32; ++e) { const float keep = half ? lg1[e] : lg0[e], send = half ? lg0[e] : lg1[e]; v32[e] = keep + __shfl_xor(send, 32); }
            float v16[16];
#pragma unroll
            for (int e = 0; e < 16; ++e) { const bool up = (lane & 16) != 0; const float keep = up ? v32[e + 16] : v32[e], send = up ? v32[e] : v32[e + 16]; v16[e] = keep + __shfl_xor(send, 16); }
            float v8[8];
#pragma unroll
            for (int e = 0; e < 8; ++e) { const bool up = (lane & 8) != 0; const float keep = up ? v16[e + 8] : v16[e], send = up ? v16[e] : v16[e + 8]; v8[e] = keep + __shfl_xor(send, 8); }
            float v4[4];
#pragma unroll
            for (int e = 0; e < 4; ++e) { const bool up = (lane & 4) != 0; const float keep = up ? v8[e + 4] : v8[e], send = up ? v8[e] : v8[e + 4]; v4[e] = keep + __shfl_xor(send, 4); }
            float v2[2];
#pragma unroll
            for (int e = 0; e < 2; ++e) { const bool up = (lane & 2) != 0; const float keep = up ? v4[e + 2] : v4[e], send = up ? v4[e] : v4[e + 2]; v2[e] = keep + __shfl_xor(send, 2); }
            float lgt;
            { const bool up = (lane & 1) != 0; const float keep = up ? v2[1] : v2[0], send = up ? v2[0] : v2[1]; lgt = keep + __shfl_xor(send, 1); }
            lgt += b_r[el];
            float bv[4]; int bi[4];
#pragma unroll
            for (int k = 0; k < 4; ++k) {
                float val = lgt; int idx = el;
#pragma unroll
                for (int o = 1; o < 32; o <<= 1) { const float ov = __shfl_xor(val, o); const int oi = __shfl_xor(idx, o); if (ov > val || (ov == val && oi < idx)) { val = ov; idx = oi; } }
                bv[k] = val; bi[k] = idx;
                if (el == idx) lgt = -INFINITY;
            }
            float ex[4], es = 0.f;
#pragma unroll
            for (int k = 0; k < 4; ++k) { ex[k] = __expf(bv[k] - bv[0]); es += ex[k]; }
            if (el == 0) {
                const int tl = tl0 + half;
#pragma unroll
                for (int k = 0; k < 4; ++k) { const unsigned pl = atomicAdd((unsigned*)&hist[bi[k]], 1u); tmp_e[tl * 4 + k] = bi[k]; tmp_p[tl * 4 + k] = (int)pl; tmp_g[tl * 4 + k] = ex[k] / es; }
            }
        }
        __syncthreads();
        if (F.tid < 32) base[F.tid] = atomicAdd(&cnt[F.tid], hist[F.tid]);
        __syncthreads();
        if (F.tid < 256) { const int i = F.tid, gi = tb * 256 + i, e = tmp_e[i];
            meta[MT_SEL_E + gi] = e; meta[MT_SEL_POS + gi] = (int)base[e] + tmp_p[i]; ((float*)meta)[MT_SEL_G + gi] = tmp_g[i]; }
        __syncthreads();
    }
}
__device__ __forceinline__ void p5_dispatch(const Frame& F, const Args& a) {
    int* meta = (int*)(a.ws + WS_META); const unsigned* cnt = (const unsigned*)(a.ws + WS_CTL) + CW_CNT;
    LAS int* ts = (LAS int*)(F.lds + RSCR_OFF);
    if (F.tid == 0) { int acc = 0; for (int e = 0; e < 32; ++e) { ts[e] = acc; acc += ((int)__hip_atomic_load(cnt + e, RLX_AGENT) + 255) >> 8; } ts[32] = acc; }
    __syncthreads();
    if (blockIdx.x == 0) {
        if (F.tid == 0) meta[MT_NT] = ts[32];
        if (F.tid < 33) meta[MT_TSTART + F.tid] = ts[F.tid];
        for (int t = F.tid; t < NT_MAX; t += NWAVES * 64) { int e = 0; for (int j = 1; j < 32; ++j) if (t >= ts[j]) e = j; meta[MT_TILE_E + t] = e; }
    }
    const int gt = F.vcu * (NWAVES * 64) + F.tid, NGT = F.G * NWAVES * 64;
    for (int i = gt; i < T * 4; i += NGT) {
        const int e = meta[MT_SEL_E + i], row = ts[e] * 256 + meta[MT_SEL_POS + i];
        meta[MT_ROW_TOK + row] = i >> 2; ((float*)meta)[MT_ROW_GATE + row] = ((const float*)meta)[MT_SEL_G + i]; meta[MT_SLOT_ROW + i] = row;
    }
    __syncthreads();
}
__device__ __forceinline__ void p8_final(const Frame& F, const Args& a) {
    float* HO = a.out; const bf16* Y = (const bf16*)(a.ws + WS_Y); const int* meta = (const int*)(a.ws + WS_META);
    const float* ln2_g = a.in[20]; const float* ln2_b = a.in[21];
    const int gw = F.vcu * NWAVES + F.wave, NGW = F.G * NWAVES, lane = F.lane;
    for (int tok = gw; tok < T; tok += NGW) {
        f32x4* hr = (f32x4*)(HO + (size_t)tok * D) + lane;
        f32x4 v[4]; float s = 0.f;
#pragma unroll
        for (int j = 0; j < 4; ++j) v[j] = hr[64 * j] * ALPHA;
#pragma unroll
        for (int k = 0; k < 4; ++k) {
            const int row = meta[MT_SLOT_ROW + tok * 4 + k];
            const u32x2* yr = (const u32x2*)(Y + (size_t)row * D) + lane;
#pragma unroll
            for (int j = 0; j < 4; ++j) { const u32x2 y = yr[64 * j]; v[j].x += __uint_as_float(y.x << 16); v[j].y += __uint_as_float(y.x & 0xffff0000u); v[j].z += __uint_as_float(y.y << 16); v[j].w += __uint_as_float(y.y & 0xffff0000u); }
        }
#pragma unroll
        for (int j = 0; j < 4; ++j) s += (v[j].x + v[j].y) + (v[j].z + v[j].w);
        const float mean = wave_sum(s) * (1.f / D); float s2 = 0.f;
#pragma unroll
        for (int j = 0; j < 4; ++j) { v[j] = v[j] - mean; s2 += (v[j].x * v[j].x + v[j].y * v[j].y) + (v[j].z * v[j].z + v[j].w * v[j].w); }
        const float rstd = rsqrtf(wave_sum(s2) * (1.f / D) + LN_EPS);
#pragma unroll
        for (int j = 0; j < 4; ++j) { const int c0 = 4 * lane + 256 * j; const f32x4 gg = *(const f32x4*)(ln2_g + c0), bb = *(const f32x4*)(ln2_b + c0); hr[64 * j] = v[j] * rstd * gg + bb; }
    }
}
#ifndef MKMASK
#define MKMASK 0x1FF
#endif
__global__ void __launch_bounds__(NWAVES * 64, 2) mk_fwd(Args args) {
    extern __shared__ __attribute__((aligned(16))) unsigned char lds_raw[];
    Frame F;
    F.lds = (LAS unsigned char*)lds_raw;
    F.tid = threadIdx.x; F.lane = F.tid & 63; F.wave = __builtin_amdgcn_readfirstlane(F.tid >> 6);
    F.G = gridDim.x; { const int bx = blockIdx.x; F.vcu = (F.G % 8 == 0) ? (bx % 8) * (F.G / 8) + bx / 8 : bx; }
    volatile LAS unsigned* MISC = (volatile LAS unsigned*)(F.lds + MISC_OFF);
    if (F.tid < 64) MISC[F.tid] = 0u;
    __syncthreads();
    unsigned char* ws = args.ws;
    unsigned* ctl = (unsigned*)(ws + WS_CTL);
    const int lo = args.ph_lo, hi = args.ph_hi;
    XcdBarrier bar; bar.bar = ctl + CW_BAR + args.li * XCD_BAR_WORDS; bar.x = 0; bar.st = nullptr;
    if (hi - lo > 1) bar = xcd_barrier_post(ctl + CW_BAR + args.li * XCD_BAR_WORDS, MISC + 8);
#define IN(k) (lo <= (k) && (k) < hi)
#define SEAM(k) do { if (IN(k) && IN((k) + 1)) xcd_barrier(bar); } while (0)
    int* meta = (int*)(ws + WS_META);
    bf16 *XB = (bf16*)(ws + WS_XB), *QB = (bf16*)(ws + WS_QB), *KB = (bf16*)(ws + WS_KB), *VT = (bf16*)(ws + WS_VT), *UB = (bf16*)(ws + WS_UB), *GB = (bf16*)(ws + WS_GB);
    bf16 *CAT = (bf16*)(ws + WS_CAT), *HB = (bf16*)(ws + WS_HB), *Y = (bf16*)(ws + WS_Y), *HID = (bf16*)(ws + WS_HID);
    bf16 *Win_t = (bf16*)(ws + WS_WIN), *Wout_t = (bf16*)(ws + WS_WOUT), *Wgu_t = (bf16*)(ws + WS_WGU), *Wd_t = (bf16*)(ws + WS_WD);
    const LAS int* rtab = (const LAS int*)(F.lds + RTAB_OFF);

    if (IN(0)) { p0_prologue(F, args); SEAM(0); }
    if (IN(1)) {
        pg8::Gemm g{XB, Win_t, D, nullptr, 0u}; pg8::StaticOrder S; S.init(T / 256, INW / 256, F.G, (int)blockIdx.x);
        pg8::EpiInProj E{args.in[2], QB, KB, VT, UB, GB};
        pg8::gemm_phase<pg8::EpiInProj, false, true>(F.lds, rtab, g, S, E);
        SEAM(1);
    }
    if (IN(2)) { p2_mixers(F, args); SEAM(2); }
    if (IN(3)) {
        pg8::Gemm g{CAT, Wout_t, D, nullptr, 0u}; pg8::StaticOrder S; S.init(T / 256, D / 256, F.G, (int)blockIdx.x);
        pg8::EpiOutProj E{args.in[0], args.in[9], args.out};
        pg8::gemm_phase<pg8::EpiOutProj, false, false>(F.lds, rtab, g, S, E);
        SEAM(3);
    }
    if (IN(4)) { p4_router(F, args); SEAM(4); }
    if (IN(5)) { p5_dispatch(F, args); SEAM(5); }
    if (IN(6)) {
        const int nT = __builtin_amdgcn_readfirstlane(meta[MT_NT]);
        pg8::StaticOrder S; S.init(nT, 2 * DFF / 256, F.G, (int)blockIdx.x);
        { pg8::Unit u; LAS int* rt = (LAS int*)(F.lds + RTAB_OFF);
          for (int i = 0; i < RTAB_UNITS && S.next(i, u); ++i) if (F.tid < 256) rt[i * 256 + F.tid] = meta[MT_ROW_TOK + u.pm * 256 + F.tid];
          __syncthreads(); }
        pg8::Gemm g{HB, Wgu_t, D, meta + MT_TILE_E, 2048u * 1024u * 2u};
        pg8::EpiSwiglu E{meta + MT_TILE_E, args.in[15], args.in[17], HID};
        pg8::gemm_phase<pg8::EpiSwiglu, true, true>(F.lds, rtab, g, S, E);
        SEAM(6);
    }
    if (IN(7)) {
        const int nT = __builtin_amdgcn_readfirstlane(meta[MT_NT]);
        pg8::StaticOrder S; S.init(nT, D / 256, F.G, (int)blockIdx.x);
        pg8::Gemm g{HID, Wd_t, DFF, meta + MT_TILE_E, 1024u * 1024u * 2u};
        pg8::EpiDown E{meta + MT_TILE_E, args.in[19], (const float*)meta + MT_ROW_GATE, Y};
        pg8::gemm_phase<pg8::EpiDown, false, true>(F.lds, rtab, g, S, E);
        SEAM(7);
    }
    if (IN(8)) { p8_final(F, args); }
#undef IN
#undef SEAM
}

extern "C" void kernel_launch(void* const* d_in, const int* in_sizes, int n_in, void* d_out, int out_size, void* d_ws, size_t ws_size, hipStream_t stream) {
    static int grid = 0;
    if (grid == 0) {
        if (n_in != 22 || in_sizes[0] != T * D || out_size != T * D || ws_size < WS_END) { fprintf(stderr, "kernel_launch: unexpected shapes (n_in %d, in0 %d, out %d, ws %zu, need %zu)\n", n_in, n_in > 0 ? in_sizes[0] : -1, out_size, ws_size, (size_t)WS_END); grid = -1; return; }
        int dev = 0, cus = 0;
        if (hipGetDevice(&dev) != hipSuccess || hipDeviceGetAttribute(&cus, hipDeviceAttributeMultiprocessorCount, dev) != hipSuccess) { grid = -1; return; }
        if (hipFuncSetAttribute((const void*)mk_fwd, hipFuncAttributeMaxDynamicSharedMemorySize, LDS_BYTES) != hipSuccess) { fprintf(stderr, "kernel_launch: hipFuncSetAttribute failed\n"); grid = -1; return; }
        int per_cu = 0;
        if (hipOccupancyMaxActiveBlocksPerMultiprocessor(&per_cu, (const void*)mk_fwd, NWAVES * 64, LDS_BYTES) != hipSuccess || per_cu < 1) fprintf(stderr, "kernel_launch: occupancy query reports %d\n", per_cu);
        (void)hipGetLastError();
        grid = cus;
    }
    if (grid < 0) return;
    const float* x = (const float*)d_in[0]; const float* w_in = (const float*)d_in[1]; const float* b_in = (const float*)d_in[2]; const float* sinks = (const float*)d_in[3];
    const float* ln_v_g = (const float*)d_in[4]; const float* ln_v_b = (const float*)d_in[5]; const float* w_sp = (const float*)d_in[6]; const float* b_sp = (const float*)d_in[7];
    const float* w_out = (const float*)d_in[8]; const float* b_out = (const float*)d_in[9]; const float* ln1_g = (const float*)d_in[10]; const float* ln1_b = (const float*)d_in[11];
    const float* w_r = (const float*)d_in[12]; const float* b_r = (const float*)d_in[13]; const float* w_gate = (const float*)d_in[14]; const float* b_gate = (const float*)d_in[15];
    const float* w_up = (const float*)d_in[16]; const float* b_up = (const float*)d_in[17]; const float* w_down = (const float*)d_in[18]; const float* b_down = (const float*)d_in[19];
    const float* ln2_g = (const float*)d_in[20]; const float* ln2_b = (const float*)d_in[21];
    unsigned char* ws = (unsigned char*)d_ws; float* out = (float*)d_out;
    unsigned* ctl = (unsigned*)(ws + WS_CTL); int* meta = (int*)(ws + WS_META);
    bf16 *XB = (bf16*)(ws + WS_XB), *QB = (bf16*)(ws + WS_QB), *KB = (bf16*)(ws + WS_KB), *VT = (bf16*)(ws + WS_VT), *UB = (bf16*)(ws + WS_UB), *GB = (bf16*)(ws + WS_GB);
    bf16 *CAT = (bf16*)(ws + WS_CAT), *HB = (bf16*)(ws + WS_HB), *Y = (bf16*)(ws + WS_Y), *HID = (bf16*)(ws + WS_HID);
    (void)hipMemsetAsync(ws + WS_CTL, 0, 1 * MiB, stream);
    Args a{};
    for (int i = 0; i < 22; ++i) a.in[i] = (const float*)d_in[i];
    a.out = out; a.ws = ws;
    int li = 0;
    for (int k = 0; k < NPHASES;) {
        if ((MKMASK >> k) & 1) {
            int j = k; while (j < NPHASES && ((MKMASK >> j) & 1)) ++j;
            a.ph_lo = k; a.ph_hi = j; a.li = li++;
            hipLaunchKernelGGL(mk_fwd, dim3(grid), dim3(NWAVES * 64), LDS_BYTES, stream, a);
            k = j; continue;
        }
        switch (k) {
        case 0: k_cvt_x<<<2048, 256, 0, stream>>>(x, XB, T * D / 4); break;
        case 1: k_inproj_naive<<<dim3(T / 64, INW / 64), 256, 0, stream>>>(XB, w_in, EpiInProjN{b_in, QB, KB, VT, UB, GB}); break;
        case 2: k_attn_naive<<<T * NQH / 4, 256, 0, stream>>>(QB, KB, VT, sinks, CAT);
                k_sgu_naive<<<T / 128 * 8, 256, 0, stream>>>(UB, GB, ln_v_g, ln_v_b, w_sp, b_sp, CAT); break;
        case 3: k_outproj_naive<<<dim3(T / 64, D / 64), 256, 0, stream>>>(CAT, w_out, EpiOutProjN{b_out, x, out}); break;
        case 4: k_router_naive<<<T / 4, 256, 0, stream>>>(out, HB, ln1_g, ln1_b, w_r, b_r, ctl + CW_CNT, meta);
                k_rowinit<<<(NROWS_MAX + 255) / 256, 256, 0, stream>>>(meta); break;
        case 5: k_dispatch1<<<1, 64, 0, stream>>>(ctl + CW_CNT, meta);
                k_scatter<<<T * 4 / 256, 256, 0, stream>>>(meta); break;
        case 6: k_gateup_naive<<<dim3(NT_MAX * 4, DFF / 64), 256, 0, stream>>>(HB, meta, w_gate, b_gate, w_up, b_up, HID); break;
        case 7: k_down_naive<<<dim3(NT_MAX * 4, D / 64), 256, 0, stream>>>(HID, meta, w_down, b_down, Y); break;
        case 8: k_final_naive<<<T / 4, 256, 0, stream>>>(out, Y, meta, ln2_g, ln2_b); break;
        }
        ++k;
    }
}
```

```cpp
#include <hip/hip_runtime.h>
#include <cstdio>
#include <cstdint>

typedef unsigned short bf16;
typedef float f32x4 __attribute__((ext_vector_type(4)));
typedef unsigned u32x4 __attribute__((ext_vector_type(4)));
typedef unsigned u32x2 __attribute__((ext_vector_type(2)));

constexpr int BATCH = 2, SEQ = 8192, D = 1024, T = BATCH * SEQ;
constexpr int NQH = 8, NKVH = 2, HD = 64, QREP = 4, AW = 512, KVW = 128, GW = 512, INW = 1792;
constexpr int NEXP = 32, TOPK = 4, DFF = 1024;
constexpr int NT_MAX = T * TOPK / 256 + NEXP;
constexpr int NROWS_MAX = NT_MAX * 256;
constexpr float LN_EPS = 1e-5f;
constexpr float ALPHA = 1.189207115002721f;
constexpr float C2 = 0.125f * 1.4426950408889634f;
constexpr float LOG2E = 1.4426950408889634f;

constexpr size_t MiB = 1u << 20;
constexpr size_t WS_CTL = 0;
constexpr size_t WS_META = 1 * MiB;
constexpr size_t WS_XB = 3 * MiB;
constexpr size_t WS_QB = WS_XB + 32 * MiB;
constexpr size_t WS_KB = WS_QB + 16 * MiB;
constexpr size_t WS_VT = WS_KB + 4 * MiB;
constexpr size_t WS_UB = WS_VT + 4 * MiB;
constexpr size_t WS_GB = WS_UB + 16 * MiB;
constexpr size_t WS_CAT = WS_GB + 16 * MiB;
constexpr size_t WS_HB = WS_CAT + 32 * MiB;
constexpr size_t WS_Y = WS_XB;
constexpr size_t WS_HID = WS_HB + 32 * MiB;
constexpr size_t WS_END_NAIVE = WS_HID + 144 * MiB;
static_assert(WS_Y + 144 * MiB <= WS_HID, "Y overlay");

constexpr int CW_CNT = 64;
constexpr int MT_NT = 0;
constexpr int MT_TSTART = 16;
constexpr int MT_TILE_E = 64;
constexpr int MT_SEL_E = 1024;
constexpr int MT_SEL_POS = MT_SEL_E + T * 4;
constexpr int MT_SEL_G = MT_SEL_POS + T * 4;
constexpr int MT_SLOT_ROW = MT_SEL_G + T * 4;
constexpr int MT_ROW_TOK = MT_SLOT_ROW + T * 4;
constexpr int MT_ROW_GATE = MT_ROW_TOK + NROWS_MAX;
constexpr int MT_ROW_SA = MT_ROW_GATE + NROWS_MAX;
constexpr int MT_SH = MT_ROW_SA + NROWS_MAX;
static_assert((size_t)(MT_SH + T) * 4 <= 2 * MiB, "meta");

__device__ __forceinline__ float bf2f(bf16 v) { return __uint_as_float((unsigned)v << 16); }
__device__ __forceinline__ unsigned f2bf(float f) { unsigned u = __float_as_uint(f); return (u + 0x7fffu + ((u >> 16) & 1u)) >> 16; }
__device__ __forceinline__ unsigned pk2(float lo, float hi) { return f2bf(lo) | (f2bf(hi) << 16); }
__device__ __forceinline__ float gelu_tanh(float x) {
    const float k2 = 2.0f * 0.7978845608028654f;
    const float u = k2 * (x + 0.044715f * x * x * x);
    return x / (1.0f + __expf(-u));
}
__device__ __forceinline__ float wave_sum(float v) {
#pragma unroll
    for (int o = 1; o < 64; o <<= 1) v += __shfl_xor(v, o);
    return v;
}
__device__ __forceinline__ float wave_max(float v) {
#pragma unroll
    for (int o = 1; o < 64; o <<= 1) v = fmaxf(v, __shfl_xor(v, o));
    return v;
}

__global__ void k_cvt_x(const float* __restrict__ x, bf16* __restrict__ xb, int n4) {
    for (int i = blockIdx.x * blockDim.x + threadIdx.x; i < n4; i += gridDim.x * blockDim.x) {
        const f32x4 v = ((const f32x4*)x)[i];
        u32x2 o; o.x = pk2(v.x, v.y); o.y = pk2(v.z, v.w);
        ((u32x2*)xb)[i] = o;
    }
}

template <int NB, class Epi>
__device__ __forceinline__ void naive_gemm_tile(const bf16* A, int lda, const int* rowidx, int m0, const float* B0, const float* B1, int ldb, int n0, int K, const Epi& epi) {
    __shared__ float As[16][68];
    __shared__ float Bs[NB][16][64];
    const int tid = threadIdx.x, ty = tid >> 4, tx = tid & 15;
    float acc[NB][4][4];
#pragma unroll
    for (int b = 0; b < NB; ++b)
#pragma unroll
        for (int i = 0; i < 4; ++i)
#pragma unroll
            for (int j = 0; j < 4; ++j) acc[b][i][j] = 0.f;
    const int ar = tid >> 2, ac = (tid & 3) * 4;
    const int arow = rowidx ? rowidx[m0 + ar] : (m0 + ar);
    const bf16* ap = A + (size_t)arow * lda + ac;
    const int br = tid >> 4, bc = (tid & 15) * 4;
    for (int k0 = 0; k0 < K; k0 += 16) {
        const u32x2 av = *(const u32x2*)(ap + k0);
        As[ac + 0][ar] = __uint_as_float(av.x << 16); As[ac + 1][ar] = __uint_as_float(av.x & 0xffff0000u);
        As[ac + 2][ar] = __uint_as_float(av.y << 16); As[ac + 3][ar] = __uint_as_float(av.y & 0xffff0000u);
        *(f32x4*)&Bs[0][br][bc] = *(const f32x4*)(B0 + (size_t)(k0 + br) * ldb + n0 + bc);
        if (NB == 2) *(f32x4*)&Bs[NB - 1][br][bc] = *(const f32x4*)(B1 + (size_t)(k0 + br) * ldb + n0 + bc);
        __syncthreads();
#pragma unroll
        for (int k = 0; k < 16; ++k) {
            const f32x4 a = *(const f32x4*)&As[k][ty * 4];
#pragma unroll
            for (int b = 0; b < NB; ++b) {
                const f32x4 bv = *(const f32x4*)&Bs[b][k][tx * 4];
#pragma unroll
                for (int i = 0; i < 4; ++i)
#pragma unroll
                    for (int j = 0; j < 4; ++j) acc[b][i][j] += a[i] * bv[j];
            }
        }
        __syncthreads();
    }
#pragma unroll
    for (int i = 0; i < 4; ++i)
#pragma unroll
        for (int j = 0; j < 4; ++j) {
            if (NB == 2) epi(m0 + ty * 4 + i, n0 + tx * 4 + j, acc[0][i][j], acc[NB - 1][i][j]);
            else epi(m0 + ty * 4 + i, n0 + tx * 4 + j, acc[0][i][j], 0.f);
        }
}

struct EpiInProjN {
    const float* b_in; bf16 *QB, *KB, *VT, *UB, *GB;
    __device__ __forceinline__ void operator()(int row, int c, float a, float) const {
        const float v = a + b_in[c];
        if (c < 512) QB[(size_t)row * 512 + c] = (bf16)f2bf(v * C2);
        else if (c < 640) KB[(size_t)row * 128 + (c - 512)] = (bf16)f2bf(v);
        else if (c < 768) { const int cv = c - 640, g = cv >> 6, d = cv & 63, b = row / SEQ, s = row % SEQ; VT[((size_t)((b * 2 + g) * 64 + d)) * SEQ + s] = (bf16)f2bf(v); }
        else if (c < 1280) UB[(size_t)row * 512 + (c - 768)] = (bf16)f2bf(gelu_tanh(v));
        else GB[(size_t)row * 512 + (c - 1280)] = (bf16)f2bf(gelu_tanh(v));
    }
};
__global__ void __launch_bounds__(256) k_inproj_naive(const bf16* XB, const float* w_in, EpiInProjN epi) {
    naive_gemm_tile<1>(XB, D, nullptr, blockIdx.x * 64, w_in, nullptr, INW, blockIdx.y * 64, D, epi);
}

__global__ void __launch_bounds__(256) k_attn_naive(const bf16* QB, const bf16* KB, const bf16* VT, const float* sinks, bf16* CAT) {
    __shared__ float pl[4][128];
    const int w = threadIdx.x >> 6, lane = threadIdx.x & 63;
    const int wu = blockIdx.x * 4 + w;
    const int tok = wu >> 3, h = wu & 7, g = h >> 2, b = tok / SEQ, t = tok % SEQ;
    const float qv = bf2f(QB[(size_t)tok * 512 + h * 64 + lane]);
    float s[2];
    {
        const int kp0 = t - 127 + lane, kp1 = kp0 + 64;
        const bf16* kr0 = KB + (size_t)(b * SEQ + (kp0 < 0 ? 0 : kp0)) * 128 + g * 64;
        const bf16* kr1 = KB + (size_t)(b * SEQ + (kp1 < 0 ? 0 : kp1)) * 128 + g * 64;
        float a0 = 0.f, a1 = 0.f;
        for (int d = 0; d < 64; ++d) { const float qd = __shfl(qv, d); a0 += qd * bf2f(kr0[d]); a1 += qd * bf2f(kr1[d]); }
        s[0] = (kp0 >= 0) ? a0 : -1e30f; s[1] = (kp1 >= 0) ? a1 : -1e30f;
    }
    const float sk = sinks[h] * LOG2E;
    const float m = fmaxf(wave_max(fmaxf(s[0], s[1])), sk);
    const float p0 = exp2f(s[0] - m), p1 = exp2f(s[1] - m);
    const float l = wave_sum(p0 + p1) + exp2f(sk - m);
    pl[w][lane] = p0; pl[w][64 + lane] = p1;
    __syncthreads();
    const bf16* vr = VT + ((size_t)((b * 2 + g) * 64 + lane)) * SEQ;
    float o = 0.f;
    for (int j = 0; j < 128; ++j) { const int kp = t - 127 + j; if (kp >= 0) o += pl[w][j] * bf2f(vr[kp]); }
    CAT[(size_t)tok * 1024 + h * 64 + lane] = (bf16)f2bf(o / l);
}

__global__ void __launch_bounds__(256) k_sgu_naive(const bf16* UB, const bf16* GB, const float* ln_g, const float* ln_b, const float* w_s, const float* b_s, bf16* CAT) {
    __shared__ float G[128][65];
    const int u = blockIdx.x, gi = u & 7, ch = u >> 3;
    const int tid = threadIdx.x, s = tid >> 1, half = tid & 1;
    const size_t tok = (size_t)ch * 128 + s;
    float v[32]; float sum = 0.f;
#pragma unroll
    for (int i = 0; i < 32; ++i) { v[i] = bf2f(GB[tok * 512 + gi * 64 + half * 32 + i]); sum += v[i]; }
    sum += __shfl_xor(sum, 1);
    const float mu = sum * (1.f / 64.f); float q = 0.f;
#pragma unroll
    for (int i = 0; i < 32; ++i) { v[i] -= mu; q += v[i] * v[i]; }
    q += __shfl_xor(q, 1);
    const float rstd = rsqrtf(q * (1.f / 64.f) + LN_EPS);
#pragma unroll
    for (int i = 0; i < 32; ++i) { const int d = half * 32 + i; G[s][d] = v[i] * rstd * ln_g[gi * 64 + d] + ln_b[gi * 64 + d]; }
    __syncthreads();
    const int t = s;
    float acc[32];
#pragma unroll
    for (int i = 0; i < 32; ++i) acc[i] = 0.f;
    const float* wr = w_s + ((size_t)gi * 128 + t) * 128;
    for (int ss = 0; ss <= t; ++ss) {
        const float w = wr[ss];
#pragma unroll
        for (int i = 0; i < 32; ++i) acc[i] += w * G[ss][half * 32 + i];
    }
    const float bb = b_s[gi * 128 + t];
#pragma unroll
    for (int i = 0; i < 32; ++i) { const int d = half * 32 + i; const float uu = bf2f(UB[tok * 512 + gi * 64 + d]); CAT[tok * 1024 + 512 + gi * 64 + d] = (bf16)f2bf(uu * (acc[i] + bb)); }
}

struct EpiOutProjN {
    const float* b_out; const float* x; float* Z;
    __device__ __forceinline__ void operator()(int row, int c, float a, float) const { Z[(size_t)row * D + c] = ALPHA * x[(size_t)row * D + c] + a + b_out[c]; }
};
__global__ void __launch_bounds__(256) k_outproj_naive(const bf16* CAT, const float* w_out, EpiOutProjN epi) {
    naive_gemm_tile<1>(CAT, D, nullptr, blockIdx.x * 64, w_out, nullptr, D, blockIdx.y * 64, D, epi);
}

__global__ void __launch_bounds__(256) k_router_naive(float* ZH, bf16* HB, const float* ln1_g, const float* ln1_b, const float* w_r, const float* b_r, unsigned* cnt, int* meta) {
    const int w = threadIdx.x >> 6, lane = threadIdx.x & 63;
    const int tok = blockIdx.x * 4 + w;
    f32x4* zr = (f32x4*)(ZH + (size_t)tok * D) + lane;
    f32x4 v[4]; float s = 0.f;
#pragma unroll
    for (int j = 0; j < 4; ++j) { v[j] = zr[64 * j]; s += (v[j].x + v[j].y) + (v[j].z + v[j].w); }
    const float mean = wave_sum(s) * (1.f / D); float s2 = 0.f;
#pragma unroll
    for (int j = 0; j < 4; ++j) { v[j] = v[j] - mean; s2 += (v[j].x * v[j].x + v[j].y * v[j].y) + (v[j].z * v[j].z + v[j].w * v[j].w); }
    const float rstd = rsqrtf(wave_sum(s2) * (1.f / D) + LN_EPS);
    float lg[32];
#pragma unroll
    for (int e = 0; e < 32; ++e) lg[e] = 0.f;
#pragma unroll
    for (int j = 0; j < 4; ++j) {
        const int c0 = 4 * lane + 256 * j;
        const f32x4 gg = *(const f32x4*)(ln1_g + c0), bb = *(const f32x4*)(ln1_b + c0);
        v[j] = v[j] * rstd * gg + bb;
        zr[64 * j] = v[j];
        u32x2 o; o.x = pk2(v[j].x, v[j].y); o.y = pk2(v[j].z, v[j].w);
        *((u32x2*)(HB + (size_t)tok * D + c0)) = o;
#pragma unroll
        for (int i = 0; i < 4; ++i) {
            const float hv = v[j][i];
            const f32x4* wr = (const f32x4*)(w_r + (size_t)(c0 + i) * 32);
#pragma unroll
            for (int e4 = 0; e4 < 8; ++e4) { const f32x4 ww = wr[e4]; lg[e4 * 4 + 0] += hv * ww.x; lg[e4 * 4 + 1] += hv * ww.y; lg[e4 * 4 + 2] += hv * ww.z; lg[e4 * 4 + 3] += hv * ww.w; }
        }
    }
#pragma unroll
    for (int e = 0; e < 32; ++e) lg[e] = wave_sum(lg[e]) + b_r[e];
    int bi[4]; float bv[4];
#pragma unroll
    for (int k = 0; k < 4; ++k) {
        float best = -INFINITY; int b = 0;
#pragma unroll
        for (int e = 0; e < 32; ++e) if (lg[e] > best) { best = lg[e]; b = e; }
#pragma unroll
        for (int e = 0; e < 32; ++e) if (e == b) lg[e] = -INFINITY;
        bi[k] = b; bv[k] = best;
    }
    float ex[4], es = 0.f;
#pragma unroll
    for (int k = 0; k < 4; ++k) { ex[k] = __expf(bv[k] - bv[0]); es += ex[k]; }
    if (lane == 0) {
#pragma unroll
        for (int k = 0; k < 4; ++k) {
            const unsigned pos = atomicAdd(&cnt[bi[k]], 1u);
            meta[MT_SEL_E + tok * 4 + k] = bi[k]; meta[MT_SEL_POS + tok * 4 + k] = (int)pos;
            ((float*)meta)[MT_SEL_G + tok * 4 + k] = ex[k] / es;
        }
    }
}

__global__ void k_dispatch1(const unsigned* cnt, int* meta) {
    __shared__ int ts[33];
    if (threadIdx.x == 0) { int acc = 0; for (int e = 0; e < 32; ++e) { ts[e] = acc; acc += ((int)cnt[e] + 255) >> 8; } ts[32] = acc; meta[MT_NT] = acc; }
    __syncthreads();
    if (threadIdx.x < 33) meta[MT_TSTART + threadIdx.x] = ts[threadIdx.x];
    for (int t = threadIdx.x; t < NT_MAX; t += blockDim.x) { int e = 0; for (int j = 1; j < 32; ++j) if (t >= ts[j]) e = j; meta[MT_TILE_E + t] = e; }
}
__global__ void k_rowinit(int* meta) {
    const int i = blockIdx.x * blockDim.x + threadIdx.x;
    if (i < NROWS_MAX) { meta[MT_ROW_TOK + i] = 0; ((float*)meta)[MT_ROW_GATE + i] = 0.f; }
}
__global__ void k_scatter(int* meta) {
    const int i = blockIdx.x * blockDim.x + threadIdx.x;
    if (i < T * 4) {
        const int e = meta[MT_SEL_E + i], row = meta[MT_TSTART + e] * 256 + meta[MT_SEL_POS + i];
        meta[MT_ROW_TOK + row] = i >> 2; ((float*)meta)[MT_ROW_GATE + row] = ((const float*)meta)[MT_SEL_G + i]; meta[MT_SLOT_ROW + i] = row;
    }
}

struct EpiGateUpN {
    const float* bg; const float* bu; bf16* HID;
    __device__ __forceinline__ void operator()(int row, int c, float a, float b) const {
        const float gt = fminf(a + bg[c], 7.0f), up = fminf(fmaxf(b + bu[c], -7.0f), 7.0f);
        const float hid = gt / (1.0f + __expf(-1.702f * gt)) * (up + 1.0f);
        HID[(size_t)row * DFF + c] = (bf16)f2bf(hid);
    }
};
__global__ void __launch_bounds__(256) k_gateup_naive(const bf16* HB, const int* meta, const float* w_gate, const float* b_gate, const float* w_up, const float* b_up, bf16* HID) {
    const int tile = blockIdx.x >> 2, sub = blockIdx.x & 3;
    if (tile >= meta[MT_NT]) return;
    const int e = meta[MT_TILE_E + tile];
    EpiGateUpN epi{b_gate + (size_t)e * DFF, b_up + (size_t)e * DFF, HID};
    naive_gemm_tile<2>(HB, D, meta + MT_ROW_TOK, tile * 256 + sub * 64, w_gate + (size_t)e * D * DFF, w_up + (size_t)e * D * DFF, DFF, blockIdx.y * 64, D, epi);
}
struct EpiDownN {
    const float* bd; const float* row_gate; bf16* Y;
    __device__ __forceinline__ void operator()(int row, int c, float a, float) const { Y[(size_t)row * D + c] = (bf16)f2bf((a + bd[c]) * row_gate[row]); }
};
__global__ void __launch_bounds__(256) k_down_naive(const bf16* HID, const int* meta, const float* w_down, const float* b_down, bf16* Y) {
    const int tile = blockIdx.x >> 2, sub = blockIdx.x & 3;
    if (tile >= meta[MT_NT]) return;
    const int e = meta[MT_TILE_E + tile];
    EpiDownN epi{b_down + (size_t)e * D, (const float*)meta + MT_ROW_GATE, Y};
    naive_gemm_tile<1>(HID, DFF, nullptr, tile * 256 + sub * 64, w_down + (size_t)e * DFF * D, nullptr, D, blockIdx.y * 64, DFF, epi);
}

__global__ void __launch_bounds__(256) k_final_naive(float* HO, const bf16* Y, const int* meta, const float* ln2_g, const float* ln2_b) {
    const int w = threadIdx.x >> 6, lane = threadIdx.x & 63;
    const int tok = blockIdx.x * 4 + w;
    f32x4* hr = (f32x4*)(HO + (size_t)tok * D) + lane;
    f32x4 v[4]; float s = 0.f;
#pragma unroll
    for (int j = 0; j < 4; ++j) v[j] = hr[64 * j] * ALPHA;
#pragma unroll
    for (int k = 0; k < 4; ++k) {
        const int row = meta[MT_SLOT_ROW + tok * 4 + k];
        const u32x2* yr = (const u32x2*)(Y + (size_t)row * D) + lane;
#pragma unroll
        for (int j = 0; j < 4; ++j) { const u32x2 y = yr[64 * j]; v[j].x += __uint_as_float(y.x << 16); v[j].y += __uint_as_float(y.x & 0xffff0000u); v[j].z += __uint_as_float(y.y << 16); v[j].w += __uint_as_float(y.y & 0xffff0000u); }
    }
#pragma unroll
    for (int j = 0; j < 4; ++j) s += (v[j].x + v[j].y) + (v[j].z + v[j].w);
    const float mean = wave_sum(s) * (1.f / D); float s2 = 0.f;
#pragma unroll
    for (int j = 0; j < 4; ++j) { v[j] = v[j] - mean; s2 += (v[j].x * v[j].x + v[j].y * v[j].y) + (v[j].z * v[j].z + v[j].w * v[j].w); }
    const float rstd = rsqrtf(wave_sum(s2) * (1.f / D) + LN_EPS);
#pragma unroll
    for (int j = 0; j < 4; ++j) { const int c0 = 4 * lane + 256 * j; const f32x4 gg = *(const f32x4*)(ln2_g + c0), bb = *(const f32x4*)(ln2_b + c0); hr[64 * j] = v[j] * rstd * gg + bb; }
}

#define LAS __attribute__((address_space(3)))
#define GAS __attribute__((address_space(1)))
typedef short bf16x8 __attribute__((ext_vector_type(8)));
typedef float f32x16 __attribute__((ext_vector_type(16)));
typedef float f32x2 __attribute__((ext_vector_type(2)));
__device__ __forceinline__ unsigned cvt_pk_bf16(float lo, float hi) { unsigned r; asm volatile("v_cvt_pk_bf16_f32 %0, %1, %2" : "=v"(r) : "v"(lo), "v"(hi)); return r; }
__device__ __forceinline__ float fast_gelu(float x) {
    const float u = -2.0f * 0.7978845608028654f * LOG2E * (x + 0.044715f * x * x * x);
    return x * __builtin_amdgcn_rcpf(1.0f + __builtin_amdgcn_exp2f(u));
}
namespace pg8 {
constexpr int BM = 256, BK = 64, HALF = 128, HTB = HALF * BK * 2  , STAGE_BYTES = 8 * HTB, NXCD = 8, WGM = 8;
__host__ __device__ __forceinline__ int lds_byte(int r, int c) { const int st = (r >> 4) * 2 + (c >> 5), rr = r & 15, cc = c & 31, ob = rr * 64 + cc * 2; return st * 1024 + (ob ^ (((ob >> 9) & 1) << 5)); }
__host__ __device__ __forceinline__ void stage_rc(int b, int& R, int& C) { const int st = b / 1024, sb = b % 1024, swz = sb ^ (((sb >> 9) & 1) << 5); R = (st >> 1) * 16 + swz / 64; C = (st & 1) * 32 + (swz % 64) / 2; }
__host__ __device__ __forceinline__ int perm32(int rho) { const int n = rho >> 4, i = rho & 15; return 8 * (i >> 2) + 4 * n + (i & 3); }

struct Unit { int pm, pn; };
struct Gemm { const void* A; const void* Bt; int KB; const int* tile_e; unsigned e_stride; };
typedef int i32x4 __attribute__((ext_vector_type(4)));

struct StaticOrder {
    int nM, nN, nwg, G, c;
    __device__ void init(int nM_, int nN_, int G_, int c_) { nM = nM_; nN = nN_; nwg = nM * nN; G = G_; c = c_; }
    __device__ bool next(int i, Unit& u) const {
        const long L = (long)i * G + c; if (L >= nwg) return false;
        int wgid = (int)L; { const int q = nwg / NXCD, r = nwg % NXCD, xcd = wgid % NXCD, off = wgid / NXCD; wgid = (xcd < r ? xcd * (q + 1) : r * (q + 1) + (xcd - r) * q) + off; }
        const int nig = WGM * nN, gid = wgid / nig, fm = gid * WGM, gsz = (nM - fm) < WGM ? (nM - fm) : WGM;
        u.pm = fm + ((wgid % nig) % gsz); u.pn = (wgid % nig) / gsz; return true;
    }
};

template <class Epi, bool GATHER, bool ALIGN_EPI, bool I8>
__device__ __forceinline__ void gemm_phase(LAS unsigned char* lds, const LAS int* rtab, const Gemm g, const StaticOrder& S, const Epi& E) {
    const int tid = threadIdx.x, wid = __builtin_amdgcn_readfirstlane(tid >> 6), lane = tid & 63, wr = wid >> 2, wc = wid & 3, fr = lane & 15, fq = lane >> 4;
    const int KB = g.KB, nt = KB / (BK * 2);
    int Rs[2], Cs[2]; unsigned voffB[2];
#pragma unroll
    for (int i = 0; i < 2; ++i) { int R, C; stage_rc(tid * 16 + i * 8192, R, C); const int Rb = Epi::PERM ? ((R & ~31) + perm32(R & 31)) : R; Rs[i] = R; Cs[i] = C; voffB[i] = (unsigned)(Rb * KB + C * 2); }
    const size_t kstep = (size_t)(BK * 2);
    const size_t hstep = (size_t)HALF * KB;
    const size_t tstep = 2 * hstep;
    const unsigned ldsw = (unsigned)wid * 1024u;
    const int aoff = lds_byte(wr * 64 + fr, fq * 8), boff = lds_byte(wc * 32 + fr, fq * 8);
#define PG8_SA(b, h) (((b) * 2 + (h)) * HTB)
#define PG8_SB(b, h) ((4 + (b) * 2 + (h)) * HTB)
#define PG8_STAGE(bufoff, gbase, voff) do { _Pragma("unroll") for (int _i = 0; _i < 2; ++_i) \
        __builtin_amdgcn_global_load_lds((const unsigned*)((const char*)(gbase) + (voff)[_i]), (LAS unsigned*)(lds + (bufoff) + ldsw + _i * 8192), 16, 0, 0); } while (0)
#define PG8_LDA(dst, b, h) do { _Pragma("unroll") for (int m = 0; m < 4; ++m) _Pragma("unroll") for (int k = 0; k < 2; ++k) dst[m][k] = *(const LAS bf16x8*)(lds + PG8_SA(b, h) + aoff + m * 2048 + k * 1024); } while (0)
#define PG8_LDB(dst, b, h) do { _Pragma("unroll") for (int n = 0; n < 2; ++n) _Pragma("unroll") for (int k = 0; k < 2; ++k) dst[n][k] = *(const LAS bf16x8*)(lds + PG8_SB(b, h) + boff + n * 2048 + k * 1024); } while (0)
#define PG8_MMA(ai, bj, At, Bt) do { __builtin_amdgcn_s_setprio(1); _Pragma("unroll") for (int m = 0; m < 4; ++m) _Pragma("unroll") for (int n = 0; n < 2; ++n) _Pragma("unroll") for (int k = 0; k < 2; ++k) \
        { if constexpr (I8) acc[ai][bj][m][n] = __builtin_bit_cast(f32x4, __builtin_amdgcn_mfma_i32_16x16x64_i8(__builtin_bit_cast(i32x4, Bt[n][k]), __builtin_bit_cast(i32x4, At[m][k]), __builtin_bit_cast(i32x4, acc[ai][bj][m][n]), 0, 0, 0)); \
          else acc[ai][bj][m][n] = __builtin_amdgcn_mfma_f32_16x16x32_bf16(Bt[n][k], At[m][k], acc[ai][bj][m][n], 0, 0, 0); } __builtin_amdgcn_s_setprio(0); } while (0)
#define PG8_WAIT_V(n) asm volatile("s_waitcnt vmcnt(" #n ")" ::: "memory")
#define PG8_WAIT_L(n) asm volatile("s_waitcnt lgkmcnt(" #n ")" ::: "memory")
#define PG8_BAR __builtin_amdgcn_s_barrier()
#define PG8_SCHED __builtin_amdgcn_sched_barrier(0)
#define PG8_VOFFA(vo, ui_, u_) do { _Pragma("unroll") for (int h_ = 0; h_ < 2; ++h_) _Pragma("unroll") for (int i_ = 0; i_ < 2; ++i_) { \
        const int row_ = GATHER ? rtab[(ui_) * 256 + h_ * 128 + Rs[i_]] : ((u_).pm * 256 + h_ * 128 + Rs[i_]); \
        vo[h_][i_] = (unsigned)(row_ * KB + Cs[i_] * 2); } } while (0)
#define PG8_BBASE(u_) ((const char*)g.Bt + (g.tile_e ? (size_t)g.tile_e[(u_).pm] * g.e_stride : (size_t)0) + (size_t)(u_).pn * tstep)
    Unit cur, nxt; int ui = 0;
    if (!S.next(0, cur)) return;
    f32x4 acc[2][2][4][2];
#pragma unroll
    for (int a = 0; a < 2; ++a)
#pragma unroll
        for (int b = 0; b < 2; ++b)
#pragma unroll
            for (int m = 0; m < 4; ++m)
#pragma unroll
                for (int n = 0; n < 2; ++n) acc[a][b][m][n] = (f32x4){0.f, 0.f, 0.f, 0.f};
    bf16x8 At[4][2], B0[2][2], B1[2][2];
    unsigned vAc[2][2], vAn[2][2];
    PG8_VOFFA(vAc, 0, cur);
    const char* const gA = (const char*)g.A;
    const char* cB = PG8_BBASE(cur);
    PG8_STAGE(PG8_SB(0, 0), cB, voffB); PG8_STAGE(PG8_SB(0, 1), cB + hstep, voffB); PG8_STAGE(PG8_SA(0, 0), gA, vAc[0]); PG8_STAGE(PG8_SA(0, 1), gA, vAc[1]);
    if (wr == 1) PG8_BAR;
    PG8_WAIT_V(2); PG8_BAR;
    PG8_STAGE(PG8_SB(1, 0), cB + kstep, voffB); PG8_STAGE(PG8_SA(1, 0), gA + kstep, vAc[0]); PG8_STAGE(PG8_SB(1, 1), cB + hstep + kstep, voffB);
    PG8_WAIT_V(6); PG8_BAR;
    for (;;) {
        const bool has_next = S.next(ui + 1, nxt);
        const char* nB = cB;
        if (has_next) { nB = PG8_BBASE(nxt); PG8_VOFFA(vAn, ui + 1, nxt); }
        else {
#pragma unroll
            for (int h = 0; h < 2; ++h)
#pragma unroll
                for (int i = 0; i < 2; ++i) vAn[h][i] = vAc[h][i];
        }
        for (int t = 0; t < nt; t += 2) {
            const bool last = (t == nt - 2);
            const char* a1 = gA + (size_t)(t + 1) * kstep;
            const char* a2 = last ? gA : gA + (size_t)(t + 2) * kstep; const char* b2 = last ? nB : cB + (size_t)(t + 2) * kstep;
            const char* a3 = a2 + kstep; const char* b3 = b2 + kstep;
            unsigned v2[2][2];
#pragma unroll
            for (int h = 0; h < 2; ++h)
#pragma unroll
                for (int i = 0; i < 2; ++i) v2[h][i] = last ? vAn[h][i] : vAc[h][i];
            PG8_LDB(B0, 0, 0); PG8_LDB(B1, 0, 1); PG8_SCHED; PG8_LDA(At, 0, 0); PG8_STAGE(PG8_SA(1, 1), a1, vAc[1]);
            PG8_WAIT_V(8); PG8_WAIT_L(0); PG8_BAR; PG8_MMA(0, 0, At, B0); PG8_MMA(0, 1, At, B1); PG8_BAR; PG8_SCHED;
            PG8_LDA(At, 0, 1); PG8_STAGE(PG8_SB(0, 0), b2, voffB); PG8_STAGE(PG8_SB(0, 1), b2 + hstep, voffB); PG8_STAGE(PG8_SA(0, 0), a2, v2[0]);
            PG8_WAIT_V(8); PG8_WAIT_L(0); PG8_BAR; PG8_MMA(1, 0, At, B0); PG8_MMA(1, 1, At, B1); PG8_BAR; PG8_SCHED;
            PG8_LDB(B0, 1, 0); PG8_LDB(B1, 1, 1); PG8_SCHED; PG8_LDA(At, 1, 0); PG8_STAGE(PG8_SA(0, 1), a2, v2[1]);
            PG8_WAIT_V(8); PG8_WAIT_L(0); PG8_BAR; PG8_MMA(0, 0, At, B0); PG8_MMA(0, 1, At, B1); PG8_BAR; PG8_SCHED;
            PG8_LDA(At, 1, 1); PG8_STAGE(PG8_SB(1, 0), b3, voffB); PG8_STAGE(PG8_SB(1, 1), b3 + hstep, voffB); PG8_STAGE(PG8_SA(1, 0), a3, v2[0]);
            PG8_WAIT_V(8); PG8_WAIT_L(0); PG8_BAR; PG8_MMA(1, 0, At, B0); PG8_MMA(1, 1, At, B1); PG8_BAR; PG8_SCHED;
        }
        if constexpr (ALIGN_EPI) { if (wr == 0) PG8_BAR; }
        E(acc, cur, wr, wc, fr, fq);
        if (!has_next) break;
#pragma unroll
        for (int a = 0; a < 2; ++a)
#pragma unroll
            for (int b = 0; b < 2; ++b)
#pragma unroll
                for (int m = 0; m < 4; ++m)
#pragma unroll
                    for (int n = 0; n < 2; ++n) acc[a][b][m][n] = (f32x4){0.f, 0.f, 0.f, 0.f};
        cur = nxt; cB = nB; ++ui;
#pragma unroll
        for (int h = 0; h < 2; ++h)
#pragma unroll
            for (int i = 0; i < 2; ++i) vAc[h][i] = vAn[h][i];
        if constexpr (ALIGN_EPI) { if (wr == 1) PG8_BAR; }
    }
    PG8_WAIT_V(0);
    if constexpr (!ALIGN_EPI) { if (wr == 0) PG8_BAR; }
    PG8_BAR;
#undef PG8_SA
#undef PG8_SB
#undef PG8_STAGE
#undef PG8_LDA
#undef PG8_LDB
#undef PG8_MMA
#undef PG8_WAIT_V
#undef PG8_WAIT_L
#undef PG8_BAR
#undef PG8_SCHED
#undef PG8_VOFFA
#undef PG8_BBASE
}

struct EpiInProj {
    static constexpr bool PERM = true;
    const float* b_in; bf16 *QB, *KB, *VT, *UB, *GB;
    __device__ __forceinline__ void operator()(const f32x4 (&acc)[2][2][4][2], const Unit& u, int wr, int wc, int fr, int fq) const {
        const int row0 = u.pm * BM + wr * 64 + fr;
#pragma unroll
        for (int bj = 0; bj < 2; ++bj) {
            const int reg = u.pn * BM + bj * HALF;
            const int c0 = reg + wc * 32 + 8 * fq;
            const f32x4 bv0 = *(const f32x4*)(b_in + c0), bv1 = *(const f32x4*)(b_in + c0 + 4);
#pragma unroll
            for (int ai = 0; ai < 2; ++ai)
#pragma unroll
                for (int m = 0; m < 4; ++m) {
                    const int row = row0 + ai * HALF + m * 16;
                    f32x4 v0 = acc[ai][bj][m][0] + bv0, v1 = acc[ai][bj][m][1] + bv1;
                    if (reg >= 640 && reg < 768) {
                        const int cv = c0 - 640, gg = cv >> 6, d = cv & 63, b = row / SEQ, s = row % SEQ;
                        bf16* vp = VT + ((size_t)((b * 2 + gg) * 64 + d)) * SEQ + s;
#pragma unroll
                        for (int j = 0; j < 4; ++j) { vp[(size_t)j * SEQ] = (bf16)f2bf(v0[j]); vp[(size_t)(j + 4) * SEQ] = (bf16)f2bf(v1[j]); }
                    } else {
                        bf16* dst;
                        if (reg < 512) { v0 = v0 * C2; v1 = v1 * C2; dst = QB + (size_t)row * 512 + c0; }
                        else if (reg < 640) { dst = KB + (size_t)row * 128 + (c0 - 512); }
                        else {
#pragma unroll
                            for (int j = 0; j < 4; ++j) { v0[j] = fast_gelu(v0[j]); v1[j] = fast_gelu(v1[j]); }
                            dst = (reg < 1280) ? (UB + (size_t)row * 512 + (c0 - 768)) : (GB + (size_t)row * 512 + (c0 - 1280));
                        }
                        u32x4 w; w.x = cvt_pk_bf16(v0[0], v0[1]); w.y = cvt_pk_bf16(v0[2], v0[3]); w.z = cvt_pk_bf16(v1[0], v1[1]); w.w = cvt_pk_bf16(v1[2], v1[3]);
                        *(u32x4*)dst = w;
                    }
                }
        }
    }
};
struct EpiOutProj {
    static constexpr bool PERM = false;
    const float* x; const float* b_out; float* Z;
    __device__ __forceinline__ void operator()(const f32x4 (&acc)[2][2][4][2], const Unit& u, int wr, int wc, int fr, int fq) const {
        const int col0 = u.pn * BM + wc * 32 + 4 * fq;
#pragma unroll
        for (int ai = 0; ai < 2; ++ai)
#pragma unroll
            for (int m = 0; m < 4; ++m) {
                const size_t off = (size_t)(u.pm * BM + ai * HALF + wr * 64 + m * 16 + fr) * D + col0;
#pragma unroll
                for (int bj = 0; bj < 2; ++bj)
#pragma unroll
                    for (int n = 0; n < 2; ++n) {
                        const f32x4 xv = *(const f32x4*)(x + off + bj * HALF + n * 16), bv = *(const f32x4*)(b_out + col0 + bj * HALF + n * 16);
                        *(f32x4*)(Z + off + bj * HALF + n * 16) = xv * ALPHA + acc[ai][bj][m][n] + bv;
                    }
            }
    }
};
struct EpiSwiglu {
    static constexpr bool PERM = true;
    const int* tile_e; const float* b_gate; const float* b_up; const float* swgu; const float* row_sa; bf16* HID;
    __device__ __forceinline__ void operator()(const f32x4 (&acc)[2][2][4][2], const Unit& u, int wr, int wc, int fr, int fq) const {
        const int e = tile_e[u.pm];
        const int fc0 = u.pn * HALF + wc * 32 + 8 * fq;
        const f32x4 g0 = *(const f32x4*)(b_gate + e * DFF + fc0), g1 = *(const f32x4*)(b_gate + e * DFF + fc0 + 4);
        const f32x4 u0 = *(const f32x4*)(b_up + e * DFF + fc0), u1 = *(const f32x4*)(b_up + e * DFF + fc0 + 4);
        const float* sw = swgu + e * 2048 + u.pn * 256 + wc * 32 + 8 * fq;
        const f32x4 sg0 = *(const f32x4*)(sw), sg1 = *(const f32x4*)(sw + 4), su0 = *(const f32x4*)(sw + 128), su1 = *(const f32x4*)(sw + 132);
#pragma unroll
        for (int ai = 0; ai < 2; ++ai)
#pragma unroll
            for (int m = 0; m < 4; ++m) {
                const int row = u.pm * BM + ai * HALF + wr * 64 + m * 16 + fr;
                const float sa = row_sa[row];
                float hv[8];
#pragma unroll
                for (int j = 0; j < 8; ++j) {
                    const float gi = (float)__float_as_int(j < 4 ? acc[ai][0][m][0][j & 3] : acc[ai][0][m][1][j & 3]);
                    const float ui = (float)__float_as_int(j < 4 ? acc[ai][1][m][0][j & 3] : acc[ai][1][m][1][j & 3]);
                    const float ga = gi * (sa * (j < 4 ? sg0[j & 3] : sg1[j & 3])) + (j < 4 ? g0[j & 3] : g1[j & 3]);
                    const float ua = ui * (sa * (j < 4 ? su0[j & 3] : su1[j & 3])) + (j < 4 ? u0[j & 3] : u1[j & 3]);
                    const float gt = fminf(ga, 7.0f), up = fminf(fmaxf(ua, -7.0f), 7.0f);
                    hv[j] = gt * __builtin_amdgcn_rcpf(1.0f + __builtin_amdgcn_exp2f(-1.702f * LOG2E * gt)) * (up + 1.0f);
                }
                u32x4 w; w.x = cvt_pk_bf16(hv[0], hv[1]); w.y = cvt_pk_bf16(hv[2], hv[3]); w.z = cvt_pk_bf16(hv[4], hv[5]); w.w = cvt_pk_bf16(hv[6], hv[7]);
                *(u32x4*)(HID + (size_t)row * DFF + fc0) = w;
            }
    }
};
struct EpiDown {
    static constexpr bool PERM = true;
    const int* tile_e; const float* b_down; const float* row_gate; bf16* Y;
    __device__ __forceinline__ void operator()(const f32x4 (&acc)[2][2][4][2], const Unit& u, int wr, int wc, int fr, int fq) const {
        const int e = tile_e[u.pm];
#pragma unroll
        for (int bj = 0; bj < 2; ++bj) {
            const int c0 = u.pn * BM + bj * HALF + wc * 32 + 8 * fq;
            const f32x4 bv0 = *(const f32x4*)(b_down + e * D + c0), bv1 = *(const f32x4*)(b_down + e * D + c0 + 4);
#pragma unroll
            for (int ai = 0; ai < 2; ++ai)
#pragma unroll
                for (int m = 0; m < 4; ++m) {
                    const int row = u.pm * BM + ai * HALF + wr * 64 + m * 16 + fr;
                    const float gt = row_gate[row];
                    const f32x4 v0 = (acc[ai][bj][m][0] + bv0) * gt, v1 = (acc[ai][bj][m][1] + bv1) * gt;
                    u32x4 w; w.x = cvt_pk_bf16(v0[0], v0[1]); w.y = cvt_pk_bf16(v0[2], v0[3]); w.z = cvt_pk_bf16(v1[0], v1[1]); w.w = cvt_pk_bf16(v1[2], v1[3]);
                    *(u32x4*)(Y + (size_t)row * D + c0) = w;
                }
        }
    }
};
}
constexpr int NWAVES = 8;
constexpr int NPHASES = 9;
constexpr size_t WS_WIN = WS_HID + 144 * MiB;
constexpr size_t WS_WOUT = WS_WIN + 4 * MiB;
constexpr size_t WS_WGU = WS_WOUT + 2 * MiB;
constexpr size_t WS_SWGU = WS_WGU + 64 * MiB;
constexpr size_t WS_WD = WS_SWGU + 1 * MiB;
constexpr size_t WS_END = WS_WD + 64 * MiB;
constexpr int CW_BAR = 4096;
constexpr int RING_BYTES = 131072;
constexpr int RTAB_OFF = RING_BYTES;
constexpr int RTAB_UNITS = 12;
constexpr int RW_BYTES = 1024 * 144;
constexpr int RSCR_OFF = RW_BYTES;
constexpr int LDS_BYTES = 163840;
constexpr int MISC_OFF = LDS_BYTES - 256;
static_assert(RTAB_OFF + RTAB_UNITS * 1024 <= MISC_OFF && RSCR_OFF + 4096 <= MISC_OFF, "LDS map");

typedef GAS unsigned gu32;
#define RLX_AGENT __ATOMIC_RELAXED, __HIP_MEMORY_SCOPE_AGENT
#define LDS_WAIT() asm volatile("s_waitcnt lgkmcnt(0)" ::: "memory")
#define VM_WAIT() asm volatile("s_waitcnt vmcnt(0)" ::: "memory")

#define XB_TMO      128
#define XB_XCNT(j)  (256  + 64 * (j))
#define XB_XSUB(j)  (1280 + 64 * (j))
#define XB_XGEN(j)  (2304 + 64 * (j))
#define XB_TOP      3328
#define XB_TOPGEN   3392
#define XCD_BAR_WORDS 3456
#define XB_SPIN_CAP (1u << 18)
__device__ __forceinline__ unsigned xb_ld(unsigned* p)              { return __hip_atomic_load(p, __ATOMIC_RELAXED, __HIP_MEMORY_SCOPE_AGENT); }
__device__ __forceinline__ unsigned xb_add(unsigned* p, unsigned v) { return __hip_atomic_fetch_add(p, v, __ATOMIC_RELAXED, __HIP_MEMORY_SCOPE_AGENT); }
__device__ __forceinline__ unsigned xb_xcc_id() { return (unsigned)__builtin_amdgcn_s_getreg((3 << 11) | 20) & 0xFu; }
#define XB_SPIN(cond, bar) do { unsigned _sp = 0; while (cond) { __builtin_amdgcn_s_sleep(1); \
    if ((++_sp & 255u) == 0u) { if (xb_ld(&(bar)[XB_TMO])) break; if (_sp > XB_SPIN_CAP) { atomicAdd(&(bar)[XB_TMO], 1u); break; } } } } while (0)
struct XcdBarrier { unsigned* bar; unsigned x; volatile LAS unsigned* st; };
__device__ __forceinline__ XcdBarrier xcd_barrier_post(unsigned* bar, volatile LAS unsigned* st) {
    XcdBarrier b; b.bar = bar; b.x = xb_xcc_id(); b.st = st;
    if (threadIdx.x == 0) (void)xb_add(&bar[XB_XCNT(b.x)], 1u);
    return b;
}
__device__ __forceinline__ void xcd_barrier_complete(unsigned* bar, unsigned x, unsigned& nloc, unsigned& nx) {
    const unsigned G = gridDim.x * gridDim.y * gridDim.z;
    unsigned sum, cnt, mine, sp = 0u;
    for (;;) {
        sum = 0u; cnt = 0u; mine = 0u;
#pragma unroll
        for (unsigned j = 0; j < 16; ++j) { const unsigned c = xb_ld(&bar[XB_XCNT(j)]); sum += c; cnt += (c > 0u) ? 1u : 0u; mine = (j == x) ? c : mine; }
        if (sum == G) break;
        __builtin_amdgcn_s_sleep(1);
        if ((++sp & 255u) == 0u) { if (xb_ld(&bar[XB_TMO])) break; if (sp > XB_SPIN_CAP) { atomicAdd(&bar[XB_TMO], 1u); break; } }
    }
    nloc = mine > 0u ? mine : 1u; nx = cnt > 0u ? cnt : 1u;
}
__device__ __forceinline__ void xcd_barrier(const XcdBarrier& b) {
    asm volatile("s_waitcnt vmcnt(0)" ::: "memory");
    __syncthreads();
    if (threadIdx.x == 0) {
        unsigned* bar = b.bar;
        __builtin_amdgcn_s_waitcnt(0);
        unsigned nloc = b.st[0], nx = b.st[1];
        if (nloc == 0u) { xcd_barrier_complete(bar, b.x, nloc, nx); b.st[0] = nloc; b.st[1] = nx; }
        const unsigned old = xb_add(&bar[XB_XSUB(b.x)], 1u);
        const unsigned gen = old / nloc;
        if (old + 1u == (gen + 1u) * nloc) {
            __builtin_amdgcn_fence(__ATOMIC_RELEASE, "agent");
            asm volatile("s_waitcnt vmcnt(0)" ::: "memory");
            const unsigned og = xb_add(&bar[XB_TOP], 1u);
            const unsigned tg = og / nx;
            if (og + 1u == (tg + 1u) * nx) xb_add(&bar[XB_TOPGEN], 1u);
            else XB_SPIN(xb_ld(&bar[XB_TOPGEN]) == tg, bar);
            __builtin_amdgcn_fence(__ATOMIC_ACQUIRE, "agent");
            xb_add(&bar[XB_XGEN(b.x)], 1u);
            asm volatile("s_waitcnt vmcnt(0)" ::: "memory");
        } else {
            XB_SPIN(xb_ld(&bar[XB_XGEN(b.x)]) == gen, bar);
            __builtin_amdgcn_fence(__ATOMIC_ACQUIRE, "agent");
            asm volatile("s_waitcnt vmcnt(0)" ::: "memory");
        }
    }
    __syncthreads();
}

struct Args {
    const float* in[22]; float* out; unsigned char* ws; int ph_lo, ph_hi, li, pad;
};
struct Frame {
    LAS unsigned char* lds;
    int tid, lane, wave, vcu, G;
};
__device__ __forceinline__ void p0_item(const float* W, int N, bf16* WT, int K, int dst_row0, int k0, int n0, LAS float* scr, int lane) {
    f32x4 v[8];
#pragma unroll
    for (int i = 0; i < 8; ++i) v[i] = *(const f32x4*)(W + (size_t)(k0 + (lane >> 3) + 8 * i) * N + n0 + 4 * (lane & 7));
#pragma unroll
    for (int i = 0; i < 8; ++i) { LAS float* s = scr + ((lane >> 3) + 8 * i) * 33 + 4 * (lane & 7); s[0] = v[i].x; s[1] = v[i].y; s[2] = v[i].z; s[3] = v[i].w; }
    LDS_WAIT(); asm volatile("" ::: "memory");
    const int c = lane & 7;
#pragma unroll
    for (int j = 0; j < 4; ++j) { const int n = (lane >> 3) + 8 * j; const LAS float* s = scr + (8 * c) * 33 + n;
        u32x4 o; o.x = pk2(s[0 * 33], s[1 * 33]); o.y = pk2(s[2 * 33], s[3 * 33]); o.z = pk2(s[4 * 33], s[5 * 33]); o.w = pk2(s[6 * 33], s[7 * 33]);
        *(u32x4*)(WT + (size_t)(dst_row0 + n) * K + k0 + 8 * c) = o; }
    LDS_WAIT(); asm volatile("" ::: "memory");
}
__device__ __forceinline__ void p0_gu_item(const Frame& F, const float* W, int n0, signed char* dst, int dst_row0, float* sc_out) {
    const int tid = F.tid, n4 = tid & 7, kl = tid >> 3;
    f32x4 v[4][4];
#pragma unroll
    for (int i = 0; i < 4; ++i)
#pragma unroll
        for (int j = 0; j < 4; ++j) v[i][j] = *(const f32x4*)(W + (size_t)(4 * (kl + 64 * i) + j) * DFF + n0 + 4 * n4);
    f32x4 am = (f32x4){0.f, 0.f, 0.f, 0.f};
#pragma unroll
    for (int i = 0; i < 4; ++i)
#pragma unroll
        for (int j = 0; j < 4; ++j) { am.x = fmaxf(am.x, fabsf(v[i][j].x)); am.y = fmaxf(am.y, fabsf(v[i][j].y)); am.z = fmaxf(am.z, fabsf(v[i][j].z)); am.w = fmaxf(am.w, fabsf(v[i][j].w)); }
#pragma unroll
    for (int o = 8; o < 64; o <<= 1) { am.x = fmaxf(am.x, __shfl_xor(am.x, o)); am.y = fmaxf(am.y, __shfl_xor(am.y, o)); am.z = fmaxf(am.z, __shfl_xor(am.z, o)); am.w = fmaxf(am.w, __shfl_xor(am.w, o)); }
    LAS unsigned* tile = (LAS unsigned*)F.lds;
    LAS float* red = (LAS float*)(F.lds + 36864);
    if (F.lane < 8) *(LAS f32x4*)(red + F.wave * 32 + 4 * n4) = am;
    __syncthreads();
    f32x4 cm = *(const LAS f32x4*)(red + 4 * n4);
#pragma unroll
    for (int w = 1; w < 8; ++w) { const f32x4 o = *(const LAS f32x4*)(red + w * 32 + 4 * n4); cm.x = fmaxf(cm.x, o.x); cm.y = fmaxf(cm.y, o.y); cm.z = fmaxf(cm.z, o.z); cm.w = fmaxf(cm.w, o.w); }
    f32x4 inv;
#pragma unroll
    for (int c = 0; c < 4; ++c) inv[c] = cm[c] > 0.f ? 127.0f / cm[c] : 0.f;
    if (kl == 0) {
#pragma unroll
        for (int c = 0; c < 4; ++c) sc_out[dst_row0 + 4 * n4 + c] = cm[c] * (1.0f / 127.0f);
    }
#pragma unroll
    for (int i = 0; i < 4; ++i)
#pragma unroll
        for (int c = 0; c < 4; ++c) {
            unsigned d = 0u;
#pragma unroll
            for (int j = 0; j < 4; ++j) { const int q = (int)rintf(v[i][j][c] * inv[c]); d |= ((unsigned)q & 0xffu) << (8 * j); }
            tile[(4 * n4 + c) * 260 + kl + 64 * i] = d;
        }
    __syncthreads();
#pragma unroll
    for (int j = 0; j < 4; ++j) { const int ch = tid + 512 * j, n = ch >> 6, c16 = ch & 63;
        *(u32x4*)(dst + (size_t)(dst_row0 + n) * 1024 + 16 * c16) = *(const LAS u32x4*)(tile + n * 260 + 4 * c16); }
    __syncthreads();
}
__device__ __forceinline__ void p0_prologue(const Frame& F, const Args& a) {
    unsigned char* ws = a.ws;
    bf16* Win_t = (bf16*)(ws + WS_WIN); bf16* Wout_t = (bf16*)(ws + WS_WOUT); signed char* Wgu8 = (signed char*)(ws + WS_WGU); float* swgu = (float*)(ws + WS_SWGU); bf16* Wd_t = (bf16*)(ws + WS_WD);
    for (int it = F.vcu; it < 2 * NEXP * 32; it += F.G) {
        const int nb = it & 31, e = (it >> 5) & 31, kind = it >> 10, n0 = nb * 32;
        p0_gu_item(F, (kind ? a.in[16] : a.in[14]) + (size_t)e * D * DFF, n0, Wgu8 + (size_t)e * 2048 * 1024, (n0 >> 7) * 256 + kind * 128 + (n0 & 127), swgu + e * 2048);
    }
    LAS float* scr = (LAS float*)(F.lds + F.wave * 8448);
    const int gw = F.vcu * NWAVES + F.wave, NGW = F.G * NWAVES;
    constexpr int I_IN = 16 * 56, I_OUT = 16 * 32, I_E = 512, NITEMS = I_IN + I_OUT + 32 * I_E;
    for (int it = gw; it < NITEMS; it += NGW) {
        int r = it;
        if (r < I_IN) { const int kb = r / 56, nb = r % 56; p0_item(a.in[1], INW, Win_t, D, nb * 32, kb * 64, nb * 32, scr, F.lane); continue; } r -= I_IN;
        if (r < I_OUT) { const int kb = r / 32, nb = r % 32; p0_item(a.in[8], D, Wout_t, D, nb * 32, kb * 64, nb * 32, scr, F.lane); continue; } r -= I_OUT;
        const int e = r / I_E, idx = r % I_E, kb = idx >> 5, nb = idx & 31, n0 = nb * 32;
        p0_item(a.in[18] + (size_t)e * DFF * D, D, Wd_t + (size_t)e * D * DFF, DFF, n0, kb * 64, n0, scr, F.lane);
    }
    const float* x = a.in[0]; bf16* XB = (bf16*)(ws + WS_XB);
    for (int m = gw; m < T; m += NGW) {
        const f32x4* xr = (const f32x4*)(x + (size_t)m * D) + F.lane; u32x2* o = (u32x2*)(XB + (size_t)m * D) + F.lane;
        f32x4 v[4];
#pragma unroll
        for (int j = 0; j < 4; ++j) v[j] = xr[64 * j];
#pragma unroll
        for (int j = 0; j < 4; ++j) { u32x2 w; w.x = pk2(v[j].x, v[j].y); w.y = pk2(v[j].z, v[j].w); o[64 * j] = w; }
    }
}

__device__ __forceinline__ int crow(int r, int hi) { return (r & 3) + 8 * (r >> 2) + 4 * hi; }
__device__ __forceinline__ void attn_wave_unit(const bf16* QB, const bf16* KB, const bf16* VT, const float* sinks, bf16* CAT, int q32, int h, int lane) {
    const int r32 = lane & 31, hi = lane >> 5;
    const int tok0 = q32 * 32, b = tok0 / SEQ, t0 = tok0 % SEQ, g = h >> 2;
    bf16x8 qf[4];
#pragma unroll
    for (int d0 = 0; d0 < 4; ++d0) qf[d0] = *(const bf16x8*)(QB + (size_t)(tok0 + r32) * 512 + h * 64 + d0 * 16 + hi * 8);
    f32x16 p[5];
    const float NEG = -INFINITY;
#pragma unroll
    for (int j = 0; j < 5; ++j) {
        const int kb = t0 - 128 + 32 * j;
        f32x16 s;
#pragma unroll
        for (int r = 0; r < 16; ++r) s[r] = 0.f;
        if (kb >= 0) {
            const bf16* kr = KB + (size_t)(b * SEQ + kb + r32) * 128 + g * 64 + hi * 8;
            bf16x8 kf[4];
#pragma unroll
            for (int d0 = 0; d0 < 4; ++d0) kf[d0] = *(const bf16x8*)(kr + d0 * 16);
#pragma unroll
            for (int d0 = 0; d0 < 4; ++d0) s = __builtin_amdgcn_mfma_f32_32x32x16_bf16(kf[d0], qf[d0], s, 0, 0, 0);
            if (j == 0) {
#pragma unroll
                for (int r = 0; r < 16; ++r) if (!(crow(r, hi) > r32)) s[r] = NEG;
            }
            if (j == 4) {
#pragma unroll
                for (int r = 0; r < 16; ++r) if (!(crow(r, hi) <= r32)) s[r] = NEG;
            }
        } else {
#pragma unroll
            for (int r = 0; r < 16; ++r) s[r] = NEG;
        }
        p[j] = s;
    }
    const float sk = sinks[h] * LOG2E;
    float m = sk;
#pragma unroll
    for (int j = 0; j < 5; ++j)
#pragma unroll
        for (int r = 0; r < 16; ++r) m = fmaxf(m, p[j][r]);
    m = fmaxf(m, __shfl_xor(m, 32));
    float l = 0.f;
#pragma unroll
    for (int j = 0; j < 5; ++j)
#pragma unroll
        for (int r = 0; r < 16; ++r) { const float e = __builtin_amdgcn_exp2f(p[j][r] - m); p[j][r] = e; l += e; }
    l += __shfl_xor(l, 32);
    l += __builtin_amdgcn_exp2f(sk - m);
    const float inv = 1.0f / l;
    u32x4 pb[5][2];
#pragma unroll
    for (int j = 0; j < 5; ++j)
#pragma unroll
        for (int s = 0; s < 2; ++s) { pb[j][s].x = cvt_pk_bf16(p[j][8 * s + 0], p[j][8 * s + 1]); pb[j][s].y = cvt_pk_bf16(p[j][8 * s + 2], p[j][8 * s + 3]); pb[j][s].z = cvt_pk_bf16(p[j][8 * s + 4], p[j][8 * s + 5]); pb[j][s].w = cvt_pk_bf16(p[j][8 * s + 6], p[j][8 * s + 7]); }
#pragma unroll
    for (int db = 0; db < 2; ++db) {
        f32x16 o;
#pragma unroll
        for (int r = 0; r < 16; ++r) o[r] = 0.f;
        const bf16* vr = VT + ((size_t)((b * 2 + g) * 64 + db * 32 + r32)) * SEQ + 4 * hi;
#pragma unroll
        for (int j = 0; j < 5; ++j) {
            const int kb = t0 - 128 + 32 * j;
            if (kb >= 0) {
#pragma unroll
                for (int s = 0; s < 2; ++s) {
                    const u32x2 lo = *(const u32x2*)(vr + kb + 16 * s), hh = *(const u32x2*)(vr + kb + 16 * s + 8);
                    u32x4 av; av.x = lo.x; av.y = lo.y; av.z = hh.x; av.w = hh.y;
                    o = __builtin_amdgcn_mfma_f32_32x32x16_bf16(__builtin_bit_cast(bf16x8, av), __builtin_bit_cast(bf16x8, pb[j][s]), o, 0, 0, 0);
                }
            }
        }
        bf16* op = CAT + (size_t)(tok0 + r32) * 1024 + h * 64 + db * 32 + 4 * hi;
#pragma unroll
        for (int gq = 0; gq < 4; ++gq) { u32x2 w; w.x = cvt_pk_bf16(o[4 * gq] * inv, o[4 * gq + 1] * inv); w.y = cvt_pk_bf16(o[4 * gq + 2] * inv, o[4 * gq + 3] * inv); *(u32x2*)(op + 8 * gq) = w; }
    }
}
__device__ __forceinline__ void sgu_unit(const Frame& F, const bf16* UB, const bf16* GB, const float* ln_g, const float* ln_b, const float* w_s, const float* b_s, bf16* CAT, int ch, int gi) {
    LAS bf16* GT = (LAS bf16*)F.lds;
    {
        const int s = F.tid >> 2, q4 = F.tid & 3; const size_t tok = (size_t)ch * 128 + s;
        const u32x4* gp = (const u32x4*)(GB + tok * 512 + gi * 64 + q4 * 16);
        const u32x4 a = gp[0], c = gp[1];
        float v[16];
        v[0] = __uint_as_float(a.x << 16); v[1] = __uint_as_float(a.x & 0xffff0000u); v[2] = __uint_as_float(a.y << 16); v[3] = __uint_as_float(a.y & 0xffff0000u);
        v[4] = __uint_as_float(a.z << 16); v[5] = __uint_as_float(a.z & 0xffff0000u); v[6] = __uint_as_float(a.w << 16); v[7] = __uint_as_float(a.w & 0xffff0000u);
        v[8] = __uint_as_float(c.x << 16); v[9] = __uint_as_float(c.x & 0xffff0000u); v[10] = __uint_as_float(c.y << 16); v[11] = __uint_as_float(c.y & 0xffff0000u);
        v[12] = __uint_as_float(c.z << 16); v[13] = __uint_as_float(c.z & 0xffff0000u); v[14] = __uint_as_float(c.w << 16); v[15] = __uint_as_float(c.w & 0xffff0000u);
        float sum = 0.f;
#pragma unroll
        for (int i = 0; i < 16; ++i) sum += v[i];
        sum += __shfl_xor(sum, 1); sum += __shfl_xor(sum, 2);
        const float mu = sum * (1.f / 64.f); float q = 0.f;
#pragma unroll
        for (int i = 0; i < 16; ++i) { v[i] -= mu; q += v[i] * v[i]; }
        q += __shfl_xor(q, 1); q += __shfl_xor(q, 2);
        const float rstd = rsqrtf(q * (1.f / 64.f) + LN_EPS);
#pragma unroll
        for (int i = 0; i < 16; ++i) { const int d = q4 * 16 + i; GT[d * 136 + s] = (bf16)f2bf(v[i] * rstd * ln_g[gi * 64 + d] + ln_b[gi * 64 + d]); }
    }
    __syncthreads();
    {
        const int r32 = F.lane & 31, hi = F.lane >> 5, tb = F.wave >> 1, db = F.wave & 1, t = tb * 32 + r32;
        f32x16 acc;
#pragma unroll
        for (int r = 0; r < 16; ++r) acc[r] = 0.f;
        const float* wrow = w_s + ((size_t)gi * 128 + t) * 128;
        const LAS bf16* arow = GT + (db * 32 + r32) * 136 + hi * 8;
        const int nks = 2 * (tb + 1);
        for (int ks = 0; ks < nks; ++ks) {
            const bf16x8 af = *(const LAS bf16x8*)(arow + ks * 16);
            const int s0 = ks * 16 + hi * 8;
            f32x4 w0 = *(const f32x4*)(wrow + s0), w1 = *(const f32x4*)(wrow + s0 + 4);
#pragma unroll
            for (int j = 0; j < 4; ++j) { if (s0 + j > t) w0[j] = 0.f; if (s0 + 4 + j > t) w1[j] = 0.f; }
            u32x4 bw; bw.x = cvt_pk_bf16(w0[0], w0[1]); bw.y = cvt_pk_bf16(w0[2], w0[3]); bw.z = cvt_pk_bf16(w1[0], w1[1]); bw.w = cvt_pk_bf16(w1[2], w1[3]);
            acc = __builtin_amdgcn_mfma_f32_32x32x16_bf16(af, __builtin_bit_cast(bf16x8, bw), acc, 0, 0, 0);
        }
        const float bb = b_s[gi * 128 + t];
        const size_t tokt = (size_t)ch * 128 + t;
        const bf16* up = UB + tokt * 512 + gi * 64 + db * 32 + 4 * hi;
        bf16* op = CAT + tokt * 1024 + 512 + gi * 64 + db * 32 + 4 * hi;
#pragma unroll
        for (int gq = 0; gq < 4; ++gq) {
            const u32x2 uu = *(const u32x2*)(up + 8 * gq);
            const float u0 = __uint_as_float(uu.x << 16), u1 = __uint_as_float(uu.x & 0xffff0000u), u2 = __uint_as_float(uu.y << 16), u3 = __uint_as_float(uu.y & 0xffff0000u);
            u32x2 w; w.x = cvt_pk_bf16(u0 * (acc[4 * gq] + bb), u1 * (acc[4 * gq + 1] + bb)); w.y = cvt_pk_bf16(u2 * (acc[4 * gq + 2] + bb), u3 * (acc[4 * gq + 3] + bb));
            *(u32x2*)(op + 8 * gq) = w;
        }
    }
    __syncthreads();
}
__device__ __forceinline__ void p2_mixers(const Frame& F, const Args& a) {
    unsigned char* ws = a.ws;
    const bf16 *QB = (const bf16*)(ws + WS_QB), *KB = (const bf16*)(ws + WS_KB), *VT = (const bf16*)(ws + WS_VT), *UB = (const bf16*)(ws + WS_UB), *GB = (const bf16*)(ws + WS_GB);
    bf16* CAT = (bf16*)(ws + WS_CAT);
    for (int qq = F.vcu; qq < T / 64; qq += F.G) {
        attn_wave_unit(QB, KB, VT, a.in[3], CAT, 2 * qq, F.wave, F.lane);
        attn_wave_unit(QB, KB, VT, a.in[3], CAT, 2 * qq + 1, F.wave, F.lane);
    }
    for (int u = F.vcu; u < (T / 128) * 8; u += F.G) sgu_unit(F, UB, GB, a.in[4], a.in[5], a.in[6], a.in[7], CAT, u >> 3, u & 7);
}

__device__ __forceinline__ void p4_router(const Frame& F, const Args& a) {
    float* ZH = a.out; signed char* HB8 = (signed char*)(a.ws + WS_HB); int* meta = (int*)(a.ws + WS_META); unsigned* cnt = (unsigned*)(a.ws + WS_CTL) + CW_CNT;
    const float* ln1_g = a.in[10]; const float* ln1_b = a.in[11]; const float* w_r = a.in[12]; const float* b_r = a.in[13];
    LAS float* W = (LAS float*)F.lds;
    LAS unsigned* hist = (LAS unsigned*)(F.lds + RSCR_OFF);
    LAS unsigned* base = hist + 32;
    LAS int* tmp_e = (LAS int*)(hist + 64);
    LAS int* tmp_p = tmp_e + 256;
    LAS float* tmp_g = (LAS float*)(tmp_p + 256);
    for (int i = F.tid; i < 1024 * 8; i += NWAVES * 64) { const int c = i >> 3, e4 = i & 7; *(LAS f32x4*)(W + c * 36 + e4 * 4) = *(const f32x4*)(w_r + c * 32 + e4 * 4); }
    { const int gt = F.vcu * (NWAVES * 64) + F.tid, NGT = F.G * NWAVES * 64;
      for (int i = gt; i < NROWS_MAX; i += NGT) { meta[MT_ROW_TOK + i] = 0; ((float*)meta)[MT_ROW_GATE + i] = 0.f; ((float*)meta)[MT_ROW_SA + i] = 0.f; } }
    const int lane = F.lane, half = lane >> 5, el = lane & 31;
    for (int tb = F.vcu; tb < T / 64; tb += F.G) {
        if (F.tid < 32) hist[F.tid] = 0u;
        __syncthreads();
        for (int pp = 0; pp < 4; ++pp) {
            const int tl0 = 8 * F.wave + 2 * pp;
            const int tok0 = tb * 64 + tl0;
            float h0[16], h1[16];
            {
                float* z0 = ZH + (size_t)tok0 * D + lane; float* z1 = z0 + D;
                float s0 = 0.f, s1 = 0.f;
#pragma unroll
                for (int i = 0; i < 16; ++i) { h0[i] = z0[64 * i]; h1[i] = z1[64 * i]; s0 += h0[i]; s1 += h1[i]; }
                const float m0 = wave_sum(s0) * (1.f / D), m1 = wave_sum(s1) * (1.f / D);
                float q0 = 0.f, q1 = 0.f;
#pragma unroll
                for (int i = 0; i < 16; ++i) { h0[i] -= m0; h1[i] -= m1; q0 += h0[i] * h0[i]; q1 += h1[i] * h1[i]; }
                const float r0 = rsqrtf(wave_sum(q0) * (1.f / D) + LN_EPS), r1 = rsqrtf(wave_sum(q1) * (1.f / D) + LN_EPS);
                float a0 = 0.f, a1 = 0.f;
#pragma unroll
                for (int i = 0; i < 16; ++i) {
                    const float gg = ln1_g[64 * i + lane], bb = ln1_b[64 * i + lane];
                    h0[i] = h0[i] * r0 * gg + bb; h1[i] = h1[i] * r1 * gg + bb;
                    z0[64 * i] = h0[i]; z1[64 * i] = h1[i];
                    a0 = fmaxf(a0, fabsf(h0[i])); a1 = fmaxf(a1, fabsf(h1[i]));
                }
                a0 = wave_max(a0); a1 = wave_max(a1);
                const float i0 = a0 > 0.f ? 127.0f / a0 : 0.f, i1 = a1 > 0.f ? 127.0f / a1 : 0.f;
                signed char* hb0 = HB8 + (size_t)tok0 * D + lane; signed char* hb1 = hb0 + D;
#pragma unroll
                for (int i = 0; i < 16; ++i) { hb0[64 * i] = (signed char)(int)rintf(h0[i] * i0); hb1[64 * i] = (signed char)(int)rintf(h1[i] * i1); }
                if (lane == 0) { ((float*)meta)[MT_SH + tok0] = a0 * (1.0f / 127.0f); ((float*)meta)[MT_SH + tok0 + 1] = a1 * (1.0f / 127.0f); }
            }
            float lg0[32], lg1[32];
#pragma unroll
            for (int e = 0; e < 32; ++e) { lg0[e] = 0.f; lg1[e] = 0.f; }
#pragma unroll
            for (int i = 0; i < 16; ++i) {
                const LAS f32x4* wr = (const LAS f32x4*)(W + (64 * i + lane) * 36);
#pragma unroll
                for (int e4 = 0; e4 < 8; ++e4) {
                    const f32x4 ww = wr[e4];
                    lg0[4 * e4 + 0] += h0[i] * ww.x; lg0[4 * e4 + 1] += h0[i] * ww.y; lg0[4 * e4 + 2] += h0[i] * ww.z; lg0[4 * e4 + 3] += h0[i] * ww.w;
                    lg1[4 * e4 + 0] += h1[i] * ww.x; lg1[4 * e4 + 1] += h1[i] * ww.y; lg1[4 * e4 + 2] += h1[i] * ww.z; lg1[4 * e4 + 3] += h1[i] * ww.w;
                }
            }
            float v32[32];
#pragma unroll
            for (int e = 0; e < 32; ++e) { const float keep = half ? lg1[e] : lg0[e], send = half ? lg0[e] : lg1[e]; v32[e] = keep + __shfl_xor(send, 32); }
            float v16[16];
#pragma unroll
            for (int e = 0; e < 16; ++e) { const bool up = (lane & 16) != 0; const float keep = up ? v32[e + 16] : v32[e], send = up ? v32[e] : v32[e + 16]; v16[e] = keep + __shfl_xor(send, 16); }
            float v8[8];
#pragma unroll
            for (int e = 0; e < 8; ++e) { const bool up = (lane & 8) != 0; const float keep = up ? v16[e + 8] : v16[e], send = up ? v16[e] : v16[e + 8]; v8[e] = keep + __shfl_xor(send, 8); }
            float v4[4];
#pragma unroll
            for (int e = 0; e < 4; ++e) { const bool up = (lane & 4) != 0; const float keep = up ? v8[e + 4] : v8[e], send = up ? v8[e] : v8[e + 4]; v4[e] = keep + __shfl_xor(send, 4); }
            float v2[2];
#pragma unroll
            for (int e = 0; e < 2; ++e) { const bool up = (lane & 2) != 0; const float keep = up ? v4[e + 2] : v4[e], send = up ? v4[e] : v4[e + 2]; v2[e] = keep + __shfl_xor(send, 2); }
            float lgt;
            { const bool up = (lane & 1) != 0; const float keep = up ? v2[1] : v2[0], send = up ? v2[0] : v2[1]; lgt = keep + __shfl_xor(send, 1); }
            lgt += b_r[el];
            float bv[4]; int bi[4];
#pragma unroll
            for (int k = 0; k < 4; ++k) {
                float val = lgt; int idx = el;
#pragma unroll
                for (int o = 1; o < 32; o <<= 1) { const float ov = __shfl_xor(val, o); const int oi = __shfl_xor(idx, o); if (ov > val || (ov == val && oi < idx)) { val = ov; idx = oi; } }
                bv[k] = val; bi[k] = idx;
                if (el == idx) lgt = -INFINITY;
            }
            float ex[4], es = 0.f;
#pragma unroll
            for (int k = 0; k < 4; ++k) { ex[k] = __expf(bv[k] - bv[0]); es += ex[k]; }
            if (el == 0) {
                const int tl = tl0 + half;
#pragma unroll
                for (int k = 0; k < 4; ++k) { const unsigned pl = atomicAdd((unsigned*)&hist[bi[k]], 1u); tmp_e[tl * 4 + k] = bi[k]; tmp_p[tl * 4 + k] = (int)pl; tmp_g[tl * 4 + k] = ex[k] / es; }
            }
        }
        __syncthreads();
        if (F.tid < 32) base[F.tid] = atomicAdd(&cnt[F.tid], hist[F.tid]);
        __syncthreads();
        if (F.tid < 256) { const int i = F.tid, gi = tb * 256 + i, e = tmp_e[i];
            meta[MT_SEL_E + gi] = e; meta[MT_SEL_POS + gi] = (int)base[e] + tmp_p[i]; ((float*)meta)[MT_SEL_G + gi] = tmp_g[i]; }
        __syncthreads();
    }
}
__device__ __forceinline__ void p5_dispatch(const Frame& F, const Args& a) {
    int* meta = (int*)(a.ws + WS_META); const unsigned* cnt = (const unsigned*)(a.ws + WS_CTL) + CW_CNT;
    LAS int* ts = (LAS int*)(F.lds + RSCR_OFF);
    if (F.tid == 0) { int acc = 0; for (int e = 0; e < 32; ++e) { ts[e] = acc; acc += ((int)__hip_atomic_load(cnt + e, RLX_AGENT) + 255) >> 8; } ts[32] = acc; }
    __syncthreads();
    if (blockIdx.x == 0) {
        if (F.tid == 0) meta[MT_NT] = ts[32];
        if (F.tid < 33) meta[MT_TSTART + F.tid] = ts[F.tid];
        for (int t = F.tid; t < NT_MAX; t += NWAVES * 64) { int e = 0; for (int j = 1; j < 32; ++j) if (t >= ts[j]) e = j; meta[MT_TILE_E + t] = e; }
    }
    const int gt = F.vcu * (NWAVES * 64) + F.tid, NGT = F.G * NWAVES * 64;
    for (int i = gt; i < T * 4; i += NGT) {
        const int e = meta[MT_SEL_E + i], row = ts[e] * 256 + meta[MT_SEL_POS + i];
        meta[MT_ROW_TOK + row] = i >> 2; ((float*)meta)[MT_ROW_GATE + row] = ((const float*)meta)[MT_SEL_G + i]; ((float*)meta)[MT_ROW_SA + row] = ((const float*)meta)[MT_SH + (i >> 2)]; meta[MT_SLOT_ROW + i] = row;
    }
    __syncthreads();
}
__device__ __forceinline__ void p8_final(const Frame& F, const Args& a) {
    float* HO = a.out; const bf16* Y = (const bf16*)(a.ws + WS_Y); const int* meta = (const int*)(a.ws + WS_META);
    const float* ln2_g = a.in[20]; const float* ln2_b = a.in[21];
    const int gw = F.vcu * NWAVES + F.wave, NGW = F.G * NWAVES, lane = F.lane;
    for (int tok = gw; tok < T; tok += NGW) {
        f32x4* hr = (f32x4*)(HO + (size_t)tok * D) + lane;
        f32x4 v[4]; float s = 0.f;
#pragma unroll
        for (int j = 0; j < 4; ++j) v[j] = hr[64 * j] * ALPHA;
#pragma unroll
        for (int k = 0; k < 4; ++k) {
            const int row = meta[MT_SLOT_ROW + tok * 4 + k];
            const u32x2* yr = (const u32x2*)(Y + (size_t)row * D) + lane;
#pragma unroll
            for (int j = 0; j < 4; ++j) { const u32x2 y = yr[64 * j]; v[j].x += __uint_as_float(y.x << 16); v[j].y += __uint_as_float(y.x & 0xffff0000u); v[j].z += __uint_as_float(y.y << 16); v[j].w += __uint_as_float(y.y & 0xffff0000u); }
        }
#pragma unroll
        for (int j = 0; j < 4; ++j) s += (v[j].x + v[j].y) + (v[j].z + v[j].w);
        const float mean = wave_sum(s) * (1.f / D); float s2 = 0.f;
#pragma unroll
        for (int j = 0; j < 4; ++j) { v[j] = v[j] - mean; s2 += (v[j].x * v[j].x + v[j].y * v[j].y) + (v[j].z * v[j].z + v[j].w * v[j].w); }
        const float rstd = rsqrtf(wave_sum(s2) * (1.f / D) + LN_EPS);
#pragma unroll
        for (int j = 0; j < 4; ++j) { const int c0 = 4 * lane + 256 * j; const f32x4 gg = *(const f32x4*)(ln2_g + c0), bb = *(const f32x4*)(ln2_b + c0); hr[64 * j] = v[j] * rstd * gg + bb; }
    }
}
#ifndef MKMASK
#define MKMASK 0x1FF
#endif
#ifndef REPEAT_MASK
#define REPEAT_MASK 0
#endif
#define NREP(k) (1 + ((REPEAT_MASK >> (k)) & 1))
__global__ void __launch_bounds__(NWAVES * 64, 2) mk_fwd(Args args) {
    extern __shared__ __attribute__((aligned(16))) unsigned char lds_raw[];
    Frame F;
    F.lds = (LAS unsigned char*)lds_raw;
    F.tid = threadIdx.x; F.lane = F.tid & 63; F.wave = __builtin_amdgcn_readfirstlane(F.tid >> 6);
    F.G = gridDim.x; { const int bx = blockIdx.x; F.vcu = (F.G % 8 == 0) ? (bx % 8) * (F.G / 8) + bx / 8 : bx; }
    volatile LAS unsigned* MISC = (volatile LAS unsigned*)(F.lds + MISC_OFF);
    if (F.tid < 64) MISC[F.tid] = 0u;
    __syncthreads();
    unsigned char* ws = args.ws;
    unsigned* ctl = (unsigned*)(ws + WS_CTL);
    const int lo = args.ph_lo, hi = args.ph_hi;
    XcdBarrier bar; bar.bar = ctl + CW_BAR + args.li * XCD_BAR_WORDS; bar.x = 0; bar.st = nullptr;
    if (hi - lo > 1) bar = xcd_barrier_post(ctl + CW_BAR + args.li * XCD_BAR_WORDS, MISC + 8);
#define IN(k) (lo <= (k) && (k) < hi)
#define SEAM(k) do { if ((IN(k) && IN((k) + 1)) || rep_ + 1 < NREP(k)) xcd_barrier(bar); } while (0)
    int* meta = (int*)(ws + WS_META);
    bf16 *XB = (bf16*)(ws + WS_XB), *QB = (bf16*)(ws + WS_QB), *KB = (bf16*)(ws + WS_KB), *VT = (bf16*)(ws + WS_VT), *UB = (bf16*)(ws + WS_UB), *GB = (bf16*)(ws + WS_GB);
    bf16 *CAT = (bf16*)(ws + WS_CAT), *HB = (bf16*)(ws + WS_HB), *Y = (bf16*)(ws + WS_Y), *HID = (bf16*)(ws + WS_HID);
    bf16 *Win_t = (bf16*)(ws + WS_WIN), *Wout_t = (bf16*)(ws + WS_WOUT), *Wgu_t = (bf16*)(ws + WS_WGU), *Wd_t = (bf16*)(ws + WS_WD);
    const LAS int* rtab = (const LAS int*)(F.lds + RTAB_OFF);

    for (int rep_ = 0; rep_ < NREP(0); ++rep_) if (IN(0)) { p0_prologue(F, args); SEAM(0); }
    for (int rep_ = 0; rep_ < NREP(1); ++rep_) if (IN(1)) {
        pg8::Gemm g{XB, Win_t, 2 * D, nullptr, 0u}; pg8::StaticOrder S; S.init(T / 256, INW / 256, F.G, (int)blockIdx.x);
        pg8::EpiInProj E{args.in[2], QB, KB, VT, UB, GB};
        pg8::gemm_phase<pg8::EpiInProj, false, true, false>(F.lds, rtab, g, S, E);
        SEAM(1);
    }
    for (int rep_ = 0; rep_ < NREP(2); ++rep_) if (IN(2)) { p2_mixers(F, args); SEAM(2); }
    for (int rep_ = 0; rep_ < NREP(3); ++rep_) if (IN(3)) {
        pg8::Gemm g{CAT, Wout_t, 2 * D, nullptr, 0u}; pg8::StaticOrder S; S.init(T / 256, D / 256, F.G, (int)blockIdx.x);
        pg8::EpiOutProj E{args.in[0], args.in[9], args.out};
        pg8::gemm_phase<pg8::EpiOutProj, false, false, false>(F.lds, rtab, g, S, E);
        SEAM(3);
    }
    for (int rep_ = 0; rep_ < NREP(4); ++rep_) if (IN(4)) { p4_router(F, args); SEAM(4); }
    for (int rep_ = 0; rep_ < NREP(5); ++rep_) if (IN(5)) { p5_dispatch(F, args); SEAM(5); }
    for (int rep_ = 0; rep_ < NREP(6); ++rep_) if (IN(6)) {
        const int nT = __builtin_amdgcn_readfirstlane(meta[MT_NT]);
        pg8::StaticOrder S; S.init(nT, 2 * DFF / 256, F.G, (int)blockIdx.x);
        { pg8::Unit u; LAS int* rt = (LAS int*)(F.lds + RTAB_OFF);
          for (int i = 0; i < RTAB_UNITS && S.next(i, u); ++i) if (F.tid < 256) rt[i * 256 + F.tid] = meta[MT_ROW_TOK + u.pm * 256 + F.tid];
          __syncthreads(); }
        pg8::Gemm g{HB, Wgu_t, D, meta + MT_TILE_E, 2048u * 1024u};
        pg8::EpiSwiglu E{meta + MT_TILE_E, args.in[15], args.in[17], (const float*)(ws + WS_SWGU), (const float*)meta + MT_ROW_SA, HID};
        pg8::gemm_phase<pg8::EpiSwiglu, true, true, true>(F.lds, rtab, g, S, E);
        SEAM(6);
    }
    for (int rep_ = 0; rep_ < NREP(7); ++rep_) if (IN(7)) {
        const int nT = __builtin_amdgcn_readfirstlane(meta[MT_NT]);
        pg8::StaticOrder S; S.init(nT, D / 256, F.G, (int)blockIdx.x);
        pg8::Gemm g{HID, Wd_t, 2 * DFF, meta + MT_TILE_E, 1024u * 1024u * 2u};
        pg8::EpiDown E{meta + MT_TILE_E, args.in[19], (const float*)meta + MT_ROW_GATE, Y};
        pg8::gemm_phase<pg8::EpiDown, false, true, false>(F.lds, rtab, g, S, E);
        SEAM(7);
    }
    { const int rep_ = 0; (void)rep_; if (IN(8)) { p8_final(F, args); } }
#undef IN
#undef SEAM
}

extern "C" void kernel_launch(void* const* d_in, const int* in_sizes, int n_in, void* d_out, int out_size, void* d_ws, size_t ws_size, hipStream_t stream) {
    static int grid = 0;
    if (grid == 0) {
        if (n_in != 22 || in_sizes[0] != T * D || out_size != T * D || ws_size < WS_END) { fprintf(stderr, "kernel_launch: unexpected shapes (n_in %d, in0 %d, out %d, ws %zu, need %zu)\n", n_in, n_in > 0 ? in_sizes[0] : -1, out_size, ws_size, (size_t)WS_END); grid = -1; return; }
        int dev = 0, cus = 0;
        if (hipGetDevice(&dev) != hipSuccess || hipDeviceGetAttribute(&cus, hipDeviceAttributeMultiprocessorCount, dev) != hipSuccess) { grid = -1; return; }
        if (hipFuncSetAttribute((const void*)mk_fwd, hipFuncAttributeMaxDynamicSharedMemorySize, LDS_BYTES) != hipSuccess) { fprintf(stderr, "kernel_launch: hipFuncSetAttribute failed\n"); grid = -1; return; }
        int per_cu = 0;
        if (hipOccupancyMaxActiveBlocksPerMultiprocessor(&per_cu, (const void*)mk_fwd, NWAVES * 64, LDS_BYTES) != hipSuccess || per_cu < 1) fprintf(stderr, "kernel_launch: occupancy query reports %d\n", per_cu);
        (void)hipGetLastError();
        grid = cus;
    }
    if (grid < 0) return;
    const float* x = (const float*)d_in[0]; const float* w_in = (const float*)d_in[1]; const float* b_in = (const float*)d_in[2]; const float* sinks = (const float*)d_in[3];
    const float* ln_v_g = (const float*)d_in[4]; const float* ln_v_b = (const float*)d_in[5]; const float* w_sp = (const float*)d_in[6]; const float* b_sp = (const float*)d_in[7];
    const float* w_out = (const float*)d_in[8]; const float* b_out = (const float*)d_in[9]; const float* ln1_g = (const float*)d_in[10]; const float* ln1_b = (const float*)d_in[11];
    const float* w_r = (const float*)d_in[12]; const float* b_r = (const float*)d_in[13]; const float* w_gate = (const float*)d_in[14]; const float* b_gate = (const float*)d_in[15];
    const float* w_up = (const float*)d_in[16]; const float* b_up = (const float*)d_in[17]; const float* w_down = (const float*)d_in[18]; const float* b_down = (const float*)d_in[19];
    const float* ln2_g = (const float*)d_in[20]; const float* ln2_b = (const float*)d_in[21];
    unsigned char* ws = (unsigned char*)d_ws; float* out = (float*)d_out;
    unsigned* ctl = (unsigned*)(ws + WS_CTL); int* meta = (int*)(ws + WS_META);
    bf16 *XB = (bf16*)(ws + WS_XB), *QB = (bf16*)(ws + WS_QB), *KB = (bf16*)(ws + WS_KB), *VT = (bf16*)(ws + WS_VT), *UB = (bf16*)(ws + WS_UB), *GB = (bf16*)(ws + WS_GB);
    bf16 *CAT = (bf16*)(ws + WS_CAT), *HB = (bf16*)(ws + WS_HB), *Y = (bf16*)(ws + WS_Y), *HID = (bf16*)(ws + WS_HID);
    (void)hipMemsetAsync(ws + WS_CTL, 0, 1 * MiB, stream);
    Args a{};
    for (int i = 0; i < 22; ++i) a.in[i] = (const float*)d_in[i];
    a.out = out; a.ws = ws;
    int li = 0;
    for (int k = 0; k < NPHASES;) {
        if ((MKMASK >> k) & 1) {
            int j = k; while (j < NPHASES && ((MKMASK >> j) & 1)) ++j;
            a.ph_lo = k; a.ph_hi = j; a.li = li++;
            hipLaunchKernelGGL(mk_fwd, dim3(grid), dim3(NWAVES * 64), LDS_BYTES, stream, a);
            k = j; continue;
        }
        switch (k) {
        case 0: k_cvt_x<<<2048, 256, 0, stream>>>(x, XB, T * D / 4); break;
        case 1: k_inproj_naive<<<dim3(T / 64, INW / 64), 256, 0, stream>>>(XB, w_in, EpiInProjN{b_in, QB, KB, VT, UB, GB}); break;
        case 2: k_attn_naive<<<T * NQH / 4, 256, 0, stream>>>(QB, KB, VT, sinks, CAT);
                k_sgu_naive<<<T / 128 * 8, 256, 0, stream>>>(UB, GB, ln_v_g, ln_v_b, w_sp, b_sp, CAT); break;
        case 3: k_outproj_naive<<<dim3(T / 64, D / 64), 256, 0, stream>>>(CAT, w_out, EpiOutProjN{b_out, x, out}); break;
        case 4: k_router_naive<<<T / 4, 256, 0, stream>>>(out, HB, ln1_g, ln1_b, w_r, b_r, ctl + CW_CNT, meta);
                k_rowinit<<<(NROWS_MAX + 255) / 256, 256, 0, stream>>>(meta); break;
        case 5: k_dispatch1<<<1, 64, 0, stream>>>(ctl + CW_CNT, meta);
                k_scatter<<<T * 4 / 256, 256, 0, stream>>>(meta); break;
        case 6: k_gateup_naive<<<dim3(NT_MAX * 4, DFF / 64), 256, 0, stream>>>(HB, meta, w_gate, b_gate, w_up, b_up, HID); break;
        case 7: k_down_naive<<<dim3(NT_MAX * 4, D / 64), 256, 0, stream>>>(HID, meta, w_down, b_down, Y); break;
        case 8: k_final_naive<<<T / 4, 256, 0, stream>>>(out, Y, meta, ln2_g, ln2_b); break;
        }
        ++k;
    }
}
```

```cpp
#include <hip/hip_runtime.h>
#include <cstdio>
#include <cstdint>

typedef unsigned short bf16;
typedef float f32x4 __attribute__((ext_vector_type(4)));
typedef unsigned u32x4 __attribute__((ext_vector_type(4)));
typedef unsigned u32x2 __attribute__((ext_vector_type(2)));

constexpr int BATCH = 2, SEQ = 8192, D = 1024, T = BATCH * SEQ;
constexpr int NQH = 8, NKVH = 2, HD = 64, QREP = 4, AW = 512, KVW = 128, GW = 512, INW = 1792;
constexpr int NEXP = 32, TOPK = 4, DFF = 1024;
constexpr int NT_MAX = T * TOPK / 256 + NEXP;
constexpr int NROWS_MAX = NT_MAX * 256;
constexpr float LN_EPS = 1e-5f;
constexpr float ALPHA = 1.189207115002721f;
constexpr float C2 = 0.125f * 1.4426950408889634f;
constexpr float LOG2E = 1.4426950408889634f;

constexpr size_t MiB = 1u << 20;
constexpr size_t WS_CTL = 0;
constexpr size_t WS_META = 1 * MiB;
constexpr size_t WS_XB = 3 * MiB;
constexpr size_t WS_QB = WS_XB + 32 * MiB;
constexpr size_t WS_KB = WS_QB + 16 * MiB;
constexpr size_t WS_VT = WS_KB + 4 * MiB;
constexpr size_t WS_UB = WS_VT + 4 * MiB;
constexpr size_t WS_GB = WS_UB + 16 * MiB;
constexpr size_t WS_CAT = WS_GB + 16 * MiB;
constexpr size_t WS_HB = WS_CAT + 32 * MiB;
constexpr size_t WS_H = WS_XB;
constexpr size_t WS_HID = WS_HB + 32 * MiB;
constexpr size_t WS_Y = WS_HID;
constexpr size_t WS_END_NAIVE = WS_HID + 144 * MiB;
static_assert(WS_H + 64 * MiB <= WS_CAT, "H overlay");

constexpr int CW_CNT = 64;
constexpr int MT_NT = 0;
constexpr int MT_TSTART = 16;
constexpr int MT_TILE_E = 64;
constexpr int MT_SEL_E = 1024;
constexpr int MT_SEL_POS = MT_SEL_E + T * 4;
constexpr int MT_SEL_G = MT_SEL_POS + T * 4;
constexpr int MT_SLOT_ROW = MT_SEL_G + T * 4;
constexpr int MT_ROW_TOK = MT_SLOT_ROW + T * 4;
constexpr int MT_ROW_GATE = MT_ROW_TOK + NROWS_MAX;
constexpr int MT_ROW_SA = MT_ROW_GATE + NROWS_MAX;
constexpr int MT_SH = MT_ROW_SA + NROWS_MAX;
constexpr size_t WS_ROWSB = 512 * 1024;
static_assert((size_t)(MT_SH + T) * 4 <= 2 * MiB, "meta");

__device__ __forceinline__ float bf2f(bf16 v) { return __uint_as_float((unsigned)v << 16); }
__device__ __forceinline__ unsigned f2bf(float f) { unsigned u = __float_as_uint(f); return (u + 0x7fffu + ((u >> 16) & 1u)) >> 16; }
__device__ __forceinline__ unsigned pk2(float lo, float hi) { return f2bf(lo) | (f2bf(hi) << 16); }
__device__ __forceinline__ float gelu_tanh(float x) {
    const float k2 = 2.0f * 0.7978845608028654f;
    const float u = k2 * (x + 0.044715f * x * x * x);
    return x / (1.0f + __expf(-u));
}
__device__ __forceinline__ float wave_sum(float v) {
#pragma unroll
    for (int o = 1; o < 64; o <<= 1) v += __shfl_xor(v, o);
    return v;
}
__device__ __forceinline__ float wave_max(float v) {
#pragma unroll
    for (int o = 1; o < 64; o <<= 1) v = fmaxf(v, __shfl_xor(v, o));
    return v;
}

__global__ void k_cvt_x(const float* __restrict__ x, bf16* __restrict__ xb, int n4) {
    for (int i = blockIdx.x * blockDim.x + threadIdx.x; i < n4; i += gridDim.x * blockDim.x) {
        const f32x4 v = ((const f32x4*)x)[i];
        u32x2 o; o.x = pk2(v.x, v.y); o.y = pk2(v.z, v.w);
        ((u32x2*)xb)[i] = o;
    }
}

template <int NB, class Epi>
__device__ __forceinline__ void naive_gemm_tile(const bf16* A, int lda, const int* rowidx, int m0, const float* B0, const float* B1, int ldb, int n0, int K, const Epi& epi) {
    __shared__ float As[16][68];
    __shared__ float Bs[NB][16][64];
    const int tid = threadIdx.x, ty = tid >> 4, tx = tid & 15;
    float acc[NB][4][4];
#pragma unroll
    for (int b = 0; b < NB; ++b)
#pragma unroll
        for (int i = 0; i < 4; ++i)
#pragma unroll
            for (int j = 0; j < 4; ++j) acc[b][i][j] = 0.f;
    const int ar = tid >> 2, ac = (tid & 3) * 4;
    const int arow = rowidx ? rowidx[m0 + ar] : (m0 + ar);
    const bf16* ap = A + (size_t)arow * lda + ac;
    const int br = tid >> 4, bc = (tid & 15) * 4;
    for (int k0 = 0; k0 < K; k0 += 16) {
        const u32x2 av = *(const u32x2*)(ap + k0);
        As[ac + 0][ar] = __uint_as_float(av.x << 16); As[ac + 1][ar] = __uint_as_float(av.x & 0xffff0000u);
        As[ac + 2][ar] = __uint_as_float(av.y << 16); As[ac + 3][ar] = __uint_as_float(av.y & 0xffff0000u);
        *(f32x4*)&Bs[0][br][bc] = *(const f32x4*)(B0 + (size_t)(k0 + br) * ldb + n0 + bc);
        if (NB == 2) *(f32x4*)&Bs[NB - 1][br][bc] = *(const f32x4*)(B1 + (size_t)(k0 + br) * ldb + n0 + bc);
        __syncthreads();
#pragma unroll
        for (int k = 0; k < 16; ++k) {
            const f32x4 a = *(const f32x4*)&As[k][ty * 4];
#pragma unroll
            for (int b = 0; b < NB; ++b) {
                const f32x4 bv = *(const f32x4*)&Bs[b][k][tx * 4];
#pragma unroll
                for (int i = 0; i < 4; ++i)
#pragma unroll
                    for (int j = 0; j < 4; ++j) acc[b][i][j] += a[i] * bv[j];
            }
        }
        __syncthreads();
    }
#pragma unroll
    for (int i = 0; i < 4; ++i)
#pragma unroll
        for (int j = 0; j < 4; ++j) {
            if (NB == 2) epi(m0 + ty * 4 + i, n0 + tx * 4 + j, acc[0][i][j], acc[NB - 1][i][j]);
            else epi(m0 + ty * 4 + i, n0 + tx * 4 + j, acc[0][i][j], 0.f);
        }
}

struct EpiInProjN {
    const float* b_in; bf16 *QB, *KB, *VT, *UB, *GB;
    __device__ __forceinline__ void operator()(int row, int c, float a, float) const {
        const float v = a + b_in[c];
        if (c < 512) QB[(size_t)row * 512 + c] = (bf16)f2bf(v * C2);
        else if (c < 640) KB[(size_t)row * 128 + (c - 512)] = (bf16)f2bf(v);
        else if (c < 768) { const int cv = c - 640, g = cv >> 6, d = cv & 63, b = row / SEQ, s = row % SEQ; VT[((size_t)((b * 2 + g) * 64 + d)) * SEQ + s] = (bf16)f2bf(v); }
        else if (c < 1280) UB[(size_t)row * 512 + (c - 768)] = (bf16)f2bf(gelu_tanh(v));
        else GB[(size_t)row * 512 + (c - 1280)] = (bf16)f2bf(gelu_tanh(v));
    }
};
__global__ void __launch_bounds__(256) k_inproj_naive(const bf16* XB, const float* w_in, EpiInProjN epi) {
    naive_gemm_tile<1>(XB, D, nullptr, blockIdx.x * 64, w_in, nullptr, INW, blockIdx.y * 64, D, epi);
}

__global__ void __launch_bounds__(256) k_attn_naive(const bf16* QB, const bf16* KB, const bf16* VT, const float* sinks, bf16* CAT) {
    __shared__ float pl[4][128];
    const int w = threadIdx.x >> 6, lane = threadIdx.x & 63;
    const int wu = blockIdx.x * 4 + w;
    const int tok = wu >> 3, h = wu & 7, g = h >> 2, b = tok / SEQ, t = tok % SEQ;
    const float qv = bf2f(QB[(size_t)tok * 512 + h * 64 + lane]);
    float s[2];
    {
        const int kp0 = t - 127 + lane, kp1 = kp0 + 64;
        const bf16* kr0 = KB + (size_t)(b * SEQ + (kp0 < 0 ? 0 : kp0)) * 128 + g * 64;
        const bf16* kr1 = KB + (size_t)(b * SEQ + (kp1 < 0 ? 0 : kp1)) * 128 + g * 64;
        float a0 = 0.f, a1 = 0.f;
        for (int d = 0; d < 64; ++d) { const float qd = __shfl(qv, d); a0 += qd * bf2f(kr0[d]); a1 += qd * bf2f(kr1[d]); }
        s[0] = (kp0 >= 0) ? a0 : -1e30f; s[1] = (kp1 >= 0) ? a1 : -1e30f;
    }
    const float sk = sinks[h] * LOG2E;
    const float m = fmaxf(wave_max(fmaxf(s[0], s[1])), sk);
    const float p0 = exp2f(s[0] - m), p1 = exp2f(s[1] - m);
    const float l = wave_sum(p0 + p1) + exp2f(sk - m);
    pl[w][lane] = p0; pl[w][64 + lane] = p1;
    __syncthreads();
    const bf16* vr = VT + ((size_t)((b * 2 + g) * 64 + lane)) * SEQ;
    float o = 0.f;
    for (int j = 0; j < 128; ++j) { const int kp = t - 127 + j; if (kp >= 0) o += pl[w][j] * bf2f(vr[kp]); }
    CAT[(size_t)tok * 1024 + h * 64 + lane] = (bf16)f2bf(o / l);
}

__global__ void __launch_bounds__(256) k_sgu_naive(const bf16* UB, const bf16* GB, const float* ln_g, const float* ln_b, const float* w_s, const float* b_s, bf16* CAT) {
    __shared__ float G[128][65];
    const int u = blockIdx.x, gi = u & 7, ch = u >> 3;
    const int tid = threadIdx.x, s = tid >> 1, half = tid & 1;
    const size_t tok = (size_t)ch * 128 + s;
    float v[32]; float sum = 0.f;
#pragma unroll
    for (int i = 0; i < 32; ++i) { v[i] = bf2f(GB[tok * 512 + gi * 64 + half * 32 + i]); sum += v[i]; }
    sum += __shfl_xor(sum, 1);
    const float mu = sum * (1.f / 64.f); float q = 0.f;
#pragma unroll
    for (int i = 0; i < 32; ++i) { v[i] -= mu; q += v[i] * v[i]; }
    q += __shfl_xor(q, 1);
    const float rstd = rsqrtf(q * (1.f / 64.f) + LN_EPS);
#pragma unroll
    for (int i = 0; i < 32; ++i) { const int d = half * 32 + i; G[s][d] = v[i] * rstd * ln_g[gi * 64 + d] + ln_b[gi * 64 + d]; }
    __syncthreads();
    const int t = s;
    float acc[32];
#pragma unroll
    for (int i = 0; i < 32; ++i) acc[i] = 0.f;
    const float* wr = w_s + ((size_t)gi * 128 + t) * 128;
    for (int ss = 0; ss <= t; ++ss) {
        const float w = wr[ss];
#pragma unroll
        for (int i = 0; i < 32; ++i) acc[i] += w * G[ss][half * 32 + i];
    }
    const float bb = b_s[gi * 128 + t];
#pragma unroll
    for (int i = 0; i < 32; ++i) { const int d = half * 32 + i; const float uu = bf2f(UB[tok * 512 + gi * 64 + d]); CAT[tok * 1024 + 512 + gi * 64 + d] = (bf16)f2bf(uu * (acc[i] + bb)); }
}

struct EpiOutProjN {
    const float* b_out; const float* x; float* Z;
    __device__ __forceinline__ void operator()(int row, int c, float a, float) const { Z[(size_t)row * D + c] = ALPHA * x[(size_t)row * D + c] + a + b_out[c]; }
};
__global__ void __launch_bounds__(256) k_outproj_naive(const bf16* CAT, const float* w_out, EpiOutProjN epi) {
    naive_gemm_tile<1>(CAT, D, nullptr, blockIdx.x * 64, w_out, nullptr, D, blockIdx.y * 64, D, epi);
}

__global__ void __launch_bounds__(256) k_router_naive(float* ZH, bf16* HB, const float* ln1_g, const float* ln1_b, const float* w_r, const float* b_r, unsigned* cnt, int* meta) {
    const int w = threadIdx.x >> 6, lane = threadIdx.x & 63;
    const int tok = blockIdx.x * 4 + w;
    f32x4* zr = (f32x4*)(ZH + (size_t)tok * D) + lane;
    f32x4 v[4]; float s = 0.f;
#pragma unroll
    for (int j = 0; j < 4; ++j) { v[j] = zr[64 * j]; s += (v[j].x + v[j].y) + (v[j].z + v[j].w); }
    const float mean = wave_sum(s) * (1.f / D); float s2 = 0.f;
#pragma unroll
    for (int j = 0; j < 4; ++j) { v[j] = v[j] - mean; s2 += (v[j].x * v[j].x + v[j].y * v[j].y) + (v[j].z * v[j].z + v[j].w * v[j].w); }
    const float rstd = rsqrtf(wave_sum(s2) * (1.f / D) + LN_EPS);
    float lg[32];
#pragma unroll
    for (int e = 0; e < 32; ++e) lg[e] = 0.f;
#pragma unroll
    for (int j = 0; j < 4; ++j) {
        const int c0 = 4 * lane + 256 * j;
        const f32x4 gg = *(const f32x4*)(ln1_g + c0), bb = *(const f32x4*)(ln1_b + c0);
        v[j] = v[j] * rstd * gg + bb;
        zr[64 * j] = v[j];
        u32x2 o; o.x = pk2(v[j].x, v[j].y); o.y = pk2(v[j].z, v[j].w);
        *((u32x2*)(HB + (size_t)tok * D + c0)) = o;
#pragma unroll
        for (int i = 0; i < 4; ++i) {
            const float hv = v[j][i];
            const f32x4* wr = (const f32x4*)(w_r + (size_t)(c0 + i) * 32);
#pragma unroll
            for (int e4 = 0; e4 < 8; ++e4) { const f32x4 ww = wr[e4]; lg[e4 * 4 + 0] += hv * ww.x; lg[e4 * 4 + 1] += hv * ww.y; lg[e4 * 4 + 2] += hv * ww.z; lg[e4 * 4 + 3] += hv * ww.w; }
        }
    }
#pragma unroll
    for (int e = 0; e < 32; ++e) lg[e] = wave_sum(lg[e]) + b_r[e];
    int bi[4]; float bv[4];
#pragma unroll
    for (int k = 0; k < 4; ++k) {
        float best = -INFINITY; int b = 0;
#pragma unroll
        for (int e = 0; e < 32; ++e) if (lg[e] > best) { best = lg[e]; b = e; }
#pragma unroll
        for (int e = 0; e < 32; ++e) if (e == b) lg[e] = -INFINITY;
        bi[k] = b; bv[k] = best;
    }
    float ex[4], es = 0.f;
#pragma unroll
    for (int k = 0; k < 4; ++k) { ex[k] = __expf(bv[k] - bv[0]); es += ex[k]; }
    if (lane == 0) {
#pragma unroll
        for (int k = 0; k < 4; ++k) {
            const unsigned pos = atomicAdd(&cnt[bi[k]], 1u);
            meta[MT_SEL_E + tok * 4 + k] = bi[k]; meta[MT_SEL_POS + tok * 4 + k] = (int)pos;
            ((float*)meta)[MT_SEL_G + tok * 4 + k] = ex[k] / es;
        }
    }
}

__global__ void k_dispatch1(const unsigned* cnt, int* meta) {
    __shared__ int ts[33];
    if (threadIdx.x == 0) { int acc = 0; for (int e = 0; e < 32; ++e) { ts[e] = acc; acc += ((int)cnt[e] + 255) >> 8; } ts[32] = acc; meta[MT_NT] = acc; }
    __syncthreads();
    if (threadIdx.x < 33) meta[MT_TSTART + threadIdx.x] = ts[threadIdx.x];
    for (int t = threadIdx.x; t < NT_MAX; t += blockDim.x) { int e = 0; for (int j = 1; j < 32; ++j) if (t >= ts[j]) e = j; meta[MT_TILE_E + t] = e; }
}
__global__ void k_rowinit(int* meta) {
    const int i = blockIdx.x * blockDim.x + threadIdx.x;
    if (i < NROWS_MAX) { meta[MT_ROW_TOK + i] = 0; ((float*)meta)[MT_ROW_GATE + i] = 0.f; }
}
__global__ void k_scatter(int* meta) {
    const int i = blockIdx.x * blockDim.x + threadIdx.x;
    if (i < T * 4) {
        const int e = meta[MT_SEL_E + i], row = meta[MT_TSTART + e] * 256 + meta[MT_SEL_POS + i];
        meta[MT_ROW_TOK + row] = i >> 2; ((float*)meta)[MT_ROW_GATE + row] = ((const float*)meta)[MT_SEL_G + i]; meta[MT_SLOT_ROW + i] = row;
    }
}

struct EpiGateUpN {
    const float* bg; const float* bu; bf16* HID;
    __device__ __forceinline__ void operator()(int row, int c, float a, float b) const {
        const float gt = fminf(a + bg[c], 7.0f), up = fminf(fmaxf(b + bu[c], -7.0f), 7.0f);
        const float hid = gt / (1.0f + __expf(-1.702f * gt)) * (up + 1.0f);
        HID[(size_t)row * DFF + c] = (bf16)f2bf(hid);
    }
};
__global__ void __launch_bounds__(256) k_gateup_naive(const bf16* HB, const int* meta, const float* w_gate, const float* b_gate, const float* w_up, const float* b_up, bf16* HID) {
    const int tile = blockIdx.x >> 2, sub = blockIdx.x & 3;
    if (tile >= meta[MT_NT]) return;
    const int e = meta[MT_TILE_E + tile];
    EpiGateUpN epi{b_gate + (size_t)e * DFF, b_up + (size_t)e * DFF, HID};
    naive_gemm_tile<2>(HB, D, meta + MT_ROW_TOK, tile * 256 + sub * 64, w_gate + (size_t)e * D * DFF, w_up + (size_t)e * D * DFF, DFF, blockIdx.y * 64, D, epi);
}
struct EpiDownN {
    const float* bd; const float* row_gate; bf16* Y;
    __device__ __forceinline__ void operator()(int row, int c, float a, float) const { Y[(size_t)row * D + c] = (bf16)f2bf((a + bd[c]) * row_gate[row]); }
};
__global__ void __launch_bounds__(256) k_down_naive(const bf16* HID, const int* meta, const float* w_down, const float* b_down, bf16* Y) {
    const int tile = blockIdx.x >> 2, sub = blockIdx.x & 3;
    if (tile >= meta[MT_NT]) return;
    const int e = meta[MT_TILE_E + tile];
    EpiDownN epi{b_down + (size_t)e * D, (const float*)meta + MT_ROW_GATE, Y};
    naive_gemm_tile<1>(HID, DFF, nullptr, tile * 256 + sub * 64, w_down + (size_t)e * DFF * D, nullptr, D, blockIdx.y * 64, DFF, epi);
}

__global__ void __launch_bounds__(256) k_final_naive(float* HO, const bf16* Y, const int* meta, const float* ln2_g, const float* ln2_b) {
    const int w = threadIdx.x >> 6, lane = threadIdx.x & 63;
    const int tok = blockIdx.x * 4 + w;
    f32x4* hr = (f32x4*)(HO + (size_t)tok * D) + lane;
    f32x4 v[4]; float s = 0.f;
#pragma unroll
    for (int j = 0; j < 4; ++j) v[j] = hr[64 * j] * ALPHA;
#pragma unroll
    for (int k = 0; k < 4; ++k) {
        const int row = meta[MT_SLOT_ROW + tok * 4 + k];
        const u32x2* yr = (const u32x2*)(Y + (size_t)row * D) + lane;
#pragma unroll
        for (int j = 0; j < 4; ++j) { const u32x2 y = yr[64 * j]; v[j].x += __uint_as_float(y.x << 16); v[j].y += __uint_as_float(y.x & 0xffff0000u); v[j].z += __uint_as_float(y.y << 16); v[j].w += __uint_as_float(y.y & 0xffff0000u); }
    }
#pragma unroll
    for (int j = 0; j < 4; ++j) s += (v[j].x + v[j].y) + (v[j].z + v[j].w);
    const float mean = wave_sum(s) * (1.f / D); float s2 = 0.f;
#pragma unroll
    for (int j = 0; j < 4; ++j) { v[j] = v[j] - mean; s2 += (v[j].x * v[j].x + v[j].y * v[j].y) + (v[j].z * v[j].z + v[j].w * v[j].w); }
    const float rstd = rsqrtf(wave_sum(s2) * (1.f / D) + LN_EPS);
#pragma unroll
    for (int j = 0; j < 4; ++j) { const int c0 = 4 * lane + 256 * j; const f32x4 gg = *(const f32x4*)(ln2_g + c0), bb = *(const f32x4*)(ln2_b + c0); hr[64 * j] = v[j] * rstd * gg + bb; }
}

#define LAS __attribute__((address_space(3)))
#define GAS __attribute__((address_space(1)))
typedef short bf16x8 __attribute__((ext_vector_type(8)));
typedef float f32x16 __attribute__((ext_vector_type(16)));
typedef float f32x2 __attribute__((ext_vector_type(2)));
__device__ __forceinline__ unsigned cvt_pk_bf16(float lo, float hi) { unsigned r; asm volatile("v_cvt_pk_bf16_f32 %0, %1, %2" : "=v"(r) : "v"(lo), "v"(hi)); return r; }
__device__ __forceinline__ float fast_gelu(float x) {
    const float u = -2.0f * 0.7978845608028654f * LOG2E * (x + 0.044715f * x * x * x);
    return x * __builtin_amdgcn_rcpf(1.0f + __builtin_amdgcn_exp2f(u));
}
namespace pg8 {
constexpr int BM = 256, BK = 64, HALF = 128, HTB = HALF * BK * 2  , STAGE_BYTES = 8 * HTB, NXCD = 8, WGM = 8;
__host__ __device__ __forceinline__ int lds_byte(int r, int c) { const int st = (r >> 4) * 2 + (c >> 5), rr = r & 15, cc = c & 31, ob = rr * 64 + cc * 2; return st * 1024 + (ob ^ (((ob >> 9) & 1) << 5)); }
__host__ __device__ __forceinline__ void stage_rc(int b, int& R, int& C) { const int st = b / 1024, sb = b % 1024, swz = sb ^ (((sb >> 9) & 1) << 5); R = (st >> 1) * 16 + swz / 64; C = (st & 1) * 32 + (swz % 64) / 2; }
__host__ __device__ __forceinline__ int perm32(int rho) { const int n = rho >> 4, i = rho & 15; return 8 * (i >> 2) + 4 * n + (i & 3); }

struct Unit { int pm, pn; };
struct Gemm { const void* A; const void* Bt; int KB; const int* tile_e; unsigned e_stride; };
typedef int i32x4 __attribute__((ext_vector_type(4)));

struct StaticOrder {
    int nM, nN, nwg, G, c;
    __device__ void init(int nM_, int nN_, int G_, int c_) { nM = nM_; nN = nN_; nwg = nM * nN; G = G_; c = c_; }
    __device__ bool next(int i, Unit& u) const {
        const long L = (long)i * G + c; if (L >= nwg) return false;
        int wgid = (int)L; { const int q = nwg / NXCD, r = nwg % NXCD, xcd = wgid % NXCD, off = wgid / NXCD; wgid = (xcd < r ? xcd * (q + 1) : r * (q + 1) + (xcd - r) * q) + off; }
        const int nig = WGM * nN, gid = wgid / nig, fm = gid * WGM, gsz = (nM - fm) < WGM ? (nM - fm) : WGM;
        u.pm = fm + ((wgid % nig) % gsz); u.pn = (wgid % nig) / gsz; return true;
    }
};

template <class Epi, bool GATHER, bool ALIGN_EPI, bool I8>
__device__ __forceinline__ void gemm_phase(LAS unsigned char* lds, const LAS int* rtab, const Gemm g, const StaticOrder& S, const Epi& E) {
    const int tid = threadIdx.x, wid = __builtin_amdgcn_readfirstlane(tid >> 6), lane = tid & 63, wr = wid >> 2, wc = wid & 3, fr = lane & 15, fq = lane >> 4;
    const int KB = g.KB, nt = KB / (BK * 2);
    int Rs[2], Cs[2]; unsigned voffB[2];
#pragma unroll
    for (int i = 0; i < 2; ++i) { int R, C; stage_rc(tid * 16 + i * 8192, R, C); const int Rb = Epi::PERM ? ((R & ~31) + perm32(R & 31)) : R; Rs[i] = R; Cs[i] = C; voffB[i] = (unsigned)(Rb * KB + C * 2); }
    const size_t kstep = (size_t)(BK * 2);
    const size_t hstep = (size_t)HALF * KB;
    const size_t tstep = 2 * hstep;
    const unsigned ldsw = (unsigned)wid * 1024u;
    const int aoff = lds_byte(wr * 64 + fr, fq * 8), boff = lds_byte(wc * 32 + fr, fq * 8);
#define PG8_SA(b, h) (((b) * 2 + (h)) * HTB)
#define PG8_SB(b, h) ((4 + (b) * 2 + (h)) * HTB)
#define PG8_STAGE(bufoff, gbase, voff) do { _Pragma("unroll") for (int _i = 0; _i < 2; ++_i) \
        __builtin_amdgcn_global_load_lds((const unsigned*)((const char*)(gbase) + (voff)[_i]), (LAS unsigned*)(lds + (bufoff) + ldsw + _i * 8192), 16, 0, 0); } while (0)
#define PG8_LDA(dst, b, h) do { _Pragma("unroll") for (int m = 0; m < 4; ++m) _Pragma("unroll") for (int k = 0; k < 2; ++k) dst[m][k] = *(const LAS bf16x8*)(lds + PG8_SA(b, h) + aoff + m * 2048 + k * 1024); } while (0)
#define PG8_LDB(dst, b, h) do { _Pragma("unroll") for (int n = 0; n < 2; ++n) _Pragma("unroll") for (int k = 0; k < 2; ++k) dst[n][k] = *(const LAS bf16x8*)(lds + PG8_SB(b, h) + boff + n * 2048 + k * 1024); } while (0)
#define PG8_MMA(ai, bj, At, Bt) do { __builtin_amdgcn_s_setprio(1); _Pragma("unroll") for (int m = 0; m < 4; ++m) _Pragma("unroll") for (int n = 0; n < 2; ++n) _Pragma("unroll") for (int k = 0; k < 2; ++k) \
        { if constexpr (I8) acc[ai][bj][m][n] = __builtin_bit_cast(f32x4, __builtin_amdgcn_mfma_i32_16x16x64_i8(__builtin_bit_cast(i32x4, Bt[n][k]), __builtin_bit_cast(i32x4, At[m][k]), __builtin_bit_cast(i32x4, acc[ai][bj][m][n]), 0, 0, 0)); \
          else acc[ai][bj][m][n] = __builtin_amdgcn_mfma_f32_16x16x32_bf16(Bt[n][k], At[m][k], acc[ai][bj][m][n], 0, 0, 0); } __builtin_amdgcn_s_setprio(0); } while (0)
#define PG8_WAIT_V(n) asm volatile("s_waitcnt vmcnt(" #n ")" ::: "memory")
#define PG8_WAIT_L(n) asm volatile("s_waitcnt lgkmcnt(" #n ")" ::: "memory")
#define PG8_BAR __builtin_amdgcn_s_barrier()
#define PG8_SCHED __builtin_amdgcn_sched_barrier(0)
#define PG8_VOFFA(vo, ui_, u_) do { _Pragma("unroll") for (int h_ = 0; h_ < 2; ++h_) _Pragma("unroll") for (int i_ = 0; i_ < 2; ++i_) { \
        const int row_ = GATHER ? rtab[(ui_) * 256 + h_ * 128 + Rs[i_]] : ((u_).pm * 256 + h_ * 128 + Rs[i_]); \
        vo[h_][i_] = (unsigned)(row_ * KB + Cs[i_] * 2); } } while (0)
#define PG8_BBASE(u_) ((const char*)g.Bt + (g.tile_e ? (size_t)g.tile_e[(u_).pm] * g.e_stride : (size_t)0) + (size_t)(u_).pn * tstep)
    Unit cur, nxt; int ui = 0;
    if (!S.next(0, cur)) return;
    f32x4 acc[2][2][4][2];
#pragma unroll
    for (int a = 0; a < 2; ++a)
#pragma unroll
        for (int b = 0; b < 2; ++b)
#pragma unroll
            for (int m = 0; m < 4; ++m)
#pragma unroll
                for (int n = 0; n < 2; ++n) acc[a][b][m][n] = (f32x4){0.f, 0.f, 0.f, 0.f};
    bf16x8 At[4][2], B0[2][2], B1[2][2];
    unsigned vAc[2][2], vAn[2][2];
    PG8_VOFFA(vAc, 0, cur);
    const char* const gA = (const char*)g.A;
    const char* cB = PG8_BBASE(cur);
    PG8_STAGE(PG8_SB(0, 0), cB, voffB); PG8_STAGE(PG8_SB(0, 1), cB + hstep, voffB); PG8_STAGE(PG8_SA(0, 0), gA, vAc[0]); PG8_STAGE(PG8_SA(0, 1), gA, vAc[1]);
    if (wr == 1) PG8_BAR;
    PG8_WAIT_V(2); PG8_BAR;
    PG8_STAGE(PG8_SB(1, 0), cB + kstep, voffB); PG8_STAGE(PG8_SA(1, 0), gA + kstep, vAc[0]); PG8_STAGE(PG8_SB(1, 1), cB + hstep + kstep, voffB);
    PG8_WAIT_V(6); PG8_BAR;
    for (;;) {
        const bool has_next = S.next(ui + 1, nxt);
        const char* nB = cB;
        if (has_next) { nB = PG8_BBASE(nxt); PG8_VOFFA(vAn, ui + 1, nxt); }
        else {
#pragma unroll
            for (int h = 0; h < 2; ++h)
#pragma unroll
                for (int i = 0; i < 2; ++i) vAn[h][i] = vAc[h][i];
        }
        for (int t = 0; t < nt; t += 2) {
            const bool last = (t == nt - 2);
            const char* a1 = gA + (size_t)(t + 1) * kstep;
            const char* a2 = last ? gA : gA + (size_t)(t + 2) * kstep; const char* b2 = last ? nB : cB + (size_t)(t + 2) * kstep;
            const char* a3 = a2 + kstep; const char* b3 = b2 + kstep;
            unsigned v2[2][2];
#pragma unroll
            for (int h = 0; h < 2; ++h)
#pragma unroll
                for (int i = 0; i < 2; ++i) v2[h][i] = last ? vAn[h][i] : vAc[h][i];
            PG8_LDB(B0, 0, 0); PG8_LDB(B1, 0, 1); PG8_SCHED; PG8_LDA(At, 0, 0); PG8_STAGE(PG8_SA(1, 1), a1, vAc[1]);
            PG8_WAIT_V(8); PG8_WAIT_L(0); PG8_BAR; PG8_MMA(0, 0, At, B0); PG8_MMA(0, 1, At, B1); PG8_BAR; PG8_SCHED;
            PG8_LDA(At, 0, 1); PG8_STAGE(PG8_SB(0, 0), b2, voffB); PG8_STAGE(PG8_SB(0, 1), b2 + hstep, voffB); PG8_STAGE(PG8_SA(0, 0), a2, v2[0]);
            PG8_WAIT_V(8); PG8_WAIT_L(0); PG8_BAR; PG8_MMA(1, 0, At, B0); PG8_MMA(1, 1, At, B1); PG8_BAR; PG8_SCHED;
            PG8_LDB(B0, 1, 0); PG8_LDB(B1, 1, 1); PG8_SCHED; PG8_LDA(At, 1, 0); PG8_STAGE(PG8_SA(0, 1), a2, v2[1]);
            PG8_WAIT_V(8); PG8_WAIT_L(0); PG8_BAR; PG8_MMA(0, 0, At, B0); PG8_MMA(0, 1, At, B1); PG8_BAR; PG8_SCHED;
            PG8_LDA(At, 1, 1); PG8_STAGE(PG8_SB(1, 0), b3, voffB); PG8_STAGE(PG8_SB(1, 1), b3 + hstep, voffB); PG8_STAGE(PG8_SA(1, 0), a3, v2[0]);
            PG8_WAIT_V(8); PG8_WAIT_L(0); PG8_BAR; PG8_MMA(1, 0, At, B0); PG8_MMA(1, 1, At, B1); PG8_BAR; PG8_SCHED;
        }
        if constexpr (ALIGN_EPI) { if (wr == 0) PG8_BAR; }
        E(acc, cur, wr, wc, fr, fq);
        if (!has_next) break;
#pragma unroll
        for (int a = 0; a < 2; ++a)
#pragma unroll
            for (int b = 0; b < 2; ++b)
#pragma unroll
                for (int m = 0; m < 4; ++m)
#pragma unroll
                    for (int n = 0; n < 2; ++n) acc[a][b][m][n] = (f32x4){0.f, 0.f, 0.f, 0.f};
        cur = nxt; cB = nB; ++ui;
#pragma unroll
        for (int h = 0; h < 2; ++h)
#pragma unroll
            for (int i = 0; i < 2; ++i) vAc[h][i] = vAn[h][i];
        if constexpr (ALIGN_EPI) { if (wr == 1) PG8_BAR; }
    }
    PG8_WAIT_V(0);
    if constexpr (!ALIGN_EPI) { if (wr == 0) PG8_BAR; }
    PG8_BAR;
#undef PG8_SA
#undef PG8_SB
#undef PG8_STAGE
#undef PG8_LDA
#undef PG8_LDB
#undef PG8_MMA
#undef PG8_WAIT_V
#undef PG8_WAIT_L
#undef PG8_BAR
#undef PG8_SCHED
#undef PG8_VOFFA
#undef PG8_BBASE
}

struct EpiInProj {
    static constexpr bool PERM = true;
    const float* b_in; bf16 *QB, *KB, *VT, *UB, *GB;
    __device__ __forceinline__ void operator()(const f32x4 (&acc)[2][2][4][2], const Unit& u, int wr, int wc, int fr, int fq) const {
        const int row0 = u.pm * BM + wr * 64 + fr;
#pragma unroll
        for (int bj = 0; bj < 2; ++bj) {
            const int reg = u.pn * BM + bj * HALF;
            const int c0 = reg + wc * 32 + 8 * fq;
            const f32x4 bv0 = *(const f32x4*)(b_in + c0), bv1 = *(const f32x4*)(b_in + c0 + 4);
#pragma unroll
            for (int ai = 0; ai < 2; ++ai)
#pragma unroll
                for (int m = 0; m < 4; ++m) {
                    const int row = row0 + ai * HALF + m * 16;
                    f32x4 v0 = acc[ai][bj][m][0] + bv0, v1 = acc[ai][bj][m][1] + bv1;
                    if (reg >= 640 && reg < 768) {
                        const int cv = c0 - 640, gg = cv >> 6, d = cv & 63, b = row / SEQ, s = row % SEQ;
                        bf16* vp = VT + ((size_t)((b * 2 + gg) * 64 + d)) * SEQ + s;
#pragma unroll
                        for (int j = 0; j < 4; ++j) { vp[(size_t)j * SEQ] = (bf16)f2bf(v0[j]); vp[(size_t)(j + 4) * SEQ] = (bf16)f2bf(v1[j]); }
                    } else {
                        bf16* dst;
                        if (reg < 512) { v0 = v0 * C2; v1 = v1 * C2; dst = QB + (size_t)row * 512 + c0; }
                        else if (reg < 640) { dst = KB + (size_t)row * 128 + (c0 - 512); }
                        else {
#pragma unroll
                            for (int j = 0; j < 4; ++j) { v0[j] = fast_gelu(v0[j]); v1[j] = fast_gelu(v1[j]); }
                            dst = (reg < 1280) ? (UB + (size_t)row * 512 + (c0 - 768)) : (GB + (size_t)row * 512 + (c0 - 1280));
                        }
                        u32x4 w; w.x = cvt_pk_bf16(v0[0], v0[1]); w.y = cvt_pk_bf16(v0[2], v0[3]); w.z = cvt_pk_bf16(v1[0], v1[1]); w.w = cvt_pk_bf16(v1[2], v1[3]);
                        *(u32x4*)dst = w;
                    }
                }
        }
    }
};
struct EpiOutProj {
    static constexpr bool PERM = false;
    const float* x; const float* b_out; float* Z;
    __device__ __forceinline__ void operator()(const f32x4 (&acc)[2][2][4][2], const Unit& u, int wr, int wc, int fr, int fq) const {
        const int col0 = u.pn * BM + wc * 32 + 4 * fq;
#pragma unroll
        for (int ai = 0; ai < 2; ++ai)
#pragma unroll
            for (int m = 0; m < 4; ++m) {
                const size_t off = (size_t)(u.pm * BM + ai * HALF + wr * 64 + m * 16 + fr) * D + col0;
#pragma unroll
                for (int bj = 0; bj < 2; ++bj)
#pragma unroll
                    for (int n = 0; n < 2; ++n) {
                        const f32x4 xv = *(const f32x4*)(x + off + bj * HALF + n * 16), bv = *(const f32x4*)(b_out + col0 + bj * HALF + n * 16);
                        *(f32x4*)(Z + off + bj * HALF + n * 16) = xv * ALPHA + acc[ai][bj][m][n] + bv;
                    }
            }
    }
};
struct EpiSwiglu {
    static constexpr bool PERM = true;
    const int* tile_e; const float* b_gate; const float* b_up; const float* swgu; const float* row_sa; bf16* HID;
    __device__ __forceinline__ void operator()(const f32x4 (&acc)[2][2][4][2], const Unit& u, int wr, int wc, int fr, int fq) const {
        const int e = tile_e[u.pm];
        const int fc0 = u.pn * HALF + wc * 32 + 8 * fq;
        const f32x4 g0 = *(const f32x4*)(b_gate + e * DFF + fc0), g1 = *(const f32x4*)(b_gate + e * DFF + fc0 + 4);
        const f32x4 u0 = *(const f32x4*)(b_up + e * DFF + fc0), u1 = *(const f32x4*)(b_up + e * DFF + fc0 + 4);
        const float* sw = swgu + e * 2048 + u.pn * 256 + wc * 32 + 8 * fq;
        const f32x4 sg0 = *(const f32x4*)(sw), sg1 = *(const f32x4*)(sw + 4), su0 = *(const f32x4*)(sw + 128), su1 = *(const f32x4*)(sw + 132);
#pragma unroll
        for (int ai = 0; ai < 2; ++ai)
#pragma unroll
            for (int m = 0; m < 4; ++m) {
                const int row = u.pm * BM + ai * HALF + wr * 64 + m * 16 + fr;
                const float sa = row_sa[row];
                float hv[8];
#pragma unroll
                for (int j = 0; j < 8; ++j) {
                    const float gi = (float)__float_as_int(j < 4 ? acc[ai][0][m][0][j & 3] : acc[ai][0][m][1][j & 3]);
                    const float ui = (float)__float_as_int(j < 4 ? acc[ai][1][m][0][j & 3] : acc[ai][1][m][1][j & 3]);
                    const float ga = gi * (sa * (j < 4 ? sg0[j & 3] : sg1[j & 3])) + (j < 4 ? g0[j & 3] : g1[j & 3]);
                    const float ua = ui * (sa * (j < 4 ? su0[j & 3] : su1[j & 3])) + (j < 4 ? u0[j & 3] : u1[j & 3]);
                    const float gt = fminf(ga, 7.0f), up = fminf(fmaxf(ua, -7.0f), 7.0f);
                    hv[j] = gt * __builtin_amdgcn_rcpf(1.0f + __builtin_amdgcn_exp2f(-1.702f * LOG2E * gt)) * (up + 1.0f);
                }
                u32x4 w; w.x = cvt_pk_bf16(hv[0], hv[1]); w.y = cvt_pk_bf16(hv[2], hv[3]); w.z = cvt_pk_bf16(hv[4], hv[5]); w.w = cvt_pk_bf16(hv[6], hv[7]);
                *(u32x4*)(HID + (size_t)row * DFF + fc0) = w;
            }
    }
};
struct EpiDown {
    static constexpr bool PERM = true;
    const int* tile_e; const float* b_down; const float* swd; const float* row_sb; const float* row_gate; bf16* Y;
    __device__ __forceinline__ void operator()(const f32x4 (&acc)[2][2][4][2], const Unit& u, int wr, int wc, int fr, int fq) const {
        const int e = tile_e[u.pm];
#pragma unroll
        for (int bj = 0; bj < 2; ++bj) {
            const int c0 = u.pn * BM + bj * HALF + wc * 32 + 8 * fq;
            const f32x4 bv0 = *(const f32x4*)(b_down + e * D + c0), bv1 = *(const f32x4*)(b_down + e * D + c0 + 4);
            const f32x4 sw0 = *(const f32x4*)(swd + e * D + c0), sw1 = *(const f32x4*)(swd + e * D + c0 + 4);
#pragma unroll
            for (int ai = 0; ai < 2; ++ai)
#pragma unroll
                for (int m = 0; m < 4; ++m) {
                    const int row = u.pm * BM + ai * HALF + wr * 64 + m * 16 + fr;
                    const float gt = row_gate[row], sb = row_sb[row];
                    f32x4 v0, v1;
#pragma unroll
                    for (int j = 0; j < 4; ++j) { v0[j] = ((float)__float_as_int(acc[ai][bj][m][0][j]) * (sb * sw0[j]) + bv0[j]) * gt; v1[j] = ((float)__float_as_int(acc[ai][bj][m][1][j]) * (sb * sw1[j]) + bv1[j]) * gt; }
                    u32x4 w; w.x = cvt_pk_bf16(v0[0], v0[1]); w.y = cvt_pk_bf16(v0[2], v0[3]); w.z = cvt_pk_bf16(v1[0], v1[1]); w.w = cvt_pk_bf16(v1[2], v1[3]);
                    *(u32x4*)(Y + (size_t)row * D + c0) = w;
                }
        }
    }
};
}
constexpr int NWAVES = 8;
constexpr int NPHASES = 10;
constexpr size_t WS_WIN = WS_HID + 144 * MiB;
constexpr size_t WS_WOUT = WS_WIN + 4 * MiB;
constexpr size_t WS_WGU = WS_WOUT + 2 * MiB;
constexpr size_t WS_SWGU = WS_WGU + 64 * MiB;
constexpr size_t WS_WD = WS_SWGU + 1 * MiB;
constexpr size_t WS_SWD = WS_WD + 32 * MiB;
constexpr size_t WS_HID8 = WS_SWD + 1 * MiB;
constexpr size_t WS_END = WS_HID8 + 72 * MiB;
constexpr int CW_BAR = 4096;
constexpr int RING_BYTES = 131072;
constexpr int RTAB_OFF = RING_BYTES;
constexpr int RTAB_UNITS = 12;
constexpr int RW_BYTES = 1024 * 144;
constexpr int RSCR_OFF = RW_BYTES;
constexpr int LDS_BYTES = 163840;
constexpr int MISC_OFF = LDS_BYTES - 256;
static_assert(RTAB_OFF + RTAB_UNITS * 1024 <= MISC_OFF && RSCR_OFF + 4096 <= MISC_OFF, "LDS map");

typedef GAS unsigned gu32;
#define RLX_AGENT __ATOMIC_RELAXED, __HIP_MEMORY_SCOPE_AGENT
#define LDS_WAIT() asm volatile("s_waitcnt lgkmcnt(0)" ::: "memory")
#define VM_WAIT() asm volatile("s_waitcnt vmcnt(0)" ::: "memory")

#define XB_TMO      128
#define XB_XCNT(j)  (256  + 64 * (j))
#define XB_XSUB(j)  (1280 + 64 * (j))
#define XB_XGEN(j)  (2304 + 64 * (j))
#define XB_TOP      3328
#define XB_TOPGEN   3392
#define XCD_BAR_WORDS 3456
#define XB_SPIN_CAP (1u << 18)
__device__ __forceinline__ unsigned xb_ld(unsigned* p)              { return __hip_atomic_load(p, __ATOMIC_RELAXED, __HIP_MEMORY_SCOPE_AGENT); }
__device__ __forceinline__ unsigned xb_add(unsigned* p, unsigned v) { return __hip_atomic_fetch_add(p, v, __ATOMIC_RELAXED, __HIP_MEMORY_SCOPE_AGENT); }
__device__ __forceinline__ unsigned xb_xcc_id() { return (unsigned)__builtin_amdgcn_s_getreg((3 << 11) | 20) & 0xFu; }
#define XB_SPIN(cond, bar) do { unsigned _sp = 0; while (cond) { __builtin_amdgcn_s_sleep(1); \
    if ((++_sp & 255u) == 0u) { if (xb_ld(&(bar)[XB_TMO])) break; if (_sp > XB_SPIN_CAP) { atomicAdd(&(bar)[XB_TMO], 1u); break; } } } } while (0)
struct XcdBarrier { unsigned* bar; unsigned x; volatile LAS unsigned* st; };
__device__ __forceinline__ XcdBarrier xcd_barrier_post(unsigned* bar, volatile LAS unsigned* st) {
    XcdBarrier b; b.bar = bar; b.x = xb_xcc_id(); b.st = st;
    if (threadIdx.x == 0) (void)xb_add(&bar[XB_XCNT(b.x)], 1u);
    return b;
}
__device__ __forceinline__ void xcd_barrier_complete(unsigned* bar, unsigned x, unsigned& nloc, unsigned& nx) {
    const unsigned G = gridDim.x * gridDim.y * gridDim.z;
    unsigned sum, cnt, mine, sp = 0u;
    for (;;) {
        sum = 0u; cnt = 0u; mine = 0u;
#pragma unroll
        for (unsigned j = 0; j < 16; ++j) { const unsigned c = xb_ld(&bar[XB_XCNT(j)]); sum += c; cnt += (c > 0u) ? 1u : 0u; mine = (j == x) ? c : mine; }
        if (sum == G) break;
        __builtin_amdgcn_s_sleep(1);
        if ((++sp & 255u) == 0u) { if (xb_ld(&bar[XB_TMO])) break; if (sp > XB_SPIN_CAP) { atomicAdd(&bar[XB_TMO], 1u); break; } }
    }
    nloc = mine > 0u ? mine : 1u; nx = cnt > 0u ? cnt : 1u;
}
__device__ __forceinline__ void xcd_barrier(const XcdBarrier& b) {
    asm volatile("s_waitcnt vmcnt(0)" ::: "memory");
    __syncthreads();
    if (threadIdx.x == 0) {
        unsigned* bar = b.bar;
        __builtin_amdgcn_s_waitcnt(0);
        unsigned nloc = b.st[0], nx = b.st[1];
        if (nloc == 0u) { xcd_barrier_complete(bar, b.x, nloc, nx); b.st[0] = nloc; b.st[1] = nx; }
        const unsigned old = xb_add(&bar[XB_XSUB(b.x)], 1u);
        const unsigned gen = old / nloc;
        if (old + 1u == (gen + 1u) * nloc) {
            __builtin_amdgcn_fence(__ATOMIC_RELEASE, "agent");
            asm volatile("s_waitcnt vmcnt(0)" ::: "memory");
            const unsigned og = xb_add(&bar[XB_TOP], 1u);
            const unsigned tg = og / nx;
            if (og + 1u == (tg + 1u) * nx) xb_add(&bar[XB_TOPGEN], 1u);
            else XB_SPIN(xb_ld(&bar[XB_TOPGEN]) == tg, bar);
            __builtin_amdgcn_fence(__ATOMIC_ACQUIRE, "agent");
            xb_add(&bar[XB_XGEN(b.x)], 1u);
            asm volatile("s_waitcnt vmcnt(0)" ::: "memory");
        } else {
            XB_SPIN(xb_ld(&bar[XB_XGEN(b.x)]) == gen, bar);
            __builtin_amdgcn_fence(__ATOMIC_ACQUIRE, "agent");
            asm volatile("s_waitcnt vmcnt(0)" ::: "memory");
        }
    }
    __syncthreads();
}

struct Args {
    const float* in[22]; float* out; unsigned char* ws; int ph_lo, ph_hi, li, pad;
};
struct Frame {
    LAS unsigned char* lds;
    int tid, lane, wave, vcu, G;
};
__device__ __forceinline__ void p0_item(const float* W, int N, bf16* WT, int K, int dst_row0, int k0, int n0, LAS float* scr, int lane) {
    f32x4 v[8];
#pragma unroll
    for (int i = 0; i < 8; ++i) v[i] = *(const f32x4*)(W + (size_t)(k0 + (lane >> 3) + 8 * i) * N + n0 + 4 * (lane & 7));
#pragma unroll
    for (int i = 0; i < 8; ++i) { LAS float* s = scr + ((lane >> 3) + 8 * i) * 33 + 4 * (lane & 7); s[0] = v[i].x; s[1] = v[i].y; s[2] = v[i].z; s[3] = v[i].w; }
    LDS_WAIT(); asm volatile("" ::: "memory");
    const int c = lane & 7;
#pragma unroll
    for (int j = 0; j < 4; ++j) { const int n = (lane >> 3) + 8 * j; const LAS float* s = scr + (8 * c) * 33 + n;
        u32x4 o; o.x = pk2(s[0 * 33], s[1 * 33]); o.y = pk2(s[2 * 33], s[3 * 33]); o.z = pk2(s[4 * 33], s[5 * 33]); o.w = pk2(s[6 * 33], s[7 * 33]);
        *(u32x4*)(WT + (size_t)(dst_row0 + n) * K + k0 + 8 * c) = o; }
    LDS_WAIT(); asm volatile("" ::: "memory");
}
struct ConvItem { const float* W; signed char* dst; float* sc; int n0, dst_row0; };
__device__ __forceinline__ ConvItem conv_decode(const Args& a, int it) {
    unsigned char* ws = a.ws;
    const int nb = it & 31, e = (it >> 5) & 31, kind = it >> 10, n0 = nb * 32;
    ConvItem c;
    c.W = (kind == 0 ? a.in[14] : kind == 1 ? a.in[16] : a.in[18]) + (size_t)e * D * DFF;
    c.dst = kind < 2 ? (signed char*)(ws + WS_WGU) + (size_t)e * 2048 * 1024 : (signed char*)(ws + WS_WD) + (size_t)e * 1024 * 1024;
    c.dst_row0 = kind < 2 ? (n0 >> 7) * 256 + kind * 128 + (n0 & 127) : n0;
    c.sc = kind < 2 ? (float*)(ws + WS_SWGU) + e * 2048 : (float*)(ws + WS_SWD) + e * 1024;
    c.n0 = n0; return c;
}
#define CONV_LOAD(v, ci) do { _Pragma("unroll") for (int i_ = 0; i_ < 4; ++i_) _Pragma("unroll") for (int j_ = 0; j_ < 4; ++j_) \
        v[i_][j_] = *(const f32x4*)((ci).W + (size_t)(4 * (kl + 64 * i_) + j_) * DFF + (ci).n0 + 4 * n4); } while (0)
__device__ __forceinline__ void conv_items(const Frame& F, const Args& a, int it_lo, int it_hi) {
    if (it_hi > 3 * NEXP * 32) it_hi = 3 * NEXP * 32;
    if (it_lo >= it_hi) return;
    const int tid = F.tid, n4 = tid & 7, kl = tid >> 3;
    LAS unsigned* tile = (LAS unsigned*)F.lds;
    LAS float* red = (LAS float*)(F.lds + 36864);
    f32x4 v[4][4];
    ConvItem cur = conv_decode(a, it_lo);
    CONV_LOAD(v, cur);
    for (int it = it_lo; it < it_hi; ++it) {
        f32x4 am = (f32x4){0.f, 0.f, 0.f, 0.f};
#pragma unroll
        for (int i = 0; i < 4; ++i)
#pragma unroll
            for (int j = 0; j < 4; ++j) { am.x = fmaxf(am.x, fabsf(v[i][j].x)); am.y = fmaxf(am.y, fabsf(v[i][j].y)); am.z = fmaxf(am.z, fabsf(v[i][j].z)); am.w = fmaxf(am.w, fabsf(v[i][j].w)); }
#pragma unroll
        for (int o = 8; o < 64; o <<= 1) { am.x = fmaxf(am.x, __shfl_xor(am.x, o)); am.y = fmaxf(am.y, __shfl_xor(am.y, o)); am.z = fmaxf(am.z, __shfl_xor(am.z, o)); am.w = fmaxf(am.w, __shfl_xor(am.w, o)); }
        if (F.lane < 8) *(LAS f32x4*)(red + F.wave * 32 + 4 * n4) = am;
        __syncthreads();
        f32x4 cm = *(const LAS f32x4*)(red + 4 * n4);
#pragma unroll
        for (int w = 1; w < 8; ++w) { const f32x4 o = *(const LAS f32x4*)(red + w * 32 + 4 * n4); cm.x = fmaxf(cm.x, o.x); cm.y = fmaxf(cm.y, o.y); cm.z = fmaxf(cm.z, o.z); cm.w = fmaxf(cm.w, o.w); }
        f32x4 inv;
#pragma unroll
        for (int c = 0; c < 4; ++c) inv[c] = cm[c] > 0.f ? 127.0f / cm[c] : 0.f;
        if (kl == 0) {
#pragma unroll
            for (int c = 0; c < 4; ++c) cur.sc[cur.dst_row0 + 4 * n4 + c] = cm[c] * (1.0f / 127.0f);
        }
#pragma unroll
        for (int i = 0; i < 4; ++i)
#pragma unroll
            for (int c = 0; c < 4; ++c) {
                unsigned d = 0u;
#pragma unroll
                for (int j = 0; j < 4; ++j) { const int q = (int)rintf(v[i][j][c] * inv[c]); d |= ((unsigned)q & 0xffu) << (8 * j); }
                tile[(4 * n4 + c) * 260 + kl + 64 * i] = d;
            }
        const ConvItem done = cur;
        if (it + 1 < it_hi) { cur = conv_decode(a, it + 1); CONV_LOAD(v, cur); }
        __syncthreads();
#pragma unroll
        for (int j = 0; j < 4; ++j) { const int ch = tid + 512 * j, n = ch >> 6, c16 = ch & 63;
            *(u32x4*)(done.dst + (size_t)(done.dst_row0 + n) * 1024 + 16 * c16) = *(const LAS u32x4*)(tile + n * 260 + 4 * c16); }
        __syncthreads();
    }
}
__device__ __forceinline__ void p0_prologue(const Frame& F, const Args& a) {
    unsigned char* ws = a.ws;
    bf16* Win_t = (bf16*)(ws + WS_WIN); bf16* Wout_t = (bf16*)(ws + WS_WOUT);
    LAS float* scr = (LAS float*)(F.lds + F.wave * 8448);
    const int gw = F.vcu * NWAVES + F.wave, NGW = F.G * NWAVES;
    constexpr int I_IN = 16 * 56, I_OUT = 16 * 32, NITEMS = I_IN + I_OUT;
    for (int it = gw; it < NITEMS; it += NGW) {
        int r = it;
        if (r < I_IN) { const int kb = r / 56, nb = r % 56; p0_item(a.in[1], INW, Win_t, D, nb * 32, kb * 64, nb * 32, scr, F.lane); continue; } r -= I_IN;
        { const int kb = r / 32, nb = r % 32; p0_item(a.in[8], D, Wout_t, D, nb * 32, kb * 64, nb * 32, scr, F.lane); }
    }
    const float* x = a.in[0]; bf16* XB = (bf16*)(ws + WS_XB);
    for (int m = gw; m < T; m += NGW) {
        const f32x4* xr = (const f32x4*)(x + (size_t)m * D) + F.lane; u32x2* o = (u32x2*)(XB + (size_t)m * D) + F.lane;
        f32x4 v[4];
#pragma unroll
        for (int j = 0; j < 4; ++j) v[j] = xr[64 * j];
#pragma unroll
        for (int j = 0; j < 4; ++j) { u32x2 w; w.x = pk2(v[j].x, v[j].y); w.y = pk2(v[j].z, v[j].w); o[64 * j] = w; }
    }
}

__device__ __forceinline__ int crow(int r, int hi) { return (r & 3) + 8 * (r >> 2) + 4 * hi; }
__device__ __forceinline__ void attn_wave_unit(const bf16* QB, const bf16* KB, const bf16* VT, const float* sinks, bf16* CAT, int q32, int h, int lane) {
    const int r32 = lane & 31, hi = lane >> 5;
    const int tok0 = q32 * 32, b = tok0 / SEQ, t0 = tok0 % SEQ, g = h >> 2;
    bf16x8 qf[4];
#pragma unroll
    for (int d0 = 0; d0 < 4; ++d0) qf[d0] = *(const bf16x8*)(QB + (size_t)(tok0 + r32) * 512 + h * 64 + d0 * 16 + hi * 8);
    f32x16 p[5];
    const float NEG = -INFINITY;
#pragma unroll
    for (int j = 0; j < 5; ++j) {
        const int kb = t0 - 128 + 32 * j;
        f32x16 s;
#pragma unroll
        for (int r = 0; r < 16; ++r) s[r] = 0.f;
        if (kb >= 0) {
            const bf16* kr = KB + (size_t)(b * SEQ + kb + r32) * 128 + g * 64 + hi * 8;
            bf16x8 kf[4];
#pragma unroll
            for (int d0 = 0; d0 < 4; ++d0) kf[d0] = *(const bf16x8*)(kr + d0 * 16);
#pragma unroll
            for (int d0 = 0; d0 < 4; ++d0) s = __builtin_amdgcn_mfma_f32_32x32x16_bf16(kf[d0], qf[d0], s, 0, 0, 0);
            if (j == 0) {
#pragma unroll
                for (int r = 0; r < 16; ++r) if (!(crow(r, hi) > r32)) s[r] = NEG;
            }
            if (j == 4) {
#pragma unroll
                for (int r = 0; r < 16; ++r) if (!(crow(r, hi) <= r32)) s[r] = NEG;
            }
        } else {
#pragma unroll
            for (int r = 0; r < 16; ++r) s[r] = NEG;
        }
        p[j] = s;
    }
    const float sk = sinks[h] * LOG2E;
    float m = sk;
#pragma unroll
    for (int j = 0; j < 5; ++j)
#pragma unroll
        for (int r = 0; r < 16; ++r) m = fmaxf(m, p[j][r]);
    m = fmaxf(m, __shfl_xor(m, 32));
    float l = 0.f;
#pragma unroll
    for (int j = 0; j < 5; ++j)
#pragma unroll
        for (int r = 0; r < 16; ++r) { const float e = __builtin_amdgcn_exp2f(p[j][r] - m); p[j][r] = e; l += e; }
    l += __shfl_xor(l, 32);
    l += __builtin_amdgcn_exp2f(sk - m);
    const float inv = 1.0f / l;
    u32x4 pb[5][2];
#pragma unroll
    for (int j = 0; j < 5; ++j)
#pragma unroll
        for (int s = 0; s < 2; ++s) { pb[j][s].x = cvt_pk_bf16(p[j][8 * s + 0], p[j][8 * s + 1]); pb[j][s].y = cvt_pk_bf16(p[j][8 * s + 2], p[j][8 * s + 3]); pb[j][s].z = cvt_pk_bf16(p[j][8 * s + 4], p[j][8 * s + 5]); pb[j][s].w = cvt_pk_bf16(p[j][8 * s + 6], p[j][8 * s + 7]); }
#pragma unroll
    for (int db = 0; db < 2; ++db) {
        f32x16 o;
#pragma unroll
        for (int r = 0; r < 16; ++r) o[r] = 0.f;
        const bf16* vr = VT + ((size_t)((b * 2 + g) * 64 + db * 32 + r32)) * SEQ + 4 * hi;
#pragma unroll
        for (int j = 0; j < 5; ++j) {
            const int kb = t0 - 128 + 32 * j;
            if (kb >= 0) {
#pragma unroll
                for (int s = 0; s < 2; ++s) {
                    const u32x2 lo = *(const u32x2*)(vr + kb + 16 * s), hh = *(const u32x2*)(vr + kb + 16 * s + 8);
                    u32x4 av; av.x = lo.x; av.y = lo.y; av.z = hh.x; av.w = hh.y;
                    o = __builtin_amdgcn_mfma_f32_32x32x16_bf16(__builtin_bit_cast(bf16x8, av), __builtin_bit_cast(bf16x8, pb[j][s]), o, 0, 0, 0);
                }
            }
        }
        bf16* op = CAT + (size_t)(tok0 + r32) * 1024 + h * 64 + db * 32 + 4 * hi;
#pragma unroll
        for (int gq = 0; gq < 4; ++gq) { u32x2 w; w.x = cvt_pk_bf16(o[4 * gq] * inv, o[4 * gq + 1] * inv); w.y = cvt_pk_bf16(o[4 * gq + 2] * inv, o[4 * gq + 3] * inv); *(u32x2*)(op + 8 * gq) = w; }
    }
}
__device__ __forceinline__ void sgu_unit(const Frame& F, const bf16* UB, const bf16* GB, const float* ln_g, const float* ln_b, const float* w_s, const float* b_s, bf16* CAT, int ch, int gi) {
    LAS bf16* GT = (LAS bf16*)F.lds;
    {
        const int s = F.tid >> 2, q4 = F.tid & 3; const size_t tok = (size_t)ch * 128 + s;
        const u32x4* gp = (const u32x4*)(GB + tok * 512 + gi * 64 + q4 * 16);
        const u32x4 a = gp[0], c = gp[1];
        float v[16];
        v[0] = __uint_as_float(a.x << 16); v[1] = __uint_as_float(a.x & 0xffff0000u); v[2] = __uint_as_float(a.y << 16); v[3] = __uint_as_float(a.y & 0xffff0000u);
        v[4] = __uint_as_float(a.z << 16); v[5] = __uint_as_float(a.z & 0xffff0000u); v[6] = __uint_as_float(a.w << 16); v[7] = __uint_as_float(a.w & 0xffff0000u);
        v[8] = __uint_as_float(c.x << 16); v[9] = __uint_as_float(c.x & 0xffff0000u); v[10] = __uint_as_float(c.y << 16); v[11] = __uint_as_float(c.y & 0xffff0000u);
        v[12] = __uint_as_float(c.z << 16); v[13] = __uint_as_float(c.z & 0xffff0000u); v[14] = __uint_as_float(c.w << 16); v[15] = __uint_as_float(c.w & 0xffff0000u);
        float sum = 0.f;
#pragma unroll
        for (int i = 0; i < 16; ++i) sum += v[i];
        sum += __shfl_xor(sum, 1); sum += __shfl_xor(sum, 2);
        const float mu = sum * (1.f / 64.f); float q = 0.f;
#pragma unroll
        for (int i = 0; i < 16; ++i) { v[i] -= mu; q += v[i] * v[i]; }
        q += __shfl_xor(q, 1); q += __shfl_xor(q, 2);
        const float rstd = rsqrtf(q * (1.f / 64.f) + LN_EPS);
#pragma unroll
        for (int i = 0; i < 16; ++i) { const int d = q4 * 16 + i; GT[d * 136 + s] = (bf16)f2bf(v[i] * rstd * ln_g[gi * 64 + d] + ln_b[gi * 64 + d]); }
    }
    __syncthreads();
    {
        const int r32 = F.lane & 31, hi = F.lane >> 5, tb = F.wave >> 1, db = F.wave & 1, t = tb * 32 + r32;
        f32x16 acc;
#pragma unroll
        for (int r = 0; r < 16; ++r) acc[r] = 0.f;
        const float* wrow = w_s + ((size_t)gi * 128 + t) * 128;
        const LAS bf16* arow = GT + (db * 32 + r32) * 136 + hi * 8;
        const int nks = 2 * (tb + 1);
        for (int ks = 0; ks < nks; ++ks) {
            const bf16x8 af = *(const LAS bf16x8*)(arow + ks * 16);
            const int s0 = ks * 16 + hi * 8;
            f32x4 w0 = *(const f32x4*)(wrow + s0), w1 = *(const f32x4*)(wrow + s0 + 4);
#pragma unroll
            for (int j = 0; j < 4; ++j) { if (s0 + j > t) w0[j] = 0.f; if (s0 + 4 + j > t) w1[j] = 0.f; }
            u32x4 bw; bw.x = cvt_pk_bf16(w0[0], w0[1]); bw.y = cvt_pk_bf16(w0[2], w0[3]); bw.z = cvt_pk_bf16(w1[0], w1[1]); bw.w = cvt_pk_bf16(w1[2], w1[3]);
            acc = __builtin_amdgcn_mfma_f32_32x32x16_bf16(af, __builtin_bit_cast(bf16x8, bw), acc, 0, 0, 0);
        }
        const float bb = b_s[gi * 128 + t];
        const size_t tokt = (size_t)ch * 128 + t;
        const bf16* up = UB + tokt * 512 + gi * 64 + db * 32 + 4 * hi;
        bf16* op = CAT + tokt * 1024 + 512 + gi * 64 + db * 32 + 4 * hi;
#pragma unroll
        for (int gq = 0; gq < 4; ++gq) {
            const u32x2 uu = *(const u32x2*)(up + 8 * gq);
            const float u0 = __uint_as_float(uu.x << 16), u1 = __uint_as_float(uu.x & 0xffff0000u), u2 = __uint_as_float(uu.y << 16), u3 = __uint_as_float(uu.y & 0xffff0000u);
            u32x2 w; w.x = cvt_pk_bf16(u0 * (acc[4 * gq] + bb), u1 * (acc[4 * gq + 1] + bb)); w.y = cvt_pk_bf16(u2 * (acc[4 * gq + 2] + bb), u3 * (acc[4 * gq + 3] + bb));
            *(u32x2*)(op + 8 * gq) = w;
        }
    }
    __syncthreads();
}
__device__ __forceinline__ void p2_mixers(const Frame& F, const Args& a) {
    unsigned char* ws = a.ws;
    const bf16 *QB = (const bf16*)(ws + WS_QB), *KB = (const bf16*)(ws + WS_KB), *VT = (const bf16*)(ws + WS_VT), *UB = (const bf16*)(ws + WS_UB), *GB = (const bf16*)(ws + WS_GB);
    bf16* CAT = (bf16*)(ws + WS_CAT);
    for (int qq = F.vcu; qq < T / 64; qq += F.G) {
        attn_wave_unit(QB, KB, VT, a.in[3], CAT, 2 * qq, F.wave, F.lane);
        attn_wave_unit(QB, KB, VT, a.in[3], CAT, 2 * qq + 1, F.wave, F.lane);
    }
    for (int u = F.vcu; u < (T / 128) * 8; u += F.G) sgu_unit(F, UB, GB, a.in[4], a.in[5], a.in[6], a.in[7], CAT, u >> 3, u & 7);
}

template <int CTRL> __device__ __forceinline__ float dppf(float v) { return __builtin_bit_cast(float, __builtin_amdgcn_update_dpp(0, __builtin_bit_cast(int, v), CTRL, 0xF, 0xF, true)); }
__device__ __forceinline__ float swap16_sum(float x, float y) { auto r = __builtin_amdgcn_permlane16_swap(__builtin_bit_cast(unsigned, x), __builtin_bit_cast(unsigned, y), false, false); return __builtin_bit_cast(float, r[0]) + __builtin_bit_cast(float, r[1]); }
__device__ __forceinline__ float swap32_sum(float x, float y) { auto r = __builtin_amdgcn_permlane32_swap(__builtin_bit_cast(unsigned, x), __builtin_bit_cast(unsigned, y), false, false); return __builtin_bit_cast(float, r[0]) + __builtin_bit_cast(float, r[1]); }
__device__ __forceinline__ float rdlane(float v, int l) { return __builtin_bit_cast(float, __builtin_amdgcn_readlane(__builtin_bit_cast(int, v), l)); }
__device__ __forceinline__ float xsum(float v) {
    v += dppf<0xB1>(v); v += dppf<0x4E>(v); v += dppf<0x124>(v); v += dppf<0x128>(v);
    return (rdlane(v, 0) + rdlane(v, 16)) + (rdlane(v, 32) + rdlane(v, 48));
}
__device__ __forceinline__ float xmax(float v) {
    v = fmaxf(v, dppf<0xB1>(v)); v = fmaxf(v, dppf<0x4E>(v)); v = fmaxf(v, dppf<0x124>(v)); v = fmaxf(v, dppf<0x128>(v));
    return fmaxf(fmaxf(rdlane(v, 0), rdlane(v, 16)), fmaxf(rdlane(v, 32), rdlane(v, 48)));
}
__device__ __forceinline__ void p4_router(const Frame& F, const Args& a, bool commit) {
    const float* Zin = a.out; float* Hout = (float*)(a.ws + WS_H); signed char* HB8 = (signed char*)(a.ws + WS_HB); int* meta = (int*)(a.ws + WS_META); unsigned* cnt = (unsigned*)(a.ws + WS_CTL) + CW_CNT;
    const float* ln1_g = a.in[10]; const float* ln1_b = a.in[11]; const float* w_r = a.in[12]; const float* b_r = a.in[13];
    LAS float* W = (LAS float*)F.lds;
    LAS unsigned* hist = (LAS unsigned*)(F.lds + RSCR_OFF);
    LAS unsigned* base = hist + 32;
    LAS int* tmp_e = (LAS int*)(hist + 64);
    LAS int* tmp_p = tmp_e + 256;
    LAS float* tmp_g = (LAS float*)(tmp_p + 256);
    {
        f32x4 t[16];
#pragma unroll
        for (int k = 0; k < 16; ++k) t[k] = *(const f32x4*)(w_r + (size_t)(F.tid + 512 * k) * 4);
#pragma unroll
        for (int k = 0; k < 16; ++k) { const int i = F.tid + 512 * k, c = i >> 3, e4 = i & 7; *(LAS f32x4*)(W + c * 36 + e4 * 4) = t[k]; }
    }
    { const int gt = F.vcu * (NWAVES * 64) + F.tid, NGT = F.G * NWAVES * 64;
      for (int i = gt; i < NROWS_MAX; i += NGT) { meta[MT_ROW_TOK + i] = 0; ((float*)meta)[MT_ROW_GATE + i] = 0.f; ((float*)meta)[MT_ROW_SA + i] = 0.f; } }
    const int lane = F.lane, half = lane >> 5, el = lane & 31;
    float gmm[16], bta[16];
#pragma unroll
    for (int i = 0; i < 16; ++i) { gmm[i] = ln1_g[64 * i + lane]; bta[i] = ln1_b[64 * i + lane]; }
    for (int tb = F.vcu; tb < T / 64; tb += F.G) {
        if (F.tid < 32) hist[F.tid] = 0u;
        __syncthreads();
        float zn0[16], zn1[16];
        { const float* z0 = Zin + (size_t)(tb * 64 + 8 * F.wave) * D + lane;
#pragma unroll
          for (int i = 0; i < 16; ++i) { zn0[i] = z0[64 * i]; zn1[i] = z0[D + 64 * i]; } }
        for (int pp = 0; pp < 4; ++pp) {
            const int tl0 = 8 * F.wave + 2 * pp;
            const int tok0 = tb * 64 + tl0;
            float h0[16], h1[16];
            {
                float* ho0 = Hout + (size_t)tok0 * D + lane; float* ho1 = ho0 + D;
                float s0 = 0.f, s1 = 0.f, q0 = 0.f, q1 = 0.f;
#pragma unroll
                for (int i = 0; i < 16; ++i) { h0[i] = zn0[i]; h1[i] = zn1[i]; }
                if (pp < 3) { const float* zp = Zin + (size_t)(tok0 + 2) * D + lane;
#pragma unroll
                    for (int i = 0; i < 16; ++i) { zn0[i] = zp[64 * i]; zn1[i] = zp[D + 64 * i]; } }
#pragma unroll
                for (int i = 0; i < 16; ++i) { s0 += h0[i]; s1 += h1[i]; q0 += h0[i] * h0[i]; q1 += h1[i] * h1[i]; }
                s0 = xsum(s0); s1 = xsum(s1); q0 = xsum(q0); q1 = xsum(q1);
                const float m0 = s0 * (1.f / D), m1 = s1 * (1.f / D);
                const float r0 = rsqrtf(fmaxf(q0 * (1.f / D) - m0 * m0, 0.f) + LN_EPS), r1 = rsqrtf(fmaxf(q1 * (1.f / D) - m1 * m1, 0.f) + LN_EPS);
                float a0 = 0.f, a1 = 0.f;
#pragma unroll
                for (int i = 0; i < 16; ++i) {
                    h0[i] = (h0[i] - m0) * r0 * gmm[i] + bta[i]; h1[i] = (h1[i] - m1) * r1 * gmm[i] + bta[i];
                    ho0[64 * i] = h0[i]; ho1[64 * i] = h1[i];
                    a0 = fmaxf(a0, fabsf(h0[i])); a1 = fmaxf(a1, fabsf(h1[i]));
                }
                a0 = xmax(a0); a1 = xmax(a1);
                const float i0 = a0 > 0.f ? 127.0f / a0 : 0.f, i1 = a1 > 0.f ? 127.0f / a1 : 0.f;
                signed char* hb0 = HB8 + (size_t)tok0 * D + lane; signed char* hb1 = hb0 + D;
#pragma unroll
                for (int i = 0; i < 16; ++i) { hb0[64 * i] = (signed char)(int)rintf(h0[i] * i0); hb1[64 * i] = (signed char)(int)rintf(h1[i] * i1); }
                if (lane == 0) { ((float*)meta)[MT_SH + tok0] = a0 * (1.0f / 127.0f); ((float*)meta)[MT_SH + tok0 + 1] = a1 * (1.0f / 127.0f); }
            }
            float lg0[32], lg1[32];
#pragma unroll
            for (int e = 0; e < 32; ++e) { lg0[e] = 0.f; lg1[e] = 0.f; }
#pragma unroll
            for (int i = 0; i < 16; ++i) {
                const LAS f32x4* wr = (const LAS f32x4*)(W + (64 * i + lane) * 36);
#pragma unroll
                for (int e4 = 0; e4 < 8; ++e4) {
                    const f32x4 ww = wr[e4];
                    lg0[4 * e4 + 0] += h0[i] * ww.x; lg0[4 * e4 + 1] += h0[i] * ww.y; lg0[4 * e4 + 2] += h0[i] * ww.z; lg0[4 * e4 + 3] += h0[i] * ww.w;
                    lg1[4 * e4 + 0] += h1[i] * ww.x; lg1[4 * e4 + 1] += h1[i] * ww.y; lg1[4 * e4 + 2] += h1[i] * ww.z; lg1[4 * e4 + 3] += h1[i] * ww.w;
                }
            }
            float v32[32];
#pragma unroll
            for (int e = 0; e < 32; ++e) { const float keep = half ? lg1[e] : lg0[e], send = half ? lg0[e] : lg1[e]; v32[e] = keep + __shfl_xor(send, 32); }
            float v16[16];
#pragma unroll
            for (int e = 0; e < 16; ++e) { const bool up = (lane & 16) != 0; const float keep = up ? v32[e + 16] : v32[e], send = up ? v32[e] : v32[e + 16]; v16[e] = keep + __shfl_xor(send, 16); }
            float v8[8];
#pragma unroll
            for (int e = 0; e < 8; ++e) { const bool up = (lane & 8) != 0; const float keep = up ? v16[e + 8] : v16[e], send = up ? v16[e] : v16[e + 8]; v8[e] = keep + dppf<0x128>(send); }
            float v4[4];
#pragma unroll
            for (int e = 0; e < 4; ++e) { const bool up = (lane & 4) != 0; const float keep = up ? v8[e + 4] : v8[e], send = up ? v8[e] : v8[e + 4]; v4[e] = keep + dppf<0x1B>(dppf<0x141>(send)); }
            float v2[2];
#pragma unroll
            for (int e = 0; e < 2; ++e) { const bool up = (lane & 2) != 0; const float keep = up ? v4[e + 2] : v4[e], send = up ? v4[e] : v4[e + 2]; v2[e] = keep + dppf<0x4E>(send); }
            float lgt;
            { const bool up = (lane & 1) != 0; const float keep = up ? v2[1] : v2[0], send = up ? v2[0] : v2[1]; lgt = keep + dppf<0xB1>(send); }
            lgt += b_r[el];
            int rank = 0;
#pragma unroll
            for (int j = 0; j < 32; ++j) {
                const float lo = rdlane(lgt, j), hi2 = rdlane(lgt, 32 + j);
                const float vj = half ? hi2 : lo;
                rank += (vj > lgt || (vj == lgt && j < el)) ? 1 : 0;
            }
            float bv[4]; int bi[4];
#pragma unroll
            for (int k = 0; k < 4; ++k) {
                const unsigned long long mk = __ballot(rank == k);
                const int i0 = __builtin_ctz((unsigned)mk | 0x80000000u), i1 = 32 + __builtin_ctz((unsigned)(mk >> 32) | 0x80000000u);
                const float x0 = rdlane(lgt, i0), x1 = rdlane(lgt, i1);
                bv[k] = half ? x1 : x0; bi[k] = half ? (i1 - 32) : i0;
            }
            float ex[4], es = 0.f;
#pragma unroll
            for (int k = 0; k < 4; ++k) { ex[k] = __expf(bv[k] - bv[0]); es += ex[k]; }
            if (el == 0) {
                const int tl = tl0 + half;
#pragma unroll
                for (int k = 0; k < 4; ++k) { const unsigned pl = atomicAdd((unsigned*)&hist[bi[k]], 1u); tmp_e[tl * 4 + k] = bi[k]; tmp_p[tl * 4 + k] = (int)pl; tmp_g[tl * 4 + k] = ex[k] / es; }
            }
        }
        __syncthreads();
        if (F.tid < 32) base[F.tid] = commit ? atomicAdd(&cnt[F.tid], hist[F.tid]) : 0u;
        __syncthreads();
        if (F.tid < 256) { const int i = F.tid, gi = tb * 256 + i, e = tmp_e[i];
            meta[MT_SEL_E + gi] = e; meta[MT_SEL_POS + gi] = (int)base[e] + tmp_p[i]; ((float*)meta)[MT_SEL_G + gi] = tmp_g[i]; }
        __syncthreads();
    }
}
__device__ __forceinline__ void p5_dispatch(const Frame& F, const Args& a) {
    int* meta = (int*)(a.ws + WS_META); const unsigned* cnt = (const unsigned*)(a.ws + WS_CTL) + CW_CNT;
    LAS int* ts = (LAS int*)(F.lds + RSCR_OFF);
    if (F.tid == 0) { int acc = 0; for (int e = 0; e < 32; ++e) { ts[e] = acc; acc += ((int)__hip_atomic_load(cnt + e, RLX_AGENT) + 255) >> 8; } ts[32] = acc; }
    __syncthreads();
    if (blockIdx.x == 0) {
        if (F.tid == 0) meta[MT_NT] = ts[32];
        if (F.tid < 33) meta[MT_TSTART + F.tid] = ts[F.tid];
        for (int t = F.tid; t < NT_MAX; t += NWAVES * 64) { int e = 0; for (int j = 1; j < 32; ++j) if (t >= ts[j]) e = j; meta[MT_TILE_E + t] = e; }
    }
    const int gt = F.vcu * (NWAVES * 64) + F.tid, NGT = F.G * NWAVES * 64;
    for (int i = gt; i < T * 4; i += NGT) {
        const int e = meta[MT_SEL_E + i], row = ts[e] * 256 + meta[MT_SEL_POS + i];
        meta[MT_ROW_TOK + row] = i >> 2; ((float*)meta)[MT_ROW_GATE + row] = ((const float*)meta)[MT_SEL_G + i]; ((float*)meta)[MT_ROW_SA + row] = ((const float*)meta)[MT_SH + (i >> 2)]; meta[MT_SLOT_ROW + i] = row;
    }
    __syncthreads();
}
__device__ __forceinline__ void p7_quant(const Frame& F, const Args& a) {
    const bf16* HID = (const bf16*)(a.ws + WS_HID); signed char* H8 = (signed char*)(a.ws + WS_HID8); float* row_sb = (float*)(a.ws + WS_ROWSB);
    const int nrows = __builtin_amdgcn_readfirstlane(((const int*)(a.ws + WS_META))[MT_NT]) * 256;
    const int gw = F.vcu * NWAVES + F.wave, NGW = F.G * NWAVES, lane = F.lane;
    for (int r0 = gw * 4; r0 < nrows; r0 += NGW * 4) {
        u32x4 v[4][2];
#pragma unroll
        for (int i = 0; i < 4; ++i)
#pragma unroll
            for (int j = 0; j < 2; ++j) v[i][j] = *((const u32x4*)(HID + (size_t)(r0 + i) * DFF + 512 * j) + lane);
#pragma unroll
        for (int i = 0; i < 4; ++i) {
            float f[16]; float am = 0.f;
#pragma unroll
            for (int j = 0; j < 2; ++j)
#pragma unroll
                for (int c = 0; c < 4; ++c) { const unsigned w = v[i][j][c]; f[8 * j + 2 * c] = __uint_as_float(w << 16); f[8 * j + 2 * c + 1] = __uint_as_float(w & 0xffff0000u); }
#pragma unroll
            for (int c = 0; c < 16; ++c) am = fmaxf(am, fabsf(f[c]));
            am = wave_max(am);
            const float inv = am > 0.f ? 127.0f / am : 0.f;
#pragma unroll
            for (int j = 0; j < 2; ++j) {
                u32x2 o; o.x = 0u; o.y = 0u;
#pragma unroll
                for (int c = 0; c < 4; ++c) { o.x |= ((unsigned)(int)rintf(f[8 * j + c] * inv) & 0xffu) << (8 * c); o.y |= ((unsigned)(int)rintf(f[8 * j + 4 + c] * inv) & 0xffu) << (8 * c); }
                *((u32x2*)(H8 + (size_t)(r0 + i) * DFF + 512 * j) + lane) = o;
            }
            if (lane == 0) row_sb[r0 + i] = am * (1.0f / 127.0f);
        }
    }
}
__device__ __forceinline__ void p8_final(const Frame& F, const Args& a) {
    const float* Hin = (const float*)(a.ws + WS_H); float* HO = a.out; const bf16* Y = (const bf16*)(a.ws + WS_Y); const int* meta = (const int*)(a.ws + WS_META);
    const float* ln2_g = a.in[20]; const float* ln2_b = a.in[21];
    const int gw = F.vcu * NWAVES + F.wave, NGW = F.G * NWAVES, lane = F.lane;
    for (int tok = gw; tok < T; tok += NGW) {
        f32x4* hr = (f32x4*)(HO + (size_t)tok * D) + lane; const f32x4* hi_ = (const f32x4*)(Hin + (size_t)tok * D) + lane;
        f32x4 v[4]; float s = 0.f;
#pragma unroll
        for (int j = 0; j < 4; ++j) v[j] = hi_[64 * j] * ALPHA;
#pragma unroll
        for (int k = 0; k < 4; ++k) {
            const int row = meta[MT_SLOT_ROW + tok * 4 + k];
            const u32x2* yr = (const u32x2*)(Y + (size_t)row * D) + lane;
#pragma unroll
            for (int j = 0; j < 4; ++j) { const u32x2 y = yr[64 * j]; v[j].x += __uint_as_float(y.x << 16); v[j].y += __uint_as_float(y.x & 0xffff0000u); v[j].z += __uint_as_float(y.y << 16); v[j].w += __uint_as_float(y.y & 0xffff0000u); }
        }
#pragma unroll
        for (int j = 0; j < 4; ++j) s += (v[j].x + v[j].y) + (v[j].z + v[j].w);
        const float mean = wave_sum(s) * (1.f / D); float s2 = 0.f;
#pragma unroll
        for (int j = 0; j < 4; ++j) { v[j] = v[j] - mean; s2 += (v[j].x * v[j].x + v[j].y * v[j].y) + (v[j].z * v[j].z + v[j].w * v[j].w); }
        const float rstd = rsqrtf(wave_sum(s2) * (1.f / D) + LN_EPS);
#pragma unroll
        for (int j = 0; j < 4; ++j) { const int c0 = 4 * lane + 256 * j; const f32x4 gg = *(const f32x4*)(ln2_g + c0), bb = *(const f32x4*)(ln2_b + c0); hr[64 * j] = v[j] * rstd * gg + bb; }
    }
}
#ifndef MKMASK
#define MKMASK 0x3FF
#endif
#ifndef REPEAT_MASK
#define REPEAT_MASK 0
#endif
#define NREP(k) (1 + ((REPEAT_MASK >> (k)) & 1))
__global__ void __launch_bounds__(NWAVES * 64, 2) mk_fwd(Args args) {
    extern __shared__ __attribute__((aligned(16))) unsigned char lds_raw[];
    Frame F;
    F.lds = (LAS unsigned char*)lds_raw;
    F.tid = threadIdx.x; F.lane = F.tid & 63; F.wave = __builtin_amdgcn_readfirstlane(F.tid >> 6);
    F.G = gridDim.x; { const int bx = blockIdx.x; F.vcu = (F.G % 8 == 0) ? (bx % 8) * (F.G / 8) + bx / 8 : bx; }
    volatile LAS unsigned* MISC = (volatile LAS unsigned*)(F.lds + MISC_OFF);
    if (F.tid < 64) MISC[F.tid] = 0u;
    __syncthreads();
    unsigned char* ws = args.ws;
    unsigned* ctl = (unsigned*)(ws + WS_CTL);
    const int lo = args.ph_lo, hi = args.ph_hi;
    XcdBarrier bar; bar.bar = ctl + CW_BAR + args.li * XCD_BAR_WORDS; bar.x = 0; bar.st = nullptr;
    if (hi - lo > 1) bar = xcd_barrier_post(ctl + CW_BAR + args.li * XCD_BAR_WORDS, MISC + 8);
#define IN(k) (lo <= (k) && (k) < hi)
#define SEAM(k) do { if ((IN(k) && IN((k) + 1)) || rep_ + 1 < NREP(k)) xcd_barrier(bar); } while (0)
    int* meta = (int*)(ws + WS_META);
    bf16 *XB = (bf16*)(ws + WS_XB), *QB = (bf16*)(ws + WS_QB), *KB = (bf16*)(ws + WS_KB), *VT = (bf16*)(ws + WS_VT), *UB = (bf16*)(ws + WS_UB), *GB = (bf16*)(ws + WS_GB);
    bf16 *CAT = (bf16*)(ws + WS_CAT), *HB = (bf16*)(ws + WS_HB), *Y = (bf16*)(ws + WS_Y), *HID = (bf16*)(ws + WS_HID);
    bf16 *Win_t = (bf16*)(ws + WS_WIN), *Wout_t = (bf16*)(ws + WS_WOUT), *Wgu_t = (bf16*)(ws + WS_WGU), *Wd_t = (bf16*)(ws + WS_WD);
    const LAS int* rtab = (const LAS int*)(F.lds + RTAB_OFF);
    const bool par = ((blockIdx.x >> 3) & 1) != 0;

    for (int rep_ = 0; rep_ < NREP(0); ++rep_) if (IN(0)) { p0_prologue(F, args); SEAM(0); }
    if (IN(1)) {
        const int c = (int)blockIdx.x;
        const int per_ = (3 * NEXP * 32 + F.G - 1) / F.G;
        const int it_lo = F.G == 256 ? (c < 192 ? c * 10 : 1920 + (c - 192) * 18) : c * per_, it_hi = F.G == 256 ? it_lo + (c < 192 ? 10 : 18) : it_lo + per_;
        if (!par) conv_items(F, args, it_lo, it_hi);
        { pg8::Gemm g{XB, Win_t, 2 * D, nullptr, 0u}; pg8::StaticOrder S; S.init(T / 256, INW / 256, F.G, c);
          pg8::EpiInProj E{args.in[2], QB, KB, VT, UB, GB};
          pg8::gemm_phase<pg8::EpiInProj, false, true, false>(F.lds, rtab, g, S, E); }
        if (par) conv_items(F, args, it_lo, it_hi);
        { const int rep_ = 0; (void)rep_; SEAM(1); }
    }
    for (int rep_ = 0; rep_ < NREP(2); ++rep_) if (IN(2)) { p2_mixers(F, args); SEAM(2); }
    for (int rep_ = 0; rep_ < NREP(3); ++rep_) if (IN(3)) {
        pg8::Gemm g{CAT, Wout_t, 2 * D, nullptr, 0u}; pg8::StaticOrder S; S.init(T / 256, D / 256, F.G, (int)blockIdx.x);
        pg8::EpiOutProj E{args.in[0], args.in[9], args.out};
        pg8::gemm_phase<pg8::EpiOutProj, false, false, false>(F.lds, rtab, g, S, E);
        SEAM(3);
    }
    for (int rep_ = 0; rep_ < NREP(4); ++rep_) if (IN(4)) { p4_router(F, args, rep_ + 1 == NREP(4)); SEAM(4); }
    for (int rep_ = 0; rep_ < NREP(5); ++rep_) if (IN(5)) { p5_dispatch(F, args); SEAM(5); }
    for (int rep_ = 0; rep_ < NREP(6); ++rep_) if (IN(6)) {
        const int nT = __builtin_amdgcn_readfirstlane(meta[MT_NT]);
        pg8::StaticOrder S; S.init(nT, 2 * DFF / 256, F.G, (int)blockIdx.x);
        { pg8::Unit u; LAS int* rt = (LAS int*)(F.lds + RTAB_OFF);
          for (int i = 0; i < RTAB_UNITS && S.next(i, u); ++i) if (F.tid < 256) rt[i * 256 + F.tid] = meta[MT_ROW_TOK + u.pm * 256 + F.tid];
          __syncthreads(); }
        pg8::Gemm g{HB, Wgu_t, D, meta + MT_TILE_E, 2048u * 1024u};
        pg8::EpiSwiglu E{meta + MT_TILE_E, args.in[15], args.in[17], (const float*)(ws + WS_SWGU), (const float*)meta + MT_ROW_SA, HID};
        pg8::gemm_phase<pg8::EpiSwiglu, true, true, true>(F.lds, rtab, g, S, E);
        SEAM(6);
    }
    for (int rep_ = 0; rep_ < NREP(7); ++rep_) if (IN(7)) { p7_quant(F, args); SEAM(7); }
    for (int rep_ = 0; rep_ < NREP(8); ++rep_) if (IN(8)) {
        const int nT = __builtin_amdgcn_readfirstlane(meta[MT_NT]);
        pg8::StaticOrder S; S.init(nT, D / 256, F.G, (int)blockIdx.x);
        pg8::Gemm g{ws + WS_HID8, Wd_t, DFF, meta + MT_TILE_E, 1024u * 1024u};
        pg8::EpiDown E{meta + MT_TILE_E, args.in[19], (const float*)(ws + WS_SWD), (const float*)(ws + WS_ROWSB), (const float*)meta + MT_ROW_GATE, Y};
        pg8::gemm_phase<pg8::EpiDown, false, true, true>(F.lds, rtab, g, S, E);
        SEAM(8);
    }
    for (int rep_ = 0; rep_ < NREP(9); ++rep_) if (IN(9)) { p8_final(F, args); if (rep_ + 1 < NREP(9)) xcd_barrier(bar); }
#undef IN
#undef SEAM
}

extern "C" void kernel_launch(void* const* d_in, const int* in_sizes, int n_in, void* d_out, int out_size, void* d_ws, size_t ws_size, hipStream_t stream) {
    static int grid = 0;
    if (grid == 0) {
        if (n_in != 22 || in_sizes[0] != T * D || out_size != T * D || ws_size < WS_END) { fprintf(stderr, "kernel_launch: unexpected shapes (n_in %d, in0 %d, out %d, ws %zu, need %zu)\n", n_in, n_in > 0 ? in_sizes[0] : -1, out_size, ws_size, (size_t)WS_END); grid = -1; return; }
        int dev = 0, cus = 0;
        if (hipGetDevice(&dev) != hipSuccess || hipDeviceGetAttribute(&cus, hipDeviceAttributeMultiprocessorCount, dev) != hipSuccess) { grid = -1; return; }
        if (hipFuncSetAttribute((const void*)mk_fwd, hipFuncAttributeMaxDynamicSharedMemorySize, LDS_BYTES) != hipSuccess) { fprintf(stderr, "kernel_launch: hipFuncSetAttribute failed\n"); grid = -1; return; }
        int per_cu = 0;
        if (hipOccupancyMaxActiveBlocksPerMultiprocessor(&per_cu, (const void*)mk_fwd, NWAVES * 64, LDS_BYTES) != hipSuccess || per_cu < 1) fprintf(stderr, "kernel_launch: occupancy query reports %d\n", per_cu);
        (void)hipGetLastError();
        grid = cus;
    }
    if (grid < 0) return;
    const float* x = (const float*)d_in[0]; const float* w_in = (const float*)d_in[1]; const float* b_in = (const float*)d_in[2]; const float* sinks = (const float*)d_in[3];
    const float* ln_v_g = (const float*)d_in[4]; const float* ln_v_b = (const float*)d_in[5]; const float* w_sp = (const float*)d_in[6]; const float* b_sp = (const float*)d_in[7];
    const float* w_out = (const float*)d_in[8]; const float* b_out = (const float*)d_in[9]; const float* ln1_g = (const float*)d_in[10]; const float* ln1_b = (const float*)d_in[11];
    const float* w_r = (const float*)d_in[12]; const float* b_r = (const float*)d_in[13]; const float* w_gate = (const float*)d_in[14]; const float* b_gate = (const float*)d_in[15];
    const float* w_up = (const float*)d_in[16]; const float* b_up = (const float*)d_in[17]; const float* w_down = (const float*)d_in[18]; const float* b_down = (const float*)d_in[19];
    const float* ln2_g = (const float*)d_in[20]; const float* ln2_b = (const float*)d_in[21];
    unsigned char* ws = (unsigned char*)d_ws; float* out = (float*)d_out;
    unsigned* ctl = (unsigned*)(ws + WS_CTL); int* meta = (int*)(ws + WS_META);
    bf16 *XB = (bf16*)(ws + WS_XB), *QB = (bf16*)(ws + WS_QB), *KB = (bf16*)(ws + WS_KB), *VT = (bf16*)(ws + WS_VT), *UB = (bf16*)(ws + WS_UB), *GB = (bf16*)(ws + WS_GB);
    bf16 *CAT = (bf16*)(ws + WS_CAT), *HB = (bf16*)(ws + WS_HB), *Y = (bf16*)(ws + WS_Y), *HID = (bf16*)(ws + WS_HID);
    (void)hipMemsetAsync(ws + WS_CTL, 0, 1 * MiB, stream);
    Args a{};
    for (int i = 0; i < 22; ++i) a.in[i] = (const float*)d_in[i];
    a.out = out; a.ws = ws;
    int li = 0;
    for (int k = 0; k < NPHASES;) {
        if ((MKMASK >> k) & 1) {
            int j = k; while (j < NPHASES && ((MKMASK >> j) & 1)) ++j;
            a.ph_lo = k; a.ph_hi = j; a.li = li++;
            hipLaunchKernelGGL(mk_fwd, dim3(grid), dim3(NWAVES * 64), LDS_BYTES, stream, a);
            k = j; continue;
        }
        switch (k) {
        case 0: k_cvt_x<<<2048, 256, 0, stream>>>(x, XB, T * D / 4); break;
        case 1: k_inproj_naive<<<dim3(T / 64, INW / 64), 256, 0, stream>>>(XB, w_in, EpiInProjN{b_in, QB, KB, VT, UB, GB}); break;
        case 2: k_attn_naive<<<T * NQH / 4, 256, 0, stream>>>(QB, KB, VT, sinks, CAT);
                k_sgu_naive<<<T / 128 * 8, 256, 0, stream>>>(UB, GB, ln_v_g, ln_v_b, w_sp, b_sp, CAT); break;
        case 3: k_outproj_naive<<<dim3(T / 64, D / 64), 256, 0, stream>>>(CAT, w_out, EpiOutProjN{b_out, x, out}); break;
        case 4: k_router_naive<<<T / 4, 256, 0, stream>>>(out, HB, ln1_g, ln1_b, w_r, b_r, ctl + CW_CNT, meta);
                k_rowinit<<<(NROWS_MAX + 255) / 256, 256, 0, stream>>>(meta); break;
        case 5: k_dispatch1<<<1, 64, 0, stream>>>(ctl + CW_CNT, meta);
                k_scatter<<<T * 4 / 256, 256, 0, stream>>>(meta); break;
        case 6: k_gateup_naive<<<dim3(NT_MAX * 4, DFF / 64), 256, 0, stream>>>(HB, meta, w_gate, b_gate, w_up, b_up, HID); break;
        case 8: k_down_naive<<<dim3(NT_MAX * 4, D / 64), 256, 0, stream>>>(HID, meta, w_down, b_down, Y); break;
        case 9: k_final_naive<<<T / 4, 256, 0, stream>>>(out, Y, meta, ln2_g, ln2_b); break;
        }
        ++k;
    }
}
```

```cpp
#include <hip/hip_runtime.h>
#include <cstdio>
#include <cstdint>

typedef unsigned short bf16;
typedef float f32x4 __attribute__((ext_vector_type(4)));
typedef unsigned u32x4 __attribute__((ext_vector_type(4)));
typedef unsigned u32x2 __attribute__((ext_vector_type(2)));

constexpr int BATCH = 2, SEQ = 8192, D = 1024, T = BATCH * SEQ;
constexpr int NQH = 8, NKVH = 2, HD = 64, QREP = 4, AW = 512, KVW = 128, GW = 512, INW = 1792;
constexpr int NEXP = 32, TOPK = 4, DFF = 1024;
constexpr int NT_MAX = T * TOPK / 256 + NEXP;
constexpr int NROWS_MAX = NT_MAX * 256;
constexpr float LN_EPS = 1e-5f;
constexpr float ALPHA = 1.189207115002721f;
constexpr float C2 = 0.125f * 1.4426950408889634f;
constexpr float LOG2E = 1.4426950408889634f;
constexpr float YSCALE = 16.0f;

constexpr size_t MiB = 1u << 20;
constexpr size_t WS_CTL = 0;
constexpr size_t WS_META = 1 * MiB;
constexpr size_t WS_XB = 3 * MiB;
constexpr size_t WS_QB = WS_XB + 32 * MiB;
constexpr size_t WS_KB = WS_QB + 16 * MiB;
constexpr size_t WS_VT = WS_KB + 4 * MiB;
constexpr size_t WS_UB = WS_VT + 4 * MiB;
constexpr size_t WS_GB = WS_UB + 16 * MiB;
constexpr size_t WS_CAT = WS_GB + 16 * MiB;
constexpr size_t WS_HB = WS_CAT + 32 * MiB;
constexpr size_t WS_H = WS_XB;
constexpr size_t WS_HID = WS_HB + 32 * MiB;
constexpr size_t WS_Y = WS_HID;
constexpr size_t WS_END_NAIVE = WS_HID + 144 * MiB;
static_assert(WS_H + 64 * MiB <= WS_CAT, "H overlay");

constexpr int CW_CNT = 64;
constexpr int MT_NT = 0;
constexpr int MT_TSTART = 16;
constexpr int MT_TILE_E = 64;
constexpr int MT_SEL_E = 1024;
constexpr int MT_SEL_POS = MT_SEL_E + T * 4;
constexpr int MT_SEL_G = MT_SEL_POS + T * 4;
constexpr int MT_SLOT_ROW = MT_SEL_G + T * 4;
constexpr int MT_ROW_TOK = MT_SLOT_ROW + T * 4;
constexpr int MT_ROW_GATE = MT_ROW_TOK + NROWS_MAX;
constexpr int MT_ROW_SA = MT_ROW_GATE + NROWS_MAX;
constexpr int MT_SH = MT_ROW_SA + NROWS_MAX;
constexpr size_t WS_ROWSB = 512 * 1024;
static_assert((size_t)(MT_SH + T) * 4 <= 2 * MiB, "meta");

__device__ __forceinline__ float bf2f(bf16 v) { return __uint_as_float((unsigned)v << 16); }
__device__ __forceinline__ unsigned f2bf(float f) { unsigned u = __float_as_uint(f); return (u + 0x7fffu + ((u >> 16) & 1u)) >> 16; }
__device__ __forceinline__ unsigned pk2(float lo, float hi) { return f2bf(lo) | (f2bf(hi) << 16); }
__device__ __forceinline__ float gelu_tanh(float x) {
    const float k2 = 2.0f * 0.7978845608028654f;
    const float u = k2 * (x + 0.044715f * x * x * x);
    return x / (1.0f + __expf(-u));
}
__device__ __forceinline__ float wave_sum(float v) {
#pragma unroll
    for (int o = 1; o < 64; o <<= 1) v += __shfl_xor(v, o);
    return v;
}
__device__ __forceinline__ float wave_max(float v) {
#pragma unroll
    for (int o = 1; o < 64; o <<= 1) v = fmaxf(v, __shfl_xor(v, o));
    return v;
}

__global__ void k_cvt_x(const float* __restrict__ x, bf16* __restrict__ xb, int n4) {
    for (int i = blockIdx.x * blockDim.x + threadIdx.x; i < n4; i += gridDim.x * blockDim.x) {
        const f32x4 v = ((const f32x4*)x)[i];
        u32x2 o; o.x = pk2(v.x, v.y); o.y = pk2(v.z, v.w);
        ((u32x2*)xb)[i] = o;
    }
}

template <int NB, class Epi>
__device__ __forceinline__ void naive_gemm_tile(const bf16* A, int lda, const int* rowidx, int m0, const float* B0, const float* B1, int ldb, int n0, int K, const Epi& epi) {
    __shared__ float As[16][68];
    __shared__ float Bs[NB][16][64];
    const int tid = threadIdx.x, ty = tid >> 4, tx = tid & 15;
    float acc[NB][4][4];
#pragma unroll
    for (int b = 0; b < NB; ++b)
#pragma unroll
        for (int i = 0; i < 4; ++i)
#pragma unroll
            for (int j = 0; j < 4; ++j) acc[b][i][j] = 0.f;
    const int ar = tid >> 2, ac = (tid & 3) * 4;
    const int arow = rowidx ? rowidx[m0 + ar] : (m0 + ar);
    const bf16* ap = A + (size_t)arow * lda + ac;
    const int br = tid >> 4, bc = (tid & 15) * 4;
    for (int k0 = 0; k0 < K; k0 += 16) {
        const u32x2 av = *(const u32x2*)(ap + k0);
        As[ac + 0][ar] = __uint_as_float(av.x << 16); As[ac + 1][ar] = __uint_as_float(av.x & 0xffff0000u);
        As[ac + 2][ar] = __uint_as_float(av.y << 16); As[ac + 3][ar] = __uint_as_float(av.y & 0xffff0000u);
        *(f32x4*)&Bs[0][br][bc] = *(const f32x4*)(B0 + (size_t)(k0 + br) * ldb + n0 + bc);
        if (NB == 2) *(f32x4*)&Bs[NB - 1][br][bc] = *(const f32x4*)(B1 + (size_t)(k0 + br) * ldb + n0 + bc);
        __syncthreads();
#pragma unroll
        for (int k = 0; k < 16; ++k) {
            const f32x4 a = *(const f32x4*)&As[k][ty * 4];
#pragma unroll
            for (int b = 0; b < NB; ++b) {
                const f32x4 bv = *(const f32x4*)&Bs[b][k][tx * 4];
#pragma unroll
                for (int i = 0; i < 4; ++i)
#pragma unroll
                    for (int j = 0; j < 4; ++j) acc[b][i][j] += a[i] * bv[j];
            }
        }
        __syncthreads();
    }
#pragma unroll
    for (int i = 0; i < 4; ++i)
#pragma unroll
        for (int j = 0; j < 4; ++j) {
            if (NB == 2) epi(m0 + ty * 4 + i, n0 + tx * 4 + j, acc[0][i][j], acc[NB - 1][i][j]);
            else epi(m0 + ty * 4 + i, n0 + tx * 4 + j, acc[0][i][j], 0.f);
        }
}

struct EpiInProjN {
    const float* b_in; bf16 *QB, *KB, *VT, *UB, *GB;
    __device__ __forceinline__ void operator()(int row, int c, float a, float) const {
        const float v = a + b_in[c];
        if (c < 512) QB[(size_t)row * 512 + c] = (bf16)f2bf(v * C2);
        else if (c < 640) KB[(size_t)row * 128 + (c - 512)] = (bf16)f2bf(v);
        else if (c < 768) { const int cv = c - 640, g = cv >> 6, d = cv & 63, b = row / SEQ, s = row % SEQ; VT[((size_t)((b * 2 + g) * 64 + d)) * SEQ + s] = (bf16)f2bf(v); }
        else if (c < 1280) UB[(size_t)row * 512 + (c - 768)] = (bf16)f2bf(gelu_tanh(v));
        else GB[(size_t)row * 512 + (c - 1280)] = (bf16)f2bf(gelu_tanh(v));
    }
};
__global__ void __launch_bounds__(256) k_inproj_naive(const bf16* XB, const float* w_in, EpiInProjN epi) {
    naive_gemm_tile<1>(XB, D, nullptr, blockIdx.x * 64, w_in, nullptr, INW, blockIdx.y * 64, D, epi);
}

__global__ void __launch_bounds__(256) k_attn_naive(const bf16* QB, const bf16* KB, const bf16* VT, const float* sinks, bf16* CAT) {
    __shared__ float pl[4][128];
    const int w = threadIdx.x >> 6, lane = threadIdx.x & 63;
    const int wu = blockIdx.x * 4 + w;
    const int tok = wu >> 3, h = wu & 7, g = h >> 2, b = tok / SEQ, t = tok % SEQ;
    const float qv = bf2f(QB[(size_t)tok * 512 + h * 64 + lane]);
    float s[2];
    {
        const int kp0 = t - 127 + lane, kp1 = kp0 + 64;
        const bf16* kr0 = KB + (size_t)(b * SEQ + (kp0 < 0 ? 0 : kp0)) * 128 + g * 64;
        const bf16* kr1 = KB + (size_t)(b * SEQ + (kp1 < 0 ? 0 : kp1)) * 128 + g * 64;
        float a0 = 0.f, a1 = 0.f;
        for (int d = 0; d < 64; ++d) { const float qd = __shfl(qv, d); a0 += qd * bf2f(kr0[d]); a1 += qd * bf2f(kr1[d]); }
        s[0] = (kp0 >= 0) ? a0 : -1e30f; s[1] = (kp1 >= 0) ? a1 : -1e30f;
    }
    const float sk = sinks[h] * LOG2E;
    const float m = fmaxf(wave_max(fmaxf(s[0], s[1])), sk);
    const float p0 = exp2f(s[0] - m), p1 = exp2f(s[1] - m);
    const float l = wave_sum(p0 + p1) + exp2f(sk - m);
    pl[w][lane] = p0; pl[w][64 + lane] = p1;
    __syncthreads();
    const bf16* vr = VT + ((size_t)((b * 2 + g) * 64 + lane)) * SEQ;
    float o = 0.f;
    for (int j = 0; j < 128; ++j) { const int kp = t - 127 + j; if (kp >= 0) o += pl[w][j] * bf2f(vr[kp]); }
    CAT[(size_t)tok * 1024 + h * 64 + lane] = (bf16)f2bf(o / l);
}

__global__ void __launch_bounds__(256) k_sgu_naive(const bf16* UB, const bf16* GB, const float* ln_g, const float* ln_b, const float* w_s, const float* b_s, bf16* CAT) {
    __shared__ float G[128][65];
    const int u = blockIdx.x, gi = u & 7, ch = u >> 3;
    const int tid = threadIdx.x, s = tid >> 1, half = tid & 1;
    const size_t tok = (size_t)ch * 128 + s;
    float v[32]; float sum = 0.f;
#pragma unroll
    for (int i = 0; i < 32; ++i) { v[i] = bf2f(GB[tok * 512 + gi * 64 + half * 32 + i]); sum += v[i]; }
    sum += __shfl_xor(sum, 1);
    const float mu = sum * (1.f / 64.f); float q = 0.f;
#pragma unroll
    for (int i = 0; i < 32; ++i) { v[i] -= mu; q += v[i] * v[i]; }
    q += __shfl_xor(q, 1);
    const float rstd = rsqrtf(q * (1.f / 64.f) + LN_EPS);
#pragma unroll
    for (int i = 0; i < 32; ++i) { const int d = half * 32 + i; G[s][d] = v[i] * rstd * ln_g[gi * 64 + d] + ln_b[gi * 64 + d]; }
    __syncthreads();
    const int t = s;
    float acc[32];
#pragma unroll
    for (int i = 0; i < 32; ++i) acc[i] = 0.f;
    const float* wr = w_s + ((size_t)gi * 128 + t) * 128;
    for (int ss = 0; ss <= t; ++ss) {
        const float w = wr[ss];
#pragma unroll
        for (int i = 0; i < 32; ++i) acc[i] += w * G[ss][half * 32 + i];
    }
    const float bb = b_s[gi * 128 + t];
#pragma unroll
    for (int i = 0; i < 32; ++i) { const int d = half * 32 + i; const float uu = bf2f(UB[tok * 512 + gi * 64 + d]); CAT[tok * 1024 + 512 + gi * 64 + d] = (bf16)f2bf(uu * (acc[i] + bb)); }
}

struct EpiOutProjN {
    const float* b_out; const float* x; float* Z;
    __device__ __forceinline__ void operator()(int row, int c, float a, float) const { Z[(size_t)row * D + c] = ALPHA * x[(size_t)row * D + c] + a + b_out[c]; }
};
__global__ void __launch_bounds__(256) k_outproj_naive(const bf16* CAT, const float* w_out, EpiOutProjN epi) {
    naive_gemm_tile<1>(CAT, D, nullptr, blockIdx.x * 64, w_out, nullptr, D, blockIdx.y * 64, D, epi);
}

__global__ void __launch_bounds__(256) k_router_naive(float* ZH, bf16* HB, const float* ln1_g, const float* ln1_b, const float* w_r, const float* b_r, unsigned* cnt, int* meta) {
    const int w = threadIdx.x >> 6, lane = threadIdx.x & 63;
    const int tok = blockIdx.x * 4 + w;
    f32x4* zr = (f32x4*)(ZH + (size_t)tok * D) + lane;
    f32x4 v[4]; float s = 0.f;
#pragma unroll
    for (int j = 0; j < 4; ++j) { v[j] = zr[64 * j]; s += (v[j].x + v[j].y) + (v[j].z + v[j].w); }
    const float mean = wave_sum(s) * (1.f / D); float s2 = 0.f;
#pragma unroll
    for (int j = 0; j < 4; ++j) { v[j] = v[j] - mean; s2 += (v[j].x * v[j].x + v[j].y * v[j].y) + (v[j].z * v[j].z + v[j].w * v[j].w); }
    const float rstd = rsqrtf(wave_sum(s2) * (1.f / D) + LN_EPS);
    float lg[32];
#pragma unroll
    for (int e = 0; e < 32; ++e) lg[e] = 0.f;
#pragma unroll
    for (int j = 0; j < 4; ++j) {
        const int c0 = 4 * lane + 256 * j;
        const f32x4 gg = *(const f32x4*)(ln1_g + c0), bb = *(const f32x4*)(ln1_b + c0);
        v[j] = v[j] * rstd * gg + bb;
        zr[64 * j] = v[j];
        u32x2 o; o.x = pk2(v[j].x, v[j].y); o.y = pk2(v[j].z, v[j].w);
        *((u32x2*)(HB + (size_t)tok * D + c0)) = o;
#pragma unroll
        for (int i = 0; i < 4; ++i) {
            const float hv = v[j][i];
            const f32x4* wr = (const f32x4*)(w_r + (size_t)(c0 + i) * 32);
#pragma unroll
            for (int e4 = 0; e4 < 8; ++e4) { const f32x4 ww = wr[e4]; lg[e4 * 4 + 0] += hv * ww.x; lg[e4 * 4 + 1] += hv * ww.y; lg[e4 * 4 + 2] += hv * ww.z; lg[e4 * 4 + 3] += hv * ww.w; }
        }
    }
#pragma unroll
    for (int e = 0; e < 32; ++e) lg[e] = wave_sum(lg[e]) + b_r[e];
    int bi[4]; float bv[4];
#pragma unroll
    for (int k = 0; k < 4; ++k) {
        float best = -INFINITY; int b = 0;
#pragma unroll
        for (int e = 0; e < 32; ++e) if (lg[e] > best) { best = lg[e]; b = e; }
#pragma unroll
        for (int e = 0; e < 32; ++e) if (e == b) lg[e] = -INFINITY;
        bi[k] = b; bv[k] = best;
    }
    float ex[4], es = 0.f;
#pragma unroll
    for (int k = 0; k < 4; ++k) { ex[k] = __expf(bv[k] - bv[0]); es += ex[k]; }
    if (lane == 0) {
#pragma unroll
        for (int k = 0; k < 4; ++k) {
            const unsigned pos = atomicAdd(&cnt[bi[k]], 1u);
            meta[MT_SEL_E + tok * 4 + k] = bi[k]; meta[MT_SEL_POS + tok * 4 + k] = (int)pos;
            ((float*)meta)[MT_SEL_G + tok * 4 + k] = ex[k] / es;
        }
    }
}

__global__ void k_dispatch1(const unsigned* cnt, int* meta) {
    __shared__ int ts[33];
    if (threadIdx.x == 0) { int acc = 0; for (int e = 0; e < 32; ++e) { ts[e] = acc; acc += ((int)cnt[e] + 255) >> 8; } ts[32] = acc; meta[MT_NT] = acc; }
    __syncthreads();
    if (threadIdx.x < 33) meta[MT_TSTART + threadIdx.x] = ts[threadIdx.x];
    for (int t = threadIdx.x; t < NT_MAX; t += blockDim.x) { int e = 0; for (int j = 1; j < 32; ++j) if (t >= ts[j]) e = j; meta[MT_TILE_E + t] = e; }
}
__global__ void k_rowinit(int* meta) {
    const int i = blockIdx.x * blockDim.x + threadIdx.x;
    if (i < NROWS_MAX) { meta[MT_ROW_TOK + i] = 0; ((float*)meta)[MT_ROW_GATE + i] = 0.f; }
}
__global__ void k_scatter(int* meta) {
    const int i = blockIdx.x * blockDim.x + threadIdx.x;
    if (i < T * 4) {
        const int e = meta[MT_SEL_E + i], row = meta[MT_TSTART + e] * 256 + meta[MT_SEL_POS + i];
        meta[MT_ROW_TOK + row] = i >> 2; ((float*)meta)[MT_ROW_GATE + row] = ((const float*)meta)[MT_SEL_G + i]; meta[MT_SLOT_ROW + i] = row;
    }
}

struct EpiGateUpN {
    const float* bg; const float* bu; bf16* HID;
    __device__ __forceinline__ void operator()(int row, int c, float a, float b) const {
        const float gt = fminf(a + bg[c], 7.0f), up = fminf(fmaxf(b + bu[c], -7.0f), 7.0f);
        const float hid = gt / (1.0f + __expf(-1.702f * gt)) * (up + 1.0f);
        HID[(size_t)row * DFF + c] = (bf16)f2bf(hid);
    }
};
__global__ void __launch_bounds__(256) k_gateup_naive(const bf16* HB, const int* meta, const float* w_gate, const float* b_gate, const float* w_up, const float* b_up, bf16* HID) {
    const int tile = blockIdx.x >> 2, sub = blockIdx.x & 3;
    if (tile >= meta[MT_NT]) return;
    const int e = meta[MT_TILE_E + tile];
    EpiGateUpN epi{b_gate + (size_t)e * DFF, b_up + (size_t)e * DFF, HID};
    naive_gemm_tile<2>(HB, D, meta + MT_ROW_TOK, tile * 256 + sub * 64, w_gate + (size_t)e * D * DFF, w_up + (size_t)e * D * DFF, DFF, blockIdx.y * 64, D, epi);
}
struct EpiDownN {
    const float* bd; const float* row_gate; bf16* Y;
    __device__ __forceinline__ void operator()(int row, int c, float a, float) const { Y[(size_t)row * D + c] = (bf16)f2bf((a + bd[c]) * row_gate[row]); }
};
__global__ void __launch_bounds__(256) k_down_naive(const bf16* HID, const int* meta, const float* w_down, const float* b_down, bf16* Y) {
    const int tile = blockIdx.x >> 2, sub = blockIdx.x & 3;
    if (tile >= meta[MT_NT]) return;
    const int e = meta[MT_TILE_E + tile];
    EpiDownN epi{b_down + (size_t)e * D, (const float*)meta + MT_ROW_GATE, Y};
    naive_gemm_tile<1>(HID, DFF, nullptr, tile * 256 + sub * 64, w_down + (size_t)e * DFF * D, nullptr, D, blockIdx.y * 64, DFF, epi);
}

__global__ void __launch_bounds__(256) k_final_naive(float* HO, const bf16* Y, const int* meta, const float* ln2_g, const float* ln2_b) {
    const int w = threadIdx.x >> 6, lane = threadIdx.x & 63;
    const int tok = blockIdx.x * 4 + w;
    f32x4* hr = (f32x4*)(HO + (size_t)tok * D) + lane;
    f32x4 v[4]; float s = 0.f;
#pragma unroll
    for (int j = 0; j < 4; ++j) v[j] = hr[64 * j] * ALPHA;
#pragma unroll
    for (int k = 0; k < 4; ++k) {
        const int row = meta[MT_SLOT_ROW + tok * 4 + k];
        const u32x2* yr = (const u32x2*)(Y + (size_t)row * D) + lane;
#pragma unroll
        for (int j = 0; j < 4; ++j) { const u32x2 y = yr[64 * j]; v[j].x += __uint_as_float(y.x << 16); v[j].y += __uint_as_float(y.x & 0xffff0000u); v[j].z += __uint_as_float(y.y << 16); v[j].w += __uint_as_float(y.y & 0xffff0000u); }
    }
#pragma unroll
    for (int j = 0; j < 4; ++j) s += (v[j].x + v[j].y) + (v[j].z + v[j].w);
    const float mean = wave_sum(s) * (1.f / D); float s2 = 0.f;
#pragma unroll
    for (int j = 0; j < 4; ++j) { v[j] = v[j] - mean; s2 += (v[j].x * v[j].x + v[j].y * v[j].y) + (v[j].z * v[j].z + v[j].w * v[j].w); }
    const float rstd = rsqrtf(wave_sum(s2) * (1.f / D) + LN_EPS);
#pragma unroll
    for (int j = 0; j < 4; ++j) { const int c0 = 4 * lane + 256 * j; const f32x4 gg = *(const f32x4*)(ln2_g + c0), bb = *(const f32x4*)(ln2_b + c0); hr[64 * j] = v[j] * rstd * gg + bb; }
}

#define LAS __attribute__((address_space(3)))
#define GAS __attribute__((address_space(1)))
typedef short bf16x8 __attribute__((ext_vector_type(8)));
typedef float f32x16 __attribute__((ext_vector_type(16)));
typedef float f32x2 __attribute__((ext_vector_type(2)));
__device__ __forceinline__ unsigned cvt_pk_bf16(float lo, float hi) { unsigned r; asm volatile("v_cvt_pk_bf16_f32 %0, %1, %2" : "=v"(r) : "v"(lo), "v"(hi)); return r; }
__device__ __forceinline__ float fast_gelu(float x) {
    const float u = -2.0f * 0.7978845608028654f * LOG2E * (x + 0.044715f * x * x * x);
    return x * __builtin_amdgcn_rcpf(1.0f + __builtin_amdgcn_exp2f(u));
}
__device__ __forceinline__ void st16_wt(void* p, u32x4 v) {
#ifdef USE_WT_STORE
    asm volatile("global_store_dwordx4 %0, %1, off sc1\n\ts_nop 1" :: "v"(p), "v"(v) : "memory");
#else
    *(u32x4*)p = v;
#endif
}
namespace pg8 {
constexpr int BM = 256, BK = 64, HALF = 128, HTB = HALF * BK * 2  , STAGE_BYTES = 8 * HTB, NXCD = 8, WGM = 8;
__host__ __device__ __forceinline__ int lds_byte(int r, int c) { const int st = (r >> 4) * 2 + (c >> 5), rr = r & 15, cc = c & 31, ob = rr * 64 + cc * 2; return st * 1024 + (ob ^ (((ob >> 9) & 1) << 5)); }
__host__ __device__ __forceinline__ void stage_rc(int b, int& R, int& C) { const int st = b / 1024, sb = b % 1024, swz = sb ^ (((sb >> 9) & 1) << 5); R = (st >> 1) * 16 + swz / 64; C = (st & 1) * 32 + (swz % 64) / 2; }
__host__ __device__ __forceinline__ int perm32(int rho) { const int n = rho >> 4, i = rho & 15; return 8 * (i >> 2) + 4 * n + (i & 3); }

struct Unit { int pm, pn; };
struct Gemm { const void* A; const void* Bt; int KB; const int* tile_e; unsigned e_stride; };
typedef int i32x4 __attribute__((ext_vector_type(4)));

struct StaticOrder {
    int nM, nN, nwg, G, c;
    __device__ void init(int nM_, int nN_, int G_, int c_) { nM = nM_; nN = nN_; nwg = nM * nN; G = G_; c = c_; }
    __device__ bool next(int i, Unit& u) const {
        const long L = (long)i * G + c; if (L >= nwg) return false;
        int wgid = (int)L; { const int q = nwg / NXCD, r = nwg % NXCD, xcd = wgid % NXCD, off = wgid / NXCD; wgid = (xcd < r ? xcd * (q + 1) : r * (q + 1) + (xcd - r) * q) + off; }
        const int nig = WGM * nN, gid = wgid / nig, fm = gid * WGM, gsz = (nM - fm) < WGM ? (nM - fm) : WGM;
        u.pm = fm + ((wgid % nig) % gsz); u.pn = (wgid % nig) / gsz; return true;
    }
};

template <class Epi, bool GATHER, bool ALIGN_EPI, bool I8>
__device__ __forceinline__ void gemm_phase(LAS unsigned char* lds, const LAS int* rtab, const Gemm g, const StaticOrder& S, const Epi& E) {
    int tid_ = threadIdx.x; asm volatile("" : "+v"(tid_));
    const int tid = tid_, wid = __builtin_amdgcn_readfirstlane(tid >> 6), lane = tid & 63, wr = wid >> 2, wc = wid & 3, fr = lane & 15, fq = lane >> 4;
    const int KB = g.KB, nt = KB / (BK * 2);
    int Rs[2], Cs[2]; unsigned voffB[2];
#pragma unroll
    for (int i = 0; i < 2; ++i) { int R, C; stage_rc(tid * 16 + i * 8192, R, C); const int Rb = Epi::PERM == 2 ? (64 * (R >> 5) + 16 * ((R >> 2) & 3) + 4 * ((R >> 4) & 1) + (R & 3)) : Epi::PERM ? ((R & ~31) + perm32(R & 31)) : R; Rs[i] = R; Cs[i] = C; voffB[i] = (unsigned)(Rb * KB + C * 2); }
    const size_t kstep = (size_t)(BK * 2);
    const size_t hstep = (size_t)HALF * KB;
    const size_t tstep = 2 * hstep;
    const size_t bhstep = Epi::PERM == 2 ? (size_t)8 * KB : hstep;
    const unsigned ldsw = (unsigned)wid * 1024u;
    const int aoff = lds_byte(wr * 64 + fr, fq * 8), boff = lds_byte(wc * 32 + fr, fq * 8);
#define PG8_SA(b, h) (((b) * 2 + (h)) * HTB)
#define PG8_SB(b, h) ((4 + (b) * 2 + (h)) * HTB)
#define PG8_STAGE(bufoff, gbase, voff) do { _Pragma("unroll") for (int _i = 0; _i < 2; ++_i) \
        __builtin_amdgcn_global_load_lds((const unsigned*)((const char*)(gbase) + (voff)[_i]), (LAS unsigned*)(lds + (bufoff) + ldsw + _i * 8192), 16, 0, 0); } while (0)
#define PG8_LDA(dst, b, h) do { _Pragma("unroll") for (int m = 0; m < 4; ++m) _Pragma("unroll") for (int k = 0; k < 2; ++k) dst[m][k] = *(const LAS bf16x8*)(lds + PG8_SA(b, h) + aoff + m * 2048 + k * 1024); } while (0)
#define PG8_LDB(dst, b, h) do { _Pragma("unroll") for (int n = 0; n < 2; ++n) _Pragma("unroll") for (int k = 0; k < 2; ++k) dst[n][k] = *(const LAS bf16x8*)(lds + PG8_SB(b, h) + boff + n * 2048 + k * 1024); } while (0)
#define PG8_MMA(ai, bj, At, Bt) do { __builtin_amdgcn_s_setprio(1); _Pragma("unroll") for (int m = 0; m < 4; ++m) _Pragma("unroll") for (int n = 0; n < 2; ++n) _Pragma("unroll") for (int k = 0; k < 2; ++k) \
        { if constexpr (I8) acc[ai][bj][m][n] = __builtin_bit_cast(f32x4, __builtin_amdgcn_mfma_i32_16x16x64_i8(__builtin_bit_cast(i32x4, Bt[n][k]), __builtin_bit_cast(i32x4, At[m][k]), __builtin_bit_cast(i32x4, acc[ai][bj][m][n]), 0, 0, 0)); \
          else acc[ai][bj][m][n] = __builtin_amdgcn_mfma_f32_16x16x32_bf16(Bt[n][k], At[m][k], acc[ai][bj][m][n], 0, 0, 0); } __builtin_amdgcn_s_setprio(0); } while (0)
#define PG8_WAIT_V(n) asm volatile("s_waitcnt vmcnt(" #n ")" ::: "memory")
#define PG8_WAIT_L(n) asm volatile("s_waitcnt lgkmcnt(" #n ")" ::: "memory")
#define PG8_BAR __builtin_amdgcn_s_barrier()
#define PG8_SCHED __builtin_amdgcn_sched_barrier(0)
#define PG8_VOFFA(vo, ui_, u_) do { _Pragma("unroll") for (int h_ = 0; h_ < 2; ++h_) _Pragma("unroll") for (int i_ = 0; i_ < 2; ++i_) { \
        const int row_ = GATHER ? rtab[(ui_) * 256 + h_ * 128 + Rs[i_]] : ((u_).pm * 256 + h_ * 128 + Rs[i_]); \
        vo[h_][i_] = (unsigned)(row_ * KB + Cs[i_] * 2); } } while (0)
#define PG8_BBASE(u_) ((const char*)g.Bt + (g.tile_e ? (size_t)g.tile_e[(u_).pm] * g.e_stride : (size_t)0) + (size_t)(u_).pn * tstep)
    Unit cur, nxt; int ui = 0;
    if (!S.next(0, cur)) return;
    f32x4 acc[2][2][4][2];
#pragma unroll
    for (int a = 0; a < 2; ++a)
#pragma unroll
        for (int b = 0; b < 2; ++b)
#pragma unroll
            for (int m = 0; m < 4; ++m)
#pragma unroll
                for (int n = 0; n < 2; ++n) acc[a][b][m][n] = (f32x4){0.f, 0.f, 0.f, 0.f};
    bf16x8 At[4][2], B0[2][2], B1[2][2];
    unsigned vAc[2][2], vAn[2][2];
    PG8_VOFFA(vAc, 0, cur);
    const char* const gA = (const char*)g.A;
    const char* cB = PG8_BBASE(cur);
    PG8_STAGE(PG8_SB(0, 0), cB, voffB); PG8_STAGE(PG8_SB(0, 1), cB + bhstep, voffB); PG8_STAGE(PG8_SA(0, 0), gA, vAc[0]); PG8_STAGE(PG8_SA(0, 1), gA, vAc[1]);
    if (wr == 1) PG8_BAR;
    PG8_WAIT_V(2); PG8_BAR;
    PG8_STAGE(PG8_SB(1, 0), cB + kstep, voffB); PG8_STAGE(PG8_SA(1, 0), gA + kstep, vAc[0]); PG8_STAGE(PG8_SB(1, 1), cB + bhstep + kstep, voffB);
    PG8_WAIT_V(6); PG8_BAR;
    for (;;) {
        const bool has_next = S.next(ui + 1, nxt);
        const char* nB = cB;
        if (has_next) { nB = PG8_BBASE(nxt); PG8_VOFFA(vAn, ui + 1, nxt); }
        else {
#pragma unroll
            for (int h = 0; h < 2; ++h)
#pragma unroll
                for (int i = 0; i < 2; ++i) vAn[h][i] = vAc[h][i];
        }
        for (int t = 0; t < nt; t += 2) {
            const bool last = (t == nt - 2);
            const char* a1 = gA + (size_t)(t + 1) * kstep;
            const char* a2 = last ? gA : gA + (size_t)(t + 2) * kstep; const char* b2 = last ? nB : cB + (size_t)(t + 2) * kstep;
            const char* a3 = a2 + kstep; const char* b3 = b2 + kstep;
            unsigned v2[2][2];
#pragma unroll
            for (int h = 0; h < 2; ++h)
#pragma unroll
                for (int i = 0; i < 2; ++i) v2[h][i] = last ? vAn[h][i] : vAc[h][i];
            PG8_LDB(B0, 0, 0); PG8_LDB(B1, 0, 1); PG8_SCHED; PG8_LDA(At, 0, 0); PG8_STAGE(PG8_SA(1, 1), a1, vAc[1]);
            PG8_WAIT_V(8); PG8_WAIT_L(0); PG8_BAR; PG8_MMA(0, 0, At, B0); PG8_MMA(0, 1, At, B1); PG8_BAR; PG8_SCHED;
            PG8_LDA(At, 0, 1); PG8_STAGE(PG8_SB(0, 0), b2, voffB); PG8_STAGE(PG8_SB(0, 1), b2 + bhstep, voffB); PG8_STAGE(PG8_SA(0, 0), a2, v2[0]);
            PG8_WAIT_V(8); PG8_WAIT_L(0); PG8_BAR; PG8_MMA(1, 0, At, B0); PG8_MMA(1, 1, At, B1); PG8_BAR; PG8_SCHED;
            PG8_LDB(B0, 1, 0); PG8_LDB(B1, 1, 1); PG8_SCHED; PG8_LDA(At, 1, 0); PG8_STAGE(PG8_SA(0, 1), a2, v2[1]);
            PG8_WAIT_V(8); PG8_WAIT_L(0); PG8_BAR; PG8_MMA(0, 0, At, B0); PG8_MMA(0, 1, At, B1); PG8_BAR; PG8_SCHED;
            PG8_LDA(At, 1, 1); PG8_STAGE(PG8_SB(1, 0), b3, voffB); PG8_STAGE(PG8_SB(1, 1), b3 + bhstep, voffB); PG8_STAGE(PG8_SA(1, 0), a3, v2[0]);
            PG8_WAIT_V(8); PG8_WAIT_L(0); PG8_BAR; PG8_MMA(1, 0, At, B0); PG8_MMA(1, 1, At, B1); PG8_BAR; PG8_SCHED;
        }
        if constexpr (ALIGN_EPI) { if (wr == 0) PG8_BAR; }
        E(acc, cur, wr, wc, fr, fq);
        if (!has_next) break;
#pragma unroll
        for (int a = 0; a < 2; ++a)
#pragma unroll
            for (int b = 0; b < 2; ++b)
#pragma unroll
                for (int m = 0; m < 4; ++m)
#pragma unroll
                    for (int n = 0; n < 2; ++n) acc[a][b][m][n] = (f32x4){0.f, 0.f, 0.f, 0.f};
        cur = nxt; cB = nB; ++ui;
#pragma unroll
        for (int h = 0; h < 2; ++h)
#pragma unroll
            for (int i = 0; i < 2; ++i) vAc[h][i] = vAn[h][i];
        if constexpr (ALIGN_EPI) { if (wr == 1) PG8_BAR; }
    }
    PG8_WAIT_V(0);
    if constexpr (!ALIGN_EPI) { if (wr == 0) PG8_BAR; }
    PG8_BAR;
#undef PG8_SA
#undef PG8_SB
#undef PG8_STAGE
#undef PG8_LDA
#undef PG8_LDB
#undef PG8_MMA
#undef PG8_WAIT_V
#undef PG8_WAIT_L
#undef PG8_BAR
#undef PG8_SCHED
#undef PG8_VOFFA
#undef PG8_BBASE
}

struct EpiInProj {
    static constexpr int PERM = 1;
    const float* b_in; bf16 *QB, *KB, *VT, *UB, *GB;
    __device__ __forceinline__ void operator()(const f32x4 (&acc)[2][2][4][2], const Unit& u, int wr, int wc, int fr, int fq) const {
        const int row0 = u.pm * BM + wr * 64 + fr;
#pragma unroll
        for (int bj = 0; bj < 2; ++bj) {
            const int reg = u.pn * BM + bj * HALF;
            const int c0 = reg + wc * 32 + 8 * fq;
            const f32x4 bv0 = *(const f32x4*)(b_in + c0), bv1 = *(const f32x4*)(b_in + c0 + 4);
#pragma unroll
            for (int ai = 0; ai < 2; ++ai)
#pragma unroll
                for (int m = 0; m < 4; ++m) {
                    const int row = row0 + ai * HALF + m * 16;
                    f32x4 v0 = acc[ai][bj][m][0] + bv0, v1 = acc[ai][bj][m][1] + bv1;
                    if (reg >= 640 && reg < 768) {
                        const int cv = c0 - 640, gg = cv >> 6, d = cv & 63, b = row / SEQ, s = row % SEQ;
                        bf16* vp = VT + ((size_t)((b * 2 + gg) * 64 + d)) * SEQ + s;
#pragma unroll
                        for (int j = 0; j < 4; ++j) { vp[(size_t)j * SEQ] = (bf16)f2bf(v0[j]); vp[(size_t)(j + 4) * SEQ] = (bf16)f2bf(v1[j]); }
                    } else {
                        bf16* dst;
                        if (reg < 512) { v0 = v0 * C2; v1 = v1 * C2; dst = QB + (size_t)row * 512 + c0; }
                        else if (reg < 640) { dst = KB + (size_t)row * 128 + (c0 - 512); }
                        else {
#pragma unroll
                            for (int j = 0; j < 4; ++j) { v0[j] = fast_gelu(v0[j]); v1[j] = fast_gelu(v1[j]); }
                            dst = (reg < 1280) ? (UB + (size_t)row * 512 + (c0 - 768)) : (GB + (size_t)row * 512 + (c0 - 1280));
                        }
                        u32x4 w; w.x = cvt_pk_bf16(v0[0], v0[1]); w.y = cvt_pk_bf16(v0[2], v0[3]); w.z = cvt_pk_bf16(v1[0], v1[1]); w.w = cvt_pk_bf16(v1[2], v1[3]);
                        *(u32x4*)dst = w;
                    }
                }
        }
    }
};
struct EpiOutProj {
    static constexpr int PERM = 0;
    const float* x; const float* b_out; float* Z;
    __device__ __forceinline__ void operator()(const f32x4 (&acc)[2][2][4][2], const Unit& u, int wr, int wc, int fr, int fq) const {
        const int col0 = u.pn * BM + wc * 32 + 4 * fq;
#pragma unroll
        for (int ai = 0; ai < 2; ++ai)
#pragma unroll
            for (int m = 0; m < 4; ++m) {
                const size_t off = (size_t)(u.pm * BM + ai * HALF + wr * 64 + m * 16 + fr) * D + col0;
#pragma unroll
                for (int bj = 0; bj < 2; ++bj)
#pragma unroll
                    for (int n = 0; n < 2; ++n) {
                        const f32x4 xv = *(const f32x4*)(x + off + bj * HALF + n * 16), bv = *(const f32x4*)(b_out + col0 + bj * HALF + n * 16);
                        *(f32x4*)(Z + off + bj * HALF + n * 16) = xv * ALPHA + acc[ai][bj][m][n] + bv;
                    }
            }
    }
};
struct EpiSwiglu {
    static constexpr int PERM = 1;
    const int* tile_e; const float* b_gate; const float* b_up; const float* swgu; const float* row_sa; bf16* HID;
    __device__ __forceinline__ void operator()(const f32x4 (&acc)[2][2][4][2], const Unit& u, int wr, int wc, int fr, int fq) const {
        const int e = tile_e[u.pm];
        const int fc0 = u.pn * HALF + wc * 32 + 8 * fq;
        const float* sw = swgu + e * 2048 + u.pn * 256 + wc * 32 + 8 * fq;
        float sa[2][4];
#pragma unroll
        for (int ai = 0; ai < 2; ++ai)
#pragma unroll
            for (int m = 0; m < 4; ++m) sa[ai][m] = row_sa[u.pm * BM + ai * HALF + wr * 64 + m * 16 + fr];
        f32x4 gb[2], ub[2], sg[2], su[2];
#pragma unroll
        for (int n = 0; n < 2; ++n) { gb[n] = *(const f32x4*)(b_gate + e * DFF + fc0 + 4 * n); ub[n] = *(const f32x4*)(b_up + e * DFF + fc0 + 4 * n); sg[n] = *(const f32x4*)(sw + 4 * n); su[n] = *(const f32x4*)(sw + 128 + 4 * n); }
#pragma unroll
        for (int ai = 0; ai < 2; ++ai)
#pragma unroll
            for (int m = 0; m < 4; ++m) {
                const int row = u.pm * BM + ai * HALF + wr * 64 + m * 16 + fr;
                float hv[8];
#pragma unroll
                for (int n = 0; n < 2; ++n)
#pragma unroll
                    for (int j = 0; j < 4; ++j) {
                        const float ga = (float)__float_as_int(acc[ai][0][m][n][j]) * (sa[ai][m] * sg[n][j]) + gb[n][j];
                        const float ua = (float)__float_as_int(acc[ai][1][m][n][j]) * (sa[ai][m] * su[n][j]) + ub[n][j];
                        const float gt = fminf(ga, 7.0f), up = __builtin_amdgcn_fmed3f(ua, -7.0f, 7.0f);
                        hv[4 * n + j] = gt * __builtin_amdgcn_rcpf(1.0f + __builtin_amdgcn_exp2f(-1.702f * LOG2E * gt)) * (up + 1.0f);
                    }
                u32x4 w; w.x = cvt_pk_bf16(hv[0], hv[1]); w.y = cvt_pk_bf16(hv[2], hv[3]); w.z = cvt_pk_bf16(hv[4], hv[5]); w.w = cvt_pk_bf16(hv[6], hv[7]);
                *(u32x4*)(HID + (size_t)row * DFF + fc0) = w;
            }
    }
};
struct EpiDown {
    static constexpr int PERM = 2;
    const int* tile_e; const float* b_down; const float* swd; const float* row_sb; const float* row_gate; unsigned char* Y;
    __device__ __forceinline__ void operator()(const f32x4 (&acc)[2][2][4][2], const Unit& u, int wr, int wc, int fr, int fq) const {
        const int e = tile_e[u.pm];
        const int c0 = u.pn * BM + wc * 64 + 16 * fq;
        f32x4 bv[2][2], sw[2][2];
#pragma unroll
        for (int bj = 0; bj < 2; ++bj)
#pragma unroll
            for (int n = 0; n < 2; ++n) { bv[bj][n] = *(const f32x4*)(b_down + e * D + c0 + 8 * bj + 4 * n); sw[bj][n] = *(const f32x4*)(swd + e * D + c0 + 8 * bj + 4 * n); }
#pragma unroll
        for (int ai = 0; ai < 2; ++ai)
#pragma unroll
            for (int m = 0; m < 4; ++m) {
                const int row = u.pm * BM + ai * HALF + wr * 64 + m * 16 + fr;
                const float gt = row_gate[row] * YSCALE, sb = row_sb[row] * gt;
                u32x4 w;
#pragma unroll
                for (int bj = 0; bj < 2; ++bj)
#pragma unroll
                    for (int n = 0; n < 2; ++n) {
                        float v[4];
#pragma unroll
                        for (int j = 0; j < 4; ++j) v[j] = __builtin_amdgcn_fmed3f((float)__float_as_int(acc[ai][bj][m][n][j]) * (sb * sw[bj][n][j]) + bv[bj][n][j] * gt, -448.0f, 448.0f);
                        int d = 0;
                        d = __builtin_amdgcn_cvt_pk_fp8_f32(v[0], v[1], d, false);
                        d = __builtin_amdgcn_cvt_pk_fp8_f32(v[2], v[3], d, true);
                        w[2 * bj + n] = (unsigned)d;
                    }
                *(u32x4*)(Y + (size_t)row * D + c0) = w;
            }
    }
};
}
constexpr int NWAVES = 8;
constexpr int NPHASES = 10;
constexpr size_t WS_WIN = WS_HID + 144 * MiB;
constexpr size_t WS_WOUT = WS_WIN + 4 * MiB;
constexpr size_t WS_WGU = WS_WOUT + 2 * MiB;
constexpr size_t WS_SWGU = WS_WGU + 64 * MiB;
constexpr size_t WS_WD = WS_SWGU + 1 * MiB;
constexpr size_t WS_SWD = WS_WD + 32 * MiB;
constexpr size_t WS_HID8 = WS_SWD + 1 * MiB;
constexpr size_t WS_END = WS_HID8 + 72 * MiB;
constexpr int CW_BAR = 4096;
constexpr int RING_BYTES = 131072;
constexpr int RTAB_OFF = RING_BYTES;
constexpr int RTAB_UNITS = 12;
constexpr int RW_BYTES = 1024 * 144;
constexpr int RSCR_OFF = RW_BYTES;
constexpr int LDS_BYTES = 163840;
constexpr int MISC_OFF = LDS_BYTES - 256;
static_assert(RTAB_OFF + RTAB_UNITS * 1024 <= MISC_OFF && RSCR_OFF + 4096 <= MISC_OFF, "LDS map");

typedef GAS unsigned gu32;
#define RLX_AGENT __ATOMIC_RELAXED, __HIP_MEMORY_SCOPE_AGENT
#define LDS_WAIT() asm volatile("s_waitcnt lgkmcnt(0)" ::: "memory")
#define VM_WAIT() asm volatile("s_waitcnt vmcnt(0)" ::: "memory")

#define XB_TMO      128
#define XB_XCNT(j)  (256  + 64 * (j))
#define XB_XSUB(j)  (1280 + 64 * (j))
#define XB_XGEN(j)  (2304 + 64 * (j))
#define XB_TOP      3328
#define XB_TOPGEN   3392
#define XCD_BAR_WORDS 3456
#define XB_SPIN_CAP (1u << 18)
__device__ __forceinline__ unsigned xb_ld(unsigned* p)              { return __hip_atomic_load(p, __ATOMIC_RELAXED, __HIP_MEMORY_SCOPE_AGENT); }
__device__ __forceinline__ unsigned xb_add(unsigned* p, unsigned v) { return __hip_atomic_fetch_add(p, v, __ATOMIC_RELAXED, __HIP_MEMORY_SCOPE_AGENT); }
__device__ __forceinline__ unsigned xb_xcc_id() { return (unsigned)__builtin_amdgcn_s_getreg((3 << 11) | 20) & 0xFu; }
#define XB_SPIN(cond, bar) do { unsigned _sp = 0; while (cond) { __builtin_amdgcn_s_sleep(1); \
    if ((++_sp & 255u) == 0u) { if (xb_ld(&(bar)[XB_TMO])) break; if (_sp > XB_SPIN_CAP) { atomicAdd(&(bar)[XB_TMO], 1u); break; } } } } while (0)
struct XcdBarrier { unsigned* bar; unsigned x; volatile LAS unsigned* st; };
__device__ __forceinline__ XcdBarrier xcd_barrier_post(unsigned* bar, volatile LAS unsigned* st) {
    XcdBarrier b; b.bar = bar; b.x = xb_xcc_id(); b.st = st;
    if (threadIdx.x == 0) (void)xb_add(&bar[XB_XCNT(b.x)], 1u);
    return b;
}
__device__ __forceinline__ void xcd_barrier_complete(unsigned* bar, unsigned x, unsigned& nloc, unsigned& nx) {
    const unsigned G = gridDim.x * gridDim.y * gridDim.z;
    unsigned sum, cnt, mine, sp = 0u;
    for (;;) {
        sum = 0u; cnt = 0u; mine = 0u;
#pragma unroll
        for (unsigned j = 0; j < 16; ++j) { const unsigned c = xb_ld(&bar[XB_XCNT(j)]); sum += c; cnt += (c > 0u) ? 1u : 0u; mine = (j == x) ? c : mine; }
        if (sum == G) break;
        __builtin_amdgcn_s_sleep(1);
        if ((++sp & 255u) == 0u) { if (xb_ld(&bar[XB_TMO])) break; if (sp > XB_SPIN_CAP) { atomicAdd(&bar[XB_TMO], 1u); break; } }
    }
    nloc = mine > 0u ? mine : 1u; nx = cnt > 0u ? cnt : 1u;
}
__device__ __forceinline__ void xcd_barrier(const XcdBarrier& b) {
    asm volatile("s_waitcnt vmcnt(0)" ::: "memory");
    __syncthreads();
    if (threadIdx.x == 0) {
        unsigned* bar = b.bar;
        __builtin_amdgcn_s_waitcnt(0);
        unsigned nloc = b.st[0], nx = b.st[1];
        if (nloc == 0u) { xcd_barrier_complete(bar, b.x, nloc, nx); b.st[0] = nloc; b.st[1] = nx; }
        const unsigned old = xb_add(&bar[XB_XSUB(b.x)], 1u);
        const unsigned gen = old / nloc;
        if (old + 1u == (gen + 1u) * nloc) {
            __builtin_amdgcn_fence(__ATOMIC_RELEASE, "agent");
            asm volatile("s_waitcnt vmcnt(0)" ::: "memory");
            const unsigned og = xb_add(&bar[XB_TOP], 1u);
            const unsigned tg = og / nx;
            if (og + 1u == (tg + 1u) * nx) xb_add(&bar[XB_TOPGEN], 1u);
            else XB_SPIN(xb_ld(&bar[XB_TOPGEN]) == tg, bar);
            __builtin_amdgcn_fence(__ATOMIC_ACQUIRE, "agent");
            xb_add(&bar[XB_XGEN(b.x)], 1u);
            asm volatile("s_waitcnt vmcnt(0)" ::: "memory");
        } else {
            XB_SPIN(xb_ld(&bar[XB_XGEN(b.x)]) == gen, bar);
            __builtin_amdgcn_fence(__ATOMIC_ACQUIRE, "agent");
            asm volatile("s_waitcnt vmcnt(0)" ::: "memory");
        }
    }
    __syncthreads();
}

struct Args {
    const float* in[22]; float* out; unsigned char* ws; int ph_lo, ph_hi, li, pad;
};
struct Frame {
    LAS unsigned char* lds;
    int tid, lane, wave, vcu, G;
};
__device__ __forceinline__ void p0_item(const float* W, int N, bf16* WT, int K, int dst_row0, int k0, int n0, LAS float* scr, int lane) {
    f32x4 v[8];
#pragma unroll
    for (int i = 0; i < 8; ++i) v[i] = *(const f32x4*)(W + (size_t)(k0 + (lane >> 3) + 8 * i) * N + n0 + 4 * (lane & 7));
#pragma unroll
    for (int i = 0; i < 8; ++i) { LAS float* s = scr + ((lane >> 3) + 8 * i) * 33 + 4 * (lane & 7); s[0] = v[i].x; s[1] = v[i].y; s[2] = v[i].z; s[3] = v[i].w; }
    LDS_WAIT(); asm volatile("" ::: "memory");
    const int c = lane & 7;
#pragma unroll
    for (int j = 0; j < 4; ++j) { const int n = (lane >> 3) + 8 * j; const LAS float* s = scr + (8 * c) * 33 + n;
        u32x4 o; o.x = pk2(s[0 * 33], s[1 * 33]); o.y = pk2(s[2 * 33], s[3 * 33]); o.z = pk2(s[4 * 33], s[5 * 33]); o.w = pk2(s[6 * 33], s[7 * 33]);
        *(u32x4*)(WT + (size_t)(dst_row0 + n) * K + k0 + 8 * c) = o; }
    LDS_WAIT(); asm volatile("" ::: "memory");
}
struct ConvItem { const float* W; signed char* dst; float* sc; int n0, dst_row0; };
__device__ __forceinline__ ConvItem conv_decode(const Args& a, int it) {
    unsigned char* ws = a.ws;
    const int nb = it & 31, e = (it >> 5) & 31, kind = it >> 10, n0 = nb * 32;
    ConvItem c;
    c.W = (kind == 0 ? a.in[14] : kind == 1 ? a.in[16] : a.in[18]) + (size_t)e * D * DFF;
    c.dst = kind < 2 ? (signed char*)(ws + WS_WGU) + (size_t)e * 2048 * 1024 : (signed char*)(ws + WS_WD) + (size_t)e * 1024 * 1024;
    c.dst_row0 = kind < 2 ? (n0 >> 7) * 256 + kind * 128 + (n0 & 127) : n0;
    c.sc = kind < 2 ? (float*)(ws + WS_SWGU) + e * 2048 : (float*)(ws + WS_SWD) + e * 1024;
    c.n0 = n0; return c;
}
#define CONV_LOAD(v, ci) do { _Pragma("unroll") for (int i_ = 0; i_ < 4; ++i_) _Pragma("unroll") for (int j_ = 0; j_ < 4; ++j_) \
        v[i_][j_] = *(const f32x4*)((ci).W + (size_t)(4 * (kl + 64 * i_) + j_) * DFF + (ci).n0 + 4 * n4); } while (0)
__device__ __forceinline__ void conv_items(const Frame& F, const Args& a, int it_lo, int it_hi) {
    if (it_hi > 3 * NEXP * 32) it_hi = 3 * NEXP * 32;
    if (it_lo >= it_hi) return;
    const int tid = F.tid, n4 = tid & 7, kl = tid >> 3;
    LAS unsigned* tile = (LAS unsigned*)F.lds;
    LAS float* red = (LAS float*)(F.lds + 36864);
    f32x4 v[4][4];
    ConvItem cur = conv_decode(a, it_lo);
    CONV_LOAD(v, cur);
    for (int it = it_lo; it < it_hi; ++it) {
        f32x4 am = (f32x4){0.f, 0.f, 0.f, 0.f};
#pragma unroll
        for (int i = 0; i < 4; ++i)
#pragma unroll
            for (int j = 0; j < 4; ++j) { am.x = fmaxf(am.x, fabsf(v[i][j].x)); am.y = fmaxf(am.y, fabsf(v[i][j].y)); am.z = fmaxf(am.z, fabsf(v[i][j].z)); am.w = fmaxf(am.w, fabsf(v[i][j].w)); }
#pragma unroll
        for (int o = 8; o < 64; o <<= 1) { am.x = fmaxf(am.x, __shfl_xor(am.x, o)); am.y = fmaxf(am.y, __shfl_xor(am.y, o)); am.z = fmaxf(am.z, __shfl_xor(am.z, o)); am.w = fmaxf(am.w, __shfl_xor(am.w, o)); }
        if (F.lane < 8) *(LAS f32x4*)(red + F.wave * 32 + 4 * n4) = am;
        __syncthreads();
        f32x4 cm = *(const LAS f32x4*)(red + 4 * n4);
#pragma unroll
        for (int w = 1; w < 8; ++w) { const f32x4 o = *(const LAS f32x4*)(red + w * 32 + 4 * n4); cm.x = fmaxf(cm.x, o.x); cm.y = fmaxf(cm.y, o.y); cm.z = fmaxf(cm.z, o.z); cm.w = fmaxf(cm.w, o.w); }
        f32x4 inv;
#pragma unroll
        for (int c = 0; c < 4; ++c) inv[c] = cm[c] > 0.f ? 127.0f / cm[c] : 0.f;
        if (kl == 0) {
#pragma unroll
            for (int c = 0; c < 4; ++c) cur.sc[cur.dst_row0 + 4 * n4 + c] = cm[c] * (1.0f / 127.0f);
        }
#pragma unroll
        for (int i = 0; i < 4; ++i)
#pragma unroll
            for (int c = 0; c < 4; ++c) {
                unsigned d = 0u;
#pragma unroll
                for (int j = 0; j < 4; ++j) { const int q = (int)rintf(v[i][j][c] * inv[c]); d |= ((unsigned)q & 0xffu) << (8 * j); }
                tile[(4 * n4 + c) * 260 + kl + 64 * i] = d;
            }
        const ConvItem done = cur;
        if (it + 1 < it_hi) { cur = conv_decode(a, it + 1); CONV_LOAD(v, cur); }
        __syncthreads();
#pragma unroll
        for (int j = 0; j < 4; ++j) { const int ch = tid + 512 * j, n = ch >> 6, c16 = ch & 63;
            *(u32x4*)(done.dst + (size_t)(done.dst_row0 + n) * 1024 + 16 * c16) = *(const LAS u32x4*)(tile + n * 260 + 4 * c16); }
        __syncthreads();
    }
}
__device__ __forceinline__ void p0_prologue(const Frame& F, const Args& a) {
    unsigned char* ws = a.ws;
    bf16* Win_t = (bf16*)(ws + WS_WIN); bf16* Wout_t = (bf16*)(ws + WS_WOUT);
    LAS float* scr = (LAS float*)(F.lds + F.wave * 8448);
    const int gw = F.vcu * NWAVES + F.wave, NGW = F.G * NWAVES;
    constexpr int I_IN = 16 * 56, I_OUT = 16 * 32, NITEMS = I_IN + I_OUT;
    for (int it = gw; it < NITEMS; it += NGW) {
        int r = it;
        if (r < I_IN) { const int kb = r / 56, nb = r % 56; p0_item(a.in[1], INW, Win_t, D, nb * 32, kb * 64, nb * 32, scr, F.lane); continue; } r -= I_IN;
        { const int kb = r / 32, nb = r % 32; p0_item(a.in[8], D, Wout_t, D, nb * 32, kb * 64, nb * 32, scr, F.lane); }
    }
    const float* x = a.in[0]; bf16* XB = (bf16*)(ws + WS_XB);
    for (int m = gw; m < T; m += NGW) {
        const f32x4* xr = (const f32x4*)(x + (size_t)m * D) + F.lane; u32x2* o = (u32x2*)(XB + (size_t)m * D) + F.lane;
        f32x4 v[4];
#pragma unroll
        for (int j = 0; j < 4; ++j) v[j] = xr[64 * j];
#pragma unroll
        for (int j = 0; j < 4; ++j) { u32x2 w; w.x = pk2(v[j].x, v[j].y); w.y = pk2(v[j].z, v[j].w); o[64 * j] = w; }
    }
}

__device__ __forceinline__ int crow(int r, int hi) { return (r & 3) + 8 * (r >> 2) + 4 * hi; }
constexpr int AT_KROW = 144, AT_KG = 192 * AT_KROW, AT_VROW = 400, AT_VG = 64 * AT_VROW, AT_VOFF = 2 * AT_KG;
__device__ __forceinline__ void attn_wave_unit(const LAS unsigned char* lds, const bf16* QB, const float* sinks, bf16* CAT, int tok0, int u, int h, int lane) {
    const int r32 = lane & 31, hi = lane >> 5;
    const int t0 = tok0 % SEQ, g = h >> 2;
    const int kk0 = 32 * u;
    bf16x8 qf[4];
#pragma unroll
    for (int d0 = 0; d0 < 4; ++d0) qf[d0] = *(const bf16x8*)(QB + (size_t)(tok0 + r32) * 512 + h * 64 + d0 * 16 + hi * 8);
    f32x16 p[5];
    const float NEG = -INFINITY;
    const LAS unsigned char* kl = lds + g * AT_KG + (kk0 + r32) * AT_KROW + hi * 16;
#pragma unroll
    for (int j = 0; j < 5; ++j) {
        const int kb = t0 - 128 + 32 * j;
        f32x16 s;
#pragma unroll
        for (int r = 0; r < 16; ++r) s[r] = 0.f;
        if (kb >= 0) {
#pragma unroll
            for (int d0 = 0; d0 < 4; ++d0) { const bf16x8 kf = *(const LAS bf16x8*)(kl + j * 32 * AT_KROW + d0 * 32); s = __builtin_amdgcn_mfma_f32_32x32x16_bf16(kf, qf[d0], s, 0, 0, 0); }
            if (j == 0) {
#pragma unroll
                for (int r = 0; r < 16; ++r) if (!(crow(r, hi) > r32)) s[r] = NEG;
            }
            if (j == 4) {
#pragma unroll
                for (int r = 0; r < 16; ++r) if (!(crow(r, hi) <= r32)) s[r] = NEG;
            }
        } else {
#pragma unroll
            for (int r = 0; r < 16; ++r) s[r] = NEG;
        }
        p[j] = s;
    }
    const float sk = sinks[h] * LOG2E;
    float m = sk;
#pragma unroll
    for (int j = 0; j < 5; ++j)
#pragma unroll
        for (int r = 0; r < 16; ++r) m = fmaxf(m, p[j][r]);
    m = fmaxf(m, __shfl_xor(m, 32));
    float l = 0.f;
#pragma unroll
    for (int j = 0; j < 5; ++j)
#pragma unroll
        for (int r = 0; r < 16; ++r) { const float e = __builtin_amdgcn_exp2f(p[j][r] - m); p[j][r] = e; l += e; }
    l += __shfl_xor(l, 32);
    l += __builtin_amdgcn_exp2f(sk - m);
    const float inv = 1.0f / l;
    u32x4 pb[5][2];
#pragma unroll
    for (int j = 0; j < 5; ++j)
#pragma unroll
        for (int s = 0; s < 2; ++s) { pb[j][s].x = cvt_pk_bf16(p[j][8 * s + 0], p[j][8 * s + 1]); pb[j][s].y = cvt_pk_bf16(p[j][8 * s + 2], p[j][8 * s + 3]); pb[j][s].z = cvt_pk_bf16(p[j][8 * s + 4], p[j][8 * s + 5]); pb[j][s].w = cvt_pk_bf16(p[j][8 * s + 6], p[j][8 * s + 7]); }
#pragma unroll
    for (int db = 0; db < 2; ++db) {
        f32x16 o;
#pragma unroll
        for (int r = 0; r < 16; ++r) o[r] = 0.f;
        const LAS unsigned char* vl = lds + AT_VOFF + g * AT_VG + (db * 32 + r32) * AT_VROW + (kk0 + 4 * hi) * 2;
#pragma unroll
        for (int j = 0; j < 5; ++j) {
            const int kb = t0 - 128 + 32 * j;
            if (kb >= 0) {
#pragma unroll
                for (int s = 0; s < 2; ++s) {
                    const u32x2 lo = *(const LAS u32x2*)(vl + (32 * j + 16 * s) * 2), hh = *(const LAS u32x2*)(vl + (32 * j + 16 * s + 8) * 2);
                    u32x4 av; av.x = lo.x; av.y = lo.y; av.z = hh.x; av.w = hh.y;
                    o = __builtin_amdgcn_mfma_f32_32x32x16_bf16(__builtin_bit_cast(bf16x8, av), __builtin_bit_cast(bf16x8, pb[j][s]), o, 0, 0, 0);
                }
            }
        }
        bf16* op = CAT + (size_t)(tok0 + r32) * 1024 + h * 64 + db * 32 + 4 * hi;
#pragma unroll
        for (int gq = 0; gq < 4; ++gq) { u32x2 w; w.x = cvt_pk_bf16(o[4 * gq] * inv, o[4 * gq + 1] * inv); w.y = cvt_pk_bf16(o[4 * gq + 2] * inv, o[4 * gq + 3] * inv); *(u32x2*)(op + 8 * gq) = w; }
    }
}
__device__ __forceinline__ void attn_block(const Frame& F, const bf16* QB, const bf16* KB, const bf16* VT, const float* sinks, bf16* CAT, int qq) {
    const int tokb = qq * 64, b = tokb / SEQ, tb = tokb % SEQ, kbase = tb - 128;
    u32x4 kv[6], vv[6];
#pragma unroll
    for (int i = 0; i < 6; ++i) {
        const int c = F.tid + 512 * i, g = c / 1536, rem = c % 1536;
        { const int key = rem >> 3, ch = rem & 7, pos = kbase + key;
          kv[i] = pos >= 0 ? *(const u32x4*)(KB + (size_t)(b * SEQ + pos) * 128 + g * 64 + ch * 8) : (u32x4){0u, 0u, 0u, 0u}; }
        { const int d = rem / 24, ch = rem % 24, pos = kbase + ch * 8;
          vv[i] = pos >= 0 ? *(const u32x4*)(VT + ((size_t)((b * 2 + g) * 64 + d)) * SEQ + pos) : (u32x4){0u, 0u, 0u, 0u}; }
    }
#pragma unroll
    for (int i = 0; i < 6; ++i) {
        const int c = F.tid + 512 * i, g = c / 1536, rem = c % 1536;
        *(LAS u32x4*)(F.lds + g * AT_KG + (rem >> 3) * AT_KROW + (rem & 7) * 16) = kv[i];
        *(LAS u32x4*)(F.lds + AT_VOFF + g * AT_VG + (rem / 24) * AT_VROW + (rem % 24) * 16) = vv[i];
    }
    __syncthreads();
    attn_wave_unit(F.lds, QB, sinks, CAT, tokb, 0, F.wave, F.lane);
    attn_wave_unit(F.lds, QB, sinks, CAT, tokb + 32, 1, F.wave, F.lane);
    __syncthreads();
}
constexpr int SG_WOFF = 20480, SG_WROW = 272;
__device__ __forceinline__ void sgu_stage_w(const Frame& F, const float* w_s, int gi) {
    f32x4 w[8];
#pragma unroll
    for (int i = 0; i < 8; ++i) w[i] = *(const f32x4*)(w_s + (size_t)gi * 16384 + (size_t)(F.tid + 512 * i) * 4);
#pragma unroll
    for (int i = 0; i < 8; ++i) { const int c = F.tid + 512 * i, t = c >> 5, s0 = (c & 31) * 4;
        f32x4 v = w[i];
#pragma unroll
        for (int j = 0; j < 4; ++j) if (s0 + j > t) v[j] = 0.f;
        u32x2 o; o.x = cvt_pk_bf16(v[0], v[1]); o.y = cvt_pk_bf16(v[2], v[3]);
        *(LAS u32x2*)(F.lds + SG_WOFF + t * SG_WROW + s0 * 2) = o; }
}
__device__ __forceinline__ void sgu_unit(const Frame& F, const bf16* UB, const bf16* GB, const float* ln_g, const float* ln_b, const float* w_s, const float* b_s, bf16* CAT, int ch, int gi) {
    LAS bf16* GT = (LAS bf16*)F.lds;
    const int r32 = F.lane & 31, hi = F.lane >> 5, tb = F.wave >> 1, db = F.wave & 1, t = tb * 32 + r32;
    const int nks = 2 * (tb + 1);
    const int s = F.tid >> 2, q4 = F.tid & 3; const size_t tok = (size_t)ch * 128 + s;
    const u32x4* gp = (const u32x4*)(GB + tok * 512 + gi * 64 + q4 * 16);
    const u32x4 a = gp[0], c = gp[1];
    const size_t tokt = (size_t)ch * 128 + t;
    const bf16* up = UB + tokt * 512 + gi * 64 + db * 32 + 4 * hi;
    u32x2 uu[4];
#pragma unroll
    for (int gq = 0; gq < 4; ++gq) uu[gq] = *(const u32x2*)(up + 8 * gq);
    const float bb = b_s[gi * 128 + t];
    float lg_[16], lb_[16];
#pragma unroll
    for (int i = 0; i < 16; ++i) { lg_[i] = ln_g[gi * 64 + q4 * 16 + i]; lb_[i] = ln_b[gi * 64 + q4 * 16 + i]; }
    {
        float v[16];
        v[0] = __uint_as_float(a.x << 16); v[1] = __uint_as_float(a.x & 0xffff0000u); v[2] = __uint_as_float(a.y << 16); v[3] = __uint_as_float(a.y & 0xffff0000u);
        v[4] = __uint_as_float(a.z << 16); v[5] = __uint_as_float(a.z & 0xffff0000u); v[6] = __uint_as_float(a.w << 16); v[7] = __uint_as_float(a.w & 0xffff0000u);
        v[8] = __uint_as_float(c.x << 16); v[9] = __uint_as_float(c.x & 0xffff0000u); v[10] = __uint_as_float(c.y << 16); v[11] = __uint_as_float(c.y & 0xffff0000u);
        v[12] = __uint_as_float(c.z << 16); v[13] = __uint_as_float(c.z & 0xffff0000u); v[14] = __uint_as_float(c.w << 16); v[15] = __uint_as_float(c.w & 0xffff0000u);
        float sum = 0.f;
#pragma unroll
        for (int i = 0; i < 16; ++i) sum += v[i];
        sum += __shfl_xor(sum, 1); sum += __shfl_xor(sum, 2);
        const float mu = sum * (1.f / 64.f); float q = 0.f;
#pragma unroll
        for (int i = 0; i < 16; ++i) { v[i] -= mu; q += v[i] * v[i]; }
        q += __shfl_xor(q, 1); q += __shfl_xor(q, 2);
        const float rstd = rsqrtf(q * (1.f / 64.f) + LN_EPS);
#pragma unroll
        for (int i = 0; i < 16; ++i) { const int d = q4 * 16 + i; GT[d * 136 + s] = (bf16)f2bf(v[i] * rstd * lg_[i] + lb_[i]); }
    }
    __syncthreads();
    {
        f32x16 acc;
#pragma unroll
        for (int r = 0; r < 16; ++r) acc[r] = 0.f;
        const LAS bf16* arow = GT + (db * 32 + r32) * 136 + hi * 8;
        const LAS unsigned char* wlds = F.lds + SG_WOFF + t * SG_WROW + hi * 16;
#pragma unroll
        for (int ks = 0; ks < 8; ++ks) if (ks < nks) {
            const bf16x8 af = *(const LAS bf16x8*)(arow + ks * 16);
            const bf16x8 bw = *(const LAS bf16x8*)(wlds + ks * 32);
            acc = __builtin_amdgcn_mfma_f32_32x32x16_bf16(af, bw, acc, 0, 0, 0);
        }
        bf16* op = CAT + tokt * 1024 + 512 + gi * 64 + db * 32 + 4 * hi;
#pragma unroll
        for (int gq = 0; gq < 4; ++gq) {
            const float u0 = __uint_as_float(uu[gq].x << 16), u1 = __uint_as_float(uu[gq].x & 0xffff0000u), u2 = __uint_as_float(uu[gq].y << 16), u3 = __uint_as_float(uu[gq].y & 0xffff0000u);
            u32x2 w; w.x = cvt_pk_bf16(u0 * (acc[4 * gq] + bb), u1 * (acc[4 * gq + 1] + bb)); w.y = cvt_pk_bf16(u2 * (acc[4 * gq + 2] + bb), u3 * (acc[4 * gq + 3] + bb));
            *(u32x2*)(op + 8 * gq) = w;
        }
    }
    __syncthreads();
}
__device__ __forceinline__ void p2_mixers(const Frame& F, const Args& a) {
    unsigned char* ws = a.ws;
    const bf16 *QB = (const bf16*)(ws + WS_QB), *KB = (const bf16*)(ws + WS_KB), *VT = (const bf16*)(ws + WS_VT), *UB = (const bf16*)(ws + WS_UB), *GB = (const bf16*)(ws + WS_GB);
    bf16* CAT = (bf16*)(ws + WS_CAT);
#ifndef P2_REP_ATTN
#define P2_REP_ATTN 1
#endif
#ifndef P2_REP_SGU
#define P2_REP_SGU 1
#endif
    for (int rp = 0; rp < P2_REP_ATTN; ++rp)
    for (int qq = F.vcu; qq < T / 64; qq += F.G) attn_block(F, QB, KB, VT, a.in[3], CAT, qq);
    int gi_staged = -1;
    for (int rp = 0; rp < P2_REP_SGU; ++rp)
    for (int u = F.vcu; u < (T / 128) * 8; u += F.G) {
        if ((u & 7) != gi_staged) { __syncthreads(); sgu_stage_w(F, a.in[6], u & 7); gi_staged = u & 7; }
        sgu_unit(F, UB, GB, a.in[4], a.in[5], a.in[6], a.in[7], CAT, u >> 3, u & 7);
    }
}

template <int CTRL> __device__ __forceinline__ float dppf(float v) { return __builtin_bit_cast(float, __builtin_amdgcn_update_dpp(0, __builtin_bit_cast(int, v), CTRL, 0xF, 0xF, true)); }
__device__ __forceinline__ float swap16_sum(float x, float y) { auto r = __builtin_amdgcn_permlane16_swap(__builtin_bit_cast(unsigned, x), __builtin_bit_cast(unsigned, y), false, false); return __builtin_bit_cast(float, r[0]) + __builtin_bit_cast(float, r[1]); }
__device__ __forceinline__ float swap32_sum(float x, float y) { auto r = __builtin_amdgcn_permlane32_swap(__builtin_bit_cast(unsigned, x), __builtin_bit_cast(unsigned, y), false, false); return __builtin_bit_cast(float, r[0]) + __builtin_bit_cast(float, r[1]); }
__device__ __forceinline__ float rdlane(float v, int l) { return __builtin_bit_cast(float, __builtin_amdgcn_readlane(__builtin_bit_cast(int, v), l)); }
__device__ __forceinline__ float xsum(float v) {
    v += dppf<0xB1>(v); v += dppf<0x4E>(v); v += dppf<0x124>(v); v += dppf<0x128>(v);
    return (rdlane(v, 0) + rdlane(v, 16)) + (rdlane(v, 32) + rdlane(v, 48));
}
__device__ __forceinline__ float xmax(float v) {
    v = fmaxf(v, dppf<0xB1>(v)); v = fmaxf(v, dppf<0x4E>(v)); v = fmaxf(v, dppf<0x124>(v)); v = fmaxf(v, dppf<0x128>(v));
    return fmaxf(fmaxf(rdlane(v, 0), rdlane(v, 16)), fmaxf(rdlane(v, 32), rdlane(v, 48)));
}
__device__ __forceinline__ void p4_router(const Frame& F, const Args& a, bool commit) {
    const float* Zin = a.out; float* Hout = (float*)(a.ws + WS_H); signed char* HB8 = (signed char*)(a.ws + WS_HB); int* meta = (int*)(a.ws + WS_META); unsigned* cnt = (unsigned*)(a.ws + WS_CTL) + CW_CNT;
    const float* ln1_g = a.in[10]; const float* ln1_b = a.in[11]; const float* w_r = a.in[12]; const float* b_r = a.in[13];
    LAS float* W = (LAS float*)F.lds;
    LAS unsigned* hist = (LAS unsigned*)(F.lds + RSCR_OFF);
    LAS unsigned* base = hist + 32;
    LAS int* tmp_e = (LAS int*)(hist + 64);
    LAS int* tmp_p = tmp_e + 256;
    LAS float* tmp_g = (LAS float*)(tmp_p + 256);
    {
        f32x4 t[16];
#pragma unroll
        for (int k = 0; k < 16; ++k) t[k] = *(const f32x4*)(w_r + (size_t)(F.tid + 512 * k) * 4);
#pragma unroll
        for (int k = 0; k < 16; ++k) { const int i = F.tid + 512 * k, c = i >> 3, e4 = i & 7; *(LAS f32x4*)(W + c * 36 + e4 * 4) = t[k]; }
    }
    { const int gt = F.vcu * (NWAVES * 64) + F.tid, NGT = F.G * NWAVES * 64;
      for (int i = gt; i < NROWS_MAX; i += NGT) { meta[MT_ROW_TOK + i] = 0; ((float*)meta)[MT_ROW_GATE + i] = 0.f; ((float*)meta)[MT_ROW_SA + i] = 0.f; } }
    const int lane = F.lane, half = lane >> 5, el = lane & 31;
    float gmm[16], bta[16];
#pragma unroll
    for (int i = 0; i < 16; ++i) { gmm[i] = ln1_g[64 * i + lane]; bta[i] = ln1_b[64 * i + lane]; }
    for (int tb = F.vcu; tb < T / 64; tb += F.G) {
        if (F.tid < 32) hist[F.tid] = 0u;
        __syncthreads();
        float zn0[16], zn1[16];
        { const float* z0 = Zin + (size_t)(tb * 64 + 8 * F.wave) * D + lane;
#pragma unroll
          for (int i = 0; i < 16; ++i) { zn0[i] = z0[64 * i]; zn1[i] = z0[D + 64 * i]; } }
        for (int pp = 0; pp < 4; ++pp) {
            const int tl0 = 8 * F.wave + 2 * pp;
            const int tok0 = tb * 64 + tl0;
            float h0[16], h1[16];
            {
                float* ho0 = Hout + (size_t)tok0 * D + lane; float* ho1 = ho0 + D;
                float s0 = 0.f, s1 = 0.f, q0 = 0.f, q1 = 0.f;
#pragma unroll
                for (int i = 0; i < 16; ++i) { h0[i] = zn0[i]; h1[i] = zn1[i]; }
                if (pp < 3) { const float* zp = Zin + (size_t)(tok0 + 2) * D + lane;
#pragma unroll
                    for (int i = 0; i < 16; ++i) { zn0[i] = zp[64 * i]; zn1[i] = zp[D + 64 * i]; } }
#pragma unroll
                for (int i = 0; i < 16; ++i) { s0 += h0[i]; s1 += h1[i]; q0 += h0[i] * h0[i]; q1 += h1[i] * h1[i]; }
                s0 = xsum(s0); s1 = xsum(s1); q0 = xsum(q0); q1 = xsum(q1);
                const float m0 = s0 * (1.f / D), m1 = s1 * (1.f / D);
                const float r0 = rsqrtf(fmaxf(q0 * (1.f / D) - m0 * m0, 0.f) + LN_EPS), r1 = rsqrtf(fmaxf(q1 * (1.f / D) - m1 * m1, 0.f) + LN_EPS);
                float a0 = 0.f, a1 = 0.f;
#pragma unroll
                for (int i = 0; i < 16; ++i) {
                    h0[i] = (h0[i] - m0) * r0 * gmm[i] + bta[i]; h1[i] = (h1[i] - m1) * r1 * gmm[i] + bta[i];
                    ho0[64 * i] = h0[i]; ho1[64 * i] = h1[i];
                    a0 = fmaxf(a0, fabsf(h0[i])); a1 = fmaxf(a1, fabsf(h1[i]));
                }
                a0 = xmax(a0); a1 = xmax(a1);
                const float i0 = a0 > 0.f ? 127.0f / a0 : 0.f, i1 = a1 > 0.f ? 127.0f / a1 : 0.f;
                signed char* hb0 = HB8 + (size_t)tok0 * D + lane; signed char* hb1 = hb0 + D;
#pragma unroll
                for (int i = 0; i < 16; ++i) { hb0[64 * i] = (signed char)(int)rintf(h0[i] * i0); hb1[64 * i] = (signed char)(int)rintf(h1[i] * i1); }
                if (lane == 0) { ((float*)meta)[MT_SH + tok0] = a0 * (1.0f / 127.0f); ((float*)meta)[MT_SH + tok0 + 1] = a1 * (1.0f / 127.0f); }
            }
            float lg0[32], lg1[32];
#pragma unroll
            for (int e = 0; e < 32; ++e) { lg0[e] = 0.f; lg1[e] = 0.f; }
#pragma unroll
            for (int i = 0; i < 16; ++i) {
                const LAS f32x4* wr = (const LAS f32x4*)(W + (64 * i + lane) * 36);
#pragma unroll
                for (int e4 = 0; e4 < 8; ++e4) {
                    const f32x4 ww = wr[e4];
                    lg0[4 * e4 + 0] += h0[i] * ww.x; lg0[4 * e4 + 1] += h0[i] * ww.y; lg0[4 * e4 + 2] += h0[i] * ww.z; lg0[4 * e4 + 3] += h0[i] * ww.w;
                    lg1[4 * e4 + 0] += h1[i] * ww.x; lg1[4 * e4 + 1] += h1[i] * ww.y; lg1[4 * e4 + 2] += h1[i] * ww.z; lg1[4 * e4 + 3] += h1[i] * ww.w;
                }
            }
            float v32[32];
#pragma unroll
            for (int e = 0; e < 32; ++e) { const float keep = half ? lg1[e] : lg0[e], send = half ? lg0[e] : lg1[e]; v32[e] = keep + __shfl_xor(send, 32); }
            float v16[16];
#pragma unroll
            for (int e = 0; e < 16; ++e) { const bool up = (lane & 16) != 0; const float keep = up ? v32[e + 16] : v32[e], send = up ? v32[e] : v32[e + 16]; v16[e] = keep + __shfl_xor(send, 16); }
            float v8[8];
#pragma unroll
            for (int e = 0; e < 8; ++e) { const bool up = (lane & 8) != 0; const float keep = up ? v16[e + 8] : v16[e], send = up ? v16[e] : v16[e + 8]; v8[e] = keep + dppf<0x128>(send); }
            float v4[4];
#pragma unroll
            for (int e = 0; e < 4; ++e) { const bool up = (lane & 4) != 0; const float keep = up ? v8[e + 4] : v8[e], send = up ? v8[e] : v8[e + 4]; v4[e] = keep + dppf<0x1B>(dppf<0x141>(send)); }
            float v2[2];
#pragma unroll
            for (int e = 0; e < 2; ++e) { const bool up = (lane & 2) != 0; const float keep = up ? v4[e + 2] : v4[e], send = up ? v4[e] : v4[e + 2]; v2[e] = keep + dppf<0x4E>(send); }
            float lgt;
            { const bool up = (lane & 1) != 0; const float keep = up ? v2[1] : v2[0], send = up ? v2[0] : v2[1]; lgt = keep + dppf<0xB1>(send); }
            lgt += b_r[el];
            int rank = 0;
#pragma unroll
            for (int j = 0; j < 32; ++j) {
                const float lo = rdlane(lgt, j), hi2 = rdlane(lgt, 32 + j);
                const float vj = half ? hi2 : lo;
                rank += (vj > lgt || (vj == lgt && j < el)) ? 1 : 0;
            }
            float bv[4]; int bi[4];
#pragma unroll
            for (int k = 0; k < 4; ++k) {
                const unsigned long long mk = __ballot(rank == k);
                const int i0 = __builtin_ctz((unsigned)mk | 0x80000000u), i1 = 32 + __builtin_ctz((unsigned)(mk >> 32) | 0x80000000u);
                const float x0 = rdlane(lgt, i0), x1 = rdlane(lgt, i1);
                bv[k] = half ? x1 : x0; bi[k] = half ? (i1 - 32) : i0;
            }
            float ex[4], es = 0.f;
#pragma unroll
            for (int k = 0; k < 4; ++k) { ex[k] = __expf(bv[k] - bv[0]); es += ex[k]; }
            if (el == 0) {
                const int tl = tl0 + half;
#pragma unroll
                for (int k = 0; k < 4; ++k) { const unsigned pl = atomicAdd((unsigned*)&hist[bi[k]], 1u); tmp_e[tl * 4 + k] = bi[k]; tmp_p[tl * 4 + k] = (int)pl; tmp_g[tl * 4 + k] = ex[k] / es; }
            }
        }
        __syncthreads();
        if (F.tid < 32) base[F.tid] = commit ? atomicAdd(&cnt[F.tid], hist[F.tid]) : 0u;
        __syncthreads();
        if (F.tid < 256) { const int i = F.tid, gi = tb * 256 + i, e = tmp_e[i];
            meta[MT_SEL_E + gi] = e; meta[MT_SEL_POS + gi] = (int)base[e] + tmp_p[i]; ((float*)meta)[MT_SEL_G + gi] = tmp_g[i]; }
        __syncthreads();
    }
}
__device__ __forceinline__ void p5_dispatch(const Frame& F, const Args& a) {
    int* meta = (int*)(a.ws + WS_META); const unsigned* cnt = (const unsigned*)(a.ws + WS_CTL) + CW_CNT;
    LAS int* ts = (LAS int*)(F.lds + RSCR_OFF);
    if (F.tid == 0) { int acc = 0; for (int e = 0; e < 32; ++e) { ts[e] = acc; acc += ((int)__hip_atomic_load(cnt + e, RLX_AGENT) + 255) >> 8; } ts[32] = acc; }
    __syncthreads();
    if (blockIdx.x == 0) {
        if (F.tid == 0) meta[MT_NT] = ts[32];
        if (F.tid < 33) meta[MT_TSTART + F.tid] = ts[F.tid];
        for (int t = F.tid; t < NT_MAX; t += NWAVES * 64) { int e = 0; for (int j = 1; j < 32; ++j) if (t >= ts[j]) e = j; meta[MT_TILE_E + t] = e; }
    }
    const int gt = F.vcu * (NWAVES * 64) + F.tid, NGT = F.G * NWAVES * 64;
    for (int i = gt; i < T * 4; i += NGT) {
        const int e = meta[MT_SEL_E + i], row = ts[e] * 256 + meta[MT_SEL_POS + i];
        meta[MT_ROW_TOK + row] = i >> 2; ((float*)meta)[MT_ROW_GATE + row] = ((const float*)meta)[MT_SEL_G + i]; ((float*)meta)[MT_ROW_SA + row] = ((const float*)meta)[MT_SH + (i >> 2)]; meta[MT_SLOT_ROW + i] = row;
    }
    __syncthreads();
}
__device__ __forceinline__ void p7_quant(const Frame& F, const Args& a) {
    const bf16* HID = (const bf16*)(a.ws + WS_HID); signed char* H8 = (signed char*)(a.ws + WS_HID8); float* row_sb = (float*)(a.ws + WS_ROWSB);
    const int nrows = __builtin_amdgcn_readfirstlane(((const int*)(a.ws + WS_META))[MT_NT]) * 256;
    const int gw = F.vcu * NWAVES + F.wave, NGW = F.G * NWAVES, lane = F.lane;
    for (int r0 = gw * 4; r0 < nrows; r0 += NGW * 4) {
        u32x4 v[4][2];
#pragma unroll
        for (int i = 0; i < 4; ++i)
#pragma unroll
            for (int j = 0; j < 2; ++j) v[i][j] = *((const u32x4*)(HID + (size_t)(r0 + i) * DFF + 512 * j) + lane);
#pragma unroll
        for (int i = 0; i < 4; ++i) {
            float f[16]; float am = 0.f;
#pragma unroll
            for (int j = 0; j < 2; ++j)
#pragma unroll
                for (int c = 0; c < 4; ++c) { const unsigned w = v[i][j][c]; f[8 * j + 2 * c] = __uint_as_float(w << 16); f[8 * j + 2 * c + 1] = __uint_as_float(w & 0xffff0000u); }
#pragma unroll
            for (int c = 0; c < 16; ++c) am = fmaxf(am, fabsf(f[c]));
            am = wave_max(am);
            const float inv = am > 0.f ? 127.0f / am : 0.f;
#pragma unroll
            for (int j = 0; j < 2; ++j) {
                u32x2 o; o.x = 0u; o.y = 0u;
#pragma unroll
                for (int c = 0; c < 4; ++c) { o.x |= ((unsigned)(int)rintf(f[8 * j + c] * inv) & 0xffu) << (8 * c); o.y |= ((unsigned)(int)rintf(f[8 * j + 4 + c] * inv) & 0xffu) << (8 * c); }
                *((u32x2*)(H8 + (size_t)(r0 + i) * DFF + 512 * j) + lane) = o;
            }
            if (lane == 0) row_sb[r0 + i] = am * (1.0f / 127.0f);
        }
    }
}
__device__ __forceinline__ void p8_final(const Frame& F, const Args& a) {
    const float* Hin = (const float*)(a.ws + WS_H); float* HO = a.out; const unsigned char* Y = (const unsigned char*)(a.ws + WS_Y); const int* meta = (const int*)(a.ws + WS_META);
    const float* ln2_g = a.in[20]; const float* ln2_b = a.in[21];
    const int gw = F.vcu * NWAVES + F.wave, NGW = F.G * NWAVES, lane = F.lane;
    for (int tok = gw; tok < T; tok += NGW) {
        f32x4* hr = (f32x4*)(HO + (size_t)tok * D) + lane; const f32x4* hi_ = (const f32x4*)(Hin + (size_t)tok * D) + lane;
        f32x4 v[4]; float s = 0.f;
#pragma unroll
        for (int j = 0; j < 4; ++j) v[j] = hi_[64 * j] * ALPHA;
#pragma unroll
        for (int k = 0; k < 4; ++k) {
            const int row = meta[MT_SLOT_ROW + tok * 4 + k];
            const unsigned* yr = (const unsigned*)(Y + (size_t)row * D) + lane;
#pragma unroll
            for (int j = 0; j < 4; ++j) { const int y = (int)yr[64 * j]; const f32x2 lo = __builtin_amdgcn_cvt_pk_f32_fp8(y, false), hi2 = __builtin_amdgcn_cvt_pk_f32_fp8(y, true);
                v[j].x += lo.x * (1.0f / YSCALE); v[j].y += lo.y * (1.0f / YSCALE); v[j].z += hi2.x * (1.0f / YSCALE); v[j].w += hi2.y * (1.0f / YSCALE); }
        }
#pragma unroll
        for (int j = 0; j < 4; ++j) s += (v[j].x + v[j].y) + (v[j].z + v[j].w);
        const float mean = wave_sum(s) * (1.f / D); float s2 = 0.f;
#pragma unroll
        for (int j = 0; j < 4; ++j) { v[j] = v[j] - mean; s2 += (v[j].x * v[j].x + v[j].y * v[j].y) + (v[j].z * v[j].z + v[j].w * v[j].w); }
        const float rstd = rsqrtf(wave_sum(s2) * (1.f / D) + LN_EPS);
#pragma unroll
        for (int j = 0; j < 4; ++j) { const int c0 = 4 * lane + 256 * j; const f32x4 gg = *(const f32x4*)(ln2_g + c0), bb = *(const f32x4*)(ln2_b + c0); hr[64 * j] = v[j] * rstd * gg + bb; }
    }
}
#ifndef MKMASK
#define MKMASK 0x3FF
#endif
#ifndef REPEAT_MASK
#define REPEAT_MASK 0
#endif
#define NREP(k) (1 + ((REPEAT_MASK >> (k)) & 1))
__global__ void __launch_bounds__(NWAVES * 64, 2) mk_fwd(Args args) {
    extern __shared__ __attribute__((aligned(16))) unsigned char lds_raw[];
    Frame F;
    F.lds = (LAS unsigned char*)lds_raw;
    F.tid = threadIdx.x; F.lane = F.tid & 63; F.wave = __builtin_amdgcn_readfirstlane(F.tid >> 6);
    F.G = gridDim.x; { const int bx = blockIdx.x; F.vcu = (F.G % 8 == 0) ? (bx % 8) * (F.G / 8) + bx / 8 : bx; }
    volatile LAS unsigned* MISC = (volatile LAS unsigned*)(F.lds + MISC_OFF);
    if (F.tid < 64) MISC[F.tid] = 0u;
    __syncthreads();
    unsigned char* ws = args.ws;
    unsigned* ctl = (unsigned*)(ws + WS_CTL);
    const int lo = args.ph_lo, hi = args.ph_hi;
    XcdBarrier bar; bar.bar = ctl + CW_BAR + args.li * XCD_BAR_WORDS; bar.x = 0; bar.st = nullptr;
    if (hi - lo > 1) bar = xcd_barrier_post(ctl + CW_BAR + args.li * XCD_BAR_WORDS, MISC + 8);
#ifndef SKIP_MASK
#define SKIP_MASK 0
#endif
#define IN(k) (lo <= (k) && (k) < hi && !((SKIP_MASK >> (k)) & 1))
#define OPAQUE_F(Fp) Frame Fp = F; asm volatile("" : "+v"(Fp.tid)); Fp.lane = Fp.tid & 63
#define SEAM(k) do { if ((IN(k) && IN((k) + 1)) || rep_ + 1 < NREP(k)) xcd_barrier(bar); } while (0)
    int* meta = (int*)(ws + WS_META);
    bf16 *XB = (bf16*)(ws + WS_XB), *QB = (bf16*)(ws + WS_QB), *KB = (bf16*)(ws + WS_KB), *VT = (bf16*)(ws + WS_VT), *UB = (bf16*)(ws + WS_UB), *GB = (bf16*)(ws + WS_GB);
    bf16 *CAT = (bf16*)(ws + WS_CAT), *HB = (bf16*)(ws + WS_HB), *Y = (bf16*)(ws + WS_Y), *HID = (bf16*)(ws + WS_HID);
    bf16 *Win_t = (bf16*)(ws + WS_WIN), *Wout_t = (bf16*)(ws + WS_WOUT), *Wgu_t = (bf16*)(ws + WS_WGU), *Wd_t = (bf16*)(ws + WS_WD);
    const LAS int* rtab = (const LAS int*)(F.lds + RTAB_OFF);
    const bool par = ((blockIdx.x >> 3) & 1) != 0;

    for (int rep_ = 0; rep_ < NREP(0); ++rep_) if (IN(0)) { OPAQUE_F(Fp); p0_prologue(Fp, args); SEAM(0); }
    if (IN(1)) {
        const int c = (int)blockIdx.x;
        const int per_ = (3 * NEXP * 32 + F.G - 1) / F.G;
        const int it_lo = F.G == 256 ? (c < 192 ? c * 10 : 1920 + (c - 192) * 18) : c * per_, it_hi = F.G == 256 ? it_lo + (c < 192 ? 10 : 18) : it_lo + per_;
        OPAQUE_F(Fp);
        if (!par) conv_items(Fp, args, it_lo, it_hi);
        { pg8::Gemm g{XB, Win_t, 2 * D, nullptr, 0u}; pg8::StaticOrder S; S.init(T / 256, INW / 256, F.G, c);
          pg8::EpiInProj E{args.in[2], QB, KB, VT, UB, GB};
          pg8::gemm_phase<pg8::EpiInProj, false, true, false>(F.lds, rtab, g, S, E); }
        if (par) conv_items(Fp, args, it_lo, it_hi);
        { const int rep_ = 0; (void)rep_; SEAM(1); }
    }
    for (int rep_ = 0; rep_ < NREP(2); ++rep_) if (IN(2)) { OPAQUE_F(Fp); p2_mixers(Fp, args); SEAM(2); }
    for (int rep_ = 0; rep_ < NREP(3); ++rep_) if (IN(3)) {
        pg8::Gemm g{CAT, Wout_t, 2 * D, nullptr, 0u}; pg8::StaticOrder S; S.init(T / 256, D / 256, F.G, (int)blockIdx.x);
        pg8::EpiOutProj E{args.in[0], args.in[9], args.out};
        pg8::gemm_phase<pg8::EpiOutProj, false, false, false>(F.lds, rtab, g, S, E);
        SEAM(3);
    }
    for (int rep_ = 0; rep_ < NREP(4); ++rep_) if (IN(4)) { OPAQUE_F(Fp); p4_router(Fp, args, rep_ + 1 == NREP(4)); SEAM(4); }
#ifndef EXTRA_BARS
#define EXTRA_BARS 0
#endif
    for (int rep_ = 0; rep_ < NREP(5); ++rep_) if (IN(5)) { OPAQUE_F(Fp); p5_dispatch(Fp, args); SEAM(5); for (int xb_ = 0; xb_ < EXTRA_BARS; ++xb_) xcd_barrier(bar); }
    for (int rep_ = 0; rep_ < NREP(6); ++rep_) if (IN(6)) {
        const int nT = __builtin_amdgcn_readfirstlane(meta[MT_NT]);
        pg8::StaticOrder S; S.init(nT, 2 * DFF / 256, F.G, (int)blockIdx.x);
        { pg8::Unit u; LAS int* rt = (LAS int*)(F.lds + RTAB_OFF);
          for (int i = 0; i < RTAB_UNITS && S.next(i, u); ++i) if (F.tid < 256) rt[i * 256 + F.tid] = meta[MT_ROW_TOK + u.pm * 256 + F.tid];
          __syncthreads(); }
        pg8::Gemm g{HB, Wgu_t, D, meta + MT_TILE_E, 2048u * 1024u};
        pg8::EpiSwiglu E{meta + MT_TILE_E, args.in[15], args.in[17], (const float*)(ws + WS_SWGU), (const float*)meta + MT_ROW_SA, HID};
        pg8::gemm_phase<pg8::EpiSwiglu, true, true, true>(F.lds, rtab, g, S, E);
        SEAM(6);
    }
    for (int rep_ = 0; rep_ < NREP(7); ++rep_) if (IN(7)) { OPAQUE_F(Fp); p7_quant(Fp, args); SEAM(7); }
    for (int rep_ = 0; rep_ < NREP(8); ++rep_) if (IN(8)) {
        const int nT = __builtin_amdgcn_readfirstlane(meta[MT_NT]);
        pg8::StaticOrder S; S.init(nT, D / 256, F.G, (int)blockIdx.x);
        pg8::Gemm g{ws + WS_HID8, Wd_t, DFF, meta + MT_TILE_E, 1024u * 1024u};
        pg8::EpiDown E{meta + MT_TILE_E, args.in[19], (const float*)(ws + WS_SWD), (const float*)(ws + WS_ROWSB), (const float*)meta + MT_ROW_GATE, (unsigned char*)Y};
#ifdef STAGGER_US
        if (par) { const unsigned long long t0_ = __builtin_amdgcn_s_memrealtime(); while (__builtin_amdgcn_s_memrealtime() - t0_ < (unsigned long long)(STAGGER_US * 100)) __builtin_amdgcn_s_sleep(8); }
#endif
        pg8::gemm_phase<pg8::EpiDown, false, true, true>(F.lds, rtab, g, S, E);
        SEAM(8);
    }
    for (int rep_ = 0; rep_ < NREP(9); ++rep_) if (IN(9)) { OPAQUE_F(Fp); p8_final(Fp, args); if (rep_ + 1 < NREP(9)) xcd_barrier(bar); }
#undef IN
#undef SEAM
}

extern "C" void kernel_launch(void* const* d_in, const int* in_sizes, int n_in, void* d_out, int out_size, void* d_ws, size_t ws_size, hipStream_t stream) {
    static int grid = 0;
    if (grid == 0) {
        if (n_in != 22 || in_sizes[0] != T * D || out_size != T * D || ws_size < WS_END) { fprintf(stderr, "kernel_launch: unexpected shapes (n_in %d, in0 %d, out %d, ws %zu, need %zu)\n", n_in, n_in > 0 ? in_sizes[0] : -1, out_size, ws_size, (size_t)WS_END); grid = -1; return; }
        int dev = 0, cus = 0;
        if (hipGetDevice(&dev) != hipSuccess || hipDeviceGetAttribute(&cus, hipDeviceAttributeMultiprocessorCount, dev) != hipSuccess) { grid = -1; return; }
        if (hipFuncSetAttribute((const void*)mk_fwd, hipFuncAttributeMaxDynamicSharedMemorySize, LDS_BYTES) != hipSuccess) { fprintf(stderr, "kernel_launch: hipFuncSetAttribute failed\n"); grid = -1; return; }
        int per_cu = 0;
        if (hipOccupancyMaxActiveBlocksPerMultiprocessor(&per_cu, (const void*)mk_fwd, NWAVES * 64, LDS_BYTES) != hipSuccess || per_cu < 1) fprintf(stderr, "kernel_launch: occupancy query reports %d\n", per_cu);
        (void)hipGetLastError();
        grid = cus;
    }
    if (grid < 0) return;
    const float* x = (const float*)d_in[0]; const float* w_in = (const float*)d_in[1]; const float* b_in = (const float*)d_in[2]; const float* sinks = (const float*)d_in[3];
    const float* ln_v_g = (const float*)d_in[4]; const float* ln_v_b = (const float*)d_in[5]; const float* w_sp = (const float*)d_in[6]; const float* b_sp = (const float*)d_in[7];
    const float* w_out = (const float*)d_in[8]; const float* b_out = (const float*)d_in[9]; const float* ln1_g = (const float*)d_in[10]; const float* ln1_b = (const float*)d_in[11];
    const float* w_r = (const float*)d_in[12]; const float* b_r = (const float*)d_in[13]; const float* w_gate = (const float*)d_in[14]; const float* b_gate = (const float*)d_in[15];
    const float* w_up = (const float*)d_in[16]; const float* b_up = (const float*)d_in[17]; const float* w_down = (const float*)d_in[18]; const float* b_down = (const float*)d_in[19];
    const float* ln2_g = (const float*)d_in[20]; const float* ln2_b = (const float*)d_in[21];
    unsigned char* ws = (unsigned char*)d_ws; float* out = (float*)d_out;
    unsigned* ctl = (unsigned*)(ws + WS_CTL); int* meta = (int*)(ws + WS_META);
    bf16 *XB = (bf16*)(ws + WS_XB), *QB = (bf16*)(ws + WS_QB), *KB = (bf16*)(ws + WS_KB), *VT = (bf16*)(ws + WS_VT), *UB = (bf16*)(ws + WS_UB), *GB = (bf16*)(ws + WS_GB);
    bf16 *CAT = (bf16*)(ws + WS_CAT), *HB = (bf16*)(ws + WS_HB), *Y = (bf16*)(ws + WS_Y), *HID = (bf16*)(ws + WS_HID);
    (void)hipMemsetAsync(ws + WS_CTL, 0, 1 * MiB, stream);
    Args a{};
    for (int i = 0; i < 22; ++i) a.in[i] = (const float*)d_in[i];
    a.out = out; a.ws = ws;
    int li = 0;
    for (int k = 0; k < NPHASES;) {
        if ((MKMASK >> k) & 1) {
            int j = k; while (j < NPHASES && ((MKMASK >> j) & 1)) ++j;
            a.ph_lo = k; a.ph_hi = j; a.li = li++;
            hipLaunchKernelGGL(mk_fwd, dim3(grid), dim3(NWAVES * 64), LDS_BYTES, stream, a);
            k = j; continue;
        }
        switch (k) {
        case 0: k_cvt_x<<<2048, 256, 0, stream>>>(x, XB, T * D / 4); break;
        case 1: k_inproj_naive<<<dim3(T / 64, INW / 64), 256, 0, stream>>>(XB, w_in, EpiInProjN{b_in, QB, KB, VT, UB, GB}); break;
        case 2: k_attn_naive<<<T * NQH / 4, 256, 0, stream>>>(QB, KB, VT, sinks, CAT);
                k_sgu_naive<<<T / 128 * 8, 256, 0, stream>>>(UB, GB, ln_v_g, ln_v_b, w_sp, b_sp, CAT); break;
        case 3: k_outproj_naive<<<dim3(T / 64, D / 64), 256, 0, stream>>>(CAT, w_out, EpiOutProjN{b_out, x, out}); break;
        case 4: k_router_naive<<<T / 4, 256, 0, stream>>>(out, HB, ln1_g, ln1_b, w_r, b_r, ctl + CW_CNT, meta);
                k_rowinit<<<(NROWS_MAX + 255) / 256, 256, 0, stream>>>(meta); break;
        case 5: k_dispatch1<<<1, 64, 0, stream>>>(ctl + CW_CNT, meta);
                k_scatter<<<T * 4 / 256, 256, 0, stream>>>(meta); break;
        case 6: k_gateup_naive<<<dim3(NT_MAX * 4, DFF / 64), 256, 0, stream>>>(HB, meta, w_gate, b_gate, w_up, b_up, HID); break;
        case 8: k_down_naive<<<dim3(NT_MAX * 4, D / 64), 256, 0, stream>>>(HID, meta, w_down, b_down, Y); break;
        case 9: k_final_naive<<<T / 4, 256, 0, stream>>>(out, Y, meta, ln2_g, ln2_b); break;
        }
        ++k;
    }
}
```

```cpp
#include <hip/hip_runtime.h>
#include <cstdio>
#include <cstdint>

typedef unsigned short bf16;
typedef float f32x4 __attribute__((ext_vector_type(4)));
typedef unsigned u32x4 __attribute__((ext_vector_type(4)));
typedef unsigned u32x2 __attribute__((ext_vector_type(2)));

constexpr int BATCH = 2, SEQ = 8192, D = 1024, T = BATCH * SEQ;
constexpr int NQH = 8, NKVH = 2, HD = 64, QREP = 4, AW = 512, KVW = 128, GW = 512, INW = 1792;
constexpr int NEXP = 32, TOPK = 4, DFF = 1024;
constexpr int NT_MAX = T * TOPK / 256 + NEXP;
constexpr int NROWS_MAX = NT_MAX * 256;
constexpr float LN_EPS = 1e-5f;
constexpr float ALPHA = 1.189207115002721f;
constexpr float C2 = 0.125f * 1.4426950408889634f;
constexpr float LOG2E = 1.4426950408889634f;
constexpr float YSCALE = 16.0f;

constexpr size_t MiB = 1u << 20;
constexpr size_t WS_CTL = 0;
constexpr size_t WS_META = 1 * MiB;
constexpr size_t WS_XB = 3 * MiB;
constexpr size_t WS_QB = WS_XB + 32 * MiB;
constexpr size_t WS_KB = WS_QB + 16 * MiB;
constexpr size_t WS_VT = WS_KB + 4 * MiB;
constexpr size_t WS_UB = WS_VT + 4 * MiB;
constexpr size_t WS_GB = WS_UB + 16 * MiB;
constexpr size_t WS_CAT = WS_GB + 16 * MiB;
constexpr size_t WS_HB = WS_CAT + 32 * MiB;
constexpr size_t WS_H = WS_XB;
constexpr size_t WS_HID = WS_HB + 32 * MiB;
constexpr size_t WS_Y = WS_HID;
constexpr size_t WS_END_NAIVE = WS_HID + 144 * MiB;
static_assert(WS_H + 64 * MiB <= WS_CAT, "H overlay");

constexpr int CW_CNT = 64;
constexpr int MT_NT = 0;
constexpr int MT_TSTART = 16;
constexpr int MT_TILE_E = 64;
constexpr int MT_SEL_E = 1024;
constexpr int MT_SEL_POS = MT_SEL_E + T * 4;
constexpr int MT_SEL_G = MT_SEL_POS + T * 4;
constexpr int MT_SLOT_ROW = MT_SEL_G + T * 4;
constexpr int MT_ROW_TOK = MT_SLOT_ROW + T * 4;
constexpr int MT_ROW_GATE = MT_ROW_TOK + NROWS_MAX;
constexpr int MT_ROW_SA = MT_ROW_GATE + NROWS_MAX;
constexpr int MT_SH = MT_ROW_SA + NROWS_MAX;
constexpr size_t WS_ROWSB = 512 * 1024;
static_assert((size_t)(MT_SH + T) * 4 <= 2 * MiB, "meta");

__device__ __forceinline__ float bf2f(bf16 v) { return __uint_as_float((unsigned)v << 16); }
__device__ __forceinline__ unsigned f2bf(float f) { unsigned u = __float_as_uint(f); return (u + 0x7fffu + ((u >> 16) & 1u)) >> 16; }
__device__ __forceinline__ unsigned pk2(float lo, float hi) { return f2bf(lo) | (f2bf(hi) << 16); }
__device__ __forceinline__ float gelu_tanh(float x) {
    const float k2 = 2.0f * 0.7978845608028654f;
    const float u = k2 * (x + 0.044715f * x * x * x);
    return x / (1.0f + __expf(-u));
}
__device__ __forceinline__ float wave_sum(float v) {
#pragma unroll
    for (int o = 1; o < 64; o <<= 1) v += __shfl_xor(v, o);
    return v;
}
__device__ __forceinline__ float wave_max(float v) {
#pragma unroll
    for (int o = 1; o < 64; o <<= 1) v = fmaxf(v, __shfl_xor(v, o));
    return v;
}

__global__ void k_cvt_x(const float* __restrict__ x, bf16* __restrict__ xb, int n4) {
    for (int i = blockIdx.x * blockDim.x + threadIdx.x; i < n4; i += gridDim.x * blockDim.x) {
        const f32x4 v = ((const f32x4*)x)[i];
        u32x2 o; o.x = pk2(v.x, v.y); o.y = pk2(v.z, v.w);
        ((u32x2*)xb)[i] = o;
    }
}

template <int NB, class Epi>
__device__ __forceinline__ void naive_gemm_tile(const bf16* A, int lda, const int* rowidx, int m0, const float* B0, const float* B1, int ldb, int n0, int K, const Epi& epi) {
    __shared__ float As[16][68];
    __shared__ float Bs[NB][16][64];
    const int tid = threadIdx.x, ty = tid >> 4, tx = tid & 15;
    float acc[NB][4][4];
#pragma unroll
    for (int b = 0; b < NB; ++b)
#pragma unroll
        for (int i = 0; i < 4; ++i)
#pragma unroll
            for (int j = 0; j < 4; ++j) acc[b][i][j] = 0.f;
    const int ar = tid >> 2, ac = (tid & 3) * 4;
    const int arow = rowidx ? rowidx[m0 + ar] : (m0 + ar);
    const bf16* ap = A + (size_t)arow * lda + ac;
    const int br = tid >> 4, bc = (tid & 15) * 4;
    for (int k0 = 0; k0 < K; k0 += 16) {
        const u32x2 av = *(const u32x2*)(ap + k0);
        As[ac + 0][ar] = __uint_as_float(av.x << 16); As[ac + 1][ar] = __uint_as_float(av.x & 0xffff0000u);
        As[ac + 2][ar] = __uint_as_float(av.y << 16); As[ac + 3][ar] = __uint_as_float(av.y & 0xffff0000u);
        *(f32x4*)&Bs[0][br][bc] = *(const f32x4*)(B0 + (size_t)(k0 + br) * ldb + n0 + bc);
        if (NB == 2) *(f32x4*)&Bs[NB - 1][br][bc] = *(const f32x4*)(B1 + (size_t)(k0 + br) * ldb + n0 + bc);
        __syncthreads();
#pragma unroll
        for (int k = 0; k < 16; ++k) {
            const f32x4 a = *(const f32x4*)&As[k][ty * 4];
#pragma unroll
            for (int b = 0; b < NB; ++b) {
                const f32x4 bv = *(const f32x4*)&Bs[b][k][tx * 4];
#pragma unroll
                for (int i = 0; i < 4; ++i)
#pragma unroll
                    for (int j = 0; j < 4; ++j) acc[b][i][j] += a[i] * bv[j];
            }
        }
        __syncthreads();
    }
#pragma unroll
    for (int i = 0; i < 4; ++i)
#pragma unroll
        for (int j = 0; j < 4; ++j) {
            if (NB == 2) epi(m0 + ty * 4 + i, n0 + tx * 4 + j, acc[0][i][j], acc[NB - 1][i][j]);
            else epi(m0 + ty * 4 + i, n0 + tx * 4 + j, acc[0][i][j], 0.f);
        }
}

struct EpiInProjN {
    const float* b_in; bf16 *QB, *KB, *VT, *UB, *GB;
    __device__ __forceinline__ void operator()(int row, int c, float a, float) const {
        const float v = a + b_in[c];
        if (c < 512) QB[(size_t)row * 512 + c] = (bf16)f2bf(v * C2);
        else if (c < 640) KB[(size_t)row * 128 + (c - 512)] = (bf16)f2bf(v);
        else if (c < 768) { const int cv = c - 640, g = cv >> 6, d = cv & 63, b = row / SEQ, s = row % SEQ; VT[((size_t)((b * 2 + g) * 64 + d)) * SEQ + s] = (bf16)f2bf(v); }
        else if (c < 1280) UB[(size_t)row * 512 + (c - 768)] = (bf16)f2bf(gelu_tanh(v));
        else GB[(size_t)row * 512 + (c - 1280)] = (bf16)f2bf(gelu_tanh(v));
    }
};
__global__ void __launch_bounds__(256) k_inproj_naive(const bf16* XB, const float* w_in, EpiInProjN epi) {
    naive_gemm_tile<1>(XB, D, nullptr, blockIdx.x * 64, w_in, nullptr, INW, blockIdx.y * 64, D, epi);
}

__global__ void __launch_bounds__(256) k_attn_naive(const bf16* QB, const bf16* KB, const bf16* VT, const float* sinks, bf16* CAT) {
    __shared__ float pl[4][128];
    const int w = threadIdx.x >> 6, lane = threadIdx.x & 63;
    const int wu = blockIdx.x * 4 + w;
    const int tok = wu >> 3, h = wu & 7, g = h >> 2, b = tok / SEQ, t = tok % SEQ;
    const float qv = bf2f(QB[(size_t)tok * 512 + h * 64 + lane]);
    float s[2];
    {
        const int kp0 = t - 127 + lane, kp1 = kp0 + 64;
        const bf16* kr0 = KB + (size_t)(b * SEQ + (kp0 < 0 ? 0 : kp0)) * 128 + g * 64;
        const bf16* kr1 = KB + (size_t)(b * SEQ + (kp1 < 0 ? 0 : kp1)) * 128 + g * 64;
        float a0 = 0.f, a1 = 0.f;
        for (int d = 0; d < 64; ++d) { const float qd = __shfl(qv, d); a0 += qd * bf2f(kr0[d]); a1 += qd * bf2f(kr1[d]); }
        s[0] = (kp0 >= 0) ? a0 : -1e30f; s[1] = (kp1 >= 0) ? a1 : -1e30f;
    }
    const float sk = sinks[h] * LOG2E;
    const float m = fmaxf(wave_max(fmaxf(s[0], s[1])), sk);
    const float p0 = exp2f(s[0] - m), p1 = exp2f(s[1] - m);
    const float l = wave_sum(p0 + p1) + exp2f(sk - m);
    pl[w][lane] = p0; pl[w][64 + lane] = p1;
    __syncthreads();
    const bf16* vr = VT + ((size_t)((b * 2 + g) * 64 + lane)) * SEQ;
    float o = 0.f;
    for (int j = 0; j < 128; ++j) { const int kp = t - 127 + j; if (kp >= 0) o += pl[w][j] * bf2f(vr[kp]); }
    CAT[(size_t)tok * 1024 + h * 64 + lane] = (bf16)f2bf(o / l);
}

__global__ void __launch_bounds__(256) k_sgu_naive(const bf16* UB, const bf16* GB, const float* ln_g, const float* ln_b, const float* w_s, const float* b_s, bf16* CAT) {
    __shared__ float G[128][65];
    const int u = blockIdx.x, gi = u & 7, ch = u >> 3;
    const int tid = threadIdx.x, s = tid >> 1, half = tid & 1;
    const size_t tok = (size_t)ch * 128 + s;
    float v[32]; float sum = 0.f;
#pragma unroll
    for (int i = 0; i < 32; ++i) { v[i] = bf2f(GB[tok * 512 + gi * 64 + half * 32 + i]); sum += v[i]; }
    sum += __shfl_xor(sum, 1);
    const float mu = sum * (1.f / 64.f); float q = 0.f;
#pragma unroll
    for (int i = 0; i < 32; ++i) { v[i] -= mu; q += v[i] * v[i]; }
    q += __shfl_xor(q, 1);
    const float rstd = rsqrtf(q * (1.f / 64.f) + LN_EPS);
#pragma unroll
    for (int i = 0; i < 32; ++i) { const int d = half * 32 + i; G[s][d] = v[i] * rstd * ln_g[gi * 64 + d] + ln_b[gi * 64 + d]; }
    __syncthreads();
    const int t = s;
    float acc[32];
#pragma unroll
    for (int i = 0; i < 32; ++i) acc[i] = 0.f;
    const float* wr = w_s + ((size_t)gi * 128 + t) * 128;
    for (int ss = 0; ss <= t; ++ss) {
        const float w = wr[ss];
#pragma unroll
        for (int i = 0; i < 32; ++i) acc[i] += w * G[ss][half * 32 + i];
    }
    const float bb = b_s[gi * 128 + t];
#pragma unroll
    for (int i = 0; i < 32; ++i) { const int d = half * 32 + i; const float uu = bf2f(UB[tok * 512 + gi * 64 + d]); CAT[tok * 1024 + 512 + gi * 64 + d] = (bf16)f2bf(uu * (acc[i] + bb)); }
}

struct EpiOutProjN {
    const float* b_out; const float* x; float* Z;
    __device__ __forceinline__ void operator()(int row, int c, float a, float) const { Z[(size_t)row * D + c] = ALPHA * x[(size_t)row * D + c] + a + b_out[c]; }
};
__global__ void __launch_bounds__(256) k_outproj_naive(const bf16* CAT, const float* w_out, EpiOutProjN epi) {
    naive_gemm_tile<1>(CAT, D, nullptr, blockIdx.x * 64, w_out, nullptr, D, blockIdx.y * 64, D, epi);
}

__global__ void __launch_bounds__(256) k_router_naive(float* ZH, bf16* HB, const float* ln1_g, const float* ln1_b, const float* w_r, const float* b_r, unsigned* cnt, int* meta) {
    const int w = threadIdx.x >> 6, lane = threadIdx.x & 63;
    const int tok = blockIdx.x * 4 + w;
    f32x4* zr = (f32x4*)(ZH + (size_t)tok * D) + lane;
    f32x4 v[4]; float s = 0.f;
#pragma unroll
    for (int j = 0; j < 4; ++j) { v[j] = zr[64 * j]; s += (v[j].x + v[j].y) + (v[j].z + v[j].w); }
    const float mean = wave_sum(s) * (1.f / D); float s2 = 0.f;
#pragma unroll
    for (int j = 0; j < 4; ++j) { v[j] = v[j] - mean; s2 += (v[j].x * v[j].x + v[j].y * v[j].y) + (v[j].z * v[j].z + v[j].w * v[j].w); }
    const float rstd = rsqrtf(wave_sum(s2) * (1.f / D) + LN_EPS);
    float lg[32];
#pragma unroll
    for (int e = 0; e < 32; ++e) lg[e] = 0.f;
#pragma unroll
    for (int j = 0; j < 4; ++j) {
        const int c0 = 4 * lane + 256 * j;
        const f32x4 gg = *(const f32x4*)(ln1_g + c0), bb = *(const f32x4*)(ln1_b + c0);
        v[j] = v[j] * rstd * gg + bb;
        zr[64 * j] = v[j];
        u32x2 o; o.x = pk2(v[j].x, v[j].y); o.y = pk2(v[j].z, v[j].w);
        *((u32x2*)(HB + (size_t)tok * D + c0)) = o;
#pragma unroll
        for (int i = 0; i < 4; ++i) {
            const float hv = v[j][i];
            const f32x4* wr = (const f32x4*)(w_r + (size_t)(c0 + i) * 32);
#pragma unroll
            for (int e4 = 0; e4 < 8; ++e4) { const f32x4 ww = wr[e4]; lg[e4 * 4 + 0] += hv * ww.x; lg[e4 * 4 + 1] += hv * ww.y; lg[e4 * 4 + 2] += hv * ww.z; lg[e4 * 4 + 3] += hv * ww.w; }
        }
    }
#pragma unroll
    for (int e = 0; e < 32; ++e) lg[e] = wave_sum(lg[e]) + b_r[e];
    int bi[4]; float bv[4];
#pragma unroll
    for (int k = 0; k < 4; ++k) {
        float best = -INFINITY; int b = 0;
#pragma unroll
        for (int e = 0; e < 32; ++e) if (lg[e] > best) { best = lg[e]; b = e; }
#pragma unroll
        for (int e = 0; e < 32; ++e) if (e == b) lg[e] = -INFINITY;
        bi[k] = b; bv[k] = best;
    }
    float ex[4], es = 0.f;
#pragma unroll
    for (int k = 0; k < 4; ++k) { ex[k] = __expf(bv[k] - bv[0]); es += ex[k]; }
    if (lane == 0) {
#pragma unroll
        for (int k = 0; k < 4; ++k) {
            const unsigned pos = atomicAdd(&cnt[bi[k]], 1u);
            meta[MT_SEL_E + tok * 4 + k] = bi[k]; meta[MT_SEL_POS + tok * 4 + k] = (int)pos;
            ((float*)meta)[MT_SEL_G + tok * 4 + k] = ex[k] / es;
        }
    }
}

__global__ void k_dispatch1(const unsigned* cnt, int* meta) {
    __shared__ int ts[33];
    if (threadIdx.x == 0) { int acc = 0; for (int e = 0; e < 32; ++e) { ts[e] = acc; acc += ((int)cnt[e] + 255) >> 8; } ts[32] = acc; meta[MT_NT] = acc; }
    __syncthreads();
    if (threadIdx.x < 33) meta[MT_TSTART + threadIdx.x] = ts[threadIdx.x];
    for (int t = threadIdx.x; t < NT_MAX; t += blockDim.x) { int e = 0; for (int j = 1; j < 32; ++j) if (t >= ts[j]) e = j; meta[MT_TILE_E + t] = e; }
}
__global__ void k_rowinit(int* meta) {
    const int i = blockIdx.x * blockDim.x + threadIdx.x;
    if (i < NROWS_MAX) { meta[MT_ROW_TOK + i] = 0; ((float*)meta)[MT_ROW_GATE + i] = 0.f; }
}
__global__ void k_scatter(int* meta) {
    const int i = blockIdx.x * blockDim.x + threadIdx.x;
    if (i < T * 4) {
        const int e = meta[MT_SEL_E + i], row = meta[MT_TSTART + e] * 256 + meta[MT_SEL_POS + i];
        meta[MT_ROW_TOK + row] = i >> 2; ((float*)meta)[MT_ROW_GATE + row] = ((const float*)meta)[MT_SEL_G + i]; meta[MT_SLOT_ROW + i] = row;
    }
}

struct EpiGateUpN {
    const float* bg; const float* bu; bf16* HID;
    __device__ __forceinline__ void operator()(int row, int c, float a, float b) const {
        const float gt = fminf(a + bg[c], 7.0f), up = fminf(fmaxf(b + bu[c], -7.0f), 7.0f);
        const float hid = gt / (1.0f + __expf(-1.702f * gt)) * (up + 1.0f);
        HID[(size_t)row * DFF + c] = (bf16)f2bf(hid);
    }
};
__global__ void __launch_bounds__(256) k_gateup_naive(const bf16* HB, const int* meta, const float* w_gate, const float* b_gate, const float* w_up, const float* b_up, bf16* HID) {
    const int tile = blockIdx.x >> 2, sub = blockIdx.x & 3;
    if (tile >= meta[MT_NT]) return;
    const int e = meta[MT_TILE_E + tile];
    EpiGateUpN epi{b_gate + (size_t)e * DFF, b_up + (size_t)e * DFF, HID};
    naive_gemm_tile<2>(HB, D, meta + MT_ROW_TOK, tile * 256 + sub * 64, w_gate + (size_t)e * D * DFF, w_up + (size_t)e * D * DFF, DFF, blockIdx.y * 64, D, epi);
}
struct EpiDownN {
    const float* bd; const float* row_gate; bf16* Y;
    __device__ __forceinline__ void operator()(int row, int c, float a, float) const { Y[(size_t)row * D + c] = (bf16)f2bf((a + bd[c]) * row_gate[row]); }
};
__global__ void __launch_bounds__(256) k_down_naive(const bf16* HID, const int* meta, const float* w_down, const float* b_down, bf16* Y) {
    const int tile = blockIdx.x >> 2, sub = blockIdx.x & 3;
    if (tile >= meta[MT_NT]) return;
    const int e = meta[MT_TILE_E + tile];
    EpiDownN epi{b_down + (size_t)e * D, (const float*)meta + MT_ROW_GATE, Y};
    naive_gemm_tile<1>(HID, DFF, nullptr, tile * 256 + sub * 64, w_down + (size_t)e * DFF * D, nullptr, D, blockIdx.y * 64, DFF, epi);
}

__global__ void __launch_bounds__(256) k_final_naive(float* HO, const bf16* Y, const int* meta, const float* ln2_g, const float* ln2_b) {
    const int w = threadIdx.x >> 6, lane = threadIdx.x & 63;
    const int tok = blockIdx.x * 4 + w;
    f32x4* hr = (f32x4*)(HO + (size_t)tok * D) + lane;
    f32x4 v[4]; float s = 0.f;
#pragma unroll
    for (int j = 0; j < 4; ++j) v[j] = hr[64 * j] * ALPHA;
#pragma unroll
    for (int k = 0; k < 4; ++k) {
        const int row = meta[MT_SLOT_ROW + tok * 4 + k];
        const u32x2* yr = (const u32x2*)(Y + (size_t)row * D) + lane;
#pragma unroll
        for (int j = 0; j < 4; ++j) { const u32x2 y = yr[64 * j]; v[j].x += __uint_as_float(y.x << 16); v[j].y += __uint_as_float(y.x & 0xffff0000u); v[j].z += __uint_as_float(y.y << 16); v[j].w += __uint_as_float(y.y & 0xffff0000u); }
    }
#pragma unroll
    for (int j = 0; j < 4; ++j) s += (v[j].x + v[j].y) + (v[j].z + v[j].w);
    const float mean = wave_sum(s) * (1.f / D); float s2 = 0.f;
#pragma unroll
    for (int j = 0; j < 4; ++j) { v[j] = v[j] - mean; s2 += (v[j].x * v[j].x + v[j].y * v[j].y) + (v[j].z * v[j].z + v[j].w * v[j].w); }
    const float rstd = rsqrtf(wave_sum(s2) * (1.f / D) + LN_EPS);
#pragma unroll
    for (int j = 0; j < 4; ++j) { const int c0 = 4 * lane + 256 * j; const f32x4 gg = *(const f32x4*)(ln2_g + c0), bb = *(const f32x4*)(ln2_b + c0); hr[64 * j] = v[j] * rstd * gg + bb; }
}

#define LAS __attribute__((address_space(3)))
#define GAS __attribute__((address_space(1)))
typedef short bf16x8 __attribute__((ext_vector_type(8)));
typedef float f32x16 __attribute__((ext_vector_type(16)));
typedef float f32x2 __attribute__((ext_vector_type(2)));
__device__ __forceinline__ unsigned cvt_pk_bf16(float lo, float hi) { unsigned r; asm volatile("v_cvt_pk_bf16_f32 %0, %1, %2" : "=v"(r) : "v"(lo), "v"(hi)); return r; }
__device__ __forceinline__ float fast_gelu(float x) {
    const float u = -2.0f * 0.7978845608028654f * LOG2E * (x + 0.044715f * x * x * x);
    return x * __builtin_amdgcn_rcpf(1.0f + __builtin_amdgcn_exp2f(u));
}
__device__ __forceinline__ void st16_wt(void* p, u32x4 v) {
#ifdef USE_WT_STORE
    asm volatile("global_store_dwordx4 %0, %1, off sc1\n\ts_nop 1" :: "v"(p), "v"(v) : "memory");
#else
    *(u32x4*)p = v;
#endif
}
namespace pg8 {
constexpr int BM = 256, BK = 64, HALF = 128, HTB = HALF * BK * 2  , STAGE_BYTES = 8 * HTB, NXCD = 8, WGM = 8;
__host__ __device__ __forceinline__ int lds_byte(int r, int c) { const int st = (r >> 4) * 2 + (c >> 5), rr = r & 15, cc = c & 31, ob = rr * 64 + cc * 2; return st * 1024 + (ob ^ (((ob >> 9) & 1) << 5)); }
__host__ __device__ __forceinline__ void stage_rc(int b, int& R, int& C) { const int st = b / 1024, sb = b % 1024, swz = sb ^ (((sb >> 9) & 1) << 5); R = (st >> 1) * 16 + swz / 64; C = (st & 1) * 32 + (swz % 64) / 2; }
__host__ __device__ __forceinline__ int perm32(int rho) { const int n = rho >> 4, i = rho & 15; return 8 * (i >> 2) + 4 * n + (i & 3); }

struct Unit { int pm, pn; };
struct Gemm { const void* A; const void* Bt; int KB; const int* tile_e; unsigned e_stride; };
typedef int i32x4 __attribute__((ext_vector_type(4)));

struct StaticOrder {
    int nM, nN, nwg, G, c, i0 = 0, i1 = 1 << 30;
    __device__ void init(int nM_, int nN_, int G_, int c_) { nM = nM_; nN = nN_; nwg = nM * nN; G = G_; c = c_; }
    __device__ bool next(int i, Unit& u) const {
        i += i0; if (i >= i1) return false;
        const long L = (long)i * G + c; if (L >= nwg) return false;
        int wgid = (int)L; { const int q = nwg / NXCD, r = nwg % NXCD, xcd = wgid % NXCD, off = wgid / NXCD; wgid = (xcd < r ? xcd * (q + 1) : r * (q + 1) + (xcd - r) * q) + off; }
        const int nig = WGM * nN, gid = wgid / nig, fm = gid * WGM, gsz = (nM - fm) < WGM ? (nM - fm) : WGM;
        u.pm = fm + ((wgid % nig) % gsz); u.pn = (wgid % nig) / gsz; return true;
    }
};

template <class Epi, bool GATHER, bool ALIGN_EPI, bool I8>
__device__ __forceinline__ void gemm_phase(LAS unsigned char* lds, const LAS int* rtab, const Gemm g, const StaticOrder& S, const Epi& E) {
    int tid_ = threadIdx.x; asm volatile("" : "+v"(tid_));
    const int tid = tid_, wid = __builtin_amdgcn_readfirstlane(tid >> 6), lane = tid & 63, wr = wid >> 2, wc = wid & 3, fr = lane & 15, fq = lane >> 4;
    const int KB = g.KB, nt = KB / (BK * 2);
    int Rs[2], Cs[2]; unsigned voffB[2];
#pragma unroll
    for (int i = 0; i < 2; ++i) { int R, C; stage_rc(tid * 16 + i * 8192, R, C); const int Rb = Epi::PERM == 2 ? (64 * (R >> 5) + 16 * ((R >> 2) & 3) + 4 * ((R >> 4) & 1) + (R & 3)) : Epi::PERM ? ((R & ~31) + perm32(R & 31)) : R; Rs[i] = R; Cs[i] = C; voffB[i] = (unsigned)(Rb * KB + C * 2); }
    const size_t kstep = (size_t)(BK * 2);
    const size_t hstep = (size_t)HALF * KB;
    const size_t tstep = 2 * hstep;
    const size_t bhstep = Epi::PERM == 2 ? (size_t)8 * KB : hstep;
    const unsigned ldsw = (unsigned)wid * 1024u;
    const int aoff = lds_byte(wr * 64 + fr, fq * 8), boff = lds_byte(wc * 32 + fr, fq * 8);
#define PG8_SA(b, h) (((b) * 2 + (h)) * HTB)
#define PG8_SB(b, h) ((4 + (b) * 2 + (h)) * HTB)
#define PG8_STAGE(bufoff, gbase, voff) do { _Pragma("unroll") for (int _i = 0; _i < 2; ++_i) \
        __builtin_amdgcn_global_load_lds((const unsigned*)((const char*)(gbase) + (voff)[_i]), (LAS unsigned*)(lds + (bufoff) + ldsw + _i * 8192), 16, 0, 0); } while (0)
#define PG8_LDA(dst, b, h) do { _Pragma("unroll") for (int m = 0; m < 4; ++m) _Pragma("unroll") for (int k = 0; k < 2; ++k) dst[m][k] = *(const LAS bf16x8*)(lds + PG8_SA(b, h) + aoff + m * 2048 + k * 1024); } while (0)
#define PG8_LDB(dst, b, h) do { _Pragma("unroll") for (int n = 0; n < 2; ++n) _Pragma("unroll") for (int k = 0; k < 2; ++k) dst[n][k] = *(const LAS bf16x8*)(lds + PG8_SB(b, h) + boff + n * 2048 + k * 1024); } while (0)
#define PG8_MMA(ai, bj, At, Bt) do { __builtin_amdgcn_s_setprio(1); _Pragma("unroll") for (int m = 0; m < 4; ++m) _Pragma("unroll") for (int n = 0; n < 2; ++n) _Pragma("unroll") for (int k = 0; k < 2; ++k) \
        { if constexpr (I8) acc[ai][bj][m][n] = __builtin_bit_cast(f32x4, __builtin_amdgcn_mfma_i32_16x16x64_i8(__builtin_bit_cast(i32x4, Bt[n][k]), __builtin_bit_cast(i32x4, At[m][k]), __builtin_bit_cast(i32x4, acc[ai][bj][m][n]), 0, 0, 0)); \
          else acc[ai][bj][m][n] = __builtin_amdgcn_mfma_f32_16x16x32_bf16(Bt[n][k], At[m][k], acc[ai][bj][m][n], 0, 0, 0); } __builtin_amdgcn_s_setprio(0); } while (0)
#define PG8_WAIT_V(n) asm volatile("s_waitcnt vmcnt(" #n ")" ::: "memory")
#define PG8_WAIT_L(n) asm volatile("s_waitcnt lgkmcnt(" #n ")" ::: "memory")
#define PG8_BAR __builtin_amdgcn_s_barrier()
#define PG8_SCHED __builtin_amdgcn_sched_barrier(0)
#define PG8_VOFFA(vo, ui_, u_) do { _Pragma("unroll") for (int h_ = 0; h_ < 2; ++h_) _Pragma("unroll") for (int i_ = 0; i_ < 2; ++i_) { \
        const int row_ = GATHER ? rtab[(ui_) * 256 + h_ * 128 + Rs[i_]] : ((u_).pm * 256 + h_ * 128 + Rs[i_]); \
        vo[h_][i_] = (unsigned)(row_ * KB + Cs[i_] * 2); } } while (0)
#define PG8_BBASE(u_) ((const char*)g.Bt + (g.tile_e ? (size_t)g.tile_e[(u_).pm] * g.e_stride : (size_t)0) + (size_t)(u_).pn * tstep)
    Unit cur, nxt; int ui = 0;
    if (!S.next(0, cur)) return;
    f32x4 acc[2][2][4][2];
    if constexpr (Epi::HAS_INIT) E.init(acc, cur, wr, wc, fr, fq);
    else {
#pragma unroll
    for (int a = 0; a < 2; ++a)
#pragma unroll
        for (int b = 0; b < 2; ++b)
#pragma unroll
            for (int m = 0; m < 4; ++m)
#pragma unroll
                for (int n = 0; n < 2; ++n) acc[a][b][m][n] = (f32x4){0.f, 0.f, 0.f, 0.f};
    }
    bf16x8 At[4][2], B0[2][2], B1[2][2];
    unsigned vAc[2][2], vAn[2][2];
    PG8_VOFFA(vAc, 0, cur);
    const char* const gA = (const char*)g.A;
    const char* cB = PG8_BBASE(cur);
    PG8_STAGE(PG8_SB(0, 0), cB, voffB); PG8_STAGE(PG8_SB(0, 1), cB + bhstep, voffB); PG8_STAGE(PG8_SA(0, 0), gA, vAc[0]); PG8_STAGE(PG8_SA(0, 1), gA, vAc[1]);
    if (wr == 1) PG8_BAR;
    PG8_WAIT_V(2); PG8_BAR;
    PG8_STAGE(PG8_SB(1, 0), cB + kstep, voffB); PG8_STAGE(PG8_SA(1, 0), gA + kstep, vAc[0]); PG8_STAGE(PG8_SB(1, 1), cB + bhstep + kstep, voffB);
    PG8_WAIT_V(6); PG8_BAR;
    for (;;) {
        const bool has_next = S.next(ui + 1, nxt);
        const char* nB = cB;
        if (has_next) { nB = PG8_BBASE(nxt); PG8_VOFFA(vAn, ui + 1, nxt); }
        else {
#pragma unroll
            for (int h = 0; h < 2; ++h)
#pragma unroll
                for (int i = 0; i < 2; ++i) vAn[h][i] = vAc[h][i];
        }
        for (int t = 0; t < nt; t += 2) {
            const bool last = (t == nt - 2);
            const char* a1 = gA + (size_t)(t + 1) * kstep;
            const char* a2 = last ? gA : gA + (size_t)(t + 2) * kstep; const char* b2 = last ? nB : cB + (size_t)(t + 2) * kstep;
            const char* a3 = a2 + kstep; const char* b3 = b2 + kstep;
            unsigned v2[2][2];
#pragma unroll
            for (int h = 0; h < 2; ++h)
#pragma unroll
                for (int i = 0; i < 2; ++i) v2[h][i] = last ? vAn[h][i] : vAc[h][i];
            PG8_LDB(B0, 0, 0); PG8_LDB(B1, 0, 1); PG8_SCHED; PG8_LDA(At, 0, 0); PG8_STAGE(PG8_SA(1, 1), a1, vAc[1]);
            PG8_WAIT_V(8); PG8_WAIT_L(0); PG8_BAR; PG8_MMA(0, 0, At, B0); PG8_MMA(0, 1, At, B1); PG8_BAR; PG8_SCHED;
            PG8_LDA(At, 0, 1); PG8_STAGE(PG8_SB(0, 0), b2, voffB); PG8_STAGE(PG8_SB(0, 1), b2 + bhstep, voffB); PG8_STAGE(PG8_SA(0, 0), a2, v2[0]);
            PG8_WAIT_V(8); PG8_WAIT_L(0); PG8_BAR; PG8_MMA(1, 0, At, B0); PG8_MMA(1, 1, At, B1); PG8_BAR; PG8_SCHED;
            PG8_LDB(B0, 1, 0); PG8_LDB(B1, 1, 1); PG8_SCHED; PG8_LDA(At, 1, 0); PG8_STAGE(PG8_SA(0, 1), a2, v2[1]);
            PG8_WAIT_V(8); PG8_WAIT_L(0); PG8_BAR; PG8_MMA(0, 0, At, B0); PG8_MMA(0, 1, At, B1); PG8_BAR; PG8_SCHED;
            PG8_LDA(At, 1, 1); PG8_STAGE(PG8_SB(1, 0), b3, voffB); PG8_STAGE(PG8_SB(1, 1), b3 + bhstep, voffB); PG8_STAGE(PG8_SA(1, 0), a3, v2[0]);
            PG8_WAIT_V(8); PG8_WAIT_L(0); PG8_BAR; PG8_MMA(1, 0, At, B0); PG8_MMA(1, 1, At, B1); PG8_BAR; PG8_SCHED;
        }
        if constexpr (ALIGN_EPI) { if (wr == 0) PG8_BAR; }
        E(acc, cur, wr, wc, fr, fq);
        if (!has_next) break;
        if constexpr (Epi::HAS_INIT) E.init(acc, nxt, wr, wc, fr, fq);
        else {
#pragma unroll
        for (int a = 0; a < 2; ++a)
#pragma unroll
            for (int b = 0; b < 2; ++b)
#pragma unroll
                for (int m = 0; m < 4; ++m)
#pragma unroll
                    for (int n = 0; n < 2; ++n) acc[a][b][m][n] = (f32x4){0.f, 0.f, 0.f, 0.f};
        }
        cur = nxt; cB = nB; ++ui;
#pragma unroll
        for (int h = 0; h < 2; ++h)
#pragma unroll
            for (int i = 0; i < 2; ++i) vAc[h][i] = vAn[h][i];
        if constexpr (ALIGN_EPI) { if (wr == 1) PG8_BAR; }
    }
    PG8_WAIT_V(0);
    if constexpr (!ALIGN_EPI) { if (wr == 0) PG8_BAR; }
    PG8_BAR;
#undef PG8_SA
#undef PG8_SB
#undef PG8_STAGE
#undef PG8_LDA
#undef PG8_LDB
#undef PG8_MMA
#undef PG8_WAIT_V
#undef PG8_WAIT_L
#undef PG8_BAR
#undef PG8_SCHED
#undef PG8_VOFFA
#undef PG8_BBASE
}

struct EpiInProj {
    static constexpr int PERM = 1; static constexpr bool HAS_INIT = false;
    const float* b_in; bf16 *QB, *KB, *VT, *UB, *GB;
    __device__ __forceinline__ void operator()(const f32x4 (&acc)[2][2][4][2], const Unit& u, int wr, int wc, int fr, int fq) const {
        const int row0 = u.pm * BM + wr * 64 + fr;
#pragma unroll
        for (int bj = 0; bj < 2; ++bj) {
            const int reg = u.pn * BM + bj * HALF;
            const int c0 = reg + wc * 32 + 8 * fq;
            const f32x4 bv0 = *(const f32x4*)(b_in + c0), bv1 = *(const f32x4*)(b_in + c0 + 4);
#pragma unroll
            for (int ai = 0; ai < 2; ++ai)
#pragma unroll
                for (int m = 0; m < 4; ++m) {
                    const int row = row0 + ai * HALF + m * 16;
                    f32x4 v0 = acc[ai][bj][m][0] + bv0, v1 = acc[ai][bj][m][1] + bv1;
                    if (reg >= 640 && reg < 768) {
                        const int cv = c0 - 640, gg = cv >> 6, d = cv & 63, b = row / SEQ, s = row % SEQ;
                        bf16* vp = VT + ((size_t)((b * 2 + gg) * 64 + d)) * SEQ + s;
#pragma unroll
                        for (int j = 0; j < 4; ++j) { vp[(size_t)j * SEQ] = (bf16)f2bf(v0[j]); vp[(size_t)(j + 4) * SEQ] = (bf16)f2bf(v1[j]); }
                    } else {
                        bf16* dst;
                        if (reg < 512) { v0 = v0 * C2; v1 = v1 * C2; dst = QB + (size_t)row * 512 + c0; }
                        else if (reg < 640) { dst = KB + (size_t)row * 128 + (c0 - 512); }
                        else {
#pragma unroll
                            for (int j = 0; j < 4; ++j) { v0[j] = fast_gelu(v0[j]); v1[j] = fast_gelu(v1[j]); }
                            dst = (reg < 1280) ? (UB + (size_t)row * 512 + (c0 - 768)) : (GB + (size_t)row * 512 + (c0 - 1280));
                        }
                        u32x4 w; w.x = cvt_pk_bf16(v0[0], v0[1]); w.y = cvt_pk_bf16(v0[2], v0[3]); w.z = cvt_pk_bf16(v1[0], v1[1]); w.w = cvt_pk_bf16(v1[2], v1[3]);
                        *(u32x4*)dst = w;
                    }
                }
        }
    }
};
struct EpiOutProj {
    static constexpr int PERM = 0; static constexpr bool HAS_INIT = true;
    const float* x; const float* b_out; float* Z;
    __device__ __forceinline__ void init(f32x4 (&acc)[2][2][4][2], const Unit& u, int wr, int wc, int fr, int fq) const {
        const int col0 = u.pn * BM + wc * 32 + 4 * fq;
#pragma unroll
        for (int ai = 0; ai < 2; ++ai)
#pragma unroll
            for (int m = 0; m < 4; ++m) {
                const size_t off = (size_t)(u.pm * BM + ai * HALF + wr * 64 + m * 16 + fr) * D + col0;
#pragma unroll
                for (int bj = 0; bj < 2; ++bj)
#pragma unroll
                    for (int n = 0; n < 2; ++n) acc[ai][bj][m][n] = *(const f32x4*)(x + off + bj * HALF + n * 16) * ALPHA + *(const f32x4*)(b_out + col0 + bj * HALF + n * 16);
            }
    }
    __device__ __forceinline__ void operator()(const f32x4 (&acc)[2][2][4][2], const Unit& u, int wr, int wc, int fr, int fq) const {
        const int col0 = u.pn * BM + wc * 32 + 4 * fq;
#pragma unroll
        for (int ai = 0; ai < 2; ++ai)
#pragma unroll
            for (int m = 0; m < 4; ++m) {
                const size_t off = (size_t)(u.pm * BM + ai * HALF + wr * 64 + m * 16 + fr) * D + col0;
#pragma unroll
                for (int bj = 0; bj < 2; ++bj)
#pragma unroll
                    for (int n = 0; n < 2; ++n) *(f32x4*)(Z + off + bj * HALF + n * 16) = acc[ai][bj][m][n];
            }
    }
};
struct EpiSwiglu {
    static constexpr int PERM = 1; static constexpr bool HAS_INIT = false;
    const int* tile_e; const float* b_gate; const float* b_up; const float* swgu; const float* row_sa; bf16* HID;
    __device__ __forceinline__ void operator()(const f32x4 (&acc)[2][2][4][2], const Unit& u, int wr, int wc, int fr, int fq) const {
        const int e = tile_e[u.pm];
        const int fc0 = u.pn * HALF + wc * 32 + 8 * fq;
        const float* sw = swgu + e * 2048 + u.pn * 256 + wc * 32 + 8 * fq;
        float sa[2][4];
#pragma unroll
        for (int ai = 0; ai < 2; ++ai)
#pragma unroll
            for (int m = 0; m < 4; ++m) sa[ai][m] = row_sa[u.pm * BM + ai * HALF + wr * 64 + m * 16 + fr];
        f32x4 gb[2], ub[2], sg[2], su[2];
#pragma unroll
        for (int n = 0; n < 2; ++n) { gb[n] = *(const f32x4*)(b_gate + e * DFF + fc0 + 4 * n); ub[n] = *(const f32x4*)(b_up + e * DFF + fc0 + 4 * n); sg[n] = *(const f32x4*)(sw + 4 * n); su[n] = *(const f32x4*)(sw + 128 + 4 * n); }
#pragma unroll
        for (int ai = 0; ai < 2; ++ai)
#pragma unroll
            for (int m = 0; m < 4; ++m) {
                const int row = u.pm * BM + ai * HALF + wr * 64 + m * 16 + fr;
                float hv[8];
#pragma unroll
                for (int n = 0; n < 2; ++n)
#pragma unroll
                    for (int j = 0; j < 4; ++j) {
                        const float ga = (float)__float_as_int(acc[ai][0][m][n][j]) * (sa[ai][m] * sg[n][j]) + gb[n][j];
                        const float ua = (float)__float_as_int(acc[ai][1][m][n][j]) * (sa[ai][m] * su[n][j]) + ub[n][j];
                        const float gt = fminf(ga, 7.0f), up = __builtin_amdgcn_fmed3f(ua, -7.0f, 7.0f);
                        hv[4 * n + j] = gt * __builtin_amdgcn_rcpf(1.0f + __builtin_amdgcn_exp2f(-1.702f * LOG2E * gt)) * (up + 1.0f);
                    }
                u32x4 w; w.x = cvt_pk_bf16(hv[0], hv[1]); w.y = cvt_pk_bf16(hv[2], hv[3]); w.z = cvt_pk_bf16(hv[4], hv[5]); w.w = cvt_pk_bf16(hv[6], hv[7]);
                *(u32x4*)(HID + (size_t)row * DFF + fc0) = w;
            }
    }
};
struct EpiDown {
    static constexpr int PERM = 2; static constexpr bool HAS_INIT = false;
    const int* tile_e; const float* b_down; const float* swd; const float* row_sb; const float* row_gate; unsigned char* Y;
    __device__ __forceinline__ void operator()(const f32x4 (&acc)[2][2][4][2], const Unit& u, int wr, int wc, int fr, int fq) const {
        const int e = tile_e[u.pm];
        const int c0 = u.pn * BM + wc * 64 + 16 * fq;
        f32x4 bv[2][2], sw[2][2];
#pragma unroll
        for (int bj = 0; bj < 2; ++bj)
#pragma unroll
            for (int n = 0; n < 2; ++n) { bv[bj][n] = *(const f32x4*)(b_down + e * D + c0 + 8 * bj + 4 * n); sw[bj][n] = *(const f32x4*)(swd + e * D + c0 + 8 * bj + 4 * n); }
#pragma unroll
        for (int ai = 0; ai < 2; ++ai)
#pragma unroll
            for (int m = 0; m < 4; ++m) {
                const int row = u.pm * BM + ai * HALF + wr * 64 + m * 16 + fr;
                const float gt = row_gate[row] * YSCALE, sb = row_sb[row] * gt;
                u32x4 w;
#pragma unroll
                for (int bj = 0; bj < 2; ++bj)
#pragma unroll
                    for (int n = 0; n < 2; ++n) {
                        float v[4];
#pragma unroll
                        for (int j = 0; j < 4; ++j) v[j] = __builtin_amdgcn_fmed3f((float)__float_as_int(acc[ai][bj][m][n][j]) * (sb * sw[bj][n][j]) + bv[bj][n][j] * gt, -448.0f, 448.0f);
                        int d = 0;
                        d = __builtin_amdgcn_cvt_pk_fp8_f32(v[0], v[1], d, false);
                        d = __builtin_amdgcn_cvt_pk_fp8_f32(v[2], v[3], d, true);
                        w[2 * bj + n] = (unsigned)d;
                    }
                *(u32x4*)(Y + (size_t)row * D + c0) = w;
            }
    }
};
}
constexpr int NWAVES = 8;
constexpr int NPHASES = 10;
constexpr size_t WS_WIN = WS_HID + 144 * MiB;
constexpr size_t WS_WOUT = WS_WIN + 4 * MiB;
constexpr size_t WS_WGU = WS_WOUT + 2 * MiB;
constexpr size_t WS_SWGU = WS_WGU + 64 * MiB;
constexpr size_t WS_WD = WS_SWGU + 1 * MiB;
constexpr size_t WS_SWD = WS_WD + 32 * MiB;
constexpr size_t WS_HID8 = WS_SWD + 1 * MiB;
constexpr size_t WS_END = WS_HID8 + 72 * MiB;
constexpr int CW_BAR = 4096;
constexpr int RING_BYTES = 131072;
constexpr int RTAB_OFF = RING_BYTES;
constexpr int RTAB_UNITS = 12;
constexpr int RW_BYTES = 1024 * 144;
constexpr int RSCR_OFF = RW_BYTES;
constexpr int LDS_BYTES = 163840;
constexpr int MISC_OFF = LDS_BYTES - 256;
static_assert(RTAB_OFF + RTAB_UNITS * 1024 <= MISC_OFF && RSCR_OFF + 4096 <= MISC_OFF, "LDS map");

typedef GAS unsigned gu32;
#define RLX_AGENT __ATOMIC_RELAXED, __HIP_MEMORY_SCOPE_AGENT
#define LDS_WAIT() asm volatile("s_waitcnt lgkmcnt(0)" ::: "memory")
#define VM_WAIT() asm volatile("s_waitcnt vmcnt(0)" ::: "memory")

#define XB_TMO      128
#define XB_XCNT(j)  (256  + 64 * (j))
#define XB_XSUB(j)  (1280 + 64 * (j))
#define XB_XGEN(j)  (2304 + 64 * (j))
#define XB_TOP      3328
#define XB_TOPGEN   3392
#define XCD_BAR_WORDS 3456
#define XB_SPIN_CAP (1u << 18)
__device__ __forceinline__ unsigned xb_ld(unsigned* p)              { return __hip_atomic_load(p, __ATOMIC_RELAXED, __HIP_MEMORY_SCOPE_AGENT); }
__device__ __forceinline__ unsigned xb_add(unsigned* p, unsigned v) { return __hip_atomic_fetch_add(p, v, __ATOMIC_RELAXED, __HIP_MEMORY_SCOPE_AGENT); }
__device__ __forceinline__ unsigned xb_xcc_id() { return (unsigned)__builtin_amdgcn_s_getreg((3 << 11) | 20) & 0xFu; }
#define XB_SPIN(cond, bar) do { unsigned _sp = 0; while (cond) { __builtin_amdgcn_s_sleep(1); \
    if ((++_sp & 255u) == 0u) { if (xb_ld(&(bar)[XB_TMO])) break; if (_sp > XB_SPIN_CAP) { atomicAdd(&(bar)[XB_TMO], 1u); break; } } } } while (0)
struct XcdBarrier { unsigned* bar; unsigned x; volatile LAS unsigned* st; };
__device__ __forceinline__ XcdBarrier xcd_barrier_post(unsigned* bar, volatile LAS unsigned* st) {
    XcdBarrier b; b.bar = bar; b.x = xb_xcc_id(); b.st = st;
    if (threadIdx.x == 0) (void)xb_add(&bar[XB_XCNT(b.x)], 1u);
    return b;
}
__device__ __forceinline__ void xcd_barrier_complete(unsigned* bar, unsigned x, unsigned& nloc, unsigned& nx) {
    const unsigned G = gridDim.x * gridDim.y * gridDim.z;
    unsigned sum, cnt, mine, sp = 0u;
    for (;;) {
        sum = 0u; cnt = 0u; mine = 0u;
#pragma unroll
        for (unsigned j = 0; j < 16; ++j) { const unsigned c = xb_ld(&bar[XB_XCNT(j)]); sum += c; cnt += (c > 0u) ? 1u : 0u; mine = (j == x) ? c : mine; }
        if (sum == G) break;
        __builtin_amdgcn_s_sleep(1);
        if ((++sp & 255u) == 0u) { if (xb_ld(&bar[XB_TMO])) break; if (sp > XB_SPIN_CAP) { atomicAdd(&bar[XB_TMO], 1u); break; } }
    }
    nloc = mine > 0u ? mine : 1u; nx = cnt > 0u ? cnt : 1u;
}
__device__ __forceinline__ void xcd_barrier(const XcdBarrier& b) {
    asm volatile("s_waitcnt vmcnt(0)" ::: "memory");
    __syncthreads();
    if (threadIdx.x == 0) {
        unsigned* bar = b.bar;
        __builtin_amdgcn_s_waitcnt(0);
        unsigned nloc = b.st[0], nx = b.st[1];
        if (nloc == 0u) { xcd_barrier_complete(bar, b.x, nloc, nx); b.st[0] = nloc; b.st[1] = nx; }
        const unsigned old = xb_add(&bar[XB_XSUB(b.x)], 1u);
        const unsigned gen = old / nloc;
        if (old + 1u == (gen + 1u) * nloc) {
            __builtin_amdgcn_fence(__ATOMIC_RELEASE, "agent");
            asm volatile("s_waitcnt vmcnt(0)" ::: "memory");
            const unsigned og = xb_add(&bar[XB_TOP], 1u);
            const unsigned tg = og / nx;
            if (og + 1u == (tg + 1u) * nx) xb_add(&bar[XB_TOPGEN], 1u);
            else XB_SPIN(xb_ld(&bar[XB_TOPGEN]) == tg, bar);
            __builtin_amdgcn_fence(__ATOMIC_ACQUIRE, "agent");
            xb_add(&bar[XB_XGEN(b.x)], 1u);
            asm volatile("s_waitcnt vmcnt(0)" ::: "memory");
        } else {
            XB_SPIN(xb_ld(&bar[XB_XGEN(b.x)]) == gen, bar);
            __builtin_amdgcn_fence(__ATOMIC_ACQUIRE, "agent");
            asm volatile("s_waitcnt vmcnt(0)" ::: "memory");
        }
    }
    __syncthreads();
}

struct Args {
    const float* in[22]; float* out; unsigned char* ws; int ph_lo, ph_hi, li, pad;
};
struct Frame {
    LAS unsigned char* lds;
    int tid, lane, wave, vcu, G;
};
__device__ __forceinline__ void p0_item(const float* W, int N, bf16* WT, int K, int dst_row0, int k0, int n0, LAS float* scr, int lane) {
    f32x4 v[8];
#pragma unroll
    for (int i = 0; i < 8; ++i) v[i] = *(const f32x4*)(W + (size_t)(k0 + (lane >> 3) + 8 * i) * N + n0 + 4 * (lane & 7));
#pragma unroll
    for (int i = 0; i < 8; ++i) { LAS float* s = scr + ((lane >> 3) + 8 * i) * 33 + 4 * (lane & 7); s[0] = v[i].x; s[1] = v[i].y; s[2] = v[i].z; s[3] = v[i].w; }
    LDS_WAIT(); asm volatile("" ::: "memory");
    const int c = lane & 7;
#pragma unroll
    for (int j = 0; j < 4; ++j) { const int n = (lane >> 3) + 8 * j; const LAS float* s = scr + (8 * c) * 33 + n;
        u32x4 o; o.x = pk2(s[0 * 33], s[1 * 33]); o.y = pk2(s[2 * 33], s[3 * 33]); o.z = pk2(s[4 * 33], s[5 * 33]); o.w = pk2(s[6 * 33], s[7 * 33]);
        *(u32x4*)(WT + (size_t)(dst_row0 + n) * K + k0 + 8 * c) = o; }
    LDS_WAIT(); asm volatile("" ::: "memory");
}
struct ConvItem { const float* W; signed char* dst; float* sc; int n0, dst_row0; };
__device__ __forceinline__ ConvItem conv_decode(const Args& a, int it) {
    unsigned char* ws = a.ws;
    const int nb = it & 31, e = (it >> 5) & 31, kind = it >> 10, n0 = nb * 32;
    ConvItem c;
    c.W = (kind == 0 ? a.in[14] : kind == 1 ? a.in[16] : a.in[18]) + (size_t)e * D * DFF;
    c.dst = kind < 2 ? (signed char*)(ws + WS_WGU) + (size_t)e * 2048 * 1024 : (signed char*)(ws + WS_WD) + (size_t)e * 1024 * 1024;
    c.dst_row0 = kind < 2 ? (n0 >> 7) * 256 + kind * 128 + (n0 & 127) : n0;
    c.sc = kind < 2 ? (float*)(ws + WS_SWGU) + e * 2048 : (float*)(ws + WS_SWD) + e * 1024;
    c.n0 = n0; return c;
}
#define CONV_LOAD(v, ci) do { _Pragma("unroll") for (int i_ = 0; i_ < 4; ++i_) _Pragma("unroll") for (int j_ = 0; j_ < 4; ++j_) \
        v[i_][j_] = *(const f32x4*)((ci).W + (size_t)(4 * (kl + 64 * i_) + j_) * DFF + (ci).n0 + 4 * n4); } while (0)
__device__ __forceinline__ void conv_items(const Frame& F, const Args& a, int it_lo, int it_hi) {
    if (it_hi > 3 * NEXP * 32) it_hi = 3 * NEXP * 32;
    if (it_lo >= it_hi) return;
    const int tid = F.tid, n4 = tid & 7, kl = tid >> 3;
    LAS unsigned* tile = (LAS unsigned*)F.lds;
    LAS float* red = (LAS float*)(F.lds + 36864);
    f32x4 v[4][4];
    ConvItem cur = conv_decode(a, it_lo);
    CONV_LOAD(v, cur);
    for (int it = it_lo; it < it_hi; ++it) {
        f32x4 am = (f32x4){0.f, 0.f, 0.f, 0.f};
#pragma unroll
        for (int i = 0; i < 4; ++i)
#pragma unroll
            for (int j = 0; j < 4; ++j) { am.x = fmaxf(am.x, fabsf(v[i][j].x)); am.y = fmaxf(am.y, fabsf(v[i][j].y)); am.z = fmaxf(am.z, fabsf(v[i][j].z)); am.w = fmaxf(am.w, fabsf(v[i][j].w)); }
#pragma unroll
        for (int o = 8; o < 64; o <<= 1) { am.x = fmaxf(am.x, __shfl_xor(am.x, o)); am.y = fmaxf(am.y, __shfl_xor(am.y, o)); am.z = fmaxf(am.z, __shfl_xor(am.z, o)); am.w = fmaxf(am.w, __shfl_xor(am.w, o)); }
        if (F.lane < 8) *(LAS f32x4*)(red + F.wave * 32 + 4 * n4) = am;
        __syncthreads();
        f32x4 cm = *(const LAS f32x4*)(red + 4 * n4);
#pragma unroll
        for (int w = 1; w < 8; ++w) { const f32x4 o = *(const LAS f32x4*)(red + w * 32 + 4 * n4); cm.x = fmaxf(cm.x, o.x); cm.y = fmaxf(cm.y, o.y); cm.z = fmaxf(cm.z, o.z); cm.w = fmaxf(cm.w, o.w); }
        f32x4 inv;
#pragma unroll
        for (int c = 0; c < 4; ++c) inv[c] = cm[c] > 0.f ? 127.0f / cm[c] : 0.f;
        if (kl == 0) {
#pragma unroll
            for (int c = 0; c < 4; ++c) cur.sc[cur.dst_row0 + 4 * n4 + c] = cm[c] * (1.0f / 127.0f);
        }
#pragma unroll
        for (int i = 0; i < 4; ++i)
#pragma unroll
            for (int c = 0; c < 4; ++c) {
                unsigned d = 0u;
#pragma unroll
                for (int j = 0; j < 4; ++j) { const int q = (int)rintf(v[i][j][c] * inv[c]); d |= ((unsigned)q & 0xffu) << (8 * j); }
                tile[(4 * n4 + c) * 260 + kl + 64 * i] = d;
            }
        const ConvItem done = cur;
        if (it + 1 < it_hi) { cur = conv_decode(a, it + 1); CONV_LOAD(v, cur); }
        __syncthreads();
#pragma unroll
        for (int j = 0; j < 4; ++j) { const int ch = tid + 512 * j, n = ch >> 6, c16 = ch & 63;
            *(u32x4*)(done.dst + (size_t)(done.dst_row0 + n) * 1024 + 16 * c16) = *(const LAS u32x4*)(tile + n * 260 + 4 * c16); }
        __syncthreads();
    }
}
__device__ __forceinline__ void p0_prologue(const Frame& F, const Args& a) {
    unsigned char* ws = a.ws;
    bf16* Win_t = (bf16*)(ws + WS_WIN); bf16* Wout_t = (bf16*)(ws + WS_WOUT);
    LAS float* scr = (LAS float*)(F.lds + F.wave * 8448);
    const int gw = F.vcu * NWAVES + F.wave, NGW = F.G * NWAVES;
    constexpr int I_IN = 16 * 56, I_OUT = 16 * 32, NITEMS = I_IN + I_OUT;
    for (int it = gw; it < NITEMS; it += NGW) {
        int r = it;
        if (r < I_IN) { const int kb = r / 56, nb = r % 56; p0_item(a.in[1], INW, Win_t, D, nb * 32, kb * 64, nb * 32, scr, F.lane); continue; } r -= I_IN;
        { const int kb = r / 32, nb = r % 32; p0_item(a.in[8], D, Wout_t, D, nb * 32, kb * 64, nb * 32, scr, F.lane); }
    }
    const float* x = a.in[0]; bf16* XB = (bf16*)(ws + WS_XB);
    for (int m = gw; m < T; m += NGW) {
        const f32x4* xr = (const f32x4*)(x + (size_t)m * D) + F.lane; u32x2* o = (u32x2*)(XB + (size_t)m * D) + F.lane;
        f32x4 v[4];
#pragma unroll
        for (int j = 0; j < 4; ++j) v[j] = xr[64 * j];
#pragma unroll
        for (int j = 0; j < 4; ++j) { u32x2 w; w.x = pk2(v[j].x, v[j].y); w.y = pk2(v[j].z, v[j].w); o[64 * j] = w; }
    }
}

__device__ __forceinline__ int crow(int r, int hi) { return (r & 3) + 8 * (r >> 2) + 4 * hi; }
constexpr int AT_KROW = 144, AT_KG = 192 * AT_KROW, AT_VROW = 400, AT_VG = 64 * AT_VROW, AT_VOFF = 2 * AT_KG;
__device__ __forceinline__ void attn_wave_unit(const LAS unsigned char* lds, const bf16x8 (&qf)[4], const float sk, bf16* CAT, int tok0, int u, int h, int lane) {
    const int r32 = lane & 31, hi = lane >> 5;
    const int t0 = tok0 % SEQ, g = h >> 2;
    const int kk0 = 32 * u;
    f32x16 p[5];
    const float NEG = -INFINITY;
    const LAS unsigned char* kl = lds + g * AT_KG + (kk0 + r32) * AT_KROW + hi * 16;
#pragma unroll
    for (int j = 0; j < 5; ++j) {
        const int kb = t0 - 128 + 32 * j;
        f32x16 s;
#pragma unroll
        for (int r = 0; r < 16; ++r) s[r] = 0.f;
        if (kb >= 0) {
#pragma unroll
            for (int d0 = 0; d0 < 4; ++d0) { const bf16x8 kf = *(const LAS bf16x8*)(kl + j * 32 * AT_KROW + d0 * 32); s = __builtin_amdgcn_mfma_f32_32x32x16_bf16(kf, qf[d0], s, 0, 0, 0); }
            if (j == 0) {
#pragma unroll
                for (int r = 0; r < 16; ++r) if (!(crow(r, hi) > r32)) s[r] = NEG;
            }
            if (j == 4) {
#pragma unroll
                for (int r = 0; r < 16; ++r) if (!(crow(r, hi) <= r32)) s[r] = NEG;
            }
        } else {
#pragma unroll
            for (int r = 0; r < 16; ++r) s[r] = NEG;
        }
        p[j] = s;
    }
    float m = sk;
#pragma unroll
    for (int j = 0; j < 5; ++j)
#pragma unroll
        for (int r = 0; r < 16; ++r) m = fmaxf(m, p[j][r]);
    m = fmaxf(m, __shfl_xor(m, 32));
    float l = 0.f;
#pragma unroll
    for (int j = 0; j < 5; ++j)
#pragma unroll
        for (int r = 0; r < 16; ++r) { const float e = __builtin_amdgcn_exp2f(p[j][r] - m); p[j][r] = e; l += e; }
    l += __shfl_xor(l, 32);
    l += __builtin_amdgcn_exp2f(sk - m);
    const float inv = 1.0f / l;
    u32x4 pb[5][2];
#pragma unroll
    for (int j = 0; j < 5; ++j)
#pragma unroll
        for (int s = 0; s < 2; ++s) { pb[j][s].x = cvt_pk_bf16(p[j][8 * s + 0], p[j][8 * s + 1]); pb[j][s].y = cvt_pk_bf16(p[j][8 * s + 2], p[j][8 * s + 3]); pb[j][s].z = cvt_pk_bf16(p[j][8 * s + 4], p[j][8 * s + 5]); pb[j][s].w = cvt_pk_bf16(p[j][8 * s + 6], p[j][8 * s + 7]); }
#pragma unroll
    for (int db = 0; db < 2; ++db) {
        f32x16 o;
#pragma unroll
        for (int r = 0; r < 16; ++r) o[r] = 0.f;
        const LAS unsigned char* vl = lds + AT_VOFF + g * AT_VG + (db * 32 + r32) * AT_VROW + (kk0 + 4 * hi) * 2;
#pragma unroll
        for (int j = 0; j < 5; ++j) {
            const int kb = t0 - 128 + 32 * j;
            if (kb >= 0) {
#pragma unroll
                for (int s = 0; s < 2; ++s) {
                    const u32x2 lo = *(const LAS u32x2*)(vl + (32 * j + 16 * s) * 2), hh = *(const LAS u32x2*)(vl + (32 * j + 16 * s + 8) * 2);
                    u32x4 av; av.x = lo.x; av.y = lo.y; av.z = hh.x; av.w = hh.y;
                    o = __builtin_amdgcn_mfma_f32_32x32x16_bf16(__builtin_bit_cast(bf16x8, av), __builtin_bit_cast(bf16x8, pb[j][s]), o, 0, 0, 0);
                }
            }
        }
        bf16* op = CAT + (size_t)(tok0 + r32) * 1024 + h * 64 + db * 32 + 4 * hi;
#pragma unroll
        for (int gq = 0; gq < 4; ++gq) { u32x2 w; w.x = cvt_pk_bf16(o[4 * gq] * inv, o[4 * gq + 1] * inv); w.y = cvt_pk_bf16(o[4 * gq + 2] * inv, o[4 * gq + 3] * inv); *(u32x2*)(op + 8 * gq) = w; }
    }
}
__device__ __forceinline__ void attn_block(const Frame& F, const bf16* QB, const bf16* KB, const bf16* VT, const float* sinks, bf16* CAT, int qq) {
    const int tokb = qq * 64, b = tokb / SEQ, tb = tokb % SEQ, kbase = tb - 128;
    u32x4 kv[6], vv[6];
    bf16x8 qf0[4], qf1[4];
    { const int r32 = F.lane & 31, hi = F.lane >> 5;
#pragma unroll
      for (int d0 = 0; d0 < 4; ++d0) { qf0[d0] = *(const bf16x8*)(QB + (size_t)(tokb + r32) * 512 + F.wave * 64 + d0 * 16 + hi * 8); qf1[d0] = *(const bf16x8*)(QB + (size_t)(tokb + 32 + r32) * 512 + F.wave * 64 + d0 * 16 + hi * 8); } }
    const float sk = sinks[F.wave] * LOG2E;
#pragma unroll
    for (int i = 0; i < 6; ++i) {
        const int c = F.tid + 512 * i, g = c / 1536, rem = c % 1536;
        { const int key = rem >> 3, ch = rem & 7, pos = kbase + key;
          kv[i] = pos >= 0 ? *(const u32x4*)(KB + (size_t)(b * SEQ + pos) * 128 + g * 64 + ch * 8) : (u32x4){0u, 0u, 0u, 0u}; }
        { const int d = rem / 24, ch = rem % 24, pos = kbase + ch * 8;
          vv[i] = pos >= 0 ? *(const u32x4*)(VT + ((size_t)((b * 2 + g) * 64 + d)) * SEQ + pos) : (u32x4){0u, 0u, 0u, 0u}; }
    }
#pragma unroll
    for (int i = 0; i < 6; ++i) {
        const int c = F.tid + 512 * i, g = c / 1536, rem = c % 1536;
        *(LAS u32x4*)(F.lds + g * AT_KG + (rem >> 3) * AT_KROW + (rem & 7) * 16) = kv[i];
        *(LAS u32x4*)(F.lds + AT_VOFF + g * AT_VG + (rem / 24) * AT_VROW + (rem % 24) * 16) = vv[i];
    }
    __syncthreads();
    attn_wave_unit(F.lds, qf0, sk, CAT, tokb, 0, F.wave, F.lane);
    attn_wave_unit(F.lds, qf1, sk, CAT, tokb + 32, 1, F.wave, F.lane);
    __syncthreads();
}
constexpr int SG_WOFF = 20480, SG_WROW = 272;
__device__ __forceinline__ void sgu_stage_w(const Frame& F, const float* w_s, int gi) {
    f32x4 w[8];
#pragma unroll
    for (int i = 0; i < 8; ++i) w[i] = *(const f32x4*)(w_s + (size_t)gi * 16384 + (size_t)(F.tid + 512 * i) * 4);
#pragma unroll
    for (int i = 0; i < 8; ++i) { const int c = F.tid + 512 * i, t = c >> 5, s0 = (c & 31) * 4;
        f32x4 v = w[i];
#pragma unroll
        for (int j = 0; j < 4; ++j) if (s0 + j > t) v[j] = 0.f;
        u32x2 o; o.x = cvt_pk_bf16(v[0], v[1]); o.y = cvt_pk_bf16(v[2], v[3]);
        *(LAS u32x2*)(F.lds + SG_WOFF + t * SG_WROW + s0 * 2) = o; }
}
__device__ __forceinline__ void sgu_unit(const Frame& F, const bf16* UB, const bf16* GB, const float* ln_g, const float* ln_b, const float* w_s, const float* b_s, bf16* CAT, int ch, int gi) {
    LAS bf16* GT = (LAS bf16*)F.lds;
    const int r32 = F.lane & 31, hi = F.lane >> 5, tb = F.wave >> 1, db = F.wave & 1, t = tb * 32 + r32;
    const int nks = 2 * (tb + 1);
    const int s = F.tid >> 2, q4 = F.tid & 3; const size_t tok = (size_t)ch * 128 + s;
    const u32x4* gp = (const u32x4*)(GB + tok * 512 + gi * 64 + q4 * 16);
    const u32x4 a = gp[0], c = gp[1];
    const size_t tokt = (size_t)ch * 128 + t;
    const bf16* up = UB + tokt * 512 + gi * 64 + db * 32 + 4 * hi;
    u32x2 uu[4];
#pragma unroll
    for (int gq = 0; gq < 4; ++gq) uu[gq] = *(const u32x2*)(up + 8 * gq);
    const float bb = b_s[gi * 128 + t];
    float lg_[16], lb_[16];
#pragma unroll
    for (int i = 0; i < 16; ++i) { lg_[i] = ln_g[gi * 64 + q4 * 16 + i]; lb_[i] = ln_b[gi * 64 + q4 * 16 + i]; }
    {
        float v[16];
        v[0] = __uint_as_float(a.x << 16); v[1] = __uint_as_float(a.x & 0xffff0000u); v[2] = __uint_as_float(a.y << 16); v[3] = __uint_as_float(a.y & 0xffff0000u);
        v[4] = __uint_as_float(a.z << 16); v[5] = __uint_as_float(a.z & 0xffff0000u); v[6] = __uint_as_float(a.w << 16); v[7] = __uint_as_float(a.w & 0xffff0000u);
        v[8] = __uint_as_float(c.x << 16); v[9] = __uint_as_float(c.x & 0xffff0000u); v[10] = __uint_as_float(c.y << 16); v[11] = __uint_as_float(c.y & 0xffff0000u);
        v[12] = __uint_as_float(c.z << 16); v[13] = __uint_as_float(c.z & 0xffff0000u); v[14] = __uint_as_float(c.w << 16); v[15] = __uint_as_float(c.w & 0xffff0000u);
        float sum = 0.f;
#pragma unroll
        for (int i = 0; i < 16; ++i) sum += v[i];
        sum += __shfl_xor(sum, 1); sum += __shfl_xor(sum, 2);
        const float mu = sum * (1.f / 64.f); float q = 0.f;
#pragma unroll
        for (int i = 0; i < 16; ++i) { v[i] -= mu; q += v[i] * v[i]; }
        q += __shfl_xor(q, 1); q += __shfl_xor(q, 2);
        const float rstd = rsqrtf(q * (1.f / 64.f) + LN_EPS);
#pragma unroll
        for (int i = 0; i < 16; ++i) { const int d = q4 * 16 + i; GT[d * 136 + s] = (bf16)f2bf(v[i] * rstd * lg_[i] + lb_[i]); }
    }
    __syncthreads();
    {
        f32x16 acc;
#pragma unroll
        for (int r = 0; r < 16; ++r) acc[r] = 0.f;
        const LAS bf16* arow = GT + (db * 32 + r32) * 136 + hi * 8;
        const LAS unsigned char* wlds = F.lds + SG_WOFF + t * SG_WROW + hi * 16;
#pragma unroll
        for (int ks = 0; ks < 8; ++ks) if (ks < nks) {
            const bf16x8 af = *(const LAS bf16x8*)(arow + ks * 16);
            const bf16x8 bw = *(const LAS bf16x8*)(wlds + ks * 32);
            acc = __builtin_amdgcn_mfma_f32_32x32x16_bf16(af, bw, acc, 0, 0, 0);
        }
        bf16* op = CAT + tokt * 1024 + 512 + gi * 64 + db * 32 + 4 * hi;
#pragma unroll
        for (int gq = 0; gq < 4; ++gq) {
            const float u0 = __uint_as_float(uu[gq].x << 16), u1 = __uint_as_float(uu[gq].x & 0xffff0000u), u2 = __uint_as_float(uu[gq].y << 16), u3 = __uint_as_float(uu[gq].y & 0xffff0000u);
            u32x2 w; w.x = cvt_pk_bf16(u0 * (acc[4 * gq] + bb), u1 * (acc[4 * gq + 1] + bb)); w.y = cvt_pk_bf16(u2 * (acc[4 * gq + 2] + bb), u3 * (acc[4 * gq + 3] + bb));
            *(u32x2*)(op + 8 * gq) = w;
        }
    }
    __syncthreads();
}
__device__ __forceinline__ void p2_mixers(const Frame& F, const Args& a) {
    unsigned char* ws = a.ws;
    const bf16 *QB = (const bf16*)(ws + WS_QB), *KB = (const bf16*)(ws + WS_KB), *VT = (const bf16*)(ws + WS_VT), *UB = (const bf16*)(ws + WS_UB), *GB = (const bf16*)(ws + WS_GB);
    bf16* CAT = (bf16*)(ws + WS_CAT);
#ifndef P2_REP_ATTN
#define P2_REP_ATTN 1
#endif
#ifndef P2_REP_SGU
#define P2_REP_SGU 1
#endif
    for (int rp = 0; rp < P2_REP_ATTN; ++rp)
    for (int qq = F.vcu; qq < T / 64; qq += F.G) attn_block(F, QB, KB, VT, a.in[3], CAT, qq);
    int gi_staged = -1;
    for (int rp = 0; rp < P2_REP_SGU; ++rp)
    for (int u = F.vcu; u < (T / 128) * 8; u += F.G) {
        if ((u & 7) != gi_staged) { __syncthreads(); sgu_stage_w(F, a.in[6], u & 7); gi_staged = u & 7; }
        sgu_unit(F, UB, GB, a.in[4], a.in[5], a.in[6], a.in[7], CAT, u >> 3, u & 7);
    }
}

template <int CTRL> __device__ __forceinline__ float dppf(float v) { return __builtin_bit_cast(float, __builtin_amdgcn_update_dpp(0, __builtin_bit_cast(int, v), CTRL, 0xF, 0xF, true)); }
__device__ __forceinline__ float swap16_sum(float x, float y) { auto r = __builtin_amdgcn_permlane16_swap(__builtin_bit_cast(unsigned, x), __builtin_bit_cast(unsigned, y), false, false); return __builtin_bit_cast(float, r[0]) + __builtin_bit_cast(float, r[1]); }
__device__ __forceinline__ float swap32_sum(float x, float y) { auto r = __builtin_amdgcn_permlane32_swap(__builtin_bit_cast(unsigned, x), __builtin_bit_cast(unsigned, y), false, false); return __builtin_bit_cast(float, r[0]) + __builtin_bit_cast(float, r[1]); }
__device__ __forceinline__ float rdlane(float v, int l) { return __builtin_bit_cast(float, __builtin_amdgcn_readlane(__builtin_bit_cast(int, v), l)); }
__device__ __forceinline__ float xsum(float v) {
    v += dppf<0xB1>(v); v += dppf<0x4E>(v); v += dppf<0x124>(v); v += dppf<0x128>(v);
    return (rdlane(v, 0) + rdlane(v, 16)) + (rdlane(v, 32) + rdlane(v, 48));
}
__device__ __forceinline__ float xmax(float v) {
    v = fmaxf(v, dppf<0xB1>(v)); v = fmaxf(v, dppf<0x4E>(v)); v = fmaxf(v, dppf<0x124>(v)); v = fmaxf(v, dppf<0x128>(v));
    return fmaxf(fmaxf(rdlane(v, 0), rdlane(v, 16)), fmaxf(rdlane(v, 32), rdlane(v, 48)));
}
__device__ __forceinline__ void p4_router(const Frame& F, const Args& a, bool commit) {
    const float* Zin = a.out; float* Hout = (float*)(a.ws + WS_H); signed char* HB8 = (signed char*)(a.ws + WS_HB); int* meta = (int*)(a.ws + WS_META); unsigned* cnt = (unsigned*)(a.ws + WS_CTL) + CW_CNT;
    const float* ln1_g = a.in[10]; const float* ln1_b = a.in[11]; const float* w_r = a.in[12]; const float* b_r = a.in[13];
    LAS float* W = (LAS float*)F.lds;
    LAS unsigned* hist = (LAS unsigned*)(F.lds + RSCR_OFF);
    LAS unsigned* base = hist + 32;
    LAS int* tmp_e = (LAS int*)(hist + 64);
    LAS int* tmp_p = tmp_e + 256;
    LAS float* tmp_g = (LAS float*)(tmp_p + 256);
    {
        f32x4 t[16];
#pragma unroll
        for (int k = 0; k < 16; ++k) t[k] = *(const f32x4*)(w_r + (size_t)(F.tid + 512 * k) * 4);
#pragma unroll
        for (int k = 0; k < 16; ++k) { const int i = F.tid + 512 * k, c = i >> 3, e4 = i & 7, pr = (c & ~255) + 64 * (c & 3) + ((c >> 2) & 63); *(LAS f32x4*)(W + pr * 36 + e4 * 4) = t[k]; }
    }
    { const int gt = F.vcu * (NWAVES * 64) + F.tid, NGT = F.G * NWAVES * 64;
      for (int i = gt; i < NROWS_MAX; i += NGT) { meta[MT_ROW_TOK + i] = 0; ((float*)meta)[MT_ROW_GATE + i] = 0.f; ((float*)meta)[MT_ROW_SA + i] = 0.f; } }
    const int lane = F.lane, half = lane >> 5, el = lane & 31;
    LAS float* gbl = (LAS float*)(F.lds + 151552);
    for (int i = F.tid; i < 512; i += NWAVES * 64) *(LAS f32x4*)(gbl + 4 * i) = i < 256 ? *(const f32x4*)(ln1_g + 4 * i) : *(const f32x4*)(ln1_b + 4 * (i - 256));
    for (int tb = F.vcu; tb < T / 64; tb += F.G) {
        if (F.tid < 32) hist[F.tid] = 0u;
        __syncthreads();
        float zn0[16], zn1[16];
        { const f32x4* z0 = (const f32x4*)(Zin + (size_t)(tb * 64 + 8 * F.wave) * D) + lane;
#pragma unroll
          for (int j = 0; j < 4; ++j) { const f32x4 a0 = z0[64 * j], a1 = z0[256 + 64 * j];
#pragma unroll
            for (int k = 0; k < 4; ++k) { zn0[4 * j + k] = a0[k]; zn1[4 * j + k] = a1[k]; } } }
        for (int pp = 0; pp < 4; ++pp) {
            const int tl0 = 8 * F.wave + 2 * pp;
            const int tok0 = tb * 64 + tl0;
            float h0[16], h1[16];
            {
                f32x4* ho0 = (f32x4*)(Hout + (size_t)tok0 * D) + lane; f32x4* ho1 = ho0 + 256;
                float s0 = 0.f, s1 = 0.f, q0 = 0.f, q1 = 0.f;
#pragma unroll
                for (int i = 0; i < 16; ++i) { h0[i] = zn0[i]; h1[i] = zn1[i]; }
                if (pp < 3) { const f32x4* zp = (const f32x4*)(Zin + (size_t)(tok0 + 2) * D) + lane;
#pragma unroll
                    for (int j = 0; j < 4; ++j) { const f32x4 a0 = zp[64 * j], a1 = zp[256 + 64 * j];
#pragma unroll
                        for (int k = 0; k < 4; ++k) { zn0[4 * j + k] = a0[k]; zn1[4 * j + k] = a1[k]; } } }
#pragma unroll
                for (int i = 0; i < 16; ++i) { s0 += h0[i]; s1 += h1[i]; q0 += h0[i] * h0[i]; q1 += h1[i] * h1[i]; }
                s0 = xsum(s0); s1 = xsum(s1); q0 = xsum(q0); q1 = xsum(q1);
                const float m0 = s0 * (1.f / D), m1 = s1 * (1.f / D);
                const float r0 = rsqrtf(fmaxf(q0 * (1.f / D) - m0 * m0, 0.f) + LN_EPS), r1 = rsqrtf(fmaxf(q1 * (1.f / D) - m1 * m1, 0.f) + LN_EPS);
                float a0 = 0.f, a1 = 0.f;
#pragma unroll
                for (int i = 0; i < 16; ++i) {
                    const float gm_ = gbl[4 * lane + 256 * (i >> 2) + (i & 3)], bt_ = gbl[1024 + 4 * lane + 256 * (i >> 2) + (i & 3)];
                    h0[i] = (h0[i] - m0) * r0 * gm_ + bt_; h1[i] = (h1[i] - m1) * r1 * gm_ + bt_;
                    a0 = fmaxf(a0, fabsf(h0[i])); a1 = fmaxf(a1, fabsf(h1[i]));
                }
                a0 = xmax(a0); a1 = xmax(a1);
                const float i0 = a0 > 0.f ? 127.0f / a0 : 0.f, i1 = a1 > 0.f ? 127.0f / a1 : 0.f;
                unsigned* hb0 = (unsigned*)(HB8 + (size_t)tok0 * D) + lane; unsigned* hb1 = hb0 + 256;
#pragma unroll
                for (int j = 0; j < 4; ++j) {
                    ho0[64 * j] = (f32x4){h0[4 * j], h0[4 * j + 1], h0[4 * j + 2], h0[4 * j + 3]}; ho1[64 * j] = (f32x4){h1[4 * j], h1[4 * j + 1], h1[4 * j + 2], h1[4 * j + 3]};
                    unsigned p0 = 0u, p1 = 0u;
#pragma unroll
                    for (int k = 0; k < 4; ++k) { p0 |= ((unsigned)(int)rintf(h0[4 * j + k] * i0) & 0xffu) << (8 * k); p1 |= ((unsigned)(int)rintf(h1[4 * j + k] * i1) & 0xffu) << (8 * k); }
                    hb0[64 * j] = p0; hb1[64 * j] = p1;
                }
                if (lane == 0) { ((float*)meta)[MT_SH + tok0] = a0 * (1.0f / 127.0f); ((float*)meta)[MT_SH + tok0 + 1] = a1 * (1.0f / 127.0f); }
            }
            f32x2 lp0[16], lp1[16];
#pragma unroll
            for (int e = 0; e < 16; ++e) { lp0[e] = (f32x2){0.f, 0.f}; lp1[e] = (f32x2){0.f, 0.f}; }
#pragma unroll
            for (int i = 0; i < 16; ++i) {
                const LAS f32x4* wr = (const LAS f32x4*)(W + (256 * (i >> 2) + 64 * (i & 3) + lane) * 36);
                const f32x2 hv0 = (f32x2){h0[i], h0[i]}, hv1 = (f32x2){h1[i], h1[i]};
#pragma unroll
                for (int e4 = 0; e4 < 8; ++e4) {
                    const f32x4 ww = wr[e4];
                    const f32x2 wlo = (f32x2){ww.x, ww.y}, whi = (f32x2){ww.z, ww.w};
                    lp0[2 * e4] = __builtin_elementwise_fma(hv0, wlo, lp0[2 * e4]); lp0[2 * e4 + 1] = __builtin_elementwise_fma(hv0, whi, lp0[2 * e4 + 1]);
                    lp1[2 * e4] = __builtin_elementwise_fma(hv1, wlo, lp1[2 * e4]); lp1[2 * e4 + 1] = __builtin_elementwise_fma(hv1, whi, lp1[2 * e4 + 1]);
                }
            }
            float lg0[32], lg1[32];
#pragma unroll
            for (int e = 0; e < 16; ++e) { lg0[2 * e] = lp0[e].x; lg0[2 * e + 1] = lp0[e].y; lg1[2 * e] = lp1[e].x; lg1[2 * e + 1] = lp1[e].y; }
            float v32[32];
#pragma unroll
            for (int e = 0; e < 32; ++e) { const float keep = half ? lg1[e] : lg0[e], send = half ? lg0[e] : lg1[e]; v32[e] = keep + __shfl_xor(send, 32); }
            float v16[16];
#pragma unroll
            for (int e = 0; e < 16; ++e) { const bool up = (lane & 16) != 0; const float keep = up ? v32[e + 16] : v32[e], send = up ? v32[e] : v32[e + 16]; v16[e] = keep + __shfl_xor(send, 16); }
            float v8[8];
#pragma unroll
            for (int e = 0; e < 8; ++e) { const bool up = (lane & 8) != 0; const float keep = up ? v16[e + 8] : v16[e], send = up ? v16[e] : v16[e + 8]; v8[e] = keep + dppf<0x128>(send); }
            float v4[4];
#pragma unroll
            for (int e = 0; e < 4; ++e) { const bool up = (lane & 4) != 0; const float keep = up ? v8[e + 4] : v8[e], send = up ? v8[e] : v8[e + 4]; v4[e] = keep + dppf<0x1B>(dppf<0x141>(send)); }
            float v2[2];
#pragma unroll
            for (int e = 0; e < 2; ++e) { const bool up = (lane & 2) != 0; const float keep = up ? v4[e + 2] : v4[e], send = up ? v4[e] : v4[e + 2]; v2[e] = keep + dppf<0x4E>(send); }
            float lgt;
            { const bool up = (lane & 1) != 0; const float keep = up ? v2[1] : v2[0], send = up ? v2[0] : v2[1]; lgt = keep + dppf<0xB1>(send); }
            lgt += b_r[el];
            int rank = 0;
#pragma unroll
            for (int j = 0; j < 32; ++j) {
                const float lo = rdlane(lgt, j), hi2 = rdlane(lgt, 32 + j);
                const float vj = half ? hi2 : lo;
                rank += (vj > lgt || (vj == lgt && j < el)) ? 1 : 0;
            }
            float bv[4]; int bi[4];
#pragma unroll
            for (int k = 0; k < 4; ++k) {
                const unsigned long long mk = __ballot(rank == k);
                const int i0 = __builtin_ctz((unsigned)mk | 0x80000000u), i1 = 32 + __builtin_ctz((unsigned)(mk >> 32) | 0x80000000u);
                const float x0 = rdlane(lgt, i0), x1 = rdlane(lgt, i1);
                bv[k] = half ? x1 : x0; bi[k] = half ? (i1 - 32) : i0;
            }
            float ex[4], es = 0.f;
#pragma unroll
            for (int k = 0; k < 4; ++k) { ex[k] = __expf(bv[k] - bv[0]); es += ex[k]; }
            if (el == 0) {
                const int tl = tl0 + half;
#pragma unroll
                for (int k = 0; k < 4; ++k) { const unsigned pl = atomicAdd((unsigned*)&hist[bi[k]], 1u); tmp_e[tl * 4 + k] = bi[k]; tmp_p[tl * 4 + k] = (int)pl; tmp_g[tl * 4 + k] = ex[k] / es; }
            }
        }
        __syncthreads();
        if (F.tid < 32) base[F.tid] = commit ? atomicAdd(&cnt[F.tid], hist[F.tid]) : 0u;
        __syncthreads();
        if (F.tid < 256) { const int i = F.tid, gi = tb * 256 + i, e = tmp_e[i];
            meta[MT_SEL_E + gi] = e; meta[MT_SEL_POS + gi] = (int)base[e] + tmp_p[i]; ((float*)meta)[MT_SEL_G + gi] = tmp_g[i]; }
        __syncthreads();
    }
}
__device__ __forceinline__ void p5_dispatch(const Frame& F, const Args& a) {
    int* meta = (int*)(a.ws + WS_META); const unsigned* cnt = (const unsigned*)(a.ws + WS_CTL) + CW_CNT;
    LAS int* ts = (LAS int*)(F.lds + RSCR_OFF);
    if (F.tid == 0) { int acc = 0; for (int e = 0; e < 32; ++e) { ts[e] = acc; acc += ((int)__hip_atomic_load(cnt + e, RLX_AGENT) + 255) >> 8; } ts[32] = acc; }
    __syncthreads();
    if (blockIdx.x == 0) {
        if (F.tid == 0) meta[MT_NT] = ts[32];
        if (F.tid < 33) meta[MT_TSTART + F.tid] = ts[F.tid];
        for (int t = F.tid; t < NT_MAX; t += NWAVES * 64) { int e = 0; for (int j = 1; j < 32; ++j) if (t >= ts[j]) e = j; meta[MT_TILE_E + t] = e; }
    }
    const int gt = F.vcu * (NWAVES * 64) + F.tid, NGT = F.G * NWAVES * 64;
    for (int i = gt; i < T * 4; i += NGT) {
        const int e = meta[MT_SEL_E + i], row = ts[e] * 256 + meta[MT_SEL_POS + i];
        meta[MT_ROW_TOK + row] = i >> 2; ((float*)meta)[MT_ROW_GATE + row] = ((const float*)meta)[MT_SEL_G + i]; ((float*)meta)[MT_ROW_SA + row] = ((const float*)meta)[MT_SH + (i >> 2)]; meta[MT_SLOT_ROW + i] = row;
    }
    __syncthreads();
}
__device__ __forceinline__ void p7_quant(const Frame& F, const Args& a) {
    const bf16* HID = (const bf16*)(a.ws + WS_HID); signed char* H8 = (signed char*)(a.ws + WS_HID8); float* row_sb = (float*)(a.ws + WS_ROWSB);
    const int nrows = __builtin_amdgcn_readfirstlane(((const int*)(a.ws + WS_META))[MT_NT]) * 256;
    const int gw = F.vcu * NWAVES + F.wave, NGW = F.G * NWAVES, lane = F.lane;
    for (int r0 = gw * 4; r0 < nrows; r0 += NGW * 4) {
        u32x4 v[4][2];
#pragma unroll
        for (int i = 0; i < 4; ++i)
#pragma unroll
            for (int j = 0; j < 2; ++j) v[i][j] = *((const u32x4*)(HID + (size_t)(r0 + i) * DFF + 512 * j) + lane);
#pragma unroll
        for (int i = 0; i < 4; ++i) {
            float f[16]; float am = 0.f;
#pragma unroll
            for (int j = 0; j < 2; ++j)
#pragma unroll
                for (int c = 0; c < 4; ++c) { const unsigned w = v[i][j][c]; f[8 * j + 2 * c] = __uint_as_float(w << 16); f[8 * j + 2 * c + 1] = __uint_as_float(w & 0xffff0000u); }
#pragma unroll
            for (int c = 0; c < 16; ++c) am = fmaxf(am, fabsf(f[c]));
            am = wave_max(am);
            const float inv = am > 0.f ? 127.0f / am : 0.f;
#pragma unroll
            for (int j = 0; j < 2; ++j) {
                u32x2 o; o.x = 0u; o.y = 0u;
#pragma unroll
                for (int c = 0; c < 4; ++c) { o.x |= ((unsigned)(int)rintf(f[8 * j + c] * inv) & 0xffu) << (8 * c); o.y |= ((unsigned)(int)rintf(f[8 * j + 4 + c] * inv) & 0xffu) << (8 * c); }
                *((u32x2*)(H8 + (size_t)(r0 + i) * DFF + 512 * j) + lane) = o;
            }
            if (lane == 0) row_sb[r0 + i] = am * (1.0f / 127.0f);
        }
    }
}
__device__ __forceinline__ void p8_final(const Frame& F, const Args& a) {
    const float* Hin = (const float*)(a.ws + WS_H); float* HO = a.out; const unsigned char* Y = (const unsigned char*)(a.ws + WS_Y); const int* meta = (const int*)(a.ws + WS_META);
    const float* ln2_g = a.in[20]; const float* ln2_b = a.in[21];
    const int gw = F.vcu * NWAVES + F.wave, NGW = F.G * NWAVES, lane = F.lane;
    f32x4 g2[4], b2[4];
#pragma unroll
    for (int j = 0; j < 4; ++j) { g2[j] = *(const f32x4*)(ln2_g + 4 * lane + 256 * j); b2[j] = *(const f32x4*)(ln2_b + 4 * lane + 256 * j); }
    for (int tok = gw; tok < T; tok += NGW) {
        f32x4* hr = (f32x4*)(HO + (size_t)tok * D) + lane; const f32x4* hi_ = (const f32x4*)(Hin + (size_t)tok * D) + lane;
        f32x4 v[4]; float s = 0.f;
#pragma unroll
        for (int j = 0; j < 4; ++j) v[j] = hi_[64 * j] * ALPHA;
#pragma unroll
        for (int k = 0; k < 4; ++k) {
            const int row = meta[MT_SLOT_ROW + tok * 4 + k];
            const unsigned* yr = (const unsigned*)(Y + (size_t)row * D) + lane;
#pragma unroll
            for (int j = 0; j < 4; ++j) { const int y = (int)yr[64 * j]; const f32x2 lo = __builtin_amdgcn_cvt_pk_f32_fp8(y, false), hi2 = __builtin_amdgcn_cvt_pk_f32_fp8(y, true);
                v[j].x += lo.x * (1.0f / YSCALE); v[j].y += lo.y * (1.0f / YSCALE); v[j].z += hi2.x * (1.0f / YSCALE); v[j].w += hi2.y * (1.0f / YSCALE); }
        }
#pragma unroll
        for (int j = 0; j < 4; ++j) s += (v[j].x + v[j].y) + (v[j].z + v[j].w);
        const float mean = wave_sum(s) * (1.f / D); float s2 = 0.f;
#pragma unroll
        for (int j = 0; j < 4; ++j) { v[j] = v[j] - mean; s2 += (v[j].x * v[j].x + v[j].y * v[j].y) + (v[j].z * v[j].z + v[j].w * v[j].w); }
        const float rstd = rsqrtf(wave_sum(s2) * (1.f / D) + LN_EPS);
#pragma unroll
        for (int j = 0; j < 4; ++j) hr[64 * j] = v[j] * rstd * g2[j] + b2[j];
    }
}
#ifndef MKMASK
#define MKMASK 0x3FF
#endif
#ifndef REPEAT_MASK
#define REPEAT_MASK 0
#endif
#define NREP(k) (1 + ((REPEAT_MASK >> (k)) & 1))
__global__ void __launch_bounds__(NWAVES * 64, 2) mk_fwd(Args args) {
    extern __shared__ __attribute__((aligned(16))) unsigned char lds_raw[];
    Frame F;
    F.lds = (LAS unsigned char*)lds_raw;
    F.tid = threadIdx.x; F.lane = F.tid & 63; F.wave = __builtin_amdgcn_readfirstlane(F.tid >> 6);
    F.G = gridDim.x; { const int bx = blockIdx.x; F.vcu = (F.G % 8 == 0) ? (bx % 8) * (F.G / 8) + bx / 8 : bx; }
    volatile LAS unsigned* MISC = (volatile LAS unsigned*)(F.lds + MISC_OFF);
    if (F.tid < 64) MISC[F.tid] = 0u;
    __syncthreads();
    unsigned char* ws = args.ws;
    unsigned* ctl = (unsigned*)(ws + WS_CTL);
    const int lo = args.ph_lo, hi = args.ph_hi;
    XcdBarrier bar; bar.bar = ctl + CW_BAR + args.li * XCD_BAR_WORDS; bar.x = 0; bar.st = nullptr;
    if (hi - lo > 1) bar = xcd_barrier_post(ctl + CW_BAR + args.li * XCD_BAR_WORDS, MISC + 8);
#ifndef SKIP_MASK
#define SKIP_MASK 0
#endif
#define IN(k) (lo <= (k) && (k) < hi && !((SKIP_MASK >> (k)) & 1))
#define OPAQUE_F(Fp) Frame Fp = F; asm volatile("" : "+v"(Fp.tid)); Fp.lane = Fp.tid & 63
#define SEAM(k) do { if ((IN(k) && IN((k) + 1)) || rep_ + 1 < NREP(k)) xcd_barrier(bar); } while (0)
    int* meta = (int*)(ws + WS_META);
    bf16 *XB = (bf16*)(ws + WS_XB), *QB = (bf16*)(ws + WS_QB), *KB = (bf16*)(ws + WS_KB), *VT = (bf16*)(ws + WS_VT), *UB = (bf16*)(ws + WS_UB), *GB = (bf16*)(ws + WS_GB);
    bf16 *CAT = (bf16*)(ws + WS_CAT), *HB = (bf16*)(ws + WS_HB), *Y = (bf16*)(ws + WS_Y), *HID = (bf16*)(ws + WS_HID);
    bf16 *Win_t = (bf16*)(ws + WS_WIN), *Wout_t = (bf16*)(ws + WS_WOUT), *Wgu_t = (bf16*)(ws + WS_WGU), *Wd_t = (bf16*)(ws + WS_WD);
    const LAS int* rtab = (const LAS int*)(F.lds + RTAB_OFF);
    const bool par = ((blockIdx.x >> 3) & 1) != 0;

    for (int rep_ = 0; rep_ < NREP(0); ++rep_) if (IN(0)) { OPAQUE_F(Fp); p0_prologue(Fp, args); SEAM(0); }
    if (IN(1)) {
        const int c = (int)blockIdx.x, grp = (c >> 3) % 3;
        const int per_ = (3 * NEXP * 32 + F.G - 1) / F.G;
        const int it_lo = F.G == 256 ? (c < 192 ? c * 10 : 1920 + (c - 192) * 18) : c * per_, it_hi = F.G == 256 ? it_lo + (c < 192 ? 10 : 18) : it_lo + per_;
        OPAQUE_F(Fp);
        if (grp == 0) conv_items(Fp, args, it_lo, it_hi);
        { pg8::Gemm g{XB, Win_t, 2 * D, nullptr, 0u}; pg8::StaticOrder S; S.init(T / 256, INW / 256, F.G, c); S.i1 = 1;
          pg8::EpiInProj E{args.in[2], QB, KB, VT, UB, GB};
          pg8::gemm_phase<pg8::EpiInProj, false, true, false>(F.lds, rtab, g, S, E); }
        if (grp == 1) conv_items(Fp, args, it_lo, it_hi);
        { pg8::Gemm g{XB, Win_t, 2 * D, nullptr, 0u}; pg8::StaticOrder S; S.init(T / 256, INW / 256, F.G, c); S.i0 = 1;
          pg8::EpiInProj E{args.in[2], QB, KB, VT, UB, GB};
          pg8::gemm_phase<pg8::EpiInProj, false, true, false>(F.lds, rtab, g, S, E); }
        if (grp == 2) conv_items(Fp, args, it_lo, it_hi);
        { const int rep_ = 0; (void)rep_; SEAM(1); }
    }
    for (int rep_ = 0; rep_ < NREP(2); ++rep_) if (IN(2)) { OPAQUE_F(Fp); p2_mixers(Fp, args); SEAM(2); }
    for (int rep_ = 0; rep_ < NREP(3); ++rep_) if (IN(3)) {
        pg8::Gemm g{CAT, Wout_t, 2 * D, nullptr, 0u}; pg8::StaticOrder S; S.init(T / 256, D / 256, F.G, (int)blockIdx.x);
        pg8::EpiOutProj E{args.in[0], args.in[9], args.out};
        pg8::gemm_phase<pg8::EpiOutProj, false, false, false>(F.lds, rtab, g, S, E);
        SEAM(3);
    }
    for (int rep_ = 0; rep_ < NREP(4); ++rep_) if (IN(4)) { OPAQUE_F(Fp); p4_router(Fp, args, rep_ + 1 == NREP(4)); SEAM(4); }
#ifndef EXTRA_BARS
#define EXTRA_BARS 0
#endif
    for (int rep_ = 0; rep_ < NREP(5); ++rep_) if (IN(5)) { OPAQUE_F(Fp); p5_dispatch(Fp, args); SEAM(5); for (int xb_ = 0; xb_ < EXTRA_BARS; ++xb_) xcd_barrier(bar); }
    for (int rep_ = 0; rep_ < NREP(6); ++rep_) if (IN(6)) {
        const int nT = __builtin_amdgcn_readfirstlane(meta[MT_NT]);
        pg8::StaticOrder S; S.init(nT, 2 * DFF / 256, F.G, (int)blockIdx.x);
        { pg8::Unit u; LAS int* rt = (LAS int*)(F.lds + RTAB_OFF);
          for (int i = 0; i < RTAB_UNITS && S.next(i, u); ++i) if (F.tid < 256) rt[i * 256 + F.tid] = meta[MT_ROW_TOK + u.pm * 256 + F.tid];
          __syncthreads(); }
        pg8::Gemm g{HB, Wgu_t, D, meta + MT_TILE_E, 2048u * 1024u};
        pg8::EpiSwiglu E{meta + MT_TILE_E, args.in[15], args.in[17], (const float*)(ws + WS_SWGU), (const float*)meta + MT_ROW_SA, HID};
        pg8::gemm_phase<pg8::EpiSwiglu, true, true, true>(F.lds, rtab, g, S, E);
        SEAM(6);
    }
    for (int rep_ = 0; rep_ < NREP(7); ++rep_) if (IN(7)) { OPAQUE_F(Fp); p7_quant(Fp, args); SEAM(7); }
    for (int rep_ = 0; rep_ < NREP(8); ++rep_) if (IN(8)) {
        const int nT = __builtin_amdgcn_readfirstlane(meta[MT_NT]);
        pg8::StaticOrder S; S.init(nT, D / 256, F.G, (int)blockIdx.x);
        pg8::Gemm g{ws + WS_HID8, Wd_t, DFF, meta + MT_TILE_E, 1024u * 1024u};
        pg8::EpiDown E{meta + MT_TILE_E, args.in[19], (const float*)(ws + WS_SWD), (const float*)(ws + WS_ROWSB), (const float*)meta + MT_ROW_GATE, (unsigned char*)Y};
#ifdef STAGGER_US
        if (par) { const unsigned long long t0_ = __builtin_amdgcn_s_memrealtime(); while (__builtin_amdgcn_s_memrealtime() - t0_ < (unsigned long long)(STAGGER_US * 100)) __builtin_amdgcn_s_sleep(8); }
#endif
        pg8::gemm_phase<pg8::EpiDown, false, true, true>(F.lds, rtab, g, S, E);
        SEAM(8);
    }
    for (int rep_ = 0; rep_ < NREP(9); ++rep_) if (IN(9)) { OPAQUE_F(Fp); p8_final(Fp, args); if (rep_ + 1 < NREP(9)) xcd_barrier(bar); }
#undef IN
#undef SEAM
}

extern "C" void kernel_launch(void* const* d_in, const int* in_sizes, int n_in, void* d_out, int out_size, void* d_ws, size_t ws_size, hipStream_t stream) {
    static int grid = 0;
    if (grid == 0) {
        if (n_in != 22 || in_sizes[0] != T * D || out_size != T * D || ws_size < WS_END) { fprintf(stderr, "kernel_launch: unexpected shapes (n_in %d, in0 %d, out %d, ws %zu, need %zu)\n", n_in, n_in > 0 ? in_sizes[0] : -1, out_size, ws_size, (size_t)WS_END); grid = -1; return; }
        int dev = 0, cus = 0;
        if (hipGetDevice(&dev) != hipSuccess || hipDeviceGetAttribute(&cus, hipDeviceAttributeMultiprocessorCount, dev) != hipSuccess) { grid = -1; return; }
        if (hipFuncSetAttribute((const void*)mk_fwd, hipFuncAttributeMaxDynamicSharedMemorySize, LDS_BYTES) != hipSuccess) { fprintf(stderr, "kernel_launch: hipFuncSetAttribute failed\n"); grid = -1; return; }
        int per_cu = 0;
        if (hipOccupancyMaxActiveBlocksPerMultiprocessor(&per_cu, (const void*)mk_fwd, NWAVES * 64, LDS_BYTES) != hipSuccess || per_cu < 1) fprintf(stderr, "kernel_launch: occupancy query reports %d\n", per_cu);
        (void)hipGetLastError();
        grid = cus;
    }
    if (grid < 0) return;
    const float* x = (const float*)d_in[0]; const float* w_in = (const float*)d_in[1]; const float* b_in = (const float*)d_in[2]; const float* sinks = (const float*)d_in[3];
    const float* ln_v_g = (const float*)d_in[4]; const float* ln_v_b = (const float*)d_in[5]; const float* w_sp = (const float*)d_in[6]; const float* b_sp = (const float*)d_in[7];
    const float* w_out = (const float*)d_in[8]; const float* b_out = (const float*)d_in[9]; const float* ln1_g = (const float*)d_in[10]; const float* ln1_b = (const float*)d_in[11];
    const float* w_r = (const float*)d_in[12]; const float* b_r = (const float*)d_in[13]; const float* w_gate = (const float*)d_in[14]; const float* b_gate = (const float*)d_in[15];
    const float* w_up = (const float*)d_in[16]; const float* b_up = (const float*)d_in[17]; const float* w_down = (const float*)d_in[18]; const float* b_down = (const float*)d_in[19];
    const float* ln2_g = (const float*)d_in[20]; const float* ln2_b = (const float*)d_in[21];
    unsigned char* ws = (unsigned char*)d_ws; float* out = (float*)d_out;
    unsigned* ctl = (unsigned*)(ws + WS_CTL); int* meta = (int*)(ws + WS_META);
    bf16 *XB = (bf16*)(ws + WS_XB), *QB = (bf16*)(ws + WS_QB), *KB = (bf16*)(ws + WS_KB), *VT = (bf16*)(ws + WS_VT), *UB = (bf16*)(ws + WS_UB), *GB = (bf16*)(ws + WS_GB);
    bf16 *CAT = (bf16*)(ws + WS_CAT), *HB = (bf16*)(ws + WS_HB), *Y = (bf16*)(ws + WS_Y), *HID = (bf16*)(ws + WS_HID);
    (void)hipMemsetAsync(ws + WS_CTL, 0, 64 * 1024, stream);
    Args a{};
    for (int i = 0; i < 22; ++i) a.in[i] = (const float*)d_in[i];
    a.out = out; a.ws = ws;
    int li = 0;
    for (int k = 0; k < NPHASES;) {
        if ((MKMASK >> k) & 1) {
            int j = k; while (j < NPHASES && ((MKMASK >> j) & 1)) ++j;
            a.ph_lo = k; a.ph_hi = j; a.li = li++;
            hipLaunchKernelGGL(mk_fwd, dim3(grid), dim3(NWAVES * 64), LDS_BYTES, stream, a);
            k = j; continue;
        }
        switch (k) {
        case 0: k_cvt_x<<<2048, 256, 0, stream>>>(x, XB, T * D / 4); break;
        case 1: k_inproj_naive<<<dim3(T / 64, INW / 64), 256, 0, stream>>>(XB, w_in, EpiInProjN{b_in, QB, KB, VT, UB, GB}); break;
        case 2: k_attn_naive<<<T * NQH / 4, 256, 0, stream>>>(QB, KB, VT, sinks, CAT);
                k_sgu_naive<<<T / 128 * 8, 256, 0, stream>>>(UB, GB, ln_v_g, ln_v_b, w_sp, b_sp, CAT); break;
        case 3: k_outproj_naive<<<dim3(T / 64, D / 64), 256, 0, stream>>>(CAT, w_out, EpiOutProjN{b_out, x, out}); break;
        case 4: k_router_naive<<<T / 4, 256, 0, stream>>>(out, HB, ln1_g, ln1_b, w_r, b_r, ctl + CW_CNT, meta);
                k_rowinit<<<(NROWS_MAX + 255) / 256, 256, 0, stream>>>(meta); break;
        case 5: k_dispatch1<<<1, 64, 0, stream>>>(ctl + CW_CNT, meta);
                k_scatter<<<T * 4 / 256, 256, 0, stream>>>(meta); break;
        case 6: k_gateup_naive<<<dim3(NT_MAX * 4, DFF / 64), 256, 0, stream>>>(HB, meta, w_gate, b_gate, w_up, b_up, HID); break;
        case 8: k_down_naive<<<dim3(NT_MAX * 4, D / 64), 256, 0, stream>>>(HID, meta, w_down, b_down, Y); break;
        case 9: k_final_naive<<<T / 4, 256, 0, stream>>>(out, Y, meta, ln2_g, ln2_b); break;
        }
        ++k;
    }
}
```

```cpp
#include <hip/hip_runtime.h>
#include <cstdio>
#include <cstdint>

typedef unsigned short bf16;
typedef float f32x4 __attribute__((ext_vector_type(4)));
typedef unsigned u32x4 __attribute__((ext_vector_type(4)));
typedef unsigned u32x2 __attribute__((ext_vector_type(2)));

constexpr int BATCH = 2, SEQ = 8192, D = 1024, T = BATCH * SEQ;
constexpr int NQH = 8, NKVH = 2, HD = 64, QREP = 4, AW = 512, KVW = 128, GW = 512, INW = 1792;
constexpr int NEXP = 32, TOPK = 4, DFF = 1024;
constexpr int NT_MAX = T * TOPK / 256 + NEXP;
constexpr int NROWS_MAX = NT_MAX * 256;
constexpr float LN_EPS = 1e-5f;
constexpr float ALPHA = 1.189207115002721f;
constexpr float C2 = 0.125f * 1.4426950408889634f;
constexpr float LOG2E = 1.4426950408889634f;
constexpr float YSCALE = 16.0f;

constexpr size_t MiB = 1u << 20;
constexpr size_t WS_CTL = 0;
constexpr size_t WS_META = 1 * MiB;
constexpr size_t WS_XB = 3 * MiB;
constexpr size_t WS_QB = WS_XB + 32 * MiB;
constexpr size_t WS_KB = WS_QB + 16 * MiB;
constexpr size_t WS_VT = WS_KB + 4 * MiB;
constexpr size_t WS_UB = WS_VT + 4 * MiB;
constexpr size_t WS_GB = WS_UB + 16 * MiB;
constexpr size_t WS_CAT = WS_GB + 16 * MiB;
constexpr size_t WS_HB = WS_CAT + 32 * MiB;
constexpr size_t WS_H = WS_XB;
constexpr size_t WS_HID = WS_HB + 32 * MiB;
constexpr size_t WS_Y = WS_HID;
static_assert(WS_H + 64 * MiB <= WS_CAT, "H overlay");

constexpr int CW_CNT = 64;
constexpr int MT_NT = 0;
constexpr int MT_TSTART = 16;
constexpr int MT_TILE_E = 64;
constexpr int MT_SEL_E = 1024;
constexpr int MT_SEL_POS = MT_SEL_E + T * 4;
constexpr int MT_SEL_G = MT_SEL_POS + T * 4;
constexpr int MT_SLOT_ROW = MT_SEL_G + T * 4;
constexpr int MT_ROW_TOK = MT_SLOT_ROW + T * 4;
constexpr int MT_ROW_GATE = MT_ROW_TOK + NROWS_MAX;
constexpr int MT_ROW_SA = MT_ROW_GATE + NROWS_MAX;
constexpr int MT_SH = MT_ROW_SA + NROWS_MAX;
constexpr size_t WS_ROWSB = 512 * 1024;
static_assert((size_t)(MT_SH + T) * 4 <= 2 * MiB, "meta");

__device__ __forceinline__ float bf2f(bf16 v) { return __uint_as_float((unsigned)v << 16); }
__device__ __forceinline__ unsigned f2bf(float f) { unsigned u = __float_as_uint(f); return (u + 0x7fffu + ((u >> 16) & 1u)) >> 16; }
__device__ __forceinline__ unsigned pk2(float lo, float hi) { return f2bf(lo) | (f2bf(hi) << 16); }
__device__ __forceinline__ float gelu_tanh(float x) {
    const float k2 = 2.0f * 0.7978845608028654f;
    const float u = k2 * (x + 0.044715f * x * x * x);
    return x / (1.0f + __expf(-u));
}
__device__ __forceinline__ float wave_sum(float v) {
#pragma unroll
    for (int o = 1; o < 64; o <<= 1) v += __shfl_xor(v, o);
    return v;
}
__device__ __forceinline__ float wave_max(float v) {
#pragma unroll
    for (int o = 1; o < 64; o <<= 1) v = fmaxf(v, __shfl_xor(v, o));
    return v;
}

#define LAS __attribute__((address_space(3)))
#define GAS __attribute__((address_space(1)))
typedef short bf16x8 __attribute__((ext_vector_type(8)));
typedef float f32x16 __attribute__((ext_vector_type(16)));
typedef float f32x2 __attribute__((ext_vector_type(2)));
__device__ __forceinline__ unsigned cvt_pk_bf16(float lo, float hi) { unsigned r; asm volatile("v_cvt_pk_bf16_f32 %0, %1, %2" : "=v"(r) : "v"(lo), "v"(hi)); return r; }
__device__ __forceinline__ float fast_gelu(float x) {
    const float u = -2.0f * 0.7978845608028654f * LOG2E * (x + 0.044715f * x * x * x);
    return x * __builtin_amdgcn_rcpf(1.0f + __builtin_amdgcn_exp2f(u));
}
__device__ __forceinline__ void st16_wt(void* p, u32x4 v) {
    *(u32x4*)p = v;
}
namespace pg8 {
constexpr int BM = 256, BK = 64, HALF = 128, HTB = HALF * BK * 2  , STAGE_BYTES = 8 * HTB, NXCD = 8, WGM = 8;
__host__ __device__ __forceinline__ int lds_byte(int r, int c) { const int st = (r >> 4) * 2 + (c >> 5), rr = r & 15, cc = c & 31, ob = rr * 64 + cc * 2; return st * 1024 + (ob ^ (((ob >> 9) & 1) << 5)); }
__host__ __device__ __forceinline__ void stage_rc(int b, int& R, int& C) { const int st = b / 1024, sb = b % 1024, swz = sb ^ (((sb >> 9) & 1) << 5); R = (st >> 1) * 16 + swz / 64; C = (st & 1) * 32 + (swz % 64) / 2; }
__host__ __device__ __forceinline__ int perm32(int rho) { const int n = rho >> 4, i = rho & 15; return 8 * (i >> 2) + 4 * n + (i & 3); }

struct Unit { int pm, pn; };
struct Gemm { const void* A; const void* Bt; int KB; const int* tile_e; unsigned e_stride; };
typedef int i32x4 __attribute__((ext_vector_type(4)));

struct StaticOrder {
    int nM, nN, nwg, G, c, i0 = 0, i1 = 1 << 30;
    __device__ void init(int nM_, int nN_, int G_, int c_) { nM = nM_; nN = nN_; nwg = nM * nN; G = G_; c = c_; }
    __device__ bool next(int i, Unit& u) const {
        i += i0; if (i >= i1) return false;
        const long L = (long)i * G + c; if (L >= nwg) return false;
        int wgid = (int)L; { const int q = nwg / NXCD, r = nwg % NXCD, xcd = wgid % NXCD, off = wgid / NXCD; wgid = (xcd < r ? xcd * (q + 1) : r * (q + 1) + (xcd - r) * q) + off; }
        const int nig = WGM * nN, gid = wgid / nig, fm = gid * WGM, gsz = (nM - fm) < WGM ? (nM - fm) : WGM;
        u.pm = fm + ((wgid % nig) % gsz); u.pn = (wgid % nig) / gsz; return true;
    }
};

template <class Epi, bool GATHER, bool ALIGN_EPI, bool I8>
__device__ __forceinline__ void gemm_phase(LAS unsigned char* lds, const LAS int* rtab, const Gemm g, const StaticOrder& S, const Epi& E) {
    int tid_ = threadIdx.x; asm volatile("" : "+v"(tid_));
    const int tid = tid_, wid = __builtin_amdgcn_readfirstlane(tid >> 6), lane = tid & 63, wr = wid >> 2, wc = wid & 3, fr = lane & 15, fq = lane >> 4;
    const int KB = g.KB, nt = KB / (BK * 2);
    int Rs[2], Cs[2]; unsigned voffB[2];
#pragma unroll
    for (int i = 0; i < 2; ++i) { int R, C; stage_rc(tid * 16 + i * 8192, R, C); const int Rb = Epi::PERM == 2 ? (64 * (R >> 5) + 16 * ((R >> 2) & 3) + 4 * ((R >> 4) & 1) + (R & 3)) : Epi::PERM ? ((R & ~31) + perm32(R & 31)) : R; Rs[i] = R; Cs[i] = C; voffB[i] = (unsigned)(Rb * KB + C * 2); }
    const size_t kstep = (size_t)(BK * 2);
    const size_t hstep = (size_t)HALF * KB;
    const size_t tstep = 2 * hstep;
    const size_t bhstep = Epi::PERM == 2 ? (size_t)8 * KB : hstep;
    const unsigned ldsw = (unsigned)wid * 1024u;
    const int aoff = lds_byte(wr * 64 + fr, fq * 8), boff = lds_byte(wc * 32 + fr, fq * 8);
#define PG8_SA(b, h) (((b) * 2 + (h)) * HTB)
#define PG8_SB(b, h) ((4 + (b) * 2 + (h)) * HTB)
#define PG8_STAGE(bufoff, gbase, voff) do { _Pragma("unroll") for (int _i = 0; _i < 2; ++_i) \
        __builtin_amdgcn_global_load_lds((const unsigned*)((const char*)(gbase) + (voff)[_i]), (LAS unsigned*)(lds + (bufoff) + ldsw + _i * 8192), 16, 0, 0); } while (0)
#define PG8_LDA(dst, b, h) do { _Pragma("unroll") for (int m = 0; m < 4; ++m) _Pragma("unroll") for (int k = 0; k < 2; ++k) dst[m][k] = *(const LAS bf16x8*)(lds + PG8_SA(b, h) + aoff + m * 2048 + k * 1024); } while (0)
#define PG8_LDB(dst, b, h) do { _Pragma("unroll") for (int n = 0; n < 2; ++n) _Pragma("unroll") for (int k = 0; k < 2; ++k) dst[n][k] = *(const LAS bf16x8*)(lds + PG8_SB(b, h) + boff + n * 2048 + k * 1024); } while (0)
#define PG8_MMA(ai, bj, At, Bt) do { __builtin_amdgcn_s_setprio(1); _Pragma("unroll") for (int m = 0; m < 4; ++m) _Pragma("unroll") for (int n = 0; n < 2; ++n) _Pragma("unroll") for (int k = 0; k < 2; ++k) \
        { if constexpr (I8) acc[ai][bj][m][n] = __builtin_bit_cast(f32x4, __builtin_amdgcn_mfma_i32_16x16x64_i8(__builtin_bit_cast(i32x4, Bt[n][k]), __builtin_bit_cast(i32x4, At[m][k]), __builtin_bit_cast(i32x4, acc[ai][bj][m][n]), 0, 0, 0)); \
          else acc[ai][bj][m][n] = __builtin_amdgcn_mfma_f32_16x16x32_bf16(Bt[n][k], At[m][k], acc[ai][bj][m][n], 0, 0, 0); } __builtin_amdgcn_s_setprio(0); } while (0)
#define PG8_WAIT_V(n) asm volatile("s_waitcnt vmcnt(" #n ")" ::: "memory")
#define PG8_WAIT_L(n) asm volatile("s_waitcnt lgkmcnt(" #n ")" ::: "memory")
#define PG8_BAR __builtin_amdgcn_s_barrier()
#define PG8_SCHED __builtin_amdgcn_sched_barrier(0)
#define PG8_VOFFA(vo, ui_, u_) do { _Pragma("unroll") for (int h_ = 0; h_ < 2; ++h_) _Pragma("unroll") for (int i_ = 0; i_ < 2; ++i_) { \
        const int row_ = GATHER ? rtab[(ui_) * 256 + h_ * 128 + Rs[i_]] : ((u_).pm * 256 + h_ * 128 + Rs[i_]); \
        vo[h_][i_] = (unsigned)(row_ * KB + Cs[i_] * 2); } } while (0)
#define PG8_BBASE(u_) ((const char*)g.Bt + (g.tile_e ? (size_t)g.tile_e[(u_).pm] * g.e_stride : (size_t)0) + (size_t)(u_).pn * tstep)
    Unit cur, nxt; int ui = 0;
    if (!S.next(0, cur)) return;
    f32x4 acc[2][2][4][2];
    if constexpr (Epi::HAS_INIT) E.init(acc, cur, wr, wc, fr, fq);
    else {
#pragma unroll
    for (int a = 0; a < 2; ++a)
#pragma unroll
        for (int b = 0; b < 2; ++b)
#pragma unroll
            for (int m = 0; m < 4; ++m)
#pragma unroll
                for (int n = 0; n < 2; ++n) acc[a][b][m][n] = (f32x4){0.f, 0.f, 0.f, 0.f};
    }
    bf16x8 At[4][2], B0[2][2], B1[2][2];
    unsigned vAc[2][2], vAn[2][2];
    PG8_VOFFA(vAc, 0, cur);
    const char* const gA = (const char*)g.A;
    const char* cB = PG8_BBASE(cur);
    PG8_STAGE(PG8_SB(0, 0), cB, voffB); PG8_STAGE(PG8_SB(0, 1), cB + bhstep, voffB); PG8_STAGE(PG8_SA(0, 0), gA, vAc[0]); PG8_STAGE(PG8_SA(0, 1), gA, vAc[1]);
    if (wr == 1) PG8_BAR;
    PG8_WAIT_V(2); PG8_BAR;
    PG8_STAGE(PG8_SB(1, 0), cB + kstep, voffB); PG8_STAGE(PG8_SA(1, 0), gA + kstep, vAc[0]); PG8_STAGE(PG8_SB(1, 1), cB + bhstep + kstep, voffB);
    PG8_WAIT_V(6); PG8_BAR;
    for (;;) {
        const bool has_next = S.next(ui + 1, nxt);
        const char* nB = cB;
        if (has_next) { nB = PG8_BBASE(nxt); PG8_VOFFA(vAn, ui + 1, nxt); }
        else {
#pragma unroll
            for (int h = 0; h < 2; ++h)
#pragma unroll
                for (int i = 0; i < 2; ++i) vAn[h][i] = vAc[h][i];
        }
        for (int t = 0; t < nt; t += 2) {
            const bool last = (t == nt - 2);
            const char* a1 = gA + (size_t)(t + 1) * kstep;
            const char* a2 = last ? gA : gA + (size_t)(t + 2) * kstep; const char* b2 = last ? nB : cB + (size_t)(t + 2) * kstep;
            const char* a3 = a2 + kstep; const char* b3 = b2 + kstep;
            unsigned v2[2][2];
#pragma unroll
            for (int h = 0; h < 2; ++h)
#pragma unroll
                for (int i = 0; i < 2; ++i) v2[h][i] = last ? vAn[h][i] : vAc[h][i];
            PG8_LDB(B0, 0, 0); PG8_LDB(B1, 0, 1); PG8_SCHED; PG8_LDA(At, 0, 0); PG8_STAGE(PG8_SA(1, 1), a1, vAc[1]);
            PG8_WAIT_V(8); PG8_WAIT_L(0); PG8_BAR; PG8_MMA(0, 0, At, B0); PG8_MMA(0, 1, At, B1); PG8_BAR; PG8_SCHED;
            PG8_LDA(At, 0, 1); PG8_STAGE(PG8_SB(0, 0), b2, voffB); PG8_STAGE(PG8_SB(0, 1), b2 + bhstep, voffB); PG8_STAGE(PG8_SA(0, 0), a2, v2[0]);
            PG8_WAIT_V(8); PG8_WAIT_L(0); PG8_BAR; PG8_MMA(1, 0, At, B0); PG8_MMA(1, 1, At, B1); PG8_BAR; PG8_SCHED;
            PG8_LDB(B0, 1, 0); PG8_LDB(B1, 1, 1); PG8_SCHED; PG8_LDA(At, 1, 0); PG8_STAGE(PG8_SA(0, 1), a2, v2[1]);
            PG8_WAIT_V(8); PG8_WAIT_L(0); PG8_BAR; PG8_MMA(0, 0, At, B0); PG8_MMA(0, 1, At, B1); PG8_BAR; PG8_SCHED;
            PG8_LDA(At, 1, 1); PG8_STAGE(PG8_SB(1, 0), b3, voffB); PG8_STAGE(PG8_SB(1, 1), b3 + bhstep, voffB); PG8_STAGE(PG8_SA(1, 0), a3, v2[0]);
            PG8_WAIT_V(8); PG8_WAIT_L(0); PG8_BAR; PG8_MMA(1, 0, At, B0); PG8_MMA(1, 1, At, B1); PG8_BAR; PG8_SCHED;
        }
        if constexpr (ALIGN_EPI) { if (wr == 0) PG8_BAR; }
        E(acc, cur, wr, wc, fr, fq);
        if (!has_next) break;
        if constexpr (Epi::HAS_INIT) E.init(acc, nxt, wr, wc, fr, fq);
        else {
#pragma unroll
        for (int a = 0; a < 2; ++a)
#pragma unroll
            for (int b = 0; b < 2; ++b)
#pragma unroll
                for (int m = 0; m < 4; ++m)
#pragma unroll
                    for (int n = 0; n < 2; ++n) acc[a][b][m][n] = (f32x4){0.f, 0.f, 0.f, 0.f};
        }
        cur = nxt; cB = nB; ++ui;
#pragma unroll
        for (int h = 0; h < 2; ++h)
#pragma unroll
            for (int i = 0; i < 2; ++i) vAc[h][i] = vAn[h][i];
        if constexpr (ALIGN_EPI) { if (wr == 1) PG8_BAR; }
    }
    PG8_WAIT_V(0);
    if constexpr (!ALIGN_EPI) { if (wr == 0) PG8_BAR; }
    PG8_BAR;
#undef PG8_SA
#undef PG8_SB
#undef PG8_STAGE
#undef PG8_LDA
#undef PG8_LDB
#undef PG8_MMA
#undef PG8_WAIT_V
#undef PG8_WAIT_L
#undef PG8_BAR
#undef PG8_SCHED
#undef PG8_VOFFA
#undef PG8_BBASE
}

struct EpiInProj {
    static constexpr int PERM = 1; static constexpr bool HAS_INIT = false;
    const float* b_in; bf16 *QB, *KB, *VT, *UB, *GB;
    __device__ __forceinline__ void operator()(const f32x4 (&acc)[2][2][4][2], const Unit& u, int wr, int wc, int fr, int fq) const {
        const int row0 = u.pm * BM + wr * 64 + fr;
#pragma unroll
        for (int bj = 0; bj < 2; ++bj) {
            const int reg = u.pn * BM + bj * HALF;
            const int c0 = reg + wc * 32 + 8 * fq;
            const f32x4 bv0 = *(const f32x4*)(b_in + c0), bv1 = *(const f32x4*)(b_in + c0 + 4);
#pragma unroll
            for (int ai = 0; ai < 2; ++ai)
#pragma unroll
                for (int m = 0; m < 4; ++m) {
                    const int row = row0 + ai * HALF + m * 16;
                    f32x4 v0 = acc[ai][bj][m][0] + bv0, v1 = acc[ai][bj][m][1] + bv1;
                    if (reg >= 640 && reg < 768) {
                        const int cv = c0 - 640, gg = cv >> 6, d = cv & 63, b = row / SEQ, s = row % SEQ;
                        bf16* vp = VT + ((size_t)((b * 2 + gg) * 64 + d)) * SEQ + s;
#pragma unroll
                        for (int j = 0; j < 4; ++j) { vp[(size_t)j * SEQ] = (bf16)f2bf(v0[j]); vp[(size_t)(j + 4) * SEQ] = (bf16)f2bf(v1[j]); }
                    } else {
                        bf16* dst;
                        if (reg < 512) { v0 = v0 * C2; v1 = v1 * C2; dst = QB + (size_t)row * 512 + c0; }
                        else if (reg < 640) { dst = KB + (size_t)row * 128 + (c0 - 512); }
                        else {
#pragma unroll
                            for (int j = 0; j < 4; ++j) { v0[j] = fast_gelu(v0[j]); v1[j] = fast_gelu(v1[j]); }
                            dst = (reg < 1280) ? (UB + (size_t)row * 512 + (c0 - 768)) : (GB + (size_t)row * 512 + (c0 - 1280));
                        }
                        u32x4 w; w.x = cvt_pk_bf16(v0[0], v0[1]); w.y = cvt_pk_bf16(v0[2], v0[3]); w.z = cvt_pk_bf16(v1[0], v1[1]); w.w = cvt_pk_bf16(v1[2], v1[3]);
                        *(u32x4*)dst = w;
                    }
                }
        }
    }
};
struct EpiOutProj {
    static constexpr int PERM = 0; static constexpr bool HAS_INIT = true;
    const float* x; const float* b_out; float* Z;
    __device__ __forceinline__ void init(f32x4 (&acc)[2][2][4][2], const Unit& u, int wr, int wc, int fr, int fq) const {
        const int col0 = u.pn * BM + wc * 32 + 4 * fq;
#pragma unroll
        for (int ai = 0; ai < 2; ++ai)
#pragma unroll
            for (int m = 0; m < 4; ++m) {
                const size_t off = (size_t)(u.pm * BM + ai * HALF + wr * 64 + m * 16 + fr) * D + col0;
#pragma unroll
                for (int bj = 0; bj < 2; ++bj)
#pragma unroll
                    for (int n = 0; n < 2; ++n) acc[ai][bj][m][n] = *(const f32x4*)(x + off + bj * HALF + n * 16) * ALPHA + *(const f32x4*)(b_out + col0 + bj * HALF + n * 16);
            }
    }
    __device__ __forceinline__ void operator()(const f32x4 (&acc)[2][2][4][2], const Unit& u, int wr, int wc, int fr, int fq) const {
        const int col0 = u.pn * BM + wc * 32 + 4 * fq;
#pragma unroll
        for (int ai = 0; ai < 2; ++ai)
#pragma unroll
            for (int m = 0; m < 4; ++m) {
                const size_t off = (size_t)(u.pm * BM + ai * HALF + wr * 64 + m * 16 + fr) * D + col0;
#pragma unroll
                for (int bj = 0; bj < 2; ++bj)
#pragma unroll
                    for (int n = 0; n < 2; ++n) *(f32x4*)(Z + off + bj * HALF + n * 16) = acc[ai][bj][m][n];
            }
    }
};
struct EpiSwiglu {
    static constexpr int PERM = 1; static constexpr bool HAS_INIT = false;
    const int* tile_e; const float* b_gate; const float* b_up; const float* swgu; const float* row_sa; bf16* HID;
    __device__ __forceinline__ void operator()(const f32x4 (&acc)[2][2][4][2], const Unit& u, int wr, int wc, int fr, int fq) const {
        const int e = tile_e[u.pm];
        const int fc0 = u.pn * HALF + wc * 32 + 8 * fq;
        const float* sw = swgu + e * 2048 + u.pn * 256 + wc * 32 + 8 * fq;
        float sa[2][4];
#pragma unroll
        for (int ai = 0; ai < 2; ++ai)
#pragma unroll
            for (int m = 0; m < 4; ++m) sa[ai][m] = row_sa[u.pm * BM + ai * HALF + wr * 64 + m * 16 + fr];
        f32x4 gb[2], ub[2], sg[2], su[2];
#pragma unroll
        for (int n = 0; n < 2; ++n) { gb[n] = *(const f32x4*)(b_gate + e * DFF + fc0 + 4 * n); ub[n] = *(const f32x4*)(b_up + e * DFF + fc0 + 4 * n); sg[n] = *(const f32x4*)(sw + 4 * n); su[n] = *(const f32x4*)(sw + 128 + 4 * n); }
#pragma unroll
        for (int ai = 0; ai < 2; ++ai)
#pragma unroll
            for (int m = 0; m < 4; ++m) {
                const int row = u.pm * BM + ai * HALF + wr * 64 + m * 16 + fr;
                float hv[8];
#pragma unroll
                for (int n = 0; n < 2; ++n)
#pragma unroll
                    for (int j = 0; j < 4; ++j) {
                        const float ga = (float)__float_as_int(acc[ai][0][m][n][j]) * (sa[ai][m] * sg[n][j]) + gb[n][j];
                        const float ua = (float)__float_as_int(acc[ai][1][m][n][j]) * (sa[ai][m] * su[n][j]) + ub[n][j];
                        const float gt = fminf(ga, 7.0f), up = __builtin_amdgcn_fmed3f(ua, -7.0f, 7.0f);
                        hv[4 * n + j] = gt * __builtin_amdgcn_rcpf(1.0f + __builtin_amdgcn_exp2f(-1.702f * LOG2E * gt)) * (up + 1.0f);
                    }
                u32x4 w; w.x = cvt_pk_bf16(hv[0], hv[1]); w.y = cvt_pk_bf16(hv[2], hv[3]); w.z = cvt_pk_bf16(hv[4], hv[5]); w.w = cvt_pk_bf16(hv[6], hv[7]);
                *(u32x4*)(HID + (size_t)row * DFF + fc0) = w;
            }
    }
};
struct EpiDown {
    static constexpr int PERM = 2; static constexpr bool HAS_INIT = false;
    const int* tile_e; const float* b_down; const float* swd; const float* row_sb; const float* row_gate; unsigned char* Y;
    __device__ __forceinline__ void operator()(const f32x4 (&acc)[2][2][4][2], const Unit& u, int wr, int wc, int fr, int fq) const {
        const int e = tile_e[u.pm];
        const int c0 = u.pn * BM + wc * 64 + 16 * fq;
        f32x4 bv[2][2], sw[2][2];
#pragma unroll
        for (int bj = 0; bj < 2; ++bj)
#pragma unroll
            for (int n = 0; n < 2; ++n) { bv[bj][n] = *(const f32x4*)(b_down + e * D + c0 + 8 * bj + 4 * n); sw[bj][n] = *(const f32x4*)(swd + e * D + c0 + 8 * bj + 4 * n); }
#pragma unroll
        for (int ai = 0; ai < 2; ++ai)
#pragma unroll
            for (int m = 0; m < 4; ++m) {
                const int row = u.pm * BM + ai * HALF + wr * 64 + m * 16 + fr;
                const float gt = row_gate[row] * YSCALE, sb = row_sb[row] * gt;
                u32x4 w;
#pragma unroll
                for (int bj = 0; bj < 2; ++bj)
#pragma unroll
                    for (int n = 0; n < 2; ++n) {
                        float v[4];
#pragma unroll
                        for (int j = 0; j < 4; ++j) v[j] = __builtin_amdgcn_fmed3f((float)__float_as_int(acc[ai][bj][m][n][j]) * (sb * sw[bj][n][j]) + bv[bj][n][j] * gt, -448.0f, 448.0f);
                        int d = 0;
                        d = __builtin_amdgcn_cvt_pk_fp8_f32(v[0], v[1], d, false);
                        d = __builtin_amdgcn_cvt_pk_fp8_f32(v[2], v[3], d, true);
                        w[2 * bj + n] = (unsigned)d;
                    }
                *(u32x4*)(Y + (size_t)row * D + c0) = w;
            }
    }
};
}
constexpr int NWAVES = 8;
constexpr int NPHASES = 10;
constexpr size_t WS_WIN = WS_HID + 144 * MiB;
constexpr size_t WS_WOUT = WS_WIN + 4 * MiB;
constexpr size_t WS_WGU = WS_WOUT + 2 * MiB;
constexpr size_t WS_SWGU = WS_WGU + 64 * MiB;
constexpr size_t WS_WD = WS_SWGU + 1 * MiB;
constexpr size_t WS_SWD = WS_WD + 32 * MiB;
constexpr size_t WS_HID8 = WS_SWD + 1 * MiB;
constexpr size_t WS_END = WS_HID8 + 72 * MiB;
constexpr int CW_BAR = 4096;
constexpr int RING_BYTES = 131072;
constexpr int RTAB_OFF = RING_BYTES;
constexpr int RTAB_UNITS = 12;
constexpr int RW_BYTES = 1024 * 144;
constexpr int RSCR_OFF = RW_BYTES;
constexpr int LDS_BYTES = 163840;
constexpr int MISC_OFF = LDS_BYTES - 256;
static_assert(RTAB_OFF + RTAB_UNITS * 1024 <= MISC_OFF && RSCR_OFF + 4096 <= MISC_OFF, "LDS map");

typedef GAS unsigned gu32;
#define RLX_AGENT __ATOMIC_RELAXED, __HIP_MEMORY_SCOPE_AGENT
#define LDS_WAIT() asm volatile("s_waitcnt lgkmcnt(0)" ::: "memory")
#define VM_WAIT() asm volatile("s_waitcnt vmcnt(0)" ::: "memory")

#define XB_TMO      128
#define XB_XCNT(j)  (256  + 64 * (j))
#define XB_XSUB(j)  (1280 + 64 * (j))
#define XB_XGEN(j)  (2304 + 64 * (j))
#define XB_TOP      3328
#define XB_TOPGEN   3392
#define XCD_BAR_WORDS 3456
#define XB_SPIN_CAP (1u << 18)
__device__ __forceinline__ unsigned xb_ld(unsigned* p)              { return __hip_atomic_load(p, __ATOMIC_RELAXED, __HIP_MEMORY_SCOPE_AGENT); }
__device__ __forceinline__ unsigned xb_add(unsigned* p, unsigned v) { return __hip_atomic_fetch_add(p, v, __ATOMIC_RELAXED, __HIP_MEMORY_SCOPE_AGENT); }
__device__ __forceinline__ unsigned xb_xcc_id() { return (unsigned)__builtin_amdgcn_s_getreg((3 << 11) | 20) & 0xFu; }
#define XB_SPIN(cond, bar) do { unsigned _sp = 0; while (cond) { __builtin_amdgcn_s_sleep(1); \
    if ((++_sp & 255u) == 0u) { if (xb_ld(&(bar)[XB_TMO])) break; if (_sp > XB_SPIN_CAP) { atomicAdd(&(bar)[XB_TMO], 1u); break; } } } } while (0)
struct XcdBarrier { unsigned* bar; unsigned x; volatile LAS unsigned* st; };
__device__ __forceinline__ XcdBarrier xcd_barrier_post(unsigned* bar, volatile LAS unsigned* st) {
    XcdBarrier b; b.bar = bar; b.x = xb_xcc_id(); b.st = st;
    if (threadIdx.x == 0) (void)xb_add(&bar[XB_XCNT(b.x)], 1u);
    return b;
}
__device__ __forceinline__ void xcd_barrier_complete(unsigned* bar, unsigned x, unsigned& nloc, unsigned& nx) {
    const unsigned G = gridDim.x * gridDim.y * gridDim.z;
    unsigned sum, cnt, mine, sp = 0u;
    for (;;) {
        sum = 0u; cnt = 0u; mine = 0u;
#pragma unroll
        for (unsigned j = 0; j < 16; ++j) { const unsigned c = xb_ld(&bar[XB_XCNT(j)]); sum += c; cnt += (c > 0u) ? 1u : 0u; mine = (j == x) ? c : mine; }
        if (sum == G) break;
        __builtin_amdgcn_s_sleep(1);
        if ((++sp & 255u) == 0u) { if (xb_ld(&bar[XB_TMO])) break; if (sp > XB_SPIN_CAP) { atomicAdd(&bar[XB_TMO], 1u); break; } }
    }
    nloc = mine > 0u ? mine : 1u; nx = cnt > 0u ? cnt : 1u;
}
__device__ __forceinline__ void xcd_barrier(const XcdBarrier& b) {
    asm volatile("s_waitcnt vmcnt(0)" ::: "memory");
    __syncthreads();
    if (threadIdx.x == 0) {
        unsigned* bar = b.bar;
        __builtin_amdgcn_s_waitcnt(0);
        unsigned nloc = b.st[0], nx = b.st[1];
        if (nloc == 0u) { xcd_barrier_complete(bar, b.x, nloc, nx); b.st[0] = nloc; b.st[1] = nx; }
        const unsigned old = xb_add(&bar[XB_XSUB(b.x)], 1u);
        const unsigned gen = old / nloc;
        if (old + 1u == (gen + 1u) * nloc) {
            __builtin_amdgcn_fence(__ATOMIC_RELEASE, "agent");
            asm volatile("s_waitcnt vmcnt(0)" ::: "memory");
            const unsigned og = xb_add(&bar[XB_TOP], 1u);
            const unsigned tg = og / nx;
            if (og + 1u == (tg + 1u) * nx) xb_add(&bar[XB_TOPGEN], 1u);
            else XB_SPIN(xb_ld(&bar[XB_TOPGEN]) == tg, bar);
            __builtin_amdgcn_fence(__ATOMIC_ACQUIRE, "agent");
            xb_add(&bar[XB_XGEN(b.x)], 1u);
            asm volatile("s_waitcnt vmcnt(0)" ::: "memory");
        } else {
            XB_SPIN(xb_ld(&bar[XB_XGEN(b.x)]) == gen, bar);
            __builtin_amdgcn_fence(__ATOMIC_ACQUIRE, "agent");
            asm volatile("s_waitcnt vmcnt(0)" ::: "memory");
        }
    }
    __syncthreads();
}

struct Args {
    const float* in[22]; float* out; unsigned char* ws; int ph_lo, ph_hi, li, pad;
};
struct Frame {
    LAS unsigned char* lds;
    int tid, lane, wave, vcu, G;
};
__device__ __forceinline__ void p0_item(const float* W, int N, bf16* WT, int K, int dst_row0, int k0, int n0, LAS float* scr, int lane) {
    f32x4 v[8];
#pragma unroll
    for (int i = 0; i < 8; ++i) v[i] = *(const f32x4*)(W + (size_t)(k0 + (lane >> 3) + 8 * i) * N + n0 + 4 * (lane & 7));
#pragma unroll
    for (int i = 0; i < 8; ++i) { LAS float* s = scr + ((lane >> 3) + 8 * i) * 33 + 4 * (lane & 7); s[0] = v[i].x; s[1] = v[i].y; s[2] = v[i].z; s[3] = v[i].w; }
    LDS_WAIT(); asm volatile("" ::: "memory");
    const int c = lane & 7;
#pragma unroll
    for (int j = 0; j < 4; ++j) { const int n = (lane >> 3) + 8 * j; const LAS float* s = scr + (8 * c) * 33 + n;
        u32x4 o; o.x = pk2(s[0 * 33], s[1 * 33]); o.y = pk2(s[2 * 33], s[3 * 33]); o.z = pk2(s[4 * 33], s[5 * 33]); o.w = pk2(s[6 * 33], s[7 * 33]);
        *(u32x4*)(WT + (size_t)(dst_row0 + n) * K + k0 + 8 * c) = o; }
    LDS_WAIT(); asm volatile("" ::: "memory");
}
struct ConvItem { const float* W; signed char* dst; float* sc; int n0, dst_row0; };
__device__ __forceinline__ ConvItem conv_decode(const Args& a, int it) {
    unsigned char* ws = a.ws;
    const int nb = it & 31, e = (it >> 5) & 31, kind = it >> 10, n0 = nb * 32;
    ConvItem c;
    c.W = (kind == 0 ? a.in[14] : kind == 1 ? a.in[16] : a.in[18]) + (size_t)e * D * DFF;
    c.dst = kind < 2 ? (signed char*)(ws + WS_WGU) + (size_t)e * 2048 * 1024 : (signed char*)(ws + WS_WD) + (size_t)e * 1024 * 1024;
    c.dst_row0 = kind < 2 ? (n0 >> 7) * 256 + kind * 128 + (n0 & 127) : n0;
    c.sc = kind < 2 ? (float*)(ws + WS_SWGU) + e * 2048 : (float*)(ws + WS_SWD) + e * 1024;
    c.n0 = n0; return c;
}
#define CONV_LOAD(v, ci) do { _Pragma("unroll") for (int i_ = 0; i_ < 4; ++i_) _Pragma("unroll") for (int j_ = 0; j_ < 4; ++j_) \
        v[i_][j_] = *(const f32x4*)((ci).W + (size_t)(4 * (kl + 64 * i_) + j_) * DFF + (ci).n0 + 4 * n4); } while (0)
__device__ __forceinline__ void conv_items(const Frame& F, const Args& a, int it_lo, int it_hi) {
    if (it_hi > 3 * NEXP * 32) it_hi = 3 * NEXP * 32;
    if (it_lo >= it_hi) return;
    const int tid = F.tid, n4 = tid & 7, kl = tid >> 3;
    LAS unsigned* tile = (LAS unsigned*)F.lds;
    LAS float* red = (LAS float*)(F.lds + 36864);
    f32x4 v[4][4];
    ConvItem cur = conv_decode(a, it_lo);
    CONV_LOAD(v, cur);
    for (int it = it_lo; it < it_hi; ++it) {
        f32x4 am = (f32x4){0.f, 0.f, 0.f, 0.f};
#pragma unroll
        for (int i = 0; i < 4; ++i)
#pragma unroll
            for (int j = 0; j < 4; ++j) { am.x = fmaxf(am.x, fabsf(v[i][j].x)); am.y = fmaxf(am.y, fabsf(v[i][j].y)); am.z = fmaxf(am.z, fabsf(v[i][j].z)); am.w = fmaxf(am.w, fabsf(v[i][j].w)); }
#pragma unroll
        for (int o = 8; o < 64; o <<= 1) { am.x = fmaxf(am.x, __shfl_xor(am.x, o)); am.y = fmaxf(am.y, __shfl_xor(am.y, o)); am.z = fmaxf(am.z, __shfl_xor(am.z, o)); am.w = fmaxf(am.w, __shfl_xor(am.w, o)); }
        if (F.lane < 8) *(LAS f32x4*)(red + F.wave * 32 + 4 * n4) = am;
        __syncthreads();
        f32x4 cm = *(const LAS f32x4*)(red + 4 * n4);
#pragma unroll
        for (int w = 1; w < 8; ++w) { const f32x4 o = *(const LAS f32x4*)(red + w * 32 + 4 * n4); cm.x = fmaxf(cm.x, o.x); cm.y = fmaxf(cm.y, o.y); cm.z = fmaxf(cm.z, o.z); cm.w = fmaxf(cm.w, o.w); }
        f32x4 inv;
#pragma unroll
        for (int c = 0; c < 4; ++c) inv[c] = cm[c] > 0.f ? 127.0f / cm[c] : 0.f;
        if (kl == 0) {
#pragma unroll
            for (int c = 0; c < 4; ++c) cur.sc[cur.dst_row0 + 4 * n4 + c] = cm[c] * (1.0f / 127.0f);
        }
#pragma unroll
        for (int i = 0; i < 4; ++i)
#pragma unroll
            for (int c = 0; c < 4; ++c) {
                unsigned d = 0u;
#pragma unroll
                for (int j = 0; j < 4; ++j) { const int q = (int)rintf(v[i][j][c] * inv[c]); d |= ((unsigned)q & 0xffu) << (8 * j); }
                tile[(4 * n4 + c) * 260 + kl + 64 * i] = d;
            }
        const ConvItem done = cur;
        if (it + 1 < it_hi) { cur = conv_decode(a, it + 1); CONV_LOAD(v, cur); }
        __syncthreads();
#pragma unroll
        for (int j = 0; j < 4; ++j) { const int ch = tid + 512 * j, n = ch >> 6, c16 = ch & 63;
            *(u32x4*)(done.dst + (size_t)(done.dst_row0 + n) * 1024 + 16 * c16) = *(const LAS u32x4*)(tile + n * 260 + 4 * c16); }
        __syncthreads();
    }
}
__device__ __forceinline__ void p0_prologue(const Frame& F, const Args& a) {
    unsigned char* ws = a.ws;
    bf16* Win_t = (bf16*)(ws + WS_WIN); bf16* Wout_t = (bf16*)(ws + WS_WOUT);
    LAS float* scr = (LAS float*)(F.lds + F.wave * 8448);
    const int gw = F.vcu * NWAVES + F.wave, NGW = F.G * NWAVES;
    constexpr int I_IN = 16 * 56, I_OUT = 16 * 32, NITEMS = I_IN + I_OUT;
    for (int it = gw; it < NITEMS; it += NGW) {
        int r = it;
        if (r < I_IN) { const int kb = r / 56, nb = r % 56; p0_item(a.in[1], INW, Win_t, D, nb * 32, kb * 64, nb * 32, scr, F.lane); continue; } r -= I_IN;
        { const int kb = r / 32, nb = r % 32; p0_item(a.in[8], D, Wout_t, D, nb * 32, kb * 64, nb * 32, scr, F.lane); }
    }
    const float* x = a.in[0]; bf16* XB = (bf16*)(ws + WS_XB);
    for (int m = gw; m < T; m += NGW) {
        const f32x4* xr = (const f32x4*)(x + (size_t)m * D) + F.lane; u32x2* o = (u32x2*)(XB + (size_t)m * D) + F.lane;
        f32x4 v[4];
#pragma unroll
        for (int j = 0; j < 4; ++j) v[j] = xr[64 * j];
#pragma unroll
        for (int j = 0; j < 4; ++j) { u32x2 w; w.x = pk2(v[j].x, v[j].y); w.y = pk2(v[j].z, v[j].w); o[64 * j] = w; }
    }
}

__device__ __forceinline__ int crow(int r, int hi) { return (r & 3) + 8 * (r >> 2) + 4 * hi; }
constexpr int AT_KROW = 144, AT_KG = 192 * AT_KROW, AT_VROW = 400, AT_VG = 64 * AT_VROW, AT_VOFF = 2 * AT_KG;
__device__ __forceinline__ void attn_wave_unit(const LAS unsigned char* lds, const bf16x8 (&qf)[4], const float sk, bf16* CAT, int tok0, int u, int h, int lane) {
    const int r32 = lane & 31, hi = lane >> 5;
    const int t0 = tok0 % SEQ, g = h >> 2;
    const int kk0 = 32 * u;
    f32x16 p[5];
    const float NEG = -INFINITY;
    const LAS unsigned char* kl = lds + g * AT_KG + (kk0 + r32) * AT_KROW + hi * 16;
#pragma unroll
    for (int j = 0; j < 5; ++j) {
        const int kb = t0 - 128 + 32 * j;
        f32x16 s;
#pragma unroll
        for (int r = 0; r < 16; ++r) s[r] = 0.f;
        if (kb >= 0) {
#pragma unroll
            for (int d0 = 0; d0 < 4; ++d0) { const bf16x8 kf = *(const LAS bf16x8*)(kl + j * 32 * AT_KROW + d0 * 32); s = __builtin_amdgcn_mfma_f32_32x32x16_bf16(kf, qf[d0], s, 0, 0, 0); }
            if (j == 0) {
#pragma unroll
                for (int r = 0; r < 16; ++r) if (!(crow(r, hi) > r32)) s[r] = NEG;
            }
            if (j == 4) {
#pragma unroll
                for (int r = 0; r < 16; ++r) if (!(crow(r, hi) <= r32)) s[r] = NEG;
            }
        } else {
#pragma unroll
            for (int r = 0; r < 16; ++r) s[r] = NEG;
        }
        p[j] = s;
    }
    float m = sk;
#pragma unroll
    for (int j = 0; j < 5; ++j)
#pragma unroll
        for (int r = 0; r < 16; ++r) m = fmaxf(m, p[j][r]);
    m = fmaxf(m, __shfl_xor(m, 32));
    float l = 0.f;
#pragma unroll
    for (int j = 0; j < 5; ++j)
#pragma unroll
        for (int r = 0; r < 16; ++r) { const float e = __builtin_amdgcn_exp2f(p[j][r] - m); p[j][r] = e; l += e; }
    l += __shfl_xor(l, 32);
    l += __builtin_amdgcn_exp2f(sk - m);
    const float inv = 1.0f / l;
    u32x4 pb[5][2];
#pragma unroll
    for (int j = 0; j < 5; ++j)
#pragma unroll
        for (int s = 0; s < 2; ++s) { pb[j][s].x = cvt_pk_bf16(p[j][8 * s + 0], p[j][8 * s + 1]); pb[j][s].y = cvt_pk_bf16(p[j][8 * s + 2], p[j][8 * s + 3]); pb[j][s].z = cvt_pk_bf16(p[j][8 * s + 4], p[j][8 * s + 5]); pb[j][s].w = cvt_pk_bf16(p[j][8 * s + 6], p[j][8 * s + 7]); }
#pragma unroll
    for (int db = 0; db < 2; ++db) {
        f32x16 o;
#pragma unroll
        for (int r = 0; r < 16; ++r) o[r] = 0.f;
        const LAS unsigned char* vl = lds + AT_VOFF + g * AT_VG + (db * 32 + r32) * AT_VROW + (kk0 + 4 * hi) * 2;
#pragma unroll
        for (int j = 0; j < 5; ++j) {
            const int kb = t0 - 128 + 32 * j;
            if (kb >= 0) {
#pragma unroll
                for (int s = 0; s < 2; ++s) {
                    const u32x2 lo = *(const LAS u32x2*)(vl + (32 * j + 16 * s) * 2), hh = *(const LAS u32x2*)(vl + (32 * j + 16 * s + 8) * 2);
                    u32x4 av; av.x = lo.x; av.y = lo.y; av.z = hh.x; av.w = hh.y;
                    o = __builtin_amdgcn_mfma_f32_32x32x16_bf16(__builtin_bit_cast(bf16x8, av), __builtin_bit_cast(bf16x8, pb[j][s]), o, 0, 0, 0);
                }
            }
        }
        bf16* op = CAT + (size_t)(tok0 + r32) * 1024 + h * 64 + db * 32 + 4 * hi;
#pragma unroll
        for (int gq = 0; gq < 4; ++gq) { u32x2 w; w.x = cvt_pk_bf16(o[4 * gq] * inv, o[4 * gq + 1] * inv); w.y = cvt_pk_bf16(o[4 * gq + 2] * inv, o[4 * gq + 3] * inv); *(u32x2*)(op + 8 * gq) = w; }
    }
}
__device__ __forceinline__ void attn_block(const Frame& F, const bf16* QB, const bf16* KB, const bf16* VT, const float* sinks, bf16* CAT, int qq) {
    const int tokb = qq * 64, b = tokb / SEQ, tb = tokb % SEQ, kbase = tb - 128;
    u32x4 kv[6], vv[6];
    bf16x8 qf0[4], qf1[4];
    { const int r32 = F.lane & 31, hi = F.lane >> 5;
#pragma unroll
      for (int d0 = 0; d0 < 4; ++d0) { qf0[d0] = *(const bf16x8*)(QB + (size_t)(tokb + r32) * 512 + F.wave * 64 + d0 * 16 + hi * 8); qf1[d0] = *(const bf16x8*)(QB + (size_t)(tokb + 32 + r32) * 512 + F.wave * 64 + d0 * 16 + hi * 8); } }
    const float sk = sinks[F.wave] * LOG2E;
#pragma unroll
    for (int i = 0; i < 6; ++i) {
        const int c = F.tid + 512 * i, g = c / 1536, rem = c % 1536;
        { const int key = rem >> 3, ch = rem & 7, pos = kbase + key;
          kv[i] = pos >= 0 ? *(const u32x4*)(KB + (size_t)(b * SEQ + pos) * 128 + g * 64 + ch * 8) : (u32x4){0u, 0u, 0u, 0u}; }
        { const int d = rem / 24, ch = rem % 24, pos = kbase + ch * 8;
          vv[i] = pos >= 0 ? *(const u32x4*)(VT + ((size_t)((b * 2 + g) * 64 + d)) * SEQ + pos) : (u32x4){0u, 0u, 0u, 0u}; }
    }
#pragma unroll
    for (int i = 0; i < 6; ++i) {
        const int c = F.tid + 512 * i, g = c / 1536, rem = c % 1536;
        *(LAS u32x4*)(F.lds + g * AT_KG + (rem >> 3) * AT_KROW + (rem & 7) * 16) = kv[i];
        *(LAS u32x4*)(F.lds + AT_VOFF + g * AT_VG + (rem / 24) * AT_VROW + (rem % 24) * 16) = vv[i];
    }
    __syncthreads();
    attn_wave_unit(F.lds, qf0, sk, CAT, tokb, 0, F.wave, F.lane);
    attn_wave_unit(F.lds, qf1, sk, CAT, tokb + 32, 1, F.wave, F.lane);
    __syncthreads();
}
template <int CTRL> __device__ __forceinline__ float dppq(float v) { return __builtin_bit_cast(float, __builtin_amdgcn_update_dpp(0, __builtin_bit_cast(int, v), CTRL, 0xF, 0xF, true)); }
constexpr int SG_WOFF = 20480, SG_WROW = 272;
__device__ __forceinline__ void sgu_stage_w(const Frame& F, const float* w_s, int gi) {
    f32x4 w[8];
#pragma unroll
    for (int i = 0; i < 8; ++i) w[i] = *(const f32x4*)(w_s + (size_t)gi * 16384 + (size_t)(F.tid + 512 * i) * 4);
#pragma unroll
    for (int i = 0; i < 8; ++i) { const int c = F.tid + 512 * i, t = c >> 5, s0 = (c & 31) * 4;
        f32x4 v = w[i];
#pragma unroll
        for (int j = 0; j < 4; ++j) if (s0 + j > t) v[j] = 0.f;
        u32x2 o; o.x = cvt_pk_bf16(v[0], v[1]); o.y = cvt_pk_bf16(v[2], v[3]);
        *(LAS u32x2*)(F.lds + SG_WOFF + t * SG_WROW + s0 * 2) = o; }
}
__device__ __forceinline__ void sgu_unit(const Frame& F, const bf16* UB, const bf16* GB, const float* ln_g, const float* ln_b, const float* w_s, const float* b_s, bf16* CAT, int ch, int gi) {
    LAS bf16* GT = (LAS bf16*)F.lds;
    const int r32 = F.lane & 31, hi = F.lane >> 5, tb = F.wave >> 1, db = F.wave & 1, t = tb * 32 + r32;
    const int nks = 2 * (tb + 1);
    const int s = F.tid >> 2, q4 = F.tid & 3; const size_t tok = (size_t)ch * 128 + s;
    const u32x4* gp = (const u32x4*)(GB + tok * 512 + gi * 64 + q4 * 16);
    const u32x4 a = gp[0], c = gp[1];
    const size_t tokt = (size_t)ch * 128 + t;
    const bf16* up = UB + tokt * 512 + gi * 64 + db * 32 + 4 * hi;
    u32x2 uu[4];
#pragma unroll
    for (int gq = 0; gq < 4; ++gq) uu[gq] = *(const u32x2*)(up + 8 * gq);
    const float bb = b_s[gi * 128 + t];
    float lg_[16], lb_[16];
#pragma unroll
    for (int i = 0; i < 16; ++i) { lg_[i] = ln_g[gi * 64 + q4 * 16 + i]; lb_[i] = ln_b[gi * 64 + q4 * 16 + i]; }
    {
        float v[16];
        v[0] = __uint_as_float(a.x << 16); v[1] = __uint_as_float(a.x & 0xffff0000u); v[2] = __uint_as_float(a.y << 16); v[3] = __uint_as_float(a.y & 0xffff0000u);
        v[4] = __uint_as_float(a.z << 16); v[5] = __uint_as_float(a.z & 0xffff0000u); v[6] = __uint_as_float(a.w << 16); v[7] = __uint_as_float(a.w & 0xffff0000u);
        v[8] = __uint_as_float(c.x << 16); v[9] = __uint_as_float(c.x & 0xffff0000u); v[10] = __uint_as_float(c.y << 16); v[11] = __uint_as_float(c.y & 0xffff0000u);
        v[12] = __uint_as_float(c.z << 16); v[13] = __uint_as_float(c.z & 0xffff0000u); v[14] = __uint_as_float(c.w << 16); v[15] = __uint_as_float(c.w & 0xffff0000u);
        float sum = 0.f;
#pragma unroll
        for (int i = 0; i < 16; ++i) sum += v[i];
        sum += dppq<0xB1>(sum); sum += dppq<0x4E>(sum);
        const float mu = sum * (1.f / 64.f); float q = 0.f;
#pragma unroll
        for (int i = 0; i < 16; ++i) { v[i] -= mu; q += v[i] * v[i]; }
        q += dppq<0xB1>(q); q += dppq<0x4E>(q);
        const float rstd = rsqrtf(q * (1.f / 64.f) + LN_EPS);
#pragma unroll
        for (int i = 0; i < 16; ++i) { const int d = q4 * 16 + i; GT[d * 136 + s] = (bf16)f2bf(v[i] * rstd * lg_[i] + lb_[i]); }
    }
    __syncthreads();
    {
        f32x16 acc;
#pragma unroll
        for (int r = 0; r < 16; ++r) acc[r] = 0.f;
        const LAS bf16* arow = GT + (db * 32 + r32) * 136 + hi * 8;
        const LAS unsigned char* wlds = F.lds + SG_WOFF + t * SG_WROW + hi * 16;
#pragma unroll
        for (int ks = 0; ks < 8; ++ks) if (ks < nks) {
            const bf16x8 af = *(const LAS bf16x8*)(arow + ks * 16);
            const bf16x8 bw = *(const LAS bf16x8*)(wlds + ks * 32);
            acc = __builtin_amdgcn_mfma_f32_32x32x16_bf16(af, bw, acc, 0, 0, 0);
        }
        bf16* op = CAT + tokt * 1024 + 512 + gi * 64 + db * 32 + 4 * hi;
#pragma unroll
        for (int gq = 0; gq < 4; ++gq) {
            const float u0 = __uint_as_float(uu[gq].x << 16), u1 = __uint_as_float(uu[gq].x & 0xffff0000u), u2 = __uint_as_float(uu[gq].y << 16), u3 = __uint_as_float(uu[gq].y & 0xffff0000u);
            u32x2 w; w.x = cvt_pk_bf16(u0 * (acc[4 * gq] + bb), u1 * (acc[4 * gq + 1] + bb)); w.y = cvt_pk_bf16(u2 * (acc[4 * gq + 2] + bb), u3 * (acc[4 * gq + 3] + bb));
            *(u32x2*)(op + 8 * gq) = w;
        }
    }
    __syncthreads();
}
__device__ __forceinline__ void p2_mixers(const Frame& F, const Args& a) {
    unsigned char* ws = a.ws;
    const bf16 *QB = (const bf16*)(ws + WS_QB), *KB = (const bf16*)(ws + WS_KB), *VT = (const bf16*)(ws + WS_VT), *UB = (const bf16*)(ws + WS_UB), *GB = (const bf16*)(ws + WS_GB);
    bf16* CAT = (bf16*)(ws + WS_CAT);
    for (int qq = F.vcu; qq < T / 64; qq += F.G) attn_block(F, QB, KB, VT, a.in[3], CAT, qq);
    int gi_staged = -1;
    for (int u = F.vcu; u < (T / 128) * 8; u += F.G) {
        if ((u & 7) != gi_staged) { __syncthreads(); sgu_stage_w(F, a.in[6], u & 7); gi_staged = u & 7; }
        sgu_unit(F, UB, GB, a.in[4], a.in[5], a.in[6], a.in[7], CAT, u >> 3, u & 7);
    }
}

template <int CTRL> __device__ __forceinline__ float dppf(float v) { return __builtin_bit_cast(float, __builtin_amdgcn_update_dpp(0, __builtin_bit_cast(int, v), CTRL, 0xF, 0xF, true)); }
__device__ __forceinline__ float swap16_sum(float x, float y) { auto r = __builtin_amdgcn_permlane16_swap(__builtin_bit_cast(unsigned, x), __builtin_bit_cast(unsigned, y), false, false); return __builtin_bit_cast(float, r[0]) + __builtin_bit_cast(float, r[1]); }
__device__ __forceinline__ float swap32_sum(float x, float y) { auto r = __builtin_amdgcn_permlane32_swap(__builtin_bit_cast(unsigned, x), __builtin_bit_cast(unsigned, y), false, false); return __builtin_bit_cast(float, r[0]) + __builtin_bit_cast(float, r[1]); }
__device__ __forceinline__ float rdlane(float v, int l) { return __builtin_bit_cast(float, __builtin_amdgcn_readlane(__builtin_bit_cast(int, v), l)); }
__device__ __forceinline__ float xsum(float v) {
    v += dppf<0xB1>(v); v += dppf<0x4E>(v); v += dppf<0x124>(v); v += dppf<0x128>(v);
    return (rdlane(v, 0) + rdlane(v, 16)) + (rdlane(v, 32) + rdlane(v, 48));
}
__device__ __forceinline__ float xmax(float v) {
    v = fmaxf(v, dppf<0xB1>(v)); v = fmaxf(v, dppf<0x4E>(v)); v = fmaxf(v, dppf<0x124>(v)); v = fmaxf(v, dppf<0x128>(v));
    return fmaxf(fmaxf(rdlane(v, 0), rdlane(v, 16)), fmaxf(rdlane(v, 32), rdlane(v, 48)));
}
__device__ __forceinline__ void p4_router(const Frame& F, const Args& a, bool commit) {
    const float* Zin = a.out; float* Hout = (float*)(a.ws + WS_H); signed char* HB8 = (signed char*)(a.ws + WS_HB); int* meta = (int*)(a.ws + WS_META); unsigned* cnt = (unsigned*)(a.ws + WS_CTL) + CW_CNT;
    const float* ln1_g = a.in[10]; const float* ln1_b = a.in[11]; const float* w_r = a.in[12]; const float* b_r = a.in[13];
    LAS float* W = (LAS float*)F.lds;
    LAS unsigned* hist = (LAS unsigned*)(F.lds + RSCR_OFF);
    LAS unsigned* base = hist + 32;
    LAS int* tmp_e = (LAS int*)(hist + 64);
    LAS int* tmp_p = tmp_e + 256;
    LAS float* tmp_g = (LAS float*)(tmp_p + 256);
    {
        f32x4 t[16];
#pragma unroll
        for (int k = 0; k < 16; ++k) t[k] = *(const f32x4*)(w_r + (size_t)(F.tid + 512 * k) * 4);
#pragma unroll
        for (int k = 0; k < 16; ++k) { const int i = F.tid + 512 * k, c = i >> 3, e4 = i & 7, pr = (c & ~255) + 64 * (c & 3) + ((c >> 2) & 63); *(LAS f32x4*)(W + pr * 36 + e4 * 4) = t[k]; }
    }
    { const int gt = F.vcu * (NWAVES * 64) + F.tid, NGT = F.G * NWAVES * 64;
      for (int i = gt; i < NROWS_MAX; i += NGT) { meta[MT_ROW_TOK + i] = 0; ((float*)meta)[MT_ROW_GATE + i] = 0.f; ((float*)meta)[MT_ROW_SA + i] = 0.f; } }
    const int lane = F.lane, half = lane >> 5, el = lane & 31;
    LAS float* gbl = (LAS float*)(F.lds + 151552);
    for (int i = F.tid; i < 512; i += NWAVES * 64) *(LAS f32x4*)(gbl + 4 * i) = i < 256 ? *(const f32x4*)(ln1_g + 4 * i) : *(const f32x4*)(ln1_b + 4 * (i - 256));
    for (int tb = F.vcu; tb < T / 64; tb += F.G) {
        if (F.tid < 32) hist[F.tid] = 0u;
        __syncthreads();
        float zn0[16], zn1[16];
        { const f32x4* z0 = (const f32x4*)(Zin + (size_t)(tb * 64 + 8 * F.wave) * D) + lane;
#pragma unroll
          for (int j = 0; j < 4; ++j) { const f32x4 a0 = z0[64 * j], a1 = z0[256 + 64 * j];
#pragma unroll
            for (int k = 0; k < 4; ++k) { zn0[4 * j + k] = a0[k]; zn1[4 * j + k] = a1[k]; } } }
        for (int pp = 0; pp < 4; ++pp) {
            const int tl0 = 8 * F.wave + 2 * pp;
            const int tok0 = tb * 64 + tl0;
            float h0[16], h1[16];
            {
                f32x4* ho0 = (f32x4*)(Hout + (size_t)tok0 * D) + lane; f32x4* ho1 = ho0 + 256;
                float s0 = 0.f, s1 = 0.f, q0 = 0.f, q1 = 0.f;
#pragma unroll
                for (int i = 0; i < 16; ++i) { h0[i] = zn0[i]; h1[i] = zn1[i]; }
                if (pp < 3) { const f32x4* zp = (const f32x4*)(Zin + (size_t)(tok0 + 2) * D) + lane;
#pragma unroll
                    for (int j = 0; j < 4; ++j) { const f32x4 a0 = zp[64 * j], a1 = zp[256 + 64 * j];
#pragma unroll
                        for (int k = 0; k < 4; ++k) { zn0[4 * j + k] = a0[k]; zn1[4 * j + k] = a1[k]; } } }
#pragma unroll
                for (int i = 0; i < 16; ++i) { s0 += h0[i]; s1 += h1[i]; q0 += h0[i] * h0[i]; q1 += h1[i] * h1[i]; }
                s0 = xsum(s0); s1 = xsum(s1); q0 = xsum(q0); q1 = xsum(q1);
                const float m0 = s0 * (1.f / D), m1 = s1 * (1.f / D);
                const float r0 = rsqrtf(fmaxf(q0 * (1.f / D) - m0 * m0, 0.f) + LN_EPS), r1 = rsqrtf(fmaxf(q1 * (1.f / D) - m1 * m1, 0.f) + LN_EPS);
                float a0 = 0.f, a1 = 0.f;
#pragma unroll
                for (int i = 0; i < 16; ++i) {
                    const float gm_ = gbl[4 * lane + 256 * (i >> 2) + (i & 3)], bt_ = gbl[1024 + 4 * lane + 256 * (i >> 2) + (i & 3)];
                    h0[i] = (h0[i] - m0) * r0 * gm_ + bt_; h1[i] = (h1[i] - m1) * r1 * gm_ + bt_;
                    a0 = fmaxf(a0, fabsf(h0[i])); a1 = fmaxf(a1, fabsf(h1[i]));
                }
                a0 = xmax(a0); a1 = xmax(a1);
                const float i0 = a0 > 0.f ? 127.0f / a0 : 0.f, i1 = a1 > 0.f ? 127.0f / a1 : 0.f;
                unsigned* hb0 = (unsigned*)(HB8 + (size_t)tok0 * D) + lane; unsigned* hb1 = hb0 + 256;
#pragma unroll
                for (int j = 0; j < 4; ++j) {
                    ho0[64 * j] = (f32x4){h0[4 * j], h0[4 * j + 1], h0[4 * j + 2], h0[4 * j + 3]}; ho1[64 * j] = (f32x4){h1[4 * j], h1[4 * j + 1], h1[4 * j + 2], h1[4 * j + 3]};
                    unsigned p0 = 0u, p1 = 0u;
#pragma unroll
                    for (int k = 0; k < 4; ++k) { p0 |= ((unsigned)(int)rintf(h0[4 * j + k] * i0) & 0xffu) << (8 * k); p1 |= ((unsigned)(int)rintf(h1[4 * j + k] * i1) & 0xffu) << (8 * k); }
                    hb0[64 * j] = p0; hb1[64 * j] = p1;
                }
                if (lane == 0) { ((float*)meta)[MT_SH + tok0] = a0 * (1.0f / 127.0f); ((float*)meta)[MT_SH + tok0 + 1] = a1 * (1.0f / 127.0f); }
            }
            f32x2 lp0[16], lp1[16];
#pragma unroll
            for (int e = 0; e < 16; ++e) { lp0[e] = (f32x2){0.f, 0.f}; lp1[e] = (f32x2){0.f, 0.f}; }
#pragma unroll
            for (int i = 0; i < 16; ++i) {
                const LAS f32x4* wr = (const LAS f32x4*)(W + (256 * (i >> 2) + 64 * (i & 3) + lane) * 36);
                const f32x2 hv0 = (f32x2){h0[i], h0[i]}, hv1 = (f32x2){h1[i], h1[i]};
#pragma unroll
                for (int e4 = 0; e4 < 8; ++e4) {
                    const f32x4 ww = wr[e4];
                    const f32x2 wlo = (f32x2){ww.x, ww.y}, whi = (f32x2){ww.z, ww.w};
                    lp0[2 * e4] = __builtin_elementwise_fma(hv0, wlo, lp0[2 * e4]); lp0[2 * e4 + 1] = __builtin_elementwise_fma(hv0, whi, lp0[2 * e4 + 1]);
                    lp1[2 * e4] = __builtin_elementwise_fma(hv1, wlo, lp1[2 * e4]); lp1[2 * e4 + 1] = __builtin_elementwise_fma(hv1, whi, lp1[2 * e4 + 1]);
                }
            }
            float lg0[32], lg1[32];
#pragma unroll
            for (int e = 0; e < 16; ++e) { lg0[2 * e] = lp0[e].x; lg0[2 * e + 1] = lp0[e].y; lg1[2 * e] = lp1[e].x; lg1[2 * e + 1] = lp1[e].y; }
            float v32[32];
#pragma unroll
            for (int e = 0; e < 32; ++e) { const float keep = half ? lg1[e] : lg0[e], send = half ? lg0[e] : lg1[e]; v32[e] = keep + __shfl_xor(send, 32); }
            float v16[16];
#pragma unroll
            for (int e = 0; e < 16; ++e) { const bool up = (lane & 16) != 0; const float keep = up ? v32[e + 16] : v32[e], send = up ? v32[e] : v32[e + 16]; v16[e] = keep + __shfl_xor(send, 16); }
            float v8[8];
#pragma unroll
            for (int e = 0; e < 8; ++e) { const bool up = (lane & 8) != 0; const float keep = up ? v16[e + 8] : v16[e], send = up ? v16[e] : v16[e + 8]; v8[e] = keep + dppf<0x128>(send); }
            float v4[4];
#pragma unroll
            for (int e = 0; e < 4; ++e) { const bool up = (lane & 4) != 0; const float keep = up ? v8[e + 4] : v8[e], send = up ? v8[e] : v8[e + 4]; v4[e] = keep + dppf<0x1B>(dppf<0x141>(send)); }
            float v2[2];
#pragma unroll
            for (int e = 0; e < 2; ++e) { const bool up = (lane & 2) != 0; const float keep = up ? v4[e + 2] : v4[e], send = up ? v4[e] : v4[e + 2]; v2[e] = keep + dppf<0x4E>(send); }
            float lgt;
            { const bool up = (lane & 1) != 0; const float keep = up ? v2[1] : v2[0], send = up ? v2[0] : v2[1]; lgt = keep + dppf<0xB1>(send); }
            lgt += b_r[el];
            int rank = 0;
#pragma unroll
            for (int j = 0; j < 32; ++j) {
                const float lo = rdlane(lgt, j), hi2 = rdlane(lgt, 32 + j);
                const float vj = half ? hi2 : lo;
                rank += (vj > lgt || (vj == lgt && j < el)) ? 1 : 0;
            }
            float bv[4]; int bi[4];
#pragma unroll
            for (int k = 0; k < 4; ++k) {
                const unsigned long long mk = __ballot(rank == k);
                const int i0 = __builtin_ctz((unsigned)mk | 0x80000000u), i1 = 32 + __builtin_ctz((unsigned)(mk >> 32) | 0x80000000u);
                const float x0 = rdlane(lgt, i0), x1 = rdlane(lgt, i1);
                bv[k] = half ? x1 : x0; bi[k] = half ? (i1 - 32) : i0;
            }
            float ex[4], es = 0.f;
#pragma unroll
            for (int k = 0; k < 4; ++k) { ex[k] = __expf(bv[k] - bv[0]); es += ex[k]; }
            if (el == 0) {
                const int tl = tl0 + half;
#pragma unroll
                for (int k = 0; k < 4; ++k) { const unsigned pl = atomicAdd((unsigned*)&hist[bi[k]], 1u); tmp_e[tl * 4 + k] = bi[k]; tmp_p[tl * 4 + k] = (int)pl; tmp_g[tl * 4 + k] = ex[k] / es; }
            }
        }
        __syncthreads();
        if (F.tid < 32) base[F.tid] = commit ? atomicAdd(&cnt[F.tid], hist[F.tid]) : 0u;
        __syncthreads();
        if (F.tid < 256) { const int i = F.tid, gi = tb * 256 + i, e = tmp_e[i];
            meta[MT_SEL_E + gi] = e; meta[MT_SEL_POS + gi] = (int)base[e] + tmp_p[i]; ((float*)meta)[MT_SEL_G + gi] = tmp_g[i]; }
        __syncthreads();
    }
}
__device__ __forceinline__ void p5_dispatch(const Frame& F, const Args& a) {
    int* meta = (int*)(a.ws + WS_META); const unsigned* cnt = (const unsigned*)(a.ws + WS_CTL) + CW_CNT;
    LAS int* ts = (LAS int*)(F.lds + RSCR_OFF);
    if (F.tid == 0) { int acc = 0; for (int e = 0; e < 32; ++e) { ts[e] = acc; acc += ((int)__hip_atomic_load(cnt + e, RLX_AGENT) + 255) >> 8; } ts[32] = acc; }
    __syncthreads();
    if (blockIdx.x == 0) {
        if (F.tid == 0) meta[MT_NT] = ts[32];
        if (F.tid < 33) meta[MT_TSTART + F.tid] = ts[F.tid];
        for (int t = F.tid; t < NT_MAX; t += NWAVES * 64) { int e = 0; for (int j = 1; j < 32; ++j) if (t >= ts[j]) e = j; meta[MT_TILE_E + t] = e; }
    }
    const int gt = F.vcu * (NWAVES * 64) + F.tid, NGT = F.G * NWAVES * 64;
    for (int i = gt; i < T * 4; i += NGT) {
        const int e = meta[MT_SEL_E + i], row = ts[e] * 256 + meta[MT_SEL_POS + i];
        meta[MT_ROW_TOK + row] = i >> 2; ((float*)meta)[MT_ROW_GATE + row] = ((const float*)meta)[MT_SEL_G + i]; ((float*)meta)[MT_ROW_SA + row] = ((const float*)meta)[MT_SH + (i >> 2)]; meta[MT_SLOT_ROW + i] = row;
    }
    __syncthreads();
}
__device__ __forceinline__ void p7_quant(const Frame& F, const Args& a) {
    const bf16* HID = (const bf16*)(a.ws + WS_HID); signed char* H8 = (signed char*)(a.ws + WS_HID8); float* row_sb = (float*)(a.ws + WS_ROWSB);
    const int nrows = __builtin_amdgcn_readfirstlane(((const int*)(a.ws + WS_META))[MT_NT]) * 256;
    const int gw = F.vcu * NWAVES + F.wave, NGW = F.G * NWAVES, lane = F.lane;
    for (int r0 = gw * 4; r0 < nrows; r0 += NGW * 4) {
        u32x4 v[4][2];
#pragma unroll
        for (int i = 0; i < 4; ++i)
#pragma unroll
            for (int j = 0; j < 2; ++j) v[i][j] = *((const u32x4*)(HID + (size_t)(r0 + i) * DFF + 512 * j) + lane);
#pragma unroll
        for (int i = 0; i < 4; ++i) {
            float f[16]; float am = 0.f;
#pragma unroll
            for (int j = 0; j < 2; ++j)
#pragma unroll
                for (int c = 0; c < 4; ++c) { const unsigned w = v[i][j][c]; f[8 * j + 2 * c] = __uint_as_float(w << 16); f[8 * j + 2 * c + 1] = __uint_as_float(w & 0xffff0000u); }
#pragma unroll
            for (int c = 0; c < 16; ++c) am = fmaxf(am, fabsf(f[c]));
            am = xmax(am);
            const float inv = am > 0.f ? 127.0f / am : 0.f;
#pragma unroll
            for (int j = 0; j < 2; ++j) {
                u32x2 o; o.x = 0u; o.y = 0u;
#pragma unroll
                for (int c = 0; c < 4; ++c) { o.x |= ((unsigned)(int)rintf(f[8 * j + c] * inv) & 0xffu) << (8 * c); o.y |= ((unsigned)(int)rintf(f[8 * j + 4 + c] * inv) & 0xffu) << (8 * c); }
                *((u32x2*)(H8 + (size_t)(r0 + i) * DFF + 512 * j) + lane) = o;
            }
            if (lane == 0) row_sb[r0 + i] = am * (1.0f / 127.0f);
        }
    }
}
__device__ __forceinline__ void p8_final(const Frame& F, const Args& a) {
    const float* Hin = (const float*)(a.ws + WS_H); float* HO = a.out; const unsigned char* Y = (const unsigned char*)(a.ws + WS_Y); const int* meta = (const int*)(a.ws + WS_META);
    const float* ln2_g = a.in[20]; const float* ln2_b = a.in[21];
    const int gw = F.vcu * NWAVES + F.wave, NGW = F.G * NWAVES, lane = F.lane;
    f32x4 g2[4], b2[4];
#pragma unroll
    for (int j = 0; j < 4; ++j) { g2[j] = *(const f32x4*)(ln2_g + 4 * lane + 256 * j); b2[j] = *(const f32x4*)(ln2_b + 4 * lane + 256 * j); }
    for (int tok = gw; tok < T; tok += NGW) {
        f32x4* hr = (f32x4*)(HO + (size_t)tok * D) + lane; const f32x4* hi_ = (const f32x4*)(Hin + (size_t)tok * D) + lane;
        f32x4 v[4]; float s = 0.f;
#pragma unroll
        for (int j = 0; j < 4; ++j) v[j] = hi_[64 * j] * ALPHA;
#pragma unroll
        for (int k = 0; k < 4; ++k) {
            const int row = meta[MT_SLOT_ROW + tok * 4 + k];
            const unsigned* yr = (const unsigned*)(Y + (size_t)row * D) + lane;
#pragma unroll
            for (int j = 0; j < 4; ++j) { const int y = (int)yr[64 * j]; const f32x2 lo = __builtin_amdgcn_cvt_pk_f32_fp8(y, false), hi2 = __builtin_amdgcn_cvt_pk_f32_fp8(y, true);
                v[j].x += lo.x * (1.0f / YSCALE); v[j].y += lo.y * (1.0f / YSCALE); v[j].z += hi2.x * (1.0f / YSCALE); v[j].w += hi2.y * (1.0f / YSCALE); }
        }
#pragma unroll
        for (int j = 0; j < 4; ++j) s += (v[j].x + v[j].y) + (v[j].z + v[j].w);
        const float mean = xsum(s) * (1.f / D); float s2 = 0.f;
#pragma unroll
        for (int j = 0; j < 4; ++j) { v[j] = v[j] - mean; s2 += (v[j].x * v[j].x + v[j].y * v[j].y) + (v[j].z * v[j].z + v[j].w * v[j].w); }
        const float rstd = rsqrtf(xsum(s2) * (1.f / D) + LN_EPS);
#pragma unroll
        for (int j = 0; j < 4; ++j) hr[64 * j] = v[j] * rstd * g2[j] + b2[j];
    }
}
__global__ void __launch_bounds__(NWAVES * 64, 2) mk_fwd(Args args) {
    extern __shared__ __attribute__((aligned(16))) unsigned char lds_raw[];
    Frame F;
    F.lds = (LAS unsigned char*)lds_raw;
    F.tid = threadIdx.x; F.lane = F.tid & 63; F.wave = __builtin_amdgcn_readfirstlane(F.tid >> 6);
    F.G = gridDim.x; { const int bx = blockIdx.x; F.vcu = (F.G % 8 == 0) ? (bx % 8) * (F.G / 8) + bx / 8 : bx; }
    volatile LAS unsigned* MISC = (volatile LAS unsigned*)(F.lds + MISC_OFF);
    if (F.tid < 64) MISC[F.tid] = 0u;
    __syncthreads();
    unsigned char* ws = args.ws;
    unsigned* ctl = (unsigned*)(ws + WS_CTL);
    const int lo = args.ph_lo, hi = args.ph_hi;
    XcdBarrier bar; bar.bar = ctl + CW_BAR + args.li * XCD_BAR_WORDS; bar.x = 0; bar.st = nullptr;
    if (hi - lo > 1) bar = xcd_barrier_post(ctl + CW_BAR + args.li * XCD_BAR_WORDS, MISC + 8);
#define IN(k) (lo <= (k) && (k) < hi)
#define OPAQUE_F(Fp) Frame Fp = F; asm volatile("" : "+v"(Fp.tid)); Fp.lane = Fp.tid & 63
#define SEAM(k) do { if (IN(k) && IN((k) + 1)) xcd_barrier(bar); } while (0)
    int* meta = (int*)(ws + WS_META);
    bf16 *XB = (bf16*)(ws + WS_XB), *QB = (bf16*)(ws + WS_QB), *KB = (bf16*)(ws + WS_KB), *VT = (bf16*)(ws + WS_VT), *UB = (bf16*)(ws + WS_UB), *GB = (bf16*)(ws + WS_GB);
    bf16 *CAT = (bf16*)(ws + WS_CAT), *HB = (bf16*)(ws + WS_HB), *Y = (bf16*)(ws + WS_Y), *HID = (bf16*)(ws + WS_HID);
    bf16 *Win_t = (bf16*)(ws + WS_WIN), *Wout_t = (bf16*)(ws + WS_WOUT), *Wgu_t = (bf16*)(ws + WS_WGU), *Wd_t = (bf16*)(ws + WS_WD);
    const LAS int* rtab = (const LAS int*)(F.lds + RTAB_OFF);
    const bool par = ((blockIdx.x >> 3) & 1) != 0;

    if (IN(0)) { OPAQUE_F(Fp); p0_prologue(Fp, args); SEAM(0); }
    if (IN(1)) {
        const int c = (int)blockIdx.x, grp = (c >> 3) % 3;
        const int per_ = (3 * NEXP * 32 + F.G - 1) / F.G;
        const int it_lo = F.G == 256 ? (c < 192 ? c * 10 : 1920 + (c - 192) * 18) : c * per_, it_hi = F.G == 256 ? it_lo + (c < 192 ? 10 : 18) : it_lo + per_;
        OPAQUE_F(Fp);
        if (grp == 0) conv_items(Fp, args, it_lo, it_hi);
        { pg8::Gemm g{XB, Win_t, 2 * D, nullptr, 0u}; pg8::StaticOrder S; S.init(T / 256, INW / 256, F.G, c); S.i1 = 1;
          pg8::EpiInProj E{args.in[2], QB, KB, VT, UB, GB};
          pg8::gemm_phase<pg8::EpiInProj, false, true, false>(F.lds, rtab, g, S, E); }
        if (grp == 1) conv_items(Fp, args, it_lo, it_hi);
        { pg8::Gemm g{XB, Win_t, 2 * D, nullptr, 0u}; pg8::StaticOrder S; S.init(T / 256, INW / 256, F.G, c); S.i0 = 1;
          pg8::EpiInProj E{args.in[2], QB, KB, VT, UB, GB};
          pg8::gemm_phase<pg8::EpiInProj, false, true, false>(F.lds, rtab, g, S, E); }
        if (grp == 2) conv_items(Fp, args, it_lo, it_hi);
        SEAM(1);
    }
    if (IN(2)) { OPAQUE_F(Fp); p2_mixers(Fp, args); SEAM(2); }
    if (IN(3)) {
        pg8::Gemm g{CAT, Wout_t, 2 * D, nullptr, 0u}; pg8::StaticOrder S; S.init(T / 256, D / 256, F.G, (int)blockIdx.x);
        pg8::EpiOutProj E{args.in[0], args.in[9], args.out};
        pg8::gemm_phase<pg8::EpiOutProj, false, false, false>(F.lds, rtab, g, S, E);
        SEAM(3);
    }
    if (IN(4)) { OPAQUE_F(Fp); p4_router(Fp, args, true); SEAM(4); }
    if (IN(5)) { OPAQUE_F(Fp); p5_dispatch(Fp, args); SEAM(5); }
    if (IN(6)) {
        const int nT = __builtin_amdgcn_readfirstlane(meta[MT_NT]);
        pg8::StaticOrder S; S.init(nT, 2 * DFF / 256, F.G, (int)blockIdx.x);
        { pg8::Unit u; LAS int* rt = (LAS int*)(F.lds + RTAB_OFF);
          for (int i = 0; i < RTAB_UNITS && S.next(i, u); ++i) if (F.tid < 256) rt[i * 256 + F.tid] = meta[MT_ROW_TOK + u.pm * 256 + F.tid];
          __syncthreads(); }
        pg8::Gemm g{HB, Wgu_t, D, meta + MT_TILE_E, 2048u * 1024u};
        pg8::EpiSwiglu E{meta + MT_TILE_E, args.in[15], args.in[17], (const float*)(ws + WS_SWGU), (const float*)meta + MT_ROW_SA, HID};
        pg8::gemm_phase<pg8::EpiSwiglu, true, true, true>(F.lds, rtab, g, S, E);
        SEAM(6);
    }
    if (IN(7)) { OPAQUE_F(Fp); p7_quant(Fp, args); SEAM(7); }
    if (IN(8)) {
        const int nT = __builtin_amdgcn_readfirstlane(meta[MT_NT]);
        pg8::StaticOrder S; S.init(nT, D / 256, F.G, (int)blockIdx.x);
        pg8::Gemm g{ws + WS_HID8, Wd_t, DFF, meta + MT_TILE_E, 1024u * 1024u};
        pg8::EpiDown E{meta + MT_TILE_E, args.in[19], (const float*)(ws + WS_SWD), (const float*)(ws + WS_ROWSB), (const float*)meta + MT_ROW_GATE, (unsigned char*)Y};
        pg8::gemm_phase<pg8::EpiDown, false, true, true>(F.lds, rtab, g, S, E);
        SEAM(8);
    }
    if (IN(9)) { OPAQUE_F(Fp); p8_final(Fp, args); }
#undef IN
#undef SEAM
}

extern "C" void kernel_launch(void* const* d_in, const int* in_sizes, int n_in, void* d_out, int out_size, void* d_ws, size_t ws_size, hipStream_t stream) {
    static int grid = 0;
    if (grid == 0) {
        if (n_in != 22 || in_sizes[0] != T * D || out_size != T * D || ws_size < WS_END) { fprintf(stderr, "kernel_launch: unexpected shapes (n_in %d, in0 %d, out %d, ws %zu, need %zu)\n", n_in, n_in > 0 ? in_sizes[0] : -1, out_size, ws_size, (size_t)WS_END); grid = -1; return; }
        int dev = 0, cus = 0;
        if (hipGetDevice(&dev) != hipSuccess || hipDeviceGetAttribute(&cus, hipDeviceAttributeMultiprocessorCount, dev) != hipSuccess) { grid = -1; return; }
        if (hipFuncSetAttribute((const void*)mk_fwd, hipFuncAttributeMaxDynamicSharedMemorySize, LDS_BYTES) != hipSuccess) { fprintf(stderr, "kernel_launch: hipFuncSetAttribute failed\n"); grid = -1; return; }
        int per_cu = 0;
        if (hipOccupancyMaxActiveBlocksPerMultiprocessor(&per_cu, (const void*)mk_fwd, NWAVES * 64, LDS_BYTES) != hipSuccess || per_cu < 1) fprintf(stderr, "kernel_launch: occupancy query reports %d\n", per_cu);
        (void)hipGetLastError();
        grid = cus;
    }
    if (grid < 0) return;
    unsigned char* ws = (unsigned char*)d_ws; float* out = (float*)d_out;
    (void)hipMemsetAsync(ws + WS_CTL, 0, 64 * 1024, stream);
    Args a{};
    for (int i = 0; i < 22; ++i) a.in[i] = (const float*)d_in[i];
    a.out = out; a.ws = ws;
    a.ph_lo = 0; a.ph_hi = NPHASES; a.li = 0;
    hipLaunchKernelGGL(mk_fwd, dim3(grid), dim3(NWAVES * 64), LDS_BYTES, stream, a);
}
```

```cpp
#include <hip/hip_runtime.h>
#include <cstdio>
#include <cstdint>

typedef unsigned short bf16;
typedef float f32x4 __attribute__((ext_vector_type(4)));
typedef unsigned u32x4 __attribute__((ext_vector_type(4)));
typedef unsigned u32x2 __attribute__((ext_vector_type(2)));

constexpr int BATCH = 2, SEQ = 8192, D = 1024, T = BATCH * SEQ;
constexpr int NQH = 8, NKVH = 2, HD = 64, QREP = 4, AW = 512, KVW = 128, GW = 512, INW = 1792;
constexpr int NEXP = 32, TOPK = 4, DFF = 1024;
constexpr int NT_MAX = T * TOPK / 256 + NEXP;
constexpr int NROWS_MAX = NT_MAX * 256;
constexpr float LN_EPS = 1e-5f;
constexpr float ALPHA = 1.189207115002721f;
constexpr float C2 = 0.125f * 1.4426950408889634f;
constexpr float LOG2E = 1.4426950408889634f;
constexpr float YSCALE = 16.0f;

constexpr size_t MiB = 1u << 20;
constexpr size_t WS_CTL = 0;
constexpr size_t WS_META = 1 * MiB;
constexpr size_t WS_XB = 3 * MiB;
constexpr size_t WS_QB = WS_XB + 32 * MiB;
constexpr size_t WS_KB = WS_QB + 16 * MiB;
constexpr size_t WS_VT = WS_KB + 4 * MiB;
constexpr size_t WS_UB = WS_VT + 4 * MiB;
constexpr size_t WS_GB = WS_UB + 16 * MiB;
constexpr size_t WS_CAT = WS_GB + 16 * MiB;
constexpr size_t WS_HB = WS_CAT + 32 * MiB;
constexpr size_t WS_H = WS_XB;
constexpr size_t WS_HID = WS_HB + 32 * MiB;
constexpr size_t WS_Y = WS_HID;
static_assert(WS_H + 64 * MiB <= WS_CAT, "H overlay");

constexpr int CW_CNT = 64;
constexpr int MT_NT = 0;
constexpr int MT_TSTART = 16;
constexpr int MT_TILE_E = 64;
constexpr int MT_SEL_E = 1024;
constexpr int MT_SEL_POS = MT_SEL_E + T * 4;
constexpr int MT_SEL_G = MT_SEL_POS + T * 4;
constexpr int MT_SLOT_ROW = MT_SEL_G + T * 4;
constexpr int MT_ROW_TOK = MT_SLOT_ROW + T * 4;
constexpr int MT_ROW_GATE = MT_ROW_TOK + NROWS_MAX;
constexpr int MT_ROW_SA = MT_ROW_GATE + NROWS_MAX;
constexpr int MT_SH = MT_ROW_SA + NROWS_MAX;
constexpr size_t WS_ELIST = WS_GB;
constexpr int TBL_CNT = 0, TBL_TS = 32, TBL_TILE = 72;
constexpr size_t WS_ROWSB = 512 * 1024;
static_assert((size_t)(MT_SH + T) * 4 <= 2 * MiB, "meta");

__device__ __forceinline__ float bf2f(bf16 v) { return __uint_as_float((unsigned)v << 16); }
__device__ __forceinline__ unsigned f2bf(float f) { unsigned u = __float_as_uint(f); return (u + 0x7fffu + ((u >> 16) & 1u)) >> 16; }
__device__ __forceinline__ unsigned pk2(float lo, float hi) { return f2bf(lo) | (f2bf(hi) << 16); }
__device__ __forceinline__ float gelu_tanh(float x) {
    const float k2 = 2.0f * 0.7978845608028654f;
    const float u = k2 * (x + 0.044715f * x * x * x);
    return x / (1.0f + __expf(-u));
}
__device__ __forceinline__ float wave_sum(float v) {
#pragma unroll
    for (int o = 1; o < 64; o <<= 1) v += __shfl_xor(v, o);
    return v;
}
__device__ __forceinline__ float wave_max(float v) {
#pragma unroll
    for (int o = 1; o < 64; o <<= 1) v = fmaxf(v, __shfl_xor(v, o));
    return v;
}

#define LAS __attribute__((address_space(3)))
#define GAS __attribute__((address_space(1)))
typedef short bf16x8 __attribute__((ext_vector_type(8)));
typedef float f32x16 __attribute__((ext_vector_type(16)));
typedef float f32x2 __attribute__((ext_vector_type(2)));
__device__ __forceinline__ unsigned cvt_pk_bf16(float lo, float hi) { unsigned r; asm volatile("v_cvt_pk_bf16_f32 %0, %1, %2" : "=v"(r) : "v"(lo), "v"(hi)); return r; }
__device__ __forceinline__ float fast_gelu(float x) {
    const float u = -2.0f * 0.7978845608028654f * LOG2E * (x + 0.044715f * x * x * x);
    return x * __builtin_amdgcn_rcpf(1.0f + __builtin_amdgcn_exp2f(u));
}
__device__ __forceinline__ void st16_wt(void* p, u32x4 v) {
    *(u32x4*)p = v;
}
namespace pg8 {
constexpr int BM = 256, BK = 64, HALF = 128, HTB = HALF * BK * 2  , STAGE_BYTES = 8 * HTB, NXCD = 8, WGM = 8;
__host__ __device__ __forceinline__ int lds_byte(int r, int c) { const int st = (r >> 4) * 2 + (c >> 5), rr = r & 15, cc = c & 31, ob = rr * 64 + cc * 2; return st * 1024 + (ob ^ (((ob >> 9) & 1) << 5)); }
__host__ __device__ __forceinline__ void stage_rc(int b, int& R, int& C) { const int st = b / 1024, sb = b % 1024, swz = sb ^ (((sb >> 9) & 1) << 5); R = (st >> 1) * 16 + swz / 64; C = (st & 1) * 32 + (swz % 64) / 2; }
__host__ __device__ __forceinline__ int perm32(int rho) { const int n = rho >> 4, i = rho & 15; return 8 * (i >> 2) + 4 * n + (i & 3); }

struct Unit { int pm, pn; };
struct Gemm { const void* A; const void* Bt; int KB; const LAS int* tile_e; unsigned e_stride; };
typedef int i32x4 __attribute__((ext_vector_type(4)));

struct StaticOrder {
    int nM, nN, nwg, G, c, i0 = 0, i1 = 1 << 30;
    __device__ void init(int nM_, int nN_, int G_, int c_) { nM = nM_; nN = nN_; nwg = nM * nN; G = G_; c = c_; }
    __device__ bool next(int i, Unit& u) const {
        i += i0; if (i >= i1) return false;
        const long L = (long)i * G + c; if (L >= nwg) return false;
        int wgid = (int)L; { const int q = nwg / NXCD, r = nwg % NXCD, xcd = wgid % NXCD, off = wgid / NXCD; wgid = (xcd < r ? xcd * (q + 1) : r * (q + 1) + (xcd - r) * q) + off; }
        const int nig = WGM * nN, gid = wgid / nig, fm = gid * WGM, gsz = (nM - fm) < WGM ? (nM - fm) : WGM;
        u.pm = fm + ((wgid % nig) % gsz); u.pn = (wgid % nig) / gsz; return true;
    }
};

template <class Epi, bool GATHER, bool ALIGN_EPI, bool I8>
__device__ __forceinline__ void gemm_phase(LAS unsigned char* lds, const LAS int* rtab, const Gemm g, const StaticOrder& S, const Epi& E) {
    int tid_ = threadIdx.x; asm volatile("" : "+v"(tid_));
    const int tid = tid_, wid = __builtin_amdgcn_readfirstlane(tid >> 6), lane = tid & 63, wr = wid >> 2, wc = wid & 3, fr = lane & 15, fq = lane >> 4;
    const int KB = g.KB, nt = KB / (BK * 2);
    int Rs[2], Cs[2]; unsigned voffB[2];
#pragma unroll
    for (int i = 0; i < 2; ++i) { int R, C; stage_rc(tid * 16 + i * 8192, R, C); const int Rb = Epi::PERM == 2 ? (64 * (R >> 5) + 16 * ((R >> 2) & 3) + 4 * ((R >> 4) & 1) + (R & 3)) : Epi::PERM ? ((R & ~31) + perm32(R & 31)) : R; Rs[i] = R; Cs[i] = C; voffB[i] = (unsigned)(Rb * KB + C * 2); }
    const size_t kstep = (size_t)(BK * 2);
    const size_t hstep = (size_t)HALF * KB;
    const size_t tstep = 2 * hstep;
    const size_t bhstep = Epi::PERM == 2 ? (size_t)8 * KB : hstep;
    const unsigned ldsw = (unsigned)wid * 1024u;
    const int aoff = lds_byte(wr * 64 + fr, fq * 8), boff = lds_byte(wc * 32 + fr, fq * 8);
#define PG8_SA(b, h) (((b) * 2 + (h)) * HTB)
#define PG8_SB(b, h) ((4 + (b) * 2 + (h)) * HTB)
#define PG8_STAGE(bufoff, gbase, voff) do { _Pragma("unroll") for (int _i = 0; _i < 2; ++_i) \
        __builtin_amdgcn_global_load_lds((const unsigned*)((const char*)(gbase) + (voff)[_i]), (LAS unsigned*)(lds + (bufoff) + ldsw + _i * 8192), 16, 0, 0); } while (0)
#define PG8_LDA(dst, b, h) do { _Pragma("unroll") for (int m = 0; m < 4; ++m) _Pragma("unroll") for (int k = 0; k < 2; ++k) dst[m][k] = *(const LAS bf16x8*)(lds + PG8_SA(b, h) + aoff + m * 2048 + k * 1024); } while (0)
#define PG8_LDB(dst, b, h) do { _Pragma("unroll") for (int n = 0; n < 2; ++n) _Pragma("unroll") for (int k = 0; k < 2; ++k) dst[n][k] = *(const LAS bf16x8*)(lds + PG8_SB(b, h) + boff + n * 2048 + k * 1024); } while (0)
#define PG8_MMA(ai, bj, At, Bt) do { __builtin_amdgcn_s_setprio(1); _Pragma("unroll") for (int m = 0; m < 4; ++m) _Pragma("unroll") for (int n = 0; n < 2; ++n) _Pragma("unroll") for (int k = 0; k < 2; ++k) \
        { if constexpr (I8) acc[ai][bj][m][n] = __builtin_bit_cast(f32x4, __builtin_amdgcn_mfma_i32_16x16x64_i8(__builtin_bit_cast(i32x4, Bt[n][k]), __builtin_bit_cast(i32x4, At[m][k]), __builtin_bit_cast(i32x4, acc[ai][bj][m][n]), 0, 0, 0)); \
          else acc[ai][bj][m][n] = __builtin_amdgcn_mfma_f32_16x16x32_bf16(Bt[n][k], At[m][k], acc[ai][bj][m][n], 0, 0, 0); } __builtin_amdgcn_s_setprio(0); } while (0)
#define PG8_WAIT_V(n) asm volatile("s_waitcnt vmcnt(" #n ")" ::: "memory")
#define PG8_WAIT_L(n) asm volatile("s_waitcnt lgkmcnt(" #n ")" ::: "memory")
#define PG8_BAR __builtin_amdgcn_s_barrier()
#define PG8_SCHED __builtin_amdgcn_sched_barrier(0)
#define PG8_VOFFA(vo, ui_, u_) do { _Pragma("unroll") for (int h_ = 0; h_ < 2; ++h_) _Pragma("unroll") for (int i_ = 0; i_ < 2; ++i_) { \
        const int row_ = GATHER ? rtab[(ui_) * 256 + h_ * 128 + Rs[i_]] : ((u_).pm * 256 + h_ * 128 + Rs[i_]); \
        vo[h_][i_] = (unsigned)(row_ * KB + Cs[i_] * 2); } } while (0)
#define PG8_BBASE(u_) ((const char*)g.Bt + (g.tile_e ? (size_t)g.tile_e[(u_).pm] * g.e_stride : (size_t)0) + (size_t)(u_).pn * tstep)
    Unit cur, nxt; int ui = 0;
    if (!S.next(0, cur)) return;
    f32x4 acc[2][2][4][2];
    if constexpr (Epi::HAS_INIT) E.init(acc, cur, wr, wc, fr, fq);
    else {
#pragma unroll
    for (int a = 0; a < 2; ++a)
#pragma unroll
        for (int b = 0; b < 2; ++b)
#pragma unroll
            for (int m = 0; m < 4; ++m)
#pragma unroll
                for (int n = 0; n < 2; ++n) acc[a][b][m][n] = (f32x4){0.f, 0.f, 0.f, 0.f};
    }
    bf16x8 At[4][2], B0[2][2], B1[2][2];
    unsigned vAc[2][2], vAn[2][2];
    PG8_VOFFA(vAc, 0, cur);
    const char* const gA = (const char*)g.A;
    const char* cB = PG8_BBASE(cur);
    PG8_STAGE(PG8_SB(0, 0), cB, voffB); PG8_STAGE(PG8_SB(0, 1), cB + bhstep, voffB); PG8_STAGE(PG8_SA(0, 0), gA, vAc[0]); PG8_STAGE(PG8_SA(0, 1), gA, vAc[1]);
    if (wr == 1) PG8_BAR;
    PG8_WAIT_V(2); PG8_BAR;
    PG8_STAGE(PG8_SB(1, 0), cB + kstep, voffB); PG8_STAGE(PG8_SA(1, 0), gA + kstep, vAc[0]); PG8_STAGE(PG8_SB(1, 1), cB + bhstep + kstep, voffB);
    PG8_WAIT_V(6); PG8_BAR;
    for (;;) {
        const bool has_next = S.next(ui + 1, nxt);
        const char* nB = cB;
        if (has_next) { nB = PG8_BBASE(nxt); PG8_VOFFA(vAn, ui + 1, nxt); }
        else {
#pragma unroll
            for (int h = 0; h < 2; ++h)
#pragma unroll
                for (int i = 0; i < 2; ++i) vAn[h][i] = vAc[h][i];
        }
        for (int t = 0; t < nt; t += 2) {
            const bool last = (t == nt - 2);
            const char* a1 = gA + (size_t)(t + 1) * kstep;
            const char* a2 = last ? gA : gA + (size_t)(t + 2) * kstep; const char* b2 = last ? nB : cB + (size_t)(t + 2) * kstep;
            const char* a3 = a2 + kstep; const char* b3 = b2 + kstep;
            unsigned v2[2][2];
#pragma unroll
            for (int h = 0; h < 2; ++h)
#pragma unroll
                for (int i = 0; i < 2; ++i) v2[h][i] = last ? vAn[h][i] : vAc[h][i];
            PG8_LDB(B0, 0, 0); PG8_LDB(B1, 0, 1); PG8_SCHED; PG8_LDA(At, 0, 0); PG8_STAGE(PG8_SA(1, 1), a1, vAc[1]);
            PG8_WAIT_V(8); PG8_WAIT_L(0); PG8_BAR; PG8_MMA(0, 0, At, B0); PG8_MMA(0, 1, At, B1); PG8_BAR; PG8_SCHED;
            PG8_LDA(At, 0, 1); PG8_STAGE(PG8_SB(0, 0), b2, voffB); PG8_STAGE(PG8_SB(0, 1), b2 + bhstep, voffB); PG8_STAGE(PG8_SA(0, 0), a2, v2[0]);
            PG8_WAIT_V(8); PG8_WAIT_L(0); PG8_BAR; PG8_MMA(1, 0, At, B0); PG8_MMA(1, 1, At, B1); PG8_BAR; PG8_SCHED;
            PG8_LDB(B0, 1, 0); PG8_LDB(B1, 1, 1); PG8_SCHED; PG8_LDA(At, 1, 0); PG8_STAGE(PG8_SA(0, 1), a2, v2[1]);
            PG8_WAIT_V(8); PG8_WAIT_L(0); PG8_BAR; PG8_MMA(0, 0, At, B0); PG8_MMA(0, 1, At, B1); PG8_BAR; PG8_SCHED;
            PG8_LDA(At, 1, 1); PG8_STAGE(PG8_SB(1, 0), b3, voffB); PG8_STAGE(PG8_SB(1, 1), b3 + bhstep, voffB); PG8_STAGE(PG8_SA(1, 0), a3, v2[0]);
            PG8_WAIT_V(8); PG8_WAIT_L(0); PG8_BAR; PG8_MMA(1, 0, At, B0); PG8_MMA(1, 1, At, B1); PG8_BAR; PG8_SCHED;
        }
        if constexpr (ALIGN_EPI) { if (wr == 0) PG8_BAR; }
        E(acc, cur, wr, wc, fr, fq);
        if (!has_next) break;
        if constexpr (Epi::HAS_INIT) E.init(acc, nxt, wr, wc, fr, fq);
        else {
#pragma unroll
        for (int a = 0; a < 2; ++a)
#pragma unroll
            for (int b = 0; b < 2; ++b)
#pragma unroll
                for (int m = 0; m < 4; ++m)
#pragma unroll
                    for (int n = 0; n < 2; ++n) acc[a][b][m][n] = (f32x4){0.f, 0.f, 0.f, 0.f};
        }
        cur = nxt; cB = nB; ++ui;
#pragma unroll
        for (int h = 0; h < 2; ++h)
#pragma unroll
            for (int i = 0; i < 2; ++i) vAc[h][i] = vAn[h][i];
        if constexpr (ALIGN_EPI) { if (wr == 1) PG8_BAR; }
    }
    PG8_WAIT_V(0);
    if constexpr (!ALIGN_EPI) { if (wr == 0) PG8_BAR; }
    PG8_BAR;
#undef PG8_SA
#undef PG8_SB
#undef PG8_STAGE
#undef PG8_LDA
#undef PG8_LDB
#undef PG8_MMA
#undef PG8_WAIT_V
#undef PG8_WAIT_L
#undef PG8_BAR
#undef PG8_SCHED
#undef PG8_VOFFA
#undef PG8_BBASE
}

struct EpiInProj {
    static constexpr int PERM = 1; static constexpr bool HAS_INIT = false;
    const float* b_in; bf16 *QB, *KB, *VT, *UB, *GB;
    __device__ __forceinline__ void operator()(const f32x4 (&acc)[2][2][4][2], const Unit& u, int wr, int wc, int fr, int fq) const {
        const int row0 = u.pm * BM + wr * 64 + fr;
#pragma unroll
        for (int bj = 0; bj < 2; ++bj) {
            const int reg = u.pn * BM + bj * HALF;
            const int c0 = reg + wc * 32 + 8 * fq;
            const f32x4 bv0 = *(const f32x4*)(b_in + c0), bv1 = *(const f32x4*)(b_in + c0 + 4);
#pragma unroll
            for (int ai = 0; ai < 2; ++ai)
#pragma unroll
                for (int m = 0; m < 4; ++m) {
                    const int row = row0 + ai * HALF + m * 16;
                    f32x4 v0 = acc[ai][bj][m][0] + bv0, v1 = acc[ai][bj][m][1] + bv1;
                    if (reg >= 640 && reg < 768) {
                        const int cv = c0 - 640, gg = cv >> 6, d = cv & 63, b = row / SEQ, s = row % SEQ;
                        bf16* vp = VT + ((size_t)((b * 2 + gg) * 64 + d)) * SEQ + s;
#pragma unroll
                        for (int j = 0; j < 4; ++j) { vp[(size_t)j * SEQ] = (bf16)f2bf(v0[j]); vp[(size_t)(j + 4) * SEQ] = (bf16)f2bf(v1[j]); }
                    } else {
                        bf16* dst;
                        if (reg < 512) { v0 = v0 * C2; v1 = v1 * C2; dst = QB + (size_t)row * 512 + c0; }
                        else if (reg < 640) { dst = KB + (size_t)row * 128 + (c0 - 512); }
                        else {
#pragma unroll
                            for (int j = 0; j < 4; ++j) { v0[j] = fast_gelu(v0[j]); v1[j] = fast_gelu(v1[j]); }
                            dst = (reg < 1280) ? (UB + (size_t)row * 512 + (c0 - 768)) : (GB + (size_t)row * 512 + (c0 - 1280));
                        }
                        u32x4 w; w.x = cvt_pk_bf16(v0[0], v0[1]); w.y = cvt_pk_bf16(v0[2], v0[3]); w.z = cvt_pk_bf16(v1[0], v1[1]); w.w = cvt_pk_bf16(v1[2], v1[3]);
                        *(u32x4*)dst = w;
                    }
                }
        }
    }
};
struct EpiOutProj {
    static constexpr int PERM = 0; static constexpr bool HAS_INIT = true;
    const float* x; const float* b_out; float* Z;
    __device__ __forceinline__ void init(f32x4 (&acc)[2][2][4][2], const Unit& u, int wr, int wc, int fr, int fq) const {
        const int col0 = u.pn * BM + wc * 32 + 4 * fq;
#pragma unroll
        for (int ai = 0; ai < 2; ++ai)
#pragma unroll
            for (int m = 0; m < 4; ++m) {
                const size_t off = (size_t)(u.pm * BM + ai * HALF + wr * 64 + m * 16 + fr) * D + col0;
#pragma unroll
                for (int bj = 0; bj < 2; ++bj)
#pragma unroll
                    for (int n = 0; n < 2; ++n) acc[ai][bj][m][n] = *(const f32x4*)(x + off + bj * HALF + n * 16) * ALPHA + *(const f32x4*)(b_out + col0 + bj * HALF + n * 16);
            }
    }
    __device__ __forceinline__ void operator()(const f32x4 (&acc)[2][2][4][2], const Unit& u, int wr, int wc, int fr, int fq) const {
        const int col0 = u.pn * BM + wc * 32 + 4 * fq;
#pragma unroll
        for (int ai = 0; ai < 2; ++ai)
#pragma unroll
            for (int m = 0; m < 4; ++m) {
                const size_t off = (size_t)(u.pm * BM + ai * HALF + wr * 64 + m * 16 + fr) * D + col0;
#pragma unroll
                for (int bj = 0; bj < 2; ++bj)
#pragma unroll
                    for (int n = 0; n < 2; ++n) *(f32x4*)(Z + off + bj * HALF + n * 16) = acc[ai][bj][m][n];
            }
    }
};
struct EpiSwiglu {
    static constexpr int PERM = 1; static constexpr bool HAS_INIT = false;
    const LAS int* tbl; const float* b_gate; const float* b_up; const float* swgu; const float* el_sa; bf16* HID;
    __device__ __forceinline__ void operator()(const f32x4 (&acc)[2][2][4][2], const Unit& u, int wr, int wc, int fr, int fq) const {
        const int e = tbl[TBL_TILE + u.pm], p0 = (u.pm - tbl[TBL_TS + e]) * BM, ce = tbl[TBL_CNT + e];
        const int fc0 = u.pn * HALF + wc * 32 + 8 * fq;
        const float* sw = swgu + e * 2048 + u.pn * 256 + wc * 32 + 8 * fq;
        float sa[2][4];
#pragma unroll
        for (int ai = 0; ai < 2; ++ai)
#pragma unroll
            for (int m = 0; m < 4; ++m) { const int ix = p0 + ai * HALF + wr * 64 + m * 16 + fr; sa[ai][m] = ix < ce ? el_sa[e * T + ix] : 0.f; }
        f32x4 gb[2], ub[2], sg[2], su[2];
#pragma unroll
        for (int n = 0; n < 2; ++n) { gb[n] = *(const f32x4*)(b_gate + e * DFF + fc0 + 4 * n); ub[n] = *(const f32x4*)(b_up + e * DFF + fc0 + 4 * n); sg[n] = *(const f32x4*)(sw + 4 * n); su[n] = *(const f32x4*)(sw + 128 + 4 * n); }
#pragma unroll
        for (int ai = 0; ai < 2; ++ai)
#pragma unroll
            for (int m = 0; m < 4; ++m) {
                const int row = u.pm * BM + ai * HALF + wr * 64 + m * 16 + fr;
                float hv[8];
#pragma unroll
                for (int n = 0; n < 2; ++n)
#pragma unroll
                    for (int j = 0; j < 4; ++j) {
                        const float ga = (float)__float_as_int(acc[ai][0][m][n][j]) * (sa[ai][m] * sg[n][j]) + gb[n][j];
                        const float ua = (float)__float_as_int(acc[ai][1][m][n][j]) * (sa[ai][m] * su[n][j]) + ub[n][j];
                        const float gt = fminf(ga, 7.0f), up = __builtin_amdgcn_fmed3f(ua, -7.0f, 7.0f);
                        hv[4 * n + j] = gt * __builtin_amdgcn_rcpf(1.0f + __builtin_amdgcn_exp2f(-1.702f * LOG2E * gt)) * (up + 1.0f);
                    }
                u32x4 w; w.x = cvt_pk_bf16(hv[0], hv[1]); w.y = cvt_pk_bf16(hv[2], hv[3]); w.z = cvt_pk_bf16(hv[4], hv[5]); w.w = cvt_pk_bf16(hv[6], hv[7]);
                *(u32x4*)(HID + (size_t)row * DFF + fc0) = w;
            }
    }
};
struct EpiDown {
    static constexpr int PERM = 2; static constexpr bool HAS_INIT = false;
    const LAS int* tbl; const float* b_down; const float* swd; const float* row_sb; const float* el_gate; unsigned char* Y;
    __device__ __forceinline__ void operator()(const f32x4 (&acc)[2][2][4][2], const Unit& u, int wr, int wc, int fr, int fq) const {
        const int e = tbl[TBL_TILE + u.pm], p0 = (u.pm - tbl[TBL_TS + e]) * BM, ce = tbl[TBL_CNT + e];
        const int c0 = u.pn * BM + wc * 64 + 16 * fq;
        f32x4 bv[2][2], sw[2][2];
#pragma unroll
        for (int bj = 0; bj < 2; ++bj)
#pragma unroll
            for (int n = 0; n < 2; ++n) { bv[bj][n] = *(const f32x4*)(b_down + e * D + c0 + 8 * bj + 4 * n); sw[bj][n] = *(const f32x4*)(swd + e * D + c0 + 8 * bj + 4 * n); }
#pragma unroll
        for (int ai = 0; ai < 2; ++ai)
#pragma unroll
            for (int m = 0; m < 4; ++m) {
                const int row = u.pm * BM + ai * HALF + wr * 64 + m * 16 + fr;
                const int ix = p0 + ai * HALF + wr * 64 + m * 16 + fr;
                const float gt = (ix < ce ? el_gate[e * T + ix] : 0.f) * YSCALE, sb = row_sb[row] * gt;
                u32x4 w;
#pragma unroll
                for (int bj = 0; bj < 2; ++bj)
#pragma unroll
                    for (int n = 0; n < 2; ++n) {
                        float v[4];
#pragma unroll
                        for (int j = 0; j < 4; ++j) v[j] = __builtin_amdgcn_fmed3f((float)__float_as_int(acc[ai][bj][m][n][j]) * (sb * sw[bj][n][j]) + bv[bj][n][j] * gt, -448.0f, 448.0f);
                        int d = 0;
                        d = __builtin_amdgcn_cvt_pk_fp8_f32(v[0], v[1], d, false);
                        d = __builtin_amdgcn_cvt_pk_fp8_f32(v[2], v[3], d, true);
                        w[2 * bj + n] = (unsigned)d;
                    }
                *(u32x4*)(Y + (size_t)row * D + c0) = w;
            }
    }
};
}
constexpr int NWAVES = 8;
constexpr int NPHASES = 10;
constexpr size_t WS_WIN = WS_HID + 144 * MiB;
constexpr size_t WS_WOUT = WS_WIN + 4 * MiB;
constexpr size_t WS_WGU = WS_WOUT + 2 * MiB;
constexpr size_t WS_SWGU = WS_WGU + 64 * MiB;
constexpr size_t WS_WD = WS_SWGU + 1 * MiB;
constexpr size_t WS_SWD = WS_WD + 32 * MiB;
constexpr size_t WS_HID8 = WS_SWD + 1 * MiB;
constexpr size_t WS_END = WS_HID8 + 72 * MiB;
constexpr int CW_BAR = 4096;
constexpr int RING_BYTES = 131072;
constexpr int RTAB_OFF = RING_BYTES;
constexpr int RTAB_UNITS = 12;
constexpr int RW_BYTES = 1024 * 144;
constexpr int RSCR_OFF = RW_BYTES;
constexpr int LDS_BYTES = 163840;
constexpr int MISC_OFF = LDS_BYTES - 256;
static_assert(RTAB_OFF + RTAB_UNITS * 1024 <= MISC_OFF && RSCR_OFF + 4096 <= MISC_OFF, "LDS map");

typedef GAS unsigned gu32;
#define RLX_AGENT __ATOMIC_RELAXED, __HIP_MEMORY_SCOPE_AGENT
#define LDS_WAIT() asm volatile("s_waitcnt lgkmcnt(0)" ::: "memory")
#define VM_WAIT() asm volatile("s_waitcnt vmcnt(0)" ::: "memory")

#define XB_TMO      128
#define XB_XCNT(j)  (256  + 64 * (j))
#define XB_XSUB(j)  (1280 + 64 * (j))
#define XB_XGEN(j)  (2304 + 64 * (j))
#define XB_TOP      3328
#define XB_TOPGEN   3392
#define XCD_BAR_WORDS 3456
#define XB_SPIN_CAP (1u << 18)
__device__ __forceinline__ unsigned xb_ld(unsigned* p)              { return __hip_atomic_load(p, __ATOMIC_RELAXED, __HIP_MEMORY_SCOPE_AGENT); }
__device__ __forceinline__ unsigned xb_add(unsigned* p, unsigned v) { return __hip_atomic_fetch_add(p, v, __ATOMIC_RELAXED, __HIP_MEMORY_SCOPE_AGENT); }
__device__ __forceinline__ unsigned xb_xcc_id() { return (unsigned)__builtin_amdgcn_s_getreg((3 << 11) | 20) & 0xFu; }
#define XB_SPIN(cond, bar) do { unsigned _sp = 0; while (cond) { __builtin_amdgcn_s_sleep(1); \
    if ((++_sp & 255u) == 0u) { if (xb_ld(&(bar)[XB_TMO])) break; if (_sp > XB_SPIN_CAP) { atomicAdd(&(bar)[XB_TMO], 1u); break; } } } } while (0)
struct XcdBarrier { unsigned* bar; unsigned x; volatile LAS unsigned* st; };
__device__ __forceinline__ XcdBarrier xcd_barrier_post(unsigned* bar, volatile LAS unsigned* st) {
    XcdBarrier b; b.bar = bar; b.x = xb_xcc_id(); b.st = st;
    if (threadIdx.x == 0) (void)xb_add(&bar[XB_XCNT(b.x)], 1u);
    return b;
}
__device__ __forceinline__ void xcd_barrier_complete(unsigned* bar, unsigned x, unsigned& nloc, unsigned& nx) {
    const unsigned G = gridDim.x * gridDim.y * gridDim.z;
    unsigned sum, cnt, mine, sp = 0u;
    for (;;) {
        sum = 0u; cnt = 0u; mine = 0u;
#pragma unroll
        for (unsigned j = 0; j < 16; ++j) { const unsigned c = xb_ld(&bar[XB_XCNT(j)]); sum += c; cnt += (c > 0u) ? 1u : 0u; mine = (j == x) ? c : mine; }
        if (sum == G) break;
        __builtin_amdgcn_s_sleep(1);
        if ((++sp & 255u) == 0u) { if (xb_ld(&bar[XB_TMO])) break; if (sp > XB_SPIN_CAP) { atomicAdd(&bar[XB_TMO], 1u); break; } }
    }
    nloc = mine > 0u ? mine : 1u; nx = cnt > 0u ? cnt : 1u;
}
__device__ __forceinline__ void xcd_barrier(const XcdBarrier& b) {
    asm volatile("s_waitcnt vmcnt(0)" ::: "memory");
    __syncthreads();
    if (threadIdx.x == 0) {
        unsigned* bar = b.bar;
        __builtin_amdgcn_s_waitcnt(0);
        unsigned nloc = b.st[0], nx = b.st[1];
        if (nloc == 0u) { xcd_barrier_complete(bar, b.x, nloc, nx); b.st[0] = nloc; b.st[1] = nx; }
        const unsigned old = xb_add(&bar[XB_XSUB(b.x)], 1u);
        const unsigned gen = old / nloc;
        if (old + 1u == (gen + 1u) * nloc) {
            __builtin_amdgcn_fence(__ATOMIC_RELEASE, "agent");
            asm volatile("s_waitcnt vmcnt(0)" ::: "memory");
            const unsigned og = xb_add(&bar[XB_TOP], 1u);
            const unsigned tg = og / nx;
            if (og + 1u == (tg + 1u) * nx) xb_add(&bar[XB_TOPGEN], 1u);
            else XB_SPIN(xb_ld(&bar[XB_TOPGEN]) == tg, bar);
            __builtin_amdgcn_fence(__ATOMIC_ACQUIRE, "agent");
            xb_add(&bar[XB_XGEN(b.x)], 1u);
            asm volatile("s_waitcnt vmcnt(0)" ::: "memory");
        } else {
            XB_SPIN(xb_ld(&bar[XB_XGEN(b.x)]) == gen, bar);
            __builtin_amdgcn_fence(__ATOMIC_ACQUIRE, "agent");
            asm volatile("s_waitcnt vmcnt(0)" ::: "memory");
        }
    }
    __syncthreads();
}

struct Args {
    const float* in[22]; float* out; unsigned char* ws; int ph_lo, ph_hi, li, pad;
};
struct Frame {
    LAS unsigned char* lds;
    int tid, lane, wave, vcu, G;
};
__device__ __forceinline__ void p0_item(const float* W, int N, bf16* WT, int K, int dst_row0, int k0, int n0, LAS float* scr, int lane) {
    f32x4 v[8];
#pragma unroll
    for (int i = 0; i < 8; ++i) v[i] = *(const f32x4*)(W + (size_t)(k0 + (lane >> 3) + 8 * i) * N + n0 + 4 * (lane & 7));
#pragma unroll
    for (int i = 0; i < 8; ++i) { LAS float* s = scr + ((lane >> 3) + 8 * i) * 33 + 4 * (lane & 7); s[0] = v[i].x; s[1] = v[i].y; s[2] = v[i].z; s[3] = v[i].w; }
    LDS_WAIT(); asm volatile("" ::: "memory");
    const int c = lane & 7;
#pragma unroll
    for (int j = 0; j < 4; ++j) { const int n = (lane >> 3) + 8 * j; const LAS float* s = scr + (8 * c) * 33 + n;
        u32x4 o; o.x = pk2(s[0 * 33], s[1 * 33]); o.y = pk2(s[2 * 33], s[3 * 33]); o.z = pk2(s[4 * 33], s[5 * 33]); o.w = pk2(s[6 * 33], s[7 * 33]);
        *(u32x4*)(WT + (size_t)(dst_row0 + n) * K + k0 + 8 * c) = o; }
    LDS_WAIT(); asm volatile("" ::: "memory");
}
struct ConvItem { const float* W; signed char* dst; float* sc; int n0, dst_row0; };
__device__ __forceinline__ ConvItem conv_decode(const Args& a, int it) {
    unsigned char* ws = a.ws;
    const int nb = it & 31, e = (it >> 5) & 31, kind = it >> 10, n0 = nb * 32;
    ConvItem c;
    c.W = (kind == 0 ? a.in[14] : kind == 1 ? a.in[16] : a.in[18]) + (size_t)e * D * DFF;
    c.dst = kind < 2 ? (signed char*)(ws + WS_WGU) + (size_t)e * 2048 * 1024 : (signed char*)(ws + WS_WD) + (size_t)e * 1024 * 1024;
    c.dst_row0 = kind < 2 ? (n0 >> 7) * 256 + kind * 128 + (n0 & 127) : n0;
    c.sc = kind < 2 ? (float*)(ws + WS_SWGU) + e * 2048 : (float*)(ws + WS_SWD) + e * 1024;
    c.n0 = n0; return c;
}
#define CONV_LOAD(v, ci) do { _Pragma("unroll") for (int i_ = 0; i_ < 4; ++i_) _Pragma("unroll") for (int j_ = 0; j_ < 4; ++j_) \
        v[i_][j_] = *(const f32x4*)((ci).W + (size_t)(4 * (kl + 64 * i_) + j_) * DFF + (ci).n0 + 4 * n4); } while (0)
__device__ __forceinline__ void conv_items(const Frame& F, const Args& a, int it_lo, int it_hi) {
    if (it_hi > 3 * NEXP * 32) it_hi = 3 * NEXP * 32;
    if (it_lo >= it_hi) return;
    const int tid = F.tid, n4 = tid & 7, kl = tid >> 3;
    LAS unsigned* tile = (LAS unsigned*)F.lds;
    LAS float* red = (LAS float*)(F.lds + 36864);
    f32x4 v[4][4];
    ConvItem cur = conv_decode(a, it_lo);
    CONV_LOAD(v, cur);
    for (int it = it_lo; it < it_hi; ++it) {
        f32x4 am = (f32x4){0.f, 0.f, 0.f, 0.f};
#pragma unroll
        for (int i = 0; i < 4; ++i)
#pragma unroll
            for (int j = 0; j < 4; ++j) { am.x = fmaxf(am.x, fabsf(v[i][j].x)); am.y = fmaxf(am.y, fabsf(v[i][j].y)); am.z = fmaxf(am.z, fabsf(v[i][j].z)); am.w = fmaxf(am.w, fabsf(v[i][j].w)); }
#pragma unroll
        for (int o = 8; o < 64; o <<= 1) { am.x = fmaxf(am.x, __shfl_xor(am.x, o)); am.y = fmaxf(am.y, __shfl_xor(am.y, o)); am.z = fmaxf(am.z, __shfl_xor(am.z, o)); am.w = fmaxf(am.w, __shfl_xor(am.w, o)); }
        if (F.lane < 8) *(LAS f32x4*)(red + F.wave * 32 + 4 * n4) = am;
        __syncthreads();
        f32x4 cm = *(const LAS f32x4*)(red + 4 * n4);
#pragma unroll
        for (int w = 1; w < 8; ++w) { const f32x4 o = *(const LAS f32x4*)(red + w * 32 + 4 * n4); cm.x = fmaxf(cm.x, o.x); cm.y = fmaxf(cm.y, o.y); cm.z = fmaxf(cm.z, o.z); cm.w = fmaxf(cm.w, o.w); }
        f32x4 inv;
#pragma unroll
        for (int c = 0; c < 4; ++c) inv[c] = cm[c] > 0.f ? 127.0f / cm[c] : 0.f;
        if (kl == 0) {
#pragma unroll
            for (int c = 0; c < 4; ++c) cur.sc[cur.dst_row0 + 4 * n4 + c] = cm[c] * (1.0f / 127.0f);
        }
#pragma unroll
        for (int i = 0; i < 4; ++i)
#pragma unroll
            for (int c = 0; c < 4; ++c) {
                unsigned d = 0u;
#pragma unroll
                for (int j = 0; j < 4; ++j) { const int q = (int)rintf(v[i][j][c] * inv[c]); d |= ((unsigned)q & 0xffu) << (8 * j); }
                tile[(4 * n4 + c) * 260 + kl + 64 * i] = d;
            }
        const ConvItem done = cur;
        if (it + 1 < it_hi) { cur = conv_decode(a, it + 1); CONV_LOAD(v, cur); }
        __syncthreads();
#pragma unroll
        for (int j = 0; j < 4; ++j) { const int ch = tid + 512 * j, n = ch >> 6, c16 = ch & 63;
            *(u32x4*)(done.dst + (size_t)(done.dst_row0 + n) * 1024 + 16 * c16) = *(const LAS u32x4*)(tile + n * 260 + 4 * c16); }
        __syncthreads();
    }
}
__device__ __forceinline__ void p0_prologue(const Frame& F, const Args& a) {
    unsigned char* ws = a.ws;
    bf16* Win_t = (bf16*)(ws + WS_WIN); bf16* Wout_t = (bf16*)(ws + WS_WOUT);
    LAS float* scr = (LAS float*)(F.lds + F.wave * 8448);
    const int gw = F.vcu * NWAVES + F.wave, NGW = F.G * NWAVES;
    constexpr int I_IN = 16 * 56, I_OUT = 16 * 32, NITEMS = I_IN + I_OUT;
    for (int it = gw; it < NITEMS; it += NGW) {
        int r = it;
        if (r < I_IN) { const int kb = r / 56, nb = r % 56; p0_item(a.in[1], INW, Win_t, D, nb * 32, kb * 64, nb * 32, scr, F.lane); continue; } r -= I_IN;
        { const int kb = r / 32, nb = r % 32; p0_item(a.in[8], D, Wout_t, D, nb * 32, kb * 64, nb * 32, scr, F.lane); }
    }
    const float* x = a.in[0]; bf16* XB = (bf16*)(ws + WS_XB);
    for (int m = gw; m < T; m += NGW) {
        const f32x4* xr = (const f32x4*)(x + (size_t)m * D) + F.lane; u32x2* o = (u32x2*)(XB + (size_t)m * D) + F.lane;
        f32x4 v[4];
#pragma unroll
        for (int j = 0; j < 4; ++j) v[j] = xr[64 * j];
#pragma unroll
        for (int j = 0; j < 4; ++j) { u32x2 w; w.x = pk2(v[j].x, v[j].y); w.y = pk2(v[j].z, v[j].w); o[64 * j] = w; }
    }
}

__device__ __forceinline__ int crow(int r, int hi) { return (r & 3) + 8 * (r >> 2) + 4 * hi; }
constexpr int AT_KROW = 144, AT_KG = 192 * AT_KROW, AT_VROW = 400, AT_VG = 64 * AT_VROW, AT_VOFF = 2 * AT_KG;
__device__ __forceinline__ void attn_wave_unit(const LAS unsigned char* lds, const bf16x8 (&qf)[4], const float sk, bf16* CAT, int tok0, int u, int h, int lane) {
    const int r32 = lane & 31, hi = lane >> 5;
    const int t0 = tok0 % SEQ, g = h >> 2;
    const int kk0 = 32 * u;
    f32x16 p[5];
    const float NEG = -INFINITY;
    const LAS unsigned char* kl = lds + g * AT_KG + (kk0 + r32) * AT_KROW + hi * 16;
#pragma unroll
    for (int j = 0; j < 5; ++j) {
        const int kb = t0 - 128 + 32 * j;
        f32x16 s;
#pragma unroll
        for (int r = 0; r < 16; ++r) s[r] = 0.f;
        if (kb >= 0) {
#pragma unroll
            for (int d0 = 0; d0 < 4; ++d0) { const bf16x8 kf = *(const LAS bf16x8*)(kl + j * 32 * AT_KROW + d0 * 32); s = __builtin_amdgcn_mfma_f32_32x32x16_bf16(kf, qf[d0], s, 0, 0, 0); }
            if (j == 0) {
#pragma unroll
                for (int r = 0; r < 16; ++r) if (!(crow(r, hi) > r32)) s[r] = NEG;
            }
            if (j == 4) {
#pragma unroll
                for (int r = 0; r < 16; ++r) if (!(crow(r, hi) <= r32)) s[r] = NEG;
            }
        } else {
#pragma unroll
            for (int r = 0; r < 16; ++r) s[r] = NEG;
        }
        p[j] = s;
    }
    float m = sk;
#pragma unroll
    for (int j = 0; j < 5; ++j)
#pragma unroll
        for (int r = 0; r < 16; ++r) m = fmaxf(m, p[j][r]);
    m = fmaxf(m, __shfl_xor(m, 32));
    float l = 0.f;
#pragma unroll
    for (int j = 0; j < 5; ++j)
#pragma unroll
        for (int r = 0; r < 16; ++r) { const float e = __builtin_amdgcn_exp2f(p[j][r] - m); p[j][r] = e; l += e; }
    l += __shfl_xor(l, 32);
    l += __builtin_amdgcn_exp2f(sk - m);
    const float inv = 1.0f / l;
    u32x4 pb[5][2];
#pragma unroll
    for (int j = 0; j < 5; ++j)
#pragma unroll
        for (int s = 0; s < 2; ++s) { pb[j][s].x = cvt_pk_bf16(p[j][8 * s + 0], p[j][8 * s + 1]); pb[j][s].y = cvt_pk_bf16(p[j][8 * s + 2], p[j][8 * s + 3]); pb[j][s].z = cvt_pk_bf16(p[j][8 * s + 4], p[j][8 * s + 5]); pb[j][s].w = cvt_pk_bf16(p[j][8 * s + 6], p[j][8 * s + 7]); }
#pragma unroll
    for (int db = 0; db < 2; ++db) {
        f32x16 o;
#pragma unroll
        for (int r = 0; r < 16; ++r) o[r] = 0.f;
        const LAS unsigned char* vl = lds + AT_VOFF + g * AT_VG + (db * 32 + r32) * AT_VROW + (kk0 + 4 * hi) * 2;
#pragma unroll
        for (int j = 0; j < 5; ++j) {
            const int kb = t0 - 128 + 32 * j;
            if (kb >= 0) {
#pragma unroll
                for (int s = 0; s < 2; ++s) {
                    const u32x2 lo = *(const LAS u32x2*)(vl + (32 * j + 16 * s) * 2), hh = *(const LAS u32x2*)(vl + (32 * j + 16 * s + 8) * 2);
                    u32x4 av; av.x = lo.x; av.y = lo.y; av.z = hh.x; av.w = hh.y;
                    o = __builtin_amdgcn_mfma_f32_32x32x16_bf16(__builtin_bit_cast(bf16x8, av), __builtin_bit_cast(bf16x8, pb[j][s]), o, 0, 0, 0);
                }
            }
        }
        bf16* op = CAT + (size_t)(tok0 + r32) * 1024 + h * 64 + db * 32 + 4 * hi;
#pragma unroll
        for (int gq = 0; gq < 4; ++gq) { u32x2 w; w.x = cvt_pk_bf16(o[4 * gq] * inv, o[4 * gq + 1] * inv); w.y = cvt_pk_bf16(o[4 * gq + 2] * inv, o[4 * gq + 3] * inv); *(u32x2*)(op + 8 * gq) = w; }
    }
}
__device__ __forceinline__ void attn_block(const Frame& F, const bf16* QB, const bf16* KB, const bf16* VT, const float* sinks, bf16* CAT, int qq) {
    const int tokb = qq * 64, b = tokb / SEQ, tb = tokb % SEQ, kbase = tb - 128;
    u32x4 kv[6], vv[6];
    bf16x8 qf0[4], qf1[4];
    { const int r32 = F.lane & 31, hi = F.lane >> 5;
#pragma unroll
      for (int d0 = 0; d0 < 4; ++d0) { qf0[d0] = *(const bf16x8*)(QB + (size_t)(tokb + r32) * 512 + F.wave * 64 + d0 * 16 + hi * 8); qf1[d0] = *(const bf16x8*)(QB + (size_t)(tokb + 32 + r32) * 512 + F.wave * 64 + d0 * 16 + hi * 8); } }
    const float sk = sinks[F.wave] * LOG2E;
#pragma unroll
    for (int i = 0; i < 6; ++i) {
        const int c = F.tid + 512 * i, g = c / 1536, rem = c % 1536;
        { const int key = rem >> 3, ch = rem & 7, pos = kbase + key;
          kv[i] = pos >= 0 ? *(const u32x4*)(KB + (size_t)(b * SEQ + pos) * 128 + g * 64 + ch * 8) : (u32x4){0u, 0u, 0u, 0u}; }
        { const int d = rem / 24, ch = rem % 24, pos = kbase + ch * 8;
          vv[i] = pos >= 0 ? *(const u32x4*)(VT + ((size_t)((b * 2 + g) * 64 + d)) * SEQ + pos) : (u32x4){0u, 0u, 0u, 0u}; }
    }
#pragma unroll
    for (int i = 0; i < 6; ++i) {
        const int c = F.tid + 512 * i, g = c / 1536, rem = c % 1536;
        *(LAS u32x4*)(F.lds + g * AT_KG + (rem >> 3) * AT_KROW + (rem & 7) * 16) = kv[i];
        *(LAS u32x4*)(F.lds + AT_VOFF + g * AT_VG + (rem / 24) * AT_VROW + (rem % 24) * 16) = vv[i];
    }
    __syncthreads();
    attn_wave_unit(F.lds, qf0, sk, CAT, tokb, 0, F.wave, F.lane);
    attn_wave_unit(F.lds, qf1, sk, CAT, tokb + 32, 1, F.wave, F.lane);
    __syncthreads();
}
template <int CTRL> __device__ __forceinline__ float dppq(float v) { return __builtin_bit_cast(float, __builtin_amdgcn_update_dpp(0, __builtin_bit_cast(int, v), CTRL, 0xF, 0xF, true)); }
constexpr int SG_WOFF = 20480, SG_WROW = 272;
__device__ __forceinline__ void sgu_stage_w(const Frame& F, const float* w_s, int gi) {
    f32x4 w[8];
#pragma unroll
    for (int i = 0; i < 8; ++i) w[i] = *(const f32x4*)(w_s + (size_t)gi * 16384 + (size_t)(F.tid + 512 * i) * 4);
#pragma unroll
    for (int i = 0; i < 8; ++i) { const int c = F.tid + 512 * i, t = c >> 5, s0 = (c & 31) * 4;
        f32x4 v = w[i];
#pragma unroll
        for (int j = 0; j < 4; ++j) if (s0 + j > t) v[j] = 0.f;
        u32x2 o; o.x = cvt_pk_bf16(v[0], v[1]); o.y = cvt_pk_bf16(v[2], v[3]);
        *(LAS u32x2*)(F.lds + SG_WOFF + t * SG_WROW + s0 * 2) = o; }
}
__device__ __forceinline__ void sgu_unit(const Frame& F, const bf16* UB, const bf16* GB, const float* ln_g, const float* ln_b, const float* w_s, const float* b_s, bf16* CAT, int ch, int gi) {
    LAS bf16* GT = (LAS bf16*)F.lds;
    const int r32 = F.lane & 31, hi = F.lane >> 5, tb = F.wave >> 1, db = F.wave & 1, t = tb * 32 + r32;
    const int nks = 2 * (tb + 1);
    const int s = F.tid >> 2, q4 = F.tid & 3; const size_t tok = (size_t)ch * 128 + s;
    const u32x4* gp = (const u32x4*)(GB + tok * 512 + gi * 64 + q4 * 16);
    const u32x4 a = gp[0], c = gp[1];
    const size_t tokt = (size_t)ch * 128 + t;
    const bf16* up = UB + tokt * 512 + gi * 64 + db * 32 + 4 * hi;
    u32x2 uu[4];
#pragma unroll
    for (int gq = 0; gq < 4; ++gq) uu[gq] = *(const u32x2*)(up + 8 * gq);
    const float bb = b_s[gi * 128 + t];
    float lg_[16], lb_[16];
#pragma unroll
    for (int i = 0; i < 16; ++i) { lg_[i] = ln_g[gi * 64 + q4 * 16 + i]; lb_[i] = ln_b[gi * 64 + q4 * 16 + i]; }
    {
        float v[16];
        v[0] = __uint_as_float(a.x << 16); v[1] = __uint_as_float(a.x & 0xffff0000u); v[2] = __uint_as_float(a.y << 16); v[3] = __uint_as_float(a.y & 0xffff0000u);
        v[4] = __uint_as_float(a.z << 16); v[5] = __uint_as_float(a.z & 0xffff0000u); v[6] = __uint_as_float(a.w << 16); v[7] = __uint_as_float(a.w & 0xffff0000u);
        v[8] = __uint_as_float(c.x << 16); v[9] = __uint_as_float(c.x & 0xffff0000u); v[10] = __uint_as_float(c.y << 16); v[11] = __uint_as_float(c.y & 0xffff0000u);
        v[12] = __uint_as_float(c.z << 16); v[13] = __uint_as_float(c.z & 0xffff0000u); v[14] = __uint_as_float(c.w << 16); v[15] = __uint_as_float(c.w & 0xffff0000u);
        float sum = 0.f;
#pragma unroll
        for (int i = 0; i < 16; ++i) sum += v[i];
        sum += dppq<0xB1>(sum); sum += dppq<0x4E>(sum);
        const float mu = sum * (1.f / 64.f); float q = 0.f;
#pragma unroll
        for (int i = 0; i < 16; ++i) { v[i] -= mu; q += v[i] * v[i]; }
        q += dppq<0xB1>(q); q += dppq<0x4E>(q);
        const float rstd = rsqrtf(q * (1.f / 64.f) + LN_EPS);
#pragma unroll
        for (int i = 0; i < 16; ++i) { const int d = q4 * 16 + i; GT[d * 136 + s] = (bf16)f2bf(v[i] * rstd * lg_[i] + lb_[i]); }
    }
    __syncthreads();
    {
        f32x16 acc;
#pragma unroll
        for (int r = 0; r < 16; ++r) acc[r] = 0.f;
        const LAS bf16* arow = GT + (db * 32 + r32) * 136 + hi * 8;
        const LAS unsigned char* wlds = F.lds + SG_WOFF + t * SG_WROW + hi * 16;
#pragma unroll
        for (int ks = 0; ks < 8; ++ks) if (ks < nks) {
            const bf16x8 af = *(const LAS bf16x8*)(arow + ks * 16);
            const bf16x8 bw = *(const LAS bf16x8*)(wlds + ks * 32);
            acc = __builtin_amdgcn_mfma_f32_32x32x16_bf16(af, bw, acc, 0, 0, 0);
        }
        bf16* op = CAT + tokt * 1024 + 512 + gi * 64 + db * 32 + 4 * hi;
#pragma unroll
        for (int gq = 0; gq < 4; ++gq) {
            const float u0 = __uint_as_float(uu[gq].x << 16), u1 = __uint_as_float(uu[gq].x & 0xffff0000u), u2 = __uint_as_float(uu[gq].y << 16), u3 = __uint_as_float(uu[gq].y & 0xffff0000u);
            u32x2 w; w.x = cvt_pk_bf16(u0 * (acc[4 * gq] + bb), u1 * (acc[4 * gq + 1] + bb)); w.y = cvt_pk_bf16(u2 * (acc[4 * gq + 2] + bb), u3 * (acc[4 * gq + 3] + bb));
            *(u32x2*)(op + 8 * gq) = w;
        }
    }
    __syncthreads();
}
__device__ __forceinline__ void p2_mixers(const Frame& F, const Args& a) {
    unsigned char* ws = a.ws;
    const bf16 *QB = (const bf16*)(ws + WS_QB), *KB = (const bf16*)(ws + WS_KB), *VT = (const bf16*)(ws + WS_VT), *UB = (const bf16*)(ws + WS_UB), *GB = (const bf16*)(ws + WS_GB);
    bf16* CAT = (bf16*)(ws + WS_CAT);
    for (int qq = F.vcu; qq < T / 64; qq += F.G) attn_block(F, QB, KB, VT, a.in[3], CAT, qq);
    int gi_staged = -1;
    for (int u = F.vcu; u < (T / 128) * 8; u += F.G) {
        if ((u & 7) != gi_staged) { __syncthreads(); sgu_stage_w(F, a.in[6], u & 7); gi_staged = u & 7; }
        sgu_unit(F, UB, GB, a.in[4], a.in[5], a.in[6], a.in[7], CAT, u >> 3, u & 7);
    }
}

template <int CTRL> __device__ __forceinline__ float dppf(float v) { return __builtin_bit_cast(float, __builtin_amdgcn_update_dpp(0, __builtin_bit_cast(int, v), CTRL, 0xF, 0xF, true)); }
__device__ __forceinline__ float swap16_sum(float x, float y) { auto r = __builtin_amdgcn_permlane16_swap(__builtin_bit_cast(unsigned, x), __builtin_bit_cast(unsigned, y), false, false); return __builtin_bit_cast(float, r[0]) + __builtin_bit_cast(float, r[1]); }
__device__ __forceinline__ float swap32_sum(float x, float y) { auto r = __builtin_amdgcn_permlane32_swap(__builtin_bit_cast(unsigned, x), __builtin_bit_cast(unsigned, y), false, false); return __builtin_bit_cast(float, r[0]) + __builtin_bit_cast(float, r[1]); }
__device__ __forceinline__ float rdlane(float v, int l) { return __builtin_bit_cast(float, __builtin_amdgcn_readlane(__builtin_bit_cast(int, v), l)); }
__device__ __forceinline__ float xsum(float v) {
    v += dppf<0xB1>(v); v += dppf<0x4E>(v); v += dppf<0x124>(v); v += dppf<0x128>(v);
    return (rdlane(v, 0) + rdlane(v, 16)) + (rdlane(v, 32) + rdlane(v, 48));
}
__device__ __forceinline__ float xmax(float v) {
    v = fmaxf(v, dppf<0xB1>(v)); v = fmaxf(v, dppf<0x4E>(v)); v = fmaxf(v, dppf<0x124>(v)); v = fmaxf(v, dppf<0x128>(v));
    return fmaxf(fmaxf(rdlane(v, 0), rdlane(v, 16)), fmaxf(rdlane(v, 32), rdlane(v, 48)));
}
__device__ __forceinline__ void p4_router(const Frame& F, const Args& a, bool commit) {
    const float* Zin = a.out; float* Hout = (float*)(a.ws + WS_H); signed char* HB8 = (signed char*)(a.ws + WS_HB); int* meta = (int*)(a.ws + WS_META); unsigned* cnt = (unsigned*)(a.ws + WS_CTL) + CW_CNT;
    const float* ln1_g = a.in[10]; const float* ln1_b = a.in[11]; const float* w_r = a.in[12]; const float* b_r = a.in[13];
    LAS float* W = (LAS float*)F.lds;
    LAS unsigned* hist = (LAS unsigned*)(F.lds + RSCR_OFF);
    LAS unsigned* base = hist + 32;
    LAS int* tmp_e = (LAS int*)(hist + 64);
    LAS int* tmp_p = tmp_e + 256;
    LAS float* tmp_g = (LAS float*)(tmp_p + 256);
    LAS float* tmp_s = tmp_g + 256;
    int* el_tok = (int*)(a.ws + WS_ELIST); float* el_gate = (float*)(a.ws + WS_ELIST) + NEXP * T; float* el_sa = el_gate + NEXP * T;
    {
        f32x4 t[16];
#pragma unroll
        for (int k = 0; k < 16; ++k) t[k] = *(const f32x4*)(w_r + (size_t)(F.tid + 512 * k) * 4);
#pragma unroll
        for (int k = 0; k < 16; ++k) { const int i = F.tid + 512 * k, c = i >> 3, e4 = i & 7, pr = (c & ~255) + 64 * (c & 3) + ((c >> 2) & 63); *(LAS f32x4*)(W + pr * 36 + e4 * 4) = t[k]; }
    }
    const int lane = F.lane, half = lane >> 5, el = lane & 31;
    LAS float* gbl = (LAS float*)(F.lds + 151552);
    for (int i = F.tid; i < 512; i += NWAVES * 64) *(LAS f32x4*)(gbl + 4 * i) = i < 256 ? *(const f32x4*)(ln1_g + 4 * i) : *(const f32x4*)(ln1_b + 4 * (i - 256));
    for (int tb = F.vcu; tb < T / 64; tb += F.G) {
        if (F.tid < 32) hist[F.tid] = 0u;
        __syncthreads();
        float zn0[16], zn1[16];
        { const f32x4* z0 = (const f32x4*)(Zin + (size_t)(tb * 64 + 8 * F.wave) * D) + lane;
#pragma unroll
          for (int j = 0; j < 4; ++j) { const f32x4 a0 = z0[64 * j], a1 = z0[256 + 64 * j];
#pragma unroll
            for (int k = 0; k < 4; ++k) { zn0[4 * j + k] = a0[k]; zn1[4 * j + k] = a1[k]; } } }
        for (int pp = 0; pp < 4; ++pp) {
            const int tl0 = 8 * F.wave + 2 * pp;
            const int tok0 = tb * 64 + tl0;
            float h0[16], h1[16];
            {
                f32x4* ho0 = (f32x4*)(Hout + (size_t)tok0 * D) + lane; f32x4* ho1 = ho0 + 256;
                float s0 = 0.f, s1 = 0.f, q0 = 0.f, q1 = 0.f;
#pragma unroll
                for (int i = 0; i < 16; ++i) { h0[i] = zn0[i]; h1[i] = zn1[i]; }
                if (pp < 3) { const f32x4* zp = (const f32x4*)(Zin + (size_t)(tok0 + 2) * D) + lane;
#pragma unroll
                    for (int j = 0; j < 4; ++j) { const f32x4 a0 = zp[64 * j], a1 = zp[256 + 64 * j];
#pragma unroll
                        for (int k = 0; k < 4; ++k) { zn0[4 * j + k] = a0[k]; zn1[4 * j + k] = a1[k]; } } }
#pragma unroll
                for (int i = 0; i < 16; ++i) { s0 += h0[i]; s1 += h1[i]; q0 += h0[i] * h0[i]; q1 += h1[i] * h1[i]; }
                s0 = xsum(s0); s1 = xsum(s1); q0 = xsum(q0); q1 = xsum(q1);
                const float m0 = s0 * (1.f / D), m1 = s1 * (1.f / D);
                const float r0 = rsqrtf(fmaxf(q0 * (1.f / D) - m0 * m0, 0.f) + LN_EPS), r1 = rsqrtf(fmaxf(q1 * (1.f / D) - m1 * m1, 0.f) + LN_EPS);
                float a0 = 0.f, a1 = 0.f;
#pragma unroll
                for (int i = 0; i < 16; ++i) {
                    const float gm_ = gbl[4 * lane + 256 * (i >> 2) + (i & 3)], bt_ = gbl[1024 + 4 * lane + 256 * (i >> 2) + (i & 3)];
                    h0[i] = (h0[i] - m0) * r0 * gm_ + bt_; h1[i] = (h1[i] - m1) * r1 * gm_ + bt_;
                    a0 = fmaxf(a0, fabsf(h0[i])); a1 = fmaxf(a1, fabsf(h1[i]));
                }
                a0 = xmax(a0); a1 = xmax(a1);
                const float i0 = a0 > 0.f ? 127.0f / a0 : 0.f, i1 = a1 > 0.f ? 127.0f / a1 : 0.f;
                unsigned* hb0 = (unsigned*)(HB8 + (size_t)tok0 * D) + lane; unsigned* hb1 = hb0 + 256;
#pragma unroll
                for (int j = 0; j < 4; ++j) {
                    ho0[64 * j] = (f32x4){h0[4 * j], h0[4 * j + 1], h0[4 * j + 2], h0[4 * j + 3]}; ho1[64 * j] = (f32x4){h1[4 * j], h1[4 * j + 1], h1[4 * j + 2], h1[4 * j + 3]};
                    unsigned p0 = 0u, p1 = 0u;
#pragma unroll
                    for (int k = 0; k < 4; ++k) { p0 |= ((unsigned)(int)rintf(h0[4 * j + k] * i0) & 0xffu) << (8 * k); p1 |= ((unsigned)(int)rintf(h1[4 * j + k] * i1) & 0xffu) << (8 * k); }
                    hb0[64 * j] = p0; hb1[64 * j] = p1;
                }
                if (lane == 0) { tmp_s[tl0] = a0 * (1.0f / 127.0f); tmp_s[tl0 + 1] = a1 * (1.0f / 127.0f); }
            }
            f32x2 lp0[16], lp1[16];
#pragma unroll
            for (int e = 0; e < 16; ++e) { lp0[e] = (f32x2){0.f, 0.f}; lp1[e] = (f32x2){0.f, 0.f}; }
#pragma unroll
            for (int i = 0; i < 16; ++i) {
                const LAS f32x4* wr = (const LAS f32x4*)(W + (256 * (i >> 2) + 64 * (i & 3) + lane) * 36);
                const f32x2 hv0 = (f32x2){h0[i], h0[i]}, hv1 = (f32x2){h1[i], h1[i]};
#pragma unroll
                for (int e4 = 0; e4 < 8; ++e4) {
                    const f32x4 ww = wr[e4];
                    const f32x2 wlo = (f32x2){ww.x, ww.y}, whi = (f32x2){ww.z, ww.w};
                    lp0[2 * e4] = __builtin_elementwise_fma(hv0, wlo, lp0[2 * e4]); lp0[2 * e4 + 1] = __builtin_elementwise_fma(hv0, whi, lp0[2 * e4 + 1]);
                    lp1[2 * e4] = __builtin_elementwise_fma(hv1, wlo, lp1[2 * e4]); lp1[2 * e4 + 1] = __builtin_elementwise_fma(hv1, whi, lp1[2 * e4 + 1]);
                }
            }
            float lg0[32], lg1[32];
#pragma unroll
            for (int e = 0; e < 16; ++e) { lg0[2 * e] = lp0[e].x; lg0[2 * e + 1] = lp0[e].y; lg1[2 * e] = lp1[e].x; lg1[2 * e + 1] = lp1[e].y; }
            float v32[32];
#pragma unroll
            for (int e = 0; e < 32; ++e) { const float keep = half ? lg1[e] : lg0[e], send = half ? lg0[e] : lg1[e]; v32[e] = keep + __shfl_xor(send, 32); }
            float v16[16];
#pragma unroll
            for (int e = 0; e < 16; ++e) { const bool up = (lane & 16) != 0; const float keep = up ? v32[e + 16] : v32[e], send = up ? v32[e] : v32[e + 16]; v16[e] = keep + __shfl_xor(send, 16); }
            float v8[8];
#pragma unroll
            for (int e = 0; e < 8; ++e) { const bool up = (lane & 8) != 0; const float keep = up ? v16[e + 8] : v16[e], send = up ? v16[e] : v16[e + 8]; v8[e] = keep + dppf<0x128>(send); }
            float v4[4];
#pragma unroll
            for (int e = 0; e < 4; ++e) { const bool up = (lane & 4) != 0; const float keep = up ? v8[e + 4] : v8[e], send = up ? v8[e] : v8[e + 4]; v4[e] = keep + dppf<0x1B>(dppf<0x141>(send)); }
            float v2[2];
#pragma unroll
            for (int e = 0; e < 2; ++e) { const bool up = (lane & 2) != 0; const float keep = up ? v4[e + 2] : v4[e], send = up ? v4[e] : v4[e + 2]; v2[e] = keep + dppf<0x4E>(send); }
            float lgt;
            { const bool up = (lane & 1) != 0; const float keep = up ? v2[1] : v2[0], send = up ? v2[0] : v2[1]; lgt = keep + dppf<0xB1>(send); }
            lgt += b_r[el];
            int rank = 0;
#pragma unroll
            for (int j = 0; j < 32; ++j) {
                const float lo = rdlane(lgt, j), hi2 = rdlane(lgt, 32 + j);
                const float vj = half ? hi2 : lo;
                rank += (vj > lgt || (vj == lgt && j < el)) ? 1 : 0;
            }
            float bv[4]; int bi[4];
#pragma unroll
            for (int k = 0; k < 4; ++k) {
                const unsigned long long mk = __ballot(rank == k);
                const int i0 = __builtin_ctz((unsigned)mk | 0x80000000u), i1 = 32 + __builtin_ctz((unsigned)(mk >> 32) | 0x80000000u);
                const float x0 = rdlane(lgt, i0), x1 = rdlane(lgt, i1);
                bv[k] = half ? x1 : x0; bi[k] = half ? (i1 - 32) : i0;
            }
            float ex[4], es = 0.f;
#pragma unroll
            for (int k = 0; k < 4; ++k) { ex[k] = __expf(bv[k] - bv[0]); es += ex[k]; }
            if (el == 0) {
                const int tl = tl0 + half;
#pragma unroll
                for (int k = 0; k < 4; ++k) { const unsigned pl = atomicAdd((unsigned*)&hist[bi[k]], 1u); tmp_e[tl * 4 + k] = bi[k]; tmp_p[tl * 4 + k] = (int)pl; tmp_g[tl * 4 + k] = ex[k] / es; }
            }
        }
        __syncthreads();
        if (F.tid < 32) base[F.tid] = commit ? atomicAdd(&cnt[F.tid], hist[F.tid]) : 0u;
        __syncthreads();
        if (F.tid < 256) { const int i = F.tid, gi = tb * 256 + i, e = tmp_e[i];
            const int pos = (int)base[e] + tmp_p[i];
            meta[MT_SEL_E + gi] = e; meta[MT_SEL_POS + gi] = pos;
            el_tok[e * T + pos] = tb * 64 + (i >> 2); el_gate[e * T + pos] = tmp_g[i]; el_sa[e * T + pos] = tmp_s[i >> 2]; }
        __syncthreads();
    }
}
__device__ __forceinline__ void build_tables(const Frame& F, const Args& a) {
    const unsigned* cnt = (const unsigned*)(a.ws + WS_CTL) + CW_CNT;
    LAS int* tb = (LAS int*)(F.lds + RSCR_OFF);
    __syncthreads();
    if (F.tid < 32) tb[TBL_CNT + F.tid] = (int)__hip_atomic_load(cnt + F.tid, RLX_AGENT);
    __syncthreads();
    if (F.tid == 0) { int acc = 0; for (int e = 0; e < 32; ++e) { tb[TBL_TS + e] = acc; acc += (tb[TBL_CNT + e] + 255) >> 8; } tb[TBL_TS + 32] = acc; }
    __syncthreads();
    for (int t = F.tid; t < NT_MAX; t += NWAVES * 64) { int e = 0; for (int j = 1; j < 32; ++j) if (t >= tb[TBL_TS + j]) e = j; tb[TBL_TILE + t] = e; }
    __syncthreads();
}
__device__ __forceinline__ void p7_quant(const Frame& F, const Args& a) {
    const bf16* HID = (const bf16*)(a.ws + WS_HID); signed char* H8 = (signed char*)(a.ws + WS_HID8); float* row_sb = (float*)(a.ws + WS_ROWSB);
    const int nrows = __builtin_amdgcn_readfirstlane(((const LAS int*)(F.lds + RSCR_OFF))[TBL_TS + 32]) * 256;
    const int gw = F.vcu * NWAVES + F.wave, NGW = F.G * NWAVES, lane = F.lane;
    for (int r0 = gw * 4; r0 < nrows; r0 += NGW * 4) {
        u32x4 v[4][2];
#pragma unroll
        for (int i = 0; i < 4; ++i)
#pragma unroll
            for (int j = 0; j < 2; ++j) v[i][j] = *((const u32x4*)(HID + (size_t)(r0 + i) * DFF + 512 * j) + lane);
#pragma unroll
        for (int i = 0; i < 4; ++i) {
            float f[16]; float am = 0.f;
#pragma unroll
            for (int j = 0; j < 2; ++j)
#pragma unroll
                for (int c = 0; c < 4; ++c) { const unsigned w = v[i][j][c]; f[8 * j + 2 * c] = __uint_as_float(w << 16); f[8 * j + 2 * c + 1] = __uint_as_float(w & 0xffff0000u); }
#pragma unroll
            for (int c = 0; c < 16; ++c) am = fmaxf(am, fabsf(f[c]));
            am = xmax(am);
            const float inv = am > 0.f ? 127.0f / am : 0.f;
#pragma unroll
            for (int j = 0; j < 2; ++j) {
                u32x2 o; o.x = 0u; o.y = 0u;
#pragma unroll
                for (int c = 0; c < 4; ++c) { o.x |= ((unsigned)(int)rintf(f[8 * j + c] * inv) & 0xffu) << (8 * c); o.y |= ((unsigned)(int)rintf(f[8 * j + 4 + c] * inv) & 0xffu) << (8 * c); }
                *((u32x2*)(H8 + (size_t)(r0 + i) * DFF + 512 * j) + lane) = o;
            }
            if (lane == 0) row_sb[r0 + i] = am * (1.0f / 127.0f);
        }
    }
}
__device__ __forceinline__ void p8_final(const Frame& F, const Args& a) {
    const float* Hin = (const float*)(a.ws + WS_H); float* HO = a.out; const unsigned char* Y = (const unsigned char*)(a.ws + WS_Y); const int* meta = (const int*)(a.ws + WS_META);
    const float* ln2_g = a.in[20]; const float* ln2_b = a.in[21]; const LAS int* tsl = (const LAS int*)(F.lds + RSCR_OFF) + TBL_TS;
    const int gw = F.vcu * NWAVES + F.wave, NGW = F.G * NWAVES, lane = F.lane;
    f32x4 g2[4], b2[4];
#pragma unroll
    for (int j = 0; j < 4; ++j) { g2[j] = *(const f32x4*)(ln2_g + 4 * lane + 256 * j); b2[j] = *(const f32x4*)(ln2_b + 4 * lane + 256 * j); }
    for (int tok = gw; tok < T; tok += NGW) {
        f32x4* hr = (f32x4*)(HO + (size_t)tok * D) + lane; const f32x4* hi_ = (const f32x4*)(Hin + (size_t)tok * D) + lane;
        f32x4 v[4]; float s = 0.f;
#pragma unroll
        for (int j = 0; j < 4; ++j) v[j] = hi_[64 * j] * ALPHA;
#pragma unroll
        for (int k = 0; k < 4; ++k) {
            const int row = tsl[meta[MT_SEL_E + tok * 4 + k]] * 256 + meta[MT_SEL_POS + tok * 4 + k];
            const unsigned* yr = (const unsigned*)(Y + (size_t)row * D) + lane;
#pragma unroll
            for (int j = 0; j < 4; ++j) { const int y = (int)yr[64 * j]; const f32x2 lo = __builtin_amdgcn_cvt_pk_f32_fp8(y, false), hi2 = __builtin_amdgcn_cvt_pk_f32_fp8(y, true);
                v[j].x += lo.x * (1.0f / YSCALE); v[j].y += lo.y * (1.0f / YSCALE); v[j].z += hi2.x * (1.0f / YSCALE); v[j].w += hi2.y * (1.0f / YSCALE); }
        }
#pragma unroll
        for (int j = 0; j < 4; ++j) s += (v[j].x + v[j].y) + (v[j].z + v[j].w);
        const float mean = xsum(s) * (1.f / D); float s2 = 0.f;
#pragma unroll
        for (int j = 0; j < 4; ++j) { v[j] = v[j] - mean; s2 += (v[j].x * v[j].x + v[j].y * v[j].y) + (v[j].z * v[j].z + v[j].w * v[j].w); }
        const float rstd = rsqrtf(xsum(s2) * (1.f / D) + LN_EPS);
#pragma unroll
        for (int j = 0; j < 4; ++j) hr[64 * j] = v[j] * rstd * g2[j] + b2[j];
    }
}
__global__ void __launch_bounds__(NWAVES * 64, 2) mk_fwd(Args args) {
    extern __shared__ __attribute__((aligned(16))) unsigned char lds_raw[];
    Frame F;
    F.lds = (LAS unsigned char*)lds_raw;
    F.tid = threadIdx.x; F.lane = F.tid & 63; F.wave = __builtin_amdgcn_readfirstlane(F.tid >> 6);
    F.G = gridDim.x; { const int bx = blockIdx.x; F.vcu = (F.G % 8 == 0) ? (bx % 8) * (F.G / 8) + bx / 8 : bx; }
    volatile LAS unsigned* MISC = (volatile LAS unsigned*)(F.lds + MISC_OFF);
    if (F.tid < 64) MISC[F.tid] = 0u;
    __syncthreads();
    unsigned char* ws = args.ws;
    unsigned* ctl = (unsigned*)(ws + WS_CTL);
    const int lo = args.ph_lo, hi = args.ph_hi;
    XcdBarrier bar; bar.bar = ctl + CW_BAR + args.li * XCD_BAR_WORDS; bar.x = 0; bar.st = nullptr;
    if (hi - lo > 1) bar = xcd_barrier_post(ctl + CW_BAR + args.li * XCD_BAR_WORDS, MISC + 8);
#define IN(k) (lo <= (k) && (k) < hi)
#define OPAQUE_F(Fp) Frame Fp = F; asm volatile("" : "+v"(Fp.tid)); Fp.lane = Fp.tid & 63
#define SEAM(k) do { if (IN(k) && IN((k) + 1)) xcd_barrier(bar); } while (0)
    int* meta = (int*)(ws + WS_META);
    bf16 *XB = (bf16*)(ws + WS_XB), *QB = (bf16*)(ws + WS_QB), *KB = (bf16*)(ws + WS_KB), *VT = (bf16*)(ws + WS_VT), *UB = (bf16*)(ws + WS_UB), *GB = (bf16*)(ws + WS_GB);
    bf16 *CAT = (bf16*)(ws + WS_CAT), *HB = (bf16*)(ws + WS_HB), *Y = (bf16*)(ws + WS_Y), *HID = (bf16*)(ws + WS_HID);
    bf16 *Win_t = (bf16*)(ws + WS_WIN), *Wout_t = (bf16*)(ws + WS_WOUT), *Wgu_t = (bf16*)(ws + WS_WGU), *Wd_t = (bf16*)(ws + WS_WD);
    const LAS int* rtab = (const LAS int*)(F.lds + RTAB_OFF);
    const bool par = ((blockIdx.x >> 3) & 1) != 0;

    if (IN(0)) { OPAQUE_F(Fp); p0_prologue(Fp, args); SEAM(0); }
    if (IN(1)) {
        const int c = (int)blockIdx.x, grp = (c >> 3) % 3;
        const int per_ = (3 * NEXP * 32 + F.G - 1) / F.G;
        const int it_lo = F.G == 256 ? (c < 192 ? c * 10 : 1920 + (c - 192) * 18) : c * per_, it_hi = F.G == 256 ? it_lo + (c < 192 ? 10 : 18) : it_lo + per_;
        OPAQUE_F(Fp);
        if (grp == 0) conv_items(Fp, args, it_lo, it_hi);
        { pg8::Gemm g{XB, Win_t, 2 * D, nullptr, 0u}; pg8::StaticOrder S; S.init(T / 256, INW / 256, F.G, c); S.i1 = 1;
          pg8::EpiInProj E{args.in[2], QB, KB, VT, UB, GB};
          pg8::gemm_phase<pg8::EpiInProj, false, true, false>(F.lds, rtab, g, S, E); }
        if (grp == 1) conv_items(Fp, args, it_lo, it_hi);
        { pg8::Gemm g{XB, Win_t, 2 * D, nullptr, 0u}; pg8::StaticOrder S; S.init(T / 256, INW / 256, F.G, c); S.i0 = 1;
          pg8::EpiInProj E{args.in[2], QB, KB, VT, UB, GB};
          pg8::gemm_phase<pg8::EpiInProj, false, true, false>(F.lds, rtab, g, S, E); }
        if (grp == 2) conv_items(Fp, args, it_lo, it_hi);
        SEAM(1);
    }
    if (IN(2)) { OPAQUE_F(Fp); p2_mixers(Fp, args); SEAM(2); }
    if (IN(3)) {
        pg8::Gemm g{CAT, Wout_t, 2 * D, nullptr, 0u}; pg8::StaticOrder S; S.init(T / 256, D / 256, F.G, (int)blockIdx.x);
        pg8::EpiOutProj E{args.in[0], args.in[9], args.out};
        pg8::gemm_phase<pg8::EpiOutProj, false, false, false>(F.lds, rtab, g, S, E);
        SEAM(3);
    }
    if (IN(4)) { OPAQUE_F(Fp); p4_router(Fp, args, true); if (hi > 5) xcd_barrier(bar); }
    const LAS int* tbl = (const LAS int*)(F.lds + RSCR_OFF);
    if (hi > 5) { OPAQUE_F(Fp); build_tables(Fp, args); }
    if (IN(6)) {
        const int nT = __builtin_amdgcn_readfirstlane(tbl[TBL_TS + 32]);
        pg8::StaticOrder S; S.init(nT, 2 * DFF / 256, F.G, (int)blockIdx.x);
        { pg8::Unit u; LAS int* rt = (LAS int*)(F.lds + RTAB_OFF); const int* el_tok = (const int*)(ws + WS_ELIST);
          for (int i = 0; i < RTAB_UNITS && S.next(i, u); ++i) if (F.tid < 256) { const int e = tbl[TBL_TILE + u.pm], ix = (u.pm - tbl[TBL_TS + e]) * 256 + F.tid; rt[i * 256 + F.tid] = ix < tbl[TBL_CNT + e] ? el_tok[e * T + ix] : 0; }
          __syncthreads(); }
        pg8::Gemm g{HB, Wgu_t, D, tbl + TBL_TILE, 2048u * 1024u};
        pg8::EpiSwiglu E{tbl, args.in[15], args.in[17], (const float*)(ws + WS_SWGU), (const float*)(ws + WS_ELIST) + 2 * NEXP * T, HID};
        pg8::gemm_phase<pg8::EpiSwiglu, true, true, true>(F.lds, rtab, g, S, E);
        SEAM(6);
    }
    if (IN(7)) { OPAQUE_F(Fp); p7_quant(Fp, args); SEAM(7); }
    if (IN(8)) {
        const int nT = __builtin_amdgcn_readfirstlane(tbl[TBL_TS + 32]);
        pg8::StaticOrder S; S.init(nT, D / 256, F.G, (int)blockIdx.x);
        pg8::Gemm g{ws + WS_HID8, Wd_t, DFF, tbl + TBL_TILE, 1024u * 1024u};
        pg8::EpiDown E{tbl, args.in[19], (const float*)(ws + WS_SWD), (const float*)(ws + WS_ROWSB), (const float*)(ws + WS_ELIST) + NEXP * T, (unsigned char*)Y};
        pg8::gemm_phase<pg8::EpiDown, false, true, true>(F.lds, rtab, g, S, E);
        SEAM(8);
    }
    if (IN(9)) { OPAQUE_F(Fp); p8_final(Fp, args); }
#undef IN
#undef SEAM
}

extern "C" void kernel_launch(void* const* d_in, const int* in_sizes, int n_in, void* d_out, int out_size, void* d_ws, size_t ws_size, hipStream_t stream) {
    static int grid = 0;
    if (grid == 0) {
        if (n_in != 22 || in_sizes[0] != T * D || out_size != T * D || ws_size < WS_END) { fprintf(stderr, "kernel_launch: unexpected shapes (n_in %d, in0 %d, out %d, ws %zu, need %zu)\n", n_in, n_in > 0 ? in_sizes[0] : -1, out_size, ws_size, (size_t)WS_END); grid = -1; return; }
        int dev = 0, cus = 0;
        if (hipGetDevice(&dev) != hipSuccess || hipDeviceGetAttribute(&cus, hipDeviceAttributeMultiprocessorCount, dev) != hipSuccess) { grid = -1; return; }
        if (hipFuncSetAttribute((const void*)mk_fwd, hipFuncAttributeMaxDynamicSharedMemorySize, LDS_BYTES) != hipSuccess) { fprintf(stderr, "kernel_launch: hipFuncSetAttribute failed\n"); grid = -1; return; }
        int per_cu = 0;
        if (hipOccupancyMaxActiveBlocksPerMultiprocessor(&per_cu, (const void*)mk_fwd, NWAVES * 64, LDS_BYTES) != hipSuccess || per_cu < 1) fprintf(stderr, "kernel_launch: occupancy query reports %d\n", per_cu);
        (void)hipGetLastError();
        grid = cus;
    }
    if (grid < 0) return;
    unsigned char* ws = (unsigned char*)d_ws; float* out = (float*)d_out;
    (void)hipMemsetAsync(ws + WS_CTL, 0, 64 * 1024, stream);
    Args a{};
    for (int i = 0; i < 22; ++i) a.in[i] = (const float*)d_in[i];
    a.out = out; a.ws = ws;
    a.ph_lo = 0; a.ph_hi = NPHASES; a.li = 0;
    hipLaunchKernelGGL(mk_fwd, dim3(grid), dim3(NWAVES * 64), LDS_BYTES, stream, a);
}
```

```cpp
#include <hip/hip_runtime.h>
#include <cstdio>
#include <cstdint>

typedef unsigned short bf16;
typedef float f32x4 __attribute__((ext_vector_type(4)));
typedef unsigned u32x4 __attribute__((ext_vector_type(4)));
typedef unsigned u32x2 __attribute__((ext_vector_type(2)));

constexpr int BATCH = 2, SEQ = 8192, D = 1024, T = BATCH * SEQ;
constexpr int NQH = 8, NKVH = 2, HD = 64, QREP = 4, AW = 512, KVW = 128, GW = 512, INW = 1792;
constexpr int NEXP = 32, TOPK = 4, DFF = 1024;
constexpr int NT_MAX = T * TOPK / 256 + NEXP;
constexpr int NROWS_MAX = NT_MAX * 256;
constexpr float LN_EPS = 1e-5f;
constexpr float ALPHA = 1.189207115002721f;
constexpr float C2 = 0.125f * 1.4426950408889634f;
constexpr float LOG2E = 1.4426950408889634f;
constexpr float YSCALE = 16.0f;

constexpr size_t MiB = 1u << 20;
constexpr size_t WS_CTL = 0;
constexpr size_t WS_META = 1 * MiB;
constexpr size_t WS_XB = 3 * MiB;
constexpr size_t WS_QB = WS_XB + 32 * MiB;
constexpr size_t WS_KB = WS_QB + 16 * MiB;
constexpr size_t WS_VT = WS_KB + 4 * MiB;
constexpr size_t WS_UB = WS_VT + 4 * MiB;
constexpr size_t WS_GB = WS_UB + 16 * MiB;
constexpr size_t WS_CAT = WS_GB + 16 * MiB;
constexpr size_t WS_HB = WS_CAT + 32 * MiB;
constexpr size_t WS_H = WS_XB;
constexpr size_t WS_HID = WS_HB + 32 * MiB;
constexpr size_t WS_Y = WS_HID;
static_assert(WS_H + 64 * MiB <= WS_CAT, "H overlay");

constexpr int CW_CNT = 64;
constexpr int MT_NT = 0;
constexpr int MT_TSTART = 16;
constexpr int MT_TILE_E = 64;
constexpr int MT_SEL_E = 1024;
constexpr int MT_SEL_POS = MT_SEL_E + T * 4;
constexpr int MT_SEL_G = MT_SEL_POS + T * 4;
constexpr int MT_SLOT_ROW = MT_SEL_G + T * 4;
constexpr int MT_ROW_TOK = MT_SLOT_ROW + T * 4;
constexpr int MT_ROW_GATE = MT_ROW_TOK + NROWS_MAX;
constexpr int MT_ROW_SA = MT_ROW_GATE + NROWS_MAX;
constexpr int MT_SH = MT_ROW_SA + NROWS_MAX;
constexpr size_t WS_ELIST = WS_GB;
constexpr int TBL_CNT = 0, TBL_TS = 32, TBL_TILE = 72;
constexpr size_t WS_ROWSB = 512 * 1024;
static_assert((size_t)(MT_SH + T) * 4 <= 2 * MiB, "meta");

__device__ __forceinline__ float bf2f(bf16 v) { return __uint_as_float((unsigned)v << 16); }
__device__ __forceinline__ unsigned f2bf(float f) { unsigned u = __float_as_uint(f); return (u + 0x7fffu + ((u >> 16) & 1u)) >> 16; }
__device__ __forceinline__ unsigned pk2(float lo, float hi) { return f2bf(lo) | (f2bf(hi) << 16); }
__device__ __forceinline__ float gelu_tanh(float x) {
    const float k2 = 2.0f * 0.7978845608028654f;
    const float u = k2 * (x + 0.044715f * x * x * x);
    return x / (1.0f + __expf(-u));
}
__device__ __forceinline__ float wave_sum(float v) {
#pragma unroll
    for (int o = 1; o < 64; o <<= 1) v += __shfl_xor(v, o);
    return v;
}
__device__ __forceinline__ float wave_max(float v) {
#pragma unroll
    for (int o = 1; o < 64; o <<= 1) v = fmaxf(v, __shfl_xor(v, o));
    return v;
}

#define LAS __attribute__((address_space(3)))
#define GAS __attribute__((address_space(1)))
typedef short bf16x8 __attribute__((ext_vector_type(8)));
typedef float f32x16 __attribute__((ext_vector_type(16)));
typedef float f32x2 __attribute__((ext_vector_type(2)));
__device__ __forceinline__ unsigned cvt_pk_bf16(float lo, float hi) { unsigned r; asm volatile("v_cvt_pk_bf16_f32 %0, %1, %2" : "=v"(r) : "v"(lo), "v"(hi)); return r; }
__device__ __forceinline__ float fast_gelu(float x) {
    const float u = -2.0f * 0.7978845608028654f * LOG2E * (x + 0.044715f * x * x * x);
    return x * __builtin_amdgcn_rcpf(1.0f + __builtin_amdgcn_exp2f(u));
}
__device__ __forceinline__ void st16_wt(void* p, u32x4 v) {
    *(u32x4*)p = v;
}
namespace pg8 {
constexpr int BM = 256, BK = 64, HALF = 128, HTB = HALF * BK * 2  , STAGE_BYTES = 8 * HTB, NXCD = 8, WGM = 8;
__host__ __device__ __forceinline__ int lds_byte(int r, int c) { const int st = (r >> 4) * 2 + (c >> 5), rr = r & 15, cc = c & 31, ob = rr * 64 + cc * 2; return st * 1024 + (ob ^ (((ob >> 9) & 1) << 5)); }
__host__ __device__ __forceinline__ void stage_rc(int b, int& R, int& C) { const int st = b / 1024, sb = b % 1024, swz = sb ^ (((sb >> 9) & 1) << 5); R = (st >> 1) * 16 + swz / 64; C = (st & 1) * 32 + (swz % 64) / 2; }
__host__ __device__ __forceinline__ int perm32(int rho) { const int n = rho >> 4, i = rho & 15; return 8 * (i >> 2) + 4 * n + (i & 3); }

struct Unit { int pm, pn; };
struct Gemm { const void* A; const void* Bt; int KB; const LAS int* tile_e; unsigned e_stride; };
typedef int i32x4 __attribute__((ext_vector_type(4)));

struct StaticOrder {
    int nM, nN, nwg, G, c, i0 = 0, i1 = 1 << 30;
    __device__ void init(int nM_, int nN_, int G_, int c_) { nM = nM_; nN = nN_; nwg = nM * nN; G = G_; c = c_; }
    __device__ bool next(int i, Unit& u) const {
        i += i0; if (i >= i1) return false;
        const long L = (long)i * G + c; if (L >= nwg) return false;
        int wgid = (int)L; { const int q = nwg / NXCD, r = nwg % NXCD, xcd = wgid % NXCD, off = wgid / NXCD; wgid = (xcd < r ? xcd * (q + 1) : r * (q + 1) + (xcd - r) * q) + off; }
        const int nig = WGM * nN, gid = wgid / nig, fm = gid * WGM, gsz = (nM - fm) < WGM ? (nM - fm) : WGM;
        u.pm = fm + ((wgid % nig) % gsz); u.pn = (wgid % nig) / gsz; return true;
    }
};

template <class Epi, bool GATHER, bool ALIGN_EPI, bool I8>
__device__ __forceinline__ void gemm_phase(LAS unsigned char* lds, const LAS int* rtab, const Gemm g, const StaticOrder& S, const Epi& E) {
    int tid_ = threadIdx.x; asm volatile("" : "+v"(tid_));
    const int tid = tid_, wid = __builtin_amdgcn_readfirstlane(tid >> 6), lane = tid & 63, wr = wid >> 2, wc = wid & 3, fr = lane & 15, fq = lane >> 4;
    const int KB = g.KB, nt = KB / (BK * 2);
    int Rs[2], Cs[2]; unsigned voffB[2];
#pragma unroll
    for (int i = 0; i < 2; ++i) { int R, C; stage_rc(tid * 16 + i * 8192, R, C); const int Rb = Epi::PERM == 2 ? (64 * (R >> 5) + 16 * ((R >> 2) & 3) + 4 * ((R >> 4) & 1) + (R & 3)) : Epi::PERM ? ((R & ~31) + perm32(R & 31)) : R; Rs[i] = R; Cs[i] = C; voffB[i] = (unsigned)(Rb * KB + C * 2); }
    const size_t kstep = (size_t)(BK * 2);
    const size_t hstep = (size_t)HALF * KB;
    const size_t tstep = 2 * hstep;
    const size_t bhstep = Epi::PERM == 2 ? (size_t)8 * KB : hstep;
    const unsigned ldsw = (unsigned)wid * 1024u;
    const int aoff = lds_byte(wr * 64 + fr, fq * 8), boff = lds_byte(wc * 32 + fr, fq * 8);
#define PG8_SA(b, h) (((b) * 2 + (h)) * HTB)
#define PG8_SB(b, h) ((4 + (b) * 2 + (h)) * HTB)
#define PG8_STAGE(bufoff, gbase, voff) do { _Pragma("unroll") for (int _i = 0; _i < 2; ++_i) \
        __builtin_amdgcn_global_load_lds((const unsigned*)((const char*)(gbase) + (voff)[_i]), (LAS unsigned*)(lds + (bufoff) + ldsw + _i * 8192), 16, 0, 0); } while (0)
#define PG8_LDA(dst, b, h) do { _Pragma("unroll") for (int m = 0; m < 4; ++m) _Pragma("unroll") for (int k = 0; k < 2; ++k) dst[m][k] = *(const LAS bf16x8*)(lds + PG8_SA(b, h) + aoff + m * 2048 + k * 1024); } while (0)
#define PG8_LDB(dst, b, h) do { _Pragma("unroll") for (int n = 0; n < 2; ++n) _Pragma("unroll") for (int k = 0; k < 2; ++k) dst[n][k] = *(const LAS bf16x8*)(lds + PG8_SB(b, h) + boff + n * 2048 + k * 1024); } while (0)
#define PG8_MMA(ai, bj, At, Bt) do { __builtin_amdgcn_s_setprio(1); _Pragma("unroll") for (int m = 0; m < 4; ++m) _Pragma("unroll") for (int n = 0; n < 2; ++n) _Pragma("unroll") for (int k = 0; k < 2; ++k) \
        { if constexpr (I8) acc[ai][bj][m][n] = __builtin_bit_cast(f32x4, __builtin_amdgcn_mfma_i32_16x16x64_i8(__builtin_bit_cast(i32x4, Bt[n][k]), __builtin_bit_cast(i32x4, At[m][k]), __builtin_bit_cast(i32x4, acc[ai][bj][m][n]), 0, 0, 0)); \
          else acc[ai][bj][m][n] = __builtin_amdgcn_mfma_f32_16x16x32_bf16(Bt[n][k], At[m][k], acc[ai][bj][m][n], 0, 0, 0); } __builtin_amdgcn_s_setprio(0); } while (0)
#define PG8_WAIT_V(n) asm volatile("s_waitcnt vmcnt(" #n ")" ::: "memory")
#define PG8_WAIT_L(n) asm volatile("s_waitcnt lgkmcnt(" #n ")" ::: "memory")
#define PG8_BAR __builtin_amdgcn_s_barrier()
#define PG8_SCHED __builtin_amdgcn_sched_barrier(0)
#define PG8_VOFFA(vo, ui_, u_) do { _Pragma("unroll") for (int h_ = 0; h_ < 2; ++h_) _Pragma("unroll") for (int i_ = 0; i_ < 2; ++i_) { \
        const int row_ = GATHER ? rtab[(ui_) * 256 + h_ * 128 + Rs[i_]] : ((u_).pm * 256 + h_ * 128 + Rs[i_]); \
        vo[h_][i_] = (unsigned)(row_ * KB + Cs[i_] * 2); } } while (0)
#define PG8_BBASE(u_) ((const char*)g.Bt + (g.tile_e ? (size_t)g.tile_e[(u_).pm] * g.e_stride : (size_t)0) + (size_t)(u_).pn * tstep)
    Unit cur, nxt; int ui = 0;
    if (!S.next(0, cur)) return;
    f32x4 acc[2][2][4][2];
    if constexpr (Epi::HAS_INIT) E.init(acc, cur, wr, wc, fr, fq);
    else {
#pragma unroll
    for (int a = 0; a < 2; ++a)
#pragma unroll
        for (int b = 0; b < 2; ++b)
#pragma unroll
            for (int m = 0; m < 4; ++m)
#pragma unroll
                for (int n = 0; n < 2; ++n) acc[a][b][m][n] = (f32x4){0.f, 0.f, 0.f, 0.f};
    }
    bf16x8 At[4][2], B0[2][2], B1[2][2];
    unsigned vAc[2][2], vAn[2][2];
    PG8_VOFFA(vAc, 0, cur);
    const char* const gA = (const char*)g.A;
    const char* cB = PG8_BBASE(cur);
    PG8_STAGE(PG8_SB(0, 0), cB, voffB); PG8_STAGE(PG8_SB(0, 1), cB + bhstep, voffB); PG8_STAGE(PG8_SA(0, 0), gA, vAc[0]); PG8_STAGE(PG8_SA(0, 1), gA, vAc[1]);
    if (wr == 1) PG8_BAR;
    PG8_WAIT_V(2); PG8_BAR;
    PG8_STAGE(PG8_SB(1, 0), cB + kstep, voffB); PG8_STAGE(PG8_SA(1, 0), gA + kstep, vAc[0]); PG8_STAGE(PG8_SB(1, 1), cB + bhstep + kstep, voffB);
    PG8_WAIT_V(6); PG8_BAR;
    for (;;) {
        const bool has_next = S.next(ui + 1, nxt);
        const char* nB = cB;
        if (has_next) { nB = PG8_BBASE(nxt); PG8_VOFFA(vAn, ui + 1, nxt); }
        else {
#pragma unroll
            for (int h = 0; h < 2; ++h)
#pragma unroll
                for (int i = 0; i < 2; ++i) vAn[h][i] = vAc[h][i];
        }
        for (int t = 0; t < nt; t += 2) {
            const bool last = (t == nt - 2);
            const char* a1 = gA + (size_t)(t + 1) * kstep;
            const char* a2 = last ? gA : gA + (size_t)(t + 2) * kstep; const char* b2 = last ? nB : cB + (size_t)(t + 2) * kstep;
            const char* a3 = a2 + kstep; const char* b3 = b2 + kstep;
            unsigned v2[2][2];
#pragma unroll
            for (int h = 0; h < 2; ++h)
#pragma unroll
                for (int i = 0; i < 2; ++i) v2[h][i] = last ? vAn[h][i] : vAc[h][i];
            PG8_LDB(B0, 0, 0); PG8_LDB(B1, 0, 1); PG8_SCHED; PG8_LDA(At, 0, 0); PG8_STAGE(PG8_SA(1, 1), a1, vAc[1]);
            PG8_WAIT_V(8); PG8_WAIT_L(0); PG8_BAR; PG8_MMA(0, 0, At, B0); PG8_MMA(0, 1, At, B1); PG8_BAR; PG8_SCHED;
            PG8_LDA(At, 0, 1); PG8_STAGE(PG8_SB(0, 0), b2, voffB); PG8_STAGE(PG8_SB(0, 1), b2 + bhstep, voffB); PG8_STAGE(PG8_SA(0, 0), a2, v2[0]);
            PG8_WAIT_V(8); PG8_WAIT_L(0); PG8_BAR; PG8_MMA(1, 0, At, B0); PG8_MMA(1, 1, At, B1); PG8_BAR; PG8_SCHED;
            PG8_LDB(B0, 1, 0); PG8_LDB(B1, 1, 1); PG8_SCHED; PG8_LDA(At, 1, 0); PG8_STAGE(PG8_SA(0, 1), a2, v2[1]);
            PG8_WAIT_V(8); PG8_WAIT_L(0); PG8_BAR; PG8_MMA(0, 0, At, B0); PG8_MMA(0, 1, At, B1); PG8_BAR; PG8_SCHED;
            PG8_LDA(At, 1, 1); PG8_STAGE(PG8_SB(1, 0), b3, voffB); PG8_STAGE(PG8_SB(1, 1), b3 + bhstep, voffB); PG8_STAGE(PG8_SA(1, 0), a3, v2[0]);
            PG8_WAIT_V(8); PG8_WAIT_L(0); PG8_BAR; PG8_MMA(1, 0, At, B0); PG8_MMA(1, 1, At, B1); PG8_BAR; PG8_SCHED;
        }
        if constexpr (ALIGN_EPI) { if (wr == 0) PG8_BAR; }
        E(acc, cur, wr, wc, fr, fq);
        if (!has_next) break;
        if constexpr (Epi::HAS_INIT) E.init(acc, nxt, wr, wc, fr, fq);
        else {
#pragma unroll
        for (int a = 0; a < 2; ++a)
#pragma unroll
            for (int b = 0; b < 2; ++b)
#pragma unroll
                for (int m = 0; m < 4; ++m)
#pragma unroll
                    for (int n = 0; n < 2; ++n) acc[a][b][m][n] = (f32x4){0.f, 0.f, 0.f, 0.f};
        }
        cur = nxt; cB = nB; ++ui;
#pragma unroll
        for (int h = 0; h < 2; ++h)
#pragma unroll
            for (int i = 0; i < 2; ++i) vAc[h][i] = vAn[h][i];
        if constexpr (ALIGN_EPI) { if (wr == 1) PG8_BAR; }
    }
    PG8_WAIT_V(0);
    if constexpr (!ALIGN_EPI) { if (wr == 0) PG8_BAR; }
    PG8_BAR;
#undef PG8_SA
#undef PG8_SB
#undef PG8_STAGE
#undef PG8_LDA
#undef PG8_LDB
#undef PG8_MMA
#undef PG8_WAIT_V
#undef PG8_WAIT_L
#undef PG8_BAR
#undef PG8_SCHED
#undef PG8_VOFFA
#undef PG8_BBASE
}

struct EpiInProj {
    static constexpr int PERM = 1; static constexpr bool HAS_INIT = false;
    const float* b_in; bf16 *QB, *KB, *VT, *UB, *GB;
    __device__ __forceinline__ void operator()(const f32x4 (&acc)[2][2][4][2], const Unit& u, int wr, int wc, int fr, int fq) const {
        const int row0 = u.pm * BM + wr * 64 + fr;
#pragma unroll
        for (int bj = 0; bj < 2; ++bj) {
            const int reg = u.pn * BM + bj * HALF;
            const int c0 = reg + wc * 32 + 8 * fq;
            const f32x4 bv0 = *(const f32x4*)(b_in + c0), bv1 = *(const f32x4*)(b_in + c0 + 4);
#pragma unroll
            for (int ai = 0; ai < 2; ++ai)
#pragma unroll
                for (int m = 0; m < 4; ++m) {
                    const int row = row0 + ai * HALF + m * 16;
                    f32x4 v0 = acc[ai][bj][m][0] + bv0, v1 = acc[ai][bj][m][1] + bv1;
                    if (reg >= 640 && reg < 768) {
                        const int cv = c0 - 640, gg = cv >> 6, d = cv & 63, b = row / SEQ, s = row % SEQ;
                        bf16* vp = VT + ((size_t)((b * 2 + gg) * 64 + d)) * SEQ + s;
#pragma unroll
                        for (int j = 0; j < 4; ++j) { vp[(size_t)j * SEQ] = (bf16)f2bf(v0[j]); vp[(size_t)(j + 4) * SEQ] = (bf16)f2bf(v1[j]); }
                    } else {
                        bf16* dst;
                        if (reg < 512) { v0 = v0 * C2; v1 = v1 * C2; dst = QB + (size_t)row * 512 + c0; }
                        else if (reg < 640) { dst = KB + (size_t)row * 128 + (c0 - 512); }
                        else {
#pragma unroll
                            for (int j = 0; j < 4; ++j) { v0[j] = fast_gelu(v0[j]); v1[j] = fast_gelu(v1[j]); }
                            dst = (reg < 1280) ? (UB + (size_t)row * 512 + (c0 - 768)) : (GB + (size_t)row * 512 + (c0 - 1280));
                        }
                        u32x4 w; w.x = cvt_pk_bf16(v0[0], v0[1]); w.y = cvt_pk_bf16(v0[2], v0[3]); w.z = cvt_pk_bf16(v1[0], v1[1]); w.w = cvt_pk_bf16(v1[2], v1[3]);
                        *(u32x4*)dst = w;
                    }
                }
        }
    }
};
struct EpiOutProj {
    static constexpr int PERM = 0; static constexpr bool HAS_INIT = true;
    const float* x; const float* b_out; float* Z;
    __device__ __forceinline__ void init(f32x4 (&acc)[2][2][4][2], const Unit& u, int wr, int wc, int fr, int fq) const {
        const int col0 = u.pn * BM + wc * 32 + 4 * fq;
#pragma unroll
        for (int ai = 0; ai < 2; ++ai)
#pragma unroll
            for (int m = 0; m < 4; ++m) {
                const size_t off = (size_t)(u.pm * BM + ai * HALF + wr * 64 + m * 16 + fr) * D + col0;
#pragma unroll
                for (int bj = 0; bj < 2; ++bj)
#pragma unroll
                    for (int n = 0; n < 2; ++n) acc[ai][bj][m][n] = *(const f32x4*)(x + off + bj * HALF + n * 16) * ALPHA + *(const f32x4*)(b_out + col0 + bj * HALF + n * 16);
            }
    }
    __device__ __forceinline__ void operator()(const f32x4 (&acc)[2][2][4][2], const Unit& u, int wr, int wc, int fr, int fq) const {
        const int col0 = u.pn * BM + wc * 32 + 4 * fq;
#pragma unroll
        for (int ai = 0; ai < 2; ++ai)
#pragma unroll
            for (int m = 0; m < 4; ++m) {
                const size_t off = (size_t)(u.pm * BM + ai * HALF + wr * 64 + m * 16 + fr) * D + col0;
#pragma unroll
                for (int bj = 0; bj < 2; ++bj)
#pragma unroll
                    for (int n = 0; n < 2; ++n) *(f32x4*)(Z + off + bj * HALF + n * 16) = acc[ai][bj][m][n];
            }
    }
};
struct EpiSwiglu {
    static constexpr int PERM = 1; static constexpr bool HAS_INIT = false;
    const LAS int* tbl; const float* b_gate; const float* b_up; const float* swgu; const float* el_sa; bf16* HID;
    __device__ __forceinline__ void operator()(const f32x4 (&acc)[2][2][4][2], const Unit& u, int wr, int wc, int fr, int fq) const {
        const int e = tbl[TBL_TILE + u.pm], p0 = (u.pm - tbl[TBL_TS + e]) * BM, ce = tbl[TBL_CNT + e];
        const int fc0 = u.pn * HALF + wc * 32 + 8 * fq;
        const float* sw = swgu + e * 2048 + u.pn * 256 + wc * 32 + 8 * fq;
        float sa[2][4];
#pragma unroll
        for (int ai = 0; ai < 2; ++ai)
#pragma unroll
            for (int m = 0; m < 4; ++m) { const int ix = p0 + ai * HALF + wr * 64 + m * 16 + fr; sa[ai][m] = ix < ce ? el_sa[e * T + ix] : 0.f; }
        f32x4 gb[2], ub[2], sg[2], su[2];
#pragma unroll
        for (int n = 0; n < 2; ++n) { gb[n] = *(const f32x4*)(b_gate + e * DFF + fc0 + 4 * n); ub[n] = *(const f32x4*)(b_up + e * DFF + fc0 + 4 * n); sg[n] = *(const f32x4*)(sw + 4 * n); su[n] = *(const f32x4*)(sw + 128 + 4 * n); }
#pragma unroll
        for (int ai = 0; ai < 2; ++ai)
#pragma unroll
            for (int m = 0; m < 4; ++m) {
                const int row = u.pm * BM + ai * HALF + wr * 64 + m * 16 + fr;
                float hv[8];
#pragma unroll
                for (int n = 0; n < 2; ++n)
#pragma unroll
                    for (int j = 0; j < 4; ++j) {
                        const float ga = (float)__float_as_int(acc[ai][0][m][n][j]) * (sa[ai][m] * sg[n][j]) + gb[n][j];
                        const float ua = (float)__float_as_int(acc[ai][1][m][n][j]) * (sa[ai][m] * su[n][j]) + ub[n][j];
                        const float gt = fminf(ga, 7.0f), up = __builtin_amdgcn_fmed3f(ua, -7.0f, 7.0f);
                        hv[4 * n + j] = gt * __builtin_amdgcn_rcpf(1.0f + __builtin_amdgcn_exp2f(-1.702f * LOG2E * gt)) * (up + 1.0f);
                    }
                u32x4 w; w.x = cvt_pk_bf16(hv[0], hv[1]); w.y = cvt_pk_bf16(hv[2], hv[3]); w.z = cvt_pk_bf16(hv[4], hv[5]); w.w = cvt_pk_bf16(hv[6], hv[7]);
                *(u32x4*)(HID + (size_t)row * DFF + fc0) = w;
            }
    }
};
struct EpiDown {
    static constexpr int PERM = 2; static constexpr bool HAS_INIT = false;
    const LAS int* tbl; const float* b_down; const float* swd; const float* row_sb; const float* el_gate; unsigned char* Y;
    __device__ __forceinline__ void operator()(const f32x4 (&acc)[2][2][4][2], const Unit& u, int wr, int wc, int fr, int fq) const {
        const int e = tbl[TBL_TILE + u.pm], p0 = (u.pm - tbl[TBL_TS + e]) * BM, ce = tbl[TBL_CNT + e];
        const int c0 = u.pn * BM + wc * 64 + 16 * fq;
        f32x4 bv[2][2], sw[2][2];
#pragma unroll
        for (int bj = 0; bj < 2; ++bj)
#pragma unroll
            for (int n = 0; n < 2; ++n) { bv[bj][n] = *(const f32x4*)(b_down + e * D + c0 + 8 * bj + 4 * n); sw[bj][n] = *(const f32x4*)(swd + e * D + c0 + 8 * bj + 4 * n); }
#pragma unroll
        for (int ai = 0; ai < 2; ++ai)
#pragma unroll
            for (int m = 0; m < 4; ++m) {
                const int row = u.pm * BM + ai * HALF + wr * 64 + m * 16 + fr;
                const int ix = p0 + ai * HALF + wr * 64 + m * 16 + fr;
                const float gt = (ix < ce ? el_gate[e * T + ix] : 0.f) * YSCALE, sb = row_sb[row] * gt;
                u32x4 w;
#pragma unroll
                for (int bj = 0; bj < 2; ++bj)
#pragma unroll
                    for (int n = 0; n < 2; ++n) {
                        float v[4];
#pragma unroll
                        for (int j = 0; j < 4; ++j) v[j] = __builtin_amdgcn_fmed3f((float)__float_as_int(acc[ai][bj][m][n][j]) * (sb * sw[bj][n][j]) + bv[bj][n][j] * gt, -448.0f, 448.0f);
                        int d = 0;
                        d = __builtin_amdgcn_cvt_pk_fp8_f32(v[0], v[1], d, false);
                        d = __builtin_amdgcn_cvt_pk_fp8_f32(v[2], v[3], d, true);
                        w[2 * bj + n] = (unsigned)d;
                    }
                *(u32x4*)(Y + (size_t)row * D + c0) = w;
            }
    }
};
}
constexpr int NWAVES = 8;
constexpr int NPHASES = 10;
constexpr size_t WS_WIN = WS_HID + 144 * MiB;
constexpr size_t WS_WOUT = WS_WIN + 4 * MiB;
constexpr size_t WS_WGU = WS_WOUT + 2 * MiB;
constexpr size_t WS_SWGU = WS_WGU + 64 * MiB;
constexpr size_t WS_WD = WS_SWGU + 1 * MiB;
constexpr size_t WS_SWD = WS_WD + 32 * MiB;
constexpr size_t WS_HID8 = WS_SWD + 1 * MiB;
constexpr size_t WS_END = WS_HID8 + 72 * MiB;
constexpr int CW_BAR = 4096;
constexpr int RING_BYTES = 131072;
constexpr int RTAB_OFF = RING_BYTES;
constexpr int RTAB_UNITS = 12;
constexpr int RW_BYTES = 1024 * 144;
constexpr int RSCR_OFF = RW_BYTES;
constexpr int LDS_BYTES = 163840;
constexpr int MISC_OFF = LDS_BYTES - 256;
static_assert(RTAB_OFF + RTAB_UNITS * 1024 <= MISC_OFF && RSCR_OFF + 4096 <= MISC_OFF, "LDS map");

typedef GAS unsigned gu32;
#define RLX_AGENT __ATOMIC_RELAXED, __HIP_MEMORY_SCOPE_AGENT
#define LDS_WAIT() asm volatile("s_waitcnt lgkmcnt(0)" ::: "memory")
#define VM_WAIT() asm volatile("s_waitcnt vmcnt(0)" ::: "memory")

#define XB_TMO      128
#define XB_XCNT(j)  (256  + 64 * (j))
#define XB_XSUB(j)  (1280 + 64 * (j))
#define XB_XGEN(j)  (2304 + 64 * (j))
#define XB_TOP      3328
#define XB_TOPGEN   3392
#define XCD_BAR_WORDS 3456
#define XB_SPIN_CAP (1u << 18)
__device__ __forceinline__ unsigned xb_ld(unsigned* p)              { return __hip_atomic_load(p, __ATOMIC_RELAXED, __HIP_MEMORY_SCOPE_AGENT); }
__device__ __forceinline__ unsigned xb_add(unsigned* p, unsigned v) { return __hip_atomic_fetch_add(p, v, __ATOMIC_RELAXED, __HIP_MEMORY_SCOPE_AGENT); }
__device__ __forceinline__ unsigned xb_xcc_id() { return (unsigned)__builtin_amdgcn_s_getreg((3 << 11) | 20) & 0xFu; }
#define XB_SPIN(cond, bar) do { unsigned _sp = 0; while (cond) { __builtin_amdgcn_s_sleep(1); \
    if ((++_sp & 255u) == 0u) { if (xb_ld(&(bar)[XB_TMO])) break; if (_sp > XB_SPIN_CAP) { atomicAdd(&(bar)[XB_TMO], 1u); break; } } } } while (0)
struct XcdBarrier { unsigned* bar; unsigned x; volatile LAS unsigned* st; };
__device__ __forceinline__ XcdBarrier xcd_barrier_post(unsigned* bar, volatile LAS unsigned* st) {
    XcdBarrier b; b.bar = bar; b.x = xb_xcc_id(); b.st = st;
    if (threadIdx.x == 0) (void)xb_add(&bar[XB_XCNT(b.x)], 1u);
    return b;
}
__device__ __forceinline__ void xcd_barrier_complete(unsigned* bar, unsigned x, unsigned& nloc, unsigned& nx) {
    const unsigned G = gridDim.x * gridDim.y * gridDim.z;
    unsigned sum, cnt, mine, sp = 0u;
    for (;;) {
        sum = 0u; cnt = 0u; mine = 0u;
#pragma unroll
        for (unsigned j = 0; j < 16; ++j) { const unsigned c = xb_ld(&bar[XB_XCNT(j)]); sum += c; cnt += (c > 0u) ? 1u : 0u; mine = (j == x) ? c : mine; }
        if (sum == G) break;
        __builtin_amdgcn_s_sleep(1);
        if ((++sp & 255u) == 0u) { if (xb_ld(&bar[XB_TMO])) break; if (sp > XB_SPIN_CAP) { atomicAdd(&bar[XB_TMO], 1u); break; } }
    }
    nloc = mine > 0u ? mine : 1u; nx = cnt > 0u ? cnt : 1u;
}
__device__ __forceinline__ void xcd_barrier(const XcdBarrier& b) {
    asm volatile("s_waitcnt vmcnt(0)" ::: "memory");
    __syncthreads();
    if (threadIdx.x == 0) {
        unsigned* bar = b.bar;
        __builtin_amdgcn_s_waitcnt(0);
        unsigned nloc = b.st[0], nx = b.st[1];
        if (nloc == 0u) { xcd_barrier_complete(bar, b.x, nloc, nx); b.st[0] = nloc; b.st[1] = nx; }
        const unsigned old = xb_add(&bar[XB_XSUB(b.x)], 1u);
        const unsigned gen = old / nloc;
        if (old + 1u == (gen + 1u) * nloc) {
            __builtin_amdgcn_fence(__ATOMIC_RELEASE, "agent");
            asm volatile("s_waitcnt vmcnt(0)" ::: "memory");
            const unsigned og = xb_add(&bar[XB_TOP], 1u);
            const unsigned tg = og / nx;
            if (og + 1u == (tg + 1u) * nx) xb_add(&bar[XB_TOPGEN], 1u);
            else XB_SPIN(xb_ld(&bar[XB_TOPGEN]) == tg, bar);
            __builtin_amdgcn_fence(__ATOMIC_ACQUIRE, "agent");
            xb_add(&bar[XB_XGEN(b.x)], 1u);
            asm volatile("s_waitcnt vmcnt(0)" ::: "memory");
        } else {
            XB_SPIN(xb_ld(&bar[XB_XGEN(b.x)]) == gen, bar);
            __builtin_amdgcn_fence(__ATOMIC_ACQUIRE, "agent");
            asm volatile("s_waitcnt vmcnt(0)" ::: "memory");
        }
    }
    __syncthreads();
}

struct Args {
    const float* in[22]; float* out; unsigned char* ws; int ph_lo, ph_hi, li, pad;
};
struct Frame {
    LAS unsigned char* lds;
    int tid, lane, wave, vcu, G;
};
__device__ __forceinline__ void p0_item(const float* W, int N, bf16* WT, int K, int dst_row0, int k0, int n0, LAS float* scr, int lane) {
    f32x4 v[8];
#pragma unroll
    for (int i = 0; i < 8; ++i) v[i] = *(const f32x4*)(W + (size_t)(k0 + (lane >> 3) + 8 * i) * N + n0 + 4 * (lane & 7));
#pragma unroll
    for (int i = 0; i < 8; ++i) { LAS float* s = scr + ((lane >> 3) + 8 * i) * 33 + 4 * (lane & 7); s[0] = v[i].x; s[1] = v[i].y; s[2] = v[i].z; s[3] = v[i].w; }
    LDS_WAIT(); asm volatile("" ::: "memory");
    const int c = lane & 7;
#pragma unroll
    for (int j = 0; j < 4; ++j) { const int n = (lane >> 3) + 8 * j; const LAS float* s = scr + (8 * c) * 33 + n;
        u32x4 o; o.x = pk2(s[0 * 33], s[1 * 33]); o.y = pk2(s[2 * 33], s[3 * 33]); o.z = pk2(s[4 * 33], s[5 * 33]); o.w = pk2(s[6 * 33], s[7 * 33]);
        *(u32x4*)(WT + (size_t)(dst_row0 + n) * K + k0 + 8 * c) = o; }
    LDS_WAIT(); asm volatile("" ::: "memory");
}
struct ConvItem { const float* W; signed char* dst; float* sc; int n0, dst_row0; };
__device__ __forceinline__ ConvItem conv_decode(const Args& a, int it) {
    unsigned char* ws = a.ws;
    const int nb = it & 31, e = (it >> 5) & 31, kind = it >> 10, n0 = nb * 32;
    ConvItem c;
    c.W = (kind == 0 ? a.in[14] : kind == 1 ? a.in[16] : a.in[18]) + (size_t)e * D * DFF;
    c.dst = kind < 2 ? (signed char*)(ws + WS_WGU) + (size_t)e * 2048 * 1024 : (signed char*)(ws + WS_WD) + (size_t)e * 1024 * 1024;
    c.dst_row0 = kind < 2 ? (n0 >> 7) * 256 + kind * 128 + (n0 & 127) : n0;
    c.sc = kind < 2 ? (float*)(ws + WS_SWGU) + e * 2048 : (float*)(ws + WS_SWD) + e * 1024;
    c.n0 = n0; return c;
}
#define CONV_LOAD(v, ci) do { _Pragma("unroll") for (int i_ = 0; i_ < 4; ++i_) _Pragma("unroll") for (int j_ = 0; j_ < 4; ++j_) \
        v[i_][j_] = *(const f32x4*)((ci).W + (size_t)(4 * (kl + 64 * i_) + j_) * DFF + (ci).n0 + 4 * n4); } while (0)
__device__ __forceinline__ void conv_items(const Frame& F, const Args& a, int it_lo, int it_hi) {
    if (it_hi > 3 * NEXP * 32) it_hi = 3 * NEXP * 32;
    if (it_lo >= it_hi) return;
    const int tid = F.tid, n4 = tid & 7, kl = tid >> 3;
    LAS unsigned* tile = (LAS unsigned*)F.lds;
    LAS float* red = (LAS float*)(F.lds + 36864);
    f32x4 v[4][4];
    ConvItem cur = conv_decode(a, it_lo);
    CONV_LOAD(v, cur);
    for (int it = it_lo; it < it_hi; ++it) {
        f32x4 am = (f32x4){0.f, 0.f, 0.f, 0.f};
#pragma unroll
        for (int i = 0; i < 4; ++i)
#pragma unroll
            for (int j = 0; j < 4; ++j) { am.x = fmaxf(am.x, fabsf(v[i][j].x)); am.y = fmaxf(am.y, fabsf(v[i][j].y)); am.z = fmaxf(am.z, fabsf(v[i][j].z)); am.w = fmaxf(am.w, fabsf(v[i][j].w)); }
#pragma unroll
        for (int o = 8; o < 64; o <<= 1) { am.x = fmaxf(am.x, __shfl_xor(am.x, o)); am.y = fmaxf(am.y, __shfl_xor(am.y, o)); am.z = fmaxf(am.z, __shfl_xor(am.z, o)); am.w = fmaxf(am.w, __shfl_xor(am.w, o)); }
        if (F.lane < 8) *(LAS f32x4*)(red + F.wave * 32 + 4 * n4) = am;
        __syncthreads();
        f32x4 cm = *(const LAS f32x4*)(red + 4 * n4);
#pragma unroll
        for (int w = 1; w < 8; ++w) { const f32x4 o = *(const LAS f32x4*)(red + w * 32 + 4 * n4); cm.x = fmaxf(cm.x, o.x); cm.y = fmaxf(cm.y, o.y); cm.z = fmaxf(cm.z, o.z); cm.w = fmaxf(cm.w, o.w); }
        f32x4 inv;
#pragma unroll
        for (int c = 0; c < 4; ++c) inv[c] = cm[c] > 0.f ? 127.0f / cm[c] : 0.f;
        if (kl == 0) {
#pragma unroll
            for (int c = 0; c < 4; ++c) cur.sc[cur.dst_row0 + 4 * n4 + c] = cm[c] * (1.0f / 127.0f);
        }
#pragma unroll
        for (int i = 0; i < 4; ++i)
#pragma unroll
            for (int c = 0; c < 4; ++c) {
                unsigned d = 0u;
#pragma unroll
                for (int j = 0; j < 4; ++j) { const int q = (int)rintf(v[i][j][c] * inv[c]); d |= ((unsigned)q & 0xffu) << (8 * j); }
                tile[(4 * n4 + c) * 260 + kl + 64 * i] = d;
            }
        const ConvItem done = cur;
        if (it + 1 < it_hi) { cur = conv_decode(a, it + 1); CONV_LOAD(v, cur); }
        __syncthreads();
#pragma unroll
        for (int j = 0; j < 4; ++j) { const int ch = tid + 512 * j, n = ch >> 6, c16 = ch & 63;
            *(u32x4*)(done.dst + (size_t)(done.dst_row0 + n) * 1024 + 16 * c16) = *(const LAS u32x4*)(tile + n * 260 + 4 * c16); }
        __syncthreads();
    }
}
__device__ __forceinline__ void p0_prologue(const Frame& F, const Args& a) {
    unsigned char* ws = a.ws;
    bf16* Win_t = (bf16*)(ws + WS_WIN); bf16* Wout_t = (bf16*)(ws + WS_WOUT);
    LAS float* scr = (LAS float*)(F.lds + F.wave * 8448);
    const int gw = F.vcu * NWAVES + F.wave, NGW = F.G * NWAVES;
    constexpr int I_IN = 16 * 56, I_OUT = 16 * 32, NITEMS = I_IN + I_OUT;
    for (int it = gw; it < NITEMS; it += NGW) {
        int r = it;
        if (r < I_IN) { const int kb = r / 56, nb = r % 56; p0_item(a.in[1], INW, Win_t, D, nb * 32, kb * 64, nb * 32, scr, F.lane); continue; } r -= I_IN;
        { const int kb = r / 32, nb = r % 32; p0_item(a.in[8], D, Wout_t, D, nb * 32, kb * 64, nb * 32, scr, F.lane); }
    }
    const float* x = a.in[0]; bf16* XB = (bf16*)(ws + WS_XB);
    for (int m = gw; m < T; m += NGW) {
        const f32x4* xr = (const f32x4*)(x + (size_t)m * D) + F.lane; u32x2* o = (u32x2*)(XB + (size_t)m * D) + F.lane;
        f32x4 v[4];
#pragma unroll
        for (int j = 0; j < 4; ++j) v[j] = xr[64 * j];
#pragma unroll
        for (int j = 0; j < 4; ++j) { u32x2 w; w.x = pk2(v[j].x, v[j].y); w.y = pk2(v[j].z, v[j].w); o[64 * j] = w; }
    }
}

__device__ __forceinline__ int crow(int r, int hi) { return (r & 3) + 8 * (r >> 2) + 4 * hi; }
constexpr int AT_KROW = 144, AT_KG = 192 * AT_KROW, AT_VROW = 400, AT_VG = 64 * AT_VROW, AT_VOFF = 2 * AT_KG;
__device__ __forceinline__ void attn_wave_unit(const LAS unsigned char* lds, const bf16x8 (&qf)[4], const float sk, bf16* CAT, int tok0, int u, int h, int lane) {
    const int r32 = lane & 31, hi = lane >> 5;
    const int t0 = tok0 % SEQ, g = h >> 2;
    const int kk0 = 32 * u;
    f32x16 p[5];
    const float NEG = -INFINITY;
    const LAS unsigned char* kl = lds + g * AT_KG + (kk0 + r32) * AT_KROW + hi * 16;
#pragma unroll
    for (int j = 0; j < 5; ++j) {
        const int kb = t0 - 128 + 32 * j;
        f32x16 s;
#pragma unroll
        for (int r = 0; r < 16; ++r) s[r] = 0.f;
        if (kb >= 0) {
#pragma unroll
            for (int d0 = 0; d0 < 4; ++d0) { const bf16x8 kf = *(const LAS bf16x8*)(kl + j * 32 * AT_KROW + d0 * 32); s = __builtin_amdgcn_mfma_f32_32x32x16_bf16(kf, qf[d0], s, 0, 0, 0); }
            if (j == 0) {
#pragma unroll
                for (int r = 0; r < 16; ++r) if (!(crow(r, hi) > r32)) s[r] = NEG;
            }
            if (j == 4) {
#pragma unroll
                for (int r = 0; r < 16; ++r) if (!(crow(r, hi) <= r32)) s[r] = NEG;
            }
        } else {
#pragma unroll
            for (int r = 0; r < 16; ++r) s[r] = NEG;
        }
        p[j] = s;
    }
    float m = sk;
#pragma unroll
    for (int j = 0; j < 5; ++j)
#pragma unroll
        for (int r = 0; r < 16; ++r) m = fmaxf(m, p[j][r]);
    m = fmaxf(m, __shfl_xor(m, 32));
    float l = 0.f;
#pragma unroll
    for (int j = 0; j < 5; ++j)
#pragma unroll
        for (int r = 0; r < 16; ++r) { const float e = __builtin_amdgcn_exp2f(p[j][r] - m); p[j][r] = e; l += e; }
    l += __shfl_xor(l, 32);
    l += __builtin_amdgcn_exp2f(sk - m);
    const float inv = 1.0f / l;
    u32x4 pb[5][2];
#pragma unroll
    for (int j = 0; j < 5; ++j)
#pragma unroll
        for (int s = 0; s < 2; ++s) { pb[j][s].x = cvt_pk_bf16(p[j][8 * s + 0], p[j][8 * s + 1]); pb[j][s].y = cvt_pk_bf16(p[j][8 * s + 2], p[j][8 * s + 3]); pb[j][s].z = cvt_pk_bf16(p[j][8 * s + 4], p[j][8 * s + 5]); pb[j][s].w = cvt_pk_bf16(p[j][8 * s + 6], p[j][8 * s + 7]); }
#pragma unroll
    for (int db = 0; db < 2; ++db) {
        f32x16 o;
#pragma unroll
        for (int r = 0; r < 16; ++r) o[r] = 0.f;
        const LAS unsigned char* vl = lds + AT_VOFF + g * AT_VG + (db * 32 + r32) * AT_VROW + (kk0 + 4 * hi) * 2;
#pragma unroll
        for (int j = 0; j < 5; ++j) {
            const int kb = t0 - 128 + 32 * j;
            if (kb >= 0) {
#pragma unroll
                for (int s = 0; s < 2; ++s) {
                    const u32x2 lo = *(const LAS u32x2*)(vl + (32 * j + 16 * s) * 2), hh = *(const LAS u32x2*)(vl + (32 * j + 16 * s + 8) * 2);
                    u32x4 av; av.x = lo.x; av.y = lo.y; av.z = hh.x; av.w = hh.y;
                    o = __builtin_amdgcn_mfma_f32_32x32x16_bf16(__builtin_bit_cast(bf16x8, av), __builtin_bit_cast(bf16x8, pb[j][s]), o, 0, 0, 0);
                }
            }
        }
        bf16* op = CAT + (size_t)(tok0 + r32) * 1024 + h * 64 + db * 32 + 4 * hi;
#pragma unroll
        for (int gq = 0; gq < 4; ++gq) { u32x2 w; w.x = cvt_pk_bf16(o[4 * gq] * inv, o[4 * gq + 1] * inv); w.y = cvt_pk_bf16(o[4 * gq + 2] * inv, o[4 * gq + 3] * inv); *(u32x2*)(op + 8 * gq) = w; }
    }
}
__device__ __forceinline__ void attn_block(const Frame& F, const bf16* QB, const bf16* KB, const bf16* VT, const float* sinks, bf16* CAT, int qq) {
    const int tokb = qq * 64, b = tokb / SEQ, tb = tokb % SEQ, kbase = tb - 128;
    u32x4 kv[6], vv[6];
    bf16x8 qf0[4], qf1[4];
    { const int r32 = F.lane & 31, hi = F.lane >> 5;
#pragma unroll
      for (int d0 = 0; d0 < 4; ++d0) { qf0[d0] = *(const bf16x8*)(QB + (size_t)(tokb + r32) * 512 + F.wave * 64 + d0 * 16 + hi * 8); qf1[d0] = *(const bf16x8*)(QB + (size_t)(tokb + 32 + r32) * 512 + F.wave * 64 + d0 * 16 + hi * 8); } }
    const float sk = sinks[F.wave] * LOG2E;
#pragma unroll
    for (int i = 0; i < 6; ++i) {
        const int c = F.tid + 512 * i, g = c / 1536, rem = c % 1536;
        { const int key = rem >> 3, ch = rem & 7, pos = kbase + key;
          kv[i] = pos >= 0 ? *(const u32x4*)(KB + (size_t)(b * SEQ + pos) * 128 + g * 64 + ch * 8) : (u32x4){0u, 0u, 0u, 0u}; }
        { const int d = rem / 24, ch = rem % 24, pos = kbase + ch * 8;
          vv[i] = pos >= 0 ? *(const u32x4*)(VT + ((size_t)((b * 2 + g) * 64 + d)) * SEQ + pos) : (u32x4){0u, 0u, 0u, 0u}; }
    }
#pragma unroll
    for (int i = 0; i < 6; ++i) {
        const int c = F.tid + 512 * i, g = c / 1536, rem = c % 1536;
        *(LAS u32x4*)(F.lds + g * AT_KG + (rem >> 3) * AT_KROW + (rem & 7) * 16) = kv[i];
        *(LAS u32x4*)(F.lds + AT_VOFF + g * AT_VG + (rem / 24) * AT_VROW + (rem % 24) * 16) = vv[i];
    }
    __syncthreads();
    attn_wave_unit(F.lds, qf0, sk, CAT, tokb, 0, F.wave, F.lane);
    attn_wave_unit(F.lds, qf1, sk, CAT, tokb + 32, 1, F.wave, F.lane);
    __syncthreads();
}
template <int CTRL> __device__ __forceinline__ float dppq(float v) { return __builtin_bit_cast(float, __builtin_amdgcn_update_dpp(0, __builtin_bit_cast(int, v), CTRL, 0xF, 0xF, true)); }
constexpr int SG_WOFF = 20480, SG_WROW = 272;
__device__ __forceinline__ void sgu_stage_w(const Frame& F, const float* w_s, int gi) {
    f32x4 w[8];
#pragma unroll
    for (int i = 0; i < 8; ++i) w[i] = *(const f32x4*)(w_s + (size_t)gi * 16384 + (size_t)(F.tid + 512 * i) * 4);
#pragma unroll
    for (int i = 0; i < 8; ++i) { const int c = F.tid + 512 * i, t = c >> 5, s0 = (c & 31) * 4;
        f32x4 v = w[i];
#pragma unroll
        for (int j = 0; j < 4; ++j) if (s0 + j > t) v[j] = 0.f;
        u32x2 o; o.x = cvt_pk_bf16(v[0], v[1]); o.y = cvt_pk_bf16(v[2], v[3]);
        *(LAS u32x2*)(F.lds + SG_WOFF + t * SG_WROW + s0 * 2) = o; }
}
__device__ __forceinline__ void sgu_unit(const Frame& F, const bf16* UB, const bf16* GB, const float* ln_g, const float* ln_b, const float* w_s, const float* b_s, bf16* CAT, int ch, int gi) {
    LAS bf16* GT = (LAS bf16*)F.lds;
    const int r32 = F.lane & 31, hi = F.lane >> 5, tb = F.wave >> 1, db = F.wave & 1, t = tb * 32 + r32;
    const int nks = 2 * (tb + 1);
    const int s = F.tid >> 2, q4 = F.tid & 3; const size_t tok = (size_t)ch * 128 + s;
    const u32x4* gp = (const u32x4*)(GB + tok * 512 + gi * 64 + q4 * 16);
    const u32x4 a = gp[0], c = gp[1];
    const size_t tokt = (size_t)ch * 128 + t;
    const bf16* up = UB + tokt * 512 + gi * 64 + db * 32 + 4 * hi;
    u32x2 uu[4];
#pragma unroll
    for (int gq = 0; gq < 4; ++gq) uu[gq] = *(const u32x2*)(up + 8 * gq);
    const float bb = b_s[gi * 128 + t];
    float lg_[16], lb_[16];
#pragma unroll
    for (int i = 0; i < 16; ++i) { lg_[i] = ln_g[gi * 64 + q4 * 16 + i]; lb_[i] = ln_b[gi * 64 + q4 * 16 + i]; }
    {
        float v[16];
        v[0] = __uint_as_float(a.x << 16); v[1] = __uint_as_float(a.x & 0xffff0000u); v[2] = __uint_as_float(a.y << 16); v[3] = __uint_as_float(a.y & 0xffff0000u);
        v[4] = __uint_as_float(a.z << 16); v[5] = __uint_as_float(a.z & 0xffff0000u); v[6] = __uint_as_float(a.w << 16); v[7] = __uint_as_float(a.w & 0xffff0000u);
        v[8] = __uint_as_float(c.x << 16); v[9] = __uint_as_float(c.x & 0xffff0000u); v[10] = __uint_as_float(c.y << 16); v[11] = __uint_as_float(c.y & 0xffff0000u);
        v[12] = __uint_as_float(c.z << 16); v[13] = __uint_as_float(c.z & 0xffff0000u); v[14] = __uint_as_float(c.w << 16); v[15] = __uint_as_float(c.w & 0xffff0000u);
        float sum = 0.f;
#pragma unroll
        for (int i = 0; i < 16; ++i) sum += v[i];
        sum += dppq<0xB1>(sum); sum += dppq<0x4E>(sum);
        const float mu = sum * (1.f / 64.f); float q = 0.f;
#pragma unroll
        for (int i = 0; i < 16; ++i) { v[i] -= mu; q += v[i] * v[i]; }
        q += dppq<0xB1>(q); q += dppq<0x4E>(q);
        const float rstd = rsqrtf(q * (1.f / 64.f) + LN_EPS);
#pragma unroll
        for (int i = 0; i < 16; ++i) { const int d = q4 * 16 + i; GT[d * 136 + s] = (bf16)f2bf(v[i] * rstd * lg_[i] + lb_[i]); }
    }
    __syncthreads();
    {
        f32x16 acc;
#pragma unroll
        for (int r = 0; r < 16; ++r) acc[r] = 0.f;
        const LAS bf16* arow = GT + (db * 32 + r32) * 136 + hi * 8;
        const LAS unsigned char* wlds = F.lds + SG_WOFF + t * SG_WROW + hi * 16;
#pragma unroll
        for (int ks = 0; ks < 8; ++ks) if (ks < nks) {
            const bf16x8 af = *(const LAS bf16x8*)(arow + ks * 16);
            const bf16x8 bw = *(const LAS bf16x8*)(wlds + ks * 32);
            acc = __builtin_amdgcn_mfma_f32_32x32x16_bf16(af, bw, acc, 0, 0, 0);
        }
        bf16* op = CAT + tokt * 1024 + 512 + gi * 64 + db * 32 + 4 * hi;
#pragma unroll
        for (int gq = 0; gq < 4; ++gq) {
            const float u0 = __uint_as_float(uu[gq].x << 16), u1 = __uint_as_float(uu[gq].x & 0xffff0000u), u2 = __uint_as_float(uu[gq].y << 16), u3 = __uint_as_float(uu[gq].y & 0xffff0000u);
            u32x2 w; w.x = cvt_pk_bf16(u0 * (acc[4 * gq] + bb), u1 * (acc[4 * gq + 1] + bb)); w.y = cvt_pk_bf16(u2 * (acc[4 * gq + 2] + bb), u3 * (acc[4 * gq + 3] + bb));
            *(u32x2*)(op + 8 * gq) = w;
        }
    }
    __syncthreads();
}
__device__ __forceinline__ void p2_mixers(const Frame& F, const Args& a) {
    unsigned char* ws = a.ws;
    const bf16 *QB = (const bf16*)(ws + WS_QB), *KB = (const bf16*)(ws + WS_KB), *VT = (const bf16*)(ws + WS_VT), *UB = (const bf16*)(ws + WS_UB), *GB = (const bf16*)(ws + WS_GB);
    bf16* CAT = (bf16*)(ws + WS_CAT);
    for (int qq = F.vcu; qq < T / 64; qq += F.G) attn_block(F, QB, KB, VT, a.in[3], CAT, qq);
    int gi_staged = -1;
    for (int u = F.vcu; u < (T / 128) * 8; u += F.G) {
        if ((u & 7) != gi_staged) { __syncthreads(); sgu_stage_w(F, a.in[6], u & 7); gi_staged = u & 7; }
        sgu_unit(F, UB, GB, a.in[4], a.in[5], a.in[6], a.in[7], CAT, u >> 3, u & 7);
    }
}

template <int CTRL> __device__ __forceinline__ float dppf(float v) { return __builtin_bit_cast(float, __builtin_amdgcn_update_dpp(0, __builtin_bit_cast(int, v), CTRL, 0xF, 0xF, true)); }
__device__ __forceinline__ float swap16_sum(float x, float y) { auto r = __builtin_amdgcn_permlane16_swap(__builtin_bit_cast(unsigned, x), __builtin_bit_cast(unsigned, y), false, false); return __builtin_bit_cast(float, r[0]) + __builtin_bit_cast(float, r[1]); }
__device__ __forceinline__ float swap32_sum(float x, float y) { auto r = __builtin_amdgcn_permlane32_swap(__builtin_bit_cast(unsigned, x), __builtin_bit_cast(unsigned, y), false, false); return __builtin_bit_cast(float, r[0]) + __builtin_bit_cast(float, r[1]); }
__device__ __forceinline__ float rdlane(float v, int l) { return __builtin_bit_cast(float, __builtin_amdgcn_readlane(__builtin_bit_cast(int, v), l)); }
__device__ __forceinline__ float xsum(float v) {
    v += dppf<0xB1>(v); v += dppf<0x4E>(v); v += dppf<0x124>(v); v += dppf<0x128>(v);
    return (rdlane(v, 0) + rdlane(v, 16)) + (rdlane(v, 32) + rdlane(v, 48));
}
__device__ __forceinline__ float xmax(float v) {
    v = fmaxf(v, dppf<0xB1>(v)); v = fmaxf(v, dppf<0x4E>(v)); v = fmaxf(v, dppf<0x124>(v)); v = fmaxf(v, dppf<0x128>(v));
    return fmaxf(fmaxf(rdlane(v, 0), rdlane(v, 16)), fmaxf(rdlane(v, 32), rdlane(v, 48)));
}
__device__ __forceinline__ void p4_router(const Frame& F, const Args& a, bool commit) {
    const float* Zin = a.out; float* Hout = (float*)(a.ws + WS_H); signed char* HB8 = (signed char*)(a.ws + WS_HB); int* meta = (int*)(a.ws + WS_META); unsigned* cnt = (unsigned*)(a.ws + WS_CTL) + CW_CNT;
    const float* ln1_g = a.in[10]; const float* ln1_b = a.in[11]; const float* w_r = a.in[12]; const float* b_r = a.in[13];
    LAS float* W = (LAS float*)F.lds;
    LAS unsigned* hist = (LAS unsigned*)(F.lds + RSCR_OFF);
    LAS unsigned* base = hist + 32;
    LAS int* tmp_e = (LAS int*)(hist + 64);
    LAS int* tmp_p = tmp_e + 256;
    LAS float* tmp_g = (LAS float*)(tmp_p + 256);
    LAS float* tmp_s = tmp_g + 256;
    int* el_tok = (int*)(a.ws + WS_ELIST); float* el_gate = (float*)(a.ws + WS_ELIST) + NEXP * T; float* el_sa = el_gate + NEXP * T;
    {
        f32x4 t[16];
#pragma unroll
        for (int k = 0; k < 16; ++k) t[k] = *(const f32x4*)(w_r + (size_t)(F.tid + 512 * k) * 4);
#pragma unroll
        for (int k = 0; k < 16; ++k) { const int i = F.tid + 512 * k, c = i >> 3, e4 = i & 7, pr = (c & ~255) + 64 * (c & 3) + ((c >> 2) & 63); *(LAS f32x4*)(W + pr * 36 + e4 * 4) = t[k]; }
    }
    const int lane = F.lane, half = lane >> 5, el = lane & 31;
    LAS float* gbl = (LAS float*)(F.lds + 151552);
    for (int i = F.tid; i < 512; i += NWAVES * 64) *(LAS f32x4*)(gbl + 4 * i) = i < 256 ? *(const f32x4*)(ln1_g + 4 * i) : *(const f32x4*)(ln1_b + 4 * (i - 256));
    for (int tb = F.vcu; tb < T / 64; tb += F.G) {
        if (F.tid < 32) hist[F.tid] = 0u;
        __syncthreads();
        float zn0[16], zn1[16];
        { const f32x4* z0 = (const f32x4*)(Zin + (size_t)(tb * 64 + 8 * F.wave) * D) + lane;
#pragma unroll
          for (int j = 0; j < 4; ++j) { const f32x4 a0 = z0[64 * j], a1 = z0[256 + 64 * j];
#pragma unroll
            for (int k = 0; k < 4; ++k) { zn0[4 * j + k] = a0[k]; zn1[4 * j + k] = a1[k]; } } }
        for (int pp = 0; pp < 4; ++pp) {
            const int tl0 = 8 * F.wave + 2 * pp;
            const int tok0 = tb * 64 + tl0;
            float h0[16], h1[16];
            {
                f32x4* ho0 = (f32x4*)(Hout + (size_t)tok0 * D) + lane; f32x4* ho1 = ho0 + 256;
                float s0 = 0.f, s1 = 0.f, q0 = 0.f, q1 = 0.f;
#pragma unroll
                for (int i = 0; i < 16; ++i) { h0[i] = zn0[i]; h1[i] = zn1[i]; }
                if (pp < 3) { const f32x4* zp = (const f32x4*)(Zin + (size_t)(tok0 + 2) * D) + lane;
#pragma unroll
                    for (int j = 0; j < 4; ++j) { const f32x4 a0 = zp[64 * j], a1 = zp[256 + 64 * j];
#pragma unroll
                        for (int k = 0; k < 4; ++k) { zn0[4 * j + k] = a0[k]; zn1[4 * j + k] = a1[k]; } } }
#pragma unroll
                for (int i = 0; i < 16; ++i) { s0 += h0[i]; s1 += h1[i]; q0 += h0[i] * h0[i]; q1 += h1[i] * h1[i]; }
                s0 = xsum(s0); s1 = xsum(s1); q0 = xsum(q0); q1 = xsum(q1);
                const float m0 = s0 * (1.f / D), m1 = s1 * (1.f / D);
                const float r0 = rsqrtf(fmaxf(q0 * (1.f / D) - m0 * m0, 0.f) + LN_EPS), r1 = rsqrtf(fmaxf(q1 * (1.f / D) - m1 * m1, 0.f) + LN_EPS);
                float a0 = 0.f, a1 = 0.f;
#pragma unroll
                for (int i = 0; i < 16; ++i) {
                    const float gm_ = gbl[4 * lane + 256 * (i >> 2) + (i & 3)], bt_ = gbl[1024 + 4 * lane + 256 * (i >> 2) + (i & 3)];
                    h0[i] = (h0[i] - m0) * r0 * gm_ + bt_; h1[i] = (h1[i] - m1) * r1 * gm_ + bt_;
                    a0 = fmaxf(a0, fabsf(h0[i])); a1 = fmaxf(a1, fabsf(h1[i]));
                }
                a0 = xmax(a0); a1 = xmax(a1);
                const float i0 = a0 > 0.f ? 127.0f / a0 : 0.f, i1 = a1 > 0.f ? 127.0f / a1 : 0.f;
                unsigned* hb0 = (unsigned*)(HB8 + (size_t)tok0 * D) + lane; unsigned* hb1 = hb0 + 256;
#pragma unroll
                for (int j = 0; j < 4; ++j) {
                    ho0[64 * j] = (f32x4){h0[4 * j], h0[4 * j + 1], h0[4 * j + 2], h0[4 * j + 3]}; ho1[64 * j] = (f32x4){h1[4 * j], h1[4 * j + 1], h1[4 * j + 2], h1[4 * j + 3]};
                    unsigned p0 = 0u, p1 = 0u;
#pragma unroll
                    for (int k = 0; k < 4; ++k) { p0 |= ((unsigned)(int)rintf(h0[4 * j + k] * i0) & 0xffu) << (8 * k); p1 |= ((unsigned)(int)rintf(h1[4 * j + k] * i1) & 0xffu) << (8 * k); }
                    hb0[64 * j] = p0; hb1[64 * j] = p1;
                }
                if (lane == 0) { tmp_s[tl0] = a0 * (1.0f / 127.0f); tmp_s[tl0 + 1] = a1 * (1.0f / 127.0f); }
            }
            f32x2 lp0[16], lp1[16];
#pragma unroll
            for (int e = 0; e < 16; ++e) { lp0[e] = (f32x2){0.f, 0.f}; lp1[e] = (f32x2){0.f, 0.f}; }
#pragma unroll
            for (int i = 0; i < 16; ++i) {
                const LAS f32x4* wr = (const LAS f32x4*)(W + (256 * (i >> 2) + 64 * (i & 3) + lane) * 36);
                const f32x2 hv0 = (f32x2){h0[i], h0[i]}, hv1 = (f32x2){h1[i], h1[i]};
#pragma unroll
                for (int e4 = 0; e4 < 8; ++e4) {
                    const f32x4 ww = wr[e4];
                    const f32x2 wlo = (f32x2){ww.x, ww.y}, whi = (f32x2){ww.z, ww.w};
                    lp0[2 * e4] = __builtin_elementwise_fma(hv0, wlo, lp0[2 * e4]); lp0[2 * e4 + 1] = __builtin_elementwise_fma(hv0, whi, lp0[2 * e4 + 1]);
                    lp1[2 * e4] = __builtin_elementwise_fma(hv1, wlo, lp1[2 * e4]); lp1[2 * e4 + 1] = __builtin_elementwise_fma(hv1, whi, lp1[2 * e4 + 1]);
                }
            }
            float lg0[32], lg1[32];
#pragma unroll
            for (int e = 0; e < 16; ++e) { lg0[2 * e] = lp0[e].x; lg0[2 * e + 1] = lp0[e].y; lg1[2 * e] = lp1[e].x; lg1[2 * e + 1] = lp1[e].y; }
            float v32[32];
#pragma unroll
            for (int e = 0; e < 32; ++e) { const float keep = half ? lg1[e] : lg0[e], send = half ? lg0[e] : lg1[e]; v32[e] = keep + __shfl_xor(send, 32); }
            float v16[16];
#pragma unroll
            for (int e = 0; e < 16; ++e) { const bool up = (lane & 16) != 0; const float keep = up ? v32[e + 16] : v32[e], send = up ? v32[e] : v32[e + 16]; v16[e] = keep + __shfl_xor(send, 16); }
            float v8[8];
#pragma unroll
            for (int e = 0; e < 8; ++e) { const bool up = (lane & 8) != 0; const float keep = up ? v16[e + 8] : v16[e], send = up ? v16[e] : v16[e + 8]; v8[e] = keep + dppf<0x128>(send); }
            float v4[4];
#pragma unroll
            for (int e = 0; e < 4; ++e) { const bool up = (lane & 4) != 0; const float keep = up ? v8[e + 4] : v8[e], send = up ? v8[e] : v8[e + 4]; v4[e] = keep + dppf<0x1B>(dppf<0x141>(send)); }
            float v2[2];
#pragma unroll
            for (int e = 0; e < 2; ++e) { const bool up = (lane & 2) != 0; const float keep = up ? v4[e + 2] : v4[e], send = up ? v4[e] : v4[e + 2]; v2[e] = keep + dppf<0x4E>(send); }
            float lgt;
            { const bool up = (lane & 1) != 0; const float keep = up ? v2[1] : v2[0], send = up ? v2[0] : v2[1]; lgt = keep + dppf<0xB1>(send); }
            lgt += b_r[el];
            float bv[4]; int bi[4];
            {
                float cur = lgt;
#pragma unroll
                for (int k = 0; k < 4; ++k) {
                    float mx = cur;
                    mx = fmaxf(mx, dppf<0xB1>(mx)); mx = fmaxf(mx, dppf<0x4E>(mx)); mx = fmaxf(mx, dppf<0x124>(mx)); mx = fmaxf(mx, dppf<0x128>(mx));
                    const float m0 = fmaxf(rdlane(mx, 0), rdlane(mx, 16)), m1 = fmaxf(rdlane(mx, 32), rdlane(mx, 48));
                    const float mm = half ? m1 : m0;
                    const unsigned long long mk = __ballot(cur == mm);
                    const int i0 = __builtin_ctz((unsigned)mk | 0x80000000u), i1 = __builtin_ctz((unsigned)(mk >> 32) | 0x80000000u);
                    bv[k] = mm; bi[k] = half ? i1 : i0;
                    if (el == bi[k]) cur = -INFINITY;
                }
            }
            float ex[4], es = 0.f;
#pragma unroll
            for (int k = 0; k < 4; ++k) { ex[k] = __expf(bv[k] - bv[0]); es += ex[k]; }
            if (el == 0) {
                const int tl = tl0 + half;
#pragma unroll
                for (int k = 0; k < 4; ++k) { const unsigned pl = atomicAdd((unsigned*)&hist[bi[k]], 1u); tmp_e[tl * 4 + k] = bi[k]; tmp_p[tl * 4 + k] = (int)pl; tmp_g[tl * 4 + k] = ex[k] / es; }
            }
        }
        __syncthreads();
        if (F.tid < 32) base[F.tid] = commit ? atomicAdd(&cnt[F.tid], hist[F.tid]) : 0u;
        __syncthreads();
        if (F.tid < 256) { const int i = F.tid, gi = tb * 256 + i, e = tmp_e[i];
            const int pos = (int)base[e] + tmp_p[i];
            meta[MT_SEL_E + gi] = e; meta[MT_SEL_POS + gi] = pos;
            el_tok[e * T + pos] = tb * 64 + (i >> 2); el_gate[e * T + pos] = tmp_g[i]; el_sa[e * T + pos] = tmp_s[i >> 2]; }
        __syncthreads();
    }
}
__device__ __forceinline__ void build_tables(const Frame& F, const Args& a) {
    const unsigned* cnt = (const unsigned*)(a.ws + WS_CTL) + CW_CNT;
    LAS int* tb = (LAS int*)(F.lds + RSCR_OFF);
    __syncthreads();
    if (F.tid < 32) tb[TBL_CNT + F.tid] = (int)__hip_atomic_load(cnt + F.tid, RLX_AGENT);
    __syncthreads();
    if (F.tid == 0) { int acc = 0; for (int e = 0; e < 32; ++e) { tb[TBL_TS + e] = acc; acc += (tb[TBL_CNT + e] + 255) >> 8; } tb[TBL_TS + 32] = acc; }
    __syncthreads();
    for (int t = F.tid; t < NT_MAX; t += NWAVES * 64) { int e = 0; for (int j = 1; j < 32; ++j) if (t >= tb[TBL_TS + j]) e = j; tb[TBL_TILE + t] = e; }
    __syncthreads();
}
__device__ __forceinline__ void p7_quant(const Frame& F, const Args& a) {
    const bf16* HID = (const bf16*)(a.ws + WS_HID); signed char* H8 = (signed char*)(a.ws + WS_HID8); float* row_sb = (float*)(a.ws + WS_ROWSB);
    const int nrows = __builtin_amdgcn_readfirstlane(((const LAS int*)(F.lds + RSCR_OFF))[TBL_TS + 32]) * 256;
    const int gw = F.vcu * NWAVES + F.wave, NGW = F.G * NWAVES, lane = F.lane;
    for (int r0 = gw * 4; r0 < nrows; r0 += NGW * 4) {
        u32x4 v[4][2];
#pragma unroll
        for (int i = 0; i < 4; ++i)
#pragma unroll
            for (int j = 0; j < 2; ++j) v[i][j] = *((const u32x4*)(HID + (size_t)(r0 + i) * DFF + 512 * j) + lane);
#pragma unroll
        for (int i = 0; i < 4; ++i) {
            float f[16]; float am = 0.f;
#pragma unroll
            for (int j = 0; j < 2; ++j)
#pragma unroll
                for (int c = 0; c < 4; ++c) { const unsigned w = v[i][j][c]; f[8 * j + 2 * c] = __uint_as_float(w << 16); f[8 * j + 2 * c + 1] = __uint_as_float(w & 0xffff0000u); }
#pragma unroll
            for (int c = 0; c < 16; ++c) am = fmaxf(am, fabsf(f[c]));
            am = xmax(am);
            const float inv = am > 0.f ? 127.0f / am : 0.f;
#pragma unroll
            for (int j = 0; j < 2; ++j) {
                u32x2 o; o.x = 0u; o.y = 0u;
#pragma unroll
                for (int c = 0; c < 4; ++c) { o.x |= ((unsigned)(int)rintf(f[8 * j + c] * inv) & 0xffu) << (8 * c); o.y |= ((unsigned)(int)rintf(f[8 * j + 4 + c] * inv) & 0xffu) << (8 * c); }
                *((u32x2*)(H8 + (size_t)(r0 + i) * DFF + 512 * j) + lane) = o;
            }
            if (lane == 0) row_sb[r0 + i] = am * (1.0f / 127.0f);
        }
    }
}
__device__ __forceinline__ void p8_final(const Frame& F, const Args& a) {
    const float* Hin = (const float*)(a.ws + WS_H); float* HO = a.out; const unsigned char* Y = (const unsigned char*)(a.ws + WS_Y); const int* meta = (const int*)(a.ws + WS_META);
    const float* ln2_g = a.in[20]; const float* ln2_b = a.in[21]; const LAS int* tsl = (const LAS int*)(F.lds + RSCR_OFF) + TBL_TS;
    const int gw = F.vcu * NWAVES + F.wave, NGW = F.G * NWAVES, lane = F.lane;
    f32x4 g2[4], b2[4];
#pragma unroll
    for (int j = 0; j < 4; ++j) { g2[j] = *(const f32x4*)(ln2_g + 4 * lane + 256 * j); b2[j] = *(const f32x4*)(ln2_b + 4 * lane + 256 * j); }
    for (int tok = gw; tok < T; tok += NGW) {
        f32x4* hr = (f32x4*)(HO + (size_t)tok * D) + lane; const f32x4* hi_ = (const f32x4*)(Hin + (size_t)tok * D) + lane;
        f32x4 v[4]; float s = 0.f;
#pragma unroll
        for (int j = 0; j < 4; ++j) v[j] = hi_[64 * j] * ALPHA;
#pragma unroll
        for (int k = 0; k < 4; ++k) {
            const int row = tsl[meta[MT_SEL_E + tok * 4 + k]] * 256 + meta[MT_SEL_POS + tok * 4 + k];
            const unsigned* yr = (const unsigned*)(Y + (size_t)row * D) + lane;
#pragma unroll
            for (int j = 0; j < 4; ++j) { const int y = (int)yr[64 * j]; const f32x2 lo = __builtin_amdgcn_cvt_pk_f32_fp8(y, false), hi2 = __builtin_amdgcn_cvt_pk_f32_fp8(y, true);
                v[j].x += lo.x * (1.0f / YSCALE); v[j].y += lo.y * (1.0f / YSCALE); v[j].z += hi2.x * (1.0f / YSCALE); v[j].w += hi2.y * (1.0f / YSCALE); }
        }
#pragma unroll
        for (int j = 0; j < 4; ++j) s += (v[j].x + v[j].y) + (v[j].z + v[j].w);
        const float mean = xsum(s) * (1.f / D); float s2 = 0.f;
#pragma unroll
        for (int j = 0; j < 4; ++j) { v[j] = v[j] - mean; s2 += (v[j].x * v[j].x + v[j].y * v[j].y) + (v[j].z * v[j].z + v[j].w * v[j].w); }
        const float rstd = rsqrtf(xsum(s2) * (1.f / D) + LN_EPS);
#pragma unroll
        for (int j = 0; j < 4; ++j) hr[64 * j] = v[j] * rstd * g2[j] + b2[j];
    }
}
__global__ void __launch_bounds__(NWAVES * 64, 2) mk_fwd(Args args) {
    extern __shared__ __attribute__((aligned(16))) unsigned char lds_raw[];
    Frame F;
    F.lds = (LAS unsigned char*)lds_raw;
    F.tid = threadIdx.x; F.lane = F.tid & 63; F.wave = __builtin_amdgcn_readfirstlane(F.tid >> 6);
    F.G = gridDim.x; { const int bx = blockIdx.x; F.vcu = (F.G % 8 == 0) ? (bx % 8) * (F.G / 8) + bx / 8 : bx; }
    volatile LAS unsigned* MISC = (volatile LAS unsigned*)(F.lds + MISC_OFF);
    if (F.tid < 64) MISC[F.tid] = 0u;
    __syncthreads();
    unsigned char* ws = args.ws;
    unsigned* ctl = (unsigned*)(ws + WS_CTL);
    const int lo = args.ph_lo, hi = args.ph_hi;
    XcdBarrier bar; bar.bar = ctl + CW_BAR + args.li * XCD_BAR_WORDS; bar.x = 0; bar.st = nullptr;
    if (hi - lo > 1) bar = xcd_barrier_post(ctl + CW_BAR + args.li * XCD_BAR_WORDS, MISC + 8);
#define IN(k) (lo <= (k) && (k) < hi)
#define OPAQUE_F(Fp) Frame Fp = F; asm volatile("" : "+v"(Fp.tid)); Fp.lane = Fp.tid & 63
#define SEAM(k) do { if (IN(k) && IN((k) + 1)) xcd_barrier(bar); } while (0)
    int* meta = (int*)(ws + WS_META);
    bf16 *XB = (bf16*)(ws + WS_XB), *QB = (bf16*)(ws + WS_QB), *KB = (bf16*)(ws + WS_KB), *VT = (bf16*)(ws + WS_VT), *UB = (bf16*)(ws + WS_UB), *GB = (bf16*)(ws + WS_GB);
    bf16 *CAT = (bf16*)(ws + WS_CAT), *HB = (bf16*)(ws + WS_HB), *Y = (bf16*)(ws + WS_Y), *HID = (bf16*)(ws + WS_HID);
    bf16 *Win_t = (bf16*)(ws + WS_WIN), *Wout_t = (bf16*)(ws + WS_WOUT), *Wgu_t = (bf16*)(ws + WS_WGU), *Wd_t = (bf16*)(ws + WS_WD);
    const LAS int* rtab = (const LAS int*)(F.lds + RTAB_OFF);
    const bool par = ((blockIdx.x >> 3) & 1) != 0;

    if (IN(0)) { OPAQUE_F(Fp); p0_prologue(Fp, args); SEAM(0); }
    if (IN(1)) {
        const int c = (int)blockIdx.x, grp = (c >> 3) % 3;
        const int per_ = (3 * NEXP * 32 + F.G - 1) / F.G;
        const int it_lo = F.G == 256 ? (c < 192 ? c * 10 : 1920 + (c - 192) * 18) : c * per_, it_hi = F.G == 256 ? it_lo + (c < 192 ? 10 : 18) : it_lo + per_;
        OPAQUE_F(Fp);
        if (grp == 0) conv_items(Fp, args, it_lo, it_hi);
        { pg8::Gemm g{XB, Win_t, 2 * D, nullptr, 0u}; pg8::StaticOrder S; S.init(T / 256, INW / 256, F.G, c); S.i1 = 1;
          pg8::EpiInProj E{args.in[2], QB, KB, VT, UB, GB};
          pg8::gemm_phase<pg8::EpiInProj, false, true, false>(F.lds, rtab, g, S, E); }
        if (grp == 1) conv_items(Fp, args, it_lo, it_hi);
        { pg8::Gemm g{XB, Win_t, 2 * D, nullptr, 0u}; pg8::StaticOrder S; S.init(T / 256, INW / 256, F.G, c); S.i0 = 1;
          pg8::EpiInProj E{args.in[2], QB, KB, VT, UB, GB};
          pg8::gemm_phase<pg8::EpiInProj, false, true, false>(F.lds, rtab, g, S, E); }
        if (grp == 2) conv_items(Fp, args, it_lo, it_hi);
        SEAM(1);
    }
    if (IN(2)) { OPAQUE_F(Fp); p2_mixers(Fp, args); SEAM(2); }
    if (IN(3)) {
        pg8::Gemm g{CAT, Wout_t, 2 * D, nullptr, 0u}; pg8::StaticOrder S; S.init(T / 256, D / 256, F.G, (int)blockIdx.x);
        pg8::EpiOutProj E{args.in[0], args.in[9], args.out};
        pg8::gemm_phase<pg8::EpiOutProj, false, false, false>(F.lds, rtab, g, S, E);
        SEAM(3);
    }
    if (IN(4)) { OPAQUE_F(Fp); p4_router(Fp, args, true); if (hi > 5) xcd_barrier(bar); }
    const LAS int* tbl = (const LAS int*)(F.lds + RSCR_OFF);
    if (hi > 5) { OPAQUE_F(Fp); build_tables(Fp, args); }
    if (IN(6)) {
        const int nT = __builtin_amdgcn_readfirstlane(tbl[TBL_TS + 32]);
        pg8::StaticOrder S; S.init(nT, 2 * DFF / 256, F.G, (int)blockIdx.x);
        { pg8::Unit u; LAS int* rt = (LAS int*)(F.lds + RTAB_OFF); const int* el_tok = (const int*)(ws + WS_ELIST);
          for (int i = 0; i < RTAB_UNITS && S.next(i, u); ++i) if (F.tid < 256) { const int e = tbl[TBL_TILE + u.pm], ix = (u.pm - tbl[TBL_TS + e]) * 256 + F.tid; rt[i * 256 + F.tid] = ix < tbl[TBL_CNT + e] ? el_tok[e * T + ix] : 0; }
          __syncthreads(); }
        pg8::Gemm g{HB, Wgu_t, D, tbl + TBL_TILE, 2048u * 1024u};
        pg8::EpiSwiglu E{tbl, args.in[15], args.in[17], (const float*)(ws + WS_SWGU), (const float*)(ws + WS_ELIST) + 2 * NEXP * T, HID};
        pg8::gemm_phase<pg8::EpiSwiglu, true, true, true>(F.lds, rtab, g, S, E);
        SEAM(6);
    }
    if (IN(7)) { OPAQUE_F(Fp); p7_quant(Fp, args); SEAM(7); }
    if (IN(8)) {
        const int nT = __builtin_amdgcn_readfirstlane(tbl[TBL_TS + 32]);
        pg8::StaticOrder S; S.init(nT, D / 256, F.G, (int)blockIdx.x);
        pg8::Gemm g{ws + WS_HID8, Wd_t, DFF, tbl + TBL_TILE, 1024u * 1024u};
        pg8::EpiDown E{tbl, args.in[19], (const float*)(ws + WS_SWD), (const float*)(ws + WS_ROWSB), (const float*)(ws + WS_ELIST) + NEXP * T, (unsigned char*)Y};
        pg8::gemm_phase<pg8::EpiDown, false, true, true>(F.lds, rtab, g, S, E);
        SEAM(8);
    }
    if (IN(9)) { OPAQUE_F(Fp); p8_final(Fp, args); }
#undef IN
#undef SEAM
}

extern "C" void kernel_launch(void* const* d_in, const int* in_sizes, int n_in, void* d_out, int out_size, void* d_ws, size_t ws_size, hipStream_t stream) {
    static int grid = 0;
    if (grid == 0) {
        if (n_in != 22 || in_sizes[0] != T * D || out_size != T * D || ws_size < WS_END) { fprintf(stderr, "kernel_launch: unexpected shapes (n_in %d, in0 %d, out %d, ws %zu, need %zu)\n", n_in, n_in > 0 ? in_sizes[0] : -1, out_size, ws_size, (size_t)WS_END); grid = -1; return; }
        int dev = 0, cus = 0;
        if (hipGetDevice(&dev) != hipSuccess || hipDeviceGetAttribute(&cus, hipDeviceAttributeMultiprocessorCount, dev) != hipSuccess) { grid = -1; return; }
        if (hipFuncSetAttribute((const void*)mk_fwd, hipFuncAttributeMaxDynamicSharedMemorySize, LDS_BYTES) != hipSuccess) { fprintf(stderr, "kernel_launch: hipFuncSetAttribute failed\n"); grid = -1; return; }
        int per_cu = 0;
        if (hipOccupancyMaxActiveBlocksPerMultiprocessor(&per_cu, (const void*)mk_fwd, NWAVES * 64, LDS_BYTES) != hipSuccess || per_cu < 1) fprintf(stderr, "kernel_launch: occupancy query reports %d\n", per_cu);
        (void)hipGetLastError();
        grid = cus;
    }
    if (grid < 0) return;
    unsigned char* ws = (unsigned char*)d_ws; float* out = (float*)d_out;
    (void)hipMemsetAsync(ws + WS_CTL, 0, 64 * 1024, stream);
    Args a{};
    for (int i = 0; i < 22; ++i) a.in[i] = (const float*)d_in[i];
    a.out = out; a.ws = ws;
    a.ph_lo = 0; a.ph_hi = NPHASES; a.li = 0;
    hipLaunchKernelGGL(mk_fwd, dim3(grid), dim3(NWAVES * 64), LDS_BYTES, stream, a);
}
```

```cpp
#include <hip/hip_runtime.h>
#include <cstdio>
#include <cstdint>

typedef unsigned short bf16;
typedef float f32x4 __attribute__((ext_vector_type(4)));
typedef unsigned u32x4 __attribute__((ext_vector_type(4)));
typedef unsigned u32x2 __attribute__((ext_vector_type(2)));

constexpr int BATCH = 2, SEQ = 8192, D = 1024, T = BATCH * SEQ;
constexpr int NQH = 8, NKVH = 2, HD = 64, QREP = 4, AW = 512, KVW = 128, GW = 512, INW = 1792;
constexpr int NEXP = 32, TOPK = 4, DFF = 1024;
constexpr int NT_MAX = T * TOPK / 256 + NEXP;
constexpr int NROWS_MAX = NT_MAX * 256;
constexpr float LN_EPS = 1e-5f;
constexpr float ALPHA = 1.189207115002721f;
constexpr float C2 = 0.125f * 1.4426950408889634f;
constexpr float LOG2E = 1.4426950408889634f;
constexpr float YSCALE = 16.0f;

constexpr size_t MiB = 1u << 20;
constexpr size_t WS_CTL = 0;
constexpr size_t WS_META = 1 * MiB;
constexpr size_t WS_XB = 3 * MiB;
constexpr size_t WS_QB = WS_XB + 32 * MiB;
constexpr size_t WS_KB = WS_QB + 16 * MiB;
constexpr size_t WS_VT = WS_KB + 4 * MiB;
constexpr size_t WS_UB = WS_VT + 4 * MiB;
constexpr size_t WS_GB = WS_UB + 16 * MiB;
constexpr size_t WS_CAT = WS_GB + 16 * MiB;
constexpr size_t WS_HB = WS_CAT + 32 * MiB;
constexpr size_t WS_H = WS_XB;
constexpr size_t WS_HID = WS_HB + 32 * MiB;
constexpr size_t WS_Y = WS_HID;
static_assert(WS_H + 64 * MiB <= WS_CAT, "H overlay");

constexpr int CW_CNT = 64;
constexpr int MT_NT = 0;
constexpr int MT_TSTART = 16;
constexpr int MT_TILE_E = 64;
constexpr int MT_SEL_E = 1024;
constexpr int MT_SEL_POS = MT_SEL_E + T * 4;
constexpr int MT_SEL_G = MT_SEL_POS + T * 4;
constexpr int MT_SLOT_ROW = MT_SEL_G + T * 4;
constexpr int MT_ROW_TOK = MT_SLOT_ROW + T * 4;
constexpr int MT_ROW_GATE = MT_ROW_TOK + NROWS_MAX;
constexpr int MT_ROW_SA = MT_ROW_GATE + NROWS_MAX;
constexpr int MT_SH = MT_ROW_SA + NROWS_MAX;
constexpr size_t WS_ELIST = WS_GB;
constexpr int TBL_CNT = 0, TBL_TS = 32, TBL_TILE = 72;
constexpr size_t WS_ROWSB = 512 * 1024;
static_assert((size_t)(MT_SH + T) * 4 <= 2 * MiB, "meta");

__device__ __forceinline__ float bf2f(bf16 v) { return __uint_as_float((unsigned)v << 16); }
__device__ __forceinline__ unsigned f2bf(float f) { unsigned u = __float_as_uint(f); return (u + 0x7fffu + ((u >> 16) & 1u)) >> 16; }
__device__ __forceinline__ unsigned pk2(float lo, float hi) { return f2bf(lo) | (f2bf(hi) << 16); }
__device__ __forceinline__ float gelu_tanh(float x) {
    const float k2 = 2.0f * 0.7978845608028654f;
    const float u = k2 * (x + 0.044715f * x * x * x);
    return x / (1.0f + __expf(-u));
}
__device__ __forceinline__ float wave_sum(float v) {
#pragma unroll
    for (int o = 1; o < 64; o <<= 1) v += __shfl_xor(v, o);
    return v;
}
__device__ __forceinline__ float wave_max(float v) {
#pragma unroll
    for (int o = 1; o < 64; o <<= 1) v = fmaxf(v, __shfl_xor(v, o));
    return v;
}

#define LAS __attribute__((address_space(3)))
#define GAS __attribute__((address_space(1)))
typedef short bf16x8 __attribute__((ext_vector_type(8)));
typedef float f32x16 __attribute__((ext_vector_type(16)));
typedef float f32x2 __attribute__((ext_vector_type(2)));
__device__ __forceinline__ unsigned cvt_pk_bf16(float lo, float hi) { unsigned r; asm volatile("v_cvt_pk_bf16_f32 %0, %1, %2" : "=v"(r) : "v"(lo), "v"(hi)); return r; }
__device__ __forceinline__ float fast_gelu(float x) {
    const float u = -2.0f * 0.7978845608028654f * LOG2E * (x + 0.044715f * x * x * x);
    return x * __builtin_amdgcn_rcpf(1.0f + __builtin_amdgcn_exp2f(u));
}
__device__ __forceinline__ void st16_wt(void* p, u32x4 v) {
    *(u32x4*)p = v;
}
namespace pg8 {
constexpr int BM = 256, BK = 64, HALF = 128, HTB = HALF * BK * 2  , STAGE_BYTES = 8 * HTB, NXCD = 8, WGM = 8;
__host__ __device__ __forceinline__ int lds_byte(int r, int c) { const int st = (r >> 4) * 2 + (c >> 5), rr = r & 15, cc = c & 31, ob = rr * 64 + cc * 2; return st * 1024 + (ob ^ (((ob >> 9) & 1) << 5)); }
__host__ __device__ __forceinline__ void stage_rc(int b, int& R, int& C) { const int st = b / 1024, sb = b % 1024, swz = sb ^ (((sb >> 9) & 1) << 5); R = (st >> 1) * 16 + swz / 64; C = (st & 1) * 32 + (swz % 64) / 2; }
__host__ __device__ __forceinline__ int perm32(int rho) { const int n = rho >> 4, i = rho & 15; return 8 * (i >> 2) + 4 * n + (i & 3); }

struct Unit { int pm, pn; };
struct Gemm { const void* A; const void* Bt; int KB; const LAS int* tile_e; unsigned e_stride; };
typedef int i32x4 __attribute__((ext_vector_type(4)));

struct StaticOrder {
    int nM, nN, nwg, G, c, i0 = 0, i1 = 1 << 30;
    __device__ void init(int nM_, int nN_, int G_, int c_) { nM = nM_; nN = nN_; nwg = nM * nN; G = G_; c = c_; }
    __device__ bool next(int i, Unit& u) const {
        i += i0; if (i >= i1) return false;
        const long L = (long)i * G + c; if (L >= nwg) return false;
        int wgid = (int)L; { const int q = nwg / NXCD, r = nwg % NXCD, xcd = wgid % NXCD, off = wgid / NXCD; wgid = (xcd < r ? xcd * (q + 1) : r * (q + 1) + (xcd - r) * q) + off; }
        const int nig = WGM * nN, gid = wgid / nig, fm = gid * WGM, gsz = (nM - fm) < WGM ? (nM - fm) : WGM;
        u.pm = fm + ((wgid % nig) % gsz); u.pn = (wgid % nig) / gsz; return true;
    }
};

template <class Epi, bool GATHER, bool ALIGN_EPI, bool I8>
__device__ __forceinline__ void gemm_phase(LAS unsigned char* lds, const LAS int* rtab, const Gemm g, const StaticOrder& S, const Epi& E) {
    int tid_ = threadIdx.x; asm volatile("" : "+v"(tid_));
    const int tid = tid_, wid = __builtin_amdgcn_readfirstlane(tid >> 6), lane = tid & 63, wr = wid >> 2, wc = wid & 3, fr = lane & 15, fq = lane >> 4;
    const int KB = g.KB, nt = KB / (BK * 2);
    int Rs[2], Cs[2]; unsigned voffB[2];
#pragma unroll
    for (int i = 0; i < 2; ++i) { int R, C; stage_rc(tid * 16 + i * 8192, R, C); const int Rb = Epi::PERM == 2 ? (64 * (R >> 5) + 16 * ((R >> 2) & 3) + 4 * ((R >> 4) & 1) + (R & 3)) : Epi::PERM ? ((R & ~31) + perm32(R & 31)) : R; Rs[i] = R; Cs[i] = C; voffB[i] = (unsigned)(Rb * KB + C * 2); }
    const size_t kstep = (size_t)(BK * 2);
    const size_t hstep = (size_t)HALF * KB;
    const size_t tstep = 2 * hstep;
    const size_t bhstep = Epi::PERM == 2 ? (size_t)8 * KB : hstep;
    const unsigned ldsw = (unsigned)wid * 1024u;
    const int aoff = lds_byte(wr * 64 + fr, fq * 8), boff = lds_byte(wc * 32 + fr, fq * 8);
#define PG8_SA(b, h) (((b) * 2 + (h)) * HTB)
#define PG8_SB(b, h) ((4 + (b) * 2 + (h)) * HTB)
#define PG8_STAGE(bufoff, gbase, voff) do { _Pragma("unroll") for (int _i = 0; _i < 2; ++_i) \
        __builtin_amdgcn_global_load_lds((const unsigned*)((const char*)(gbase) + (voff)[_i]), (LAS unsigned*)(lds + (bufoff) + ldsw + _i * 8192), 16, 0, 0); } while (0)
#define PG8_LDA(dst, b, h) do { _Pragma("unroll") for (int m = 0; m < 4; ++m) _Pragma("unroll") for (int k = 0; k < 2; ++k) dst[m][k] = *(const LAS bf16x8*)(lds + PG8_SA(b, h) + aoff + m * 2048 + k * 1024); } while (0)
#define PG8_LDB(dst, b, h) do { _Pragma("unroll") for (int n = 0; n < 2; ++n) _Pragma("unroll") for (int k = 0; k < 2; ++k) dst[n][k] = *(const LAS bf16x8*)(lds + PG8_SB(b, h) + boff + n * 2048 + k * 1024); } while (0)
#define PG8_MMA(ai, bj, At, Bt) do { __builtin_amdgcn_s_setprio(1); _Pragma("unroll") for (int m = 0; m < 4; ++m) _Pragma("unroll") for (int n = 0; n < 2; ++n) _Pragma("unroll") for (int k = 0; k < 2; ++k) \
        { if constexpr (I8) acc[ai][bj][m][n] = __builtin_bit_cast(f32x4, __builtin_amdgcn_mfma_i32_16x16x64_i8(__builtin_bit_cast(i32x4, Bt[n][k]), __builtin_bit_cast(i32x4, At[m][k]), __builtin_bit_cast(i32x4, acc[ai][bj][m][n]), 0, 0, 0)); \
          else acc[ai][bj][m][n] = __builtin_amdgcn_mfma_f32_16x16x32_bf16(Bt[n][k], At[m][k], acc[ai][bj][m][n], 0, 0, 0); } __builtin_amdgcn_s_setprio(0); } while (0)
#define PG8_WAIT_V(n) asm volatile("s_waitcnt vmcnt(" #n ")" ::: "memory")
#define PG8_WAIT_L(n) asm volatile("s_waitcnt lgkmcnt(" #n ")" ::: "memory")
#define PG8_BAR __builtin_amdgcn_s_barrier()
#define PG8_SCHED __builtin_amdgcn_sched_barrier(0)
#define PG8_VOFFA(vo, ui_, u_) do { _Pragma("unroll") for (int h_ = 0; h_ < 2; ++h_) _Pragma("unroll") for (int i_ = 0; i_ < 2; ++i_) { \
        const int row_ = GATHER ? rtab[(ui_) * 256 + h_ * 128 + Rs[i_]] : ((u_).pm * 256 + h_ * 128 + Rs[i_]); \
        vo[h_][i_] = (unsigned)(row_ * KB + Cs[i_] * 2); } } while (0)
#define PG8_BBASE(u_) ((const char*)g.Bt + (g.tile_e ? (size_t)g.tile_e[(u_).pm] * g.e_stride : (size_t)0) + (size_t)(u_).pn * tstep)
    Unit cur, nxt; int ui = 0;
    if (!S.next(0, cur)) return;
    f32x4 acc[2][2][4][2];
    if constexpr (Epi::HAS_INIT) E.init(acc, cur, wr, wc, fr, fq);
    else {
#pragma unroll
    for (int a = 0; a < 2; ++a)
#pragma unroll
        for (int b = 0; b < 2; ++b)
#pragma unroll
            for (int m = 0; m < 4; ++m)
#pragma unroll
                for (int n = 0; n < 2; ++n) acc[a][b][m][n] = (f32x4){0.f, 0.f, 0.f, 0.f};
    }
    bf16x8 At[4][2], B0[2][2], B1[2][2];
    unsigned vAc[2][2], vAn[2][2];
    PG8_VOFFA(vAc, 0, cur);
    const char* const gA = (const char*)g.A;
    const char* cB = PG8_BBASE(cur);
    PG8_STAGE(PG8_SB(0, 0), cB, voffB); PG8_STAGE(PG8_SB(0, 1), cB + bhstep, voffB); PG8_STAGE(PG8_SA(0, 0), gA, vAc[0]); PG8_STAGE(PG8_SA(0, 1), gA, vAc[1]);
    if (wr == 1) PG8_BAR;
    PG8_WAIT_V(2); PG8_BAR;
    PG8_STAGE(PG8_SB(1, 0), cB + kstep, voffB); PG8_STAGE(PG8_SA(1, 0), gA + kstep, vAc[0]); PG8_STAGE(PG8_SB(1, 1), cB + bhstep + kstep, voffB);
    PG8_WAIT_V(6); PG8_BAR;
    for (;;) {
        const bool has_next = S.next(ui + 1, nxt);
        const char* nB = cB;
        if (has_next) { nB = PG8_BBASE(nxt); PG8_VOFFA(vAn, ui + 1, nxt); }
        else {
#pragma unroll
            for (int h = 0; h < 2; ++h)
#pragma unroll
                for (int i = 0; i < 2; ++i) vAn[h][i] = vAc[h][i];
        }
        for (int t = 0; t < nt; t += 2) {
            const bool last = (t == nt - 2);
            const char* a1 = gA + (size_t)(t + 1) * kstep;
            const char* a2 = last ? gA : gA + (size_t)(t + 2) * kstep; const char* b2 = last ? nB : cB + (size_t)(t + 2) * kstep;
            const char* a3 = a2 + kstep; const char* b3 = b2 + kstep;
            unsigned v2[2][2];
#pragma unroll
            for (int h = 0; h < 2; ++h)
#pragma unroll
                for (int i = 0; i < 2; ++i) v2[h][i] = last ? vAn[h][i] : vAc[h][i];
            PG8_LDB(B0, 0, 0); PG8_LDB(B1, 0, 1); PG8_SCHED; PG8_LDA(At, 0, 0); PG8_STAGE(PG8_SA(1, 1), a1, vAc[1]);
            PG8_WAIT_V(8); PG8_WAIT_L(0); PG8_BAR; PG8_MMA(0, 0, At, B0); PG8_MMA(0, 1, At, B1); PG8_BAR; PG8_SCHED;
            PG8_LDA(At, 0, 1); PG8_STAGE(PG8_SB(0, 0), b2, voffB); PG8_STAGE(PG8_SB(0, 1), b2 + bhstep, voffB); PG8_STAGE(PG8_SA(0, 0), a2, v2[0]);
            PG8_WAIT_V(8); PG8_WAIT_L(0); PG8_BAR; PG8_MMA(1, 0, At, B0); PG8_MMA(1, 1, At, B1); PG8_BAR; PG8_SCHED;
            PG8_LDB(B0, 1, 0); PG8_LDB(B1, 1, 1); PG8_SCHED; PG8_LDA(At, 1, 0); PG8_STAGE(PG8_SA(0, 1), a2, v2[1]);
            PG8_WAIT_V(8); PG8_WAIT_L(0); PG8_BAR; PG8_MMA(0, 0, At, B0); PG8_MMA(0, 1, At, B1); PG8_BAR; PG8_SCHED;
            PG8_LDA(At, 1, 1); PG8_STAGE(PG8_SB(1, 0), b3, voffB); PG8_STAGE(PG8_SB(1, 1), b3 + bhstep, voffB); PG8_STAGE(PG8_SA(1, 0), a3, v2[0]);
            PG8_WAIT_V(8); PG8_WAIT_L(0); PG8_BAR; PG8_MMA(1, 0, At, B0); PG8_MMA(1, 1, At, B1); PG8_BAR; PG8_SCHED;
        }
        if constexpr (ALIGN_EPI) { if (wr == 0) PG8_BAR; }
        E(acc, cur, wr, wc, fr, fq);
        if (!has_next) break;
        if constexpr (Epi::HAS_INIT) E.init(acc, nxt, wr, wc, fr, fq);
        else {
#pragma unroll
        for (int a = 0; a < 2; ++a)
#pragma unroll
            for (int b = 0; b < 2; ++b)
#pragma unroll
                for (int m = 0; m < 4; ++m)
#pragma unroll
                    for (int n = 0; n < 2; ++n) acc[a][b][m][n] = (f32x4){0.f, 0.f, 0.f, 0.f};
        }
        cur = nxt; cB = nB; ++ui;
#pragma unroll
        for (int h = 0; h < 2; ++h)
#pragma unroll
            for (int i = 0; i < 2; ++i) vAc[h][i] = vAn[h][i];
        if constexpr (ALIGN_EPI) { if (wr == 1) PG8_BAR; }
    }
    PG8_WAIT_V(0);
    if constexpr (!ALIGN_EPI) { if (wr == 0) PG8_BAR; }
    PG8_BAR;
#undef PG8_SA
#undef PG8_SB
#undef PG8_STAGE
#undef PG8_LDA
#undef PG8_LDB
#undef PG8_MMA
#undef PG8_WAIT_V
#undef PG8_WAIT_L
#undef PG8_BAR
#undef PG8_SCHED
#undef PG8_VOFFA
#undef PG8_BBASE
}

struct EpiInProj {
    static constexpr int PERM = 1; static constexpr bool HAS_INIT = false;
    const float* b_in; bf16 *QB, *KB, *VT, *UB, *GB;
    __device__ __forceinline__ void operator()(const f32x4 (&acc)[2][2][4][2], const Unit& u, int wr, int wc, int fr, int fq) const {
        const int row0 = u.pm * BM + wr * 64 + fr;
#pragma unroll
        for (int bj = 0; bj < 2; ++bj) {
            const int reg = u.pn * BM + bj * HALF;
            const int c0 = reg + wc * 32 + 8 * fq;
            const f32x4 bv0 = *(const f32x4*)(b_in + c0), bv1 = *(const f32x4*)(b_in + c0 + 4);
#pragma unroll
            for (int ai = 0; ai < 2; ++ai)
#pragma unroll
                for (int m = 0; m < 4; ++m) {
                    const int row = row0 + ai * HALF + m * 16;
                    f32x4 v0 = acc[ai][bj][m][0] + bv0, v1 = acc[ai][bj][m][1] + bv1;
                    if (reg >= 640 && reg < 768) {
                        const int cv = c0 - 640, gg = cv >> 6, d = cv & 63, b = row / SEQ, s = row % SEQ;
                        bf16* vp = VT + ((size_t)((b * 2 + gg) * 64 + d)) * SEQ + s;
#pragma unroll
                        for (int j = 0; j < 4; ++j) { vp[(size_t)j * SEQ] = (bf16)f2bf(v0[j]); vp[(size_t)(j + 4) * SEQ] = (bf16)f2bf(v1[j]); }
                    } else {
                        bf16* dst;
                        if (reg < 512) { v0 = v0 * C2; v1 = v1 * C2; dst = QB + (size_t)row * 512 + c0; }
                        else if (reg < 640) { dst = KB + (size_t)row * 128 + (c0 - 512); }
                        else {
#pragma unroll
                            for (int j = 0; j < 4; ++j) { v0[j] = fast_gelu(v0[j]); v1[j] = fast_gelu(v1[j]); }
                            dst = (reg < 1280) ? (UB + (size_t)row * 512 + (c0 - 768)) : (GB + (size_t)row * 512 + (c0 - 1280));
                        }
                        u32x4 w; w.x = cvt_pk_bf16(v0[0], v0[1]); w.y = cvt_pk_bf16(v0[2], v0[3]); w.z = cvt_pk_bf16(v1[0], v1[1]); w.w = cvt_pk_bf16(v1[2], v1[3]);
                        *(u32x4*)dst = w;
                    }
                }
        }
    }
};
struct EpiOutProj {
    static constexpr int PERM = 0; static constexpr bool HAS_INIT = true;
    const float* x; const float* b_out; float* Z;
    __device__ __forceinline__ void init(f32x4 (&acc)[2][2][4][2], const Unit& u, int wr, int wc, int fr, int fq) const {
        const int col0 = u.pn * BM + wc * 32 + 4 * fq;
#pragma unroll
        for (int ai = 0; ai < 2; ++ai)
#pragma unroll
            for (int m = 0; m < 4; ++m) {
                const size_t off = (size_t)(u.pm * BM + ai * HALF + wr * 64 + m * 16 + fr) * D + col0;
#pragma unroll
                for (int bj = 0; bj < 2; ++bj)
#pragma unroll
                    for (int n = 0; n < 2; ++n) acc[ai][bj][m][n] = *(const f32x4*)(x + off + bj * HALF + n * 16) * ALPHA + *(const f32x4*)(b_out + col0 + bj * HALF + n * 16);
            }
    }
    __device__ __forceinline__ void operator()(const f32x4 (&acc)[2][2][4][2], const Unit& u, int wr, int wc, int fr, int fq) const {
        const int col0 = u.pn * BM + wc * 32 + 4 * fq;
#pragma unroll
        for (int ai = 0; ai < 2; ++ai)
#pragma unroll
            for (int m = 0; m < 4; ++m) {
                const size_t off = (size_t)(u.pm * BM + ai * HALF + wr * 64 + m * 16 + fr) * D + col0;
#pragma unroll
                for (int bj = 0; bj < 2; ++bj)
#pragma unroll
                    for (int n = 0; n < 2; ++n) *(f32x4*)(Z + off + bj * HALF + n * 16) = acc[ai][bj][m][n];
            }
    }
};
struct EpiSwiglu {
    static constexpr int PERM = 1; static constexpr bool HAS_INIT = false;
    const LAS int* tbl; const float* b_gate; const float* b_up; const float* swgu; const float* el_sa; bf16* HID;
    __device__ __forceinline__ void operator()(const f32x4 (&acc)[2][2][4][2], const Unit& u, int wr, int wc, int fr, int fq) const {
        const int e = tbl[TBL_TILE + u.pm], p0 = (u.pm - tbl[TBL_TS + e]) * BM, ce = tbl[TBL_CNT + e];
        const int fc0 = u.pn * HALF + wc * 32 + 8 * fq;
        const float* sw = swgu + e * 2048 + u.pn * 256 + wc * 32 + 8 * fq;
        float sa[2][4];
#pragma unroll
        for (int ai = 0; ai < 2; ++ai)
#pragma unroll
            for (int m = 0; m < 4; ++m) { const int ix = p0 + ai * HALF + wr * 64 + m * 16 + fr; sa[ai][m] = ix < ce ? el_sa[e * T + ix] : 0.f; }
        f32x4 gb[2], ub[2], sg[2], su[2];
#pragma unroll
        for (int n = 0; n < 2; ++n) { gb[n] = *(const f32x4*)(b_gate + e * DFF + fc0 + 4 * n); ub[n] = *(const f32x4*)(b_up + e * DFF + fc0 + 4 * n); sg[n] = *(const f32x4*)(sw + 4 * n); su[n] = *(const f32x4*)(sw + 128 + 4 * n); }
#pragma unroll
        for (int ai = 0; ai < 2; ++ai)
#pragma unroll
            for (int m = 0; m < 4; ++m) {
                const int row = u.pm * BM + ai * HALF + wr * 64 + m * 16 + fr;
                float hv[8];
#pragma unroll
                for (int n = 0; n < 2; ++n)
#pragma unroll
                    for (int j = 0; j < 4; ++j) {
                        const float ga = (float)__float_as_int(acc[ai][0][m][n][j]) * (sa[ai][m] * sg[n][j]) + gb[n][j];
                        const float ua = (float)__float_as_int(acc[ai][1][m][n][j]) * (sa[ai][m] * su[n][j]) + ub[n][j];
                        const float gt = fminf(ga, 7.0f), up = __builtin_amdgcn_fmed3f(ua, -7.0f, 7.0f);
                        hv[4 * n + j] = gt * __builtin_amdgcn_rcpf(1.0f + __builtin_amdgcn_exp2f(-1.702f * LOG2E * gt)) * (up + 1.0f);
                    }
                u32x4 w; w.x = cvt_pk_bf16(hv[0], hv[1]); w.y = cvt_pk_bf16(hv[2], hv[3]); w.z = cvt_pk_bf16(hv[4], hv[5]); w.w = cvt_pk_bf16(hv[6], hv[7]);
                *(u32x4*)(HID + (size_t)row * DFF + fc0) = w;
            }
    }
};
struct EpiDown {
    static constexpr int PERM = 2; static constexpr bool HAS_INIT = false;
    const LAS int* tbl; const float* b_down; const float* swd; const float* row_sb; const float* el_gate; unsigned char* Y;
    __device__ __forceinline__ void operator()(const f32x4 (&acc)[2][2][4][2], const Unit& u, int wr, int wc, int fr, int fq) const {
        const int e = tbl[TBL_TILE + u.pm], p0 = (u.pm - tbl[TBL_TS + e]) * BM, ce = tbl[TBL_CNT + e];
        const int c0 = u.pn * BM + wc * 64 + 16 * fq;
        f32x4 bv[2][2], sw[2][2];
#pragma unroll
        for (int bj = 0; bj < 2; ++bj)
#pragma unroll
            for (int n = 0; n < 2; ++n) { bv[bj][n] = *(const f32x4*)(b_down + e * D + c0 + 8 * bj + 4 * n); sw[bj][n] = *(const f32x4*)(swd + e * D + c0 + 8 * bj + 4 * n); }
#pragma unroll
        for (int ai = 0; ai < 2; ++ai)
#pragma unroll
            for (int m = 0; m < 4; ++m) {
                const int row = u.pm * BM + ai * HALF + wr * 64 + m * 16 + fr;
                const int ix = p0 + ai * HALF + wr * 64 + m * 16 + fr;
                const float gt = (ix < ce ? el_gate[e * T + ix] : 0.f) * YSCALE, sb = row_sb[row] * gt;
                u32x4 w;
#pragma unroll
                for (int bj = 0; bj < 2; ++bj)
#pragma unroll
                    for (int n = 0; n < 2; ++n) {
                        float v[4];
#pragma unroll
                        for (int j = 0; j < 4; ++j) v[j] = __builtin_amdgcn_fmed3f((float)__float_as_int(acc[ai][bj][m][n][j]) * (sb * sw[bj][n][j]) + bv[bj][n][j] * gt, -448.0f, 448.0f);
                        int d = 0;
                        d = __builtin_amdgcn_cvt_pk_fp8_f32(v[0], v[1], d, false);
                        d = __builtin_amdgcn_cvt_pk_fp8_f32(v[2], v[3], d, true);
                        w[2 * bj + n] = (unsigned)d;
                    }
                *(u32x4*)(Y + (size_t)row * D + c0) = w;
            }
    }
};
}
constexpr int NWAVES = 8;
constexpr int NPHASES = 10;
constexpr size_t WS_WIN = WS_HID + 144 * MiB;
constexpr size_t WS_WOUT = WS_WIN + 4 * MiB;
constexpr size_t WS_WGU = WS_WOUT + 2 * MiB;
constexpr size_t WS_SWGU = WS_WGU + 64 * MiB;
constexpr size_t WS_WD = WS_SWGU + 1 * MiB;
constexpr size_t WS_SWD = WS_WD + 32 * MiB;
constexpr size_t WS_HID8 = WS_SWD + 1 * MiB;
constexpr size_t WS_END = WS_HID8 + 72 * MiB;
constexpr int CW_BAR = 4096;
constexpr int RING_BYTES = 131072;
constexpr int RTAB_OFF = RING_BYTES;
constexpr int RTAB_UNITS = 12;
constexpr int RW_BYTES = 1024 * 144;
constexpr int RSCR_OFF = RW_BYTES;
constexpr int LDS_BYTES = 163840;
constexpr int MISC_OFF = LDS_BYTES - 256;
static_assert(RTAB_OFF + RTAB_UNITS * 1024 <= MISC_OFF && RSCR_OFF + 4096 <= MISC_OFF, "LDS map");

typedef GAS unsigned gu32;
#define RLX_AGENT __ATOMIC_RELAXED, __HIP_MEMORY_SCOPE_AGENT
#define LDS_WAIT() asm volatile("s_waitcnt lgkmcnt(0)" ::: "memory")
#define VM_WAIT() asm volatile("s_waitcnt vmcnt(0)" ::: "memory")

#define XB_TMO      128
#define XB_XCNT(j)  (256  + 64 * (j))
#define XB_XSUB(j)  (1280 + 64 * (j))
#define XB_XGEN(j)  (2304 + 64 * (j))
#define XB_TOP      3328
#define XB_TOPGEN   3392
#define XCD_BAR_WORDS 3456
#define XB_SPIN_CAP (1u << 18)
__device__ __forceinline__ unsigned xb_ld(unsigned* p)              { return __hip_atomic_load(p, __ATOMIC_RELAXED, __HIP_MEMORY_SCOPE_AGENT); }
__device__ __forceinline__ unsigned xb_add(unsigned* p, unsigned v) { return __hip_atomic_fetch_add(p, v, __ATOMIC_RELAXED, __HIP_MEMORY_SCOPE_AGENT); }
__device__ __forceinline__ unsigned xb_xcc_id() { return (unsigned)__builtin_amdgcn_s_getreg((3 << 11) | 20) & 0xFu; }
#define XB_SPIN(cond, bar) do { unsigned _sp = 0; while (cond) { __builtin_amdgcn_s_sleep(1); \
    if ((++_sp & 255u) == 0u) { if (xb_ld(&(bar)[XB_TMO])) break; if (_sp > XB_SPIN_CAP) { atomicAdd(&(bar)[XB_TMO], 1u); break; } } } } while (0)
struct XcdBarrier { unsigned* bar; unsigned x; volatile LAS unsigned* st; };
__device__ __forceinline__ XcdBarrier xcd_barrier_post(unsigned* bar, volatile LAS unsigned* st) {
    XcdBarrier b; b.bar = bar; b.x = xb_xcc_id(); b.st = st;
    if (threadIdx.x == 0) (void)xb_add(&bar[XB_XCNT(b.x)], 1u);
    return b;
}
__device__ __forceinline__ void xcd_barrier_complete(unsigned* bar, unsigned x, unsigned& nloc, unsigned& nx) {
    const unsigned G = gridDim.x * gridDim.y * gridDim.z;
    unsigned sum, cnt, mine, sp = 0u;
    for (;;) {
        sum = 0u; cnt = 0u; mine = 0u;
#pragma unroll
        for (unsigned j = 0; j < 16; ++j) { const unsigned c = xb_ld(&bar[XB_XCNT(j)]); sum += c; cnt += (c > 0u) ? 1u : 0u; mine = (j == x) ? c : mine; }
        if (sum == G) break;
        __builtin_amdgcn_s_sleep(1);
        if ((++sp & 255u) == 0u) { if (xb_ld(&bar[XB_TMO])) break; if (sp > XB_SPIN_CAP) { atomicAdd(&bar[XB_TMO], 1u); break; } }
    }
    nloc = mine > 0u ? mine : 1u; nx = cnt > 0u ? cnt : 1u;
}
__device__ __forceinline__ void xcd_barrier(const XcdBarrier& b) {
    asm volatile("s_waitcnt vmcnt(0)" ::: "memory");
    __syncthreads();
    if (threadIdx.x == 0) {
        unsigned* bar = b.bar;
        __builtin_amdgcn_s_waitcnt(0);
        unsigned nloc = b.st[0], nx = b.st[1];
        if (nloc == 0u) { xcd_barrier_complete(bar, b.x, nloc, nx); b.st[0] = nloc; b.st[1] = nx; }
        const unsigned old = xb_add(&bar[XB_XSUB(b.x)], 1u);
        const unsigned gen = old / nloc;
        if (old + 1u == (gen + 1u) * nloc) {
            __builtin_amdgcn_fence(__ATOMIC_RELEASE, "agent");
            asm volatile("s_waitcnt vmcnt(0)" ::: "memory");
            const unsigned og = xb_add(&bar[XB_TOP], 1u);
            const unsigned tg = og / nx;
            if (og + 1u == (tg + 1u) * nx) xb_add(&bar[XB_TOPGEN], 1u);
            else XB_SPIN(xb_ld(&bar[XB_TOPGEN]) == tg, bar);
            __builtin_amdgcn_fence(__ATOMIC_ACQUIRE, "agent");
            xb_add(&bar[XB_XGEN(b.x)], 1u);
            asm volatile("s_waitcnt vmcnt(0)" ::: "memory");
        } else {
            XB_SPIN(xb_ld(&bar[XB_XGEN(b.x)]) == gen, bar);
            __builtin_amdgcn_fence(__ATOMIC_ACQUIRE, "agent");
            asm volatile("s_waitcnt vmcnt(0)" ::: "memory");
        }
    }
    __syncthreads();
}

struct Args {
    const float* in[22]; float* out; unsigned char* ws; int ph_lo, ph_hi, li, pad;
};
struct Frame {
    LAS unsigned char* lds;
    int tid, lane, wave, vcu, G;
};
__device__ __forceinline__ void p0_item(const float* W, int N, bf16* WT, int K, int dst_row0, int k0, int n0, LAS float* scr, int lane) {
    f32x4 v[8];
#pragma unroll
    for (int i = 0; i < 8; ++i) v[i] = *(const f32x4*)(W + (size_t)(k0 + (lane >> 3) + 8 * i) * N + n0 + 4 * (lane & 7));
#pragma unroll
    for (int i = 0; i < 8; ++i) { LAS float* s = scr + ((lane >> 3) + 8 * i) * 33 + 4 * (lane & 7); s[0] = v[i].x; s[1] = v[i].y; s[2] = v[i].z; s[3] = v[i].w; }
    LDS_WAIT(); asm volatile("" ::: "memory");
    const int c = lane & 7;
#pragma unroll
    for (int j = 0; j < 4; ++j) { const int n = (lane >> 3) + 8 * j; const LAS float* s = scr + (8 * c) * 33 + n;
        u32x4 o; o.x = pk2(s[0 * 33], s[1 * 33]); o.y = pk2(s[2 * 33], s[3 * 33]); o.z = pk2(s[4 * 33], s[5 * 33]); o.w = pk2(s[6 * 33], s[7 * 33]);
        *(u32x4*)(WT + (size_t)(dst_row0 + n) * K + k0 + 8 * c) = o; }
    LDS_WAIT(); asm volatile("" ::: "memory");
}
struct ConvItem { const float* W; signed char* dst; float* sc; int n0, dst_row0; };
__device__ __forceinline__ ConvItem conv_decode(const Args& a, int it) {
    unsigned char* ws = a.ws;
    const int nb = it & 31, e = (it >> 5) & 31, kind = it >> 10, n0 = nb * 32;
    ConvItem c;
    c.W = (kind == 0 ? a.in[14] : kind == 1 ? a.in[16] : a.in[18]) + (size_t)e * D * DFF;
    c.dst = kind < 2 ? (signed char*)(ws + WS_WGU) + (size_t)e * 2048 * 1024 : (signed char*)(ws + WS_WD) + (size_t)e * 1024 * 1024;
    c.dst_row0 = kind < 2 ? (n0 >> 7) * 256 + kind * 128 + (n0 & 127) : n0;
    c.sc = kind < 2 ? (float*)(ws + WS_SWGU) + e * 2048 : (float*)(ws + WS_SWD) + e * 1024;
    c.n0 = n0; return c;
}
#define CONV_LOAD(v, ci) do { _Pragma("unroll") for (int i_ = 0; i_ < 4; ++i_) _Pragma("unroll") for (int j_ = 0; j_ < 4; ++j_) \
        v[i_][j_] = *(const f32x4*)((ci).W + (size_t)(4 * (kl + 64 * i_) + j_) * DFF + (ci).n0 + 4 * n4); } while (0)
__device__ __forceinline__ void conv_items(const Frame& F, const Args& a, int it_lo, int it_hi) {
    if (it_hi > 3 * NEXP * 32) it_hi = 3 * NEXP * 32;
    if (it_lo >= it_hi) return;
    const int tid = F.tid, n4 = tid & 7, kl = tid >> 3;
    LAS unsigned* tile = (LAS unsigned*)F.lds;
    LAS float* red = (LAS float*)(F.lds + 36864);
    f32x4 v[4][4];
    ConvItem cur = conv_decode(a, it_lo);
    CONV_LOAD(v, cur);
    for (int it = it_lo; it < it_hi; ++it) {
        f32x4 am = (f32x4){0.f, 0.f, 0.f, 0.f};
#pragma unroll
        for (int i = 0; i < 4; ++i)
#pragma unroll
            for (int j = 0; j < 4; ++j) { am.x = fmaxf(am.x, fabsf(v[i][j].x)); am.y = fmaxf(am.y, fabsf(v[i][j].y)); am.z = fmaxf(am.z, fabsf(v[i][j].z)); am.w = fmaxf(am.w, fabsf(v[i][j].w)); }
#pragma unroll
        for (int o = 8; o < 64; o <<= 1) { am.x = fmaxf(am.x, __shfl_xor(am.x, o)); am.y = fmaxf(am.y, __shfl_xor(am.y, o)); am.z = fmaxf(am.z, __shfl_xor(am.z, o)); am.w = fmaxf(am.w, __shfl_xor(am.w, o)); }
        if (F.lane < 8) *(LAS f32x4*)(red + F.wave * 32 + 4 * n4) = am;
        __syncthreads();
        f32x4 cm = *(const LAS f32x4*)(red + 4 * n4);
#pragma unroll
        for (int w = 1; w < 8; ++w) { const f32x4 o = *(const LAS f32x4*)(red + w * 32 + 4 * n4); cm.x = fmaxf(cm.x, o.x); cm.y = fmaxf(cm.y, o.y); cm.z = fmaxf(cm.z, o.z); cm.w = fmaxf(cm.w, o.w); }
        f32x4 inv;
#pragma unroll
        for (int c = 0; c < 4; ++c) inv[c] = cm[c] > 0.f ? 127.0f / cm[c] : 0.f;
        if (kl == 0) {
#pragma unroll
            for (int c = 0; c < 4; ++c) cur.sc[cur.dst_row0 + 4 * n4 + c] = cm[c] * (1.0f / 127.0f);
        }
#pragma unroll
        for (int i = 0; i < 4; ++i)
#pragma unroll
            for (int c = 0; c < 4; ++c) {
                unsigned d = 0u;
#pragma unroll
                for (int j = 0; j < 4; ++j) { const int q = (int)rintf(v[i][j][c] * inv[c]); d |= ((unsigned)q & 0xffu) << (8 * j); }
                tile[(4 * n4 + c) * 260 + kl + 64 * i] = d;
            }
        const ConvItem done = cur;
        if (it + 1 < it_hi) { cur = conv_decode(a, it + 1); CONV_LOAD(v, cur); }
        __syncthreads();
#pragma unroll
        for (int j = 0; j < 4; ++j) { const int ch = tid + 512 * j, n = ch >> 6, c16 = ch & 63;
            *(u32x4*)(done.dst + (size_t)(done.dst_row0 + n) * 1024 + 16 * c16) = *(const LAS u32x4*)(tile + n * 260 + 4 * c16); }
        __syncthreads();
    }
}
__device__ __forceinline__ void p0_prologue(const Frame& F, const Args& a) {
    unsigned char* ws = a.ws;
    bf16* Win_t = (bf16*)(ws + WS_WIN); bf16* Wout_t = (bf16*)(ws + WS_WOUT);
    LAS float* scr = (LAS float*)(F.lds + F.wave * 8448);
    const int gw = F.vcu * NWAVES + F.wave, NGW = F.G * NWAVES;
    constexpr int I_IN = 16 * 56, I_OUT = 16 * 32, NITEMS = I_IN + I_OUT;
    for (int it = gw; it < NITEMS; it += NGW) {
        int r = it;
        if (r < I_IN) { const int kb = r / 56, nb = r % 56; p0_item(a.in[1], INW, Win_t, D, nb * 32, kb * 64, nb * 32, scr, F.lane); continue; } r -= I_IN;
        { const int kb = r / 32, nb = r % 32; p0_item(a.in[8], D, Wout_t, D, nb * 32, kb * 64, nb * 32, scr, F.lane); }
    }
    const float* x = a.in[0]; bf16* XB = (bf16*)(ws + WS_XB);
    for (int m = gw; m < T; m += NGW) {
        const f32x4* xr = (const f32x4*)(x + (size_t)m * D) + F.lane; u32x2* o = (u32x2*)(XB + (size_t)m * D) + F.lane;
        f32x4 v[4];
#pragma unroll
        for (int j = 0; j < 4; ++j) v[j] = xr[64 * j];
#pragma unroll
        for (int j = 0; j < 4; ++j) { u32x2 w; w.x = pk2(v[j].x, v[j].y); w.y = pk2(v[j].z, v[j].w); o[64 * j] = w; }
    }
}

__device__ __forceinline__ int crow(int r, int hi) { return (r & 3) + 8 * (r >> 2) + 4 * hi; }
constexpr int AT_KROW = 144, AT_KG = 192 * AT_KROW, AT_VROW = 400, AT_VG = 64 * AT_VROW, AT_VOFF = 2 * AT_KG;
__device__ __forceinline__ void attn_wave_unit(const LAS unsigned char* lds, const bf16x8 (&qf)[4], const float sk, bf16* CAT, int tok0, int u, int h, int lane) {
    const int r32 = lane & 31, hi = lane >> 5;
    const int t0 = tok0 % SEQ, g = h >> 2;
    const int kk0 = 32 * u;
    f32x16 p[5];
    const float NEG = -INFINITY;
    const LAS unsigned char* kl = lds + g * AT_KG + (kk0 + r32) * AT_KROW + hi * 16;
#pragma unroll
    for (int j = 0; j < 5; ++j) {
        const int kb = t0 - 128 + 32 * j;
        f32x16 s;
#pragma unroll
        for (int r = 0; r < 16; ++r) s[r] = 0.f;
        if (kb >= 0) {
#pragma unroll
            for (int d0 = 0; d0 < 4; ++d0) { const bf16x8 kf = *(const LAS bf16x8*)(kl + j * 32 * AT_KROW + d0 * 32); s = __builtin_amdgcn_mfma_f32_32x32x16_bf16(kf, qf[d0], s, 0, 0, 0); }
            if (j == 0) {
#pragma unroll
                for (int r = 0; r < 16; ++r) if (!(crow(r, hi) > r32)) s[r] = NEG;
            }
            if (j == 4) {
#pragma unroll
                for (int r = 0; r < 16; ++r) if (!(crow(r, hi) <= r32)) s[r] = NEG;
            }
        } else {
#pragma unroll
            for (int r = 0; r < 16; ++r) s[r] = NEG;
        }
        p[j] = s;
    }
    float m = sk;
#pragma unroll
    for (int j = 0; j < 5; ++j)
#pragma unroll
        for (int r = 0; r < 16; ++r) m = fmaxf(m, p[j][r]);
    m = fmaxf(m, __shfl_xor(m, 32));
    float l = 0.f;
#pragma unroll
    for (int j = 0; j < 5; ++j)
#pragma unroll
        for (int r = 0; r < 16; ++r) { const float e = __builtin_amdgcn_exp2f(p[j][r] - m); p[j][r] = e; l += e; }
    l += __shfl_xor(l, 32);
    l += __builtin_amdgcn_exp2f(sk - m);
    const float inv = 1.0f / l;
    u32x4 pb[5][2];
#pragma unroll
    for (int j = 0; j < 5; ++j)
#pragma unroll
        for (int s = 0; s < 2; ++s) { pb[j][s].x = cvt_pk_bf16(p[j][8 * s + 0], p[j][8 * s + 1]); pb[j][s].y = cvt_pk_bf16(p[j][8 * s + 2], p[j][8 * s + 3]); pb[j][s].z = cvt_pk_bf16(p[j][8 * s + 4], p[j][8 * s + 5]); pb[j][s].w = cvt_pk_bf16(p[j][8 * s + 6], p[j][8 * s + 7]); }
#pragma unroll
    for (int db = 0; db < 2; ++db) {
        f32x16 o;
#pragma unroll
        for (int r = 0; r < 16; ++r) o[r] = 0.f;
        const LAS unsigned char* vl = lds + AT_VOFF + g * AT_VG + (db * 32 + r32) * AT_VROW + (kk0 + 4 * hi) * 2;
#pragma unroll
        for (int j = 0; j < 5; ++j) {
            const int kb = t0 - 128 + 32 * j;
            if (kb >= 0) {
#pragma unroll
                for (int s = 0; s < 2; ++s) {
                    const u32x2 lo = *(const LAS u32x2*)(vl + (32 * j + 16 * s) * 2), hh = *(const LAS u32x2*)(vl + (32 * j + 16 * s + 8) * 2);
                    u32x4 av; av.x = lo.x; av.y = lo.y; av.z = hh.x; av.w = hh.y;
                    o = __builtin_amdgcn_mfma_f32_32x32x16_bf16(__builtin_bit_cast(bf16x8, av), __builtin_bit_cast(bf16x8, pb[j][s]), o, 0, 0, 0);
                }
            }
        }
        bf16* op = CAT + (size_t)(tok0 + r32) * 1024 + h * 64 + db * 32 + 4 * hi;
#pragma unroll
        for (int gq = 0; gq < 4; ++gq) { u32x2 w; w.x = cvt_pk_bf16(o[4 * gq] * inv, o[4 * gq + 1] * inv); w.y = cvt_pk_bf16(o[4 * gq + 2] * inv, o[4 * gq + 3] * inv); *(u32x2*)(op + 8 * gq) = w; }
    }
}
__device__ __forceinline__ void attn_block(const Frame& F, const bf16* QB, const bf16* KB, const bf16* VT, const float* sinks, bf16* CAT, int qq) {
    const int tokb = qq * 64, b = tokb / SEQ, tb = tokb % SEQ, kbase = tb - 128;
    u32x4 kv[6], vv[6];
    bf16x8 qf0[4], qf1[4];
    { const int r32 = F.lane & 31, hi = F.lane >> 5;
#pragma unroll
      for (int d0 = 0; d0 < 4; ++d0) { qf0[d0] = *(const bf16x8*)(QB + (size_t)(tokb + r32) * 512 + F.wave * 64 + d0 * 16 + hi * 8); qf1[d0] = *(const bf16x8*)(QB + (size_t)(tokb + 32 + r32) * 512 + F.wave * 64 + d0 * 16 + hi * 8); } }
    const float sk = sinks[F.wave] * LOG2E;
#pragma unroll
    for (int i = 0; i < 6; ++i) {
        const int c = F.tid + 512 * i, g = c / 1536, rem = c % 1536;
        { const int key = rem >> 3, ch = rem & 7, pos = kbase + key;
          kv[i] = pos >= 0 ? *(const u32x4*)(KB + (size_t)(b * SEQ + pos) * 128 + g * 64 + ch * 8) : (u32x4){0u, 0u, 0u, 0u}; }
        { const int d = rem / 24, ch = rem % 24, pos = kbase + ch * 8;
          vv[i] = pos >= 0 ? *(const u32x4*)(VT + ((size_t)((b * 2 + g) * 64 + d)) * SEQ + pos) : (u32x4){0u, 0u, 0u, 0u}; }
    }
#pragma unroll
    for (int i = 0; i < 6; ++i) {
        const int c = F.tid + 512 * i, g = c / 1536, rem = c % 1536;
        *(LAS u32x4*)(F.lds + g * AT_KG + (rem >> 3) * AT_KROW + (rem & 7) * 16) = kv[i];
        *(LAS u32x4*)(F.lds + AT_VOFF + g * AT_VG + (rem / 24) * AT_VROW + (rem % 24) * 16) = vv[i];
    }
    __syncthreads();
    attn_wave_unit(F.lds, qf0, sk, CAT, tokb, 0, F.wave, F.lane);
    attn_wave_unit(F.lds, qf1, sk, CAT, tokb + 32, 1, F.wave, F.lane);
    __syncthreads();
}
template <int CTRL> __device__ __forceinline__ float dppq(float v) { return __builtin_bit_cast(float, __builtin_amdgcn_update_dpp(0, __builtin_bit_cast(int, v), CTRL, 0xF, 0xF, true)); }
constexpr int SG_WOFF = 20480, SG_WROW = 272;
__device__ __forceinline__ void sgu_stage_w(const Frame& F, const float* w_s, int gi) {
    f32x4 w[8];
#pragma unroll
    for (int i = 0; i < 8; ++i) w[i] = *(const f32x4*)(w_s + (size_t)gi * 16384 + (size_t)(F.tid + 512 * i) * 4);
#pragma unroll
    for (int i = 0; i < 8; ++i) { const int c = F.tid + 512 * i, t = c >> 5, s0 = (c & 31) * 4;
        f32x4 v = w[i];
#pragma unroll
        for (int j = 0; j < 4; ++j) if (s0 + j > t) v[j] = 0.f;
        u32x2 o; o.x = cvt_pk_bf16(v[0], v[1]); o.y = cvt_pk_bf16(v[2], v[3]);
        *(LAS u32x2*)(F.lds + SG_WOFF + t * SG_WROW + s0 * 2) = o; }
}
__device__ __forceinline__ void sgu_unit(const Frame& F, const bf16* UB, const bf16* GB, const float* ln_g, const float* ln_b, const float* w_s, const float* b_s, bf16* CAT, int ch, int gi) {
    LAS bf16* GT = (LAS bf16*)F.lds;
    const int r32 = F.lane & 31, hi = F.lane >> 5, tb = F.wave >> 1, db = F.wave & 1, t = tb * 32 + r32;
    const int nks = 2 * (tb + 1);
    const int s = F.tid >> 2, q4 = F.tid & 3; const size_t tok = (size_t)ch * 128 + s;
    const u32x4* gp = (const u32x4*)(GB + tok * 512 + gi * 64 + q4 * 16);
    const u32x4 a = gp[0], c = gp[1];
    const size_t tokt = (size_t)ch * 128 + t;
    const bf16* up = UB + tokt * 512 + gi * 64 + db * 32 + 4 * hi;
    u32x2 uu[4];
#pragma unroll
    for (int gq = 0; gq < 4; ++gq) uu[gq] = *(const u32x2*)(up + 8 * gq);
    const float bb = b_s[gi * 128 + t];
    float lg_[16], lb_[16];
#pragma unroll
    for (int i = 0; i < 16; ++i) { lg_[i] = ln_g[gi * 64 + q4 * 16 + i]; lb_[i] = ln_b[gi * 64 + q4 * 16 + i]; }
    {
        float v[16];
        v[0] = __uint_as_float(a.x << 16); v[1] = __uint_as_float(a.x & 0xffff0000u); v[2] = __uint_as_float(a.y << 16); v[3] = __uint_as_float(a.y & 0xffff0000u);
        v[4] = __uint_as_float(a.z << 16); v[5] = __uint_as_float(a.z & 0xffff0000u); v[6] = __uint_as_float(a.w << 16); v[7] = __uint_as_float(a.w & 0xffff0000u);
        v[8] = __uint_as_float(c.x << 16); v[9] = __uint_as_float(c.x & 0xffff0000u); v[10] = __uint_as_float(c.y << 16); v[11] = __uint_as_float(c.y & 0xffff0000u);
        v[12] = __uint_as_float(c.z << 16); v[13] = __uint_as_float(c.z & 0xffff0000u); v[14] = __uint_as_float(c.w << 16); v[15] = __uint_as_float(c.w & 0xffff0000u);
        float sum = 0.f;
#pragma unroll
        for (int i = 0; i < 16; ++i) sum += v[i];
        sum += dppq<0xB1>(sum); sum += dppq<0x4E>(sum);
        const float mu = sum * (1.f / 64.f); float q = 0.f;
#pragma unroll
        for (int i = 0; i < 16; ++i) { v[i] -= mu; q += v[i] * v[i]; }
        q += dppq<0xB1>(q); q += dppq<0x4E>(q);
        const float rstd = rsqrtf(q * (1.f / 64.f) + LN_EPS);
#pragma unroll
        for (int i = 0; i < 16; ++i) { const int d = q4 * 16 + i; GT[d * 136 + s] = (bf16)f2bf(v[i] * rstd * lg_[i] + lb_[i]); }
    }
    __syncthreads();
    {
        f32x16 acc;
#pragma unroll
        for (int r = 0; r < 16; ++r) acc[r] = 0.f;
        const LAS bf16* arow = GT + (db * 32 + r32) * 136 + hi * 8;
        const LAS unsigned char* wlds = F.lds + SG_WOFF + t * SG_WROW + hi * 16;
#pragma unroll
        for (int ks = 0; ks < 8; ++ks) if (ks < nks) {
            const bf16x8 af = *(const LAS bf16x8*)(arow + ks * 16);
            const bf16x8 bw = *(const LAS bf16x8*)(wlds + ks * 32);
            acc = __builtin_amdgcn_mfma_f32_32x32x16_bf16(af, bw, acc, 0, 0, 0);
        }
        bf16* op = CAT + tokt * 1024 + 512 + gi * 64 + db * 32 + 4 * hi;
#pragma unroll
        for (int gq = 0; gq < 4; ++gq) {
            const float u0 = __uint_as_float(uu[gq].x << 16), u1 = __uint_as_float(uu[gq].x & 0xffff0000u), u2 = __uint_as_float(uu[gq].y << 16), u3 = __uint_as_float(uu[gq].y & 0xffff0000u);
            u32x2 w; w.x = cvt_pk_bf16(u0 * (acc[4 * gq] + bb), u1 * (acc[4 * gq + 1] + bb)); w.y = cvt_pk_bf16(u2 * (acc[4 * gq + 2] + bb), u3 * (acc[4 * gq + 3] + bb));
            *(u32x2*)(op + 8 * gq) = w;
        }
    }
    __syncthreads();
}
__device__ __forceinline__ void p2_mixers(const Frame& F, const Args& a) {
    unsigned char* ws = a.ws;
    const bf16 *QB = (const bf16*)(ws + WS_QB), *KB = (const bf16*)(ws + WS_KB), *VT = (const bf16*)(ws + WS_VT), *UB = (const bf16*)(ws + WS_UB), *GB = (const bf16*)(ws + WS_GB);
    bf16* CAT = (bf16*)(ws + WS_CAT);
    for (int qq = F.vcu; qq < T / 64; qq += F.G) attn_block(F, QB, KB, VT, a.in[3], CAT, qq);
    int gi_staged = -1;
    for (int u = F.vcu; u < (T / 128) * 8; u += F.G) {
        if ((u & 7) != gi_staged) { __syncthreads(); sgu_stage_w(F, a.in[6], u & 7); gi_staged = u & 7; }
        sgu_unit(F, UB, GB, a.in[4], a.in[5], a.in[6], a.in[7], CAT, u >> 3, u & 7);
    }
}

template <int CTRL> __device__ __forceinline__ float dppf(float v) { return __builtin_bit_cast(float, __builtin_amdgcn_update_dpp(0, __builtin_bit_cast(int, v), CTRL, 0xF, 0xF, true)); }
__device__ __forceinline__ float swap16_sum(float x, float y) { auto r = __builtin_amdgcn_permlane16_swap(__builtin_bit_cast(unsigned, x), __builtin_bit_cast(unsigned, y), false, false); return __builtin_bit_cast(float, r[0]) + __builtin_bit_cast(float, r[1]); }
__device__ __forceinline__ float swap32_sum(float x, float y) { auto r = __builtin_amdgcn_permlane32_swap(__builtin_bit_cast(unsigned, x), __builtin_bit_cast(unsigned, y), false, false); return __builtin_bit_cast(float, r[0]) + __builtin_bit_cast(float, r[1]); }
__device__ __forceinline__ float rdlane(float v, int l) { return __builtin_bit_cast(float, __builtin_amdgcn_readlane(__builtin_bit_cast(int, v), l)); }
__device__ __forceinline__ float xsum(float v) {
    v += dppf<0xB1>(v); v += dppf<0x4E>(v); v += dppf<0x124>(v); v += dppf<0x128>(v);
    return (rdlane(v, 0) + rdlane(v, 16)) + (rdlane(v, 32) + rdlane(v, 48));
}
__device__ __forceinline__ float xmax(float v) {
    v = fmaxf(v, dppf<0xB1>(v)); v = fmaxf(v, dppf<0x4E>(v)); v = fmaxf(v, dppf<0x124>(v)); v = fmaxf(v, dppf<0x128>(v));
    return fmaxf(fmaxf(rdlane(v, 0), rdlane(v, 16)), fmaxf(rdlane(v, 32), rdlane(v, 48)));
}
__device__ __forceinline__ void p4_router(const Frame& F, const Args& a, bool commit) {
    const float* Zin = a.out; bf16* Hout = (bf16*)(a.ws + WS_H); signed char* HB8 = (signed char*)(a.ws + WS_HB); int* meta = (int*)(a.ws + WS_META); unsigned* cnt = (unsigned*)(a.ws + WS_CTL) + CW_CNT;
    const float* ln1_g = a.in[10]; const float* ln1_b = a.in[11]; const float* w_r = a.in[12]; const float* b_r = a.in[13];
    LAS float* W = (LAS float*)F.lds;
    LAS unsigned* hist = (LAS unsigned*)(F.lds + RSCR_OFF);
    LAS unsigned* base = hist + 32;
    LAS int* tmp_e = (LAS int*)(hist + 64);
    LAS int* tmp_p = tmp_e + 256;
    LAS float* tmp_g = (LAS float*)(tmp_p + 256);
    LAS float* tmp_s = tmp_g + 256;
    int* el_tok = (int*)(a.ws + WS_ELIST); float* el_gate = (float*)(a.ws + WS_ELIST) + NEXP * T; float* el_sa = el_gate + NEXP * T;
    {
        f32x4 t[16];
#pragma unroll
        for (int k = 0; k < 16; ++k) t[k] = *(const f32x4*)(w_r + (size_t)(F.tid + 512 * k) * 4);
#pragma unroll
        for (int k = 0; k < 16; ++k) { const int i = F.tid + 512 * k, c = i >> 3, e4 = i & 7, pr = (c & ~255) + 64 * (c & 3) + ((c >> 2) & 63); *(LAS f32x4*)(W + pr * 36 + e4 * 4) = t[k]; }
    }
    const int lane = F.lane, half = lane >> 5, el = lane & 31;
    LAS float* gbl = (LAS float*)(F.lds + 151552);
    for (int i = F.tid; i < 512; i += NWAVES * 64) *(LAS f32x4*)(gbl + 4 * i) = i < 256 ? *(const f32x4*)(ln1_g + 4 * i) : *(const f32x4*)(ln1_b + 4 * (i - 256));
    for (int tb = F.vcu; tb < T / 64; tb += F.G) {
        if (F.tid < 32) hist[F.tid] = 0u;
        __syncthreads();
        float zn0[16], zn1[16];
        { const f32x4* z0 = (const f32x4*)(Zin + (size_t)(tb * 64 + 8 * F.wave) * D) + lane;
#pragma unroll
          for (int j = 0; j < 4; ++j) { const f32x4 a0 = z0[64 * j], a1 = z0[256 + 64 * j];
#pragma unroll
            for (int k = 0; k < 4; ++k) { zn0[4 * j + k] = a0[k]; zn1[4 * j + k] = a1[k]; } } }
        for (int pp = 0; pp < 4; ++pp) {
            const int tl0 = 8 * F.wave + 2 * pp;
            const int tok0 = tb * 64 + tl0;
            float h0[16], h1[16];
            {
                u32x2* ho0 = (u32x2*)(Hout + (size_t)tok0 * D) + lane; u32x2* ho1 = ho0 + 256;
                float s0 = 0.f, s1 = 0.f, q0 = 0.f, q1 = 0.f;
#pragma unroll
                for (int i = 0; i < 16; ++i) { h0[i] = zn0[i]; h1[i] = zn1[i]; }
                if (pp < 3) { const f32x4* zp = (const f32x4*)(Zin + (size_t)(tok0 + 2) * D) + lane;
#pragma unroll
                    for (int j = 0; j < 4; ++j) { const f32x4 a0 = zp[64 * j], a1 = zp[256 + 64 * j];
#pragma unroll
                        for (int k = 0; k < 4; ++k) { zn0[4 * j + k] = a0[k]; zn1[4 * j + k] = a1[k]; } } }
#pragma unroll
                for (int i = 0; i < 16; ++i) { s0 += h0[i]; s1 += h1[i]; q0 += h0[i] * h0[i]; q1 += h1[i] * h1[i]; }
                s0 = xsum(s0); s1 = xsum(s1); q0 = xsum(q0); q1 = xsum(q1);
                const float m0 = s0 * (1.f / D), m1 = s1 * (1.f / D);
                const float r0 = rsqrtf(fmaxf(q0 * (1.f / D) - m0 * m0, 0.f) + LN_EPS), r1 = rsqrtf(fmaxf(q1 * (1.f / D) - m1 * m1, 0.f) + LN_EPS);
                float a0 = 0.f, a1 = 0.f;
#pragma unroll
                for (int i = 0; i < 16; ++i) {
                    const float gm_ = gbl[4 * lane + 256 * (i >> 2) + (i & 3)], bt_ = gbl[1024 + 4 * lane + 256 * (i >> 2) + (i & 3)];
                    h0[i] = (h0[i] - m0) * r0 * gm_ + bt_; h1[i] = (h1[i] - m1) * r1 * gm_ + bt_;
                    a0 = fmaxf(a0, fabsf(h0[i])); a1 = fmaxf(a1, fabsf(h1[i]));
                }
                a0 = xmax(a0); a1 = xmax(a1);
                const float i0 = a0 > 0.f ? 127.0f / a0 : 0.f, i1 = a1 > 0.f ? 127.0f / a1 : 0.f;
                unsigned* hb0 = (unsigned*)(HB8 + (size_t)tok0 * D) + lane; unsigned* hb1 = hb0 + 256;
#pragma unroll
                for (int j = 0; j < 4; ++j) {
                    { u32x2 w0, w1; w0.x = cvt_pk_bf16(h0[4 * j], h0[4 * j + 1]); w0.y = cvt_pk_bf16(h0[4 * j + 2], h0[4 * j + 3]); w1.x = cvt_pk_bf16(h1[4 * j], h1[4 * j + 1]); w1.y = cvt_pk_bf16(h1[4 * j + 2], h1[4 * j + 3]); ho0[64 * j] = w0; ho1[64 * j] = w1; }
                    unsigned p0 = 0u, p1 = 0u;
#pragma unroll
                    for (int k = 0; k < 4; ++k) { p0 |= ((unsigned)(int)rintf(h0[4 * j + k] * i0) & 0xffu) << (8 * k); p1 |= ((unsigned)(int)rintf(h1[4 * j + k] * i1) & 0xffu) << (8 * k); }
                    hb0[64 * j] = p0; hb1[64 * j] = p1;
                }
                if (lane == 0) { tmp_s[tl0] = a0 * (1.0f / 127.0f); tmp_s[tl0 + 1] = a1 * (1.0f / 127.0f); }
            }
            f32x2 lp0[16], lp1[16];
#pragma unroll
            for (int e = 0; e < 16; ++e) { lp0[e] = (f32x2){0.f, 0.f}; lp1[e] = (f32x2){0.f, 0.f}; }
#pragma unroll
            for (int i = 0; i < 16; ++i) {
                const LAS f32x4* wr = (const LAS f32x4*)(W + (256 * (i >> 2) + 64 * (i & 3) + lane) * 36);
                const f32x2 hv0 = (f32x2){h0[i], h0[i]}, hv1 = (f32x2){h1[i], h1[i]};
#pragma unroll
                for (int e4 = 0; e4 < 8; ++e4) {
                    const f32x4 ww = wr[e4];
                    const f32x2 wlo = (f32x2){ww.x, ww.y}, whi = (f32x2){ww.z, ww.w};
                    lp0[2 * e4] = __builtin_elementwise_fma(hv0, wlo, lp0[2 * e4]); lp0[2 * e4 + 1] = __builtin_elementwise_fma(hv0, whi, lp0[2 * e4 + 1]);
                    lp1[2 * e4] = __builtin_elementwise_fma(hv1, wlo, lp1[2 * e4]); lp1[2 * e4 + 1] = __builtin_elementwise_fma(hv1, whi, lp1[2 * e4 + 1]);
                }
            }
            float lg0[32], lg1[32];
#pragma unroll
            for (int e = 0; e < 16; ++e) { lg0[2 * e] = lp0[e].x; lg0[2 * e + 1] = lp0[e].y; lg1[2 * e] = lp1[e].x; lg1[2 * e + 1] = lp1[e].y; }
            float v32[32];
#pragma unroll
            for (int e = 0; e < 32; ++e) { const float keep = half ? lg1[e] : lg0[e], send = half ? lg0[e] : lg1[e]; v32[e] = keep + __shfl_xor(send, 32); }
            float v16[16];
#pragma unroll
            for (int e = 0; e < 16; ++e) { const bool up = (lane & 16) != 0; const float keep = up ? v32[e + 16] : v32[e], send = up ? v32[e] : v32[e + 16]; v16[e] = keep + __shfl_xor(send, 16); }
            float v8[8];
#pragma unroll
            for (int e = 0; e < 8; ++e) { const bool up = (lane & 8) != 0; const float keep = up ? v16[e + 8] : v16[e], send = up ? v16[e] : v16[e + 8]; v8[e] = keep + dppf<0x128>(send); }
            float v4[4];
#pragma unroll
            for (int e = 0; e < 4; ++e) { const bool up = (lane & 4) != 0; const float keep = up ? v8[e + 4] : v8[e], send = up ? v8[e] : v8[e + 4]; v4[e] = keep + dppf<0x1B>(dppf<0x141>(send)); }
            float v2[2];
#pragma unroll
            for (int e = 0; e < 2; ++e) { const bool up = (lane & 2) != 0; const float keep = up ? v4[e + 2] : v4[e], send = up ? v4[e] : v4[e + 2]; v2[e] = keep + dppf<0x4E>(send); }
            float lgt;
            { const bool up = (lane & 1) != 0; const float keep = up ? v2[1] : v2[0], send = up ? v2[0] : v2[1]; lgt = keep + dppf<0xB1>(send); }
            lgt += b_r[el];
            float bv[4]; int bi[4];
            {
                float cur = lgt;
#pragma unroll
                for (int k = 0; k < 4; ++k) {
                    float mx = cur;
                    mx = fmaxf(mx, dppf<0xB1>(mx)); mx = fmaxf(mx, dppf<0x4E>(mx)); mx = fmaxf(mx, dppf<0x124>(mx)); mx = fmaxf(mx, dppf<0x128>(mx));
                    const float m0 = fmaxf(rdlane(mx, 0), rdlane(mx, 16)), m1 = fmaxf(rdlane(mx, 32), rdlane(mx, 48));
                    const float mm = half ? m1 : m0;
                    const unsigned long long mk = __ballot(cur == mm);
                    const int i0 = __builtin_ctz((unsigned)mk | 0x80000000u), i1 = __builtin_ctz((unsigned)(mk >> 32) | 0x80000000u);
                    bv[k] = mm; bi[k] = half ? i1 : i0;
                    if (el == bi[k]) cur = -INFINITY;
                }
            }
            float ex[4], es = 0.f;
#pragma unroll
            for (int k = 0; k < 4; ++k) { ex[k] = __expf(bv[k] - bv[0]); es += ex[k]; }
            if (el == 0) {
                const int tl = tl0 + half;
#pragma unroll
                for (int k = 0; k < 4; ++k) { const unsigned pl = atomicAdd((unsigned*)&hist[bi[k]], 1u); tmp_e[tl * 4 + k] = bi[k]; tmp_p[tl * 4 + k] = (int)pl; tmp_g[tl * 4 + k] = ex[k] / es; }
            }
        }
        __syncthreads();
        if (F.tid < 32) base[F.tid] = commit ? atomicAdd(&cnt[F.tid], hist[F.tid]) : 0u;
        __syncthreads();
        if (F.tid < 256) { const int i = F.tid, gi = tb * 256 + i, e = tmp_e[i];
            const int pos = (int)base[e] + tmp_p[i];
            meta[MT_SEL_E + gi] = e; meta[MT_SEL_POS + gi] = pos;
            el_tok[e * T + pos] = tb * 64 + (i >> 2); el_gate[e * T + pos] = tmp_g[i]; el_sa[e * T + pos] = tmp_s[i >> 2]; }
        __syncthreads();
    }
}
__device__ __forceinline__ void build_tables(const Frame& F, const Args& a) {
    const unsigned* cnt = (const unsigned*)(a.ws + WS_CTL) + CW_CNT;
    LAS int* tb = (LAS int*)(F.lds + RSCR_OFF);
    __syncthreads();
    if (F.tid < 32) tb[TBL_CNT + F.tid] = (int)__hip_atomic_load(cnt + F.tid, RLX_AGENT);
    __syncthreads();
    if (F.tid == 0) { int acc = 0; for (int e = 0; e < 32; ++e) { tb[TBL_TS + e] = acc; acc += (tb[TBL_CNT + e] + 255) >> 8; } tb[TBL_TS + 32] = acc; }
    __syncthreads();
    for (int t = F.tid; t < NT_MAX; t += NWAVES * 64) { int e = 0; for (int j = 1; j < 32; ++j) if (t >= tb[TBL_TS + j]) e = j; tb[TBL_TILE + t] = e; }
    __syncthreads();
}
__device__ __forceinline__ void p7_quant(const Frame& F, const Args& a) {
    const bf16* HID = (const bf16*)(a.ws + WS_HID); signed char* H8 = (signed char*)(a.ws + WS_HID8); float* row_sb = (float*)(a.ws + WS_ROWSB);
    const int nrows = __builtin_amdgcn_readfirstlane(((const LAS int*)(F.lds + RSCR_OFF))[TBL_TS + 32]) * 256;
    const int gw = F.vcu * NWAVES + F.wave, NGW = F.G * NWAVES, lane = F.lane;
    for (int r0 = gw * 4; r0 < nrows; r0 += NGW * 4) {
        u32x4 v[4][2];
#pragma unroll
        for (int i = 0; i < 4; ++i)
#pragma unroll
            for (int j = 0; j < 2; ++j) v[i][j] = *((const u32x4*)(HID + (size_t)(r0 + i) * DFF + 512 * j) + lane);
#pragma unroll
        for (int i = 0; i < 4; ++i) {
            float f[16]; float am = 0.f;
#pragma unroll
            for (int j = 0; j < 2; ++j)
#pragma unroll
                for (int c = 0; c < 4; ++c) { const unsigned w = v[i][j][c]; f[8 * j + 2 * c] = __uint_as_float(w << 16); f[8 * j + 2 * c + 1] = __uint_as_float(w & 0xffff0000u); }
#pragma unroll
            for (int c = 0; c < 16; ++c) am = fmaxf(am, fabsf(f[c]));
            am = xmax(am);
            const float inv = am > 0.f ? 127.0f / am : 0.f;
#pragma unroll
            for (int j = 0; j < 2; ++j) {
                u32x2 o; o.x = 0u; o.y = 0u;
#pragma unroll
                for (int c = 0; c < 4; ++c) { o.x |= ((unsigned)(int)rintf(f[8 * j + c] * inv) & 0xffu) << (8 * c); o.y |= ((unsigned)(int)rintf(f[8 * j + 4 + c] * inv) & 0xffu) << (8 * c); }
                *((u32x2*)(H8 + (size_t)(r0 + i) * DFF + 512 * j) + lane) = o;
            }
            if (lane == 0) row_sb[r0 + i] = am * (1.0f / 127.0f);
        }
    }
}
__device__ __forceinline__ void p8_final(const Frame& F, const Args& a) {
    const bf16* Hin = (const bf16*)(a.ws + WS_H); float* HO = a.out; const unsigned char* Y = (const unsigned char*)(a.ws + WS_Y); const int* meta = (const int*)(a.ws + WS_META);
    const float* ln2_g = a.in[20]; const float* ln2_b = a.in[21]; const LAS int* tsl = (const LAS int*)(F.lds + RSCR_OFF) + TBL_TS;
    const int gw = F.vcu * NWAVES + F.wave, NGW = F.G * NWAVES, lane = F.lane;
    f32x4 g2[4], b2[4];
#pragma unroll
    for (int j = 0; j < 4; ++j) { g2[j] = *(const f32x4*)(ln2_g + 4 * lane + 256 * j); b2[j] = *(const f32x4*)(ln2_b + 4 * lane + 256 * j); }
    for (int tok = gw; tok < T; tok += NGW) {
        f32x4* hr = (f32x4*)(HO + (size_t)tok * D) + lane; const u32x2* hi_ = (const u32x2*)(Hin + (size_t)tok * D) + lane;
        f32x4 v[4]; float s = 0.f;
#pragma unroll
        for (int j = 0; j < 4; ++j) { const u32x2 hh = hi_[64 * j]; v[j] = (f32x4){__uint_as_float(hh.x << 16), __uint_as_float(hh.x & 0xffff0000u), __uint_as_float(hh.y << 16), __uint_as_float(hh.y & 0xffff0000u)} * ALPHA; }
#pragma unroll
        for (int k = 0; k < 4; ++k) {
            const int row = tsl[meta[MT_SEL_E + tok * 4 + k]] * 256 + meta[MT_SEL_POS + tok * 4 + k];
            const unsigned* yr = (const unsigned*)(Y + (size_t)row * D) + lane;
#pragma unroll
            for (int j = 0; j < 4; ++j) { const int y = (int)yr[64 * j]; const f32x2 lo = __builtin_amdgcn_cvt_pk_f32_fp8(y, false), hi2 = __builtin_amdgcn_cvt_pk_f32_fp8(y, true);
                v[j].x += lo.x * (1.0f / YSCALE); v[j].y += lo.y * (1.0f / YSCALE); v[j].z += hi2.x * (1.0f / YSCALE); v[j].w += hi2.y * (1.0f / YSCALE); }
        }
#pragma unroll
        for (int j = 0; j < 4; ++j) s += (v[j].x + v[j].y) + (v[j].z + v[j].w);
        const float mean = xsum(s) * (1.f / D); float s2 = 0.f;
#pragma unroll
        for (int j = 0; j < 4; ++j) { v[j] = v[j] - mean; s2 += (v[j].x * v[j].x + v[j].y * v[j].y) + (v[j].z * v[j].z + v[j].w * v[j].w); }
        const float rstd = rsqrtf(xsum(s2) * (1.f / D) + LN_EPS);
#pragma unroll
        for (int j = 0; j < 4; ++j) hr[64 * j] = v[j] * rstd * g2[j] + b2[j];
    }
}
__global__ void __launch_bounds__(NWAVES * 64, 2) mk_fwd(Args args) {
    extern __shared__ __attribute__((aligned(16))) unsigned char lds_raw[];
    Frame F;
    F.lds = (LAS unsigned char*)lds_raw;
    F.tid = threadIdx.x; F.lane = F.tid & 63; F.wave = __builtin_amdgcn_readfirstlane(F.tid >> 6);
    F.G = gridDim.x; { const int bx = blockIdx.x; F.vcu = (F.G % 8 == 0) ? (bx % 8) * (F.G / 8) + bx / 8 : bx; }
    volatile LAS unsigned* MISC = (volatile LAS unsigned*)(F.lds + MISC_OFF);
    if (F.tid < 64) MISC[F.tid] = 0u;
    __syncthreads();
    unsigned char* ws = args.ws;
    unsigned* ctl = (unsigned*)(ws + WS_CTL);
    const int lo = args.ph_lo, hi = args.ph_hi;
    XcdBarrier bar; bar.bar = ctl + CW_BAR + args.li * XCD_BAR_WORDS; bar.x = 0; bar.st = nullptr;
    if (hi - lo > 1) bar = xcd_barrier_post(ctl + CW_BAR + args.li * XCD_BAR_WORDS, MISC + 8);
#define IN(k) (lo <= (k) && (k) < hi)
#define OPAQUE_F(Fp) Frame Fp = F; asm volatile("" : "+v"(Fp.tid)); Fp.lane = Fp.tid & 63
#define SEAM(k) do { if (IN(k) && IN((k) + 1)) xcd_barrier(bar); } while (0)
    int* meta = (int*)(ws + WS_META);
    bf16 *XB = (bf16*)(ws + WS_XB), *QB = (bf16*)(ws + WS_QB), *KB = (bf16*)(ws + WS_KB), *VT = (bf16*)(ws + WS_VT), *UB = (bf16*)(ws + WS_UB), *GB = (bf16*)(ws + WS_GB);
    bf16 *CAT = (bf16*)(ws + WS_CAT), *HB = (bf16*)(ws + WS_HB), *Y = (bf16*)(ws + WS_Y), *HID = (bf16*)(ws + WS_HID);
    bf16 *Win_t = (bf16*)(ws + WS_WIN), *Wout_t = (bf16*)(ws + WS_WOUT), *Wgu_t = (bf16*)(ws + WS_WGU), *Wd_t = (bf16*)(ws + WS_WD);
    const LAS int* rtab = (const LAS int*)(F.lds + RTAB_OFF);
    const bool par = ((blockIdx.x >> 3) & 1) != 0;

    if (IN(0)) { OPAQUE_F(Fp); p0_prologue(Fp, args); SEAM(0); }
    if (IN(1)) {
        const int c = (int)blockIdx.x, grp = (c >> 3) % 3;
        const int per_ = (3 * NEXP * 32 + F.G - 1) / F.G;
        const int it_lo = F.G == 256 ? (c < 192 ? c * 10 : 1920 + (c - 192) * 18) : c * per_, it_hi = F.G == 256 ? it_lo + (c < 192 ? 10 : 18) : it_lo + per_;
        OPAQUE_F(Fp);
        if (grp == 0) conv_items(Fp, args, it_lo, it_hi);
        { pg8::Gemm g{XB, Win_t, 2 * D, nullptr, 0u}; pg8::StaticOrder S; S.init(T / 256, INW / 256, F.G, c); S.i1 = 1;
          pg8::EpiInProj E{args.in[2], QB, KB, VT, UB, GB};
          pg8::gemm_phase<pg8::EpiInProj, false, true, false>(F.lds, rtab, g, S, E); }
        if (grp == 1) conv_items(Fp, args, it_lo, it_hi);
        { pg8::Gemm g{XB, Win_t, 2 * D, nullptr, 0u}; pg8::StaticOrder S; S.init(T / 256, INW / 256, F.G, c); S.i0 = 1;
          pg8::EpiInProj E{args.in[2], QB, KB, VT, UB, GB};
          pg8::gemm_phase<pg8::EpiInProj, false, true, false>(F.lds, rtab, g, S, E); }
        if (grp == 2) conv_items(Fp, args, it_lo, it_hi);
        SEAM(1);
    }
    if (IN(2)) { OPAQUE_F(Fp); p2_mixers(Fp, args); SEAM(2); }
    if (IN(3)) {
        pg8::Gemm g{CAT, Wout_t, 2 * D, nullptr, 0u}; pg8::StaticOrder S; S.init(T / 256, D / 256, F.G, (int)blockIdx.x);
        pg8::EpiOutProj E{args.in[0], args.in[9], args.out};
        pg8::gemm_phase<pg8::EpiOutProj, false, false, false>(F.lds, rtab, g, S, E);
        SEAM(3);
    }
    if (IN(4)) { OPAQUE_F(Fp); p4_router(Fp, args, true); if (hi > 5) xcd_barrier(bar); }
    const LAS int* tbl = (const LAS int*)(F.lds + RSCR_OFF);
    if (hi > 5) { OPAQUE_F(Fp); build_tables(Fp, args); }
    if (IN(6)) {
        const int nT = __builtin_amdgcn_readfirstlane(tbl[TBL_TS + 32]);
        pg8::StaticOrder S; S.init(nT, 2 * DFF / 256, F.G, (int)blockIdx.x);
        { pg8::Unit u; LAS int* rt = (LAS int*)(F.lds + RTAB_OFF); const int* el_tok = (const int*)(ws + WS_ELIST);
          for (int i = 0; i < RTAB_UNITS && S.next(i, u); ++i) if (F.tid < 256) { const int e = tbl[TBL_TILE + u.pm], ix = (u.pm - tbl[TBL_TS + e]) * 256 + F.tid; rt[i * 256 + F.tid] = ix < tbl[TBL_CNT + e] ? el_tok[e * T + ix] : 0; }
          __syncthreads(); }
        pg8::Gemm g{HB, Wgu_t, D, tbl + TBL_TILE, 2048u * 1024u};
        pg8::EpiSwiglu E{tbl, args.in[15], args.in[17], (const float*)(ws + WS_SWGU), (const float*)(ws + WS_ELIST) + 2 * NEXP * T, HID};
        pg8::gemm_phase<pg8::EpiSwiglu, true, true, true>(F.lds, rtab, g, S, E);
        SEAM(6);
    }
    if (IN(7)) { OPAQUE_F(Fp); p7_quant(Fp, args); SEAM(7); }
    if (IN(8)) {
        const int nT = __builtin_amdgcn_readfirstlane(tbl[TBL_TS + 32]);
        pg8::StaticOrder S; S.init(nT, D / 256, F.G, (int)blockIdx.x);
        pg8::Gemm g{ws + WS_HID8, Wd_t, DFF, tbl + TBL_TILE, 1024u * 1024u};
        pg8::EpiDown E{tbl, args.in[19], (const float*)(ws + WS_SWD), (const float*)(ws + WS_ROWSB), (const float*)(ws + WS_ELIST) + NEXP * T, (unsigned char*)Y};
        pg8::gemm_phase<pg8::EpiDown, false, true, true>(F.lds, rtab, g, S, E);
        SEAM(8);
    }
    if (IN(9)) { OPAQUE_F(Fp); p8_final(Fp, args); }
#undef IN
#undef SEAM
}

extern "C" void kernel_launch(void* const* d_in, const int* in_sizes, int n_in, void* d_out, int out_size, void* d_ws, size_t ws_size, hipStream_t stream) {
    static int grid = 0;
    if (grid == 0) {
        if (n_in != 22 || in_sizes[0] != T * D || out_size != T * D || ws_size < WS_END) { fprintf(stderr, "kernel_launch: unexpected shapes (n_in %d, in0 %d, out %d, ws %zu, need %zu)\n", n_in, n_in > 0 ? in_sizes[0] : -1, out_size, ws_size, (size_t)WS_END); grid = -1; return; }
        int dev = 0, cus = 0;
        if (hipGetDevice(&dev) != hipSuccess || hipDeviceGetAttribute(&cus, hipDeviceAttributeMultiprocessorCount, dev) != hipSuccess) { grid = -1; return; }
        if (hipFuncSetAttribute((const void*)mk_fwd, hipFuncAttributeMaxDynamicSharedMemorySize, LDS_BYTES) != hipSuccess) { fprintf(stderr, "kernel_launch: hipFuncSetAttribute failed\n"); grid = -1; return; }
        int per_cu = 0;
        if (hipOccupancyMaxActiveBlocksPerMultiprocessor(&per_cu, (const void*)mk_fwd, NWAVES * 64, LDS_BYTES) != hipSuccess || per_cu < 1) fprintf(stderr, "kernel_launch: occupancy query reports %d\n", per_cu);
        (void)hipGetLastError();
        grid = cus;
    }
    if (grid < 0) return;
    unsigned char* ws = (unsigned char*)d_ws; float* out = (float*)d_out;
    (void)hipMemsetAsync(ws + WS_CTL, 0, 64 * 1024, stream);
    Args a{};
    for (int i = 0; i < 22; ++i) a.in[i] = (const float*)d_in[i];
    a.out = out; a.ws = ws;
    a.ph_lo = 0; a.ph_hi = NPHASES; a.li = 0;
    hipLaunchKernelGGL(mk_fwd, dim3(grid), dim3(NWAVES * 64), LDS_BYTES, stream, a);
}
```

```cpp
#include <hip/hip_runtime.h>
#include <cstdio>
#include <cstdint>

typedef unsigned short bf16;
typedef float f32x4 __attribute__((ext_vector_type(4)));
typedef unsigned u32x4 __attribute__((ext_vector_type(4)));
typedef unsigned u32x2 __attribute__((ext_vector_type(2)));

constexpr int BATCH = 2, SEQ = 8192, D = 1024, T = BATCH * SEQ;
constexpr int NQH = 8, NKVH = 2, HD = 64, QREP = 4, AW = 512, KVW = 128, GW = 512, INW = 1792;
constexpr int NEXP = 32, TOPK = 4, DFF = 1024;
constexpr int NT_MAX = T * TOPK / 256 + NEXP;
constexpr int NROWS_MAX = NT_MAX * 256;
constexpr float LN_EPS = 1e-5f;
constexpr float ALPHA = 1.189207115002721f;
constexpr float C2 = 0.125f * 1.4426950408889634f;
constexpr float LOG2E = 1.4426950408889634f;
constexpr float YSCALE = 16.0f;

constexpr size_t MiB = 1u << 20;
constexpr size_t WS_CTL = 0;
constexpr size_t WS_META = 1 * MiB;
constexpr size_t WS_XB = 3 * MiB;
constexpr size_t WS_QB = WS_XB + 32 * MiB;
constexpr size_t WS_KB = WS_QB + 16 * MiB;
constexpr size_t WS_VT = WS_KB + 4 * MiB;
constexpr size_t WS_UB = WS_VT + 4 * MiB;
constexpr size_t WS_GB = WS_UB + 16 * MiB;
constexpr size_t WS_CAT = WS_GB + 16 * MiB;
constexpr size_t WS_HB = WS_CAT + 32 * MiB;
constexpr size_t WS_H = WS_XB;
constexpr size_t WS_HID = WS_HB + 32 * MiB;
constexpr size_t WS_Y = WS_HID;
static_assert(WS_H + 64 * MiB <= WS_CAT, "H overlay");

constexpr int CW_CNT = 64;
constexpr int MT_NT = 0;
constexpr int MT_TSTART = 16;
constexpr int MT_TILE_E = 64;
constexpr int MT_SEL_E = 1024;
constexpr int MT_SEL_POS = MT_SEL_E + T * 4;
constexpr int MT_SEL_G = MT_SEL_POS + T * 4;
constexpr int MT_SLOT_ROW = MT_SEL_G + T * 4;
constexpr int MT_ROW_TOK = MT_SLOT_ROW + T * 4;
constexpr int MT_ROW_GATE = MT_ROW_TOK + NROWS_MAX;
constexpr int MT_ROW_SA = MT_ROW_GATE + NROWS_MAX;
constexpr int MT_SH = MT_ROW_SA + NROWS_MAX;
constexpr size_t WS_ELIST = WS_GB;
constexpr int TBL_CNT = 0, TBL_TS = 32, TBL_TILE = 72;
constexpr size_t WS_ROWSB = 512 * 1024;
static_assert((size_t)(MT_SH + T) * 4 <= 2 * MiB, "meta");

__device__ __forceinline__ float bf2f(bf16 v) { return __uint_as_float((unsigned)v << 16); }
__device__ __forceinline__ unsigned f2bf(float f) { unsigned u = __float_as_uint(f); return (u + 0x7fffu + ((u >> 16) & 1u)) >> 16; }
__device__ __forceinline__ unsigned pk2(float lo, float hi) { return f2bf(lo) | (f2bf(hi) << 16); }
__device__ __forceinline__ float gelu_tanh(float x) {
    const float k2 = 2.0f * 0.7978845608028654f;
    const float u = k2 * (x + 0.044715f * x * x * x);
    return x / (1.0f + __expf(-u));
}
__device__ __forceinline__ float wave_sum(float v) {
#pragma unroll
    for (int o = 1; o < 64; o <<= 1) v += __shfl_xor(v, o);
    return v;
}
__device__ __forceinline__ float wave_max(float v) {
#pragma unroll
    for (int o = 1; o < 64; o <<= 1) v = fmaxf(v, __shfl_xor(v, o));
    return v;
}

#define LAS __attribute__((address_space(3)))
#define GAS __attribute__((address_space(1)))
typedef short bf16x8 __attribute__((ext_vector_type(8)));
typedef float f32x16 __attribute__((ext_vector_type(16)));
typedef float f32x2 __attribute__((ext_vector_type(2)));
__device__ __forceinline__ unsigned cvt_pk_bf16(float lo, float hi) { unsigned r; asm volatile("v_cvt_pk_bf16_f32 %0, %1, %2" : "=v"(r) : "v"(lo), "v"(hi)); return r; }
__device__ __forceinline__ float fast_gelu(float x) {
    const float u = -2.0f * 0.7978845608028654f * LOG2E * (x + 0.044715f * x * x * x);
    return x * __builtin_amdgcn_rcpf(1.0f + __builtin_amdgcn_exp2f(u));
}
__device__ __forceinline__ void st16_wt(void* p, u32x4 v) {
    *(u32x4*)p = v;
}
namespace pg8 {
constexpr int BM = 256, BK = 64, HALF = 128, HTB = HALF * BK * 2  , STAGE_BYTES = 8 * HTB, NXCD = 8, WGM = 8;
__host__ __device__ __forceinline__ int lds_byte(int r, int c) { const int st = (r >> 4) * 2 + (c >> 5), rr = r & 15, cc = c & 31, ob = rr * 64 + cc * 2; return st * 1024 + (ob ^ (((ob >> 9) & 1) << 5)); }
__host__ __device__ __forceinline__ void stage_rc(int b, int& R, int& C) { const int st = b / 1024, sb = b % 1024, swz = sb ^ (((sb >> 9) & 1) << 5); R = (st >> 1) * 16 + swz / 64; C = (st & 1) * 32 + (swz % 64) / 2; }
__host__ __device__ __forceinline__ int perm32(int rho) { const int n = rho >> 4, i = rho & 15; return 8 * (i >> 2) + 4 * n + (i & 3); }

struct Unit { int pm, pn; };
struct Gemm { const void* A; const void* Bt; int KB; const LAS int* tile_e; unsigned e_stride; };
typedef int i32x4 __attribute__((ext_vector_type(4)));

struct StaticOrder {
    int nM, nN, nwg, G, c, i0 = 0, i1 = 1 << 30;
    __device__ void init(int nM_, int nN_, int G_, int c_) { nM = nM_; nN = nN_; nwg = nM * nN; G = G_; c = c_; }
    __device__ bool next(int i, Unit& u) const {
        i += i0; if (i >= i1) return false;
        const long L = (long)i * G + c; if (L >= nwg) return false;
        int wgid = (int)L; { const int q = nwg / NXCD, r = nwg % NXCD, xcd = wgid % NXCD, off = wgid / NXCD; wgid = (xcd < r ? xcd * (q + 1) : r * (q + 1) + (xcd - r) * q) + off; }
        const int nig = WGM * nN, gid = wgid / nig, fm = gid * WGM, gsz = (nM - fm) < WGM ? (nM - fm) : WGM;
        u.pm = fm + ((wgid % nig) % gsz); u.pn = (wgid % nig) / gsz; return true;
    }
};

template <class Epi, bool GATHER, bool ALIGN_EPI, bool I8>
__device__ __forceinline__ void gemm_phase(LAS unsigned char* lds, const LAS int* rtab, const Gemm g, const StaticOrder& S, const Epi& E) {
    int tid_ = threadIdx.x; asm volatile("" : "+v"(tid_));
    const int tid = tid_, wid = __builtin_amdgcn_readfirstlane(tid >> 6), lane = tid & 63, wr = wid >> 2, wc = wid & 3, fr = lane & 15, fq = lane >> 4;
    const int KB = g.KB, nt = KB / (BK * 2);
    int Rs[2], Cs[2]; unsigned voffB[2];
#pragma unroll
    for (int i = 0; i < 2; ++i) { int R, C; stage_rc(tid * 16 + i * 8192, R, C); const int Rb = Epi::PERM == 2 ? (64 * (R >> 5) + 16 * ((R >> 2) & 3) + 4 * ((R >> 4) & 1) + (R & 3)) : Epi::PERM ? ((R & ~31) + perm32(R & 31)) : R; Rs[i] = R; Cs[i] = C; voffB[i] = (unsigned)(Rb * KB + C * 2); }
    const size_t kstep = (size_t)(BK * 2);
    const size_t hstep = (size_t)HALF * KB;
    const size_t tstep = 2 * hstep;
    const size_t bhstep = Epi::PERM == 2 ? (size_t)8 * KB : hstep;
    const unsigned ldsw = (unsigned)wid * 1024u;
    const int aoff = lds_byte(wr * 64 + fr, fq * 8), boff = lds_byte(wc * 32 + fr, fq * 8);
#define PG8_SA(b, h) (((b) * 2 + (h)) * HTB)
#define PG8_SB(b, h) ((4 + (b) * 2 + (h)) * HTB)
#define PG8_STAGE(bufoff, gbase, voff) do { _Pragma("unroll") for (int _i = 0; _i < 2; ++_i) \
        __builtin_amdgcn_global_load_lds((const unsigned*)((const char*)(gbase) + (voff)[_i]), (LAS unsigned*)(lds + (bufoff) + ldsw + _i * 8192), 16, 0, 0); } while (0)
#define PG8_LDA(dst, b, h) do { _Pragma("unroll") for (int m = 0; m < 4; ++m) _Pragma("unroll") for (int k = 0; k < 2; ++k) dst[m][k] = *(const LAS bf16x8*)(lds + PG8_SA(b, h) + aoff + m * 2048 + k * 1024); } while (0)
#define PG8_LDB(dst, b, h) do { _Pragma("unroll") for (int n = 0; n < 2; ++n) _Pragma("unroll") for (int k = 0; k < 2; ++k) dst[n][k] = *(const LAS bf16x8*)(lds + PG8_SB(b, h) + boff + n * 2048 + k * 1024); } while (0)
#define PG8_MMA(ai, bj, At, Bt) do { __builtin_amdgcn_s_setprio(1); _Pragma("unroll") for (int m = 0; m < 4; ++m) _Pragma("unroll") for (int n = 0; n < 2; ++n) _Pragma("unroll") for (int k = 0; k < 2; ++k) \
        { if constexpr (I8) acc[ai][bj][m][n] = __builtin_bit_cast(f32x4, __builtin_amdgcn_mfma_i32_16x16x64_i8(__builtin_bit_cast(i32x4, Bt[n][k]), __builtin_bit_cast(i32x4, At[m][k]), __builtin_bit_cast(i32x4, acc[ai][bj][m][n]), 0, 0, 0)); \
          else acc[ai][bj][m][n] = __builtin_amdgcn_mfma_f32_16x16x32_bf16(Bt[n][k], At[m][k], acc[ai][bj][m][n], 0, 0, 0); } __builtin_amdgcn_s_setprio(0); } while (0)
#define PG8_WAIT_V(n) asm volatile("s_waitcnt vmcnt(" #n ")" ::: "memory")
#define PG8_WAIT_L(n) asm volatile("s_waitcnt lgkmcnt(" #n ")" ::: "memory")
#define PG8_BAR __builtin_amdgcn_s_barrier()
#define PG8_SCHED __builtin_amdgcn_sched_barrier(0)
#define PG8_VOFFA(vo, ui_, u_) do { _Pragma("unroll") for (int h_ = 0; h_ < 2; ++h_) _Pragma("unroll") for (int i_ = 0; i_ < 2; ++i_) { \
        const int row_ = GATHER ? rtab[(ui_) * 256 + h_ * 128 + Rs[i_]] : ((u_).pm * 256 + h_ * 128 + Rs[i_]); \
        vo[h_][i_] = (unsigned)(row_ * KB + Cs[i_] * 2); } } while (0)
#define PG8_BBASE(u_) ((const char*)g.Bt + (g.tile_e ? (size_t)g.tile_e[(u_).pm] * g.e_stride : (size_t)0) + (size_t)(u_).pn * tstep)
    Unit cur, nxt; int ui = 0;
    if (!S.next(0, cur)) return;
    f32x4 acc[2][2][4][2];
    if constexpr (Epi::HAS_INIT) E.init(acc, cur, wr, wc, fr, fq);
    else {
#pragma unroll
    for (int a = 0; a < 2; ++a)
#pragma unroll
        for (int b = 0; b < 2; ++b)
#pragma unroll
            for (int m = 0; m < 4; ++m)
#pragma unroll
                for (int n = 0; n < 2; ++n) acc[a][b][m][n] = (f32x4){0.f, 0.f, 0.f, 0.f};
    }
    bf16x8 At[4][2], B0[2][2], B1[2][2];
    unsigned vAc[2][2], vAn[2][2];
    PG8_VOFFA(vAc, 0, cur);
    const char* const gA = (const char*)g.A;
    const char* cB = PG8_BBASE(cur);
    PG8_STAGE(PG8_SB(0, 0), cB, voffB); PG8_STAGE(PG8_SB(0, 1), cB + bhstep, voffB); PG8_STAGE(PG8_SA(0, 0), gA, vAc[0]); PG8_STAGE(PG8_SA(0, 1), gA, vAc[1]);
    if (wr == 1) PG8_BAR;
    PG8_WAIT_V(2); PG8_BAR;
    PG8_STAGE(PG8_SB(1, 0), cB + kstep, voffB); PG8_STAGE(PG8_SA(1, 0), gA + kstep, vAc[0]); PG8_STAGE(PG8_SB(1, 1), cB + bhstep + kstep, voffB);
    PG8_WAIT_V(6); PG8_BAR;
    for (;;) {
        const bool has_next = S.next(ui + 1, nxt);
        const char* nB = cB;
        if (has_next) { nB = PG8_BBASE(nxt); PG8_VOFFA(vAn, ui + 1, nxt); }
        else {
#pragma unroll
            for (int h = 0; h < 2; ++h)
#pragma unroll
                for (int i = 0; i < 2; ++i) vAn[h][i] = vAc[h][i];
        }
        for (int t = 0; t < nt; t += 2) {
            const bool last = (t == nt - 2);
            const char* a1 = gA + (size_t)(t + 1) * kstep;
            const char* a2 = last ? gA : gA + (size_t)(t + 2) * kstep; const char* b2 = last ? nB : cB + (size_t)(t + 2) * kstep;
            const char* a3 = a2 + kstep; const char* b3 = b2 + kstep;
            unsigned v2[2][2];
#pragma unroll
            for (int h = 0; h < 2; ++h)
#pragma unroll
                for (int i = 0; i < 2; ++i) v2[h][i] = last ? vAn[h][i] : vAc[h][i];
            PG8_LDB(B0, 0, 0); PG8_LDB(B1, 0, 1); PG8_SCHED; PG8_LDA(At, 0, 0); PG8_STAGE(PG8_SA(1, 1), a1, vAc[1]);
            PG8_WAIT_V(8); PG8_WAIT_L(0); PG8_BAR; PG8_MMA(0, 0, At, B0); PG8_MMA(0, 1, At, B1); PG8_BAR; PG8_SCHED;
            PG8_LDA(At, 0, 1); PG8_STAGE(PG8_SB(0, 0), b2, voffB); PG8_STAGE(PG8_SB(0, 1), b2 + bhstep, voffB); PG8_STAGE(PG8_SA(0, 0), a2, v2[0]);
            PG8_WAIT_V(8); PG8_WAIT_L(0); PG8_BAR; PG8_MMA(1, 0, At, B0); PG8_MMA(1, 1, At, B1); PG8_BAR; PG8_SCHED;
            PG8_LDB(B0, 1, 0); PG8_LDB(B1, 1, 1); PG8_SCHED; PG8_LDA(At, 1, 0); PG8_STAGE(PG8_SA(0, 1), a2, v2[1]);
            PG8_WAIT_V(8); PG8_WAIT_L(0); PG8_BAR; PG8_MMA(0, 0, At, B0); PG8_MMA(0, 1, At, B1); PG8_BAR; PG8_SCHED;
            PG8_LDA(At, 1, 1); PG8_STAGE(PG8_SB(1, 0), b3, voffB); PG8_STAGE(PG8_SB(1, 1), b3 + bhstep, voffB); PG8_STAGE(PG8_SA(1, 0), a3, v2[0]);
            PG8_WAIT_V(8); PG8_WAIT_L(0); PG8_BAR; PG8_MMA(1, 0, At, B0); PG8_MMA(1, 1, At, B1); PG8_BAR; PG8_SCHED;
        }
        if constexpr (ALIGN_EPI) { if (wr == 0) PG8_BAR; }
        E(acc, cur, wr, wc, fr, fq);
        if (!has_next) break;
        if constexpr (Epi::HAS_INIT) E.init(acc, nxt, wr, wc, fr, fq);
        else {
#pragma unroll
        for (int a = 0; a < 2; ++a)
#pragma unroll
            for (int b = 0; b < 2; ++b)
#pragma unroll
                for (int m = 0; m < 4; ++m)
#pragma unroll
                    for (int n = 0; n < 2; ++n) acc[a][b][m][n] = (f32x4){0.f, 0.f, 0.f, 0.f};
        }
        cur = nxt; cB = nB; ++ui;
#pragma unroll
        for (int h = 0; h < 2; ++h)
#pragma unroll
            for (int i = 0; i < 2; ++i) vAc[h][i] = vAn[h][i];
        if constexpr (ALIGN_EPI) { if (wr == 1) PG8_BAR; }
    }
    PG8_WAIT_V(0);
    if constexpr (!ALIGN_EPI) { if (wr == 0) PG8_BAR; }
    PG8_BAR;
#undef PG8_SA
#undef PG8_SB
#undef PG8_STAGE
#undef PG8_LDA
#undef PG8_LDB
#undef PG8_MMA
#undef PG8_WAIT_V
#undef PG8_WAIT_L
#undef PG8_BAR
#undef PG8_SCHED
#undef PG8_VOFFA
#undef PG8_BBASE
}

struct EpiInProj {
    static constexpr int PERM = 1; static constexpr bool HAS_INIT = false;
    const float* b_in; bf16 *QB, *KB, *VT, *UB, *GB;
    __device__ __forceinline__ void operator()(const f32x4 (&acc)[2][2][4][2], const Unit& u, int wr, int wc, int fr, int fq) const {
        const int row0 = u.pm * BM + wr * 64 + fr;
#pragma unroll
        for (int bj = 0; bj < 2; ++bj) {
            const int reg = u.pn * BM + bj * HALF;
            const int c0 = reg + wc * 32 + 8 * fq;
            const f32x4 bv0 = *(const f32x4*)(b_in + c0), bv1 = *(const f32x4*)(b_in + c0 + 4);
#pragma unroll
            for (int ai = 0; ai < 2; ++ai)
#pragma unroll
                for (int m = 0; m < 4; ++m) {
                    const int row = row0 + ai * HALF + m * 16;
                    f32x4 v0 = acc[ai][bj][m][0] + bv0, v1 = acc[ai][bj][m][1] + bv1;
                    if (reg >= 640 && reg < 768) {
                        const int cv = c0 - 640, gg = cv >> 6, d = cv & 63, b = row / SEQ, s = row % SEQ;
                        bf16* vp = VT + ((size_t)((b * 2 + gg) * 64 + d)) * SEQ + s;
#pragma unroll
                        for (int j = 0; j < 4; ++j) { vp[(size_t)j * SEQ] = (bf16)f2bf(v0[j]); vp[(size_t)(j + 4) * SEQ] = (bf16)f2bf(v1[j]); }
                    } else {
                        bf16* dst;
                        if (reg < 512) { v0 = v0 * C2; v1 = v1 * C2; dst = QB + (size_t)row * 512 + c0; }
                        else if (reg < 640) { dst = KB + (size_t)row * 128 + (c0 - 512); }
                        else {
#pragma unroll
                            for (int j = 0; j < 4; ++j) { v0[j] = fast_gelu(v0[j]); v1[j] = fast_gelu(v1[j]); }
                            dst = (reg < 1280) ? (UB + (size_t)row * 512 + (c0 - 768)) : (GB + (size_t)row * 512 + (c0 - 1280));
                        }
                        u32x4 w; w.x = cvt_pk_bf16(v0[0], v0[1]); w.y = cvt_pk_bf16(v0[2], v0[3]); w.z = cvt_pk_bf16(v1[0], v1[1]); w.w = cvt_pk_bf16(v1[2], v1[3]);
                        *(u32x4*)dst = w;
                    }
                }
        }
    }
};
struct EpiOutProj {
    static constexpr int PERM = 0; static constexpr bool HAS_INIT = true;
    const float* x; const float* b_out; float* Z;
    __device__ __forceinline__ void init(f32x4 (&acc)[2][2][4][2], const Unit& u, int wr, int wc, int fr, int fq) const {
        const int col0 = u.pn * BM + wc * 32 + 4 * fq;
#pragma unroll
        for (int ai = 0; ai < 2; ++ai)
#pragma unroll
            for (int m = 0; m < 4; ++m) {
                const size_t off = (size_t)(u.pm * BM + ai * HALF + wr * 64 + m * 16 + fr) * D + col0;
#pragma unroll
                for (int bj = 0; bj < 2; ++bj)
#pragma unroll
                    for (int n = 0; n < 2; ++n) acc[ai][bj][m][n] = *(const f32x4*)(x + off + bj * HALF + n * 16) * ALPHA + *(const f32x4*)(b_out + col0 + bj * HALF + n * 16);
            }
    }
    __device__ __forceinline__ void operator()(const f32x4 (&acc)[2][2][4][2], const Unit& u, int wr, int wc, int fr, int fq) const {
        const int col0 = u.pn * BM + wc * 32 + 4 * fq;
#pragma unroll
        for (int ai = 0; ai < 2; ++ai)
#pragma unroll
            for (int m = 0; m < 4; ++m) {
                const size_t off = (size_t)(u.pm * BM + ai * HALF + wr * 64 + m * 16 + fr) * D + col0;
#pragma unroll
                for (int bj = 0; bj < 2; ++bj)
#pragma unroll
                    for (int n = 0; n < 2; ++n) *(f32x4*)(Z + off + bj * HALF + n * 16) = acc[ai][bj][m][n];
            }
    }
};
struct EpiSwiglu {
    static constexpr int PERM = 1; static constexpr bool HAS_INIT = false;
    const LAS int* tbl; const float* b_gate; const float* b_up; const float* swgu; const float* el_sa; bf16* HID;
    __device__ __forceinline__ void operator()(const f32x4 (&acc)[2][2][4][2], const Unit& u, int wr, int wc, int fr, int fq) const {
        const int e = tbl[TBL_TILE + u.pm], p0 = (u.pm - tbl[TBL_TS + e]) * BM, ce = tbl[TBL_CNT + e];
        const int fc0 = u.pn * HALF + wc * 32 + 8 * fq;
        const float* sw = swgu + e * 2048 + u.pn * 256 + wc * 32 + 8 * fq;
        float sa[2][4];
#pragma unroll
        for (int ai = 0; ai < 2; ++ai)
#pragma unroll
            for (int m = 0; m < 4; ++m) { const int ix = p0 + ai * HALF + wr * 64 + m * 16 + fr; sa[ai][m] = ix < ce ? el_sa[e * T + ix] : 0.f; }
        f32x4 gb[2], ub[2], sg[2], su[2];
#pragma unroll
        for (int n = 0; n < 2; ++n) { gb[n] = *(const f32x4*)(b_gate + e * DFF + fc0 + 4 * n); ub[n] = *(const f32x4*)(b_up + e * DFF + fc0 + 4 * n); sg[n] = *(const f32x4*)(sw + 4 * n); su[n] = *(const f32x4*)(sw + 128 + 4 * n); }
#pragma unroll
        for (int ai = 0; ai < 2; ++ai)
#pragma unroll
            for (int m = 0; m < 4; ++m) {
                const int row = u.pm * BM + ai * HALF + wr * 64 + m * 16 + fr;
                float hv[8];
                const f32x2 sa2 = (f32x2){sa[ai][m], sa[ai][m]};
#pragma unroll
                for (int n = 0; n < 2; ++n)
#pragma unroll
                    for (int jp = 0; jp < 2; ++jp) {
                        const f32x2 gi = (f32x2){(float)__float_as_int(acc[ai][0][m][n][2 * jp]), (float)__float_as_int(acc[ai][0][m][n][2 * jp + 1])};
                        const f32x2 ui = (f32x2){(float)__float_as_int(acc[ai][1][m][n][2 * jp]), (float)__float_as_int(acc[ai][1][m][n][2 * jp + 1])};
                        const f32x2 sg2 = (f32x2){sg[n][2 * jp], sg[n][2 * jp + 1]}, su2 = (f32x2){su[n][2 * jp], su[n][2 * jp + 1]};
                        const f32x2 gb2 = (f32x2){gb[n][2 * jp], gb[n][2 * jp + 1]}, ub2 = (f32x2){ub[n][2 * jp], ub[n][2 * jp + 1]};
                        const f32x2 ga = __builtin_elementwise_fma(gi * sa2, sg2, gb2), ua = __builtin_elementwise_fma(ui * sa2, su2, ub2);
                        f32x2 gt, up;
                        gt.x = fminf(ga.x, 7.0f); gt.y = fminf(ga.y, 7.0f); up.x = __builtin_amdgcn_fmed3f(ua.x, -7.0f, 7.0f); up.y = __builtin_amdgcn_fmed3f(ua.y, -7.0f, 7.0f);
                        const f32x2 ex = gt * (-1.702f * LOG2E);
                        f32x2 en; en.x = __builtin_amdgcn_exp2f(ex.x); en.y = __builtin_amdgcn_exp2f(ex.y);
                        const f32x2 den = en + 1.0f, upp = up + 1.0f;
                        f32x2 rc; rc.x = __builtin_amdgcn_rcpf(den.x); rc.y = __builtin_amdgcn_rcpf(den.y);
                        const f32x2 hh = (gt * rc) * upp;
                        hv[4 * n + 2 * jp] = hh.x; hv[4 * n + 2 * jp + 1] = hh.y;
                    }
                u32x4 w; w.x = cvt_pk_bf16(hv[0], hv[1]); w.y = cvt_pk_bf16(hv[2], hv[3]); w.z = cvt_pk_bf16(hv[4], hv[5]); w.w = cvt_pk_bf16(hv[6], hv[7]);
                *(u32x4*)(HID + (size_t)row * DFF + fc0) = w;
            }
    }
};
struct EpiDown {
    static constexpr int PERM = 2; static constexpr bool HAS_INIT = false;
    const LAS int* tbl; const float* b_down; const float* swd; const float* row_sb; const float* el_gate; unsigned char* Y;
    __device__ __forceinline__ void operator()(const f32x4 (&acc)[2][2][4][2], const Unit& u, int wr, int wc, int fr, int fq) const {
        const int e = tbl[TBL_TILE + u.pm], p0 = (u.pm - tbl[TBL_TS + e]) * BM, ce = tbl[TBL_CNT + e];
        const int c0 = u.pn * BM + wc * 64 + 16 * fq;
        f32x4 bv[2][2], sw[2][2];
#pragma unroll
        for (int bj = 0; bj < 2; ++bj)
#pragma unroll
            for (int n = 0; n < 2; ++n) { bv[bj][n] = *(const f32x4*)(b_down + e * D + c0 + 8 * bj + 4 * n); sw[bj][n] = *(const f32x4*)(swd + e * D + c0 + 8 * bj + 4 * n); }
#pragma unroll
        for (int ai = 0; ai < 2; ++ai)
#pragma unroll
            for (int m = 0; m < 4; ++m) {
                const int row = u.pm * BM + ai * HALF + wr * 64 + m * 16 + fr;
                const int ix = p0 + ai * HALF + wr * 64 + m * 16 + fr;
                const float gt = (ix < ce ? el_gate[e * T + ix] : 0.f) * YSCALE, sb = row_sb[row] * gt;
                u32x4 w;
#pragma unroll
                for (int bj = 0; bj < 2; ++bj)
#pragma unroll
                    for (int n = 0; n < 2; ++n) {
                        float v[4];
#pragma unroll
                        for (int jp = 0; jp < 2; ++jp) {
                            const f32x2 ci = (f32x2){(float)__float_as_int(acc[ai][bj][m][n][2 * jp]), (float)__float_as_int(acc[ai][bj][m][n][2 * jp + 1])};
                            const f32x2 s2 = (f32x2){sw[bj][n][2 * jp], sw[bj][n][2 * jp + 1]} * sb, b2 = (f32x2){bv[bj][n][2 * jp], bv[bj][n][2 * jp + 1]} * gt;
                            const f32x2 r = __builtin_elementwise_fma(ci, s2, b2);
                            v[2 * jp] = __builtin_amdgcn_fmed3f(r.x, -448.0f, 448.0f); v[2 * jp + 1] = __builtin_amdgcn_fmed3f(r.y, -448.0f, 448.0f);
                        }
                        int d = 0;
                        d = __builtin_amdgcn_cvt_pk_fp8_f32(v[0], v[1], d, false);
                        d = __builtin_amdgcn_cvt_pk_fp8_f32(v[2], v[3], d, true);
                        w[2 * bj + n] = (unsigned)d;
                    }
                *(u32x4*)(Y + (size_t)row * D + c0) = w;
            }
    }
};
}
constexpr int NWAVES = 8;
constexpr int NPHASES = 10;
constexpr size_t WS_WIN = WS_HID + 144 * MiB;
constexpr size_t WS_WOUT = WS_WIN + 4 * MiB;
constexpr size_t WS_WGU = WS_WOUT + 2 * MiB;
constexpr size_t WS_SWGU = WS_WGU + 64 * MiB;
constexpr size_t WS_WD = WS_SWGU + 1 * MiB;
constexpr size_t WS_SWD = WS_WD + 32 * MiB;
constexpr size_t WS_HID8 = WS_SWD + 1 * MiB;
constexpr size_t WS_END = WS_HID8 + 72 * MiB;
constexpr int CW_BAR = 4096;
constexpr int RING_BYTES = 131072;
constexpr int RTAB_OFF = RING_BYTES;
constexpr int RTAB_UNITS = 12;
constexpr int RW_BYTES = 1024 * 144;
constexpr int RSCR_OFF = RW_BYTES;
constexpr int LDS_BYTES = 163840;
constexpr int MISC_OFF = LDS_BYTES - 256;
static_assert(RTAB_OFF + RTAB_UNITS * 1024 <= MISC_OFF && RSCR_OFF + 4096 <= MISC_OFF, "LDS map");

typedef GAS unsigned gu32;
#define RLX_AGENT __ATOMIC_RELAXED, __HIP_MEMORY_SCOPE_AGENT
#define LDS_WAIT() asm volatile("s_waitcnt lgkmcnt(0)" ::: "memory")
#define VM_WAIT() asm volatile("s_waitcnt vmcnt(0)" ::: "memory")

#define XB_TMO      128
#define XB_XCNT(j)  (256  + 64 * (j))
#define XB_XSUB(j)  (1280 + 64 * (j))
#define XB_XGEN(j)  (2304 + 64 * (j))
#define XB_TOP      3328
#define XB_TOPGEN   3392
#define XCD_BAR_WORDS 3456
#define XB_SPIN_CAP (1u << 18)
__device__ __forceinline__ unsigned xb_ld(unsigned* p)              { return __hip_atomic_load(p, __ATOMIC_RELAXED, __HIP_MEMORY_SCOPE_AGENT); }
__device__ __forceinline__ unsigned xb_add(unsigned* p, unsigned v) { return __hip_atomic_fetch_add(p, v, __ATOMIC_RELAXED, __HIP_MEMORY_SCOPE_AGENT); }
__device__ __forceinline__ unsigned xb_xcc_id() { return (unsigned)__builtin_amdgcn_s_getreg((3 << 11) | 20) & 0xFu; }
#define XB_SPIN(cond, bar) do { unsigned _sp = 0; while (cond) { __builtin_amdgcn_s_sleep(1); \
    if ((++_sp & 255u) == 0u) { if (xb_ld(&(bar)[XB_TMO])) break; if (_sp > XB_SPIN_CAP) { atomicAdd(&(bar)[XB_TMO], 1u); break; } } } } while (0)
struct XcdBarrier { unsigned* bar; unsigned x; volatile LAS unsigned* st; };
__device__ __forceinline__ XcdBarrier xcd_barrier_post(unsigned* bar, volatile LAS unsigned* st) {
    XcdBarrier b; b.bar = bar; b.x = xb_xcc_id(); b.st = st;
    if (threadIdx.x == 0) (void)xb_add(&bar[XB_XCNT(b.x)], 1u);
    return b;
}
__device__ __forceinline__ void xcd_barrier_complete(unsigned* bar, unsigned x, unsigned& nloc, unsigned& nx) {
    const unsigned G = gridDim.x * gridDim.y * gridDim.z;
    unsigned sum, cnt, mine, sp = 0u;
    for (;;) {
        sum = 0u; cnt = 0u; mine = 0u;
#pragma unroll
        for (unsigned j = 0; j < 16; ++j) { const unsigned c = xb_ld(&bar[XB_XCNT(j)]); sum += c; cnt += (c > 0u) ? 1u : 0u; mine = (j == x) ? c : mine; }
        if (sum == G) break;
        __builtin_amdgcn_s_sleep(1);
        if ((++sp & 255u) == 0u) { if (xb_ld(&bar[XB_TMO])) break; if (sp > XB_SPIN_CAP) { atomicAdd(&bar[XB_TMO], 1u); break; } }
    }
    nloc = mine > 0u ? mine : 1u; nx = cnt > 0u ? cnt : 1u;
}
__device__ __forceinline__ void xcd_barrier(const XcdBarrier& b) {
    asm volatile("s_waitcnt vmcnt(0)" ::: "memory");
    __syncthreads();
    if (threadIdx.x == 0) {
        unsigned* bar = b.bar;
        __builtin_amdgcn_s_waitcnt(0);
        unsigned nloc = b.st[0], nx = b.st[1];
        if (nloc == 0u) { xcd_barrier_complete(bar, b.x, nloc, nx); b.st[0] = nloc; b.st[1] = nx; }
        const unsigned old = xb_add(&bar[XB_XSUB(b.x)], 1u);
        const unsigned gen = old / nloc;
        if (old + 1u == (gen + 1u) * nloc) {
            __builtin_amdgcn_fence(__ATOMIC_RELEASE, "agent");
            asm volatile("s_waitcnt vmcnt(0)" ::: "memory");
            const unsigned og = xb_add(&bar[XB_TOP], 1u);
            const unsigned tg = og / nx;
            if (og + 1u == (tg + 1u) * nx) xb_add(&bar[XB_TOPGEN], 1u);
            else XB_SPIN(xb_ld(&bar[XB_TOPGEN]) == tg, bar);
            __builtin_amdgcn_fence(__ATOMIC_ACQUIRE, "agent");
            xb_add(&bar[XB_XGEN(b.x)], 1u);
            asm volatile("s_waitcnt vmcnt(0)" ::: "memory");
        } else {
            XB_SPIN(xb_ld(&bar[XB_XGEN(b.x)]) == gen, bar);
            __builtin_amdgcn_fence(__ATOMIC_ACQUIRE, "agent");
            asm volatile("s_waitcnt vmcnt(0)" ::: "memory");
        }
    }
    __syncthreads();
}

struct Args {
    const float* in[22]; float* out; unsigned char* ws; int ph_lo, ph_hi, li, pad;
};
struct Frame {
    LAS unsigned char* lds;
    int tid, lane, wave, vcu, G;
};
__device__ __forceinline__ void p0_item(const float* W, int N, bf16* WT, int K, int dst_row0, int k0, int n0, LAS float* scr, int lane) {
    f32x4 v[8];
#pragma unroll
    for (int i = 0; i < 8; ++i) v[i] = *(const f32x4*)(W + (size_t)(k0 + (lane >> 3) + 8 * i) * N + n0 + 4 * (lane & 7));
#pragma unroll
    for (int i = 0; i < 8; ++i) { LAS float* s = scr + ((lane >> 3) + 8 * i) * 33 + 4 * (lane & 7); s[0] = v[i].x; s[1] = v[i].y; s[2] = v[i].z; s[3] = v[i].w; }
    LDS_WAIT(); asm volatile("" ::: "memory");
    const int c = lane & 7;
#pragma unroll
    for (int j = 0; j < 4; ++j) { const int n = (lane >> 3) + 8 * j; const LAS float* s = scr + (8 * c) * 33 + n;
        u32x4 o; o.x = pk2(s[0 * 33], s[1 * 33]); o.y = pk2(s[2 * 33], s[3 * 33]); o.z = pk2(s[4 * 33], s[5 * 33]); o.w = pk2(s[6 * 33], s[7 * 33]);
        *(u32x4*)(WT + (size_t)(dst_row0 + n) * K + k0 + 8 * c) = o; }
    LDS_WAIT(); asm volatile("" ::: "memory");
}
struct ConvItem { const float* W; signed char* dst; float* sc; int n0, dst_row0; };
__device__ __forceinline__ ConvItem conv_decode(const Args& a, int it) {
    unsigned char* ws = a.ws;
    const int nb = it & 31, e = (it >> 5) & 31, kind = it >> 10, n0 = nb * 32;
    ConvItem c;
    c.W = (kind == 0 ? a.in[14] : kind == 1 ? a.in[16] : a.in[18]) + (size_t)e * D * DFF;
    c.dst = kind < 2 ? (signed char*)(ws + WS_WGU) + (size_t)e * 2048 * 1024 : (signed char*)(ws + WS_WD) + (size_t)e * 1024 * 1024;
    c.dst_row0 = kind < 2 ? (n0 >> 7) * 256 + kind * 128 + (n0 & 127) : n0;
    c.sc = kind < 2 ? (float*)(ws + WS_SWGU) + e * 2048 : (float*)(ws + WS_SWD) + e * 1024;
    c.n0 = n0; return c;
}
#define CONV_LOAD(v, ci) do { _Pragma("unroll") for (int i_ = 0; i_ < 4; ++i_) _Pragma("unroll") for (int j_ = 0; j_ < 4; ++j_) \
        v[i_][j_] = *(const f32x4*)((ci).W + (size_t)(4 * (kl + 64 * i_) + j_) * DFF + (ci).n0 + 4 * n4); } while (0)
__device__ __forceinline__ void conv_items(const Frame& F, const Args& a, int it_lo, int it_hi) {
    if (it_hi > 3 * NEXP * 32) it_hi = 3 * NEXP * 32;
    if (it_lo >= it_hi) return;
    const int tid = F.tid, n4 = tid & 7, kl = tid >> 3;
    LAS unsigned* tile = (LAS unsigned*)F.lds;
    LAS float* red = (LAS float*)(F.lds + 36864);
    f32x4 v[4][4];
    ConvItem cur = conv_decode(a, it_lo);
    CONV_LOAD(v, cur);
    for (int it = it_lo; it < it_hi; ++it) {
        f32x4 am = (f32x4){0.f, 0.f, 0.f, 0.f};
#pragma unroll
        for (int i = 0; i < 4; ++i)
#pragma unroll
            for (int j = 0; j < 4; ++j) { am.x = fmaxf(am.x, fabsf(v[i][j].x)); am.y = fmaxf(am.y, fabsf(v[i][j].y)); am.z = fmaxf(am.z, fabsf(v[i][j].z)); am.w = fmaxf(am.w, fabsf(v[i][j].w)); }
#pragma unroll
        for (int o = 8; o < 64; o <<= 1) { am.x = fmaxf(am.x, __shfl_xor(am.x, o)); am.y = fmaxf(am.y, __shfl_xor(am.y, o)); am.z = fmaxf(am.z, __shfl_xor(am.z, o)); am.w = fmaxf(am.w, __shfl_xor(am.w, o)); }
        if (F.lane < 8) *(LAS f32x4*)(red + F.wave * 32 + 4 * n4) = am;
        __syncthreads();
        f32x4 cm = *(const LAS f32x4*)(red + 4 * n4);
#pragma unroll
        for (int w = 1; w < 8; ++w) { const f32x4 o = *(const LAS f32x4*)(red + w * 32 + 4 * n4); cm.x = fmaxf(cm.x, o.x); cm.y = fmaxf(cm.y, o.y); cm.z = fmaxf(cm.z, o.z); cm.w = fmaxf(cm.w, o.w); }
        f32x4 inv;
#pragma unroll
        for (int c = 0; c < 4; ++c) inv[c] = cm[c] > 0.f ? 127.0f / cm[c] : 0.f;
        if (kl == 0) {
#pragma unroll
            for (int c = 0; c < 4; ++c) cur.sc[cur.dst_row0 + 4 * n4 + c] = cm[c] * (1.0f / 127.0f);
        }
#pragma unroll
        for (int i = 0; i < 4; ++i)
#pragma unroll
            for (int c = 0; c < 4; ++c) {
                unsigned d = 0u;
#pragma unroll
                for (int j = 0; j < 4; ++j) { const int q = (int)rintf(v[i][j][c] * inv[c]); d |= ((unsigned)q & 0xffu) << (8 * j); }
                tile[(4 * n4 + c) * 260 + kl + 64 * i] = d;
            }
        const ConvItem done = cur;
        if (it + 1 < it_hi) { cur = conv_decode(a, it + 1); CONV_LOAD(v, cur); }
        __syncthreads();
#pragma unroll
        for (int j = 0; j < 4; ++j) { const int ch = tid + 512 * j, n = ch >> 6, c16 = ch & 63;
            *(u32x4*)(done.dst + (size_t)(done.dst_row0 + n) * 1024 + 16 * c16) = *(const LAS u32x4*)(tile + n * 260 + 4 * c16); }
        __syncthreads();
    }
}
__device__ __forceinline__ void p0_prologue(const Frame& F, const Args& a) {
    unsigned char* ws = a.ws;
    bf16* Win_t = (bf16*)(ws + WS_WIN); bf16* Wout_t = (bf16*)(ws + WS_WOUT);
    LAS float* scr = (LAS float*)(F.lds + F.wave * 8448);
    const int gw = F.vcu * NWAVES + F.wave, NGW = F.G * NWAVES;
    constexpr int I_IN = 16 * 56, I_OUT = 16 * 32, NITEMS = I_IN + I_OUT;
    for (int it = gw; it < NITEMS; it += NGW) {
        int r = it;
        if (r < I_IN) { const int kb = r / 56, nb = r % 56; p0_item(a.in[1], INW, Win_t, D, nb * 32, kb * 64, nb * 32, scr, F.lane); continue; } r -= I_IN;
        { const int kb = r / 32, nb = r % 32; p0_item(a.in[8], D, Wout_t, D, nb * 32, kb * 64, nb * 32, scr, F.lane); }
    }
    const float* x = a.in[0]; bf16* XB = (bf16*)(ws + WS_XB);
    for (int m = gw; m < T; m += NGW) {
        const f32x4* xr = (const f32x4*)(x + (size_t)m * D) + F.lane; u32x2* o = (u32x2*)(XB + (size_t)m * D) + F.lane;
        f32x4 v[4];
#pragma unroll
        for (int j = 0; j < 4; ++j) v[j] = xr[64 * j];
#pragma unroll
        for (int j = 0; j < 4; ++j) { u32x2 w; w.x = pk2(v[j].x, v[j].y); w.y = pk2(v[j].z, v[j].w); o[64 * j] = w; }
    }
}

__device__ __forceinline__ int crow(int r, int hi) { return (r & 3) + 8 * (r >> 2) + 4 * hi; }
constexpr int AT_KROW = 144, AT_KG = 192 * AT_KROW, AT_VROW = 400, AT_VG = 64 * AT_VROW, AT_VOFF = 2 * AT_KG;
__device__ __forceinline__ void attn_wave_unit(const LAS unsigned char* lds, const bf16x8 (&qf)[4], const float sk, bf16* CAT, int tok0, int u, int h, int lane) {
    const int r32 = lane & 31, hi = lane >> 5;
    const int t0 = tok0 % SEQ, g = h >> 2;
    const int kk0 = 32 * u;
    f32x16 p[5];
    const float NEG = -INFINITY;
    const LAS unsigned char* kl = lds + g * AT_KG + (kk0 + r32) * AT_KROW + hi * 16;
#pragma unroll
    for (int j = 0; j < 5; ++j) {
        const int kb = t0 - 128 + 32 * j;
        f32x16 s;
#pragma unroll
        for (int r = 0; r < 16; ++r) s[r] = 0.f;
        if (kb >= 0) {
#pragma unroll
            for (int d0 = 0; d0 < 4; ++d0) { const bf16x8 kf = *(const LAS bf16x8*)(kl + j * 32 * AT_KROW + d0 * 32); s = __builtin_amdgcn_mfma_f32_32x32x16_bf16(kf, qf[d0], s, 0, 0, 0); }
            if (j == 0) {
#pragma unroll
                for (int r = 0; r < 16; ++r) if (!(crow(r, hi) > r32)) s[r] = NEG;
            }
            if (j == 4) {
#pragma unroll
                for (int r = 0; r < 16; ++r) if (!(crow(r, hi) <= r32)) s[r] = NEG;
            }
        } else {
#pragma unroll
            for (int r = 0; r < 16; ++r) s[r] = NEG;
        }
        p[j] = s;
    }
    float m = sk;
#pragma unroll
    for (int j = 0; j < 5; ++j)
#pragma unroll
        for (int r = 0; r < 16; ++r) m = fmaxf(m, p[j][r]);
    m = fmaxf(m, __shfl_xor(m, 32));
    float l = 0.f;
#pragma unroll
    for (int j = 0; j < 5; ++j)
#pragma unroll
        for (int r = 0; r < 16; ++r) { const float e = __builtin_amdgcn_exp2f(p[j][r] - m); p[j][r] = e; l += e; }
    l += __shfl_xor(l, 32);
    l += __builtin_amdgcn_exp2f(sk - m);
    const float inv = 1.0f / l;
    u32x4 pb[5][2];
#pragma unroll
    for (int j = 0; j < 5; ++j)
#pragma unroll
        for (int s = 0; s < 2; ++s) { pb[j][s].x = cvt_pk_bf16(p[j][8 * s + 0], p[j][8 * s + 1]); pb[j][s].y = cvt_pk_bf16(p[j][8 * s + 2], p[j][8 * s + 3]); pb[j][s].z = cvt_pk_bf16(p[j][8 * s + 4], p[j][8 * s + 5]); pb[j][s].w = cvt_pk_bf16(p[j][8 * s + 6], p[j][8 * s + 7]); }
#pragma unroll
    for (int db = 0; db < 2; ++db) {
        f32x16 o;
#pragma unroll
        for (int r = 0; r < 16; ++r) o[r] = 0.f;
        const LAS unsigned char* vl = lds + AT_VOFF + g * AT_VG + (db * 32 + r32) * AT_VROW + (kk0 + 4 * hi) * 2;
#pragma unroll
        for (int j = 0; j < 5; ++j) {
            const int kb = t0 - 128 + 32 * j;
            if (kb >= 0) {
#pragma unroll
                for (int s = 0; s < 2; ++s) {
                    const u32x2 lo = *(const LAS u32x2*)(vl + (32 * j + 16 * s) * 2), hh = *(const LAS u32x2*)(vl + (32 * j + 16 * s + 8) * 2);
                    u32x4 av; av.x = lo.x; av.y = lo.y; av.z = hh.x; av.w = hh.y;
                    o = __builtin_amdgcn_mfma_f32_32x32x16_bf16(__builtin_bit_cast(bf16x8, av), __builtin_bit_cast(bf16x8, pb[j][s]), o, 0, 0, 0);
                }
            }
        }
        bf16* op = CAT + (size_t)(tok0 + r32) * 1024 + h * 64 + db * 32 + 4 * hi;
#pragma unroll
        for (int gq = 0; gq < 4; ++gq) { u32x2 w; w.x = cvt_pk_bf16(o[4 * gq] * inv, o[4 * gq + 1] * inv); w.y = cvt_pk_bf16(o[4 * gq + 2] * inv, o[4 * gq + 3] * inv); *(u32x2*)(op + 8 * gq) = w; }
    }
}
__device__ __forceinline__ void attn_block(const Frame& F, const bf16* QB, const bf16* KB, const bf16* VT, const float* sinks, bf16* CAT, int qq) {
    const int tokb = qq * 64, b = tokb / SEQ, tb = tokb % SEQ, kbase = tb - 128;
    u32x4 kv[6], vv[6];
    bf16x8 qf0[4], qf1[4];
    { const int r32 = F.lane & 31, hi = F.lane >> 5;
#pragma unroll
      for (int d0 = 0; d0 < 4; ++d0) { qf0[d0] = *(const bf16x8*)(QB + (size_t)(tokb + r32) * 512 + F.wave * 64 + d0 * 16 + hi * 8); qf1[d0] = *(const bf16x8*)(QB + (size_t)(tokb + 32 + r32) * 512 + F.wave * 64 + d0 * 16 + hi * 8); } }
    const float sk = sinks[F.wave] * LOG2E;
#pragma unroll
    for (int i = 0; i < 6; ++i) {
        const int c = F.tid + 512 * i, g = c / 1536, rem = c % 1536;
        { const int key = rem >> 3, ch = rem & 7, pos = kbase + key;
          kv[i] = pos >= 0 ? *(const u32x4*)(KB + (size_t)(b * SEQ + pos) * 128 + g * 64 + ch * 8) : (u32x4){0u, 0u, 0u, 0u}; }
        { const int d = rem / 24, ch = rem % 24, pos = kbase + ch * 8;
          vv[i] = pos >= 0 ? *(const u32x4*)(VT + ((size_t)((b * 2 + g) * 64 + d)) * SEQ + pos) : (u32x4){0u, 0u, 0u, 0u}; }
    }
#pragma unroll
    for (int i = 0; i < 6; ++i) {
        const int c = F.tid + 512 * i, g = c / 1536, rem = c % 1536;
        *(LAS u32x4*)(F.lds + g * AT_KG + (rem >> 3) * AT_KROW + (rem & 7) * 16) = kv[i];
        *(LAS u32x4*)(F.lds + AT_VOFF + g * AT_VG + (rem / 24) * AT_VROW + (rem % 24) * 16) = vv[i];
    }
    __syncthreads();
    attn_wave_unit(F.lds, qf0, sk, CAT, tokb, 0, F.wave, F.lane);
    attn_wave_unit(F.lds, qf1, sk, CAT, tokb + 32, 1, F.wave, F.lane);
    __syncthreads();
}
template <int CTRL> __device__ __forceinline__ float dppq(float v) { return __builtin_bit_cast(float, __builtin_amdgcn_update_dpp(0, __builtin_bit_cast(int, v), CTRL, 0xF, 0xF, true)); }
constexpr int SG_WOFF = 20480, SG_WROW = 272;
__device__ __forceinline__ void sgu_stage_w(const Frame& F, const float* w_s, int gi) {
    f32x4 w[8];
#pragma unroll
    for (int i = 0; i < 8; ++i) w[i] = *(const f32x4*)(w_s + (size_t)gi * 16384 + (size_t)(F.tid + 512 * i) * 4);
#pragma unroll
    for (int i = 0; i < 8; ++i) { const int c = F.tid + 512 * i, t = c >> 5, s0 = (c & 31) * 4;
        f32x4 v = w[i];
#pragma unroll
        for (int j = 0; j < 4; ++j) if (s0 + j > t) v[j] = 0.f;
        u32x2 o; o.x = cvt_pk_bf16(v[0], v[1]); o.y = cvt_pk_bf16(v[2], v[3]);
        *(LAS u32x2*)(F.lds + SG_WOFF + t * SG_WROW + s0 * 2) = o; }
}
__device__ __forceinline__ void sgu_unit(const Frame& F, const bf16* UB, const bf16* GB, const float* ln_g, const float* ln_b, const float* w_s, const float* b_s, bf16* CAT, int ch, int gi) {
    LAS bf16* GT = (LAS bf16*)F.lds;
    const int r32 = F.lane & 31, hi = F.lane >> 5, tb = F.wave >> 1, db = F.wave & 1, t = tb * 32 + r32;
    const int nks = 2 * (tb + 1);
    const int s = F.tid >> 2, q4 = F.tid & 3; const size_t tok = (size_t)ch * 128 + s;
    const u32x4* gp = (const u32x4*)(GB + tok * 512 + gi * 64 + q4 * 16);
    const u32x4 a = gp[0], c = gp[1];
    const size_t tokt = (size_t)ch * 128 + t;
    const bf16* up = UB + tokt * 512 + gi * 64 + db * 32 + 4 * hi;
    u32x2 uu[4];
#pragma unroll
    for (int gq = 0; gq < 4; ++gq) uu[gq] = *(const u32x2*)(up + 8 * gq);
    const float bb = b_s[gi * 128 + t];
    float lg_[16], lb_[16];
#pragma unroll
    for (int i = 0; i < 16; ++i) { lg_[i] = ln_g[gi * 64 + q4 * 16 + i]; lb_[i] = ln_b[gi * 64 + q4 * 16 + i]; }
    {
        float v[16];
        v[0] = __uint_as_float(a.x << 16); v[1] = __uint_as_float(a.x & 0xffff0000u); v[2] = __uint_as_float(a.y << 16); v[3] = __uint_as_float(a.y & 0xffff0000u);
        v[4] = __uint_as_float(a.z << 16); v[5] = __uint_as_float(a.z & 0xffff0000u); v[6] = __uint_as_float(a.w << 16); v[7] = __uint_as_float(a.w & 0xffff0000u);
        v[8] = __uint_as_float(c.x << 16); v[9] = __uint_as_float(c.x & 0xffff0000u); v[10] = __uint_as_float(c.y << 16); v[11] = __uint_as_float(c.y & 0xffff0000u);
        v[12] = __uint_as_float(c.z << 16); v[13] = __uint_as_float(c.z & 0xffff0000u); v[14] = __uint_as_float(c.w << 16); v[15] = __uint_as_float(c.w & 0xffff0000u);
        float sum = 0.f;
#pragma unroll
        for (int i = 0; i < 16; ++i) sum += v[i];
        sum += dppq<0xB1>(sum); sum += dppq<0x4E>(sum);
        const float mu = sum * (1.f / 64.f); float q = 0.f;
#pragma unroll
        for (int i = 0; i < 16; ++i) { v[i] -= mu; q += v[i] * v[i]; }
        q += dppq<0xB1>(q); q += dppq<0x4E>(q);
        const float rstd = rsqrtf(q * (1.f / 64.f) + LN_EPS);
#pragma unroll
        for (int i = 0; i < 16; ++i) { const int d = q4 * 16 + i; GT[d * 136 + s] = (bf16)f2bf(v[i] * rstd * lg_[i] + lb_[i]); }
    }
    __syncthreads();
    {
        f32x16 acc;
#pragma unroll
        for (int r = 0; r < 16; ++r) acc[r] = 0.f;
        const LAS bf16* arow = GT + (db * 32 + r32) * 136 + hi * 8;
        const LAS unsigned char* wlds = F.lds + SG_WOFF + t * SG_WROW + hi * 16;
#pragma unroll
        for (int ks = 0; ks < 8; ++ks) if (ks < nks) {
            const bf16x8 af = *(const LAS bf16x8*)(arow + ks * 16);
            const bf16x8 bw = *(const LAS bf16x8*)(wlds + ks * 32);
            acc = __builtin_amdgcn_mfma_f32_32x32x16_bf16(af, bw, acc, 0, 0, 0);
        }
        bf16* op = CAT + tokt * 1024 + 512 + gi * 64 + db * 32 + 4 * hi;
#pragma unroll
        for (int gq = 0; gq < 4; ++gq) {
            const float u0 = __uint_as_float(uu[gq].x << 16), u1 = __uint_as_float(uu[gq].x & 0xffff0000u), u2 = __uint_as_float(uu[gq].y << 16), u3 = __uint_as_float(uu[gq].y & 0xffff0000u);
            u32x2 w; w.x = cvt_pk_bf16(u0 * (acc[4 * gq] + bb), u1 * (acc[4 * gq + 1] + bb)); w.y = cvt_pk_bf16(u2 * (acc[4 * gq + 2] + bb), u3 * (acc[4 * gq + 3] + bb));
            *(u32x2*)(op + 8 * gq) = w;
        }
    }
    __syncthreads();
}
__device__ __forceinline__ void p2_mixers(const Frame& F, const Args& a) {
    unsigned char* ws = a.ws;
    const bf16 *QB = (const bf16*)(ws + WS_QB), *KB = (const bf16*)(ws + WS_KB), *VT = (const bf16*)(ws + WS_VT), *UB = (const bf16*)(ws + WS_UB), *GB = (const bf16*)(ws + WS_GB);
    bf16* CAT = (bf16*)(ws + WS_CAT);
    for (int qq = F.vcu; qq < T / 64; qq += F.G) attn_block(F, QB, KB, VT, a.in[3], CAT, qq);
    int gi_staged = -1;
    for (int u = F.vcu; u < (T / 128) * 8; u += F.G) {
        if ((u & 7) != gi_staged) { __syncthreads(); sgu_stage_w(F, a.in[6], u & 7); gi_staged = u & 7; }
        sgu_unit(F, UB, GB, a.in[4], a.in[5], a.in[6], a.in[7], CAT, u >> 3, u & 7);
    }
}

template <int CTRL> __device__ __forceinline__ float dppf(float v) { return __builtin_bit_cast(float, __builtin_amdgcn_update_dpp(0, __builtin_bit_cast(int, v), CTRL, 0xF, 0xF, true)); }
__device__ __forceinline__ float swap16_sum(float x, float y) { auto r = __builtin_amdgcn_permlane16_swap(__builtin_bit_cast(unsigned, x), __builtin_bit_cast(unsigned, y), false, false); return __builtin_bit_cast(float, r[0]) + __builtin_bit_cast(float, r[1]); }
__device__ __forceinline__ float swap32_sum(float x, float y) { auto r = __builtin_amdgcn_permlane32_swap(__builtin_bit_cast(unsigned, x), __builtin_bit_cast(unsigned, y), false, false); return __builtin_bit_cast(float, r[0]) + __builtin_bit_cast(float, r[1]); }
__device__ __forceinline__ float rdlane(float v, int l) { return __builtin_bit_cast(float, __builtin_amdgcn_readlane(__builtin_bit_cast(int, v), l)); }
__device__ __forceinline__ float xsum(float v) {
    v += dppf<0xB1>(v); v += dppf<0x4E>(v); v += dppf<0x124>(v); v += dppf<0x128>(v);
    return (rdlane(v, 0) + rdlane(v, 16)) + (rdlane(v, 32) + rdlane(v, 48));
}
__device__ __forceinline__ float xmax(float v) {
    v = fmaxf(v, dppf<0xB1>(v)); v = fmaxf(v, dppf<0x4E>(v)); v = fmaxf(v, dppf<0x124>(v)); v = fmaxf(v, dppf<0x128>(v));
    return fmaxf(fmaxf(rdlane(v, 0), rdlane(v, 16)), fmaxf(rdlane(v, 32), rdlane(v, 48)));
}
__device__ __forceinline__ void p4_router(const Frame& F, const Args& a, bool commit) {
    const float* Zin = a.out; bf16* Hout = (bf16*)(a.ws + WS_H); signed char* HB8 = (signed char*)(a.ws + WS_HB); int* meta = (int*)(a.ws + WS_META); unsigned* cnt = (unsigned*)(a.ws + WS_CTL) + CW_CNT;
    const float* ln1_g = a.in[10]; const float* ln1_b = a.in[11]; const float* w_r = a.in[12]; const float* b_r = a.in[13];
    LAS float* W = (LAS float*)F.lds;
    LAS unsigned* hist = (LAS unsigned*)(F.lds + RSCR_OFF);
    LAS unsigned* base = hist + 32;
    LAS int* tmp_e = (LAS int*)(hist + 64);
    LAS int* tmp_p = tmp_e + 256;
    LAS float* tmp_g = (LAS float*)(tmp_p + 256);
    LAS float* tmp_s = tmp_g + 256;
    int* el_tok = (int*)(a.ws + WS_ELIST); float* el_gate = (float*)(a.ws + WS_ELIST) + NEXP * T; float* el_sa = el_gate + NEXP * T;
    {
        f32x4 t[16];
#pragma unroll
        for (int k = 0; k < 16; ++k) t[k] = *(const f32x4*)(w_r + (size_t)(F.tid + 512 * k) * 4);
#pragma unroll
        for (int k = 0; k < 16; ++k) { const int i = F.tid + 512 * k, c = i >> 3, e4 = i & 7, pr = (c & ~255) + 64 * (c & 3) + ((c >> 2) & 63); *(LAS f32x4*)(W + pr * 36 + e4 * 4) = t[k]; }
    }
    const int lane = F.lane, half = lane >> 5, el = lane & 31;
    LAS float* gbl = (LAS float*)(F.lds + 151552);
    for (int i = F.tid; i < 512; i += NWAVES * 64) *(LAS f32x4*)(gbl + 4 * i) = i < 256 ? *(const f32x4*)(ln1_g + 4 * i) : *(const f32x4*)(ln1_b + 4 * (i - 256));
    for (int tb = F.vcu; tb < T / 64; tb += F.G) {
        if (F.tid < 32) hist[F.tid] = 0u;
        __syncthreads();
        float zn0[16], zn1[16];
        { const f32x4* z0 = (const f32x4*)(Zin + (size_t)(tb * 64 + 8 * F.wave) * D) + lane;
#pragma unroll
          for (int j = 0; j < 4; ++j) { const f32x4 a0 = z0[64 * j], a1 = z0[256 + 64 * j];
#pragma unroll
            for (int k = 0; k < 4; ++k) { zn0[4 * j + k] = a0[k]; zn1[4 * j + k] = a1[k]; } } }
        for (int pp = 0; pp < 4; ++pp) {
            const int tl0 = 8 * F.wave + 2 * pp;
            const int tok0 = tb * 64 + tl0;
            float h0[16], h1[16];
            {
                u32x2* ho0 = (u32x2*)(Hout + (size_t)tok0 * D) + lane; u32x2* ho1 = ho0 + 256;
                float s0 = 0.f, s1 = 0.f, q0 = 0.f, q1 = 0.f;
#pragma unroll
                for (int i = 0; i < 16; ++i) { h0[i] = zn0[i]; h1[i] = zn1[i]; }
                if (pp < 3) { const f32x4* zp = (const f32x4*)(Zin + (size_t)(tok0 + 2) * D) + lane;
#pragma unroll
                    for (int j = 0; j < 4; ++j) { const f32x4 a0 = zp[64 * j], a1 = zp[256 + 64 * j];
#pragma unroll
                        for (int k = 0; k < 4; ++k) { zn0[4 * j + k] = a0[k]; zn1[4 * j + k] = a1[k]; } } }
#pragma unroll
                for (int i = 0; i < 16; ++i) { s0 += h0[i]; s1 += h1[i]; q0 += h0[i] * h0[i]; q1 += h1[i] * h1[i]; }
                s0 = xsum(s0); s1 = xsum(s1); q0 = xsum(q0); q1 = xsum(q1);
                const float m0 = s0 * (1.f / D), m1 = s1 * (1.f / D);
                const float r0 = rsqrtf(fmaxf(q0 * (1.f / D) - m0 * m0, 0.f) + LN_EPS), r1 = rsqrtf(fmaxf(q1 * (1.f / D) - m1 * m1, 0.f) + LN_EPS);
                float a0 = 0.f, a1 = 0.f;
#pragma unroll
                for (int i = 0; i < 16; ++i) {
                    const float gm_ = gbl[4 * lane + 256 * (i >> 2) + (i & 3)], bt_ = gbl[1024 + 4 * lane + 256 * (i >> 2) + (i & 3)];
                    h0[i] = (h0[i] - m0) * r0 * gm_ + bt_; h1[i] = (h1[i] - m1) * r1 * gm_ + bt_;
                    a0 = fmaxf(a0, fabsf(h0[i])); a1 = fmaxf(a1, fabsf(h1[i]));
                }
                a0 = xmax(a0); a1 = xmax(a1);
                const float i0 = a0 > 0.f ? 127.0f / a0 : 0.f, i1 = a1 > 0.f ? 127.0f / a1 : 0.f;
                unsigned* hb0 = (unsigned*)(HB8 + (size_t)tok0 * D) + lane; unsigned* hb1 = hb0 + 256;
#pragma unroll
                for (int j = 0; j < 4; ++j) {
                    { u32x2 w0, w1; w0.x = cvt_pk_bf16(h0[4 * j], h0[4 * j + 1]); w0.y = cvt_pk_bf16(h0[4 * j + 2], h0[4 * j + 3]); w1.x = cvt_pk_bf16(h1[4 * j], h1[4 * j + 1]); w1.y = cvt_pk_bf16(h1[4 * j + 2], h1[4 * j + 3]); ho0[64 * j] = w0; ho1[64 * j] = w1; }
                    unsigned p0 = 0u, p1 = 0u;
#pragma unroll
                    for (int k = 0; k < 4; ++k) { p0 |= ((unsigned)(int)rintf(h0[4 * j + k] * i0) & 0xffu) << (8 * k); p1 |= ((unsigned)(int)rintf(h1[4 * j + k] * i1) & 0xffu) << (8 * k); }
                    hb0[64 * j] = p0; hb1[64 * j] = p1;
                }
                if (lane == 0) { tmp_s[tl0] = a0 * (1.0f / 127.0f); tmp_s[tl0 + 1] = a1 * (1.0f / 127.0f); }
            }
            f32x2 lp0[16], lp1[16];
#pragma unroll
            for (int e = 0; e < 16; ++e) { lp0[e] = (f32x2){0.f, 0.f}; lp1[e] = (f32x2){0.f, 0.f}; }
#pragma unroll
            for (int i = 0; i < 16; ++i) {
                const LAS f32x4* wr = (const LAS f32x4*)(W + (256 * (i >> 2) + 64 * (i & 3) + lane) * 36);
                const f32x2 hv0 = (f32x2){h0[i], h0[i]}, hv1 = (f32x2){h1[i], h1[i]};
#pragma unroll
                for (int e4 = 0; e4 < 8; ++e4) {
                    const f32x4 ww = wr[e4];
                    const f32x2 wlo = (f32x2){ww.x, ww.y}, whi = (f32x2){ww.z, ww.w};
                    lp0[2 * e4] = __builtin_elementwise_fma(hv0, wlo, lp0[2 * e4]); lp0[2 * e4 + 1] = __builtin_elementwise_fma(hv0, whi, lp0[2 * e4 + 1]);
                    lp1[2 * e4] = __builtin_elementwise_fma(hv1, wlo, lp1[2 * e4]); lp1[2 * e4 + 1] = __builtin_elementwise_fma(hv1, whi, lp1[2 * e4 + 1]);
                }
            }
            float lg0[32], lg1[32];
#pragma unroll
            for (int e = 0; e < 16; ++e) { lg0[2 * e] = lp0[e].x; lg0[2 * e + 1] = lp0[e].y; lg1[2 * e] = lp1[e].x; lg1[2 * e + 1] = lp1[e].y; }
            float v32[32];
#pragma unroll
            for (int e = 0; e < 32; ++e) { const float keep = half ? lg1[e] : lg0[e], send = half ? lg0[e] : lg1[e]; v32[e] = keep + __shfl_xor(send, 32); }
            float v16[16];
#pragma unroll
            for (int e = 0; e < 16; ++e) { const bool up = (lane & 16) != 0; const float keep = up ? v32[e + 16] : v32[e], send = up ? v32[e] : v32[e + 16]; v16[e] = keep + __shfl_xor(send, 16); }
            float v8[8];
#pragma unroll
            for (int e = 0; e < 8; ++e) { const bool up = (lane & 8) != 0; const float keep = up ? v16[e + 8] : v16[e], send = up ? v16[e] : v16[e + 8]; v8[e] = keep + dppf<0x128>(send); }
            float v4[4];
#pragma unroll
            for (int e = 0; e < 4; ++e) { const bool up = (lane & 4) != 0; const float keep = up ? v8[e + 4] : v8[e], send = up ? v8[e] : v8[e + 4]; v4[e] = keep + dppf<0x1B>(dppf<0x141>(send)); }
            float v2[2];
#pragma unroll
            for (int e = 0; e < 2; ++e) { const bool up = (lane & 2) != 0; const float keep = up ? v4[e + 2] : v4[e], send = up ? v4[e] : v4[e + 2]; v2[e] = keep + dppf<0x4E>(send); }
            float lgt;
            { const bool up = (lane & 1) != 0; const float keep = up ? v2[1] : v2[0], send = up ? v2[0] : v2[1]; lgt = keep + dppf<0xB1>(send); }
            lgt += b_r[el];
            float bv[4]; int bi[4];
            {
                float cur = lgt;
#pragma unroll
                for (int k = 0; k < 4; ++k) {
                    float mx = cur;
                    mx = fmaxf(mx, dppf<0xB1>(mx)); mx = fmaxf(mx, dppf<0x4E>(mx)); mx = fmaxf(mx, dppf<0x124>(mx)); mx = fmaxf(mx, dppf<0x128>(mx));
                    const float m0 = fmaxf(rdlane(mx, 0), rdlane(mx, 16)), m1 = fmaxf(rdlane(mx, 32), rdlane(mx, 48));
                    const float mm = half ? m1 : m0;
                    const unsigned long long mk = __ballot(cur == mm);
                    const int i0 = __builtin_ctz((unsigned)mk | 0x80000000u), i1 = __builtin_ctz((unsigned)(mk >> 32) | 0x80000000u);
                    bv[k] = mm; bi[k] = half ? i1 : i0;
                    if (el == bi[k]) cur = -INFINITY;
                }
            }
            float ex[4], es = 0.f;
#pragma unroll
            for (int k = 0; k < 4; ++k) { ex[k] = __expf(bv[k] - bv[0]); es += ex[k]; }
            if (el == 0) {
                const int tl = tl0 + half;
#pragma unroll
                for (int k = 0; k < 4; ++k) { const unsigned pl = atomicAdd((unsigned*)&hist[bi[k]], 1u); tmp_e[tl * 4 + k] = bi[k]; tmp_p[tl * 4 + k] = (int)pl; tmp_g[tl * 4 + k] = ex[k] / es; }
            }
        }
        __syncthreads();
        if (F.tid < 32) base[F.tid] = commit ? atomicAdd(&cnt[F.tid], hist[F.tid]) : 0u;
        __syncthreads();
        if (F.tid < 256) { const int i = F.tid, gi = tb * 256 + i, e = tmp_e[i];
            const int pos = (int)base[e] + tmp_p[i];
            meta[MT_SEL_E + gi] = e; meta[MT_SEL_POS + gi] = pos;
            el_tok[e * T + pos] = tb * 64 + (i >> 2); el_gate[e * T + pos] = tmp_g[i]; el_sa[e * T + pos] = tmp_s[i >> 2]; }
        __syncthreads();
    }
}
__device__ __forceinline__ void build_tables(const Frame& F, const Args& a) {
    const unsigned* cnt = (const unsigned*)(a.ws + WS_CTL) + CW_CNT;
    LAS int* tb = (LAS int*)(F.lds + RSCR_OFF);
    __syncthreads();
    if (F.tid < 32) tb[TBL_CNT + F.tid] = (int)__hip_atomic_load(cnt + F.tid, RLX_AGENT);
    __syncthreads();
    if (F.tid == 0) { int acc = 0; for (int e = 0; e < 32; ++e) { tb[TBL_TS + e] = acc; acc += (tb[TBL_CNT + e] + 255) >> 8; } tb[TBL_TS + 32] = acc; }
    __syncthreads();
    for (int t = F.tid; t < NT_MAX; t += NWAVES * 64) { int e = 0; for (int j = 1; j < 32; ++j) if (t >= tb[TBL_TS + j]) e = j; tb[TBL_TILE + t] = e; }
    __syncthreads();
}
__device__ __forceinline__ void p7_quant(const Frame& F, const Args& a) {
    const bf16* HID = (const bf16*)(a.ws + WS_HID); signed char* H8 = (signed char*)(a.ws + WS_HID8); float* row_sb = (float*)(a.ws + WS_ROWSB);
    const int nrows = __builtin_amdgcn_readfirstlane(((const LAS int*)(F.lds + RSCR_OFF))[TBL_TS + 32]) * 256;
    const int gw = F.vcu * NWAVES + F.wave, NGW = F.G * NWAVES, lane = F.lane;
    for (int r0 = gw * 4; r0 < nrows; r0 += NGW * 4) {
        u32x4 v[4][2];
#pragma unroll
        for (int i = 0; i < 4; ++i)
#pragma unroll
            for (int j = 0; j < 2; ++j) v[i][j] = *((const u32x4*)(HID + (size_t)(r0 + i) * DFF + 512 * j) + lane);
#pragma unroll
        for (int i = 0; i < 4; ++i) {
            float f[16]; float am = 0.f;
#pragma unroll
            for (int j = 0; j < 2; ++j)
#pragma unroll
                for (int c = 0; c < 4; ++c) { const unsigned w = v[i][j][c]; f[8 * j + 2 * c] = __uint_as_float(w << 16); f[8 * j + 2 * c + 1] = __uint_as_float(w & 0xffff0000u); }
#pragma unroll
            for (int c = 0; c < 16; ++c) am = fmaxf(am, fabsf(f[c]));
            am = xmax(am);
            const float inv = am > 0.f ? 127.0f / am : 0.f;
#pragma unroll
            for (int j = 0; j < 2; ++j) {
                u32x2 o; o.x = 0u; o.y = 0u;
#pragma unroll
                for (int c = 0; c < 4; ++c) { o.x |= ((unsigned)(int)rintf(f[8 * j + c] * inv) & 0xffu) << (8 * c); o.y |= ((unsigned)(int)rintf(f[8 * j + 4 + c] * inv) & 0xffu) << (8 * c); }
                *((u32x2*)(H8 + (size_t)(r0 + i) * DFF + 512 * j) + lane) = o;
            }
            if (lane == 0) row_sb[r0 + i] = am * (1.0f / 127.0f);
        }
    }
}
__device__ __forceinline__ void p8_final(const Frame& F, const Args& a) {
    const bf16* Hin = (const bf16*)(a.ws + WS_H); float* HO = a.out; const unsigned char* Y = (const unsigned char*)(a.ws + WS_Y); const int* meta = (const int*)(a.ws + WS_META);
    const float* ln2_g = a.in[20]; const float* ln2_b = a.in[21]; const LAS int* tsl = (const LAS int*)(F.lds + RSCR_OFF) + TBL_TS;
    const int gw = F.vcu * NWAVES + F.wave, NGW = F.G * NWAVES, lane = F.lane;
    f32x4 g2[4], b2[4];
#pragma unroll
    for (int j = 0; j < 4; ++j) { g2[j] = *(const f32x4*)(ln2_g + 4 * lane + 256 * j); b2[j] = *(const f32x4*)(ln2_b + 4 * lane + 256 * j); }
    for (int tok = gw; tok < T; tok += NGW) {
        f32x4* hr = (f32x4*)(HO + (size_t)tok * D) + lane; const u32x2* hi_ = (const u32x2*)(Hin + (size_t)tok * D) + lane;
        f32x4 v[4]; float s = 0.f;
#pragma unroll
        for (int j = 0; j < 4; ++j) { const u32x2 hh = hi_[64 * j]; v[j] = (f32x4){__uint_as_float(hh.x << 16), __uint_as_float(hh.x & 0xffff0000u), __uint_as_float(hh.y << 16), __uint_as_float(hh.y & 0xffff0000u)} * ALPHA; }
#pragma unroll
        for (int k = 0; k < 4; ++k) {
            const int row = tsl[meta[MT_SEL_E + tok * 4 + k]] * 256 + meta[MT_SEL_POS + tok * 4 + k];
            const unsigned* yr = (const unsigned*)(Y + (size_t)row * D) + lane;
#pragma unroll
            for (int j = 0; j < 4; ++j) { const int y = (int)yr[64 * j]; const f32x2 lo = __builtin_amdgcn_cvt_pk_f32_fp8(y, false), hi2 = __builtin_amdgcn_cvt_pk_f32_fp8(y, true);
                v[j].x += lo.x * (1.0f / YSCALE); v[j].y += lo.y * (1.0f / YSCALE); v[j].z += hi2.x * (1.0f / YSCALE); v[j].w += hi2.y * (1.0f / YSCALE); }
        }
#pragma unroll
        for (int j = 0; j < 4; ++j) s += (v[j].x + v[j].y) + (v[j].z + v[j].w);
        const float mean = xsum(s) * (1.f / D); float s2 = 0.f;
#pragma unroll
        for (int j = 0; j < 4; ++j) { v[j] = v[j] - mean; s2 += (v[j].x * v[j].x + v[j].y * v[j].y) + (v[j].z * v[j].z + v[j].w * v[j].w); }
        const float rstd = rsqrtf(xsum(s2) * (1.f / D) + LN_EPS);
#pragma unroll
        for (int j = 0; j < 4; ++j) hr[64 * j] = v[j] * rstd * g2[j] + b2[j];
    }
}
__global__ void __launch_bounds__(NWAVES * 64, 2) mk_fwd(Args args) {
    extern __shared__ __attribute__((aligned(16))) unsigned char lds_raw[];
    Frame F;
    F.lds = (LAS unsigned char*)lds_raw;
    F.tid = threadIdx.x; F.lane = F.tid & 63; F.wave = __builtin_amdgcn_readfirstlane(F.tid >> 6);
    F.G = gridDim.x; { const int bx = blockIdx.x; F.vcu = (F.G % 8 == 0) ? (bx % 8) * (F.G / 8) + bx / 8 : bx; }
    volatile LAS unsigned* MISC = (volatile LAS unsigned*)(F.lds + MISC_OFF);
    if (F.tid < 64) MISC[F.tid] = 0u;
    __syncthreads();
    unsigned char* ws = args.ws;
    unsigned* ctl = (unsigned*)(ws + WS_CTL);
    const int lo = args.ph_lo, hi = args.ph_hi;
    XcdBarrier bar; bar.bar = ctl + CW_BAR + args.li * XCD_BAR_WORDS; bar.x = 0; bar.st = nullptr;
    if (hi - lo > 1) bar = xcd_barrier_post(ctl + CW_BAR + args.li * XCD_BAR_WORDS, MISC + 8);
#define IN(k) (lo <= (k) && (k) < hi)
#define OPAQUE_F(Fp) Frame Fp = F; asm volatile("" : "+v"(Fp.tid)); Fp.lane = Fp.tid & 63
#define SEAM(k) do { if (IN(k) && IN((k) + 1)) xcd_barrier(bar); } while (0)
    int* meta = (int*)(ws + WS_META);
    bf16 *XB = (bf16*)(ws + WS_XB), *QB = (bf16*)(ws + WS_QB), *KB = (bf16*)(ws + WS_KB), *VT = (bf16*)(ws + WS_VT), *UB = (bf16*)(ws + WS_UB), *GB = (bf16*)(ws + WS_GB);
    bf16 *CAT = (bf16*)(ws + WS_CAT), *HB = (bf16*)(ws + WS_HB), *Y = (bf16*)(ws + WS_Y), *HID = (bf16*)(ws + WS_HID);
    bf16 *Win_t = (bf16*)(ws + WS_WIN), *Wout_t = (bf16*)(ws + WS_WOUT), *Wgu_t = (bf16*)(ws + WS_WGU), *Wd_t = (bf16*)(ws + WS_WD);
    const LAS int* rtab = (const LAS int*)(F.lds + RTAB_OFF);
    const bool par = ((blockIdx.x >> 3) & 1) != 0;

    if (IN(0)) { OPAQUE_F(Fp); p0_prologue(Fp, args); SEAM(0); }
    if (IN(1)) {
        const int c = (int)blockIdx.x, grp = (c >> 3) % 3;
        const int per_ = (3 * NEXP * 32 + F.G - 1) / F.G;
        const int it_lo = F.G == 256 ? (c < 192 ? c * 10 : 1920 + (c - 192) * 18) : c * per_, it_hi = F.G == 256 ? it_lo + (c < 192 ? 10 : 18) : it_lo + per_;
        OPAQUE_F(Fp);
        if (grp == 0) conv_items(Fp, args, it_lo, it_hi);
        { pg8::Gemm g{XB, Win_t, 2 * D, nullptr, 0u}; pg8::StaticOrder S; S.init(T / 256, INW / 256, F.G, c); S.i1 = 1;
          pg8::EpiInProj E{args.in[2], QB, KB, VT, UB, GB};
          pg8::gemm_phase<pg8::EpiInProj, false, true, false>(F.lds, rtab, g, S, E); }
        if (grp == 1) conv_items(Fp, args, it_lo, it_hi);
        { pg8::Gemm g{XB, Win_t, 2 * D, nullptr, 0u}; pg8::StaticOrder S; S.init(T / 256, INW / 256, F.G, c); S.i0 = 1;
          pg8::EpiInProj E{args.in[2], QB, KB, VT, UB, GB};
          pg8::gemm_phase<pg8::EpiInProj, false, true, false>(F.lds, rtab, g, S, E); }
        if (grp == 2) conv_items(Fp, args, it_lo, it_hi);
        SEAM(1);
    }
    if (IN(2)) { OPAQUE_F(Fp); p2_mixers(Fp, args); SEAM(2); }
    if (IN(3)) {
        pg8::Gemm g{CAT, Wout_t, 2 * D, nullptr, 0u}; pg8::StaticOrder S; S.init(T / 256, D / 256, F.G, (int)blockIdx.x);
        pg8::EpiOutProj E{args.in[0], args.in[9], args.out};
        pg8::gemm_phase<pg8::EpiOutProj, false, false, false>(F.lds, rtab, g, S, E);
        SEAM(3);
    }
    if (IN(4)) { OPAQUE_F(Fp); p4_router(Fp, args, true); if (hi > 5) xcd_barrier(bar); }
    const LAS int* tbl = (const LAS int*)(F.lds + RSCR_OFF);
    if (hi > 5) { OPAQUE_F(Fp); build_tables(Fp, args); }
    if (IN(6)) {
        const int nT = __builtin_amdgcn_readfirstlane(tbl[TBL_TS + 32]);
        pg8::StaticOrder S; S.init(nT, 2 * DFF / 256, F.G, (int)blockIdx.x);
        { pg8::Unit u; LAS int* rt = (LAS int*)(F.lds + RTAB_OFF); const int* el_tok = (const int*)(ws + WS_ELIST);
          for (int i = 0; i < RTAB_UNITS && S.next(i, u); ++i) if (F.tid < 256) { const int e = tbl[TBL_TILE + u.pm], ix = (u.pm - tbl[TBL_TS + e]) * 256 + F.tid; rt[i * 256 + F.tid] = ix < tbl[TBL_CNT + e] ? el_tok[e * T + ix] : 0; }
          __syncthreads(); }
        pg8::Gemm g{HB, Wgu_t, D, tbl + TBL_TILE, 2048u * 1024u};
        pg8::EpiSwiglu E{tbl, args.in[15], args.in[17], (const float*)(ws + WS_SWGU), (const float*)(ws + WS_ELIST) + 2 * NEXP * T, HID};
        pg8::gemm_phase<pg8::EpiSwiglu, true, true, true>(F.lds, rtab, g, S, E);
        SEAM(6);
    }
    if (IN(7)) { OPAQUE_F(Fp); p7_quant(Fp, args); SEAM(7); }
    if (IN(8)) {
        const int nT = __builtin_amdgcn_readfirstlane(tbl[TBL_TS + 32]);
        pg8::StaticOrder S; S.init(nT, D / 256, F.G, (int)blockIdx.x);
        pg8::Gemm g{ws + WS_HID8, Wd_t, DFF, tbl + TBL_TILE, 1024u * 1024u};
        pg8::EpiDown E{tbl, args.in[19], (const float*)(ws + WS_SWD), (const float*)(ws + WS_ROWSB), (const float*)(ws + WS_ELIST) + NEXP * T, (unsigned char*)Y};
        pg8::gemm_phase<pg8::EpiDown, false, true, true>(F.lds, rtab, g, S, E);
        SEAM(8);
    }
    if (IN(9)) { OPAQUE_F(Fp); p8_final(Fp, args); }
#undef IN
#undef SEAM
}

extern "C" void kernel_launch(void* const* d_in, const int* in_sizes, int n_in, void* d_out, int out_size, void* d_ws, size_t ws_size, hipStream_t stream) {
    static int grid = 0;
    if (grid == 0) {
        if (n_in != 22 || in_sizes[0] != T * D || out_size != T * D || ws_size < WS_END) { fprintf(stderr, "kernel_launch: unexpected shapes (n_in %d, in0 %d, out %d, ws %zu, need %zu)\n", n_in, n_in > 0 ? in_sizes[0] : -1, out_size, ws_size, (size_t)WS_END); grid = -1; return; }
        int dev = 0, cus = 0;
        if (hipGetDevice(&dev) != hipSuccess || hipDeviceGetAttribute(&cus, hipDeviceAttributeMultiprocessorCount, dev) != hipSuccess) { grid = -1; return; }
        if (hipFuncSetAttribute((const void*)mk_fwd, hipFuncAttributeMaxDynamicSharedMemorySize, LDS_BYTES) != hipSuccess) { fprintf(stderr, "kernel_launch: hipFuncSetAttribute failed\n"); grid = -1; return; }
        int per_cu = 0;
        if (hipOccupancyMaxActiveBlocksPerMultiprocessor(&per_cu, (const void*)mk_fwd, NWAVES * 64, LDS_BYTES) != hipSuccess || per_cu < 1) fprintf(stderr, "kernel_launch: occupancy query reports %d\n", per_cu);
        (void)hipGetLastError();
        grid = cus;
    }
    if (grid < 0) return;
    unsigned char* ws = (unsigned char*)d_ws; float* out = (float*)d_out;
    (void)hipMemsetAsync(ws + WS_CTL, 0, 64 * 1024, stream);
    Args a{};
    for (int i = 0; i < 22; ++i) a.in[i] = (const float*)d_in[i];
    a.out = out; a.ws = ws;
    a.ph_lo = 0; a.ph_hi = NPHASES; a.li = 0;
    hipLaunchKernelGGL(mk_fwd, dim3(grid), dim3(NWAVES * 64), LDS_BYTES, stream, a);
}
```

```cpp
#include <hip/hip_runtime.h>
#include <cstdio>
#include <cstdint>

typedef unsigned short bf16;
typedef float f32x4 __attribute__((ext_vector_type(4)));
typedef unsigned u32x4 __attribute__((ext_vector_type(4)));
typedef unsigned u32x2 __attribute__((ext_vector_type(2)));

constexpr int BATCH = 2, SEQ = 8192, D = 1024, T = BATCH * SEQ;
constexpr int NQH = 8, NKVH = 2, HD = 64, QREP = 4, AW = 512, KVW = 128, GW = 512, INW = 1792;
constexpr int NEXP = 32, TOPK = 4, DFF = 1024;
constexpr int NT_MAX = T * TOPK / 256 + NEXP;
constexpr int NROWS_MAX = NT_MAX * 256;
constexpr float LN_EPS = 1e-5f;
constexpr float ALPHA = 1.189207115002721f;
constexpr float C2 = 0.125f * 1.4426950408889634f;
constexpr float LOG2E = 1.4426950408889634f;
constexpr float YSCALE = 16.0f;

constexpr size_t MiB = 1u << 20;
constexpr size_t WS_CTL = 0;
constexpr size_t WS_META = 1 * MiB;
constexpr size_t WS_XB = 3 * MiB;
constexpr size_t WS_QB = WS_XB + 32 * MiB;
constexpr size_t WS_KB = WS_QB + 16 * MiB;
constexpr size_t WS_VT = WS_KB + 4 * MiB;
constexpr size_t WS_UB = WS_VT + 4 * MiB;
constexpr size_t WS_GB = WS_UB + 16 * MiB;
constexpr size_t WS_CAT = WS_GB + 16 * MiB;
constexpr size_t WS_HB = WS_CAT + 32 * MiB;
constexpr size_t WS_H = WS_XB;
constexpr size_t WS_HID = WS_HB + 32 * MiB;
constexpr size_t WS_Y = WS_HID;
static_assert(WS_H + 64 * MiB <= WS_CAT, "H overlay");

constexpr int CW_CNT = 64;
constexpr int MT_NT = 0;
constexpr int MT_TSTART = 16;
constexpr int MT_TILE_E = 64;
constexpr int MT_SEL_E = 1024;
constexpr int MT_SEL_POS = MT_SEL_E + T * 4;
constexpr int MT_SEL_G = MT_SEL_POS + T * 4;
constexpr int MT_SLOT_ROW = MT_SEL_G + T * 4;
constexpr int MT_ROW_TOK = MT_SLOT_ROW + T * 4;
constexpr int MT_ROW_GATE = MT_ROW_TOK + NROWS_MAX;
constexpr int MT_ROW_SA = MT_ROW_GATE + NROWS_MAX;
constexpr int MT_SH = MT_ROW_SA + NROWS_MAX;
constexpr size_t WS_ELIST = WS_GB;
constexpr int TBL_CNT = 0, TBL_TS = 32, TBL_TILE = 72;
constexpr size_t WS_ROWSB = 512 * 1024;
static_assert((size_t)(MT_SH + T) * 4 <= 2 * MiB, "meta");

__device__ __forceinline__ float bf2f(bf16 v) { return __uint_as_float((unsigned)v << 16); }
__device__ __forceinline__ unsigned f2bf(float f) { unsigned u = __float_as_uint(f); return (u + 0x7fffu + ((u >> 16) & 1u)) >> 16; }
__device__ __forceinline__ unsigned pk2(float lo, float hi) { return f2bf(lo) | (f2bf(hi) << 16); }
__device__ __forceinline__ float gelu_tanh(float x) {
    const float k2 = 2.0f * 0.7978845608028654f;
    const float u = k2 * (x + 0.044715f * x * x * x);
    return x / (1.0f + __expf(-u));
}
__device__ __forceinline__ float wave_sum(float v) {
#pragma unroll
    for (int o = 1; o < 64; o <<= 1) v += __shfl_xor(v, o);
    return v;
}
__device__ __forceinline__ float wave_max(float v) {
#pragma unroll
    for (int o = 1; o < 64; o <<= 1) v = fmaxf(v, __shfl_xor(v, o));
    return v;
}

#define LAS __attribute__((address_space(3)))
#define GAS __attribute__((address_space(1)))
typedef short bf16x8 __attribute__((ext_vector_type(8)));
typedef float f32x16 __attribute__((ext_vector_type(16)));
typedef float f32x2 __attribute__((ext_vector_type(2)));
__device__ __forceinline__ unsigned cvt_pk_bf16(float lo, float hi) { unsigned r; asm volatile("v_cvt_pk_bf16_f32 %0, %1, %2" : "=v"(r) : "v"(lo), "v"(hi)); return r; }
__device__ __forceinline__ float fast_gelu(float x) {
    const float u = -2.0f * 0.7978845608028654f * LOG2E * (x + 0.044715f * x * x * x);
    return x * __builtin_amdgcn_rcpf(1.0f + __builtin_amdgcn_exp2f(u));
}
__device__ __forceinline__ void st16_wt(void* p, u32x4 v) {
    *(u32x4*)p = v;
}
namespace pg8 {
constexpr int BM = 256, BK = 64, HALF = 128, HTB = HALF * BK * 2  , STAGE_BYTES = 8 * HTB, NXCD = 8, WGM = 8;
__host__ __device__ __forceinline__ int lds_byte(int r, int c) { const int st = (r >> 4) * 2 + (c >> 5), rr = r & 15, cc = c & 31, ob = rr * 64 + cc * 2; return st * 1024 + (ob ^ (((ob >> 9) & 1) << 5)); }
__host__ __device__ __forceinline__ void stage_rc(int b, int& R, int& C) { const int st = b / 1024, sb = b % 1024, swz = sb ^ (((sb >> 9) & 1) << 5); R = (st >> 1) * 16 + swz / 64; C = (st & 1) * 32 + (swz % 64) / 2; }
__host__ __device__ __forceinline__ int perm32(int rho) { const int n = rho >> 4, i = rho & 15; return 8 * (i >> 2) + 4 * n + (i & 3); }

struct Unit { int pm, pn; };
struct Gemm { const void* A; const void* Bt; int KB; const LAS int* tile_e; unsigned e_stride; };
typedef int i32x4 __attribute__((ext_vector_type(4)));

struct StaticOrder {
    int nM, nN, nwg, G, c, i0 = 0, i1 = 1 << 30;
    __device__ void init(int nM_, int nN_, int G_, int c_) { nM = nM_; nN = nN_; nwg = nM * nN; G = G_; c = c_; }
    __device__ bool next(int i, Unit& u) const {
        i += i0; if (i >= i1) return false;
        const long L = (long)i * G + c; if (L >= nwg) return false;
        int wgid = (int)L; { const int q = nwg / NXCD, r = nwg % NXCD, xcd = wgid % NXCD, off = wgid / NXCD; wgid = (xcd < r ? xcd * (q + 1) : r * (q + 1) + (xcd - r) * q) + off; }
        const int nig = WGM * nN, gid = wgid / nig, fm = gid * WGM, gsz = (nM - fm) < WGM ? (nM - fm) : WGM;
        u.pm = fm + ((wgid % nig) % gsz); u.pn = (wgid % nig) / gsz; return true;
    }
};

template <class Epi, bool GATHER, bool ALIGN_EPI, bool I8>
__device__ __forceinline__ void gemm_phase(LAS unsigned char* lds, const LAS int* rtab, const Gemm g, const StaticOrder& S, const Epi& E) {
    int tid_ = threadIdx.x; asm volatile("" : "+v"(tid_));
    const int tid = tid_, wid = __builtin_amdgcn_readfirstlane(tid >> 6), lane = tid & 63, wr = wid >> 2, wc = wid & 3, fr = lane & 15, fq = lane >> 4;
    const int KB = g.KB, nt = KB / (BK * 2);
    int Rs[2], Cs[2]; unsigned voffB[2];
#pragma unroll
    for (int i = 0; i < 2; ++i) { int R, C; stage_rc(tid * 16 + i * 8192, R, C); const int Rb = Epi::PERM == 2 ? (64 * (R >> 5) + 16 * ((R >> 2) & 3) + 4 * ((R >> 4) & 1) + (R & 3)) : Epi::PERM ? ((R & ~31) + perm32(R & 31)) : R; Rs[i] = R; Cs[i] = C; voffB[i] = (unsigned)(Rb * KB + C * 2); }
    const size_t kstep = (size_t)(BK * 2);
    const size_t hstep = (size_t)HALF * KB;
    const size_t tstep = 2 * hstep;
    const size_t bhstep = Epi::PERM == 2 ? (size_t)8 * KB : hstep;
    const unsigned ldsw = (unsigned)wid * 1024u;
    const int aoff = lds_byte(wr * 64 + fr, fq * 8), boff = lds_byte(wc * 32 + fr, fq * 8);
#define PG8_SA(b, h) (((b) * 2 + (h)) * HTB)
#define PG8_SB(b, h) ((4 + (b) * 2 + (h)) * HTB)
#define PG8_STAGE(bufoff, gbase, voff) do { _Pragma("unroll") for (int _i = 0; _i < 2; ++_i) \
        __builtin_amdgcn_global_load_lds((const unsigned*)((const char*)(gbase) + (voff)[_i]), (LAS unsigned*)(lds + (bufoff) + ldsw + _i * 8192), 16, 0, 0); } while (0)
#define PG8_LDA(dst, b, h) do { _Pragma("unroll") for (int m = 0; m < 4; ++m) _Pragma("unroll") for (int k = 0; k < 2; ++k) dst[m][k] = *(const LAS bf16x8*)(lds + PG8_SA(b, h) + aoff + m * 2048 + k * 1024); } while (0)
#define PG8_LDB(dst, b, h) do { _Pragma("unroll") for (int n = 0; n < 2; ++n) _Pragma("unroll") for (int k = 0; k < 2; ++k) dst[n][k] = *(const LAS bf16x8*)(lds + PG8_SB(b, h) + boff + n * 2048 + k * 1024); } while (0)
#define PG8_MMA(ai, bj, At, Bt) do { __builtin_amdgcn_s_setprio(1); _Pragma("unroll") for (int m = 0; m < 4; ++m) _Pragma("unroll") for (int n = 0; n < 2; ++n) _Pragma("unroll") for (int k = 0; k < 2; ++k) \
        { if constexpr (I8) acc[ai][bj][m][n] = __builtin_bit_cast(f32x4, __builtin_amdgcn_mfma_i32_16x16x64_i8(__builtin_bit_cast(i32x4, Bt[n][k]), __builtin_bit_cast(i32x4, At[m][k]), __builtin_bit_cast(i32x4, acc[ai][bj][m][n]), 0, 0, 0)); \
          else acc[ai][bj][m][n] = __builtin_amdgcn_mfma_f32_16x16x32_bf16(Bt[n][k], At[m][k], acc[ai][bj][m][n], 0, 0, 0); } __builtin_amdgcn_s_setprio(0); } while (0)
#define PG8_WAIT_V(n) asm volatile("s_waitcnt vmcnt(" #n ")" ::: "memory")
#define PG8_WAIT_L(n) asm volatile("s_waitcnt lgkmcnt(" #n ")" ::: "memory")
#define PG8_BAR __builtin_amdgcn_s_barrier()
#define PG8_SCHED __builtin_amdgcn_sched_barrier(0)
#define PG8_VOFFA(vo, ui_, u_) do { _Pragma("unroll") for (int h_ = 0; h_ < 2; ++h_) _Pragma("unroll") for (int i_ = 0; i_ < 2; ++i_) { \
        const int row_ = GATHER ? rtab[(ui_) * 256 + h_ * 128 + Rs[i_]] : ((u_).pm * 256 + h_ * 128 + Rs[i_]); \
        vo[h_][i_] = (unsigned)(row_ * KB + Cs[i_] * 2); } } while (0)
#define PG8_BBASE(u_) ((const char*)g.Bt + (g.tile_e ? (size_t)g.tile_e[(u_).pm] * g.e_stride : (size_t)0) + (size_t)(u_).pn * tstep)
    Unit cur, nxt; int ui = 0;
    if (!S.next(0, cur)) return;
    f32x4 acc[2][2][4][2];
    if constexpr (Epi::HAS_INIT) E.init(acc, cur, wr, wc, fr, fq);
    else {
#pragma unroll
    for (int a = 0; a < 2; ++a)
#pragma unroll
        for (int b = 0; b < 2; ++b)
#pragma unroll
            for (int m = 0; m < 4; ++m)
#pragma unroll
                for (int n = 0; n < 2; ++n) acc[a][b][m][n] = (f32x4){0.f, 0.f, 0.f, 0.f};
    }
    bf16x8 At[4][2], B0[2][2], B1[2][2];
    unsigned vAc[2][2], vAn[2][2];
    PG8_VOFFA(vAc, 0, cur);
    const char* const gA = (const char*)g.A;
    const char* cB = PG8_BBASE(cur);
    PG8_STAGE(PG8_SB(0, 0), cB, voffB); PG8_STAGE(PG8_SB(0, 1), cB + bhstep, voffB); PG8_STAGE(PG8_SA(0, 0), gA, vAc[0]); PG8_STAGE(PG8_SA(0, 1), gA, vAc[1]);
    if (wr == 1) PG8_BAR;
    PG8_WAIT_V(2); PG8_BAR;
    PG8_STAGE(PG8_SB(1, 0), cB + kstep, voffB); PG8_STAGE(PG8_SA(1, 0), gA + kstep, vAc[0]); PG8_STAGE(PG8_SB(1, 1), cB + bhstep + kstep, voffB);
    PG8_WAIT_V(6); PG8_BAR;
    for (;;) {
        const bool has_next = S.next(ui + 1, nxt);
        const char* nB = cB;
        if (has_next) { nB = PG8_BBASE(nxt); PG8_VOFFA(vAn, ui + 1, nxt); }
        else {
#pragma unroll
            for (int h = 0; h < 2; ++h)
#pragma unroll
                for (int i = 0; i < 2; ++i) vAn[h][i] = vAc[h][i];
        }
        for (int t = 0; t < nt; t += 2) {
            const bool last = (t == nt - 2);
            const char* a1 = gA + (size_t)(t + 1) * kstep;
            const char* a2 = last ? gA : gA + (size_t)(t + 2) * kstep; const char* b2 = last ? nB : cB + (size_t)(t + 2) * kstep;
            const char* a3 = a2 + kstep; const char* b3 = b2 + kstep;
            unsigned v2[2][2];
#pragma unroll
            for (int h = 0; h < 2; ++h)
#pragma unroll
                for (int i = 0; i < 2; ++i) v2[h][i] = last ? vAn[h][i] : vAc[h][i];
            PG8_LDB(B0, 0, 0); PG8_LDB(B1, 0, 1); PG8_SCHED; PG8_LDA(At, 0, 0); PG8_STAGE(PG8_SA(1, 1), a1, vAc[1]);
            PG8_WAIT_V(8); PG8_WAIT_L(0); PG8_BAR; PG8_MMA(0, 0, At, B0); PG8_MMA(0, 1, At, B1); PG8_BAR; PG8_SCHED;
            PG8_LDA(At, 0, 1); PG8_STAGE(PG8_SB(0, 0), b2, voffB); PG8_STAGE(PG8_SB(0, 1), b2 + bhstep, voffB); PG8_STAGE(PG8_SA(0, 0), a2, v2[0]);
            PG8_WAIT_V(8); PG8_WAIT_L(0); PG8_BAR; PG8_MMA(1, 0, At, B0); PG8_MMA(1, 1, At, B1); PG8_BAR; PG8_SCHED;
            PG8_LDB(B0, 1, 0); PG8_LDB(B1, 1, 1); PG8_SCHED; PG8_LDA(At, 1, 0); PG8_STAGE(PG8_SA(0, 1), a2, v2[1]);
            PG8_WAIT_V(8); PG8_WAIT_L(0); PG8_BAR; PG8_MMA(0, 0, At, B0); PG8_MMA(0, 1, At, B1); PG8_BAR; PG8_SCHED;
            PG8_LDA(At, 1, 1); PG8_STAGE(PG8_SB(1, 0), b3, voffB); PG8_STAGE(PG8_SB(1, 1), b3 + bhstep, voffB); PG8_STAGE(PG8_SA(1, 0), a3, v2[0]);
            PG8_WAIT_V(8); PG8_WAIT_L(0); PG8_BAR; PG8_MMA(1, 0, At, B0); PG8_MMA(1, 1, At, B1); PG8_BAR; PG8_SCHED;
        }
        if constexpr (ALIGN_EPI) { if (wr == 0) PG8_BAR; }
        E(acc, cur, wr, wc, fr, fq);
        if (!has_next) break;
        if constexpr (Epi::HAS_INIT) E.init(acc, nxt, wr, wc, fr, fq);
        else {
#pragma unroll
        for (int a = 0; a < 2; ++a)
#pragma unroll
            for (int b = 0; b < 2; ++b)
#pragma unroll
                for (int m = 0; m < 4; ++m)
#pragma unroll
                    for (int n = 0; n < 2; ++n) acc[a][b][m][n] = (f32x4){0.f, 0.f, 0.f, 0.f};
        }
        cur = nxt; cB = nB; ++ui;
#pragma unroll
        for (int h = 0; h < 2; ++h)
#pragma unroll
            for (int i = 0; i < 2; ++i) vAc[h][i] = vAn[h][i];
        if constexpr (ALIGN_EPI) { if (wr == 1) PG8_BAR; }
    }
    PG8_WAIT_V(0);
    if constexpr (!ALIGN_EPI) { if (wr == 0) PG8_BAR; }
    PG8_BAR;
#undef PG8_SA
#undef PG8_SB
#undef PG8_STAGE
#undef PG8_LDA
#undef PG8_LDB
#undef PG8_MMA
#undef PG8_WAIT_V
#undef PG8_WAIT_L
#undef PG8_BAR
#undef PG8_SCHED
#undef PG8_VOFFA
#undef PG8_BBASE
}

struct EpiInProj {
    static constexpr int PERM = 1; static constexpr bool HAS_INIT = false;
    const float* b_in; bf16 *QB, *KB, *VT, *UB, *GB;
    __device__ __forceinline__ void operator()(const f32x4 (&acc)[2][2][4][2], const Unit& u, int wr, int wc, int fr, int fq) const {
        const int row0 = u.pm * BM + wr * 64 + fr;
#pragma unroll
        for (int bj = 0; bj < 2; ++bj) {
            const int reg = u.pn * BM + bj * HALF;
            const int c0 = reg + wc * 32 + 8 * fq;
            const f32x4 bv0 = *(const f32x4*)(b_in + c0), bv1 = *(const f32x4*)(b_in + c0 + 4);
#pragma unroll
            for (int ai = 0; ai < 2; ++ai)
#pragma unroll
                for (int m = 0; m < 4; ++m) {
                    const int row = row0 + ai * HALF + m * 16;
                    f32x4 v0 = acc[ai][bj][m][0] + bv0, v1 = acc[ai][bj][m][1] + bv1;
                    if (reg >= 640 && reg < 768) {
                        const int cv = c0 - 640, gg = cv >> 6, d = cv & 63, b = row / SEQ, s = row % SEQ;
                        bf16* vp = VT + ((size_t)((b * 2 + gg) * 64 + d)) * SEQ + s;
#pragma unroll
                        for (int j = 0; j < 4; ++j) { vp[(size_t)j * SEQ] = (bf16)f2bf(v0[j]); vp[(size_t)(j + 4) * SEQ] = (bf16)f2bf(v1[j]); }
                    } else {
                        bf16* dst;
                        if (reg < 512) { v0 = v0 * C2; v1 = v1 * C2; dst = QB + (size_t)row * 512 + c0; }
                        else if (reg < 640) { dst = KB + (size_t)row * 128 + (c0 - 512); }
                        else {
#pragma unroll
                            for (int j = 0; j < 4; ++j) { v0[j] = fast_gelu(v0[j]); v1[j] = fast_gelu(v1[j]); }
                            dst = (reg < 1280) ? (UB + (size_t)row * 512 + (c0 - 768)) : (GB + (size_t)row * 512 + (c0 - 1280));
                        }
                        u32x4 w; w.x = cvt_pk_bf16(v0[0], v0[1]); w.y = cvt_pk_bf16(v0[2], v0[3]); w.z = cvt_pk_bf16(v1[0], v1[1]); w.w = cvt_pk_bf16(v1[2], v1[3]);
                        *(u32x4*)dst = w;
                    }
                }
        }
    }
};
struct EpiOutProj {
    static constexpr int PERM = 0; static constexpr bool HAS_INIT = true;
    const float* x; const float* b_out; float* Z;
    __device__ __forceinline__ void init(f32x4 (&acc)[2][2][4][2], const Unit& u, int wr, int wc, int fr, int fq) const {
        const int col0 = u.pn * BM + wc * 32 + 4 * fq;
#pragma unroll
        for (int ai = 0; ai < 2; ++ai)
#pragma unroll
            for (int m = 0; m < 4; ++m) {
                const size_t off = (size_t)(u.pm * BM + ai * HALF + wr * 64 + m * 16 + fr) * D + col0;
#pragma unroll
                for (int bj = 0; bj < 2; ++bj)
#pragma unroll
                    for (int n = 0; n < 2; ++n) acc[ai][bj][m][n] = *(const f32x4*)(x + off + bj * HALF + n * 16) * ALPHA + *(const f32x4*)(b_out + col0 + bj * HALF + n * 16);
            }
    }
    __device__ __forceinline__ void operator()(const f32x4 (&acc)[2][2][4][2], const Unit& u, int wr, int wc, int fr, int fq) const {
        const int col0 = u.pn * BM + wc * 32 + 4 * fq;
#pragma unroll
        for (int ai = 0; ai < 2; ++ai)
#pragma unroll
            for (int m = 0; m < 4; ++m) {
                const size_t off = (size_t)(u.pm * BM + ai * HALF + wr * 64 + m * 16 + fr) * D + col0;
#pragma unroll
                for (int bj = 0; bj < 2; ++bj)
#pragma unroll
                    for (int n = 0; n < 2; ++n) *(f32x4*)(Z + off + bj * HALF + n * 16) = acc[ai][bj][m][n];
            }
    }
};
struct EpiSwiglu {
    static constexpr int PERM = 1; static constexpr bool HAS_INIT = false;
    const LAS int* tbl; const float* b_gate; const float* b_up; const float* swgu; const float* el_sa; bf16* HID;
    __device__ __forceinline__ void operator()(const f32x4 (&acc)[2][2][4][2], const Unit& u, int wr, int wc, int fr, int fq) const {
        const int e = tbl[TBL_TILE + u.pm], p0 = (u.pm - tbl[TBL_TS + e]) * BM, ce = tbl[TBL_CNT + e];
        const int fc0 = u.pn * HALF + wc * 32 + 8 * fq;
        const float* sw = swgu + e * 2048 + u.pn * 256 + wc * 32 + 8 * fq;
        float sa[2][4];
#pragma unroll
        for (int ai = 0; ai < 2; ++ai)
#pragma unroll
            for (int m = 0; m < 4; ++m) { const int ix = p0 + ai * HALF + wr * 64 + m * 16 + fr; sa[ai][m] = ix < ce ? el_sa[e * T + ix] : 0.f; }
        f32x4 gb[2], ub[2], sg[2], su[2];
#pragma unroll
        for (int n = 0; n < 2; ++n) { gb[n] = *(const f32x4*)(b_gate + e * DFF + fc0 + 4 * n); ub[n] = *(const f32x4*)(b_up + e * DFF + fc0 + 4 * n); sg[n] = *(const f32x4*)(sw + 4 * n); su[n] = *(const f32x4*)(sw + 128 + 4 * n); }
#pragma unroll
        for (int ai = 0; ai < 2; ++ai)
#pragma unroll
            for (int m = 0; m < 4; ++m) {
                const int row = u.pm * BM + ai * HALF + wr * 64 + m * 16 + fr;
                float hv[8];
                const f32x2 sa2 = (f32x2){sa[ai][m], sa[ai][m]};
#pragma unroll
                for (int n = 0; n < 2; ++n)
#pragma unroll
                    for (int jp = 0; jp < 2; ++jp) {
                        const f32x2 gi = (f32x2){(float)__float_as_int(acc[ai][0][m][n][2 * jp]), (float)__float_as_int(acc[ai][0][m][n][2 * jp + 1])};
                        const f32x2 ui = (f32x2){(float)__float_as_int(acc[ai][1][m][n][2 * jp]), (float)__float_as_int(acc[ai][1][m][n][2 * jp + 1])};
                        const f32x2 sg2 = (f32x2){sg[n][2 * jp], sg[n][2 * jp + 1]}, su2 = (f32x2){su[n][2 * jp], su[n][2 * jp + 1]};
                        const f32x2 gb2 = (f32x2){gb[n][2 * jp], gb[n][2 * jp + 1]}, ub2 = (f32x2){ub[n][2 * jp], ub[n][2 * jp + 1]};
                        const f32x2 ga = __builtin_elementwise_fma(gi * sa2, sg2, gb2), ua = __builtin_elementwise_fma(ui * sa2, su2, ub2);
                        f32x2 gt, up;
                        gt.x = fminf(ga.x, 7.0f); gt.y = fminf(ga.y, 7.0f); up.x = __builtin_amdgcn_fmed3f(ua.x, -7.0f, 7.0f); up.y = __builtin_amdgcn_fmed3f(ua.y, -7.0f, 7.0f);
                        const f32x2 ex = gt * (-1.702f * LOG2E);
                        f32x2 en; en.x = __builtin_amdgcn_exp2f(ex.x); en.y = __builtin_amdgcn_exp2f(ex.y);
                        const f32x2 den = en + 1.0f, upp = up + 1.0f;
                        f32x2 rc; rc.x = __builtin_amdgcn_rcpf(den.x); rc.y = __builtin_amdgcn_rcpf(den.y);
                        const f32x2 hh = (gt * rc) * upp;
                        hv[4 * n + 2 * jp] = hh.x; hv[4 * n + 2 * jp + 1] = hh.y;
                    }
                u32x4 w; w.x = cvt_pk_bf16(hv[0], hv[1]); w.y = cvt_pk_bf16(hv[2], hv[3]); w.z = cvt_pk_bf16(hv[4], hv[5]); w.w = cvt_pk_bf16(hv[6], hv[7]);
                *(u32x4*)(HID + (size_t)row * DFF + fc0) = w;
            }
    }
};
struct EpiDown {
    static constexpr int PERM = 2; static constexpr bool HAS_INIT = false;
    const LAS int* tbl; const float* b_down; const float* swd; const float* row_sb; const float* el_gate; unsigned char* Y;
    __device__ __forceinline__ void operator()(const f32x4 (&acc)[2][2][4][2], const Unit& u, int wr, int wc, int fr, int fq) const {
        const int e = tbl[TBL_TILE + u.pm], p0 = (u.pm - tbl[TBL_TS + e]) * BM, ce = tbl[TBL_CNT + e];
        const int c0 = u.pn * BM + wc * 64 + 16 * fq;
        f32x4 bv[2][2], sw[2][2];
#pragma unroll
        for (int bj = 0; bj < 2; ++bj)
#pragma unroll
            for (int n = 0; n < 2; ++n) { bv[bj][n] = *(const f32x4*)(b_down + e * D + c0 + 8 * bj + 4 * n); sw[bj][n] = *(const f32x4*)(swd + e * D + c0 + 8 * bj + 4 * n); }
#pragma unroll
        for (int ai = 0; ai < 2; ++ai)
#pragma unroll
            for (int m = 0; m < 4; ++m) {
                const int row = u.pm * BM + ai * HALF + wr * 64 + m * 16 + fr;
                const int ix = p0 + ai * HALF + wr * 64 + m * 16 + fr;
                const float gt = (ix < ce ? el_gate[e * T + ix] : 0.f) * YSCALE, sb = row_sb[row] * gt;
                u32x4 w;
#pragma unroll
                for (int bj = 0; bj < 2; ++bj)
#pragma unroll
                    for (int n = 0; n < 2; ++n) {
                        float v[4];
#pragma unroll
                        for (int jp = 0; jp < 2; ++jp) {
                            const f32x2 ci = (f32x2){(float)__float_as_int(acc[ai][bj][m][n][2 * jp]), (float)__float_as_int(acc[ai][bj][m][n][2 * jp + 1])};
                            const f32x2 s2 = (f32x2){sw[bj][n][2 * jp], sw[bj][n][2 * jp + 1]} * sb, b2 = (f32x2){bv[bj][n][2 * jp], bv[bj][n][2 * jp + 1]} * gt;
                            const f32x2 r = __builtin_elementwise_fma(ci, s2, b2);
                            v[2 * jp] = __builtin_amdgcn_fmed3f(r.x, -448.0f, 448.0f); v[2 * jp + 1] = __builtin_amdgcn_fmed3f(r.y, -448.0f, 448.0f);
                        }
                        int d = 0;
                        d = __builtin_amdgcn_cvt_pk_fp8_f32(v[0], v[1], d, false);
                        d = __builtin_amdgcn_cvt_pk_fp8_f32(v[2], v[3], d, true);
                        w[2 * bj + n] = (unsigned)d;
                    }
                *(u32x4*)(Y + (size_t)row * D + c0) = w;
            }
    }
};
}
constexpr int NWAVES = 8;
constexpr int NPHASES = 10;
constexpr size_t WS_WIN = WS_HID + 144 * MiB;
constexpr size_t WS_WOUT = WS_WIN + 4 * MiB;
constexpr size_t WS_WGU = WS_WOUT + 2 * MiB;
constexpr size_t WS_SWGU = WS_WGU + 64 * MiB;
constexpr size_t WS_WD = WS_SWGU + 1 * MiB;
constexpr size_t WS_SWD = WS_WD + 32 * MiB;
constexpr size_t WS_HID8 = WS_SWD + 1 * MiB;
constexpr size_t WS_END = WS_HID8 + 72 * MiB;
constexpr int CW_BAR = 4096;
constexpr int RING_BYTES = 131072;
constexpr int RTAB_OFF = RING_BYTES;
constexpr int RTAB_UNITS = 12;
constexpr int RW_BYTES = 1024 * 144;
constexpr int RSCR_OFF = RW_BYTES;
constexpr int LDS_BYTES = 163840;
constexpr int MISC_OFF = LDS_BYTES - 256;
static_assert(RTAB_OFF + RTAB_UNITS * 1024 <= MISC_OFF && RSCR_OFF + 4096 <= MISC_OFF, "LDS map");

typedef GAS unsigned gu32;
#define RLX_AGENT __ATOMIC_RELAXED, __HIP_MEMORY_SCOPE_AGENT
#define LDS_WAIT() asm volatile("s_waitcnt lgkmcnt(0)" ::: "memory")
#define VM_WAIT() asm volatile("s_waitcnt vmcnt(0)" ::: "memory")

#define XB_TMO      128
#define XB_XCNT(j)  (256  + 64 * (j))
#define XB_XSUB(j)  (1280 + 64 * (j))
#define XB_XGEN(j)  (2304 + 64 * (j))
#define XB_TOP      3328
#define XB_TOPGEN   3392
#define XCD_BAR_WORDS 3456
#define XB_SPIN_CAP (1u << 18)
__device__ __forceinline__ unsigned xb_ld(unsigned* p)              { return __hip_atomic_load(p, __ATOMIC_RELAXED, __HIP_MEMORY_SCOPE_AGENT); }
__device__ __forceinline__ unsigned xb_add(unsigned* p, unsigned v) { return __hip_atomic_fetch_add(p, v, __ATOMIC_RELAXED, __HIP_MEMORY_SCOPE_AGENT); }
__device__ __forceinline__ unsigned xb_xcc_id() { return (unsigned)__builtin_amdgcn_s_getreg((3 << 11) | 20) & 0xFu; }
#define XB_SPIN(cond, bar) do { unsigned _sp = 0; while (cond) { __builtin_amdgcn_s_sleep(1); \
    if ((++_sp & 255u) == 0u) { if (xb_ld(&(bar)[XB_TMO])) break; if (_sp > XB_SPIN_CAP) { atomicAdd(&(bar)[XB_TMO], 1u); break; } } } } while (0)
struct XcdBarrier { unsigned* bar; unsigned x; volatile LAS unsigned* st; };
__device__ __forceinline__ XcdBarrier xcd_barrier_post(unsigned* bar, volatile LAS unsigned* st) {
    XcdBarrier b; b.bar = bar; b.x = xb_xcc_id(); b.st = st;
    if (threadIdx.x == 0) (void)xb_add(&bar[XB_XCNT(b.x)], 1u);
    return b;
}
__device__ __forceinline__ void xcd_barrier_complete(unsigned* bar, unsigned x, unsigned& nloc, unsigned& nx) {
    const unsigned G = gridDim.x * gridDim.y * gridDim.z;
    unsigned sum, cnt, mine, sp = 0u;
    for (;;) {
        sum = 0u; cnt = 0u; mine = 0u;
#pragma unroll
        for (unsigned j = 0; j < 16; ++j) { const unsigned c = xb_ld(&bar[XB_XCNT(j)]); sum += c; cnt += (c > 0u) ? 1u : 0u; mine = (j == x) ? c : mine; }
        if (sum == G) break;
        __builtin_amdgcn_s_sleep(1);
        if ((++sp & 255u) == 0u) { if (xb_ld(&bar[XB_TMO])) break; if (sp > XB_SPIN_CAP) { atomicAdd(&bar[XB_TMO], 1u); break; } }
    }
    nloc = mine > 0u ? mine : 1u; nx = cnt > 0u ? cnt : 1u;
}
__device__ __forceinline__ void xcd_barrier(const XcdBarrier& b) {
    asm volatile("s_waitcnt vmcnt(0)" ::: "memory");
    __syncthreads();
    if (threadIdx.x == 0) {
        unsigned* bar = b.bar;
        __builtin_amdgcn_s_waitcnt(0);
        unsigned nloc = b.st[0], nx = b.st[1];
        if (nloc == 0u) { xcd_barrier_complete(bar, b.x, nloc, nx); b.st[0] = nloc; b.st[1] = nx; }
        const unsigned old = xb_add(&bar[XB_XSUB(b.x)], 1u);
        const unsigned gen = old / nloc;
        if (old + 1u == (gen + 1u) * nloc) {
            __builtin_amdgcn_fence(__ATOMIC_RELEASE, "agent");
            asm volatile("s_waitcnt vmcnt(0)" ::: "memory");
            const unsigned og = xb_add(&bar[XB_TOP], 1u);
            const unsigned tg = og / nx;
            if (og + 1u == (tg + 1u) * nx) xb_add(&bar[XB_TOPGEN], 1u);
            else XB_SPIN(xb_ld(&bar[XB_TOPGEN]) == tg, bar);
            __builtin_amdgcn_fence(__ATOMIC_ACQUIRE, "agent");
            xb_add(&bar[XB_XGEN(b.x)], 1u);
            asm volatile("s_waitcnt vmcnt(0)" ::: "memory");
        } else {
            XB_SPIN(xb_ld(&bar[XB_XGEN(b.x)]) == gen, bar);
            __builtin_amdgcn_fence(__ATOMIC_ACQUIRE, "agent");
            asm volatile("s_waitcnt vmcnt(0)" ::: "memory");
        }
    }
    __syncthreads();
}

struct Args {
    const float* in[22]; float* out; unsigned char* ws; int ph_lo, ph_hi, li, pad;
};
struct Frame {
    LAS unsigned char* lds;
    int tid, lane, wave, vcu, G;
};
__device__ __forceinline__ void p0_item(const float* W, int N, bf16* WT, int K, int dst_row0, int k0, int n0, LAS float* scr, int lane) {
    f32x4 v[8];
#pragma unroll
    for (int i = 0; i < 8; ++i) v[i] = *(const f32x4*)(W + (size_t)(k0 + (lane >> 3) + 8 * i) * N + n0 + 4 * (lane & 7));
#pragma unroll
    for (int i = 0; i < 8; ++i) { LAS float* s = scr + ((lane >> 3) + 8 * i) * 33 + 4 * (lane & 7); s[0] = v[i].x; s[1] = v[i].y; s[2] = v[i].z; s[3] = v[i].w; }
    LDS_WAIT(); asm volatile("" ::: "memory");
    const int c = lane & 7;
#pragma unroll
    for (int j = 0; j < 4; ++j) { const int n = (lane >> 3) + 8 * j; const LAS float* s = scr + (8 * c) * 33 + n;
        u32x4 o; o.x = pk2(s[0 * 33], s[1 * 33]); o.y = pk2(s[2 * 33], s[3 * 33]); o.z = pk2(s[4 * 33], s[5 * 33]); o.w = pk2(s[6 * 33], s[7 * 33]);
        *(u32x4*)(WT + (size_t)(dst_row0 + n) * K + k0 + 8 * c) = o; }
    LDS_WAIT(); asm volatile("" ::: "memory");
}
struct ConvItem { const float* W; signed char* dst; float* sc; int n0, dst_row0; };
__device__ __forceinline__ ConvItem conv_decode(const Args& a, int it) {
    unsigned char* ws = a.ws;
    const int nb = it & 31, e = (it >> 5) & 31, kind = it >> 10, n0 = nb * 32;
    ConvItem c;
    c.W = (kind == 0 ? a.in[14] : kind == 1 ? a.in[16] : a.in[18]) + (size_t)e * D * DFF;
    c.dst = kind < 2 ? (signed char*)(ws + WS_WGU) + (size_t)e * 2048 * 1024 : (signed char*)(ws + WS_WD) + (size_t)e * 1024 * 1024;
    c.dst_row0 = kind < 2 ? (n0 >> 7) * 256 + kind * 128 + (n0 & 127) : n0;
    c.sc = kind < 2 ? (float*)(ws + WS_SWGU) + e * 2048 : (float*)(ws + WS_SWD) + e * 1024;
    c.n0 = n0; return c;
}
#define CONV_LOAD(v, ci) do { _Pragma("unroll") for (int i_ = 0; i_ < 4; ++i_) _Pragma("unroll") for (int j_ = 0; j_ < 4; ++j_) \
        v[i_][j_] = __builtin_nontemporal_load((const f32x4*)((ci).W + (size_t)(4 * (kl + 64 * i_) + j_) * DFF + (ci).n0 + 4 * n4)); } while (0)
__device__ __forceinline__ void conv_items(const Frame& F, const Args& a, int it_lo, int it_hi) {
    if (it_hi > 3 * NEXP * 32) it_hi = 3 * NEXP * 32;
    if (it_lo >= it_hi) return;
    const int tid = F.tid, n4 = tid & 7, kl = tid >> 3;
    LAS unsigned* tile = (LAS unsigned*)F.lds;
    LAS float* red = (LAS float*)(F.lds + 36864);
    f32x4 v[4][4];
    ConvItem cur = conv_decode(a, it_lo);
    CONV_LOAD(v, cur);
    for (int it = it_lo; it < it_hi; ++it) {
        f32x4 am = (f32x4){0.f, 0.f, 0.f, 0.f};
#pragma unroll
        for (int i = 0; i < 4; ++i)
#pragma unroll
            for (int j = 0; j < 4; ++j) { am.x = fmaxf(am.x, fabsf(v[i][j].x)); am.y = fmaxf(am.y, fabsf(v[i][j].y)); am.z = fmaxf(am.z, fabsf(v[i][j].z)); am.w = fmaxf(am.w, fabsf(v[i][j].w)); }
#pragma unroll
        for (int o = 8; o < 64; o <<= 1) { am.x = fmaxf(am.x, __shfl_xor(am.x, o)); am.y = fmaxf(am.y, __shfl_xor(am.y, o)); am.z = fmaxf(am.z, __shfl_xor(am.z, o)); am.w = fmaxf(am.w, __shfl_xor(am.w, o)); }
        if (F.lane < 8) *(LAS f32x4*)(red + F.wave * 32 + 4 * n4) = am;
        __syncthreads();
        f32x4 cm = *(const LAS f32x4*)(red + 4 * n4);
#pragma unroll
        for (int w = 1; w < 8; ++w) { const f32x4 o = *(const LAS f32x4*)(red + w * 32 + 4 * n4); cm.x = fmaxf(cm.x, o.x); cm.y = fmaxf(cm.y, o.y); cm.z = fmaxf(cm.z, o.z); cm.w = fmaxf(cm.w, o.w); }
        f32x4 inv;
#pragma unroll
        for (int c = 0; c < 4; ++c) inv[c] = cm[c] > 0.f ? 127.0f / cm[c] : 0.f;
        if (kl == 0) {
#pragma unroll
            for (int c = 0; c < 4; ++c) cur.sc[cur.dst_row0 + 4 * n4 + c] = cm[c] * (1.0f / 127.0f);
        }
#pragma unroll
        for (int i = 0; i < 4; ++i)
#pragma unroll
            for (int c = 0; c < 4; ++c) {
                unsigned d = 0u;
#pragma unroll
                for (int j = 0; j < 4; ++j) { const int q = (int)rintf(v[i][j][c] * inv[c]); d |= ((unsigned)q & 0xffu) << (8 * j); }
                tile[(4 * n4 + c) * 260 + kl + 64 * i] = d;
            }
        const ConvItem done = cur;
        if (it + 1 < it_hi) { cur = conv_decode(a, it + 1); CONV_LOAD(v, cur); }
        __syncthreads();
#pragma unroll
        for (int j = 0; j < 4; ++j) { const int ch = tid + 512 * j, n = ch >> 6, c16 = ch & 63;
            *(u32x4*)(done.dst + (size_t)(done.dst_row0 + n) * 1024 + 16 * c16) = *(const LAS u32x4*)(tile + n * 260 + 4 * c16); }
        __syncthreads();
    }
}
__device__ __forceinline__ void p0_prologue(const Frame& F, const Args& a) {
    unsigned char* ws = a.ws;
    bf16* Win_t = (bf16*)(ws + WS_WIN); bf16* Wout_t = (bf16*)(ws + WS_WOUT);
    LAS float* scr = (LAS float*)(F.lds + F.wave * 8448);
    const int gw = F.vcu * NWAVES + F.wave, NGW = F.G * NWAVES;
    constexpr int I_IN = 16 * 56, I_OUT = 16 * 32, NITEMS = I_IN + I_OUT;
    for (int it = gw; it < NITEMS; it += NGW) {
        int r = it;
        if (r < I_IN) { const int kb = r / 56, nb = r % 56; p0_item(a.in[1], INW, Win_t, D, nb * 32, kb * 64, nb * 32, scr, F.lane); continue; } r -= I_IN;
        { const int kb = r / 32, nb = r % 32; p0_item(a.in[8], D, Wout_t, D, nb * 32, kb * 64, nb * 32, scr, F.lane); }
    }
    const float* x = a.in[0]; bf16* XB = (bf16*)(ws + WS_XB);
    for (int m = gw; m < T; m += NGW) {
        const f32x4* xr = (const f32x4*)(x + (size_t)m * D) + F.lane; u32x2* o = (u32x2*)(XB + (size_t)m * D) + F.lane;
        f32x4 v[4];
#pragma unroll
        for (int j = 0; j < 4; ++j) v[j] = xr[64 * j];
#pragma unroll
        for (int j = 0; j < 4; ++j) { u32x2 w; w.x = pk2(v[j].x, v[j].y); w.y = pk2(v[j].z, v[j].w); o[64 * j] = w; }
    }
}

__device__ __forceinline__ int crow(int r, int hi) { return (r & 3) + 8 * (r >> 2) + 4 * hi; }
constexpr int AT_KROW = 144, AT_KG = 192 * AT_KROW, AT_VROW = 400, AT_VG = 64 * AT_VROW, AT_VOFF = 2 * AT_KG;
__device__ __forceinline__ void attn_wave_unit(const LAS unsigned char* lds, const bf16x8 (&qf)[4], const float sk, bf16* CAT, int tok0, int u, int h, int lane) {
    const int r32 = lane & 31, hi = lane >> 5;
    const int t0 = tok0 % SEQ, g = h >> 2;
    const int kk0 = 32 * u;
    f32x16 p[5];
    const float NEG = -INFINITY;
    const LAS unsigned char* kl = lds + g * AT_KG + (kk0 + r32) * AT_KROW + hi * 16;
#pragma unroll
    for (int j = 0; j < 5; ++j) {
        const int kb = t0 - 128 + 32 * j;
        f32x16 s;
#pragma unroll
        for (int r = 0; r < 16; ++r) s[r] = 0.f;
        if (kb >= 0) {
#pragma unroll
            for (int d0 = 0; d0 < 4; ++d0) { const bf16x8 kf = *(const LAS bf16x8*)(kl + j * 32 * AT_KROW + d0 * 32); s = __builtin_amdgcn_mfma_f32_32x32x16_bf16(kf, qf[d0], s, 0, 0, 0); }
            if (j == 0) {
#pragma unroll
                for (int r = 0; r < 16; ++r) if (!(crow(r, hi) > r32)) s[r] = NEG;
            }
            if (j == 4) {
#pragma unroll
                for (int r = 0; r < 16; ++r) if (!(crow(r, hi) <= r32)) s[r] = NEG;
            }
        } else {
#pragma unroll
            for (int r = 0; r < 16; ++r) s[r] = NEG;
        }
        p[j] = s;
    }
    float m = sk;
#pragma unroll
    for (int j = 0; j < 5; ++j)
#pragma unroll
        for (int r = 0; r < 16; ++r) m = fmaxf(m, p[j][r]);
    m = fmaxf(m, __shfl_xor(m, 32));
    float l = 0.f;
#pragma unroll
    for (int j = 0; j < 5; ++j)
#pragma unroll
        for (int r = 0; r < 16; ++r) { const float e = __builtin_amdgcn_exp2f(p[j][r] - m); p[j][r] = e; l += e; }
    l += __shfl_xor(l, 32);
    l += __builtin_amdgcn_exp2f(sk - m);
    const float inv = 1.0f / l;
    u32x4 pb[5][2];
#pragma unroll
    for (int j = 0; j < 5; ++j)
#pragma unroll
        for (int s = 0; s < 2; ++s) { pb[j][s].x = cvt_pk_bf16(p[j][8 * s + 0], p[j][8 * s + 1]); pb[j][s].y = cvt_pk_bf16(p[j][8 * s + 2], p[j][8 * s + 3]); pb[j][s].z = cvt_pk_bf16(p[j][8 * s + 4], p[j][8 * s + 5]); pb[j][s].w = cvt_pk_bf16(p[j][8 * s + 6], p[j][8 * s + 7]); }
#pragma unroll
    for (int db = 0; db < 2; ++db) {
        f32x16 o;
#pragma unroll
        for (int r = 0; r < 16; ++r) o[r] = 0.f;
        const LAS unsigned char* vl = lds + AT_VOFF + g * AT_VG + (db * 32 + r32) * AT_VROW + (kk0 + 4 * hi) * 2;
#pragma unroll
        for (int j = 0; j < 5; ++j) {
            const int kb = t0 - 128 + 32 * j;
            if (kb >= 0) {
#pragma unroll
                for (int s = 0; s < 2; ++s) {
                    const u32x2 lo = *(const LAS u32x2*)(vl + (32 * j + 16 * s) * 2), hh = *(const LAS u32x2*)(vl + (32 * j + 16 * s + 8) * 2);
                    u32x4 av; av.x = lo.x; av.y = lo.y; av.z = hh.x; av.w = hh.y;
                    o = __builtin_amdgcn_mfma_f32_32x32x16_bf16(__builtin_bit_cast(bf16x8, av), __builtin_bit_cast(bf16x8, pb[j][s]), o, 0, 0, 0);
                }
            }
        }
        bf16* op = CAT + (size_t)(tok0 + r32) * 1024 + h * 64 + db * 32 + 4 * hi;
#pragma unroll
        for (int gq = 0; gq < 4; ++gq) { u32x2 w; w.x = cvt_pk_bf16(o[4 * gq] * inv, o[4 * gq + 1] * inv); w.y = cvt_pk_bf16(o[4 * gq + 2] * inv, o[4 * gq + 3] * inv); *(u32x2*)(op + 8 * gq) = w; }
    }
}
__device__ __forceinline__ void attn_block(const Frame& F, const bf16* QB, const bf16* KB, const bf16* VT, const float* sinks, bf16* CAT, int qq) {
    const int tokb = qq * 64, b = tokb / SEQ, tb = tokb % SEQ, kbase = tb - 128;
    u32x4 kv[6], vv[6];
    bf16x8 qf0[4], qf1[4];
    { const int r32 = F.lane & 31, hi = F.lane >> 5;
#pragma unroll
      for (int d0 = 0; d0 < 4; ++d0) { qf0[d0] = *(const bf16x8*)(QB + (size_t)(tokb + r32) * 512 + F.wave * 64 + d0 * 16 + hi * 8); qf1[d0] = *(const bf16x8*)(QB + (size_t)(tokb + 32 + r32) * 512 + F.wave * 64 + d0 * 16 + hi * 8); } }
    const float sk = sinks[F.wave] * LOG2E;
#pragma unroll
    for (int i = 0; i < 6; ++i) {
        const int c = F.tid + 512 * i, g = c / 1536, rem = c % 1536;
        { const int key = rem >> 3, ch = rem & 7, pos = kbase + key;
          kv[i] = pos >= 0 ? *(const u32x4*)(KB + (size_t)(b * SEQ + pos) * 128 + g * 64 + ch * 8) : (u32x4){0u, 0u, 0u, 0u}; }
        { const int d = rem / 24, ch = rem % 24, pos = kbase + ch * 8;
          vv[i] = pos >= 0 ? *(const u32x4*)(VT + ((size_t)((b * 2 + g) * 64 + d)) * SEQ + pos) : (u32x4){0u, 0u, 0u, 0u}; }
    }
#pragma unroll
    for (int i = 0; i < 6; ++i) {
        const int c = F.tid + 512 * i, g = c / 1536, rem = c % 1536;
        *(LAS u32x4*)(F.lds + g * AT_KG + (rem >> 3) * AT_KROW + (rem & 7) * 16) = kv[i];
        *(LAS u32x4*)(F.lds + AT_VOFF + g * AT_VG + (rem / 24) * AT_VROW + (rem % 24) * 16) = vv[i];
    }
    __syncthreads();
    attn_wave_unit(F.lds, qf0, sk, CAT, tokb, 0, F.wave, F.lane);
    attn_wave_unit(F.lds, qf1, sk, CAT, tokb + 32, 1, F.wave, F.lane);
    __syncthreads();
}
template <int CTRL> __device__ __forceinline__ float dppq(float v) { return __builtin_bit_cast(float, __builtin_amdgcn_update_dpp(0, __builtin_bit_cast(int, v), CTRL, 0xF, 0xF, true)); }
constexpr int SG_WOFF = 20480, SG_WROW = 272;
__device__ __forceinline__ void sgu_stage_w(const Frame& F, const float* w_s, int gi) {
    f32x4 w[8];
#pragma unroll
    for (int i = 0; i < 8; ++i) w[i] = *(const f32x4*)(w_s + (size_t)gi * 16384 + (size_t)(F.tid + 512 * i) * 4);
#pragma unroll
    for (int i = 0; i < 8; ++i) { const int c = F.tid + 512 * i, t = c >> 5, s0 = (c & 31) * 4;
        f32x4 v = w[i];
#pragma unroll
        for (int j = 0; j < 4; ++j) if (s0 + j > t) v[j] = 0.f;
        u32x2 o; o.x = cvt_pk_bf16(v[0], v[1]); o.y = cvt_pk_bf16(v[2], v[3]);
        *(LAS u32x2*)(F.lds + SG_WOFF + t * SG_WROW + s0 * 2) = o; }
}
__device__ __forceinline__ void sgu_unit(const Frame& F, const bf16* UB, const bf16* GB, const float* ln_g, const float* ln_b, const float* w_s, const float* b_s, bf16* CAT, int ch, int gi) {
    LAS bf16* GT = (LAS bf16*)F.lds;
    const int r32 = F.lane & 31, hi = F.lane >> 5, tb = F.wave >> 1, db = F.wave & 1, t = tb * 32 + r32;
    const int nks = 2 * (tb + 1);
    const int s = F.tid >> 2, q4 = F.tid & 3; const size_t tok = (size_t)ch * 128 + s;
    const u32x4* gp = (const u32x4*)(GB + tok * 512 + gi * 64 + q4 * 16);
    const u32x4 a = gp[0], c = gp[1];
    const size_t tokt = (size_t)ch * 128 + t;
    const bf16* up = UB + tokt * 512 + gi * 64 + db * 32 + 4 * hi;
    u32x2 uu[4];
#pragma unroll
    for (int gq = 0; gq < 4; ++gq) uu[gq] = *(const u32x2*)(up + 8 * gq);
    const float bb = b_s[gi * 128 + t];
    float lg_[16], lb_[16];
#pragma unroll
    for (int i = 0; i < 16; ++i) { lg_[i] = ln_g[gi * 64 + q4 * 16 + i]; lb_[i] = ln_b[gi * 64 + q4 * 16 + i]; }
    {
        float v[16];
        v[0] = __uint_as_float(a.x << 16); v[1] = __uint_as_float(a.x & 0xffff0000u); v[2] = __uint_as_float(a.y << 16); v[3] = __uint_as_float(a.y & 0xffff0000u);
        v[4] = __uint_as_float(a.z << 16); v[5] = __uint_as_float(a.z & 0xffff0000u); v[6] = __uint_as_float(a.w << 16); v[7] = __uint_as_float(a.w & 0xffff0000u);
        v[8] = __uint_as_float(c.x << 16); v[9] = __uint_as_float(c.x & 0xffff0000u); v[10] = __uint_as_float(c.y << 16); v[11] = __uint_as_float(c.y & 0xffff0000u);
        v[12] = __uint_as_float(c.z << 16); v[13] = __uint_as_float(c.z & 0xffff0000u); v[14] = __uint_as_float(c.w << 16); v[15] = __uint_as_float(c.w & 0xffff0000u);
        float sum = 0.f;
#pragma unroll
        for (int i = 0; i < 16; ++i) sum += v[i];
        sum += dppq<0xB1>(sum); sum += dppq<0x4E>(sum);
        const float mu = sum * (1.f / 64.f); float q = 0.f;
#pragma unroll
        for (int i = 0; i < 16; ++i) { v[i] -= mu; q += v[i] * v[i]; }
        q += dppq<0xB1>(q); q += dppq<0x4E>(q);
        const float rstd = rsqrtf(q * (1.f / 64.f) + LN_EPS);
#pragma unroll
        for (int i = 0; i < 16; ++i) { const int d = q4 * 16 + i; GT[d * 136 + s] = (bf16)f2bf(v[i] * rstd * lg_[i] + lb_[i]); }
    }
    __syncthreads();
    {
        f32x16 acc;
#pragma unroll
        for (int r = 0; r < 16; ++r) acc[r] = 0.f;
        const LAS bf16* arow = GT + (db * 32 + r32) * 136 + hi * 8;
        const LAS unsigned char* wlds = F.lds + SG_WOFF + t * SG_WROW + hi * 16;
#pragma unroll
        for (int ks = 0; ks < 8; ++ks) if (ks < nks) {
            const bf16x8 af = *(const LAS bf16x8*)(arow + ks * 16);
            const bf16x8 bw = *(const LAS bf16x8*)(wlds + ks * 32);
            acc = __builtin_amdgcn_mfma_f32_32x32x16_bf16(af, bw, acc, 0, 0, 0);
        }
        bf16* op = CAT + tokt * 1024 + 512 + gi * 64 + db * 32 + 4 * hi;
#pragma unroll
        for (int gq = 0; gq < 4; ++gq) {
            const float u0 = __uint_as_float(uu[gq].x << 16), u1 = __uint_as_float(uu[gq].x & 0xffff0000u), u2 = __uint_as_float(uu[gq].y << 16), u3 = __uint_as_float(uu[gq].y & 0xffff0000u);
            u32x2 w; w.x = cvt_pk_bf16(u0 * (acc[4 * gq] + bb), u1 * (acc[4 * gq + 1] + bb)); w.y = cvt_pk_bf16(u2 * (acc[4 * gq + 2] + bb), u3 * (acc[4 * gq + 3] + bb));
            *(u32x2*)(op + 8 * gq) = w;
        }
    }
    __syncthreads();
}
__device__ __forceinline__ void p2_mixers(const Frame& F, const Args& a) {
    unsigned char* ws = a.ws;
    const bf16 *QB = (const bf16*)(ws + WS_QB), *KB = (const bf16*)(ws + WS_KB), *VT = (const bf16*)(ws + WS_VT), *UB = (const bf16*)(ws + WS_UB), *GB = (const bf16*)(ws + WS_GB);
    bf16* CAT = (bf16*)(ws + WS_CAT);
    for (int qq = F.vcu; qq < T / 64; qq += F.G) attn_block(F, QB, KB, VT, a.in[3], CAT, qq);
    int gi_staged = -1;
    for (int u = F.vcu; u < (T / 128) * 8; u += F.G) {
        if ((u & 7) != gi_staged) { __syncthreads(); sgu_stage_w(F, a.in[6], u & 7); gi_staged = u & 7; }
        sgu_unit(F, UB, GB, a.in[4], a.in[5], a.in[6], a.in[7], CAT, u >> 3, u & 7);
    }
}

template <int CTRL> __device__ __forceinline__ float dppf(float v) { return __builtin_bit_cast(float, __builtin_amdgcn_update_dpp(0, __builtin_bit_cast(int, v), CTRL, 0xF, 0xF, true)); }
__device__ __forceinline__ float swap16_sum(float x, float y) { auto r = __builtin_amdgcn_permlane16_swap(__builtin_bit_cast(unsigned, x), __builtin_bit_cast(unsigned, y), false, false); return __builtin_bit_cast(float, r[0]) + __builtin_bit_cast(float, r[1]); }
__device__ __forceinline__ float swap32_sum(float x, float y) { auto r = __builtin_amdgcn_permlane32_swap(__builtin_bit_cast(unsigned, x), __builtin_bit_cast(unsigned, y), false, false); return __builtin_bit_cast(float, r[0]) + __builtin_bit_cast(float, r[1]); }
__device__ __forceinline__ float rdlane(float v, int l) { return __builtin_bit_cast(float, __builtin_amdgcn_readlane(__builtin_bit_cast(int, v), l)); }
__device__ __forceinline__ float xsum(float v) {
    v += dppf<0xB1>(v); v += dppf<0x4E>(v); v += dppf<0x124>(v); v += dppf<0x128>(v);
    return (rdlane(v, 0) + rdlane(v, 16)) + (rdlane(v, 32) + rdlane(v, 48));
}
__device__ __forceinline__ float xmax(float v) {
    v = fmaxf(v, dppf<0xB1>(v)); v = fmaxf(v, dppf<0x4E>(v)); v = fmaxf(v, dppf<0x124>(v)); v = fmaxf(v, dppf<0x128>(v));
    return fmaxf(fmaxf(rdlane(v, 0), rdlane(v, 16)), fmaxf(rdlane(v, 32), rdlane(v, 48)));
}
__device__ __forceinline__ void p4_router(const Frame& F, const Args& a, bool commit) {
    const float* Zin = a.out; bf16* Hout = (bf16*)(a.ws + WS_H); signed char* HB8 = (signed char*)(a.ws + WS_HB); int* meta = (int*)(a.ws + WS_META); unsigned* cnt = (unsigned*)(a.ws + WS_CTL) + CW_CNT;
    const float* ln1_g = a.in[10]; const float* ln1_b = a.in[11]; const float* w_r = a.in[12]; const float* b_r = a.in[13];
    LAS float* W = (LAS float*)F.lds;
    LAS unsigned* hist = (LAS unsigned*)(F.lds + RSCR_OFF);
    LAS unsigned* base = hist + 32;
    LAS int* tmp_e = (LAS int*)(hist + 64);
    LAS int* tmp_p = tmp_e + 256;
    LAS float* tmp_g = (LAS float*)(tmp_p + 256);
    LAS float* tmp_s = tmp_g + 256;
    int* el_tok = (int*)(a.ws + WS_ELIST); float* el_gate = (float*)(a.ws + WS_ELIST) + NEXP * T; float* el_sa = el_gate + NEXP * T;
    {
        f32x4 t[16];
#pragma unroll
        for (int k = 0; k < 16; ++k) t[k] = *(const f32x4*)(w_r + (size_t)(F.tid + 512 * k) * 4);
#pragma unroll
        for (int k = 0; k < 16; ++k) { const int i = F.tid + 512 * k, c = i >> 3, e4 = i & 7, pr = (c & ~255) + 64 * (c & 3) + ((c >> 2) & 63); *(LAS f32x4*)(W + pr * 36 + e4 * 4) = t[k]; }
    }
    const int lane = F.lane, half = lane >> 5, el = lane & 31;
    LAS float* gbl = (LAS float*)(F.lds + 151552);
    for (int i = F.tid; i < 512; i += NWAVES * 64) *(LAS f32x4*)(gbl + 4 * i) = i < 256 ? *(const f32x4*)(ln1_g + 4 * i) : *(const f32x4*)(ln1_b + 4 * (i - 256));
    for (int tb = F.vcu; tb < T / 64; tb += F.G) {
        if (F.tid < 32) hist[F.tid] = 0u;
        __syncthreads();
        float zn0[16], zn1[16];
        { const f32x4* z0 = (const f32x4*)(Zin + (size_t)(tb * 64 + 8 * F.wave) * D) + lane;
#pragma unroll
          for (int j = 0; j < 4; ++j) { const f32x4 a0 = z0[64 * j], a1 = z0[256 + 64 * j];
#pragma unroll
            for (int k = 0; k < 4; ++k) { zn0[4 * j + k] = a0[k]; zn1[4 * j + k] = a1[k]; } } }
        for (int pp = 0; pp < 4; ++pp) {
            const int tl0 = 8 * F.wave + 2 * pp;
            const int tok0 = tb * 64 + tl0;
            float h0[16], h1[16];
            {
                u32x2* ho0 = (u32x2*)(Hout + (size_t)tok0 * D) + lane; u32x2* ho1 = ho0 + 256;
                float s0 = 0.f, s1 = 0.f, q0 = 0.f, q1 = 0.f;
#pragma unroll
                for (int i = 0; i < 16; ++i) { h0[i] = zn0[i]; h1[i] = zn1[i]; }
                if (pp < 3) { const f32x4* zp = (const f32x4*)(Zin + (size_t)(tok0 + 2) * D) + lane;
#pragma unroll
                    for (int j = 0; j < 4; ++j) { const f32x4 a0 = zp[64 * j], a1 = zp[256 + 64 * j];
#pragma unroll
                        for (int k = 0; k < 4; ++k) { zn0[4 * j + k] = a0[k]; zn1[4 * j + k] = a1[k]; } } }
#pragma unroll
                for (int i = 0; i < 16; ++i) { s0 += h0[i]; s1 += h1[i]; q0 += h0[i] * h0[i]; q1 += h1[i] * h1[i]; }
                s0 = xsum(s0); s1 = xsum(s1); q0 = xsum(q0); q1 = xsum(q1);
                const float m0 = s0 * (1.f / D), m1 = s1 * (1.f / D);
                const float r0 = rsqrtf(fmaxf(q0 * (1.f / D) - m0 * m0, 0.f) + LN_EPS), r1 = rsqrtf(fmaxf(q1 * (1.f / D) - m1 * m1, 0.f) + LN_EPS);
                float a0 = 0.f, a1 = 0.f;
#pragma unroll
                for (int i = 0; i < 16; ++i) {
                    const float gm_ = gbl[4 * lane + 256 * (i >> 2) + (i & 3)], bt_ = gbl[1024 + 4 * lane + 256 * (i >> 2) + (i & 3)];
                    h0[i] = (h0[i] - m0) * r0 * gm_ + bt_; h1[i] = (h1[i] - m1) * r1 * gm_ + bt_;
                    a0 = fmaxf(a0, fabsf(h0[i])); a1 = fmaxf(a1, fabsf(h1[i]));
                }
                a0 = xmax(a0); a1 = xmax(a1);
                const float i0 = a0 > 0.f ? 127.0f / a0 : 0.f, i1 = a1 > 0.f ? 127.0f / a1 : 0.f;
                unsigned* hb0 = (unsigned*)(HB8 + (size_t)tok0 * D) + lane; unsigned* hb1 = hb0 + 256;
#pragma unroll
                for (int j = 0; j < 4; ++j) {
                    { u32x2 w0, w1; w0.x = cvt_pk_bf16(h0[4 * j], h0[4 * j + 1]); w0.y = cvt_pk_bf16(h0[4 * j + 2], h0[4 * j + 3]); w1.x = cvt_pk_bf16(h1[4 * j], h1[4 * j + 1]); w1.y = cvt_pk_bf16(h1[4 * j + 2], h1[4 * j + 3]); ho0[64 * j] = w0; ho1[64 * j] = w1; }
                    unsigned p0 = 0u, p1 = 0u;
#pragma unroll
                    for (int k = 0; k < 4; ++k) { p0 |= ((unsigned)(int)rintf(h0[4 * j + k] * i0) & 0xffu) << (8 * k); p1 |= ((unsigned)(int)rintf(h1[4 * j + k] * i1) & 0xffu) << (8 * k); }
                    hb0[64 * j] = p0; hb1[64 * j] = p1;
                }
                if (lane == 0) { tmp_s[tl0] = a0 * (1.0f / 127.0f); tmp_s[tl0 + 1] = a1 * (1.0f / 127.0f); }
            }
            f32x2 lp0[16], lp1[16];
#pragma unroll
            for (int e = 0; e < 16; ++e) { lp0[e] = (f32x2){0.f, 0.f}; lp1[e] = (f32x2){0.f, 0.f}; }
#pragma unroll
            for (int i = 0; i < 16; ++i) {
                const LAS f32x4* wr = (const LAS f32x4*)(W + (256 * (i >> 2) + 64 * (i & 3) + lane) * 36);
                const f32x2 hv0 = (f32x2){h0[i], h0[i]}, hv1 = (f32x2){h1[i], h1[i]};
#pragma unroll
                for (int e4 = 0; e4 < 8; ++e4) {
                    const f32x4 ww = wr[e4];
                    const f32x2 wlo = (f32x2){ww.x, ww.y}, whi = (f32x2){ww.z, ww.w};
                    lp0[2 * e4] = __builtin_elementwise_fma(hv0, wlo, lp0[2 * e4]); lp0[2 * e4 + 1] = __builtin_elementwise_fma(hv0, whi, lp0[2 * e4 + 1]);
                    lp1[2 * e4] = __builtin_elementwise_fma(hv1, wlo, lp1[2 * e4]); lp1[2 * e4 + 1] = __builtin_elementwise_fma(hv1, whi, lp1[2 * e4 + 1]);
                }
            }
            float lg0[32], lg1[32];
#pragma unroll
            for (int e = 0; e < 16; ++e) { lg0[2 * e] = lp0[e].x; lg0[2 * e + 1] = lp0[e].y; lg1[2 * e] = lp1[e].x; lg1[2 * e + 1] = lp1[e].y; }
            float v32[32];
#pragma unroll
            for (int e = 0; e < 32; ++e) { const float keep = half ? lg1[e] : lg0[e], send = half ? lg0[e] : lg1[e]; v32[e] = keep + __shfl_xor(send, 32); }
            float v16[16];
#pragma unroll
            for (int e = 0; e < 16; ++e) { const bool up = (lane & 16) != 0; const float keep = up ? v32[e + 16] : v32[e], send = up ? v32[e] : v32[e + 16]; v16[e] = keep + __shfl_xor(send, 16); }
            float v8[8];
#pragma unroll
            for (int e = 0; e < 8; ++e) { const bool up = (lane & 8) != 0; const float keep = up ? v16[e + 8] : v16[e], send = up ? v16[e] : v16[e + 8]; v8[e] = keep + dppf<0x128>(send); }
            float v4[4];
#pragma unroll
            for (int e = 0; e < 4; ++e) { const bool up = (lane & 4) != 0; const float keep = up ? v8[e + 4] : v8[e], send = up ? v8[e] : v8[e + 4]; v4[e] = keep + dppf<0x1B>(dppf<0x141>(send)); }
            float v2[2];
#pragma unroll
            for (int e = 0; e < 2; ++e) { const bool up = (lane & 2) != 0; const float keep = up ? v4[e + 2] : v4[e], send = up ? v4[e] : v4[e + 2]; v2[e] = keep + dppf<0x4E>(send); }
            float lgt;
            { const bool up = (lane & 1) != 0; const float keep = up ? v2[1] : v2[0], send = up ? v2[0] : v2[1]; lgt = keep + dppf<0xB1>(send); }
            lgt += b_r[el];
            float bv[4]; int bi[4];
            {
                float cur = lgt;
#pragma unroll
                for (int k = 0; k < 4; ++k) {
                    float mx = cur;
                    mx = fmaxf(mx, dppf<0xB1>(mx)); mx = fmaxf(mx, dppf<0x4E>(mx)); mx = fmaxf(mx, dppf<0x124>(mx)); mx = fmaxf(mx, dppf<0x128>(mx));
                    const float m0 = fmaxf(rdlane(mx, 0), rdlane(mx, 16)), m1 = fmaxf(rdlane(mx, 32), rdlane(mx, 48));
                    const float mm = half ? m1 : m0;
                    const unsigned long long mk = __ballot(cur == mm);
                    const int i0 = __builtin_ctz((unsigned)mk | 0x80000000u), i1 = __builtin_ctz((unsigned)(mk >> 32) | 0x80000000u);
                    bv[k] = mm; bi[k] = half ? i1 : i0;
                    if (el == bi[k]) cur = -INFINITY;
                }
            }
            float ex[4], es = 0.f;
#pragma unroll
            for (int k = 0; k < 4; ++k) { ex[k] = __expf(bv[k] - bv[0]); es += ex[k]; }
            if (el == 0) {
                const int tl = tl0 + half;
#pragma unroll
                for (int k = 0; k < 4; ++k) { const unsigned pl = atomicAdd((unsigned*)&hist[bi[k]], 1u); tmp_e[tl * 4 + k] = bi[k]; tmp_p[tl * 4 + k] = (int)pl; tmp_g[tl * 4 + k] = ex[k] / es; }
            }
        }
        __syncthreads();
        if (F.tid < 32) base[F.tid] = commit ? atomicAdd(&cnt[F.tid], hist[F.tid]) : 0u;
        __syncthreads();
        if (F.tid < 256) { const int i = F.tid, gi = tb * 256 + i, e = tmp_e[i];
            const int pos = (int)base[e] + tmp_p[i];
            meta[MT_SEL_E + gi] = e; meta[MT_SEL_POS + gi] = pos;
            el_tok[e * T + pos] = tb * 64 + (i >> 2); el_gate[e * T + pos] = tmp_g[i]; el_sa[e * T + pos] = tmp_s[i >> 2]; }
        __syncthreads();
    }
}
__device__ __forceinline__ void build_tables(const Frame& F, const Args& a) {
    const unsigned* cnt = (const unsigned*)(a.ws + WS_CTL) + CW_CNT;
    LAS int* tb = (LAS int*)(F.lds + RSCR_OFF);
    __syncthreads();
    if (F.tid < 32) tb[TBL_CNT + F.tid] = (int)__hip_atomic_load(cnt + F.tid, RLX_AGENT);
    __syncthreads();
    if (F.tid == 0) { int acc = 0; for (int e = 0; e < 32; ++e) { tb[TBL_TS + e] = acc; acc += (tb[TBL_CNT + e] + 255) >> 8; } tb[TBL_TS + 32] = acc; }
    __syncthreads();
    for (int t = F.tid; t < NT_MAX; t += NWAVES * 64) { int e = 0; for (int j = 1; j < 32; ++j) if (t >= tb[TBL_TS + j]) e = j; tb[TBL_TILE + t] = e; }
    __syncthreads();
}
__device__ __forceinline__ void p7_quant(const Frame& F, const Args& a) {
    const bf16* HID = (const bf16*)(a.ws + WS_HID); signed char* H8 = (signed char*)(a.ws + WS_HID8); float* row_sb = (float*)(a.ws + WS_ROWSB);
    const int nrows = __builtin_amdgcn_readfirstlane(((const LAS int*)(F.lds + RSCR_OFF))[TBL_TS + 32]) * 256;
    const int gw = F.vcu * NWAVES + F.wave, NGW = F.G * NWAVES, lane = F.lane;
    for (int r0 = gw * 4; r0 < nrows; r0 += NGW * 4) {
        u32x4 v[4][2];
#pragma unroll
        for (int i = 0; i < 4; ++i)
#pragma unroll
            for (int j = 0; j < 2; ++j) v[i][j] = *((const u32x4*)(HID + (size_t)(r0 + i) * DFF + 512 * j) + lane);
#pragma unroll
        for (int i = 0; i < 4; ++i) {
            float f[16]; float am = 0.f;
#pragma unroll
            for (int j = 0; j < 2; ++j)
#pragma unroll
                for (int c = 0; c < 4; ++c) { const unsigned w = v[i][j][c]; f[8 * j + 2 * c] = __uint_as_float(w << 16); f[8 * j + 2 * c + 1] = __uint_as_float(w & 0xffff0000u); }
#pragma unroll
            for (int c = 0; c < 16; ++c) am = fmaxf(am, fabsf(f[c]));
            am = xmax(am);
            const float inv = am > 0.f ? 127.0f / am : 0.f;
#pragma unroll
            for (int j = 0; j < 2; ++j) {
                u32x2 o; o.x = 0u; o.y = 0u;
#pragma unroll
                for (int c = 0; c < 4; ++c) { o.x |= ((unsigned)(int)rintf(f[8 * j + c] * inv) & 0xffu) << (8 * c); o.y |= ((unsigned)(int)rintf(f[8 * j + 4 + c] * inv) & 0xffu) << (8 * c); }
                *((u32x2*)(H8 + (size_t)(r0 + i) * DFF + 512 * j) + lane) = o;
            }
            if (lane == 0) row_sb[r0 + i] = am * (1.0f / 127.0f);
        }
    }
}
__device__ __forceinline__ void p8_final(const Frame& F, const Args& a) {
    const bf16* Hin = (const bf16*)(a.ws + WS_H); float* HO = a.out; const unsigned char* Y = (const unsigned char*)(a.ws + WS_Y); const int* meta = (const int*)(a.ws + WS_META);
    const float* ln2_g = a.in[20]; const float* ln2_b = a.in[21]; const LAS int* tsl = (const LAS int*)(F.lds + RSCR_OFF) + TBL_TS;
    const int gw = F.vcu * NWAVES + F.wave, NGW = F.G * NWAVES, lane = F.lane;
    f32x4 g2[4], b2[4];
#pragma unroll
    for (int j = 0; j < 4; ++j) { g2[j] = *(const f32x4*)(ln2_g + 4 * lane + 256 * j); b2[j] = *(const f32x4*)(ln2_b + 4 * lane + 256 * j); }
    for (int tok = gw; tok < T; tok += NGW) {
        f32x4* hr = (f32x4*)(HO + (size_t)tok * D) + lane; const u32x2* hi_ = (const u32x2*)(Hin + (size_t)tok * D) + lane;
        f32x4 v[4]; float s = 0.f;
#pragma unroll
        for (int j = 0; j < 4; ++j) { const u32x2 hh = hi_[64 * j]; v[j] = (f32x4){__uint_as_float(hh.x << 16), __uint_as_float(hh.x & 0xffff0000u), __uint_as_float(hh.y << 16), __uint_as_float(hh.y & 0xffff0000u)} * ALPHA; }
#pragma unroll
        for (int k = 0; k < 4; ++k) {
            const int row = tsl[meta[MT_SEL_E + tok * 4 + k]] * 256 + meta[MT_SEL_POS + tok * 4 + k];
            const unsigned* yr = (const unsigned*)(Y + (size_t)row * D) + lane;
#pragma unroll
            for (int j = 0; j < 4; ++j) { const int y = (int)yr[64 * j]; const f32x2 lo = __builtin_amdgcn_cvt_pk_f32_fp8(y, false), hi2 = __builtin_amdgcn_cvt_pk_f32_fp8(y, true);
                v[j].x += lo.x * (1.0f / YSCALE); v[j].y += lo.y * (1.0f / YSCALE); v[j].z += hi2.x * (1.0f / YSCALE); v[j].w += hi2.y * (1.0f / YSCALE); }
        }
#pragma unroll
        for (int j = 0; j < 4; ++j) s += (v[j].x + v[j].y) + (v[j].z + v[j].w);
        const float mean = xsum(s) * (1.f / D); float s2 = 0.f;
#pragma unroll
        for (int j = 0; j < 4; ++j) { v[j] = v[j] - mean; s2 += (v[j].x * v[j].x + v[j].y * v[j].y) + (v[j].z * v[j].z + v[j].w * v[j].w); }
        const float rstd = rsqrtf(xsum(s2) * (1.f / D) + LN_EPS);
#pragma unroll
        for (int j = 0; j < 4; ++j) hr[64 * j] = v[j] * rstd * g2[j] + b2[j];
    }
}
__global__ void __launch_bounds__(NWAVES * 64, 2) mk_fwd(Args args) {
    extern __shared__ __attribute__((aligned(16))) unsigned char lds_raw[];
    Frame F;
    F.lds = (LAS unsigned char*)lds_raw;
    F.tid = threadIdx.x; F.lane = F.tid & 63; F.wave = __builtin_amdgcn_readfirstlane(F.tid >> 6);
    F.G = gridDim.x; { const int bx = blockIdx.x; F.vcu = (F.G % 8 == 0) ? (bx % 8) * (F.G / 8) + bx / 8 : bx; }
    volatile LAS unsigned* MISC = (volatile LAS unsigned*)(F.lds + MISC_OFF);
    if (F.tid < 64) MISC[F.tid] = 0u;
    __syncthreads();
    unsigned char* ws = args.ws;
    unsigned* ctl = (unsigned*)(ws + WS_CTL);
    const int lo = args.ph_lo, hi = args.ph_hi;
    XcdBarrier bar; bar.bar = ctl + CW_BAR + args.li * XCD_BAR_WORDS; bar.x = 0; bar.st = nullptr;
    if (hi - lo > 1) bar = xcd_barrier_post(ctl + CW_BAR + args.li * XCD_BAR_WORDS, MISC + 8);
#define IN(k) (lo <= (k) && (k) < hi)
#define OPAQUE_F(Fp) Frame Fp = F; asm volatile("" : "+v"(Fp.tid)); Fp.lane = Fp.tid & 63
#define SEAM(k) do { if (IN(k) && IN((k) + 1)) xcd_barrier(bar); } while (0)
    int* meta = (int*)(ws + WS_META);
    bf16 *XB = (bf16*)(ws + WS_XB), *QB = (bf16*)(ws + WS_QB), *KB = (bf16*)(ws + WS_KB), *VT = (bf16*)(ws + WS_VT), *UB = (bf16*)(ws + WS_UB), *GB = (bf16*)(ws + WS_GB);
    bf16 *CAT = (bf16*)(ws + WS_CAT), *HB = (bf16*)(ws + WS_HB), *Y = (bf16*)(ws + WS_Y), *HID = (bf16*)(ws + WS_HID);
    bf16 *Win_t = (bf16*)(ws + WS_WIN), *Wout_t = (bf16*)(ws + WS_WOUT), *Wgu_t = (bf16*)(ws + WS_WGU), *Wd_t = (bf16*)(ws + WS_WD);
    const LAS int* rtab = (const LAS int*)(F.lds + RTAB_OFF);
    const bool par = ((blockIdx.x >> 3) & 1) != 0;

    if (IN(0)) { OPAQUE_F(Fp); p0_prologue(Fp, args); SEAM(0); }
    if (IN(1)) {
        const int c = (int)blockIdx.x, grp = (c >> 3) % 3;
        const int per_ = (3 * NEXP * 32 + F.G - 1) / F.G;
        const int it_lo = F.G == 256 ? (c < 192 ? c * 10 : 1920 + (c - 192) * 18) : c * per_, it_hi = F.G == 256 ? it_lo + (c < 192 ? 10 : 18) : it_lo + per_;
        OPAQUE_F(Fp);
        if (grp == 0) conv_items(Fp, args, it_lo, it_hi);
        { pg8::Gemm g{XB, Win_t, 2 * D, nullptr, 0u}; pg8::StaticOrder S; S.init(T / 256, INW / 256, F.G, c); S.i1 = 1;
          pg8::EpiInProj E{args.in[2], QB, KB, VT, UB, GB};
          pg8::gemm_phase<pg8::EpiInProj, false, true, false>(F.lds, rtab, g, S, E); }
        if (grp == 1) conv_items(Fp, args, it_lo, it_hi);
        { pg8::Gemm g{XB, Win_t, 2 * D, nullptr, 0u}; pg8::StaticOrder S; S.init(T / 256, INW / 256, F.G, c); S.i0 = 1;
          pg8::EpiInProj E{args.in[2], QB, KB, VT, UB, GB};
          pg8::gemm_phase<pg8::EpiInProj, false, true, false>(F.lds, rtab, g, S, E); }
        if (grp == 2) conv_items(Fp, args, it_lo, it_hi);
        SEAM(1);
    }
    if (IN(2)) { OPAQUE_F(Fp); p2_mixers(Fp, args); SEAM(2); }
    if (IN(3)) {
        pg8::Gemm g{CAT, Wout_t, 2 * D, nullptr, 0u}; pg8::StaticOrder S; S.init(T / 256, D / 256, F.G, (int)blockIdx.x);
        pg8::EpiOutProj E{args.in[0], args.in[9], args.out};
        pg8::gemm_phase<pg8::EpiOutProj, false, false, false>(F.lds, rtab, g, S, E);
        SEAM(3);
    }
    if (IN(4)) { OPAQUE_F(Fp); p4_router(Fp, args, true); if (hi > 5) xcd_barrier(bar); }
    const LAS int* tbl = (const LAS int*)(F.lds + RSCR_OFF);
    if (hi > 5) { OPAQUE_F(Fp); build_tables(Fp, args); }
    if (IN(6)) {
        const int nT = __builtin_amdgcn_readfirstlane(tbl[TBL_TS + 32]);
        pg8::StaticOrder S; S.init(nT, 2 * DFF / 256, F.G, (int)blockIdx.x);
        { pg8::Unit u; LAS int* rt = (LAS int*)(F.lds + RTAB_OFF); const int* el_tok = (const int*)(ws + WS_ELIST);
          for (int i = 0; i < RTAB_UNITS && S.next(i, u); ++i) if (F.tid < 256) { const int e = tbl[TBL_TILE + u.pm], ix = (u.pm - tbl[TBL_TS + e]) * 256 + F.tid; rt[i * 256 + F.tid] = ix < tbl[TBL_CNT + e] ? el_tok[e * T + ix] : 0; }
          __syncthreads(); }
        pg8::Gemm g{HB, Wgu_t, D, tbl + TBL_TILE, 2048u * 1024u};
        pg8::EpiSwiglu E{tbl, args.in[15], args.in[17], (const float*)(ws + WS_SWGU), (const float*)(ws + WS_ELIST) + 2 * NEXP * T, HID};
        pg8::gemm_phase<pg8::EpiSwiglu, true, true, true>(F.lds, rtab, g, S, E);
        SEAM(6);
    }
    if (IN(7)) { OPAQUE_F(Fp); p7_quant(Fp, args); SEAM(7); }
    if (IN(8)) {
        const int nT = __builtin_amdgcn_readfirstlane(tbl[TBL_TS + 32]);
        pg8::StaticOrder S; S.init(nT, D / 256, F.G, (int)blockIdx.x);
        pg8::Gemm g{ws + WS_HID8, Wd_t, DFF, tbl + TBL_TILE, 1024u * 1024u};
        pg8::EpiDown E{tbl, args.in[19], (const float*)(ws + WS_SWD), (const float*)(ws + WS_ROWSB), (const float*)(ws + WS_ELIST) + NEXP * T, (unsigned char*)Y};
        pg8::gemm_phase<pg8::EpiDown, false, true, true>(F.lds, rtab, g, S, E);
        SEAM(8);
    }
    if (IN(9)) { OPAQUE_F(Fp); p8_final(Fp, args); }
#undef IN
#undef SEAM
}

extern "C" void kernel_launch(void* const* d_in, const int* in_sizes, int n_in, void* d_out, int out_size, void* d_ws, size_t ws_size, hipStream_t stream) {
    static int grid = 0;
    if (grid == 0) {
        if (n_in != 22 || in_sizes[0] != T * D || out_size != T * D || ws_size < WS_END) { fprintf(stderr, "kernel_launch: unexpected shapes (n_in %d, in0 %d, out %d, ws %zu, need %zu)\n", n_in, n_in > 0 ? in_sizes[0] : -1, out_size, ws_size, (size_t)WS_END); grid = -1; return; }
        int dev = 0, cus = 0;
        if (hipGetDevice(&dev) != hipSuccess || hipDeviceGetAttribute(&cus, hipDeviceAttributeMultiprocessorCount, dev) != hipSuccess) { grid = -1; return; }
        if (hipFuncSetAttribute((const void*)mk_fwd, hipFuncAttributeMaxDynamicSharedMemorySize, LDS_BYTES) != hipSuccess) { fprintf(stderr, "kernel_launch: hipFuncSetAttribute failed\n"); grid = -1; return; }
        int per_cu = 0;
        if (hipOccupancyMaxActiveBlocksPerMultiprocessor(&per_cu, (const void*)mk_fwd, NWAVES * 64, LDS_BYTES) != hipSuccess || per_cu < 1) fprintf(stderr, "kernel_launch: occupancy query reports %d\n", per_cu);
        (void)hipGetLastError();
        grid = cus;
    }
    if (grid < 0) return;
    unsigned char* ws = (unsigned char*)d_ws; float* out = (float*)d_out;
    (void)hipMemsetAsync(ws + WS_CTL, 0, 64 * 1024, stream);
    Args a{};
    for (int i = 0; i < 22; ++i) a.in[i] = (const float*)d_in[i];
    a.out = out; a.ws = ws;
    a.ph_lo = 0; a.ph_hi = NPHASES; a.li = 0;
    hipLaunchKernelGGL(mk_fwd, dim3(grid), dim3(NWAVES * 64), LDS_BYTES, stream, a);
}
```

```cpp
#include <hip/hip_runtime.h>
#include <cstdio>
#include <cstdint>

typedef unsigned short bf16;
typedef float f32x4 __attribute__((ext_vector_type(4)));
typedef unsigned u32x4 __attribute__((ext_vector_type(4)));
typedef unsigned u32x2 __attribute__((ext_vector_type(2)));

constexpr int BATCH = 2, SEQ = 8192, D = 1024, T = BATCH * SEQ;
constexpr int NQH = 8, NKVH = 2, HD = 64, QREP = 4, AW = 512, KVW = 128, GW = 512, INW = 1792;
constexpr int NEXP = 32, TOPK = 4, DFF = 1024;
constexpr int NT_MAX = T * TOPK / 256 + NEXP;
constexpr int NROWS_MAX = NT_MAX * 256;
constexpr float LN_EPS = 1e-5f;
constexpr float ALPHA = 1.189207115002721f;
constexpr float C2 = 0.125f * 1.4426950408889634f;
constexpr float LOG2E = 1.4426950408889634f;
constexpr float YSCALE = 16.0f;

constexpr size_t MiB = 1u << 20;
constexpr size_t WS_CTL = 0;
constexpr size_t WS_META = 1 * MiB;
constexpr size_t WS_XB = 3 * MiB;
constexpr size_t WS_QB = WS_XB + 32 * MiB;
constexpr size_t WS_KB = WS_QB + 16 * MiB;
constexpr size_t WS_VT = WS_KB + 4 * MiB;
constexpr size_t WS_UB = WS_VT + 4 * MiB;
constexpr size_t WS_GB = WS_UB + 16 * MiB;
constexpr size_t WS_CAT = WS_GB + 16 * MiB;
constexpr size_t WS_HB = WS_CAT + 32 * MiB;
constexpr size_t WS_H = WS_XB;
constexpr size_t WS_HID = WS_HB + 32 * MiB;
constexpr size_t WS_Y = WS_HID;
static_assert(WS_H + 64 * MiB <= WS_CAT, "H overlay");

constexpr int CW_CNT = 64;
constexpr int MT_NT = 0;
constexpr int MT_TSTART = 16;
constexpr int MT_TILE_E = 64;
constexpr int MT_SEL_E = 1024;
constexpr int MT_SEL_POS = MT_SEL_E + T * 4;
constexpr int MT_SEL_G = MT_SEL_POS + T * 4;
constexpr int MT_SLOT_ROW = MT_SEL_G + T * 4;
constexpr int MT_ROW_TOK = MT_SLOT_ROW + T * 4;
constexpr int MT_ROW_GATE = MT_ROW_TOK + NROWS_MAX;
constexpr int MT_ROW_SA = MT_ROW_GATE + NROWS_MAX;
constexpr int MT_SH = MT_ROW_SA + NROWS_MAX;
constexpr size_t WS_ELIST = WS_GB;
constexpr int TBL_CNT = 0, TBL_TS = 32, TBL_TILE = 72;
constexpr size_t WS_ROWSB = 512 * 1024;
static_assert((size_t)(MT_SH + T) * 4 <= 2 * MiB, "meta");

__device__ __forceinline__ float bf2f(bf16 v) { return __uint_as_float((unsigned)v << 16); }
__device__ __forceinline__ unsigned f2bf(float f) { unsigned u = __float_as_uint(f); return (u + 0x7fffu + ((u >> 16) & 1u)) >> 16; }
__device__ __forceinline__ unsigned pk2(float lo, float hi) { return f2bf(lo) | (f2bf(hi) << 16); }
__device__ __forceinline__ float gelu_tanh(float x) {
    const float k2 = 2.0f * 0.7978845608028654f;
    const float u = k2 * (x + 0.044715f * x * x * x);
    return x / (1.0f + __expf(-u));
}
__device__ __forceinline__ float wave_sum(float v) {
#pragma unroll
    for (int o = 1; o < 64; o <<= 1) v += __shfl_xor(v, o);
    return v;
}
__device__ __forceinline__ float wave_max(float v) {
#pragma unroll
    for (int o = 1; o < 64; o <<= 1) v = fmaxf(v, __shfl_xor(v, o));
    return v;
}

#define LAS __attribute__((address_space(3)))
#define GAS __attribute__((address_space(1)))
typedef short bf16x8 __attribute__((ext_vector_type(8)));
typedef float f32x16 __attribute__((ext_vector_type(16)));
typedef float f32x2 __attribute__((ext_vector_type(2)));
__device__ __forceinline__ unsigned cvt_pk_bf16(float lo, float hi) { unsigned r; asm volatile("v_cvt_pk_bf16_f32 %0, %1, %2" : "=v"(r) : "v"(lo), "v"(hi)); return r; }
__device__ __forceinline__ float fast_gelu(float x) {
    const float u = -2.0f * 0.7978845608028654f * LOG2E * (x + 0.044715f * x * x * x);
    return x * __builtin_amdgcn_rcpf(1.0f + __builtin_amdgcn_exp2f(u));
}
__device__ __forceinline__ void st16_wt(void* p, u32x4 v) {
    *(u32x4*)p = v;
}
namespace pg8 {
constexpr int BM = 256, BK = 64, HALF = 128, HTB = HALF * BK * 2  , STAGE_BYTES = 8 * HTB, NXCD = 8, WGM = 8;
__host__ __device__ __forceinline__ int lds_byte(int r, int c) { const int st = (r >> 4) * 2 + (c >> 5), rr = r & 15, cc = c & 31, ob = rr * 64 + cc * 2; return st * 1024 + (ob ^ (((ob >> 9) & 1) << 5)); }
__host__ __device__ __forceinline__ void stage_rc(int b, int& R, int& C) { const int st = b / 1024, sb = b % 1024, swz = sb ^ (((sb >> 9) & 1) << 5); R = (st >> 1) * 16 + swz / 64; C = (st & 1) * 32 + (swz % 64) / 2; }
__host__ __device__ __forceinline__ int perm32(int rho) { const int n = rho >> 4, i = rho & 15; return 8 * (i >> 2) + 4 * n + (i & 3); }

struct Unit { int pm, pn; };
struct Gemm { const void* A; const void* Bt; int KB; const LAS int* tile_e; unsigned e_stride; };
typedef int i32x4 __attribute__((ext_vector_type(4)));

struct StaticOrder {
    int nM, nN, nwg, G, c, i0 = 0, i1 = 1 << 30;
    __device__ void init(int nM_, int nN_, int G_, int c_) { nM = nM_; nN = nN_; nwg = nM * nN; G = G_; c = c_; }
    __device__ bool next(int i, Unit& u) const {
        i += i0; if (i >= i1) return false;
        const long L = (long)i * G + c; if (L >= nwg) return false;
        int wgid = (int)L; { const int q = nwg / NXCD, r = nwg % NXCD, xcd = wgid % NXCD, off = wgid / NXCD; wgid = (xcd < r ? xcd * (q + 1) : r * (q + 1) + (xcd - r) * q) + off; }
        const int nig = WGM * nN, gid = wgid / nig, fm = gid * WGM, gsz = (nM - fm) < WGM ? (nM - fm) : WGM;
        u.pm = fm + ((wgid % nig) % gsz); u.pn = (wgid % nig) / gsz; return true;
    }
};

template <class Epi, bool GATHER, bool ALIGN_EPI, bool I8>
__device__ __forceinline__ void gemm_phase(LAS unsigned char* lds, const LAS int* rtab, const Gemm g, const StaticOrder& S, const Epi& E) {
    int tid_ = threadIdx.x; asm volatile("" : "+v"(tid_));
    const int tid = tid_, wid = __builtin_amdgcn_readfirstlane(tid >> 6), lane = tid & 63, wr = wid >> 2, wc = wid & 3, fr = lane & 15, fq = lane >> 4;
    const int KB = g.KB, nt = KB / (BK * 2);
    int Rs[2], Cs[2]; unsigned voffB[2];
#pragma unroll
    for (int i = 0; i < 2; ++i) { int R, C; stage_rc(tid * 16 + i * 8192, R, C); const int Rb = Epi::PERM == 2 ? (64 * (R >> 5) + 16 * ((R >> 2) & 3) + 4 * ((R >> 4) & 1) + (R & 3)) : Epi::PERM ? ((R & ~31) + perm32(R & 31)) : R; Rs[i] = R; Cs[i] = C; voffB[i] = (unsigned)(Rb * KB + C * 2); }
    const size_t kstep = (size_t)(BK * 2);
    const size_t hstep = (size_t)HALF * KB;
    const size_t tstep = 2 * hstep;
    const size_t bhstep = Epi::PERM == 2 ? (size_t)8 * KB : hstep;
    const unsigned ldsw = (unsigned)wid * 1024u;
    const int aoff = lds_byte(wr * 64 + fr, fq * 8), boff = lds_byte(wc * 32 + fr, fq * 8);
#define PG8_SA(b, h) (((b) * 2 + (h)) * HTB)
#define PG8_SB(b, h) ((4 + (b) * 2 + (h)) * HTB)
#define PG8_STAGE(bufoff, gbase, voff) do { _Pragma("unroll") for (int _i = 0; _i < 2; ++_i) \
        __builtin_amdgcn_global_load_lds((const unsigned*)((const char*)(gbase) + (voff)[_i]), (LAS unsigned*)(lds + (bufoff) + ldsw + _i * 8192), 16, 0, 0); } while (0)
#define PG8_LDA(dst, b, h) do { _Pragma("unroll") for (int m = 0; m < 4; ++m) _Pragma("unroll") for (int k = 0; k < 2; ++k) dst[m][k] = *(const LAS bf16x8*)(lds + PG8_SA(b, h) + aoff + m * 2048 + k * 1024); } while (0)
#define PG8_LDB(dst, b, h) do { _Pragma("unroll") for (int n = 0; n < 2; ++n) _Pragma("unroll") for (int k = 0; k < 2; ++k) dst[n][k] = *(const LAS bf16x8*)(lds + PG8_SB(b, h) + boff + n * 2048 + k * 1024); } while (0)
#define PG8_MMA(ai, bj, At, Bt) do { __builtin_amdgcn_s_setprio(1); _Pragma("unroll") for (int m = 0; m < 4; ++m) _Pragma("unroll") for (int n = 0; n < 2; ++n) _Pragma("unroll") for (int k = 0; k < 2; ++k) \
        { if constexpr (I8) acc[ai][bj][m][n] = __builtin_bit_cast(f32x4, __builtin_amdgcn_mfma_i32_16x16x64_i8(__builtin_bit_cast(i32x4, Bt[n][k]), __builtin_bit_cast(i32x4, At[m][k]), __builtin_bit_cast(i32x4, acc[ai][bj][m][n]), 0, 0, 0)); \
          else acc[ai][bj][m][n] = __builtin_amdgcn_mfma_f32_16x16x32_bf16(Bt[n][k], At[m][k], acc[ai][bj][m][n], 0, 0, 0); } __builtin_amdgcn_s_setprio(0); } while (0)
#define PG8_WAIT_V(n) asm volatile("s_waitcnt vmcnt(" #n ")" ::: "memory")
#define PG8_WAIT_L(n) asm volatile("s_waitcnt lgkmcnt(" #n ")" ::: "memory")
#define PG8_BAR __builtin_amdgcn_s_barrier()
#define PG8_SCHED __builtin_amdgcn_sched_barrier(0)
#define PG8_VOFFA(vo, ui_, u_) do { _Pragma("unroll") for (int h_ = 0; h_ < 2; ++h_) _Pragma("unroll") for (int i_ = 0; i_ < 2; ++i_) { \
        const int row_ = GATHER ? rtab[(ui_) * 256 + h_ * 128 + Rs[i_]] : ((u_).pm * 256 + h_ * 128 + Rs[i_]); \
        vo[h_][i_] = (unsigned)(row_ * KB + Cs[i_] * 2); } } while (0)
#define PG8_BBASE(u_) ((const char*)g.Bt + (g.tile_e ? (size_t)g.tile_e[(u_).pm] * g.e_stride : (size_t)0) + (size_t)(u_).pn * tstep)
    Unit cur, nxt; int ui = 0;
    if (!S.next(0, cur)) return;
    f32x4 acc[2][2][4][2];
    if constexpr (Epi::HAS_INIT) E.init(acc, cur, wr, wc, fr, fq);
    else {
#pragma unroll
    for (int a = 0; a < 2; ++a)
#pragma unroll
        for (int b = 0; b < 2; ++b)
#pragma unroll
            for (int m = 0; m < 4; ++m)
#pragma unroll
                for (int n = 0; n < 2; ++n) acc[a][b][m][n] = (f32x4){0.f, 0.f, 0.f, 0.f};
    }
    bf16x8 At[4][2], B0[2][2], B1[2][2];
    unsigned vAc[2][2], vAn[2][2];
    PG8_VOFFA(vAc, 0, cur);
    const char* const gA = (const char*)g.A;
    const char* cB = PG8_BBASE(cur);
    PG8_STAGE(PG8_SB(0, 0), cB, voffB); PG8_STAGE(PG8_SB(0, 1), cB + bhstep, voffB); PG8_STAGE(PG8_SA(0, 0), gA, vAc[0]); PG8_STAGE(PG8_SA(0, 1), gA, vAc[1]);
    if (wr == 1) PG8_BAR;
    PG8_WAIT_V(2); PG8_BAR;
    PG8_STAGE(PG8_SB(1, 0), cB + kstep, voffB); PG8_STAGE(PG8_SA(1, 0), gA + kstep, vAc[0]); PG8_STAGE(PG8_SB(1, 1), cB + bhstep + kstep, voffB);
    PG8_WAIT_V(6); PG8_BAR;
    for (;;) {
        const bool has_next = S.next(ui + 1, nxt);
        const char* nB = cB;
        if (has_next) { nB = PG8_BBASE(nxt); PG8_VOFFA(vAn, ui + 1, nxt); }
        else {
#pragma unroll
            for (int h = 0; h < 2; ++h)
#pragma unroll
                for (int i = 0; i < 2; ++i) vAn[h][i] = vAc[h][i];
        }
        for (int t = 0; t < nt; t += 2) {
            const bool last = (t == nt - 2);
            const char* a1 = gA + (size_t)(t + 1) * kstep;
            const char* a2 = last ? gA : gA + (size_t)(t + 2) * kstep; const char* b2 = last ? nB : cB + (size_t)(t + 2) * kstep;
            const char* a3 = a2 + kstep; const char* b3 = b2 + kstep;
            unsigned v2[2][2];
#pragma unroll
            for (int h = 0; h < 2; ++h)
#pragma unroll
                for (int i = 0; i < 2; ++i) v2[h][i] = last ? vAn[h][i] : vAc[h][i];
            PG8_LDB(B0, 0, 0); PG8_LDB(B1, 0, 1); PG8_SCHED; PG8_LDA(At, 0, 0); PG8_STAGE(PG8_SA(1, 1), a1, vAc[1]);
            PG8_WAIT_V(8); PG8_WAIT_L(0); PG8_BAR; PG8_MMA(0, 0, At, B0); PG8_MMA(0, 1, At, B1); PG8_BAR; PG8_SCHED;
            PG8_LDA(At, 0, 1); PG8_STAGE(PG8_SB(0, 0), b2, voffB); PG8_STAGE(PG8_SB(0, 1), b2 + bhstep, voffB); PG8_STAGE(PG8_SA(0, 0), a2, v2[0]);
            PG8_WAIT_V(8); PG8_WAIT_L(0); PG8_BAR; PG8_MMA(1, 0, At, B0); PG8_MMA(1, 1, At, B1); PG8_BAR; PG8_SCHED;
            PG8_LDB(B0, 1, 0); PG8_LDB(B1, 1, 1); PG8_SCHED; PG8_LDA(At, 1, 0); PG8_STAGE(PG8_SA(0, 1), a2, v2[1]);
            PG8_WAIT_V(8); PG8_WAIT_L(0); PG8_BAR; PG8_MMA(0, 0, At, B0); PG8_MMA(0, 1, At, B1); PG8_BAR; PG8_SCHED;
            PG8_LDA(At, 1, 1); PG8_STAGE(PG8_SB(1, 0), b3, voffB); PG8_STAGE(PG8_SB(1, 1), b3 + bhstep, voffB); PG8_STAGE(PG8_SA(1, 0), a3, v2[0]);
            PG8_WAIT_V(8); PG8_WAIT_L(0); PG8_BAR; PG8_MMA(1, 0, At, B0); PG8_MMA(1, 1, At, B1); PG8_BAR; PG8_SCHED;
        }
        if constexpr (ALIGN_EPI) { if (wr == 0) PG8_BAR; }
        E(acc, cur, wr, wc, fr, fq);
        if (!has_next) break;
        if constexpr (Epi::HAS_INIT) E.init(acc, nxt, wr, wc, fr, fq);
        else {
#pragma unroll
        for (int a = 0; a < 2; ++a)
#pragma unroll
            for (int b = 0; b < 2; ++b)
#pragma unroll
                for (int m = 0; m < 4; ++m)
#pragma unroll
                    for (int n = 0; n < 2; ++n) acc[a][b][m][n] = (f32x4){0.f, 0.f, 0.f, 0.f};
        }
        cur = nxt; cB = nB; ++ui;
#pragma unroll
        for (int h = 0; h < 2; ++h)
#pragma unroll
            for (int i = 0; i < 2; ++i) vAc[h][i] = vAn[h][i];
        if constexpr (ALIGN_EPI) { if (wr == 1) PG8_BAR; }
    }
    PG8_WAIT_V(0);
    if constexpr (!ALIGN_EPI) { if (wr == 0) PG8_BAR; }
    PG8_BAR;
#undef PG8_SA
#undef PG8_SB
#undef PG8_STAGE
#undef PG8_LDA
#undef PG8_LDB
#undef PG8_MMA
#undef PG8_WAIT_V
#undef PG8_WAIT_L
#undef PG8_BAR
#undef PG8_SCHED
#undef PG8_VOFFA
#undef PG8_BBASE
}

struct EpiInProj {
    static constexpr int PERM = 1; static constexpr bool HAS_INIT = false;
    const float* b_in; bf16 *QB, *KB, *VT, *UB, *GB;
    __device__ __forceinline__ void operator()(const f32x4 (&acc)[2][2][4][2], const Unit& u, int wr, int wc, int fr, int fq) const {
        const int row0 = u.pm * BM + wr * 64 + fr;
#pragma unroll
        for (int bj = 0; bj < 2; ++bj) {
            const int reg = u.pn * BM + bj * HALF;
            const int c0 = reg + wc * 32 + 8 * fq;
            const f32x4 bv0 = *(const f32x4*)(b_in + c0), bv1 = *(const f32x4*)(b_in + c0 + 4);
#pragma unroll
            for (int ai = 0; ai < 2; ++ai)
#pragma unroll
                for (int m = 0; m < 4; ++m) {
                    const int row = row0 + ai * HALF + m * 16;
                    f32x4 v0 = acc[ai][bj][m][0] + bv0, v1 = acc[ai][bj][m][1] + bv1;
                    if (reg >= 640 && reg < 768) {
                        const int cv = c0 - 640, gg = cv >> 6, d = cv & 63, b = row / SEQ, s = row % SEQ;
                        bf16* vp = VT + ((size_t)((b * 2 + gg) * 64 + d)) * SEQ + s;
#pragma unroll
                        for (int j = 0; j < 4; ++j) { vp[(size_t)j * SEQ] = (bf16)f2bf(v0[j]); vp[(size_t)(j + 4) * SEQ] = (bf16)f2bf(v1[j]); }
                    } else {
                        bf16* dst;
                        if (reg < 512) { v0 = v0 * C2; v1 = v1 * C2; dst = QB + (size_t)row * 512 + c0; }
                        else if (reg < 640) { dst = KB + (size_t)row * 128 + (c0 - 512); }
                        else {
#pragma unroll
                            for (int j = 0; j < 4; ++j) { v0[j] = fast_gelu(v0[j]); v1[j] = fast_gelu(v1[j]); }
                            dst = (reg < 1280) ? (UB + (size_t)row * 512 + (c0 - 768)) : (GB + (size_t)row * 512 + (c0 - 1280));
                        }
                        u32x4 w; w.x = cvt_pk_bf16(v0[0], v0[1]); w.y = cvt_pk_bf16(v0[2], v0[3]); w.z = cvt_pk_bf16(v1[0], v1[1]); w.w = cvt_pk_bf16(v1[2], v1[3]);
                        *(u32x4*)dst = w;
                    }
                }
        }
    }
};
struct EpiOutProj {
    static constexpr int PERM = 0; static constexpr bool HAS_INIT = true;
    const float* x; const float* b_out; float* Z;
    __device__ __forceinline__ void init(f32x4 (&acc)[2][2][4][2], const Unit& u, int wr, int wc, int fr, int fq) const {
        const int col0 = u.pn * BM + wc * 32 + 4 * fq;
#pragma unroll
        for (int ai = 0; ai < 2; ++ai)
#pragma unroll
            for (int m = 0; m < 4; ++m) {
                const size_t off = (size_t)(u.pm * BM + ai * HALF + wr * 64 + m * 16 + fr) * D + col0;
#pragma unroll
                for (int bj = 0; bj < 2; ++bj)
#pragma unroll
                    for (int n = 0; n < 2; ++n) acc[ai][bj][m][n] = __builtin_nontemporal_load((const f32x4*)(x + off + bj * HALF + n * 16)) * ALPHA + *(const f32x4*)(b_out + col0 + bj * HALF + n * 16);
            }
    }
    __device__ __forceinline__ void operator()(const f32x4 (&acc)[2][2][4][2], const Unit& u, int wr, int wc, int fr, int fq) const {
        const int col0 = u.pn * BM + wc * 32 + 4 * fq;
#pragma unroll
        for (int ai = 0; ai < 2; ++ai)
#pragma unroll
            for (int m = 0; m < 4; ++m) {
                const size_t off = (size_t)(u.pm * BM + ai * HALF + wr * 64 + m * 16 + fr) * D + col0;
#pragma unroll
                for (int bj = 0; bj < 2; ++bj)
#pragma unroll
                    for (int n = 0; n < 2; ++n) *(f32x4*)(Z + off + bj * HALF + n * 16) = acc[ai][bj][m][n];
            }
    }
};
struct EpiSwiglu {
    static constexpr int PERM = 1; static constexpr bool HAS_INIT = false;
    const LAS int* tbl; const float* b_gate; const float* b_up; const float* swgu; const float* el_sa; bf16* HID;
    __device__ __forceinline__ void operator()(const f32x4 (&acc)[2][2][4][2], const Unit& u, int wr, int wc, int fr, int fq) const {
        const int e = tbl[TBL_TILE + u.pm], p0 = (u.pm - tbl[TBL_TS + e]) * BM, ce = tbl[TBL_CNT + e];
        const int fc0 = u.pn * HALF + wc * 32 + 8 * fq;
        const float* sw = swgu + e * 2048 + u.pn * 256 + wc * 32 + 8 * fq;
        float sa[2][4];
#pragma unroll
        for (int ai = 0; ai < 2; ++ai)
#pragma unroll
            for (int m = 0; m < 4; ++m) { const int ix = p0 + ai * HALF + wr * 64 + m * 16 + fr; sa[ai][m] = ix < ce ? el_sa[e * T + ix] : 0.f; }
        f32x4 gb[2], ub[2], sg[2], su[2];
#pragma unroll
        for (int n = 0; n < 2; ++n) { gb[n] = *(const f32x4*)(b_gate + e * DFF + fc0 + 4 * n); ub[n] = *(const f32x4*)(b_up + e * DFF + fc0 + 4 * n); sg[n] = *(const f32x4*)(sw + 4 * n); su[n] = *(const f32x4*)(sw + 128 + 4 * n); }
#pragma unroll
        for (int ai = 0; ai < 2; ++ai)
#pragma unroll
            for (int m = 0; m < 4; ++m) {
                const int row = u.pm * BM + ai * HALF + wr * 64 + m * 16 + fr;
                float hv[8];
                const f32x2 sa2 = (f32x2){sa[ai][m], sa[ai][m]};
#pragma unroll
                for (int n = 0; n < 2; ++n)
#pragma unroll
                    for (int jp = 0; jp < 2; ++jp) {
                        const f32x2 gi = (f32x2){(float)__float_as_int(acc[ai][0][m][n][2 * jp]), (float)__float_as_int(acc[ai][0][m][n][2 * jp + 1])};
                        const f32x2 ui = (f32x2){(float)__float_as_int(acc[ai][1][m][n][2 * jp]), (float)__float_as_int(acc[ai][1][m][n][2 * jp + 1])};
                        const f32x2 sg2 = (f32x2){sg[n][2 * jp], sg[n][2 * jp + 1]}, su2 = (f32x2){su[n][2 * jp], su[n][2 * jp + 1]};
                        const f32x2 gb2 = (f32x2){gb[n][2 * jp], gb[n][2 * jp + 1]}, ub2 = (f32x2){ub[n][2 * jp], ub[n][2 * jp + 1]};
                        const f32x2 ga = __builtin_elementwise_fma(gi * sa2, sg2, gb2), ua = __builtin_elementwise_fma(ui * sa2, su2, ub2);
                        f32x2 gt, up;
                        gt.x = fminf(ga.x, 7.0f); gt.y = fminf(ga.y, 7.0f); up.x = __builtin_amdgcn_fmed3f(ua.x, -7.0f, 7.0f); up.y = __builtin_amdgcn_fmed3f(ua.y, -7.0f, 7.0f);
                        const f32x2 ex = gt * (-1.702f * LOG2E);
                        f32x2 en; en.x = __builtin_amdgcn_exp2f(ex.x); en.y = __builtin_amdgcn_exp2f(ex.y);
                        const f32x2 den = en + 1.0f, upp = up + 1.0f;
                        f32x2 rc; rc.x = __builtin_amdgcn_rcpf(den.x); rc.y = __builtin_amdgcn_rcpf(den.y);
                        const f32x2 hh = (gt * rc) * upp;
                        hv[4 * n + 2 * jp] = hh.x; hv[4 * n + 2 * jp + 1] = hh.y;
                    }
                u32x4 w; w.x = cvt_pk_bf16(hv[0], hv[1]); w.y = cvt_pk_bf16(hv[2], hv[3]); w.z = cvt_pk_bf16(hv[4], hv[5]); w.w = cvt_pk_bf16(hv[6], hv[7]);
                *(u32x4*)(HID + (size_t)row * DFF + fc0) = w;
            }
    }
};
struct EpiDown {
    static constexpr int PERM = 2; static constexpr bool HAS_INIT = false;
    const LAS int* tbl; const float* b_down; const float* swd; const float* row_sb; const float* el_gate; unsigned char* Y;
    __device__ __forceinline__ void operator()(const f32x4 (&acc)[2][2][4][2], const Unit& u, int wr, int wc, int fr, int fq) const {
        const int e = tbl[TBL_TILE + u.pm], p0 = (u.pm - tbl[TBL_TS + e]) * BM, ce = tbl[TBL_CNT + e];
        const int c0 = u.pn * BM + wc * 64 + 16 * fq;
        f32x4 bv[2][2], sw[2][2];
#pragma unroll
        for (int bj = 0; bj < 2; ++bj)
#pragma unroll
            for (int n = 0; n < 2; ++n) { bv[bj][n] = *(const f32x4*)(b_down + e * D + c0 + 8 * bj + 4 * n); sw[bj][n] = *(const f32x4*)(swd + e * D + c0 + 8 * bj + 4 * n); }
#pragma unroll
        for (int ai = 0; ai < 2; ++ai)
#pragma unroll
            for (int m = 0; m < 4; ++m) {
                const int row = u.pm * BM + ai * HALF + wr * 64 + m * 16 + fr;
                const int ix = p0 + ai * HALF + wr * 64 + m * 16 + fr;
                const float gt = (ix < ce ? el_gate[e * T + ix] : 0.f) * YSCALE, sb = row_sb[row] * gt;
                u32x4 w;
#pragma unroll
                for (int bj = 0; bj < 2; ++bj)
#pragma unroll
                    for (int n = 0; n < 2; ++n) {
                        float v[4];
#pragma unroll
                        for (int jp = 0; jp < 2; ++jp) {
                            const f32x2 ci = (f32x2){(float)__float_as_int(acc[ai][bj][m][n][2 * jp]), (float)__float_as_int(acc[ai][bj][m][n][2 * jp + 1])};
                            const f32x2 s2 = (f32x2){sw[bj][n][2 * jp], sw[bj][n][2 * jp + 1]} * sb, b2 = (f32x2){bv[bj][n][2 * jp], bv[bj][n][2 * jp + 1]} * gt;
                            const f32x2 r = __builtin_elementwise_fma(ci, s2, b2);
                            v[2 * jp] = __builtin_amdgcn_fmed3f(r.x, -448.0f, 448.0f); v[2 * jp + 1] = __builtin_amdgcn_fmed3f(r.y, -448.0f, 448.0f);
                        }
                        int d = 0;
                        d = __builtin_amdgcn_cvt_pk_fp8_f32(v[0], v[1], d, false);
                        d = __builtin_amdgcn_cvt_pk_fp8_f32(v[2], v[3], d, true);
                        w[2 * bj + n] = (unsigned)d;
                    }
                *(u32x4*)(Y + (size_t)row * D + c0) = w;
            }
    }
};
}
constexpr int NWAVES = 8;
constexpr int NPHASES = 10;
constexpr size_t WS_WIN = WS_HID + 144 * MiB;
constexpr size_t WS_WOUT = WS_WIN + 4 * MiB;
constexpr size_t WS_WGU = WS_WOUT + 2 * MiB;
constexpr size_t WS_SWGU = WS_WGU + 64 * MiB;
constexpr size_t WS_WD = WS_SWGU + 1 * MiB;
constexpr size_t WS_SWD = WS_WD + 32 * MiB;
constexpr size_t WS_HID8 = WS_SWD + 1 * MiB;
constexpr size_t WS_END = WS_HID8 + 72 * MiB;
constexpr int CW_BAR = 4096;
constexpr int RING_BYTES = 131072;
constexpr int RTAB_OFF = RING_BYTES;
constexpr int RTAB_UNITS = 12;
constexpr int RW_BYTES = 1024 * 144;
constexpr int RSCR_OFF = RW_BYTES;
constexpr int LDS_BYTES = 163840;
constexpr int MISC_OFF = LDS_BYTES - 256;
static_assert(RTAB_OFF + RTAB_UNITS * 1024 <= MISC_OFF && RSCR_OFF + 4096 <= MISC_OFF, "LDS map");

typedef GAS unsigned gu32;
#define RLX_AGENT __ATOMIC_RELAXED, __HIP_MEMORY_SCOPE_AGENT
#define LDS_WAIT() asm volatile("s_waitcnt lgkmcnt(0)" ::: "memory")
#define VM_WAIT() asm volatile("s_waitcnt vmcnt(0)" ::: "memory")

#define XB_TMO      128
#define XB_XCNT(j)  (256  + 64 * (j))
#define XB_XSUB(j)  (1280 + 64 * (j))
#define XB_XGEN(j)  (2304 + 64 * (j))
#define XB_TOP      3328
#define XB_TOPGEN   3392
#define XCD_BAR_WORDS 3456
#define XB_SPIN_CAP (1u << 18)
__device__ __forceinline__ unsigned xb_ld(unsigned* p)              { return __hip_atomic_load(p, __ATOMIC_RELAXED, __HIP_MEMORY_SCOPE_AGENT); }
__device__ __forceinline__ unsigned xb_add(unsigned* p, unsigned v) { return __hip_atomic_fetch_add(p, v, __ATOMIC_RELAXED, __HIP_MEMORY_SCOPE_AGENT); }
__device__ __forceinline__ unsigned xb_xcc_id() { return (unsigned)__builtin_amdgcn_s_getreg((3 << 11) | 20) & 0xFu; }
#define XB_SPIN(cond, bar) do { unsigned _sp = 0; while (cond) { __builtin_amdgcn_s_sleep(1); \
    if ((++_sp & 255u) == 0u) { if (xb_ld(&(bar)[XB_TMO])) break; if (_sp > XB_SPIN_CAP) { atomicAdd(&(bar)[XB_TMO], 1u); break; } } } } while (0)
struct XcdBarrier { unsigned* bar; unsigned x; volatile LAS unsigned* st; };
__device__ __forceinline__ XcdBarrier xcd_barrier_post(unsigned* bar, volatile LAS unsigned* st) {
    XcdBarrier b; b.bar = bar; b.x = xb_xcc_id(); b.st = st;
    if (threadIdx.x == 0) (void)xb_add(&bar[XB_XCNT(b.x)], 1u);
    return b;
}
__device__ __forceinline__ void xcd_barrier_complete(unsigned* bar, unsigned x, unsigned& nloc, unsigned& nx) {
    const unsigned G = gridDim.x * gridDim.y * gridDim.z;
    unsigned sum, cnt, mine, sp = 0u;
    for (;;) {
        sum = 0u; cnt = 0u; mine = 0u;
#pragma unroll
        for (unsigned j = 0; j < 16; ++j) { const unsigned c = xb_ld(&bar[XB_XCNT(j)]); sum += c; cnt += (c > 0u) ? 1u : 0u; mine = (j == x) ? c : mine; }
        if (sum == G) break;
        __builtin_amdgcn_s_sleep(1);
        if ((++sp & 255u) == 0u) { if (xb_ld(&bar[XB_TMO])) break; if (sp > XB_SPIN_CAP) { atomicAdd(&bar[XB_TMO], 1u); break; } }
    }
    nloc = mine > 0u ? mine : 1u; nx = cnt > 0u ? cnt : 1u;
}
__device__ __forceinline__ void xcd_barrier(const XcdBarrier& b) {
    asm volatile("s_waitcnt vmcnt(0)" ::: "memory");
    __syncthreads();
    if (threadIdx.x == 0) {
        unsigned* bar = b.bar;
        __builtin_amdgcn_s_waitcnt(0);
        unsigned nloc = b.st[0], nx = b.st[1];
        if (nloc == 0u) { xcd_barrier_complete(bar, b.x, nloc, nx); b.st[0] = nloc; b.st[1] = nx; }
        const unsigned old = xb_add(&bar[XB_XSUB(b.x)], 1u);
        const unsigned gen = old / nloc;
        if (old + 1u == (gen + 1u) * nloc) {
            __builtin_amdgcn_fence(__ATOMIC_RELEASE, "agent");
            asm volatile("s_waitcnt vmcnt(0)" ::: "memory");
            const unsigned og = xb_add(&bar[XB_TOP], 1u);
            const unsigned tg = og / nx;
            if (og + 1u == (tg + 1u) * nx) xb_add(&bar[XB_TOPGEN], 1u);
            else XB_SPIN(xb_ld(&bar[XB_TOPGEN]) == tg, bar);
            __builtin_amdgcn_fence(__ATOMIC_ACQUIRE, "agent");
            xb_add(&bar[XB_XGEN(b.x)], 1u);
            asm volatile("s_waitcnt vmcnt(0)" ::: "memory");
        } else {
            XB_SPIN(xb_ld(&bar[XB_XGEN(b.x)]) == gen, bar);
            __builtin_amdgcn_fence(__ATOMIC_ACQUIRE, "agent");
            asm volatile("s_waitcnt vmcnt(0)" ::: "memory");
        }
    }
    __syncthreads();
}

struct Args {
    const float* in[22]; float* out; unsigned char* ws; int ph_lo, ph_hi, li, pad;
};
struct Frame {
    LAS unsigned char* lds;
    int tid, lane, wave, vcu, G;
};
__device__ __forceinline__ void p0_item(const float* W, int N, bf16* WT, int K, int dst_row0, int k0, int n0, LAS float* scr, int lane) {
    f32x4 v[8];
#pragma unroll
    for (int i = 0; i < 8; ++i) v[i] = *(const f32x4*)(W + (size_t)(k0 + (lane >> 3) + 8 * i) * N + n0 + 4 * (lane & 7));
#pragma unroll
    for (int i = 0; i < 8; ++i) { LAS float* s = scr + ((lane >> 3) + 8 * i) * 33 + 4 * (lane & 7); s[0] = v[i].x; s[1] = v[i].y; s[2] = v[i].z; s[3] = v[i].w; }
    LDS_WAIT(); asm volatile("" ::: "memory");
    const int c = lane & 7;
#pragma unroll
    for (int j = 0; j < 4; ++j) { const int n = (lane >> 3) + 8 * j; const LAS float* s = scr + (8 * c) * 33 + n;
        u32x4 o; o.x = pk2(s[0 * 33], s[1 * 33]); o.y = pk2(s[2 * 33], s[3 * 33]); o.z = pk2(s[4 * 33], s[5 * 33]); o.w = pk2(s[6 * 33], s[7 * 33]);
        *(u32x4*)(WT + (size_t)(dst_row0 + n) * K + k0 + 8 * c) = o; }
    LDS_WAIT(); asm volatile("" ::: "memory");
}
struct ConvItem { const float* W; signed char* dst; float* sc; int n0, dst_row0; };
__device__ __forceinline__ ConvItem conv_decode(const Args& a, int it) {
    unsigned char* ws = a.ws;
    const int nb = it & 31, e = (it >> 5) & 31, kind = it >> 10, n0 = nb * 32;
    ConvItem c;
    c.W = (kind == 0 ? a.in[14] : kind == 1 ? a.in[16] : a.in[18]) + (size_t)e * D * DFF;
    c.dst = kind < 2 ? (signed char*)(ws + WS_WGU) + (size_t)e * 2048 * 1024 : (signed char*)(ws + WS_WD) + (size_t)e * 1024 * 1024;
    c.dst_row0 = kind < 2 ? (n0 >> 7) * 256 + kind * 128 + (n0 & 127) : n0;
    c.sc = kind < 2 ? (float*)(ws + WS_SWGU) + e * 2048 : (float*)(ws + WS_SWD) + e * 1024;
    c.n0 = n0; return c;
}
#define CONV_LOAD(v, ci) do { _Pragma("unroll") for (int i_ = 0; i_ < 4; ++i_) _Pragma("unroll") for (int j_ = 0; j_ < 4; ++j_) \
        v[i_][j_] = __builtin_nontemporal_load((const f32x4*)((ci).W + (size_t)(4 * (kl + 64 * i_) + j_) * DFF + (ci).n0 + 4 * n4)); } while (0)
__device__ __forceinline__ void conv_items(const Frame& F, const Args& a, int it_lo, int it_hi) {
    if (it_hi > 3 * NEXP * 32) it_hi = 3 * NEXP * 32;
    if (it_lo >= it_hi) return;
    const int tid = F.tid, n4 = tid & 7, kl = tid >> 3;
    LAS unsigned* tile = (LAS unsigned*)F.lds;
    LAS float* red = (LAS float*)(F.lds + 36864);
    f32x4 v[4][4];
    ConvItem cur = conv_decode(a, it_lo);
    CONV_LOAD(v, cur);
    for (int it = it_lo; it < it_hi; ++it) {
        f32x4 am = (f32x4){0.f, 0.f, 0.f, 0.f};
#pragma unroll
        for (int i = 0; i < 4; ++i)
#pragma unroll
            for (int j = 0; j < 4; ++j) { am.x = fmaxf(am.x, fabsf(v[i][j].x)); am.y = fmaxf(am.y, fabsf(v[i][j].y)); am.z = fmaxf(am.z, fabsf(v[i][j].z)); am.w = fmaxf(am.w, fabsf(v[i][j].w)); }
#pragma unroll
        for (int o = 8; o < 64; o <<= 1) { am.x = fmaxf(am.x, __shfl_xor(am.x, o)); am.y = fmaxf(am.y, __shfl_xor(am.y, o)); am.z = fmaxf(am.z, __shfl_xor(am.z, o)); am.w = fmaxf(am.w, __shfl_xor(am.w, o)); }
        if (F.lane < 8) *(LAS f32x4*)(red + F.wave * 32 + 4 * n4) = am;
        __syncthreads();
        f32x4 cm = *(const LAS f32x4*)(red + 4 * n4);
#pragma unroll
        for (int w = 1; w < 8; ++w) { const f32x4 o = *(const LAS f32x4*)(red + w * 32 + 4 * n4); cm.x = fmaxf(cm.x, o.x); cm.y = fmaxf(cm.y, o.y); cm.z = fmaxf(cm.z, o.z); cm.w = fmaxf(cm.w, o.w); }
        f32x4 inv;
#pragma unroll
        for (int c = 0; c < 4; ++c) inv[c] = cm[c] > 0.f ? 127.0f / cm[c] : 0.f;
        if (kl == 0) {
#pragma unroll
            for (int c = 0; c < 4; ++c) cur.sc[cur.dst_row0 + 4 * n4 + c] = cm[c] * (1.0f / 127.0f);
        }
#pragma unroll
        for (int i = 0; i < 4; ++i)
#pragma unroll
            for (int c = 0; c < 4; ++c) {
                unsigned d = 0u;
#pragma unroll
                for (int j = 0; j < 4; ++j) { const int q = (int)rintf(v[i][j][c] * inv[c]); d |= ((unsigned)q & 0xffu) << (8 * j); }
                tile[(4 * n4 + c) * 260 + kl + 64 * i] = d;
            }
        const ConvItem done = cur;
        if (it + 1 < it_hi) { cur = conv_decode(a, it + 1); CONV_LOAD(v, cur); }
        __syncthreads();
#pragma unroll
        for (int j = 0; j < 4; ++j) { const int ch = tid + 512 * j, n = ch >> 6, c16 = ch & 63;
            *(u32x4*)(done.dst + (size_t)(done.dst_row0 + n) * 1024 + 16 * c16) = *(const LAS u32x4*)(tile + n * 260 + 4 * c16); }
        __syncthreads();
    }
}
__device__ __forceinline__ void p0_prologue(const Frame& F, const Args& a) {
    unsigned char* ws = a.ws;
    bf16* Win_t = (bf16*)(ws + WS_WIN); bf16* Wout_t = (bf16*)(ws + WS_WOUT);
    LAS float* scr = (LAS float*)(F.lds + F.wave * 8448);
    const int gw = F.vcu * NWAVES + F.wave, NGW = F.G * NWAVES;
    constexpr int I_IN = 16 * 56, I_OUT = 16 * 32, NITEMS = I_IN + I_OUT;
    for (int it = gw; it < NITEMS; it += NGW) {
        int r = it;
        if (r < I_IN) { const int kb = r / 56, nb = r % 56; p0_item(a.in[1], INW, Win_t, D, nb * 32, kb * 64, nb * 32, scr, F.lane); continue; } r -= I_IN;
        { const int kb = r / 32, nb = r % 32; p0_item(a.in[8], D, Wout_t, D, nb * 32, kb * 64, nb * 32, scr, F.lane); }
    }
    const float* x = a.in[0]; bf16* XB = (bf16*)(ws + WS_XB);
    for (int m = gw; m < T; m += NGW) {
        const f32x4* xr = (const f32x4*)(x + (size_t)m * D) + F.lane; u32x2* o = (u32x2*)(XB + (size_t)m * D) + F.lane;
        f32x4 v[4];
#pragma unroll
        for (int j = 0; j < 4; ++j) v[j] = __builtin_nontemporal_load(xr + 64 * j);
#pragma unroll
        for (int j = 0; j < 4; ++j) { u32x2 w; w.x = pk2(v[j].x, v[j].y); w.y = pk2(v[j].z, v[j].w); o[64 * j] = w; }
    }
}

__device__ __forceinline__ int crow(int r, int hi) { return (r & 3) + 8 * (r >> 2) + 4 * hi; }
constexpr int AT_KROW = 144, AT_KG = 192 * AT_KROW, AT_VROW = 400, AT_VG = 64 * AT_VROW, AT_VOFF = 2 * AT_KG;
__device__ __forceinline__ void attn_wave_unit(const LAS unsigned char* lds, const bf16x8 (&qf)[4], const float sk, bf16* CAT, int tok0, int u, int h, int lane) {
    const int r32 = lane & 31, hi = lane >> 5;
    const int t0 = tok0 % SEQ, g = h >> 2;
    const int kk0 = 32 * u;
    f32x16 p[5];
    const float NEG = -INFINITY;
    const LAS unsigned char* kl = lds + g * AT_KG + (kk0 + r32) * AT_KROW + hi * 16;
#pragma unroll
    for (int j = 0; j < 5; ++j) {
        const int kb = t0 - 128 + 32 * j;
        f32x16 s;
#pragma unroll
        for (int r = 0; r < 16; ++r) s[r] = 0.f;
        if (kb >= 0) {
#pragma unroll
            for (int d0 = 0; d0 < 4; ++d0) { const bf16x8 kf = *(const LAS bf16x8*)(kl + j * 32 * AT_KROW + d0 * 32); s = __builtin_amdgcn_mfma_f32_32x32x16_bf16(kf, qf[d0], s, 0, 0, 0); }
            if (j == 0) {
#pragma unroll
                for (int r = 0; r < 16; ++r) if (!(crow(r, hi) > r32)) s[r] = NEG;
            }
            if (j == 4) {
#pragma unroll
                for (int r = 0; r < 16; ++r) if (!(crow(r, hi) <= r32)) s[r] = NEG;
            }
        } else {
#pragma unroll
            for (int r = 0; r < 16; ++r) s[r] = NEG;
        }
        p[j] = s;
    }
    float m = sk;
#pragma unroll
    for (int j = 0; j < 5; ++j)
#pragma unroll
        for (int r = 0; r < 16; ++r) m = fmaxf(m, p[j][r]);
    m = fmaxf(m, __shfl_xor(m, 32));
    float l = 0.f;
#pragma unroll
    for (int j = 0; j < 5; ++j)
#pragma unroll
        for (int r = 0; r < 16; ++r) { const float e = __builtin_amdgcn_exp2f(p[j][r] - m); p[j][r] = e; l += e; }
    l += __shfl_xor(l, 32);
    l += __builtin_amdgcn_exp2f(sk - m);
    const float inv = 1.0f / l;
    u32x4 pb[5][2];
#pragma unroll
    for (int j = 0; j < 5; ++j)
#pragma unroll
        for (int s = 0; s < 2; ++s) { pb[j][s].x = cvt_pk_bf16(p[j][8 * s + 0], p[j][8 * s + 1]); pb[j][s].y = cvt_pk_bf16(p[j][8 * s + 2], p[j][8 * s + 3]); pb[j][s].z = cvt_pk_bf16(p[j][8 * s + 4], p[j][8 * s + 5]); pb[j][s].w = cvt_pk_bf16(p[j][8 * s + 6], p[j][8 * s + 7]); }
#pragma unroll
    for (int db = 0; db < 2; ++db) {
        f32x16 o;
#pragma unroll
        for (int r = 0; r < 16; ++r) o[r] = 0.f;
        const LAS unsigned char* vl = lds + AT_VOFF + g * AT_VG + (db * 32 + r32) * AT_VROW + (kk0 + 4 * hi) * 2;
#pragma unroll
        for (int j = 0; j < 5; ++j) {
            const int kb = t0 - 128 + 32 * j;
            if (kb >= 0) {
#pragma unroll
                for (int s = 0; s < 2; ++s) {
                    const u32x2 lo = *(const LAS u32x2*)(vl + (32 * j + 16 * s) * 2), hh = *(const LAS u32x2*)(vl + (32 * j + 16 * s + 8) * 2);
                    u32x4 av; av.x = lo.x; av.y = lo.y; av.z = hh.x; av.w = hh.y;
                    o = __builtin_amdgcn_mfma_f32_32x32x16_bf16(__builtin_bit_cast(bf16x8, av), __builtin_bit_cast(bf16x8, pb[j][s]), o, 0, 0, 0);
                }
            }
        }
        bf16* op = CAT + (size_t)(tok0 + r32) * 1024 + h * 64 + db * 32 + 4 * hi;
#pragma unroll
        for (int gq = 0; gq < 4; ++gq) { u32x2 w; w.x = cvt_pk_bf16(o[4 * gq] * inv, o[4 * gq + 1] * inv); w.y = cvt_pk_bf16(o[4 * gq + 2] * inv, o[4 * gq + 3] * inv); *(u32x2*)(op + 8 * gq) = w; }
    }
}
__device__ __forceinline__ void attn_block(const Frame& F, const bf16* QB, const bf16* KB, const bf16* VT, const float* sinks, bf16* CAT, int qq) {
    const int tokb = qq * 64, b = tokb / SEQ, tb = tokb % SEQ, kbase = tb - 128;
    u32x4 kv[6], vv[6];
    bf16x8 qf0[4], qf1[4];
    { const int r32 = F.lane & 31, hi = F.lane >> 5;
#pragma unroll
      for (int d0 = 0; d0 < 4; ++d0) { qf0[d0] = *(const bf16x8*)(QB + (size_t)(tokb + r32) * 512 + F.wave * 64 + d0 * 16 + hi * 8); qf1[d0] = *(const bf16x8*)(QB + (size_t)(tokb + 32 + r32) * 512 + F.wave * 64 + d0 * 16 + hi * 8); } }
    const float sk = sinks[F.wave] * LOG2E;
#pragma unroll
    for (int i = 0; i < 6; ++i) {
        const int c = F.tid + 512 * i, g = c / 1536, rem = c % 1536;
        { const int key = rem >> 3, ch = rem & 7, pos = kbase + key;
          kv[i] = pos >= 0 ? *(const u32x4*)(KB + (size_t)(b * SEQ + pos) * 128 + g * 64 + ch * 8) : (u32x4){0u, 0u, 0u, 0u}; }
        { const int d = rem / 24, ch = rem % 24, pos = kbase + ch * 8;
          vv[i] = pos >= 0 ? *(const u32x4*)(VT + ((size_t)((b * 2 + g) * 64 + d)) * SEQ + pos) : (u32x4){0u, 0u, 0u, 0u}; }
    }
#pragma unroll
    for (int i = 0; i < 6; ++i) {
        const int c = F.tid + 512 * i, g = c / 1536, rem = c % 1536;
        *(LAS u32x4*)(F.lds + g * AT_KG + (rem >> 3) * AT_KROW + (rem & 7) * 16) = kv[i];
        *(LAS u32x4*)(F.lds + AT_VOFF + g * AT_VG + (rem / 24) * AT_VROW + (rem % 24) * 16) = vv[i];
    }
    __syncthreads();
    attn_wave_unit(F.lds, qf0, sk, CAT, tokb, 0, F.wave, F.lane);
    attn_wave_unit(F.lds, qf1, sk, CAT, tokb + 32, 1, F.wave, F.lane);
    __syncthreads();
}
template <int CTRL> __device__ __forceinline__ float dppq(float v) { return __builtin_bit_cast(float, __builtin_amdgcn_update_dpp(0, __builtin_bit_cast(int, v), CTRL, 0xF, 0xF, true)); }
constexpr int SG_WOFF = 20480, SG_WROW = 272;
__device__ __forceinline__ void sgu_stage_w(const Frame& F, const float* w_s, int gi) {
    f32x4 w[8];
#pragma unroll
    for (int i = 0; i < 8; ++i) w[i] = *(const f32x4*)(w_s + (size_t)gi * 16384 + (size_t)(F.tid + 512 * i) * 4);
#pragma unroll
    for (int i = 0; i < 8; ++i) { const int c = F.tid + 512 * i, t = c >> 5, s0 = (c & 31) * 4;
        f32x4 v = w[i];
#pragma unroll
        for (int j = 0; j < 4; ++j) if (s0 + j > t) v[j] = 0.f;
        u32x2 o; o.x = cvt_pk_bf16(v[0], v[1]); o.y = cvt_pk_bf16(v[2], v[3]);
        *(LAS u32x2*)(F.lds + SG_WOFF + t * SG_WROW + s0 * 2) = o; }
}
__device__ __forceinline__ void sgu_unit(const Frame& F, const bf16* UB, const bf16* GB, const float* ln_g, const float* ln_b, const float* w_s, const float* b_s, bf16* CAT, int ch, int gi) {
    LAS bf16* GT = (LAS bf16*)F.lds;
    const int r32 = F.lane & 31, hi = F.lane >> 5, tb = F.wave >> 1, db = F.wave & 1, t = tb * 32 + r32;
    const int nks = 2 * (tb + 1);
    const int s = F.tid >> 2, q4 = F.tid & 3; const size_t tok = (size_t)ch * 128 + s;
    const u32x4* gp = (const u32x4*)(GB + tok * 512 + gi * 64 + q4 * 16);
    const u32x4 a = gp[0], c = gp[1];
    const size_t tokt = (size_t)ch * 128 + t;
    const bf16* up = UB + tokt * 512 + gi * 64 + db * 32 + 4 * hi;
    u32x2 uu[4];
#pragma unroll
    for (int gq = 0; gq < 4; ++gq) uu[gq] = *(const u32x2*)(up + 8 * gq);
    const float bb = b_s[gi * 128 + t];
    float lg_[16], lb_[16];
#pragma unroll
    for (int i = 0; i < 16; ++i) { lg_[i] = ln_g[gi * 64 + q4 * 16 + i]; lb_[i] = ln_b[gi * 64 + q4 * 16 + i]; }
    {
        float v[16];
        v[0] = __uint_as_float(a.x << 16); v[1] = __uint_as_float(a.x & 0xffff0000u); v[2] = __uint_as_float(a.y << 16); v[3] = __uint_as_float(a.y & 0xffff0000u);
        v[4] = __uint_as_float(a.z << 16); v[5] = __uint_as_float(a.z & 0xffff0000u); v[6] = __uint_as_float(a.w << 16); v[7] = __uint_as_float(a.w & 0xffff0000u);
        v[8] = __uint_as_float(c.x << 16); v[9] = __uint_as_float(c.x & 0xffff0000u); v[10] = __uint_as_float(c.y << 16); v[11] = __uint_as_float(c.y & 0xffff0000u);
        v[12] = __uint_as_float(c.z << 16); v[13] = __uint_as_float(c.z & 0xffff0000u); v[14] = __uint_as_float(c.w << 16); v[15] = __uint_as_float(c.w & 0xffff0000u);
        float sum = 0.f;
#pragma unroll
        for (int i = 0; i < 16; ++i) sum += v[i];
        sum += dppq<0xB1>(sum); sum += dppq<0x4E>(sum);
        const float mu = sum * (1.f / 64.f); float q = 0.f;
#pragma unroll
        for (int i = 0; i < 16; ++i) { v[i] -= mu; q += v[i] * v[i]; }
        q += dppq<0xB1>(q); q += dppq<0x4E>(q);
        const float rstd = rsqrtf(q * (1.f / 64.f) + LN_EPS);
#pragma unroll
        for (int i = 0; i < 16; ++i) { const int d = q4 * 16 + i; GT[d * 136 + s] = (bf16)f2bf(v[i] * rstd * lg_[i] + lb_[i]); }
    }
    __syncthreads();
    {
        f32x16 acc;
#pragma unroll
        for (int r = 0; r < 16; ++r) acc[r] = 0.f;
        const LAS bf16* arow = GT + (db * 32 + r32) * 136 + hi * 8;
        const LAS unsigned char* wlds = F.lds + SG_WOFF + t * SG_WROW + hi * 16;
#pragma unroll
        for (int ks = 0; ks < 8; ++ks) if (ks < nks) {
            const bf16x8 af = *(const LAS bf16x8*)(arow + ks * 16);
            const bf16x8 bw = *(const LAS bf16x8*)(wlds + ks * 32);
            acc = __builtin_amdgcn_mfma_f32_32x32x16_bf16(af, bw, acc, 0, 0, 0);
        }
        bf16* op = CAT + tokt * 1024 + 512 + gi * 64 + db * 32 + 4 * hi;
#pragma unroll
        for (int gq = 0; gq < 4; ++gq) {
            const float u0 = __uint_as_float(uu[gq].x << 16), u1 = __uint_as_float(uu[gq].x & 0xffff0000u), u2 = __uint_as_float(uu[gq].y << 16), u3 = __uint_as_float(uu[gq].y & 0xffff0000u);
            u32x2 w; w.x = cvt_pk_bf16(u0 * (acc[4 * gq] + bb), u1 * (acc[4 * gq + 1] + bb)); w.y = cvt_pk_bf16(u2 * (acc[4 * gq + 2] + bb), u3 * (acc[4 * gq + 3] + bb));
            *(u32x2*)(op + 8 * gq) = w;
        }
    }
    __syncthreads();
}
__device__ __forceinline__ void p2_mixers(const Frame& F, const Args& a) {
    unsigned char* ws = a.ws;
    const bf16 *QB = (const bf16*)(ws + WS_QB), *KB = (const bf16*)(ws + WS_KB), *VT = (const bf16*)(ws + WS_VT), *UB = (const bf16*)(ws + WS_UB), *GB = (const bf16*)(ws + WS_GB);
    bf16* CAT = (bf16*)(ws + WS_CAT);
    for (int qq = F.vcu; qq < T / 64; qq += F.G) attn_block(F, QB, KB, VT, a.in[3], CAT, qq);
    int gi_staged = -1;
    for (int u = F.vcu; u < (T / 128) * 8; u += F.G) {
        if ((u & 7) != gi_staged) { __syncthreads(); sgu_stage_w(F, a.in[6], u & 7); gi_staged = u & 7; }
        sgu_unit(F, UB, GB, a.in[4], a.in[5], a.in[6], a.in[7], CAT, u >> 3, u & 7);
    }
}

template <int CTRL> __device__ __forceinline__ float dppf(float v) { return __builtin_bit_cast(float, __builtin_amdgcn_update_dpp(0, __builtin_bit_cast(int, v), CTRL, 0xF, 0xF, true)); }
__device__ __forceinline__ float swap16_sum(float x, float y) { auto r = __builtin_amdgcn_permlane16_swap(__builtin_bit_cast(unsigned, x), __builtin_bit_cast(unsigned, y), false, false); return __builtin_bit_cast(float, r[0]) + __builtin_bit_cast(float, r[1]); }
__device__ __forceinline__ float swap32_sum(float x, float y) { auto r = __builtin_amdgcn_permlane32_swap(__builtin_bit_cast(unsigned, x), __builtin_bit_cast(unsigned, y), false, false); return __builtin_bit_cast(float, r[0]) + __builtin_bit_cast(float, r[1]); }
__device__ __forceinline__ float rdlane(float v, int l) { return __builtin_bit_cast(float, __builtin_amdgcn_readlane(__builtin_bit_cast(int, v), l)); }
__device__ __forceinline__ float xsum(float v) {
    v += dppf<0xB1>(v); v += dppf<0x4E>(v); v += dppf<0x124>(v); v += dppf<0x128>(v);
    return (rdlane(v, 0) + rdlane(v, 16)) + (rdlane(v, 32) + rdlane(v, 48));
}
__device__ __forceinline__ float xmax(float v) {
    v = fmaxf(v, dppf<0xB1>(v)); v = fmaxf(v, dppf<0x4E>(v)); v = fmaxf(v, dppf<0x124>(v)); v = fmaxf(v, dppf<0x128>(v));
    return fmaxf(fmaxf(rdlane(v, 0), rdlane(v, 16)), fmaxf(rdlane(v, 32), rdlane(v, 48)));
}
__device__ __forceinline__ void p4_router(const Frame& F, const Args& a, bool commit) {
    const float* Zin = a.out; bf16* Hout = (bf16*)(a.ws + WS_H); signed char* HB8 = (signed char*)(a.ws + WS_HB); int* meta = (int*)(a.ws + WS_META); unsigned* cnt = (unsigned*)(a.ws + WS_CTL) + CW_CNT;
    const float* ln1_g = a.in[10]; const float* ln1_b = a.in[11]; const float* w_r = a.in[12]; const float* b_r = a.in[13];
    LAS float* W = (LAS float*)F.lds;
    LAS unsigned* hist = (LAS unsigned*)(F.lds + RSCR_OFF);
    LAS unsigned* base = hist + 32;
    LAS int* tmp_e = (LAS int*)(hist + 64);
    LAS int* tmp_p = tmp_e + 256;
    LAS float* tmp_g = (LAS float*)(tmp_p + 256);
    LAS float* tmp_s = tmp_g + 256;
    int* el_tok = (int*)(a.ws + WS_ELIST); float* el_gate = (float*)(a.ws + WS_ELIST) + NEXP * T; float* el_sa = el_gate + NEXP * T;
    {
        f32x4 t[16];
#pragma unroll
        for (int k = 0; k < 16; ++k) t[k] = *(const f32x4*)(w_r + (size_t)(F.tid + 512 * k) * 4);
#pragma unroll
        for (int k = 0; k < 16; ++k) { const int i = F.tid + 512 * k, c = i >> 3, e4 = i & 7, pr = (c & ~255) + 64 * (c & 3) + ((c >> 2) & 63); *(LAS f32x4*)(W + pr * 36 + e4 * 4) = t[k]; }
    }
    const int lane = F.lane, half = lane >> 5, el = lane & 31;
    LAS float* gbl = (LAS float*)(F.lds + 151552);
    for (int i = F.tid; i < 512; i += NWAVES * 64) *(LAS f32x4*)(gbl + 4 * i) = i < 256 ? *(const f32x4*)(ln1_g + 4 * i) : *(const f32x4*)(ln1_b + 4 * (i - 256));
    for (int tb = F.vcu; tb < T / 64; tb += F.G) {
        if (F.tid < 32) hist[F.tid] = 0u;
        __syncthreads();
        float zn0[16], zn1[16];
        { const f32x4* z0 = (const f32x4*)(Zin + (size_t)(tb * 64 + 8 * F.wave) * D) + lane;
#pragma unroll
          for (int j = 0; j < 4; ++j) { const f32x4 a0 = __builtin_nontemporal_load(z0 + 64 * j), a1 = __builtin_nontemporal_load(z0 + 256 + 64 * j);
#pragma unroll
            for (int k = 0; k < 4; ++k) { zn0[4 * j + k] = a0[k]; zn1[4 * j + k] = a1[k]; } } }
        for (int pp = 0; pp < 4; ++pp) {
            const int tl0 = 8 * F.wave + 2 * pp;
            const int tok0 = tb * 64 + tl0;
            float h0[16], h1[16];
            {
                u32x2* ho0 = (u32x2*)(Hout + (size_t)tok0 * D) + lane; u32x2* ho1 = ho0 + 256;
                float s0 = 0.f, s1 = 0.f, q0 = 0.f, q1 = 0.f;
#pragma unroll
                for (int i = 0; i < 16; ++i) { h0[i] = zn0[i]; h1[i] = zn1[i]; }
                if (pp < 3) { const f32x4* zp = (const f32x4*)(Zin + (size_t)(tok0 + 2) * D) + lane;
#pragma unroll
                    for (int j = 0; j < 4; ++j) { const f32x4 a0 = __builtin_nontemporal_load(zp + 64 * j), a1 = __builtin_nontemporal_load(zp + 256 + 64 * j);
#pragma unroll
                        for (int k = 0; k < 4; ++k) { zn0[4 * j + k] = a0[k]; zn1[4 * j + k] = a1[k]; } } }
#pragma unroll
                for (int i = 0; i < 16; ++i) { s0 += h0[i]; s1 += h1[i]; q0 += h0[i] * h0[i]; q1 += h1[i] * h1[i]; }
                s0 = xsum(s0); s1 = xsum(s1); q0 = xsum(q0); q1 = xsum(q1);
                const float m0 = s0 * (1.f / D), m1 = s1 * (1.f / D);
                const float r0 = rsqrtf(fmaxf(q0 * (1.f / D) - m0 * m0, 0.f) + LN_EPS), r1 = rsqrtf(fmaxf(q1 * (1.f / D) - m1 * m1, 0.f) + LN_EPS);
                float a0 = 0.f, a1 = 0.f;
#pragma unroll
                for (int i = 0; i < 16; ++i) {
                    const float gm_ = gbl[4 * lane + 256 * (i >> 2) + (i & 3)], bt_ = gbl[1024 + 4 * lane + 256 * (i >> 2) + (i & 3)];
                    h0[i] = (h0[i] - m0) * r0 * gm_ + bt_; h1[i] = (h1[i] - m1) * r1 * gm_ + bt_;
                    a0 = fmaxf(a0, fabsf(h0[i])); a1 = fmaxf(a1, fabsf(h1[i]));
                }
                a0 = xmax(a0); a1 = xmax(a1);
                const float i0 = a0 > 0.f ? 127.0f / a0 : 0.f, i1 = a1 > 0.f ? 127.0f / a1 : 0.f;
                unsigned* hb0 = (unsigned*)(HB8 + (size_t)tok0 * D) + lane; unsigned* hb1 = hb0 + 256;
#pragma unroll
                for (int j = 0; j < 4; ++j) {
                    { u32x2 w0, w1; w0.x = cvt_pk_bf16(h0[4 * j], h0[4 * j + 1]); w0.y = cvt_pk_bf16(h0[4 * j + 2], h0[4 * j + 3]); w1.x = cvt_pk_bf16(h1[4 * j], h1[4 * j + 1]); w1.y = cvt_pk_bf16(h1[4 * j + 2], h1[4 * j + 3]); ho0[64 * j] = w0; ho1[64 * j] = w1; }
                    unsigned p0 = 0u, p1 = 0u;
#pragma unroll
                    for (int k = 0; k < 4; ++k) { p0 |= ((unsigned)(int)rintf(h0[4 * j + k] * i0) & 0xffu) << (8 * k); p1 |= ((unsigned)(int)rintf(h1[4 * j + k] * i1) & 0xffu) << (8 * k); }
                    hb0[64 * j] = p0; hb1[64 * j] = p1;
                }
                if (lane == 0) { tmp_s[tl0] = a0 * (1.0f / 127.0f); tmp_s[tl0 + 1] = a1 * (1.0f / 127.0f); }
            }
            f32x2 lp0[16], lp1[16];
#pragma unroll
            for (int e = 0; e < 16; ++e) { lp0[e] = (f32x2){0.f, 0.f}; lp1[e] = (f32x2){0.f, 0.f}; }
#pragma unroll
            for (int i = 0; i < 16; ++i) {
                const LAS f32x4* wr = (const LAS f32x4*)(W + (256 * (i >> 2) + 64 * (i & 3) + lane) * 36);
                const f32x2 hv0 = (f32x2){h0[i], h0[i]}, hv1 = (f32x2){h1[i], h1[i]};
#pragma unroll
                for (int e4 = 0; e4 < 8; ++e4) {
                    const f32x4 ww = wr[e4];
                    const f32x2 wlo = (f32x2){ww.x, ww.y}, whi = (f32x2){ww.z, ww.w};
                    lp0[2 * e4] = __builtin_elementwise_fma(hv0, wlo, lp0[2 * e4]); lp0[2 * e4 + 1] = __builtin_elementwise_fma(hv0, whi, lp0[2 * e4 + 1]);
                    lp1[2 * e4] = __builtin_elementwise_fma(hv1, wlo, lp1[2 * e4]); lp1[2 * e4 + 1] = __builtin_elementwise_fma(hv1, whi, lp1[2 * e4 + 1]);
                }
            }
            float lg0[32], lg1[32];
#pragma unroll
            for (int e = 0; e < 16; ++e) { lg0[2 * e] = lp0[e].x; lg0[2 * e + 1] = lp0[e].y; lg1[2 * e] = lp1[e].x; lg1[2 * e + 1] = lp1[e].y; }
            float v32[32];
#pragma unroll
            for (int e = 0; e < 32; ++e) { const float keep = half ? lg1[e] : lg0[e], send = half ? lg0[e] : lg1[e]; v32[e] = keep + __shfl_xor(send, 32); }
            float v16[16];
#pragma unroll
            for (int e = 0; e < 16; ++e) { const bool up = (lane & 16) != 0; const float keep = up ? v32[e + 16] : v32[e], send = up ? v32[e] : v32[e + 16]; v16[e] = keep + __shfl_xor(send, 16); }
            float v8[8];
#pragma unroll
            for (int e = 0; e < 8; ++e) { const bool up = (lane & 8) != 0; const float keep = up ? v16[e + 8] : v16[e], send = up ? v16[e] : v16[e + 8]; v8[e] = keep + dppf<0x128>(send); }
            float v4[4];
#pragma unroll
            for (int e = 0; e < 4; ++e) { const bool up = (lane & 4) != 0; const float keep = up ? v8[e + 4] : v8[e], send = up ? v8[e] : v8[e + 4]; v4[e] = keep + dppf<0x1B>(dppf<0x141>(send)); }
            float v2[2];
#pragma unroll
            for (int e = 0; e < 2; ++e) { const bool up = (lane & 2) != 0; const float keep = up ? v4[e + 2] : v4[e], send = up ? v4[e] : v4[e + 2]; v2[e] = keep + dppf<0x4E>(send); }
            float lgt;
            { const bool up = (lane & 1) != 0; const float keep = up ? v2[1] : v2[0], send = up ? v2[0] : v2[1]; lgt = keep + dppf<0xB1>(send); }
            lgt += b_r[el];
            float bv[4]; int bi[4];
            {
                float cur = lgt;
#pragma unroll
                for (int k = 0; k < 4; ++k) {
                    float mx = cur;
                    mx = fmaxf(mx, dppf<0xB1>(mx)); mx = fmaxf(mx, dppf<0x4E>(mx)); mx = fmaxf(mx, dppf<0x124>(mx)); mx = fmaxf(mx, dppf<0x128>(mx));
                    const float m0 = fmaxf(rdlane(mx, 0), rdlane(mx, 16)), m1 = fmaxf(rdlane(mx, 32), rdlane(mx, 48));
                    const float mm = half ? m1 : m0;
                    const unsigned long long mk = __ballot(cur == mm);
                    const int i0 = __builtin_ctz((unsigned)mk | 0x80000000u), i1 = __builtin_ctz((unsigned)(mk >> 32) | 0x80000000u);
                    bv[k] = mm; bi[k] = half ? i1 : i0;
                    if (el == bi[k]) cur = -INFINITY;
                }
            }
            float ex[4], es = 0.f;
#pragma unroll
            for (int k = 0; k < 4; ++k) { ex[k] = __expf(bv[k] - bv[0]); es += ex[k]; }
            if (el == 0) {
                const int tl = tl0 + half;
#pragma unroll
                for (int k = 0; k < 4; ++k) { const unsigned pl = atomicAdd((unsigned*)&hist[bi[k]], 1u); tmp_e[tl * 4 + k] = bi[k]; tmp_p[tl * 4 + k] = (int)pl; tmp_g[tl * 4 + k] = ex[k] / es; }
            }
        }
        __syncthreads();
        if (F.tid < 32) base[F.tid] = commit ? atomicAdd(&cnt[F.tid], hist[F.tid]) : 0u;
        __syncthreads();
        if (F.tid < 256) { const int i = F.tid, gi = tb * 256 + i, e = tmp_e[i];
            const int pos = (int)base[e] + tmp_p[i];
            meta[MT_SEL_E + gi] = e; meta[MT_SEL_POS + gi] = pos;
            el_tok[e * T + pos] = tb * 64 + (i >> 2); el_gate[e * T + pos] = tmp_g[i]; el_sa[e * T + pos] = tmp_s[i >> 2]; }
        __syncthreads();
    }
}
__device__ __forceinline__ void build_tables(const Frame& F, const Args& a) {
    const unsigned* cnt = (const unsigned*)(a.ws + WS_CTL) + CW_CNT;
    LAS int* tb = (LAS int*)(F.lds + RSCR_OFF);
    __syncthreads();
    if (F.tid < 32) tb[TBL_CNT + F.tid] = (int)__hip_atomic_load(cnt + F.tid, RLX_AGENT);
    __syncthreads();
    if (F.tid == 0) { int acc = 0; for (int e = 0; e < 32; ++e) { tb[TBL_TS + e] = acc; acc += (tb[TBL_CNT + e] + 255) >> 8; } tb[TBL_TS + 32] = acc; }
    __syncthreads();
    for (int t = F.tid; t < NT_MAX; t += NWAVES * 64) { int e = 0; for (int j = 1; j < 32; ++j) if (t >= tb[TBL_TS + j]) e = j; tb[TBL_TILE + t] = e; }
    __syncthreads();
}
__device__ __forceinline__ void p7_quant(const Frame& F, const Args& a) {
    const bf16* HID = (const bf16*)(a.ws + WS_HID); signed char* H8 = (signed char*)(a.ws + WS_HID8); float* row_sb = (float*)(a.ws + WS_ROWSB);
    const int nrows = __builtin_amdgcn_readfirstlane(((const LAS int*)(F.lds + RSCR_OFF))[TBL_TS + 32]) * 256;
    const int gw = F.vcu * NWAVES + F.wave, NGW = F.G * NWAVES, lane = F.lane;
    for (int r0 = gw * 4; r0 < nrows; r0 += NGW * 4) {
        u32x4 v[4][2];
#pragma unroll
        for (int i = 0; i < 4; ++i)
#pragma unroll
            for (int j = 0; j < 2; ++j) v[i][j] = __builtin_nontemporal_load((const u32x4*)(HID + (size_t)(r0 + i) * DFF + 512 * j) + lane);
#pragma unroll
        for (int i = 0; i < 4; ++i) {
            float f[16]; float am = 0.f;
#pragma unroll
            for (int j = 0; j < 2; ++j)
#pragma unroll
                for (int c = 0; c < 4; ++c) { const unsigned w = v[i][j][c]; f[8 * j + 2 * c] = __uint_as_float(w << 16); f[8 * j + 2 * c + 1] = __uint_as_float(w & 0xffff0000u); }
#pragma unroll
            for (int c = 0; c < 16; ++c) am = fmaxf(am, fabsf(f[c]));
            am = xmax(am);
            const float inv = am > 0.f ? 127.0f / am : 0.f;
#pragma unroll
            for (int j = 0; j < 2; ++j) {
                u32x2 o; o.x = 0u; o.y = 0u;
#pragma unroll
                for (int c = 0; c < 4; ++c) { o.x |= ((unsigned)(int)rintf(f[8 * j + c] * inv) & 0xffu) << (8 * c); o.y |= ((unsigned)(int)rintf(f[8 * j + 4 + c] * inv) & 0xffu) << (8 * c); }
                *((u32x2*)(H8 + (size_t)(r0 + i) * DFF + 512 * j) + lane) = o;
            }
            if (lane == 0) row_sb[r0 + i] = am * (1.0f / 127.0f);
        }
    }
}
__device__ __forceinline__ void p8_final(const Frame& F, const Args& a) {
    const bf16* Hin = (const bf16*)(a.ws + WS_H); float* HO = a.out; const unsigned char* Y = (const unsigned char*)(a.ws + WS_Y); const int* meta = (const int*)(a.ws + WS_META);
    const float* ln2_g = a.in[20]; const float* ln2_b = a.in[21]; const LAS int* tsl = (const LAS int*)(F.lds + RSCR_OFF) + TBL_TS;
    const int gw = F.vcu * NWAVES + F.wave, NGW = F.G * NWAVES, lane = F.lane;
    f32x4 g2[4], b2[4];
#pragma unroll
    for (int j = 0; j < 4; ++j) { g2[j] = *(const f32x4*)(ln2_g + 4 * lane + 256 * j); b2[j] = *(const f32x4*)(ln2_b + 4 * lane + 256 * j); }
    for (int tok = gw; tok < T; tok += NGW) {
        f32x4* hr = (f32x4*)(HO + (size_t)tok * D) + lane; const u32x2* hi_ = (const u32x2*)(Hin + (size_t)tok * D) + lane;
        f32x4 v[4]; float s = 0.f;
#pragma unroll
        for (int j = 0; j < 4; ++j) { const u32x2 hh = __builtin_nontemporal_load(hi_ + 64 * j); v[j] = (f32x4){__uint_as_float(hh.x << 16), __uint_as_float(hh.x & 0xffff0000u), __uint_as_float(hh.y << 16), __uint_as_float(hh.y & 0xffff0000u)} * ALPHA; }
#pragma unroll
        for (int k = 0; k < 4; ++k) {
            const int row = tsl[meta[MT_SEL_E + tok * 4 + k]] * 256 + meta[MT_SEL_POS + tok * 4 + k];
            const unsigned* yr = (const unsigned*)(Y + (size_t)row * D) + lane;
#pragma unroll
            for (int j = 0; j < 4; ++j) { const int y = (int)__builtin_nontemporal_load(yr + 64 * j); const f32x2 lo = __builtin_amdgcn_cvt_pk_f32_fp8(y, false), hi2 = __builtin_amdgcn_cvt_pk_f32_fp8(y, true);
                v[j].x += lo.x * (1.0f / YSCALE); v[j].y += lo.y * (1.0f / YSCALE); v[j].z += hi2.x * (1.0f / YSCALE); v[j].w += hi2.y * (1.0f / YSCALE); }
        }
#pragma unroll
        for (int j = 0; j < 4; ++j) s += (v[j].x + v[j].y) + (v[j].z + v[j].w);
        const float mean = xsum(s) * (1.f / D); float s2 = 0.f;
#pragma unroll
        for (int j = 0; j < 4; ++j) { v[j] = v[j] - mean; s2 += (v[j].x * v[j].x + v[j].y * v[j].y) + (v[j].z * v[j].z + v[j].w * v[j].w); }
        const float rstd = rsqrtf(xsum(s2) * (1.f / D) + LN_EPS);
#pragma unroll
        for (int j = 0; j < 4; ++j) hr[64 * j] = v[j] * rstd * g2[j] + b2[j];
    }
}
__global__ void __launch_bounds__(NWAVES * 64, 2) mk_fwd(Args args) {
    extern __shared__ __attribute__((aligned(16))) unsigned char lds_raw[];
    Frame F;
    F.lds = (LAS unsigned char*)lds_raw;
    F.tid = threadIdx.x; F.lane = F.tid & 63; F.wave = __builtin_amdgcn_readfirstlane(F.tid >> 6);
    F.G = gridDim.x; { const int bx = blockIdx.x; F.vcu = (F.G % 8 == 0) ? (bx % 8) * (F.G / 8) + bx / 8 : bx; }
    volatile LAS unsigned* MISC = (volatile LAS unsigned*)(F.lds + MISC_OFF);
    if (F.tid < 64) MISC[F.tid] = 0u;
    __syncthreads();
    unsigned char* ws = args.ws;
    unsigned* ctl = (unsigned*)(ws + WS_CTL);
    const int lo = args.ph_lo, hi = args.ph_hi;
    XcdBarrier bar; bar.bar = ctl + CW_BAR + args.li * XCD_BAR_WORDS; bar.x = 0; bar.st = nullptr;
    if (hi - lo > 1) bar = xcd_barrier_post(ctl + CW_BAR + args.li * XCD_BAR_WORDS, MISC + 8);
#define IN(k) (lo <= (k) && (k) < hi)
#define OPAQUE_F(Fp) Frame Fp = F; asm volatile("" : "+v"(Fp.tid)); Fp.lane = Fp.tid & 63
#define SEAM(k) do { if (IN(k) && IN((k) + 1)) xcd_barrier(bar); } while (0)
    int* meta = (int*)(ws + WS_META);
    bf16 *XB = (bf16*)(ws + WS_XB), *QB = (bf16*)(ws + WS_QB), *KB = (bf16*)(ws + WS_KB), *VT = (bf16*)(ws + WS_VT), *UB = (bf16*)(ws + WS_UB), *GB = (bf16*)(ws + WS_GB);
    bf16 *CAT = (bf16*)(ws + WS_CAT), *HB = (bf16*)(ws + WS_HB), *Y = (bf16*)(ws + WS_Y), *HID = (bf16*)(ws + WS_HID);
    bf16 *Win_t = (bf16*)(ws + WS_WIN), *Wout_t = (bf16*)(ws + WS_WOUT), *Wgu_t = (bf16*)(ws + WS_WGU), *Wd_t = (bf16*)(ws + WS_WD);
    const LAS int* rtab = (const LAS int*)(F.lds + RTAB_OFF);
    const bool par = ((blockIdx.x >> 3) & 1) != 0;

    if (IN(0)) { OPAQUE_F(Fp); p0_prologue(Fp, args); SEAM(0); }
    if (IN(1)) {
        const int c = (int)blockIdx.x, grp = (c >> 3) % 3;
        const int per_ = (3 * NEXP * 32 + F.G - 1) / F.G;
        const int it_lo = F.G == 256 ? (c < 192 ? c * 10 : 1920 + (c - 192) * 18) : c * per_, it_hi = F.G == 256 ? it_lo + (c < 192 ? 10 : 18) : it_lo + per_;
        OPAQUE_F(Fp);
        if (grp == 0) conv_items(Fp, args, it_lo, it_hi);
        { pg8::Gemm g{XB, Win_t, 2 * D, nullptr, 0u}; pg8::StaticOrder S; S.init(T / 256, INW / 256, F.G, c); S.i1 = 1;
          pg8::EpiInProj E{args.in[2], QB, KB, VT, UB, GB};
          pg8::gemm_phase<pg8::EpiInProj, false, true, false>(F.lds, rtab, g, S, E); }
        if (grp == 1) conv_items(Fp, args, it_lo, it_hi);
        { pg8::Gemm g{XB, Win_t, 2 * D, nullptr, 0u}; pg8::StaticOrder S; S.init(T / 256, INW / 256, F.G, c); S.i0 = 1;
          pg8::EpiInProj E{args.in[2], QB, KB, VT, UB, GB};
          pg8::gemm_phase<pg8::EpiInProj, false, true, false>(F.lds, rtab, g, S, E); }
        if (grp == 2) conv_items(Fp, args, it_lo, it_hi);
        SEAM(1);
    }
    if (IN(2)) { OPAQUE_F(Fp); p2_mixers(Fp, args); SEAM(2); }
    if (IN(3)) {
        pg8::Gemm g{CAT, Wout_t, 2 * D, nullptr, 0u}; pg8::StaticOrder S; S.init(T / 256, D / 256, F.G, (int)blockIdx.x);
        pg8::EpiOutProj E{args.in[0], args.in[9], args.out};
        pg8::gemm_phase<pg8::EpiOutProj, false, false, false>(F.lds, rtab, g, S, E);
        SEAM(3);
    }
    if (IN(4)) { OPAQUE_F(Fp); p4_router(Fp, args, true); if (hi > 5) xcd_barrier(bar); }
    const LAS int* tbl = (const LAS int*)(F.lds + RSCR_OFF);
    if (hi > 5) { OPAQUE_F(Fp); build_tables(Fp, args); }
    if (IN(6)) {
        const int nT = __builtin_amdgcn_readfirstlane(tbl[TBL_TS + 32]);
        pg8::StaticOrder S; S.init(nT, 2 * DFF / 256, F.G, (int)blockIdx.x);
        { pg8::Unit u; LAS int* rt = (LAS int*)(F.lds + RTAB_OFF); const int* el_tok = (const int*)(ws + WS_ELIST);
          for (int i = 0; i < RTAB_UNITS && S.next(i, u); ++i) if (F.tid < 256) { const int e = tbl[TBL_TILE + u.pm], ix = (u.pm - tbl[TBL_TS + e]) * 256 + F.tid; rt[i * 256 + F.tid] = ix < tbl[TBL_CNT + e] ? el_tok[e * T + ix] : 0; }
          __syncthreads(); }
        pg8::Gemm g{HB, Wgu_t, D, tbl + TBL_TILE, 2048u * 1024u};
        pg8::EpiSwiglu E{tbl, args.in[15], args.in[17], (const float*)(ws + WS_SWGU), (const float*)(ws + WS_ELIST) + 2 * NEXP * T, HID};
        pg8::gemm_phase<pg8::EpiSwiglu, true, true, true>(F.lds, rtab, g, S, E);
        SEAM(6);
    }
    if (IN(7)) { OPAQUE_F(Fp); p7_quant(Fp, args); SEAM(7); }
    if (IN(8)) {
        const int nT = __builtin_amdgcn_readfirstlane(tbl[TBL_TS + 32]);
        pg8::StaticOrder S; S.init(nT, D / 256, F.G, (int)blockIdx.x);
        pg8::Gemm g{ws + WS_HID8, Wd_t, DFF, tbl + TBL_TILE, 1024u * 1024u};
        pg8::EpiDown E{tbl, args.in[19], (const float*)(ws + WS_SWD), (const float*)(ws + WS_ROWSB), (const float*)(ws + WS_ELIST) + NEXP * T, (unsigned char*)Y};
        pg8::gemm_phase<pg8::EpiDown, false, true, true>(F.lds, rtab, g, S, E);
        SEAM(8);
    }
    if (IN(9)) { OPAQUE_F(Fp); p8_final(Fp, args); }
#undef IN
#undef SEAM
}

extern "C" void kernel_launch(void* const* d_in, const int* in_sizes, int n_in, void* d_out, int out_size, void* d_ws, size_t ws_size, hipStream_t stream) {
    static int grid = 0;
    if (grid == 0) {
        if (n_in != 22 || in_sizes[0] != T * D || out_size != T * D || ws_size < WS_END) { fprintf(stderr, "kernel_launch: unexpected shapes (n_in %d, in0 %d, out %d, ws %zu, need %zu)\n", n_in, n_in > 0 ? in_sizes[0] : -1, out_size, ws_size, (size_t)WS_END); grid = -1; return; }
        int dev = 0, cus = 0;
        if (hipGetDevice(&dev) != hipSuccess || hipDeviceGetAttribute(&cus, hipDeviceAttributeMultiprocessorCount, dev) != hipSuccess) { grid = -1; return; }
        if (hipFuncSetAttribute((const void*)mk_fwd, hipFuncAttributeMaxDynamicSharedMemorySize, LDS_BYTES) != hipSuccess) { fprintf(stderr, "kernel_launch: hipFuncSetAttribute failed\n"); grid = -1; return; }
        int per_cu = 0;
        if (hipOccupancyMaxActiveBlocksPerMultiprocessor(&per_cu, (const void*)mk_fwd, NWAVES * 64, LDS_BYTES) != hipSuccess || per_cu < 1) fprintf(stderr, "kernel_launch: occupancy query reports %d\n", per_cu);
        (void)hipGetLastError();
        grid = cus;
    }
    if (grid < 0) return;
    unsigned char* ws = (unsigned char*)d_ws; float* out = (float*)d_out;
    (void)hipMemsetAsync(ws + WS_CTL, 0, 64 * 1024, stream);
    Args a{};
    for (int i = 0; i < 22; ++i) a.in[i] = (const float*)d_in[i];
    a.out = out; a.ws = ws;
    a.ph_lo = 0; a.ph_hi = NPHASES; a.li = 0;
    hipLaunchKernelGGL(mk_fwd, dim3(grid), dim3(NWAVES * 64), LDS_BYTES, stream, a);
}
```

```cpp
#include <hip/hip_runtime.h>
#include <cstdio>
#include <cstdint>

typedef unsigned short bf16;
typedef float f32x4 __attribute__((ext_vector_type(4)));
typedef unsigned u32x4 __attribute__((ext_vector_type(4)));
typedef unsigned u32x2 __attribute__((ext_vector_type(2)));

constexpr int BATCH = 2, SEQ = 8192, D = 1024, T = BATCH * SEQ;
constexpr int NQH = 8, NKVH = 2, HD = 64, QREP = 4, AW = 512, KVW = 128, GW = 512, INW = 1792;
constexpr int NEXP = 32, TOPK = 4, DFF = 1024;
constexpr int NT_MAX = T * TOPK / 256 + NEXP;
constexpr int NROWS_MAX = NT_MAX * 256;
constexpr float LN_EPS = 1e-5f;
constexpr float ALPHA = 1.189207115002721f;
constexpr float C2 = 0.125f * 1.4426950408889634f;
constexpr float LOG2E = 1.4426950408889634f;
constexpr float YSCALE = 16.0f;

constexpr size_t MiB = 1u << 20;
constexpr size_t WS_CTL = 0;
constexpr size_t WS_META = 1 * MiB;
constexpr size_t WS_XB = 3 * MiB;
constexpr size_t WS_QB = WS_XB + 32 * MiB;
constexpr size_t WS_KB = WS_QB + 16 * MiB;
constexpr size_t WS_VT = WS_KB + 4 * MiB;
constexpr size_t WS_UB = WS_VT + 4 * MiB;
constexpr size_t WS_GB = WS_UB + 16 * MiB;
constexpr size_t WS_CAT = WS_GB + 16 * MiB;
constexpr size_t WS_HB = WS_CAT + 32 * MiB;
constexpr size_t WS_H = WS_XB;
constexpr size_t WS_HID = WS_HB + 32 * MiB;
constexpr size_t WS_Y = WS_HID;
static_assert(WS_H + 64 * MiB <= WS_CAT, "H overlay");

constexpr int CW_CNT = 64;
constexpr int MT_NT = 0;
constexpr int MT_TSTART = 16;
constexpr int MT_TILE_E = 64;
constexpr int MT_SEL_E = 1024;
constexpr int MT_SEL_POS = MT_SEL_E + T * 4;
constexpr int MT_SEL_G = MT_SEL_POS + T * 4;
constexpr int MT_SLOT_ROW = MT_SEL_G + T * 4;
constexpr int MT_ROW_TOK = MT_SLOT_ROW + T * 4;
constexpr int MT_ROW_GATE = MT_ROW_TOK + NROWS_MAX;
constexpr int MT_ROW_SA = MT_ROW_GATE + NROWS_MAX;
constexpr int MT_SH = MT_ROW_SA + NROWS_MAX;
constexpr size_t WS_ELIST = WS_GB;
constexpr int TBL_CNT = 0, TBL_TS = 32, TBL_TILE = 72;
constexpr size_t WS_ROWSB = 512 * 1024;
static_assert((size_t)(MT_SH + T) * 4 <= 2 * MiB, "meta");

__device__ __forceinline__ float bf2f(bf16 v) { return __uint_as_float((unsigned)v << 16); }
__device__ __forceinline__ unsigned f2bf(float f) { unsigned u = __float_as_uint(f); return (u + 0x7fffu + ((u >> 16) & 1u)) >> 16; }
__device__ __forceinline__ unsigned pk2(float lo, float hi) { return f2bf(lo) | (f2bf(hi) << 16); }
__device__ __forceinline__ float gelu_tanh(float x) {
    const float k2 = 2.0f * 0.7978845608028654f;
    const float u = k2 * (x + 0.044715f * x * x * x);
    return x / (1.0f + __expf(-u));
}
__device__ __forceinline__ float wave_sum(float v) {
#pragma unroll
    for (int o = 1; o < 64; o <<= 1) v += __shfl_xor(v, o);
    return v;
}
__device__ __forceinline__ float wave_max(float v) {
#pragma unroll
    for (int o = 1; o < 64; o <<= 1) v = fmaxf(v, __shfl_xor(v, o));
    return v;
}

#define LAS __attribute__((address_space(3)))
#define GAS __attribute__((address_space(1)))
typedef short bf16x8 __attribute__((ext_vector_type(8)));
typedef float f32x16 __attribute__((ext_vector_type(16)));
typedef float f32x2 __attribute__((ext_vector_type(2)));
__device__ __forceinline__ unsigned cvt_pk_bf16(float lo, float hi) { unsigned r; asm volatile("v_cvt_pk_bf16_f32 %0, %1, %2" : "=v"(r) : "v"(lo), "v"(hi)); return r; }
__device__ __forceinline__ float fast_gelu(float x) {
    const float u = -2.0f * 0.7978845608028654f * LOG2E * (x + 0.044715f * x * x * x);
    return x * __builtin_amdgcn_rcpf(1.0f + __builtin_amdgcn_exp2f(u));
}
__device__ __forceinline__ void st16_wt(void* p, u32x4 v) {
    *(u32x4*)p = v;
}
namespace pg8 {
constexpr int BM = 256, BK = 64, HALF = 128, HTB = HALF * BK * 2  , STAGE_BYTES = 8 * HTB, NXCD = 8, WGM = 8;
__host__ __device__ __forceinline__ int lds_byte(int r, int c) { const int st = (r >> 4) * 2 + (c >> 5), rr = r & 15, cc = c & 31, ob = rr * 64 + cc * 2; return st * 1024 + (ob ^ (((ob >> 9) & 1) << 5)); }
__host__ __device__ __forceinline__ void stage_rc(int b, int& R, int& C) { const int st = b / 1024, sb = b % 1024, swz = sb ^ (((sb >> 9) & 1) << 5); R = (st >> 1) * 16 + swz / 64; C = (st & 1) * 32 + (swz % 64) / 2; }
__host__ __device__ __forceinline__ int perm32(int rho) { const int n = rho >> 4, i = rho & 15; return 8 * (i >> 2) + 4 * n + (i & 3); }

struct Unit { int pm, pn; };
struct Gemm { const void* A; const void* Bt; int KB; const LAS int* tile_e; unsigned e_stride; };
typedef int i32x4 __attribute__((ext_vector_type(4)));

struct StaticOrder {
    int nM, nN, nwg, G, c, i0 = 0, i1 = 1 << 30;
    __device__ void init(int nM_, int nN_, int G_, int c_) { nM = nM_; nN = nN_; nwg = nM * nN; G = G_; c = c_; }
    __device__ bool next(int i, Unit& u) const {
        i += i0; if (i >= i1) return false;
        const long L = (long)i * G + c; if (L >= nwg) return false;
        int wgid = (int)L; { const int q = nwg / NXCD, r = nwg % NXCD, xcd = wgid % NXCD, off = wgid / NXCD; wgid = (xcd < r ? xcd * (q + 1) : r * (q + 1) + (xcd - r) * q) + off; }
        const int nig = WGM * nN, gid = wgid / nig, fm = gid * WGM, gsz = (nM - fm) < WGM ? (nM - fm) : WGM;
        u.pm = fm + ((wgid % nig) % gsz); u.pn = (wgid % nig) / gsz; return true;
    }
};

template <class Epi, bool GATHER, bool ALIGN_EPI, bool I8>
__device__ __forceinline__ void gemm_phase(LAS unsigned char* lds, const LAS int* rtab, const Gemm g, const StaticOrder& S, const Epi& E) {
    int tid_ = threadIdx.x; asm volatile("" : "+v"(tid_));
    const int tid = tid_, wid = __builtin_amdgcn_readfirstlane(tid >> 6), lane = tid & 63, wr = wid >> 2, wc = wid & 3, fr = lane & 15, fq = lane >> 4;
    const int KB = g.KB, nt = KB / (BK * 2);
    int Rs[2], Cs[2]; unsigned voffB[2];
#pragma unroll
    for (int i = 0; i < 2; ++i) { int R, C; stage_rc(tid * 16 + i * 8192, R, C); const int Rb = Epi::PERM == 2 ? (64 * (R >> 5) + 16 * ((R >> 2) & 3) + 4 * ((R >> 4) & 1) + (R & 3)) : Epi::PERM ? ((R & ~31) + perm32(R & 31)) : R; Rs[i] = R; Cs[i] = C; voffB[i] = (unsigned)(Rb * KB + C * 2); }
    const size_t kstep = (size_t)(BK * 2);
    const size_t hstep = (size_t)HALF * KB;
    const size_t tstep = 2 * hstep;
    const size_t bhstep = Epi::PERM == 2 ? (size_t)8 * KB : hstep;
    const unsigned ldsw = (unsigned)wid * 1024u;
    const int aoff = lds_byte(wr * 64 + fr, fq * 8), boff = lds_byte(wc * 32 + fr, fq * 8);
#define PG8_SA(b, h) (((b) * 2 + (h)) * HTB)
#define PG8_SB(b, h) ((4 + (b) * 2 + (h)) * HTB)
#define PG8_STAGE(bufoff, gbase, voff) do { _Pragma("unroll") for (int _i = 0; _i < 2; ++_i) \
        __builtin_amdgcn_global_load_lds((const unsigned*)((const char*)(gbase) + (voff)[_i]), (LAS unsigned*)(lds + (bufoff) + ldsw + _i * 8192), 16, 0, 0); } while (0)
#define PG8_LDA(dst, b, h) do { _Pragma("unroll") for (int m = 0; m < 4; ++m) _Pragma("unroll") for (int k = 0; k < 2; ++k) dst[m][k] = *(const LAS bf16x8*)(lds + PG8_SA(b, h) + aoff + m * 2048 + k * 1024); } while (0)
#define PG8_LDB(dst, b, h) do { _Pragma("unroll") for (int n = 0; n < 2; ++n) _Pragma("unroll") for (int k = 0; k < 2; ++k) dst[n][k] = *(const LAS bf16x8*)(lds + PG8_SB(b, h) + boff + n * 2048 + k * 1024); } while (0)
#define PG8_MMA(ai, bj, At, Bt) do { __builtin_amdgcn_s_setprio(1); _Pragma("unroll") for (int m = 0; m < 4; ++m) _Pragma("unroll") for (int n = 0; n < 2; ++n) _Pragma("unroll") for (int k = 0; k < 2; ++k) \
        { if constexpr (I8) acc[ai][bj][m][n] = __builtin_bit_cast(f32x4, __builtin_amdgcn_mfma_i32_16x16x64_i8(__builtin_bit_cast(i32x4, Bt[n][k]), __builtin_bit_cast(i32x4, At[m][k]), __builtin_bit_cast(i32x4, acc[ai][bj][m][n]), 0, 0, 0)); \
          else acc[ai][bj][m][n] = __builtin_amdgcn_mfma_f32_16x16x32_bf16(Bt[n][k], At[m][k], acc[ai][bj][m][n], 0, 0, 0); } __builtin_amdgcn_s_setprio(0); } while (0)
#define PG8_WAIT_V(n) asm volatile("s_waitcnt vmcnt(" #n ")" ::: "memory")
#define PG8_WAIT_L(n) asm volatile("s_waitcnt lgkmcnt(" #n ")" ::: "memory")
#define PG8_BAR __builtin_amdgcn_s_barrier()
#define PG8_SCHED __builtin_amdgcn_sched_barrier(0)
#define PG8_VOFFA(vo, ui_, u_) do { _Pragma("unroll") for (int h_ = 0; h_ < 2; ++h_) _Pragma("unroll") for (int i_ = 0; i_ < 2; ++i_) { \
        const int row_ = GATHER ? rtab[(ui_) * 256 + h_ * 128 + Rs[i_]] : ((u_).pm * 256 + h_ * 128 + Rs[i_]); \
        vo[h_][i_] = (unsigned)(row_ * KB + Cs[i_] * 2); } } while (0)
#define PG8_BBASE(u_) ((const char*)g.Bt + (g.tile_e ? (size_t)g.tile_e[(u_).pm] * g.e_stride : (size_t)0) + (size_t)(u_).pn * tstep)
    Unit cur, nxt; int ui = 0;
    if (!S.next(0, cur)) return;
    f32x4 acc[2][2][4][2];
    if constexpr (Epi::HAS_INIT) E.init(acc, cur, wr, wc, fr, fq);
    else {
#pragma unroll
    for (int a = 0; a < 2; ++a)
#pragma unroll
        for (int b = 0; b < 2; ++b)
#pragma unroll
            for (int m = 0; m < 4; ++m)
#pragma unroll
                for (int n = 0; n < 2; ++n) acc[a][b][m][n] = (f32x4){0.f, 0.f, 0.f, 0.f};
    }
    bf16x8 At[4][2], B0[2][2], B1[2][2];
    unsigned vAc[2][2], vAn[2][2];
    PG8_VOFFA(vAc, 0, cur);
    const char* const gA = (const char*)g.A;
    const char* cB = PG8_BBASE(cur);
    PG8_STAGE(PG8_SB(0, 0), cB, voffB); PG8_STAGE(PG8_SB(0, 1), cB + bhstep, voffB); PG8_STAGE(PG8_SA(0, 0), gA, vAc[0]); PG8_STAGE(PG8_SA(0, 1), gA, vAc[1]);
    if (wr == 1) PG8_BAR;
    PG8_WAIT_V(2); PG8_BAR;
    PG8_STAGE(PG8_SB(1, 0), cB + kstep, voffB); PG8_STAGE(PG8_SA(1, 0), gA + kstep, vAc[0]); PG8_STAGE(PG8_SB(1, 1), cB + bhstep + kstep, voffB);
    PG8_WAIT_V(6); PG8_BAR;
    for (;;) {
        const bool has_next = S.next(ui + 1, nxt);
        const char* nB = cB;
        if (has_next) { nB = PG8_BBASE(nxt); PG8_VOFFA(vAn, ui + 1, nxt); }
        else {
#pragma unroll
            for (int h = 0; h < 2; ++h)
#pragma unroll
                for (int i = 0; i < 2; ++i) vAn[h][i] = vAc[h][i];
        }
        for (int t = 0; t < nt; t += 2) {
            const bool last = (t == nt - 2);
            const char* a1 = gA + (size_t)(t + 1) * kstep;
            const char* a2 = last ? gA : gA + (size_t)(t + 2) * kstep; const char* b2 = last ? nB : cB + (size_t)(t + 2) * kstep;
            const char* a3 = a2 + kstep; const char* b3 = b2 + kstep;
            unsigned v2[2][2];
#pragma unroll
            for (int h = 0; h < 2; ++h)
#pragma unroll
                for (int i = 0; i < 2; ++i) v2[h][i] = last ? vAn[h][i] : vAc[h][i];
            PG8_LDB(B0, 0, 0); PG8_LDB(B1, 0, 1); PG8_SCHED; PG8_LDA(At, 0, 0); PG8_STAGE(PG8_SA(1, 1), a1, vAc[1]);
            PG8_WAIT_V(8); PG8_WAIT_L(0); PG8_BAR; PG8_MMA(0, 0, At, B0); PG8_MMA(0, 1, At, B1); PG8_BAR; PG8_SCHED;
            PG8_LDA(At, 0, 1); PG8_STAGE(PG8_SB(0, 0), b2, voffB); PG8_STAGE(PG8_SB(0, 1), b2 + bhstep, voffB); PG8_STAGE(PG8_SA(0, 0), a2, v2[0]);
            PG8_WAIT_V(8); PG8_WAIT_L(0); PG8_BAR; PG8_MMA(1, 0, At, B0); PG8_MMA(1, 1, At, B1); PG8_BAR; PG8_SCHED;
            PG8_LDB(B0, 1, 0); PG8_LDB(B1, 1, 1); PG8_SCHED; PG8_LDA(At, 1, 0); PG8_STAGE(PG8_SA(0, 1), a2, v2[1]);
            PG8_WAIT_V(8); PG8_WAIT_L(0); PG8_BAR; PG8_MMA(0, 0, At, B0); PG8_MMA(0, 1, At, B1); PG8_BAR; PG8_SCHED;
            PG8_LDA(At, 1, 1); PG8_STAGE(PG8_SB(1, 0), b3, voffB); PG8_STAGE(PG8_SB(1, 1), b3 + bhstep, voffB); PG8_STAGE(PG8_SA(1, 0), a3, v2[0]);
            PG8_WAIT_V(8); PG8_WAIT_L(0); PG8_BAR; PG8_MMA(1, 0, At, B0); PG8_MMA(1, 1, At, B1); PG8_BAR; PG8_SCHED;
        }
        if constexpr (ALIGN_EPI) { if (wr == 0) PG8_BAR; }
        E(acc, cur, wr, wc, fr, fq);
        if (!has_next) break;
        if constexpr (Epi::HAS_INIT) E.init(acc, nxt, wr, wc, fr, fq);
        else {
#pragma unroll
        for (int a = 0; a < 2; ++a)
#pragma unroll
            for (int b = 0; b < 2; ++b)
#pragma unroll
                for (int m = 0; m < 4; ++m)
#pragma unroll
                    for (int n = 0; n < 2; ++n) acc[a][b][m][n] = (f32x4){0.f, 0.f, 0.f, 0.f};
        }
        cur = nxt; cB = nB; ++ui;
#pragma unroll
        for (int h = 0; h < 2; ++h)
#pragma unroll
            for (int i = 0; i < 2; ++i) vAc[h][i] = vAn[h][i];
        if constexpr (ALIGN_EPI) { if (wr == 1) PG8_BAR; }
    }
    PG8_WAIT_V(0);
    if constexpr (!ALIGN_EPI) { if (wr == 0) PG8_BAR; }
    PG8_BAR;
#undef PG8_SA
#undef PG8_SB
#undef PG8_STAGE
#undef PG8_LDA
#undef PG8_LDB
#undef PG8_MMA
#undef PG8_WAIT_V
#undef PG8_WAIT_L
#undef PG8_BAR
#undef PG8_SCHED
#undef PG8_VOFFA
#undef PG8_BBASE
}

struct EpiInProj {
    static constexpr int PERM = 1; static constexpr bool HAS_INIT = false;
    const float* b_in; bf16 *QB, *KB, *VT, *UB, *GB;
    __device__ __forceinline__ void operator()(const f32x4 (&acc)[2][2][4][2], const Unit& u, int wr, int wc, int fr, int fq) const {
        const int row0 = u.pm * BM + wr * 64 + fr;
#pragma unroll
        for (int bj = 0; bj < 2; ++bj) {
            const int reg = u.pn * BM + bj * HALF;
            const int c0 = reg + wc * 32 + 8 * fq;
            const f32x4 bv0 = *(const f32x4*)(b_in + c0), bv1 = *(const f32x4*)(b_in + c0 + 4);
#pragma unroll
            for (int ai = 0; ai < 2; ++ai)
#pragma unroll
                for (int m = 0; m < 4; ++m) {
                    const int row = row0 + ai * HALF + m * 16;
                    f32x4 v0 = acc[ai][bj][m][0] + bv0, v1 = acc[ai][bj][m][1] + bv1;
                    if (reg >= 640 && reg < 768) {
                        const int cv = c0 - 640, gg = cv >> 6, d = cv & 63, b = row / SEQ, s = row % SEQ;
                        bf16* vp = VT + ((size_t)((b * 2 + gg) * 64 + d)) * SEQ + s;
#pragma unroll
                        for (int j = 0; j < 4; ++j) { vp[(size_t)j * SEQ] = (bf16)f2bf(v0[j]); vp[(size_t)(j + 4) * SEQ] = (bf16)f2bf(v1[j]); }
                    } else {
                        bf16* dst;
                        if (reg < 512) { v0 = v0 * C2; v1 = v1 * C2; dst = QB + (size_t)row * 512 + c0; }
                        else if (reg < 640) { dst = KB + (size_t)row * 128 + (c0 - 512); }
                        else {
#pragma unroll
                            for (int j = 0; j < 4; ++j) { v0[j] = fast_gelu(v0[j]); v1[j] = fast_gelu(v1[j]); }
                            dst = (reg < 1280) ? (UB + (size_t)row * 512 + (c0 - 768)) : (GB + (size_t)row * 512 + (c0 - 1280));
                        }
                        u32x4 w; w.x = cvt_pk_bf16(v0[0], v0[1]); w.y = cvt_pk_bf16(v0[2], v0[3]); w.z = cvt_pk_bf16(v1[0], v1[1]); w.w = cvt_pk_bf16(v1[2], v1[3]);
                        *(u32x4*)dst = w;
                    }
                }
        }
    }
};
struct EpiOutProj {
    static constexpr int PERM = 0; static constexpr bool HAS_INIT = true;
    const float* x; const float* b_out; float* Z;
    __device__ __forceinline__ void init(f32x4 (&acc)[2][2][4][2], const Unit& u, int wr, int wc, int fr, int fq) const {
        const int col0 = u.pn * BM + wc * 32 + 4 * fq;
#pragma unroll
        for (int ai = 0; ai < 2; ++ai)
#pragma unroll
            for (int m = 0; m < 4; ++m) {
                const size_t off = (size_t)(u.pm * BM + ai * HALF + wr * 64 + m * 16 + fr) * D + col0;
#pragma unroll
                for (int bj = 0; bj < 2; ++bj)
#pragma unroll
                    for (int n = 0; n < 2; ++n) acc[ai][bj][m][n] = __builtin_nontemporal_load((const f32x4*)(x + off + bj * HALF + n * 16)) * ALPHA + *(const f32x4*)(b_out + col0 + bj * HALF + n * 16);
            }
    }
    __device__ __forceinline__ void operator()(const f32x4 (&acc)[2][2][4][2], const Unit& u, int wr, int wc, int fr, int fq) const {
        const int col0 = u.pn * BM + wc * 32 + 4 * fq;
#pragma unroll
        for (int ai = 0; ai < 2; ++ai)
#pragma unroll
            for (int m = 0; m < 4; ++m) {
                const size_t off = (size_t)(u.pm * BM + ai * HALF + wr * 64 + m * 16 + fr) * D + col0;
#pragma unroll
                for (int bj = 0; bj < 2; ++bj)
#pragma unroll
                    for (int n = 0; n < 2; ++n) *(f32x4*)(Z + off + bj * HALF + n * 16) = acc[ai][bj][m][n];
            }
    }
};
struct EpiSwiglu {
    static constexpr int PERM = 1; static constexpr bool HAS_INIT = false;
    const LAS int* tbl; const float* b_gate; const float* b_up; const float* swgu; const float* el_sa; bf16* HID;
    __device__ __forceinline__ void operator()(const f32x4 (&acc)[2][2][4][2], const Unit& u, int wr, int wc, int fr, int fq) const {
        const int e = tbl[TBL_TILE + u.pm], p0 = (u.pm - tbl[TBL_TS + e]) * BM, ce = tbl[TBL_CNT + e];
        const int fc0 = u.pn * HALF + wc * 32 + 8 * fq;
        const float* sw = swgu + e * 2048 + u.pn * 256 + wc * 32 + 8 * fq;
        float sa[2][4];
#pragma unroll
        for (int ai = 0; ai < 2; ++ai)
#pragma unroll
            for (int m = 0; m < 4; ++m) { const int ix = p0 + ai * HALF + wr * 64 + m * 16 + fr; sa[ai][m] = ix < ce ? el_sa[e * T + ix] : 0.f; }
        f32x4 gb[2], ub[2], sg[2], su[2];
#pragma unroll
        for (int n = 0; n < 2; ++n) { gb[n] = *(const f32x4*)(b_gate + e * DFF + fc0 + 4 * n); ub[n] = *(const f32x4*)(b_up + e * DFF + fc0 + 4 * n); sg[n] = *(const f32x4*)(sw + 4 * n); su[n] = *(const f32x4*)(sw + 128 + 4 * n); }
#pragma unroll
        for (int ai = 0; ai < 2; ++ai)
#pragma unroll
            for (int m = 0; m < 4; ++m) {
                const int row = u.pm * BM + ai * HALF + wr * 64 + m * 16 + fr;
                float hv[8];
                const f32x2 sa2 = (f32x2){sa[ai][m], sa[ai][m]};
#pragma unroll
                for (int n = 0; n < 2; ++n)
#pragma unroll
                    for (int jp = 0; jp < 2; ++jp) {
                        const f32x2 gi = (f32x2){(float)__float_as_int(acc[ai][0][m][n][2 * jp]), (float)__float_as_int(acc[ai][0][m][n][2 * jp + 1])};
                        const f32x2 ui = (f32x2){(float)__float_as_int(acc[ai][1][m][n][2 * jp]), (float)__float_as_int(acc[ai][1][m][n][2 * jp + 1])};
                        const f32x2 sg2 = (f32x2){sg[n][2 * jp], sg[n][2 * jp + 1]}, su2 = (f32x2){su[n][2 * jp], su[n][2 * jp + 1]};
                        const f32x2 gb2 = (f32x2){gb[n][2 * jp], gb[n][2 * jp + 1]}, ub2 = (f32x2){ub[n][2 * jp], ub[n][2 * jp + 1]};
                        const f32x2 ga = __builtin_elementwise_fma(gi * sa2, sg2, gb2), ua = __builtin_elementwise_fma(ui * sa2, su2, ub2);
                        f32x2 gt, up;
                        gt.x = fminf(ga.x, 7.0f); gt.y = fminf(ga.y, 7.0f); up.x = __builtin_amdgcn_fmed3f(ua.x, -7.0f, 7.0f); up.y = __builtin_amdgcn_fmed3f(ua.y, -7.0f, 7.0f);
                        const f32x2 ex = gt * (-1.702f * LOG2E);
                        f32x2 en; en.x = __builtin_amdgcn_exp2f(ex.x); en.y = __builtin_amdgcn_exp2f(ex.y);
                        const f32x2 den = en + 1.0f, upp = up + 1.0f;
                        f32x2 rc; rc.x = __builtin_amdgcn_rcpf(den.x); rc.y = __builtin_amdgcn_rcpf(den.y);
                        const f32x2 hh = (gt * rc) * upp;
                        hv[4 * n + 2 * jp] = hh.x; hv[4 * n + 2 * jp + 1] = hh.y;
                    }
                u32x4 w; w.x = cvt_pk_bf16(hv[0], hv[1]); w.y = cvt_pk_bf16(hv[2], hv[3]); w.z = cvt_pk_bf16(hv[4], hv[5]); w.w = cvt_pk_bf16(hv[6], hv[7]);
                *(u32x4*)(HID + (size_t)row * DFF + fc0) = w;
            }
    }
};
struct EpiDown {
    static constexpr int PERM = 2; static constexpr bool HAS_INIT = false;
    const LAS int* tbl; const float* b_down; const float* swd; const float* row_sb; const float* el_gate; unsigned char* Y;
    __device__ __forceinline__ void operator()(const f32x4 (&acc)[2][2][4][2], const Unit& u, int wr, int wc, int fr, int fq) const {
        const int e = tbl[TBL_TILE + u.pm], p0 = (u.pm - tbl[TBL_TS + e]) * BM, ce = tbl[TBL_CNT + e];
        const int c0 = u.pn * BM + wc * 64 + 16 * fq;
        f32x4 bv[2][2], sw[2][2];
#pragma unroll
        for (int bj = 0; bj < 2; ++bj)
#pragma unroll
            for (int n = 0; n < 2; ++n) { bv[bj][n] = *(const f32x4*)(b_down + e * D + c0 + 8 * bj + 4 * n); sw[bj][n] = *(const f32x4*)(swd + e * D + c0 + 8 * bj + 4 * n); }
#pragma unroll
        for (int ai = 0; ai < 2; ++ai)
#pragma unroll
            for (int m = 0; m < 4; ++m) {
                const int row = u.pm * BM + ai * HALF + wr * 64 + m * 16 + fr;
                const int ix = p0 + ai * HALF + wr * 64 + m * 16 + fr;
                const float gt = (ix < ce ? el_gate[e * T + ix] : 0.f) * YSCALE, sb = row_sb[row] * gt;
                u32x4 w;
#pragma unroll
                for (int bj = 0; bj < 2; ++bj)
#pragma unroll
                    for (int n = 0; n < 2; ++n) {
                        float v[4];
#pragma unroll
                        for (int jp = 0; jp < 2; ++jp) {
                            const f32x2 ci = (f32x2){(float)__float_as_int(acc[ai][bj][m][n][2 * jp]), (float)__float_as_int(acc[ai][bj][m][n][2 * jp + 1])};
                            const f32x2 s2 = (f32x2){sw[bj][n][2 * jp], sw[bj][n][2 * jp + 1]} * sb, b2 = (f32x2){bv[bj][n][2 * jp], bv[bj][n][2 * jp + 1]} * gt;
                            const f32x2 r = __builtin_elementwise_fma(ci, s2, b2);
                            v[2 * jp] = __builtin_amdgcn_fmed3f(r.x, -448.0f, 448.0f); v[2 * jp + 1] = __builtin_amdgcn_fmed3f(r.y, -448.0f, 448.0f);
                        }
                        int d = 0;
                        d = __builtin_amdgcn_cvt_pk_fp8_f32(v[0], v[1], d, false);
                        d = __builtin_amdgcn_cvt_pk_fp8_f32(v[2], v[3], d, true);
                        w[2 * bj + n] = (unsigned)d;
                    }
                *(u32x4*)(Y + (size_t)row * D + c0) = w;
            }
    }
};
}
constexpr int NWAVES = 8;
constexpr int NPHASES = 10;
constexpr size_t WS_WIN = WS_HID + 144 * MiB;
constexpr size_t WS_WOUT = WS_WIN + 4 * MiB;
constexpr size_t WS_WGU = WS_WOUT + 2 * MiB;
constexpr size_t WS_SWGU = WS_WGU + 64 * MiB;
constexpr size_t WS_WD = WS_SWGU + 1 * MiB;
constexpr size_t WS_SWD = WS_WD + 32 * MiB;
constexpr size_t WS_HID8 = WS_SWD + 1 * MiB;
constexpr size_t WS_END = WS_HID8 + 72 * MiB;
constexpr int CW_BAR = 4096;
constexpr int RING_BYTES = 131072;
constexpr int RTAB_OFF = RING_BYTES;
constexpr int RTAB_UNITS = 12;
constexpr int RW_BYTES = 1024 * 144;
constexpr int RSCR_OFF = RW_BYTES;
constexpr int LDS_BYTES = 163840;
constexpr int MISC_OFF = LDS_BYTES - 256;
static_assert(RTAB_OFF + RTAB_UNITS * 1024 <= MISC_OFF && RSCR_OFF + 4096 <= MISC_OFF, "LDS map");

typedef GAS unsigned gu32;
#define RLX_AGENT __ATOMIC_RELAXED, __HIP_MEMORY_SCOPE_AGENT
#define LDS_WAIT() asm volatile("s_waitcnt lgkmcnt(0)" ::: "memory")
#define VM_WAIT() asm volatile("s_waitcnt vmcnt(0)" ::: "memory")

#define XB_TMO      128
#define XB_XCNT(j)  (256  + 64 * (j))
#define XB_XSUB(j)  (1280 + 64 * (j))
#define XB_XGEN(j)  (2304 + 64 * (j))
#define XB_TOP      3328
#define XB_TOPGEN   3392
#define XCD_BAR_WORDS 3456
#define XB_SPIN_CAP (1u << 18)
__device__ __forceinline__ unsigned xb_ld(unsigned* p)              { return __hip_atomic_load(p, __ATOMIC_RELAXED, __HIP_MEMORY_SCOPE_AGENT); }
__device__ __forceinline__ unsigned xb_add(unsigned* p, unsigned v) { return __hip_atomic_fetch_add(p, v, __ATOMIC_RELAXED, __HIP_MEMORY_SCOPE_AGENT); }
__device__ __forceinline__ unsigned xb_xcc_id() { return (unsigned)__builtin_amdgcn_s_getreg((3 << 11) | 20) & 0xFu; }
#define XB_SPIN(cond, bar) do { unsigned _sp = 0; while (cond) { __builtin_amdgcn_s_sleep(1); \
    if ((++_sp & 255u) == 0u) { if (xb_ld(&(bar)[XB_TMO])) break; if (_sp > XB_SPIN_CAP) { atomicAdd(&(bar)[XB_TMO], 1u); break; } } } } while (0)
struct XcdBarrier { unsigned* bar; unsigned x; volatile LAS unsigned* st; };
__device__ __forceinline__ XcdBarrier xcd_barrier_post(unsigned* bar, volatile LAS unsigned* st) {
    XcdBarrier b; b.bar = bar; b.x = xb_xcc_id(); b.st = st;
    if (threadIdx.x == 0) (void)xb_add(&bar[XB_XCNT(b.x)], 1u);
    return b;
}
__device__ __forceinline__ void xcd_barrier_complete(unsigned* bar, unsigned x, unsigned& nloc, unsigned& nx) {
    const unsigned G = gridDim.x * gridDim.y * gridDim.z;
    unsigned sum, cnt, mine, sp = 0u;
    for (;;) {
        sum = 0u; cnt = 0u; mine = 0u;
#pragma unroll
        for (unsigned j = 0; j < 16; ++j) { const unsigned c = xb_ld(&bar[XB_XCNT(j)]); sum += c; cnt += (c > 0u) ? 1u : 0u; mine = (j == x) ? c : mine; }
        if (sum == G) break;
        __builtin_amdgcn_s_sleep(1);
        if ((++sp & 255u) == 0u) { if (xb_ld(&bar[XB_TMO])) break; if (sp > XB_SPIN_CAP) { atomicAdd(&bar[XB_TMO], 1u); break; } }
    }
    nloc = mine > 0u ? mine : 1u; nx = cnt > 0u ? cnt : 1u;
}
__device__ __forceinline__ void xcd_barrier(const XcdBarrier& b) {
    asm volatile("s_waitcnt vmcnt(0)" ::: "memory");
    __syncthreads();
    if (threadIdx.x == 0) {
        unsigned* bar = b.bar;
        __builtin_amdgcn_s_waitcnt(0);
        unsigned nloc = b.st[0], nx = b.st[1];
        if (nloc == 0u) { xcd_barrier_complete(bar, b.x, nloc, nx); b.st[0] = nloc; b.st[1] = nx; }
        const unsigned old = xb_add(&bar[XB_XSUB(b.x)], 1u);
        const unsigned gen = old / nloc;
        if (old + 1u == (gen + 1u) * nloc) {
            __builtin_amdgcn_fence(__ATOMIC_RELEASE, "agent");
            asm volatile("s_waitcnt vmcnt(0)" ::: "memory");
            const unsigned og = xb_add(&bar[XB_TOP], 1u);
            const unsigned tg = og / nx;
            if (og + 1u == (tg + 1u) * nx) xb_add(&bar[XB_TOPGEN], 1u);
            else XB_SPIN(xb_ld(&bar[XB_TOPGEN]) == tg, bar);
            __builtin_amdgcn_fence(__ATOMIC_ACQUIRE, "agent");
            xb_add(&bar[XB_XGEN(b.x)], 1u);
            asm volatile("s_waitcnt vmcnt(0)" ::: "memory");
        } else {
            XB_SPIN(xb_ld(&bar[XB_XGEN(b.x)]) == gen, bar);
            __builtin_amdgcn_fence(__ATOMIC_ACQUIRE, "agent");
            asm volatile("s_waitcnt vmcnt(0)" ::: "memory");
        }
    }
    __syncthreads();
}

struct Args {
    const float* in[22]; float* out; unsigned char* ws; int ph_lo, ph_hi, li, pad;
};
struct Frame {
    LAS unsigned char* lds;
    int tid, lane, wave, vcu, G;
};
__device__ __forceinline__ void p0_item(const float* W, int N, bf16* WT, int K, int dst_row0, int k0, int n0, LAS float* scr, int lane) {
    f32x4 v[8];
#pragma unroll
    for (int i = 0; i < 8; ++i) v[i] = __builtin_nontemporal_load((const f32x4*)(W + (size_t)(k0 + (lane >> 3) + 8 * i) * N + n0 + 4 * (lane & 7)));
#pragma unroll
    for (int i = 0; i < 8; ++i) { LAS float* s = scr + ((lane >> 3) + 8 * i) * 33 + 4 * (lane & 7); s[0] = v[i].x; s[1] = v[i].y; s[2] = v[i].z; s[3] = v[i].w; }
    LDS_WAIT(); asm volatile("" ::: "memory");
    const int c = lane & 7;
#pragma unroll
    for (int j = 0; j < 4; ++j) { const int n = (lane >> 3) + 8 * j; const LAS float* s = scr + (8 * c) * 33 + n;
        u32x4 o; o.x = pk2(s[0 * 33], s[1 * 33]); o.y = pk2(s[2 * 33], s[3 * 33]); o.z = pk2(s[4 * 33], s[5 * 33]); o.w = pk2(s[6 * 33], s[7 * 33]);
        *(u32x4*)(WT + (size_t)(dst_row0 + n) * K + k0 + 8 * c) = o; }
    LDS_WAIT(); asm volatile("" ::: "memory");
}
struct ConvItem { const float* W; signed char* dst; float* sc; int n0, dst_row0; };
__device__ __forceinline__ ConvItem conv_decode(const Args& a, int it) {
    unsigned char* ws = a.ws;
    const int nb = it & 31, e = (it >> 5) & 31, kind = it >> 10, n0 = nb * 32;
    ConvItem c;
    c.W = (kind == 0 ? a.in[14] : kind == 1 ? a.in[16] : a.in[18]) + (size_t)e * D * DFF;
    c.dst = kind < 2 ? (signed char*)(ws + WS_WGU) + (size_t)e * 2048 * 1024 : (signed char*)(ws + WS_WD) + (size_t)e * 1024 * 1024;
    c.dst_row0 = kind < 2 ? (n0 >> 7) * 256 + kind * 128 + (n0 & 127) : n0;
    c.sc = kind < 2 ? (float*)(ws + WS_SWGU) + e * 2048 : (float*)(ws + WS_SWD) + e * 1024;
    c.n0 = n0; return c;
}
#define CONV_LOAD(v, ci) do { _Pragma("unroll") for (int i_ = 0; i_ < 4; ++i_) _Pragma("unroll") for (int j_ = 0; j_ < 4; ++j_) \
        v[i_][j_] = __builtin_nontemporal_load((const f32x4*)((ci).W + (size_t)(4 * (kl + 64 * i_) + j_) * DFF + (ci).n0 + 4 * n4)); } while (0)
__device__ __forceinline__ void conv_items(const Frame& F, const Args& a, int it_lo, int it_hi) {
    if (it_hi > 3 * NEXP * 32) it_hi = 3 * NEXP * 32;
    if (it_lo >= it_hi) return;
    const int tid = F.tid, n4 = tid & 7, kl = tid >> 3;
    LAS unsigned* tile = (LAS unsigned*)F.lds;
    LAS float* red = (LAS float*)(F.lds + 36864);
    f32x4 v[4][4];
    ConvItem cur = conv_decode(a, it_lo);
    CONV_LOAD(v, cur);
    for (int it = it_lo; it < it_hi; ++it) {
        f32x4 am = (f32x4){0.f, 0.f, 0.f, 0.f};
#pragma unroll
        for (int i = 0; i < 4; ++i)
#pragma unroll
            for (int j = 0; j < 4; ++j) { am.x = fmaxf(am.x, fabsf(v[i][j].x)); am.y = fmaxf(am.y, fabsf(v[i][j].y)); am.z = fmaxf(am.z, fabsf(v[i][j].z)); am.w = fmaxf(am.w, fabsf(v[i][j].w)); }
#pragma unroll
        for (int o = 8; o < 64; o <<= 1) { am.x = fmaxf(am.x, __shfl_xor(am.x, o)); am.y = fmaxf(am.y, __shfl_xor(am.y, o)); am.z = fmaxf(am.z, __shfl_xor(am.z, o)); am.w = fmaxf(am.w, __shfl_xor(am.w, o)); }
        if (F.lane < 8) *(LAS f32x4*)(red + F.wave * 32 + 4 * n4) = am;
        __syncthreads();
        f32x4 cm = *(const LAS f32x4*)(red + 4 * n4);
#pragma unroll
        for (int w = 1; w < 8; ++w) { const f32x4 o = *(const LAS f32x4*)(red + w * 32 + 4 * n4); cm.x = fmaxf(cm.x, o.x); cm.y = fmaxf(cm.y, o.y); cm.z = fmaxf(cm.z, o.z); cm.w = fmaxf(cm.w, o.w); }
        f32x4 inv;
#pragma unroll
        for (int c = 0; c < 4; ++c) inv[c] = cm[c] > 0.f ? 127.0f / cm[c] : 0.f;
        if (kl == 0) {
#pragma unroll
            for (int c = 0; c < 4; ++c) cur.sc[cur.dst_row0 + 4 * n4 + c] = cm[c] * (1.0f / 127.0f);
        }
#pragma unroll
        for (int i = 0; i < 4; ++i)
#pragma unroll
            for (int c = 0; c < 4; ++c) {
                unsigned d = 0u;
#pragma unroll
                for (int j = 0; j < 4; ++j) { const int q = (int)rintf(v[i][j][c] * inv[c]); d |= ((unsigned)q & 0xffu) << (8 * j); }
                tile[(4 * n4 + c) * 260 + kl + 64 * i] = d;
            }
        const ConvItem done = cur;
        if (it + 1 < it_hi) { cur = conv_decode(a, it + 1); CONV_LOAD(v, cur); }
        __syncthreads();
#pragma unroll
        for (int j = 0; j < 4; ++j) { const int ch = tid + 512 * j, n = ch >> 6, c16 = ch & 63;
            *(u32x4*)(done.dst + (size_t)(done.dst_row0 + n) * 1024 + 16 * c16) = *(const LAS u32x4*)(tile + n * 260 + 4 * c16); }
        __syncthreads();
    }
}
__device__ __forceinline__ void p0_prologue(const Frame& F, const Args& a) {
    unsigned char* ws = a.ws;
    bf16* Win_t = (bf16*)(ws + WS_WIN); bf16* Wout_t = (bf16*)(ws + WS_WOUT);
    LAS float* scr = (LAS float*)(F.lds + F.wave * 8448);
    const int gw = F.vcu * NWAVES + F.wave, NGW = F.G * NWAVES;
    constexpr int I_IN = 16 * 56, I_OUT = 16 * 32, NITEMS = I_IN + I_OUT;
    for (int it = gw; it < NITEMS; it += NGW) {
        int r = it;
        if (r < I_IN) { const int kb = r / 56, nb = r % 56; p0_item(a.in[1], INW, Win_t, D, nb * 32, kb * 64, nb * 32, scr, F.lane); continue; } r -= I_IN;
        { const int kb = r / 32, nb = r % 32; p0_item(a.in[8], D, Wout_t, D, nb * 32, kb * 64, nb * 32, scr, F.lane); }
    }
    const float* x = a.in[0]; bf16* XB = (bf16*)(ws + WS_XB);
    for (int m = gw; m < T; m += NGW) {
        const f32x4* xr = (const f32x4*)(x + (size_t)m * D) + F.lane; u32x2* o = (u32x2*)(XB + (size_t)m * D) + F.lane;
        f32x4 v[4];
#pragma unroll
        for (int j = 0; j < 4; ++j) v[j] = __builtin_nontemporal_load(xr + 64 * j);
#pragma unroll
        for (int j = 0; j < 4; ++j) { u32x2 w; w.x = pk2(v[j].x, v[j].y); w.y = pk2(v[j].z, v[j].w); o[64 * j] = w; }
    }
}

__device__ __forceinline__ int crow(int r, int hi) { return (r & 3) + 8 * (r >> 2) + 4 * hi; }
constexpr int AT_KROW = 144, AT_KG = 192 * AT_KROW, AT_VROW = 400, AT_VG = 64 * AT_VROW, AT_VOFF = 2 * AT_KG;
__device__ __forceinline__ void attn_wave_unit(const LAS unsigned char* lds, const bf16x8 (&qf)[4], const float sk, bf16* CAT, int tok0, int u, int h, int lane) {
    const int r32 = lane & 31, hi = lane >> 5;
    const int t0 = tok0 % SEQ, g = h >> 2;
    const int kk0 = 32 * u;
    f32x16 p[5];
    const float NEG = -INFINITY;
    const LAS unsigned char* kl = lds + g * AT_KG + (kk0 + r32) * AT_KROW + hi * 16;
#pragma unroll
    for (int j = 0; j < 5; ++j) {
        const int kb = t0 - 128 + 32 * j;
        f32x16 s;
#pragma unroll
        for (int r = 0; r < 16; ++r) s[r] = 0.f;
        if (kb >= 0) {
#pragma unroll
            for (int d0 = 0; d0 < 4; ++d0) { const bf16x8 kf = *(const LAS bf16x8*)(kl + j * 32 * AT_KROW + d0 * 32); s = __builtin_amdgcn_mfma_f32_32x32x16_bf16(kf, qf[d0], s, 0, 0, 0); }
            if (j == 0) {
#pragma unroll
                for (int r = 0; r < 16; ++r) if (!(crow(r, hi) > r32)) s[r] = NEG;
            }
            if (j == 4) {
#pragma unroll
                for (int r = 0; r < 16; ++r) if (!(crow(r, hi) <= r32)) s[r] = NEG;
            }
        } else {
#pragma unroll
            for (int r = 0; r < 16; ++r) s[r] = NEG;
        }
        p[j] = s;
    }
    float m = sk;
#pragma unroll
    for (int j = 0; j < 5; ++j)
#pragma unroll
        for (int r = 0; r < 16; ++r) m = fmaxf(m, p[j][r]);
    m = fmaxf(m, __shfl_xor(m, 32));
    float l = 0.f;
#pragma unroll
    for (int j = 0; j < 5; ++j)
#pragma unroll
        for (int r = 0; r < 16; ++r) { const float e = __builtin_amdgcn_exp2f(p[j][r] - m); p[j][r] = e; l += e; }
    l += __shfl_xor(l, 32);
    l += __builtin_amdgcn_exp2f(sk - m);
    const float inv = 1.0f / l;
    u32x4 pb[5][2];
#pragma unroll
    for (int j = 0; j < 5; ++j)
#pragma unroll
        for (int s = 0; s < 2; ++s) { pb[j][s].x = cvt_pk_bf16(p[j][8 * s + 0], p[j][8 * s + 1]); pb[j][s].y = cvt_pk_bf16(p[j][8 * s + 2], p[j][8 * s + 3]); pb[j][s].z = cvt_pk_bf16(p[j][8 * s + 4], p[j][8 * s + 5]); pb[j][s].w = cvt_pk_bf16(p[j][8 * s + 6], p[j][8 * s + 7]); }
#pragma unroll
    for (int db = 0; db < 2; ++db) {
        f32x16 o;
#pragma unroll
        for (int r = 0; r < 16; ++r) o[r] = 0.f;
        const LAS unsigned char* vl = lds + AT_VOFF + g * AT_VG + (db * 32 + r32) * AT_VROW + (kk0 + 4 * hi) * 2;
#pragma unroll
        for (int j = 0; j < 5; ++j) {
            const int kb = t0 - 128 + 32 * j;
            if (kb >= 0) {
#pragma unroll
                for (int s = 0; s < 2; ++s) {
                    const u32x2 lo = *(const LAS u32x2*)(vl + (32 * j + 16 * s) * 2), hh = *(const LAS u32x2*)(vl + (32 * j + 16 * s + 8) * 2);
                    u32x4 av; av.x = lo.x; av.y = lo.y; av.z = hh.x; av.w = hh.y;
                    o = __builtin_amdgcn_mfma_f32_32x32x16_bf16(__builtin_bit_cast(bf16x8, av), __builtin_bit_cast(bf16x8, pb[j][s]), o, 0, 0, 0);
                }
            }
        }
        bf16* op = CAT + (size_t)(tok0 + r32) * 1024 + h * 64 + db * 32 + 4 * hi;
#pragma unroll
        for (int gq = 0; gq < 4; ++gq) { u32x2 w; w.x = cvt_pk_bf16(o[4 * gq] * inv, o[4 * gq + 1] * inv); w.y = cvt_pk_bf16(o[4 * gq + 2] * inv, o[4 * gq + 3] * inv); *(u32x2*)(op + 8 * gq) = w; }
    }
}
__device__ __forceinline__ void attn_block(const Frame& F, const bf16* QB, const bf16* KB, const bf16* VT, const float* sinks, bf16* CAT, int qq) {
    const int tokb = qq * 64, b = tokb / SEQ, tb = tokb % SEQ, kbase = tb - 128;
    u32x4 kv[6], vv[6];
    bf16x8 qf0[4], qf1[4];
    { const int r32 = F.lane & 31, hi = F.lane >> 5;
#pragma unroll
      for (int d0 = 0; d0 < 4; ++d0) { qf0[d0] = *(const bf16x8*)(QB + (size_t)(tokb + r32) * 512 + F.wave * 64 + d0 * 16 + hi * 8); qf1[d0] = *(const bf16x8*)(QB + (size_t)(tokb + 32 + r32) * 512 + F.wave * 64 + d0 * 16 + hi * 8); } }
    const float sk = sinks[F.wave] * LOG2E;
#pragma unroll
    for (int i = 0; i < 6; ++i) {
        const int c = F.tid + 512 * i, g = c / 1536, rem = c % 1536;
        { const int key = rem >> 3, ch = rem & 7, pos = kbase + key;
          kv[i] = pos >= 0 ? __builtin_nontemporal_load((const u32x4*)(KB + (size_t)(b * SEQ + pos) * 128 + g * 64 + ch * 8)) : (u32x4){0u, 0u, 0u, 0u}; }
        { const int d = rem / 24, ch = rem % 24, pos = kbase + ch * 8;
          vv[i] = pos >= 0 ? __builtin_nontemporal_load((const u32x4*)(VT + ((size_t)((b * 2 + g) * 64 + d)) * SEQ + pos)) : (u32x4){0u, 0u, 0u, 0u}; }
    }
#pragma unroll
    for (int i = 0; i < 6; ++i) {
        const int c = F.tid + 512 * i, g = c / 1536, rem = c % 1536;
        *(LAS u32x4*)(F.lds + g * AT_KG + (rem >> 3) * AT_KROW + (rem & 7) * 16) = kv[i];
        *(LAS u32x4*)(F.lds + AT_VOFF + g * AT_VG + (rem / 24) * AT_VROW + (rem % 24) * 16) = vv[i];
    }
    __syncthreads();
    attn_wave_unit(F.lds, qf0, sk, CAT, tokb, 0, F.wave, F.lane);
    attn_wave_unit(F.lds, qf1, sk, CAT, tokb + 32, 1, F.wave, F.lane);
    __syncthreads();
}
template <int CTRL> __device__ __forceinline__ float dppq(float v) { return __builtin_bit_cast(float, __builtin_amdgcn_update_dpp(0, __builtin_bit_cast(int, v), CTRL, 0xF, 0xF, true)); }
constexpr int SG_WOFF = 20480, SG_WROW = 272;
__device__ __forceinline__ void sgu_stage_w(const Frame& F, const float* w_s, int gi) {
    f32x4 w[8];
#pragma unroll
    for (int i = 0; i < 8; ++i) w[i] = *(const f32x4*)(w_s + (size_t)gi * 16384 + (size_t)(F.tid + 512 * i) * 4);
#pragma unroll
    for (int i = 0; i < 8; ++i) { const int c = F.tid + 512 * i, t = c >> 5, s0 = (c & 31) * 4;
        f32x4 v = w[i];
#pragma unroll
        for (int j = 0; j < 4; ++j) if (s0 + j > t) v[j] = 0.f;
        u32x2 o; o.x = cvt_pk_bf16(v[0], v[1]); o.y = cvt_pk_bf16(v[2], v[3]);
        *(LAS u32x2*)(F.lds + SG_WOFF + t * SG_WROW + s0 * 2) = o; }
}
__device__ __forceinline__ void sgu_unit(const Frame& F, const bf16* UB, const bf16* GB, const float* ln_g, const float* ln_b, const float* w_s, const float* b_s, bf16* CAT, int ch, int gi) {
    LAS bf16* GT = (LAS bf16*)F.lds;
    const int r32 = F.lane & 31, hi = F.lane >> 5, tb = F.wave >> 1, db = F.wave & 1, t = tb * 32 + r32;
    const int nks = 2 * (tb + 1);
    const int s = F.tid >> 2, q4 = F.tid & 3; const size_t tok = (size_t)ch * 128 + s;
    const u32x4* gp = (const u32x4*)(GB + tok * 512 + gi * 64 + q4 * 16);
    const u32x4 a = gp[0], c = gp[1];
    const size_t tokt = (size_t)ch * 128 + t;
    const bf16* up = UB + tokt * 512 + gi * 64 + db * 32 + 4 * hi;
    u32x2 uu[4];
#pragma unroll
    for (int gq = 0; gq < 4; ++gq) uu[gq] = *(const u32x2*)(up + 8 * gq);
    const float bb = b_s[gi * 128 + t];
    float lg_[16], lb_[16];
#pragma unroll
    for (int i = 0; i < 16; ++i) { lg_[i] = ln_g[gi * 64 + q4 * 16 + i]; lb_[i] = ln_b[gi * 64 + q4 * 16 + i]; }
    {
        float v[16];
        v[0] = __uint_as_float(a.x << 16); v[1] = __uint_as_float(a.x & 0xffff0000u); v[2] = __uint_as_float(a.y << 16); v[3] = __uint_as_float(a.y & 0xffff0000u);
        v[4] = __uint_as_float(a.z << 16); v[5] = __uint_as_float(a.z & 0xffff0000u); v[6] = __uint_as_float(a.w << 16); v[7] = __uint_as_float(a.w & 0xffff0000u);
        v[8] = __uint_as_float(c.x << 16); v[9] = __uint_as_float(c.x & 0xffff0000u); v[10] = __uint_as_float(c.y << 16); v[11] = __uint_as_float(c.y & 0xffff0000u);
        v[12] = __uint_as_float(c.z << 16); v[13] = __uint_as_float(c.z & 0xffff0000u); v[14] = __uint_as_float(c.w << 16); v[15] = __uint_as_float(c.w & 0xffff0000u);
        float sum = 0.f;
#pragma unroll
        for (int i = 0; i < 16; ++i) sum += v[i];
        sum += dppq<0xB1>(sum); sum += dppq<0x4E>(sum);
        const float mu = sum * (1.f / 64.f); float q = 0.f;
#pragma unroll
        for (int i = 0; i < 16; ++i) { v[i] -= mu; q += v[i] * v[i]; }
        q += dppq<0xB1>(q); q += dppq<0x4E>(q);
        const float rstd = rsqrtf(q * (1.f / 64.f) + LN_EPS);
#pragma unroll
        for (int i = 0; i < 16; ++i) { const int d = q4 * 16 + i; GT[d * 136 + s] = (bf16)f2bf(v[i] * rstd * lg_[i] + lb_[i]); }
    }
    __syncthreads();
    {
        f32x16 acc;
#pragma unroll
        for (int r = 0; r < 16; ++r) acc[r] = 0.f;
        const LAS bf16* arow = GT + (db * 32 + r32) * 136 + hi * 8;
        const LAS unsigned char* wlds = F.lds + SG_WOFF + t * SG_WROW + hi * 16;
#pragma unroll
        for (int ks = 0; ks < 8; ++ks) if (ks < nks) {
            const bf16x8 af = *(const LAS bf16x8*)(arow + ks * 16);
            const bf16x8 bw = *(const LAS bf16x8*)(wlds + ks * 32);
            acc = __builtin_amdgcn_mfma_f32_32x32x16_bf16(af, bw, acc, 0, 0, 0);
        }
        bf16* op = CAT + tokt * 1024 + 512 + gi * 64 + db * 32 + 4 * hi;
#pragma unroll
        for (int gq = 0; gq < 4; ++gq) {
            const float u0 = __uint_as_float(uu[gq].x << 16), u1 = __uint_as_float(uu[gq].x & 0xffff0000u), u2 = __uint_as_float(uu[gq].y << 16), u3 = __uint_as_float(uu[gq].y & 0xffff0000u);
            u32x2 w; w.x = cvt_pk_bf16(u0 * (acc[4 * gq] + bb), u1 * (acc[4 * gq + 1] + bb)); w.y = cvt_pk_bf16(u2 * (acc[4 * gq + 2] + bb), u3 * (acc[4 * gq + 3] + bb));
            *(u32x2*)(op + 8 * gq) = w;
        }
    }
    __syncthreads();
}
__device__ __forceinline__ void p2_mixers(const Frame& F, const Args& a) {
    unsigned char* ws = a.ws;
    const bf16 *QB = (const bf16*)(ws + WS_QB), *KB = (const bf16*)(ws + WS_KB), *VT = (const bf16*)(ws + WS_VT), *UB = (const bf16*)(ws + WS_UB), *GB = (const bf16*)(ws + WS_GB);
    bf16* CAT = (bf16*)(ws + WS_CAT);
    for (int qq = F.vcu; qq < T / 64; qq += F.G) attn_block(F, QB, KB, VT, a.in[3], CAT, qq);
    int gi_staged = -1;
    for (int u = F.vcu; u < (T / 128) * 8; u += F.G) {
        if ((u & 7) != gi_staged) { __syncthreads(); sgu_stage_w(F, a.in[6], u & 7); gi_staged = u & 7; }
        sgu_unit(F, UB, GB, a.in[4], a.in[5], a.in[6], a.in[7], CAT, u >> 3, u & 7);
    }
}

template <int CTRL> __device__ __forceinline__ float dppf(float v) { return __builtin_bit_cast(float, __builtin_amdgcn_update_dpp(0, __builtin_bit_cast(int, v), CTRL, 0xF, 0xF, true)); }
__device__ __forceinline__ float swap16_sum(float x, float y) { auto r = __builtin_amdgcn_permlane16_swap(__builtin_bit_cast(unsigned, x), __builtin_bit_cast(unsigned, y), false, false); return __builtin_bit_cast(float, r[0]) + __builtin_bit_cast(float, r[1]); }
__device__ __forceinline__ float swap32_sum(float x, float y) { auto r = __builtin_amdgcn_permlane32_swap(__builtin_bit_cast(unsigned, x), __builtin_bit_cast(unsigned, y), false, false); return __builtin_bit_cast(float, r[0]) + __builtin_bit_cast(float, r[1]); }
__device__ __forceinline__ float rdlane(float v, int l) { return __builtin_bit_cast(float, __builtin_amdgcn_readlane(__builtin_bit_cast(int, v), l)); }
__device__ __forceinline__ float xsum(float v) {
    v += dppf<0xB1>(v); v += dppf<0x4E>(v); v += dppf<0x124>(v); v += dppf<0x128>(v);
    return (rdlane(v, 0) + rdlane(v, 16)) + (rdlane(v, 32) + rdlane(v, 48));
}
__device__ __forceinline__ float xmax(float v) {
    v = fmaxf(v, dppf<0xB1>(v)); v = fmaxf(v, dppf<0x4E>(v)); v = fmaxf(v, dppf<0x124>(v)); v = fmaxf(v, dppf<0x128>(v));
    return fmaxf(fmaxf(rdlane(v, 0), rdlane(v, 16)), fmaxf(rdlane(v, 32), rdlane(v, 48)));
}
__device__ __forceinline__ void p4_router(const Frame& F, const Args& a, bool commit) {
    const float* Zin = a.out; bf16* Hout = (bf16*)(a.ws + WS_H); signed char* HB8 = (signed char*)(a.ws + WS_HB); int* meta = (int*)(a.ws + WS_META); unsigned* cnt = (unsigned*)(a.ws + WS_CTL) + CW_CNT;
    const float* ln1_g = a.in[10]; const float* ln1_b = a.in[11]; const float* w_r = a.in[12]; const float* b_r = a.in[13];
    LAS float* W = (LAS float*)F.lds;
    LAS unsigned* hist = (LAS unsigned*)(F.lds + RSCR_OFF);
    LAS unsigned* base = hist + 32;
    LAS int* tmp_e = (LAS int*)(hist + 64);
    LAS int* tmp_p = tmp_e + 256;
    LAS float* tmp_g = (LAS float*)(tmp_p + 256);
    LAS float* tmp_s = tmp_g + 256;
    int* el_tok = (int*)(a.ws + WS_ELIST); float* el_gate = (float*)(a.ws + WS_ELIST) + NEXP * T; float* el_sa = el_gate + NEXP * T;
    {
        f32x4 t[16];
#pragma unroll
        for (int k = 0; k < 16; ++k) t[k] = *(const f32x4*)(w_r + (size_t)(F.tid + 512 * k) * 4);
#pragma unroll
        for (int k = 0; k < 16; ++k) { const int i = F.tid + 512 * k, c = i >> 3, e4 = i & 7, pr = (c & ~255) + 64 * (c & 3) + ((c >> 2) & 63); *(LAS f32x4*)(W + pr * 36 + e4 * 4) = t[k]; }
    }
    const int lane = F.lane, half = lane >> 5, el = lane & 31;
    LAS float* gbl = (LAS float*)(F.lds + 151552);
    for (int i = F.tid; i < 512; i += NWAVES * 64) *(LAS f32x4*)(gbl + 4 * i) = i < 256 ? *(const f32x4*)(ln1_g + 4 * i) : *(const f32x4*)(ln1_b + 4 * (i - 256));
    for (int tb = F.vcu; tb < T / 64; tb += F.G) {
        if (F.tid < 32) hist[F.tid] = 0u;
        __syncthreads();
        float zn0[16], zn1[16];
        { const f32x4* z0 = (const f32x4*)(Zin + (size_t)(tb * 64 + 8 * F.wave) * D) + lane;
#pragma unroll
          for (int j = 0; j < 4; ++j) { const f32x4 a0 = __builtin_nontemporal_load(z0 + 64 * j), a1 = __builtin_nontemporal_load(z0 + 256 + 64 * j);
#pragma unroll
            for (int k = 0; k < 4; ++k) { zn0[4 * j + k] = a0[k]; zn1[4 * j + k] = a1[k]; } } }
        for (int pp = 0; pp < 4; ++pp) {
            const int tl0 = 8 * F.wave + 2 * pp;
            const int tok0 = tb * 64 + tl0;
            float h0[16], h1[16];
            {
                u32x2* ho0 = (u32x2*)(Hout + (size_t)tok0 * D) + lane; u32x2* ho1 = ho0 + 256;
                float s0 = 0.f, s1 = 0.f, q0 = 0.f, q1 = 0.f;
#pragma unroll
                for (int i = 0; i < 16; ++i) { h0[i] = zn0[i]; h1[i] = zn1[i]; }
                if (pp < 3) { const f32x4* zp = (const f32x4*)(Zin + (size_t)(tok0 + 2) * D) + lane;
#pragma unroll
                    for (int j = 0; j < 4; ++j) { const f32x4 a0 = __builtin_nontemporal_load(zp + 64 * j), a1 = __builtin_nontemporal_load(zp + 256 + 64 * j);
#pragma unroll
                        for (int k = 0; k < 4; ++k) { zn0[4 * j + k] = a0[k]; zn1[4 * j + k] = a1[k]; } } }
#pragma unroll
                for (int i = 0; i < 16; ++i) { s0 += h0[i]; s1 += h1[i]; q0 += h0[i] * h0[i]; q1 += h1[i] * h1[i]; }
                s0 = xsum(s0); s1 = xsum(s1); q0 = xsum(q0); q1 = xsum(q1);
                const float m0 = s0 * (1.f / D), m1 = s1 * (1.f / D);
                const float r0 = rsqrtf(fmaxf(q0 * (1.f / D) - m0 * m0, 0.f) + LN_EPS), r1 = rsqrtf(fmaxf(q1 * (1.f / D) - m1 * m1, 0.f) + LN_EPS);
                float a0 = 0.f, a1 = 0.f;
#pragma unroll
                for (int i = 0; i < 16; ++i) {
                    const float gm_ = gbl[4 * lane + 256 * (i >> 2) + (i & 3)], bt_ = gbl[1024 + 4 * lane + 256 * (i >> 2) + (i & 3)];
                    h0[i] = (h0[i] - m0) * r0 * gm_ + bt_; h1[i] = (h1[i] - m1) * r1 * gm_ + bt_;
                    a0 = fmaxf(a0, fabsf(h0[i])); a1 = fmaxf(a1, fabsf(h1[i]));
                }
                a0 = xmax(a0); a1 = xmax(a1);
                const float i0 = a0 > 0.f ? 127.0f / a0 : 0.f, i1 = a1 > 0.f ? 127.0f / a1 : 0.f;
                unsigned* hb0 = (unsigned*)(HB8 + (size_t)tok0 * D) + lane; unsigned* hb1 = hb0 + 256;
#pragma unroll
                for (int j = 0; j < 4; ++j) {
                    { u32x2 w0, w1; w0.x = cvt_pk_bf16(h0[4 * j], h0[4 * j + 1]); w0.y = cvt_pk_bf16(h0[4 * j + 2], h0[4 * j + 3]); w1.x = cvt_pk_bf16(h1[4 * j], h1[4 * j + 1]); w1.y = cvt_pk_bf16(h1[4 * j + 2], h1[4 * j + 3]); ho0[64 * j] = w0; ho1[64 * j] = w1; }
                    unsigned p0 = 0u, p1 = 0u;
#pragma unroll
                    for (int k = 0; k < 4; ++k) { p0 |= ((unsigned)(int)rintf(h0[4 * j + k] * i0) & 0xffu) << (8 * k); p1 |= ((unsigned)(int)rintf(h1[4 * j + k] * i1) & 0xffu) << (8 * k); }
                    hb0[64 * j] = p0; hb1[64 * j] = p1;
                }
                if (lane == 0) { tmp_s[tl0] = a0 * (1.0f / 127.0f); tmp_s[tl0 + 1] = a1 * (1.0f / 127.0f); }
            }
            f32x2 lp0[16], lp1[16];
#pragma unroll
            for (int e = 0; e < 16; ++e) { lp0[e] = (f32x2){0.f, 0.f}; lp1[e] = (f32x2){0.f, 0.f}; }
#pragma unroll
            for (int i = 0; i < 16; ++i) {
                const LAS f32x4* wr = (const LAS f32x4*)(W + (256 * (i >> 2) + 64 * (i & 3) + lane) * 36);
                const f32x2 hv0 = (f32x2){h0[i], h0[i]}, hv1 = (f32x2){h1[i], h1[i]};
#pragma unroll
                for (int e4 = 0; e4 < 8; ++e4) {
                    const f32x4 ww = wr[e4];
                    const f32x2 wlo = (f32x2){ww.x, ww.y}, whi = (f32x2){ww.z, ww.w};
                    lp0[2 * e4] = __builtin_elementwise_fma(hv0, wlo, lp0[2 * e4]); lp0[2 * e4 + 1] = __builtin_elementwise_fma(hv0, whi, lp0[2 * e4 + 1]);
                    lp1[2 * e4] = __builtin_elementwise_fma(hv1, wlo, lp1[2 * e4]); lp1[2 * e4 + 1] = __builtin_elementwise_fma(hv1, whi, lp1[2 * e4 + 1]);
                }
            }
            float lg0[32], lg1[32];
#pragma unroll
            for (int e = 0; e < 16; ++e) { lg0[2 * e] = lp0[e].x; lg0[2 * e + 1] = lp0[e].y; lg1[2 * e] = lp1[e].x; lg1[2 * e + 1] = lp1[e].y; }
            float v32[32];
#pragma unroll
            for (int e = 0; e < 32; ++e) { const float keep = half ? lg1[e] : lg0[e], send = half ? lg0[e] : lg1[e]; v32[e] = keep + __shfl_xor(send, 32); }
            float v16[16];
#pragma unroll
            for (int e = 0; e < 16; ++e) { const bool up = (lane & 16) != 0; const float keep = up ? v32[e + 16] : v32[e], send = up ? v32[e] : v32[e + 16]; v16[e] = keep + __shfl_xor(send, 16); }
            float v8[8];
#pragma unroll
            for (int e = 0; e < 8; ++e) { const bool up = (lane & 8) != 0; const float keep = up ? v16[e + 8] : v16[e], send = up ? v16[e] : v16[e + 8]; v8[e] = keep + dppf<0x128>(send); }
            float v4[4];
#pragma unroll
            for (int e = 0; e < 4; ++e) { const bool up = (lane & 4) != 0; const float keep = up ? v8[e + 4] : v8[e], send = up ? v8[e] : v8[e + 4]; v4[e] = keep + dppf<0x1B>(dppf<0x141>(send)); }
            float v2[2];
#pragma unroll
            for (int e = 0; e < 2; ++e) { const bool up = (lane & 2) != 0; const float keep = up ? v4[e + 2] : v4[e], send = up ? v4[e] : v4[e + 2]; v2[e] = keep + dppf<0x4E>(send); }
            float lgt;
            { const bool up = (lane & 1) != 0; const float keep = up ? v2[1] : v2[0], send = up ? v2[0] : v2[1]; lgt = keep + dppf<0xB1>(send); }
            lgt += b_r[el];
            float bv[4]; int bi[4];
            {
                float cur = lgt;
#pragma unroll
                for (int k = 0; k < 4; ++k) {
                    float mx = cur;
                    mx = fmaxf(mx, dppf<0xB1>(mx)); mx = fmaxf(mx, dppf<0x4E>(mx)); mx = fmaxf(mx, dppf<0x124>(mx)); mx = fmaxf(mx, dppf<0x128>(mx));
                    const float m0 = fmaxf(rdlane(mx, 0), rdlane(mx, 16)), m1 = fmaxf(rdlane(mx, 32), rdlane(mx, 48));
                    const float mm = half ? m1 : m0;
                    const unsigned long long mk = __ballot(cur == mm);
                    const int i0 = __builtin_ctz((unsigned)mk | 0x80000000u), i1 = __builtin_ctz((unsigned)(mk >> 32) | 0x80000000u);
                    bv[k] = mm; bi[k] = half ? i1 : i0;
                    if (el == bi[k]) cur = -INFINITY;
                }
            }
            float ex[4], es = 0.f;
#pragma unroll
            for (int k = 0; k < 4; ++k) { ex[k] = __expf(bv[k] - bv[0]); es += ex[k]; }
            if (el == 0) {
                const int tl = tl0 + half;
#pragma unroll
                for (int k = 0; k < 4; ++k) { const unsigned pl = atomicAdd((unsigned*)&hist[bi[k]], 1u); tmp_e[tl * 4 + k] = bi[k]; tmp_p[tl * 4 + k] = (int)pl; tmp_g[tl * 4 + k] = ex[k] / es; }
            }
        }
        __syncthreads();
        if (F.tid < 32) base[F.tid] = commit ? atomicAdd(&cnt[F.tid], hist[F.tid]) : 0u;
        __syncthreads();
        if (F.tid < 256) { const int i = F.tid, gi = tb * 256 + i, e = tmp_e[i];
            const int pos = (int)base[e] + tmp_p[i];
            meta[MT_SEL_E + gi] = e; meta[MT_SEL_POS + gi] = pos;
            el_tok[e * T + pos] = tb * 64 + (i >> 2); el_gate[e * T + pos] = tmp_g[i]; el_sa[e * T + pos] = tmp_s[i >> 2]; }
        __syncthreads();
    }
}
__device__ __forceinline__ void build_tables(const Frame& F, const Args& a) {
    const unsigned* cnt = (const unsigned*)(a.ws + WS_CTL) + CW_CNT;
    LAS int* tb = (LAS int*)(F.lds + RSCR_OFF);
    __syncthreads();
    if (F.tid < 32) tb[TBL_CNT + F.tid] = (int)__hip_atomic_load(cnt + F.tid, RLX_AGENT);
    __syncthreads();
    if (F.tid == 0) { int acc = 0; for (int e = 0; e < 32; ++e) { tb[TBL_TS + e] = acc; acc += (tb[TBL_CNT + e] + 255) >> 8; } tb[TBL_TS + 32] = acc; }
    __syncthreads();
    for (int t = F.tid; t < NT_MAX; t += NWAVES * 64) { int e = 0; for (int j = 1; j < 32; ++j) if (t >= tb[TBL_TS + j]) e = j; tb[TBL_TILE + t] = e; }
    __syncthreads();
}
__device__ __forceinline__ void p7_quant(const Frame& F, const Args& a) {
    const bf16* HID = (const bf16*)(a.ws + WS_HID); signed char* H8 = (signed char*)(a.ws + WS_HID8); float* row_sb = (float*)(a.ws + WS_ROWSB);
    const int nrows = __builtin_amdgcn_readfirstlane(((const LAS int*)(F.lds + RSCR_OFF))[TBL_TS + 32]) * 256;
    const int gw = F.vcu * NWAVES + F.wave, NGW = F.G * NWAVES, lane = F.lane;
    for (int r0 = gw * 4; r0 < nrows; r0 += NGW * 4) {
        u32x4 v[4][2];
#pragma unroll
        for (int i = 0; i < 4; ++i)
#pragma unroll
            for (int j = 0; j < 2; ++j) v[i][j] = __builtin_nontemporal_load((const u32x4*)(HID + (size_t)(r0 + i) * DFF + 512 * j) + lane);
#pragma unroll
        for (int i = 0; i < 4; ++i) {
            float f[16]; float am = 0.f;
#pragma unroll
            for (int j = 0; j < 2; ++j)
#pragma unroll
                for (int c = 0; c < 4; ++c) { const unsigned w = v[i][j][c]; f[8 * j + 2 * c] = __uint_as_float(w << 16); f[8 * j + 2 * c + 1] = __uint_as_float(w & 0xffff0000u); }
#pragma unroll
            for (int c = 0; c < 16; ++c) am = fmaxf(am, fabsf(f[c]));
            am = xmax(am);
            const float inv = am > 0.f ? 127.0f / am : 0.f;
#pragma unroll
            for (int j = 0; j < 2; ++j) {
                u32x2 o; o.x = 0u; o.y = 0u;
#pragma unroll
                for (int c = 0; c < 4; ++c) { o.x |= ((unsigned)(int)rintf(f[8 * j + c] * inv) & 0xffu) << (8 * c); o.y |= ((unsigned)(int)rintf(f[8 * j + 4 + c] * inv) & 0xffu) << (8 * c); }
                *((u32x2*)(H8 + (size_t)(r0 + i) * DFF + 512 * j) + lane) = o;
            }
            if (lane == 0) row_sb[r0 + i] = am * (1.0f / 127.0f);
        }
    }
}
__device__ __forceinline__ void p8_final(const Frame& F, const Args& a) {
    const bf16* Hin = (const bf16*)(a.ws + WS_H); float* HO = a.out; const unsigned char* Y = (const unsigned char*)(a.ws + WS_Y); const int* meta = (const int*)(a.ws + WS_META);
    const float* ln2_g = a.in[20]; const float* ln2_b = a.in[21]; const LAS int* tsl = (const LAS int*)(F.lds + RSCR_OFF) + TBL_TS;
    const int gw = F.vcu * NWAVES + F.wave, NGW = F.G * NWAVES, lane = F.lane;
    f32x4 g2[4], b2[4];
#pragma unroll
    for (int j = 0; j < 4; ++j) { g2[j] = *(const f32x4*)(ln2_g + 4 * lane + 256 * j); b2[j] = *(const f32x4*)(ln2_b + 4 * lane + 256 * j); }
    for (int tok = gw; tok < T; tok += NGW) {
        f32x4* hr = (f32x4*)(HO + (size_t)tok * D) + lane; const u32x2* hi_ = (const u32x2*)(Hin + (size_t)tok * D) + lane;
        f32x4 v[4]; float s = 0.f;
#pragma unroll
        for (int j = 0; j < 4; ++j) { const u32x2 hh = __builtin_nontemporal_load(hi_ + 64 * j); v[j] = (f32x4){__uint_as_float(hh.x << 16), __uint_as_float(hh.x & 0xffff0000u), __uint_as_float(hh.y << 16), __uint_as_float(hh.y & 0xffff0000u)} * ALPHA; }
#pragma unroll
        for (int k = 0; k < 4; ++k) {
            const int row = tsl[meta[MT_SEL_E + tok * 4 + k]] * 256 + meta[MT_SEL_POS + tok * 4 + k];
            const unsigned* yr = (const unsigned*)(Y + (size_t)row * D) + lane;
#pragma unroll
            for (int j = 0; j < 4; ++j) { const int y = (int)__builtin_nontemporal_load(yr + 64 * j); const f32x2 lo = __builtin_amdgcn_cvt_pk_f32_fp8(y, false), hi2 = __builtin_amdgcn_cvt_pk_f32_fp8(y, true);
                v[j].x += lo.x * (1.0f / YSCALE); v[j].y += lo.y * (1.0f / YSCALE); v[j].z += hi2.x * (1.0f / YSCALE); v[j].w += hi2.y * (1.0f / YSCALE); }
        }
#pragma unroll
        for (int j = 0; j < 4; ++j) s += (v[j].x + v[j].y) + (v[j].z + v[j].w);
        const float mean = xsum(s) * (1.f / D); float s2 = 0.f;
#pragma unroll
        for (int j = 0; j < 4; ++j) { v[j] = v[j] - mean; s2 += (v[j].x * v[j].x + v[j].y * v[j].y) + (v[j].z * v[j].z + v[j].w * v[j].w); }
        const float rstd = rsqrtf(xsum(s2) * (1.f / D) + LN_EPS);
#pragma unroll
        for (int j = 0; j < 4; ++j) hr[64 * j] = v[j] * rstd * g2[j] + b2[j];
    }
}
__global__ void __launch_bounds__(NWAVES * 64, 2) mk_fwd(Args args) {
    extern __shared__ __attribute__((aligned(16))) unsigned char lds_raw[];
    Frame F;
    F.lds = (LAS unsigned char*)lds_raw;
    F.tid = threadIdx.x; F.lane = F.tid & 63; F.wave = __builtin_amdgcn_readfirstlane(F.tid >> 6);
    F.G = gridDim.x; { const int bx = blockIdx.x; F.vcu = (F.G % 8 == 0) ? (bx % 8) * (F.G / 8) + bx / 8 : bx; }
    volatile LAS unsigned* MISC = (volatile LAS unsigned*)(F.lds + MISC_OFF);
    if (F.tid < 64) MISC[F.tid] = 0u;
    __syncthreads();
    unsigned char* ws = args.ws;
    unsigned* ctl = (unsigned*)(ws + WS_CTL);
    const int lo = args.ph_lo, hi = args.ph_hi;
    XcdBarrier bar; bar.bar = ctl + CW_BAR + args.li * XCD_BAR_WORDS; bar.x = 0; bar.st = nullptr;
    if (hi - lo > 1) bar = xcd_barrier_post(ctl + CW_BAR + args.li * XCD_BAR_WORDS, MISC + 8);
#define IN(k) (lo <= (k) && (k) < hi)
#define OPAQUE_F(Fp) Frame Fp = F; asm volatile("" : "+v"(Fp.tid)); Fp.lane = Fp.tid & 63
#define SEAM(k) do { if (IN(k) && IN((k) + 1)) xcd_barrier(bar); } while (0)
    int* meta = (int*)(ws + WS_META);
    bf16 *XB = (bf16*)(ws + WS_XB), *QB = (bf16*)(ws + WS_QB), *KB = (bf16*)(ws + WS_KB), *VT = (bf16*)(ws + WS_VT), *UB = (bf16*)(ws + WS_UB), *GB = (bf16*)(ws + WS_GB);
    bf16 *CAT = (bf16*)(ws + WS_CAT), *HB = (bf16*)(ws + WS_HB), *Y = (bf16*)(ws + WS_Y), *HID = (bf16*)(ws + WS_HID);
    bf16 *Win_t = (bf16*)(ws + WS_WIN), *Wout_t = (bf16*)(ws + WS_WOUT), *Wgu_t = (bf16*)(ws + WS_WGU), *Wd_t = (bf16*)(ws + WS_WD);
    const LAS int* rtab = (const LAS int*)(F.lds + RTAB_OFF);
    const bool par = ((blockIdx.x >> 3) & 1) != 0;

    if (IN(0)) { OPAQUE_F(Fp); p0_prologue(Fp, args); SEAM(0); }
    if (IN(1)) {
        const int c = (int)blockIdx.x, grp = (c >> 3) % 3;
        const int per_ = (3 * NEXP * 32 + F.G - 1) / F.G;
        const int it_lo = F.G == 256 ? (c < 192 ? c * 10 : 1920 + (c - 192) * 18) : c * per_, it_hi = F.G == 256 ? it_lo + (c < 192 ? 10 : 18) : it_lo + per_;
        OPAQUE_F(Fp);
        if (grp == 0) conv_items(Fp, args, it_lo, it_hi);
        { pg8::Gemm g{XB, Win_t, 2 * D, nullptr, 0u}; pg8::StaticOrder S; S.init(T / 256, INW / 256, F.G, c); S.i1 = 1;
          pg8::EpiInProj E{args.in[2], QB, KB, VT, UB, GB};
          pg8::gemm_phase<pg8::EpiInProj, false, true, false>(F.lds, rtab, g, S, E); }
        if (grp == 1) conv_items(Fp, args, it_lo, it_hi);
        { pg8::Gemm g{XB, Win_t, 2 * D, nullptr, 0u}; pg8::StaticOrder S; S.init(T / 256, INW / 256, F.G, c); S.i0 = 1;
          pg8::EpiInProj E{args.in[2], QB, KB, VT, UB, GB};
          pg8::gemm_phase<pg8::EpiInProj, false, true, false>(F.lds, rtab, g, S, E); }
        if (grp == 2) conv_items(Fp, args, it_lo, it_hi);
        SEAM(1);
    }
    if (IN(2)) { OPAQUE_F(Fp); p2_mixers(Fp, args); SEAM(2); }
    if (IN(3)) {
        pg8::Gemm g{CAT, Wout_t, 2 * D, nullptr, 0u}; pg8::StaticOrder S; S.init(T / 256, D / 256, F.G, (int)blockIdx.x);
        pg8::EpiOutProj E{args.in[0], args.in[9], args.out};
        pg8::gemm_phase<pg8::EpiOutProj, false, false, false>(F.lds, rtab, g, S, E);
        SEAM(3);
    }
    if (IN(4)) { OPAQUE_F(Fp); p4_router(Fp, args, true); if (hi > 5) xcd_barrier(bar); }
    const LAS int* tbl = (const LAS int*)(F.lds + RSCR_OFF);
    if (hi > 5) { OPAQUE_F(Fp); build_tables(Fp, args); }
    if (IN(6)) {
        const int nT = __builtin_amdgcn_readfirstlane(tbl[TBL_TS + 32]);
        pg8::StaticOrder S; S.init(nT, 2 * DFF / 256, F.G, (int)blockIdx.x);
        { pg8::Unit u; LAS int* rt = (LAS int*)(F.lds + RTAB_OFF); const int* el_tok = (const int*)(ws + WS_ELIST);
          for (int i = 0; i < RTAB_UNITS && S.next(i, u); ++i) if (F.tid < 256) { const int e = tbl[TBL_TILE + u.pm], ix = (u.pm - tbl[TBL_TS + e]) * 256 + F.tid; rt[i * 256 + F.tid] = ix < tbl[TBL_CNT + e] ? el_tok[e * T + ix] : 0; }
          __syncthreads(); }
        pg8::Gemm g{HB, Wgu_t, D, tbl + TBL_TILE, 2048u * 1024u};
        pg8::EpiSwiglu E{tbl, args.in[15], args.in[17], (const float*)(ws + WS_SWGU), (const float*)(ws + WS_ELIST) + 2 * NEXP * T, HID};
        pg8::gemm_phase<pg8::EpiSwiglu, true, true, true>(F.lds, rtab, g, S, E);
        SEAM(6);
    }
    if (IN(7)) { OPAQUE_F(Fp); p7_quant(Fp, args); SEAM(7); }
    if (IN(8)) {
        const int nT = __builtin_amdgcn_readfirstlane(tbl[TBL_TS + 32]);
        pg8::StaticOrder S; S.init(nT, D / 256, F.G, (int)blockIdx.x);
        pg8::Gemm g{ws + WS_HID8, Wd_t, DFF, tbl + TBL_TILE, 1024u * 1024u};
        pg8::EpiDown E{tbl, args.in[19], (const float*)(ws + WS_SWD), (const float*)(ws + WS_ROWSB), (const float*)(ws + WS_ELIST) + NEXP * T, (unsigned char*)Y};
        pg8::gemm_phase<pg8::EpiDown, false, true, true>(F.lds, rtab, g, S, E);
        SEAM(8);
    }
    if (IN(9)) { OPAQUE_F(Fp); p8_final(Fp, args); }
#undef IN
#undef SEAM
}

extern "C" void kernel_launch(void* const* d_in, const int* in_sizes, int n_in, void* d_out, int out_size, void* d_ws, size_t ws_size, hipStream_t stream) {
    static int grid = 0;
    if (grid == 0) {
        if (n_in != 22 || in_sizes[0] != T * D || out_size != T * D || ws_size < WS_END) { fprintf(stderr, "kernel_launch: unexpected shapes (n_in %d, in0 %d, out %d, ws %zu, need %zu)\n", n_in, n_in > 0 ? in_sizes[0] : -1, out_size, ws_size, (size_t)WS_END); grid = -1; return; }
        int dev = 0, cus = 0;
        if (hipGetDevice(&dev) != hipSuccess || hipDeviceGetAttribute(&cus, hipDeviceAttributeMultiprocessorCount, dev) != hipSuccess) { grid = -1; return; }
        if (hipFuncSetAttribute((const void*)mk_fwd, hipFuncAttributeMaxDynamicSharedMemorySize, LDS_BYTES) != hipSuccess) { fprintf(stderr, "kernel_launch: hipFuncSetAttribute failed\n"); grid = -1; return; }
        int per_cu = 0;
        if (hipOccupancyMaxActiveBlocksPerMultiprocessor(&per_cu, (const void*)mk_fwd, NWAVES * 64, LDS_BYTES) != hipSuccess || per_cu < 1) fprintf(stderr, "kernel_launch: occupancy query reports %d\n", per_cu);
        (void)hipGetLastError();
        grid = cus;
    }
    if (grid < 0) return;
    unsigned char* ws = (unsigned char*)d_ws; float* out = (float*)d_out;
    (void)hipMemsetAsync(ws + WS_CTL, 0, 64 * 1024, stream);
    Args a{};
    for (int i = 0; i < 22; ++i) a.in[i] = (const float*)d_in[i];
    a.out = out; a.ws = ws;
    a.ph_lo = 0; a.ph_hi = NPHASES; a.li = 0;
    hipLaunchKernelGGL(mk_fwd, dim3(grid), dim3(NWAVES * 64), LDS_BYTES, stream, a);
}
```

```cpp
#include <hip/hip_runtime.h>
#include <cstdio>
#include <cstdint>

typedef unsigned short bf16;
typedef float f32x4 __attribute__((ext_vector_type(4)));
typedef unsigned u32x4 __attribute__((ext_vector_type(4)));
typedef unsigned u32x2 __attribute__((ext_vector_type(2)));

constexpr int BATCH = 2, SEQ = 8192, D = 1024, T = BATCH * SEQ;
constexpr int NQH = 8, NKVH = 2, HD = 64, QREP = 4, AW = 512, KVW = 128, GW = 512, INW = 1792;
constexpr int NEXP = 32, TOPK = 4, DFF = 1024;
constexpr int NT_MAX = T * TOPK / 256 + NEXP;
constexpr int NROWS_MAX = NT_MAX * 256;
constexpr float LN_EPS = 1e-5f;
constexpr float ALPHA = 1.189207115002721f;
constexpr float C2 = 0.125f * 1.4426950408889634f;
constexpr float LOG2E = 1.4426950408889634f;
constexpr float HSCALE = 4.0f;
constexpr float WDMAX = 440.0f;
constexpr float YSCALE = 16.0f;

constexpr size_t MiB = 1u << 20;
constexpr size_t WS_CTL = 0;
constexpr size_t WS_META = 1 * MiB;
constexpr size_t WS_XB = 3 * MiB;
constexpr size_t WS_QB = WS_XB + 32 * MiB;
constexpr size_t WS_KB = WS_QB + 16 * MiB;
constexpr size_t WS_VT = WS_KB + 4 * MiB;
constexpr size_t WS_UB = WS_VT + 4 * MiB;
constexpr size_t WS_GB = WS_UB + 16 * MiB;
constexpr size_t WS_CAT = WS_GB + 16 * MiB;
constexpr size_t WS_HB = WS_CAT + 32 * MiB;
constexpr size_t WS_H = WS_XB;
constexpr size_t WS_HID = WS_HB + 32 * MiB;
constexpr size_t WS_Y = WS_HID;
static_assert(WS_H + 64 * MiB <= WS_CAT, "H overlay");

constexpr int CW_CNT = 64;
constexpr int MT_NT = 0;
constexpr int MT_TSTART = 16;
constexpr int MT_TILE_E = 64;
constexpr int MT_SEL_E = 1024;
constexpr int MT_SEL_POS = MT_SEL_E + T * 4;
constexpr int MT_SEL_G = MT_SEL_POS + T * 4;
constexpr int MT_SLOT_ROW = MT_SEL_G + T * 4;
constexpr int MT_ROW_TOK = MT_SLOT_ROW + T * 4;
constexpr int MT_ROW_GATE = MT_ROW_TOK + NROWS_MAX;
constexpr int MT_ROW_SA = MT_ROW_GATE + NROWS_MAX;
constexpr int MT_SH = MT_ROW_SA + NROWS_MAX;
constexpr size_t WS_ELIST = WS_GB;
constexpr int TBL_CNT = 0, TBL_TS = 32, TBL_TILE = 72;
constexpr size_t WS_ROWSB = 512 * 1024;
static_assert((size_t)(MT_SH + T) * 4 <= 2 * MiB, "meta");

__device__ __forceinline__ float bf2f(bf16 v) { return __uint_as_float((unsigned)v << 16); }
__device__ __forceinline__ unsigned f2bf(float f) { unsigned u = __float_as_uint(f); return (u + 0x7fffu + ((u >> 16) & 1u)) >> 16; }
__device__ __forceinline__ unsigned pk2(float lo, float hi) { return f2bf(lo) | (f2bf(hi) << 16); }
__device__ __forceinline__ float gelu_tanh(float x) {
    const float k2 = 2.0f * 0.7978845608028654f;
    const float u = k2 * (x + 0.044715f * x * x * x);
    return x / (1.0f + __expf(-u));
}
__device__ __forceinline__ float wave_sum(float v) {
#pragma unroll
    for (int o = 1; o < 64; o <<= 1) v += __shfl_xor(v, o);
    return v;
}
__device__ __forceinline__ float wave_max(float v) {
#pragma unroll
    for (int o = 1; o < 64; o <<= 1) v = fmaxf(v, __shfl_xor(v, o));
    return v;
}

#define LAS __attribute__((address_space(3)))
#define GAS __attribute__((address_space(1)))
typedef short bf16x8 __attribute__((ext_vector_type(8)));
typedef float f32x16 __attribute__((ext_vector_type(16)));
typedef float f32x2 __attribute__((ext_vector_type(2)));
__device__ __forceinline__ unsigned cvt_pk_bf16(float lo, float hi) { unsigned r; asm volatile("v_cvt_pk_bf16_f32 %0, %1, %2" : "=v"(r) : "v"(lo), "v"(hi)); return r; }
__device__ __forceinline__ float fast_gelu(float x) {
    const float u = -2.0f * 0.7978845608028654f * LOG2E * (x + 0.044715f * x * x * x);
    return x * __builtin_amdgcn_rcpf(1.0f + __builtin_amdgcn_exp2f(u));
}
__device__ __forceinline__ void st16_wt(void* p, u32x4 v) {
    *(u32x4*)p = v;
}
namespace pg8 {
constexpr int BM = 256, BK = 64, HALF = 128, HTB = HALF * BK * 2  , STAGE_BYTES = 8 * HTB, NXCD = 8, WGM = 8;
__host__ __device__ __forceinline__ int lds_byte(int r, int c) { const int st = (r >> 4) * 2 + (c >> 5), rr = r & 15, cc = c & 31, ob = rr * 64 + cc * 2; return st * 1024 + (ob ^ (((ob >> 9) & 1) << 5)); }
__host__ __device__ __forceinline__ void stage_rc(int b, int& R, int& C) { const int st = b / 1024, sb = b % 1024, swz = sb ^ (((sb >> 9) & 1) << 5); R = (st >> 1) * 16 + swz / 64; C = (st & 1) * 32 + (swz % 64) / 2; }
__host__ __device__ __forceinline__ int perm32(int rho) { const int n = rho >> 4, i = rho & 15; return 8 * (i >> 2) + 4 * n + (i & 3); }

struct Unit { int pm, pn; };
struct Gemm { const void* A; const void* Bt; int KB; const LAS int* tile_e; unsigned e_stride; };
typedef int i32x4 __attribute__((ext_vector_type(4)));

struct StaticOrder {
    int nM, nN, nwg, G, c, i0 = 0, i1 = 1 << 30;
    __device__ void init(int nM_, int nN_, int G_, int c_) { nM = nM_; nN = nN_; nwg = nM * nN; G = G_; c = c_; }
    __device__ bool next(int i, Unit& u) const {
        i += i0; if (i >= i1) return false;
        const long L = (long)i * G + c; if (L >= nwg) return false;
        int wgid = (int)L; { const int q = nwg / NXCD, r = nwg % NXCD, xcd = wgid % NXCD, off = wgid / NXCD; wgid = (xcd < r ? xcd * (q + 1) : r * (q + 1) + (xcd - r) * q) + off; }
        const int nig = WGM * nN, gid = wgid / nig, fm = gid * WGM, gsz = (nM - fm) < WGM ? (nM - fm) : WGM;
        u.pm = fm + ((wgid % nig) % gsz); u.pn = (wgid % nig) / gsz; return true;
    }
};

template <class Epi, bool GATHER, bool ALIGN_EPI, int I8>
__device__ __forceinline__ void gemm_phase(LAS unsigned char* lds, const LAS int* rtab, const Gemm g, const StaticOrder& S, const Epi& E) {
    int tid_ = threadIdx.x; asm volatile("" : "+v"(tid_));
    const int tid = tid_, wid = __builtin_amdgcn_readfirstlane(tid >> 6), lane = tid & 63, wr = wid >> 2, wc = wid & 3, fr = lane & 15, fq = lane >> 4;
    const int KB = g.KB, nt = KB / (BK * 2);
    int Rs[2], Cs[2]; unsigned voffB[2];
#pragma unroll
    for (int i = 0; i < 2; ++i) { int R, C; stage_rc(tid * 16 + i * 8192, R, C); const int Rb = Epi::PERM == 2 ? (64 * (R >> 5) + 16 * ((R >> 2) & 3) + 4 * ((R >> 4) & 1) + (R & 3)) : Epi::PERM ? ((R & ~31) + perm32(R & 31)) : R; Rs[i] = R; Cs[i] = C; voffB[i] = (unsigned)(Rb * KB + C * 2); }
    const unsigned kstep = (unsigned)(BK * 2);
    const unsigned hstep = (unsigned)HALF * KB;
    const unsigned tstep = 2 * hstep;
    const unsigned bhstep = Epi::PERM == 2 ? (unsigned)8 * KB : hstep;
    const unsigned ldsw = (unsigned)wid * 1024u;
    const int aoff = lds_byte(wr * 64 + fr, fq * 8), boff = lds_byte(wc * 32 + fr, fq * 8);
#define PG8_SA(b, h) (((b) * 2 + (h)) * HTB)
#define PG8_SB(b, h) ((4 + (b) * 2 + (h)) * HTB)
#define PG8_STAGE(bufoff, rs, soff, voff) do { _Pragma("unroll") for (int _i = 0; _i < 2; ++_i) \
        __builtin_amdgcn_raw_ptr_buffer_load_lds(rs, (LAS void*)(lds + (bufoff) + ldsw + _i * 8192), 16, (int)(voff)[_i], (int)(soff), 0, 0); } while (0)
#define PG8_LDA(dst, b, h) do { _Pragma("unroll") for (int m = 0; m < 4; ++m) _Pragma("unroll") for (int k = 0; k < 2; ++k) dst[m][k] = *(const LAS bf16x8*)(lds + PG8_SA(b, h) + aoff + m * 2048 + k * 1024); } while (0)
#define PG8_LDB(dst, b, h) do { _Pragma("unroll") for (int n = 0; n < 2; ++n) _Pragma("unroll") for (int k = 0; k < 2; ++k) dst[n][k] = *(const LAS bf16x8*)(lds + PG8_SB(b, h) + boff + n * 2048 + k * 1024); } while (0)
#define PG8_MMA(ai, bj, At, Bt) do { __builtin_amdgcn_s_setprio(1); _Pragma("unroll") for (int m = 0; m < 4; ++m) _Pragma("unroll") for (int n = 0; n < 2; ++n) _Pragma("unroll") for (int k = 0; k < 2; ++k) \
        { if constexpr (I8 == 2) { if (k == 0) acc[ai][bj][m][n] = __builtin_amdgcn_mfma_scale_f32_16x16x128_f8f6f4( \
              __builtin_shufflevector(__builtin_bit_cast(i32x4, Bt[n][0]), __builtin_bit_cast(i32x4, Bt[n][1]), 0, 1, 2, 3, 4, 5, 6, 7), \
              __builtin_shufflevector(__builtin_bit_cast(i32x4, At[m][0]), __builtin_bit_cast(i32x4, At[m][1]), 0, 1, 2, 3, 4, 5, 6, 7), acc[ai][bj][m][n], 0, 0, 0, 0, 0, 0); } \
          else if constexpr (I8 == 1) acc[ai][bj][m][n] = __builtin_bit_cast(f32x4, __builtin_amdgcn_mfma_i32_16x16x64_i8(__builtin_bit_cast(i32x4, Bt[n][k]), __builtin_bit_cast(i32x4, At[m][k]), __builtin_bit_cast(i32x4, acc[ai][bj][m][n]), 0, 0, 0)); \
          else acc[ai][bj][m][n] = __builtin_amdgcn_mfma_f32_16x16x32_bf16(Bt[n][k], At[m][k], acc[ai][bj][m][n], 0, 0, 0); } __builtin_amdgcn_s_setprio(0); } while (0)
#define PG8_WAIT_V(n) asm volatile("s_waitcnt vmcnt(" #n ")" ::: "memory")
#define PG8_WAIT_L(n) asm volatile("s_waitcnt lgkmcnt(" #n ")" ::: "memory")
#define PG8_BAR __builtin_amdgcn_s_barrier()
#define PG8_SCHED __builtin_amdgcn_sched_barrier(0)
#define PG8_VOFFA(vo, ui_, u_) do { _Pragma("unroll") for (int h_ = 0; h_ < 2; ++h_) _Pragma("unroll") for (int i_ = 0; i_ < 2; ++i_) { \
        const int row_ = GATHER ? rtab[(ui_) * 256 + h_ * 128 + Rs[i_]] : Rs[i_]; \
        vo[h_][i_] = (unsigned)(row_ * KB + Cs[i_] * 2); } } while (0)
#define PG8_ABASE(u_) (GATHER ? 0u : (unsigned)(u_).pm * tstep)
#define PG8_AH(p_) ((p_) + (GATHER ? 0u : hstep))
#define PG8_BBASE(u_) ((g.tile_e ? (unsigned)__builtin_amdgcn_readfirstlane(g.tile_e[(u_).pm]) * g.e_stride : 0u) + (unsigned)(u_).pn * tstep)
    Unit cur, nxt; int ui = 0;
    if (!S.next(0, cur)) return;
    f32x4 acc[2][2][4][2];
    if constexpr (Epi::HAS_INIT) E.init(acc, cur, wr, wc, fr, fq);
    else {
#pragma unroll
    for (int a = 0; a < 2; ++a)
#pragma unroll
        for (int b = 0; b < 2; ++b)
#pragma unroll
            for (int m = 0; m < 4; ++m)
#pragma unroll
                for (int n = 0; n < 2; ++n) acc[a][b][m][n] = (f32x4){0.f, 0.f, 0.f, 0.f};
    }
    bf16x8 At[4][2], B0[2][2], B1[2][2];
    unsigned vAc[2][2], vAn[2][2];
    PG8_VOFFA(vAc, 0, cur);
    const __amdgpu_buffer_rsrc_t rsA = __builtin_amdgcn_make_buffer_rsrc((void*)g.A, (short)0, 0x7fffffff, 0x00020000), rsB = __builtin_amdgcn_make_buffer_rsrc((void*)g.Bt, (short)0, 0x7fffffff, 0x00020000);
    unsigned cA = PG8_ABASE(cur);
    unsigned cB = PG8_BBASE(cur);
    PG8_STAGE(PG8_SB(0, 0), rsB, cB, voffB); PG8_STAGE(PG8_SB(0, 1), rsB, cB + bhstep, voffB); PG8_STAGE(PG8_SA(0, 0), rsA, cA, vAc[0]); PG8_STAGE(PG8_SA(0, 1), rsA, PG8_AH(cA), vAc[1]);
    if (wr == 1) PG8_BAR;
    PG8_WAIT_V(2); PG8_BAR;
    PG8_STAGE(PG8_SB(1, 0), rsB, cB + kstep, voffB); PG8_STAGE(PG8_SA(1, 0), rsA, cA + kstep, vAc[0]); PG8_STAGE(PG8_SB(1, 1), rsB, cB + bhstep + kstep, voffB);
    PG8_WAIT_V(6); PG8_BAR;
    for (;;) {
        const bool has_next = S.next(ui + 1, nxt);
        unsigned nB = cB, nA = cA;
        if (has_next) { nB = PG8_BBASE(nxt); nA = PG8_ABASE(nxt); PG8_VOFFA(vAn, ui + 1, nxt); }
        else {
#pragma unroll
            for (int h = 0; h < 2; ++h)
#pragma unroll
                for (int i = 0; i < 2; ++i) vAn[h][i] = vAc[h][i];
        }
        for (int t = 0; t < nt; t += 2) {
            const bool last = (t == nt - 2);
            const unsigned a1 = cA + (unsigned)(t + 1) * kstep;
            const unsigned a2 = last ? nA : cA + (unsigned)(t + 2) * kstep, b2 = last ? nB : cB + (unsigned)(t + 2) * kstep;
            const unsigned a3 = a2 + kstep, b3 = b2 + kstep;
            unsigned v2[2][2];
#pragma unroll
            for (int h = 0; h < 2; ++h)
#pragma unroll
                for (int i = 0; i < 2; ++i) v2[h][i] = last ? vAn[h][i] : vAc[h][i];
            PG8_LDB(B0, 0, 0); PG8_LDB(B1, 0, 1); PG8_SCHED; PG8_LDA(At, 0, 0); PG8_STAGE(PG8_SA(1, 1), rsA, PG8_AH(a1), vAc[1]);
            PG8_WAIT_V(8); PG8_WAIT_L(0); PG8_BAR; PG8_MMA(0, 0, At, B0); PG8_MMA(0, 1, At, B1); PG8_BAR; PG8_SCHED;
            PG8_LDA(At, 0, 1); PG8_STAGE(PG8_SB(0, 0), rsB, b2, voffB); PG8_STAGE(PG8_SB(0, 1), rsB, b2 + bhstep, voffB); PG8_STAGE(PG8_SA(0, 0), rsA, a2, v2[0]);
            PG8_WAIT_V(8); PG8_WAIT_L(0); PG8_BAR; PG8_MMA(1, 0, At, B0); PG8_MMA(1, 1, At, B1); PG8_BAR; PG8_SCHED;
            PG8_LDB(B0, 1, 0); PG8_LDB(B1, 1, 1); PG8_SCHED; PG8_LDA(At, 1, 0); PG8_STAGE(PG8_SA(0, 1), rsA, PG8_AH(a2), v2[1]);
            PG8_WAIT_V(8); PG8_WAIT_L(0); PG8_BAR; PG8_MMA(0, 0, At, B0); PG8_MMA(0, 1, At, B1); PG8_BAR; PG8_SCHED;
            PG8_LDA(At, 1, 1); PG8_STAGE(PG8_SB(1, 0), rsB, b3, voffB); PG8_STAGE(PG8_SB(1, 1), rsB, b3 + bhstep, voffB); PG8_STAGE(PG8_SA(1, 0), rsA, a3, v2[0]);
            PG8_WAIT_V(8); PG8_WAIT_L(0); PG8_BAR; PG8_MMA(1, 0, At, B0); PG8_MMA(1, 1, At, B1); PG8_BAR; PG8_SCHED;
        }
        if constexpr (ALIGN_EPI) { if (wr == 0) PG8_BAR; }
        E(acc, cur, wr, wc, fr, fq);
        if (!has_next) break;
        if constexpr (Epi::HAS_INIT) E.init(acc, nxt, wr, wc, fr, fq);
        else {
#pragma unroll
        for (int a = 0; a < 2; ++a)
#pragma unroll
            for (int b = 0; b < 2; ++b)
#pragma unroll
                for (int m = 0; m < 4; ++m)
#pragma unroll
                    for (int n = 0; n < 2; ++n) acc[a][b][m][n] = (f32x4){0.f, 0.f, 0.f, 0.f};
        }
        cur = nxt; cB = nB; cA = nA; ++ui;
#pragma unroll
        for (int h = 0; h < 2; ++h)
#pragma unroll
            for (int i = 0; i < 2; ++i) vAc[h][i] = vAn[h][i];
        if constexpr (ALIGN_EPI) { if (wr == 1) PG8_BAR; }
    }
    PG8_WAIT_V(0);
    if constexpr (!ALIGN_EPI) { if (wr == 0) PG8_BAR; }
    PG8_BAR;
#undef PG8_SA
#undef PG8_SB
#undef PG8_STAGE
#undef PG8_LDA
#undef PG8_LDB
#undef PG8_MMA
#undef PG8_WAIT_V
#undef PG8_WAIT_L
#undef PG8_BAR
#undef PG8_SCHED
#undef PG8_VOFFA
#undef PG8_BBASE
#undef PG8_ABASE
#undef PG8_AH
}

struct EpiInProj {
    static constexpr int PERM = 1; static constexpr bool HAS_INIT = false;
    const float* b_in; bf16 *QB, *KB, *VT, *UB, *GB;
    __device__ __forceinline__ void operator()(const f32x4 (&acc)[2][2][4][2], const Unit& u, int wr, int wc, int fr, int fq) const {
        const int row0 = u.pm * BM + wr * 64 + fr;
#pragma unroll
        for (int bj = 0; bj < 2; ++bj) {
            const int reg = u.pn * BM + bj * HALF;
            const int c0 = reg + wc * 32 + 8 * fq;
            const f32x4 bv0 = *(const f32x4*)(b_in + c0), bv1 = *(const f32x4*)(b_in + c0 + 4);
#pragma unroll
            for (int ai = 0; ai < 2; ++ai)
#pragma unroll
                for (int m = 0; m < 4; ++m) {
                    const int row = row0 + ai * HALF + m * 16;
                    f32x4 v0 = acc[ai][bj][m][0] + bv0, v1 = acc[ai][bj][m][1] + bv1;
                    if (reg >= 640 && reg < 768) {
                        const int cv = c0 - 640, gg = cv >> 6, d = cv & 63, b = row / SEQ, s = row % SEQ;
                        bf16* vp = VT + ((size_t)((b * 2 + gg) * 64 + d)) * SEQ + s;
#pragma unroll
                        for (int j = 0; j < 4; ++j) { vp[(size_t)j * SEQ] = (bf16)f2bf(v0[j]); vp[(size_t)(j + 4) * SEQ] = (bf16)f2bf(v1[j]); }
                    } else {
                        bf16* dst;
                        if (reg < 512) { v0 = v0 * C2; v1 = v1 * C2; dst = QB + (size_t)row * 512 + c0; }
                        else if (reg < 640) { dst = KB + (size_t)row * 128 + (c0 - 512); }
                        else {
#pragma unroll
                            for (int j = 0; j < 4; ++j) { v0[j] = fast_gelu(v0[j]); v1[j] = fast_gelu(v1[j]); }
                            dst = (reg < 1280) ? (UB + (size_t)row * 512 + (c0 - 768)) : (GB + (size_t)row * 512 + (c0 - 1280));
                        }
                        u32x4 w; w.x = cvt_pk_bf16(v0[0], v0[1]); w.y = cvt_pk_bf16(v0[2], v0[3]); w.z = cvt_pk_bf16(v1[0], v1[1]); w.w = cvt_pk_bf16(v1[2], v1[3]);
                        *(u32x4*)dst = w;
                    }
                }
        }
    }
};
struct EpiOutProj {
    static constexpr int PERM = 0; static constexpr bool HAS_INIT = true;
    const float* x; const float* b_out; float* Z;
    __device__ __forceinline__ void init(f32x4 (&acc)[2][2][4][2], const Unit& u, int wr, int wc, int fr, int fq) const {
        const int col0 = u.pn * BM + wc * 32 + 4 * fq;
#pragma unroll
        for (int ai = 0; ai < 2; ++ai)
#pragma unroll
            for (int m = 0; m < 4; ++m) {
                const size_t off = (size_t)(u.pm * BM + ai * HALF + wr * 64 + m * 16 + fr) * D + col0;
#pragma unroll
                for (int bj = 0; bj < 2; ++bj)
#pragma unroll
                    for (int n = 0; n < 2; ++n) acc[ai][bj][m][n] = __builtin_nontemporal_load((const f32x4*)(x + off + bj * HALF + n * 16)) * ALPHA + *(const f32x4*)(b_out + col0 + bj * HALF + n * 16);
            }
    }
    __device__ __forceinline__ void operator()(const f32x4 (&acc)[2][2][4][2], const Unit& u, int wr, int wc, int fr, int fq) const {
        const int col0 = u.pn * BM + wc * 32 + 4 * fq;
#pragma unroll
        for (int ai = 0; ai < 2; ++ai)
#pragma unroll
            for (int m = 0; m < 4; ++m) {
                const size_t off = (size_t)(u.pm * BM + ai * HALF + wr * 64 + m * 16 + fr) * D + col0;
#pragma unroll
                for (int bj = 0; bj < 2; ++bj)
#pragma unroll
                    for (int n = 0; n < 2; ++n) *(f32x4*)(Z + off + bj * HALF + n * 16) = acc[ai][bj][m][n];
            }
    }
};
struct EpiSwiglu {
    static constexpr int PERM = 1; static constexpr bool HAS_INIT = false;
    const LAS int* tbl; const float* b_gate; const float* b_up; const float* swgu; const float* el_sa; unsigned char* HID;
    __device__ __forceinline__ void operator()(const f32x4 (&acc)[2][2][4][2], const Unit& u, int wr, int wc, int fr, int fq) const {
        const int e = tbl[TBL_TILE + u.pm], p0 = (u.pm - tbl[TBL_TS + e]) * BM, ce = tbl[TBL_CNT + e];
        const int fc0 = u.pn * HALF + wc * 32 + 8 * fq;
        const float* sw = swgu + e * 2048 + u.pn * 256 + wc * 32 + 8 * fq;
        float sa[2][4];
#pragma unroll
        for (int ai = 0; ai < 2; ++ai)
#pragma unroll
            for (int m = 0; m < 4; ++m) { const int ix = p0 + ai * HALF + wr * 64 + m * 16 + fr; sa[ai][m] = ix < ce ? el_sa[e * T + ix] : 0.f; }
        f32x4 gb[2], ub[2], sg[2], su[2];
#pragma unroll
        for (int n = 0; n < 2; ++n) { gb[n] = *(const f32x4*)(b_gate + e * DFF + fc0 + 4 * n); ub[n] = *(const f32x4*)(b_up + e * DFF + fc0 + 4 * n); sg[n] = *(const f32x4*)(sw + 4 * n); su[n] = *(const f32x4*)(sw + 128 + 4 * n); }
#pragma unroll
        for (int ai = 0; ai < 2; ++ai)
#pragma unroll
            for (int m = 0; m < 4; ++m) {
                const int row = u.pm * BM + ai * HALF + wr * 64 + m * 16 + fr;
                float hv[8];
                const f32x2 sa2 = (f32x2){sa[ai][m], sa[ai][m]};
#pragma unroll
                for (int n = 0; n < 2; ++n)
#pragma unroll
                    for (int jp = 0; jp < 2; ++jp) {
                        const f32x2 gi = (f32x2){(float)__float_as_int(acc[ai][0][m][n][2 * jp]), (float)__float_as_int(acc[ai][0][m][n][2 * jp + 1])};
                        const f32x2 ui = (f32x2){(float)__float_as_int(acc[ai][1][m][n][2 * jp]), (float)__float_as_int(acc[ai][1][m][n][2 * jp + 1])};
                        const f32x2 sg2 = (f32x2){sg[n][2 * jp], sg[n][2 * jp + 1]}, su2 = (f32x2){su[n][2 * jp], su[n][2 * jp + 1]};
                        const f32x2 gb2 = (f32x2){gb[n][2 * jp], gb[n][2 * jp + 1]}, ub2 = (f32x2){ub[n][2 * jp], ub[n][2 * jp + 1]};
                        const f32x2 ga = __builtin_elementwise_fma(gi * sa2, sg2, gb2), ua = __builtin_elementwise_fma(ui * sa2, su2, ub2);
                        f32x2 gt, up;
                        gt.x = fminf(ga.x, 7.0f); gt.y = fminf(ga.y, 7.0f); up.x = __builtin_amdgcn_fmed3f(ua.x, -7.0f, 7.0f); up.y = __builtin_amdgcn_fmed3f(ua.y, -7.0f, 7.0f);
                        const f32x2 ex = gt * (-1.702f * LOG2E);
                        f32x2 en; en.x = __builtin_amdgcn_exp2f(ex.x); en.y = __builtin_amdgcn_exp2f(ex.y);
                        const f32x2 den = en + 1.0f, upp = up * HSCALE + HSCALE;
                        f32x2 rc; rc.x = __builtin_amdgcn_rcpf(den.x); rc.y = __builtin_amdgcn_rcpf(den.y);
                        const f32x2 hh = (gt * rc) * upp;
                        hv[4 * n + 2 * jp] = hh.x; hv[4 * n + 2 * jp + 1] = hh.y;
                    }
                int d0 = 0, d1 = 0;
                d0 = __builtin_amdgcn_cvt_pk_fp8_f32(hv[0], hv[1], d0, false); d0 = __builtin_amdgcn_cvt_pk_fp8_f32(hv[2], hv[3], d0, true);
                d1 = __builtin_amdgcn_cvt_pk_fp8_f32(hv[4], hv[5], d1, false); d1 = __builtin_amdgcn_cvt_pk_fp8_f32(hv[6], hv[7], d1, true);
                u32x2 w; w.x = (unsigned)d0; w.y = (unsigned)d1;
                *(u32x2*)(HID + (size_t)row * DFF + fc0) = w;
            }
    }
};
struct EpiDown {
    static constexpr int PERM = 2; static constexpr bool HAS_INIT = false;
    const LAS int* tbl; const float* b_down; const float* swd; const float* el_gate; unsigned char* Y;
    __device__ __forceinline__ void operator()(const f32x4 (&acc)[2][2][4][2], const Unit& u, int wr, int wc, int fr, int fq) const {
        const int e = tbl[TBL_TILE + u.pm], p0 = (u.pm - tbl[TBL_TS + e]) * BM, ce = tbl[TBL_CNT + e];
        const int c0 = u.pn * BM + wc * 64 + 16 * fq;
        f32x4 bv[2][2], sw[2][2];
#pragma unroll
        for (int bj = 0; bj < 2; ++bj)
#pragma unroll
            for (int n = 0; n < 2; ++n) { bv[bj][n] = *(const f32x4*)(b_down + e * D + c0 + 8 * bj + 4 * n); sw[bj][n] = *(const f32x4*)(swd + e * D + c0 + 8 * bj + 4 * n); }
#pragma unroll
        for (int ai = 0; ai < 2; ++ai)
#pragma unroll
            for (int m = 0; m < 4; ++m) {
                const int row = u.pm * BM + ai * HALF + wr * 64 + m * 16 + fr;
                const int ix = p0 + ai * HALF + wr * 64 + m * 16 + fr;
                const float gt = (ix < ce ? el_gate[e * T + ix] : 0.f) * YSCALE, sb = gt * (1.0f / HSCALE);
                u32x4 w;
#pragma unroll
                for (int bj = 0; bj < 2; ++bj)
#pragma unroll
                    for (int n = 0; n < 2; ++n) {
                        float v[4];
#pragma unroll
                        for (int jp = 0; jp < 2; ++jp) {
                            const f32x2 ci = (f32x2){acc[ai][bj][m][n][2 * jp], acc[ai][bj][m][n][2 * jp + 1]};
                            const f32x2 s2 = (f32x2){sw[bj][n][2 * jp], sw[bj][n][2 * jp + 1]} * sb, b2 = (f32x2){bv[bj][n][2 * jp], bv[bj][n][2 * jp + 1]} * gt;
                            const f32x2 r = __builtin_elementwise_fma(ci, s2, b2);
                            v[2 * jp] = __builtin_amdgcn_fmed3f(r.x, -448.0f, 448.0f); v[2 * jp + 1] = __builtin_amdgcn_fmed3f(r.y, -448.0f, 448.0f);
                        }
                        int d = 0;
                        d = __builtin_amdgcn_cvt_pk_fp8_f32(v[0], v[1], d, false);
                        d = __builtin_amdgcn_cvt_pk_fp8_f32(v[2], v[3], d, true);
                        w[2 * bj + n] = (unsigned)d;
                    }
                *(u32x4*)(Y + (size_t)row * D + c0) = w;
            }
    }
};
}
constexpr int NWAVES = 8;
constexpr int NPHASES = 10;
constexpr size_t WS_WIN = WS_HID + 144 * MiB;
constexpr size_t WS_WOUT = WS_WIN + 4 * MiB;
constexpr size_t WS_WGU = WS_WOUT + 2 * MiB;
constexpr size_t WS_SWGU = WS_WGU + 64 * MiB;
constexpr size_t WS_WD = WS_SWGU + 1 * MiB;
constexpr size_t WS_SWD = WS_WD + 32 * MiB;
constexpr size_t WS_HID8 = WS_SWD + 1 * MiB;
constexpr size_t WS_END = WS_HID8 + 72 * MiB;
constexpr int CW_BAR = 4096;
constexpr int RING_BYTES = 131072;
constexpr int RTAB_OFF = RING_BYTES;
constexpr int RTAB_UNITS = 12;
constexpr int RW_BYTES = 1024 * 144;
constexpr int RSCR_OFF = RW_BYTES;
constexpr int LDS_BYTES = 163840;
constexpr int MISC_OFF = LDS_BYTES - 256;
static_assert(RTAB_OFF + RTAB_UNITS * 1024 <= MISC_OFF && RSCR_OFF + 4096 <= MISC_OFF, "LDS map");

typedef GAS unsigned gu32;
#define RLX_AGENT __ATOMIC_RELAXED, __HIP_MEMORY_SCOPE_AGENT
#define LDS_WAIT() asm volatile("s_waitcnt lgkmcnt(0)" ::: "memory")
#define VM_WAIT() asm volatile("s_waitcnt vmcnt(0)" ::: "memory")

#define XB_TMO      128
#define XB_XCNT(j)  (256  + 64 * (j))
#define XB_XSUB(j)  (1280 + 64 * (j))
#define XB_XGEN(j)  (2304 + 64 * (j))
#define XB_TOP      3328
#define XB_TOPGEN   3392
#define XCD_BAR_WORDS 3456
#define XB_SPIN_CAP (1u << 18)
__device__ __forceinline__ unsigned xb_ld(unsigned* p)              { return __hip_atomic_load(p, __ATOMIC_RELAXED, __HIP_MEMORY_SCOPE_AGENT); }
__device__ __forceinline__ unsigned xb_add(unsigned* p, unsigned v) { return __hip_atomic_fetch_add(p, v, __ATOMIC_RELAXED, __HIP_MEMORY_SCOPE_AGENT); }
__device__ __forceinline__ unsigned xb_xcc_id() { return (unsigned)__builtin_amdgcn_s_getreg((3 << 11) | 20) & 0xFu; }
#define XB_SPIN(cond, bar) do { unsigned _sp = 0; while (cond) { __builtin_amdgcn_s_sleep(1); \
    if ((++_sp & 255u) == 0u) { if (xb_ld(&(bar)[XB_TMO])) break; if (_sp > XB_SPIN_CAP) { atomicAdd(&(bar)[XB_TMO], 1u); break; } } } } while (0)
struct XcdBarrier { unsigned* bar; unsigned x; volatile LAS unsigned* st; };
__device__ __forceinline__ XcdBarrier xcd_barrier_post(unsigned* bar, volatile LAS unsigned* st) {
    XcdBarrier b; b.bar = bar; b.x = xb_xcc_id(); b.st = st;
    if (threadIdx.x == 0) (void)xb_add(&bar[XB_XCNT(b.x)], 1u);
    return b;
}
__device__ __forceinline__ void xcd_barrier_complete(unsigned* bar, unsigned x, unsigned& nloc, unsigned& nx) {
    const unsigned G = gridDim.x * gridDim.y * gridDim.z;
    unsigned sum, cnt, mine, sp = 0u;
    for (;;) {
        sum = 0u; cnt = 0u; mine = 0u;
#pragma unroll
        for (unsigned j = 0; j < 16; ++j) { const unsigned c = xb_ld(&bar[XB_XCNT(j)]); sum += c; cnt += (c > 0u) ? 1u : 0u; mine = (j == x) ? c : mine; }
        if (sum == G) break;
        __builtin_amdgcn_s_sleep(1);
        if ((++sp & 255u) == 0u) { if (xb_ld(&bar[XB_TMO])) break; if (sp > XB_SPIN_CAP) { atomicAdd(&bar[XB_TMO], 1u); break; } }
    }
    nloc = mine > 0u ? mine : 1u; nx = cnt > 0u ? cnt : 1u;
}
__device__ __forceinline__ void xcd_barrier(const XcdBarrier& b) {
    asm volatile("s_waitcnt vmcnt(0)" ::: "memory");
    __syncthreads();
    if (threadIdx.x == 0) {
        unsigned* bar = b.bar;
        __builtin_amdgcn_s_waitcnt(0);
        unsigned nloc = b.st[0], nx = b.st[1];
        if (nloc == 0u) { xcd_barrier_complete(bar, b.x, nloc, nx); b.st[0] = nloc; b.st[1] = nx; }
        const unsigned old = xb_add(&bar[XB_XSUB(b.x)], 1u);
        const unsigned gen = old / nloc;
        if (old + 1u == (gen + 1u) * nloc) {
            __builtin_amdgcn_fence(__ATOMIC_RELEASE, "agent");
            asm volatile("s_waitcnt vmcnt(0)" ::: "memory");
            const unsigned og = xb_add(&bar[XB_TOP], 1u);
            const unsigned tg = og / nx;
            if (og + 1u == (tg + 1u) * nx) xb_add(&bar[XB_TOPGEN], 1u);
            else XB_SPIN(xb_ld(&bar[XB_TOPGEN]) == tg, bar);
            __builtin_amdgcn_fence(__ATOMIC_ACQUIRE, "agent");
            xb_add(&bar[XB_XGEN(b.x)], 1u);
            asm volatile("s_waitcnt vmcnt(0)" ::: "memory");
        } else {
            XB_SPIN(xb_ld(&bar[XB_XGEN(b.x)]) == gen, bar);
            __builtin_amdgcn_fence(__ATOMIC_ACQUIRE, "agent");
            asm volatile("s_waitcnt vmcnt(0)" ::: "memory");
        }
    }
    __syncthreads();
}

struct Args {
    const float* in[22]; float* out; unsigned char* ws; int ph_lo, ph_hi, li, pad;
};
struct Frame {
    LAS unsigned char* lds;
    int tid, lane, wave, vcu, G;
};
__device__ __forceinline__ void p0_item(const float* W, int N, bf16* WT, int K, int dst_row0, int k0, int n0, LAS float* scr, int lane) {
    f32x4 v[8];
#pragma unroll
    for (int i = 0; i < 8; ++i) v[i] = __builtin_nontemporal_load((const f32x4*)(W + (size_t)(k0 + (lane >> 3) + 8 * i) * N + n0 + 4 * (lane & 7)));
#pragma unroll
    for (int i = 0; i < 8; ++i) { LAS float* s = scr + ((lane >> 3) + 8 * i) * 33 + 4 * (lane & 7); s[0] = v[i].x; s[1] = v[i].y; s[2] = v[i].z; s[3] = v[i].w; }
    LDS_WAIT(); asm volatile("" ::: "memory");
    const int c = lane & 7;
#pragma unroll
    for (int j = 0; j < 4; ++j) { const int n = (lane >> 3) + 8 * j; const LAS float* s = scr + (8 * c) * 33 + n;
        u32x4 o; o.x = pk2(s[0 * 33], s[1 * 33]); o.y = pk2(s[2 * 33], s[3 * 33]); o.z = pk2(s[4 * 33], s[5 * 33]); o.w = pk2(s[6 * 33], s[7 * 33]);
        *(u32x4*)(WT + (size_t)(dst_row0 + n) * K + k0 + 8 * c) = o; }
    LDS_WAIT(); asm volatile("" ::: "memory");
}
struct ConvItem { const float* W; signed char* dst; float* sc; int n0, dst_row0; bool f8; };
__device__ __forceinline__ ConvItem conv_decode(const Args& a, int it) {
    unsigned char* ws = a.ws;
    const int nb = it & 31, e = (it >> 5) & 31, kind = it >> 10, n0 = nb * 32;
    ConvItem c;
    c.W = (kind == 0 ? a.in[14] : kind == 1 ? a.in[16] : a.in[18]) + (size_t)e * D * DFF;
    c.dst = kind < 2 ? (signed char*)(ws + WS_WGU) + (size_t)e * 2048 * 1024 : (signed char*)(ws + WS_WD) + (size_t)e * 1024 * 1024;
    c.dst_row0 = kind < 2 ? (n0 >> 7) * 256 + kind * 128 + (n0 & 127) : n0;
    c.sc = kind < 2 ? (float*)(ws + WS_SWGU) + e * 2048 : (float*)(ws + WS_SWD) + e * 1024;
    c.n0 = n0; c.f8 = kind == 2; return c;
}
#define CONV_LOAD(v, ci) do { _Pragma("unroll") for (int i_ = 0; i_ < 4; ++i_) _Pragma("unroll") for (int j_ = 0; j_ < 4; ++j_) \
        v[i_][j_] = __builtin_nontemporal_load((const f32x4*)((ci).W + (size_t)(4 * (kl + 64 * i_) + j_) * DFF + (ci).n0 + 4 * n4)); } while (0)
__device__ __forceinline__ void conv_items(const Frame& F, const Args& a, int it_lo, int it_hi) {
    if (it_hi > 3 * NEXP * 32) it_hi = 3 * NEXP * 32;
    if (it_lo >= it_hi) return;
    const int tid = F.tid, n4 = tid & 7, kl = tid >> 3;
    LAS unsigned* tile = (LAS unsigned*)F.lds;
    LAS float* red = (LAS float*)(F.lds + 36864);
    f32x4 v[4][4];
    ConvItem cur = conv_decode(a, it_lo);
    CONV_LOAD(v, cur);
    for (int it = it_lo; it < it_hi; ++it) {
        f32x4 am = (f32x4){0.f, 0.f, 0.f, 0.f};
#pragma unroll
        for (int i = 0; i < 4; ++i)
#pragma unroll
            for (int j = 0; j < 4; ++j) { am.x = fmaxf(am.x, fabsf(v[i][j].x)); am.y = fmaxf(am.y, fabsf(v[i][j].y)); am.z = fmaxf(am.z, fabsf(v[i][j].z)); am.w = fmaxf(am.w, fabsf(v[i][j].w)); }
#pragma unroll
        for (int o = 8; o < 64; o <<= 1) { am.x = fmaxf(am.x, __shfl_xor(am.x, o)); am.y = fmaxf(am.y, __shfl_xor(am.y, o)); am.z = fmaxf(am.z, __shfl_xor(am.z, o)); am.w = fmaxf(am.w, __shfl_xor(am.w, o)); }
        if (F.lane < 8) *(LAS f32x4*)(red + F.wave * 32 + 4 * n4) = am;
        __syncthreads();
        f32x4 cm = *(const LAS f32x4*)(red + 4 * n4);
#pragma unroll
        for (int w = 1; w < 8; ++w) { const f32x4 o = *(const LAS f32x4*)(red + w * 32 + 4 * n4); cm.x = fmaxf(cm.x, o.x); cm.y = fmaxf(cm.y, o.y); cm.z = fmaxf(cm.z, o.z); cm.w = fmaxf(cm.w, o.w); }
        const float qmax = cur.f8 ? WDMAX : 127.0f;
        f32x4 inv;
#pragma unroll
        for (int c = 0; c < 4; ++c) inv[c] = cm[c] > 0.f ? qmax / cm[c] : 0.f;
        if (kl == 0) {
#pragma unroll
            for (int c = 0; c < 4; ++c) cur.sc[cur.dst_row0 + 4 * n4 + c] = cm[c] * (1.0f / qmax);
        }
        if (cur.f8) {
#pragma unroll
            for (int i = 0; i < 4; ++i)
#pragma unroll
                for (int c = 0; c < 4; ++c) {
                    int d = 0;
                    d = __builtin_amdgcn_cvt_pk_fp8_f32(v[i][0][c] * inv[c], v[i][1][c] * inv[c], d, false);
                    d = __builtin_amdgcn_cvt_pk_fp8_f32(v[i][2][c] * inv[c], v[i][3][c] * inv[c], d, true);
                    tile[(4 * n4 + c) * 260 + kl + 64 * i] = (unsigned)d;
                }
        } else {
#pragma unroll
        for (int i = 0; i < 4; ++i)
#pragma unroll
            for (int c = 0; c < 4; ++c) {
                unsigned d = 0u;
#pragma unroll
                for (int j = 0; j < 4; ++j) { const int q = (int)rintf(v[i][j][c] * inv[c]); d |= ((unsigned)q & 0xffu) << (8 * j); }
                tile[(4 * n4 + c) * 260 + kl + 64 * i] = d;
            }
        }
        const ConvItem done = cur;
        if (it + 1 < it_hi) { cur = conv_decode(a, it + 1); CONV_LOAD(v, cur); }
        __syncthreads();
#pragma unroll
        for (int j = 0; j < 4; ++j) { const int ch = tid + 512 * j, n = ch >> 6, c16 = ch & 63;
            *(u32x4*)(done.dst + (size_t)(done.dst_row0 + n) * 1024 + 16 * c16) = *(const LAS u32x4*)(tile + n * 260 + 4 * c16); }
        __syncthreads();
    }
}
__device__ __forceinline__ void p0_prologue(const Frame& F, const Args& a) {
    unsigned char* ws = a.ws;
    bf16* Win_t = (bf16*)(ws + WS_WIN); bf16* Wout_t = (bf16*)(ws + WS_WOUT);
    LAS float* scr = (LAS float*)(F.lds + F.wave * 8448);
    const int gw = F.vcu * NWAVES + F.wave, NGW = F.G * NWAVES;
    constexpr int I_IN = 16 * 56, I_OUT = 16 * 32, NITEMS = I_IN + I_OUT;
    for (int it = gw; it < NITEMS; it += NGW) {
        int r = it;
        if (r < I_IN) { const int kb = r / 56, nb = r % 56; p0_item(a.in[1], INW, Win_t, D, nb * 32, kb * 64, nb * 32, scr, F.lane); continue; } r -= I_IN;
        { const int kb = r / 32, nb = r % 32; p0_item(a.in[8], D, Wout_t, D, nb * 32, kb * 64, nb * 32, scr, F.lane); }
    }
    const float* x = a.in[0]; bf16* XB = (bf16*)(ws + WS_XB);
    for (int m = gw; m < T; m += NGW) {
        const f32x4* xr = (const f32x4*)(x + (size_t)m * D) + F.lane; u32x2* o = (u32x2*)(XB + (size_t)m * D) + F.lane;
        f32x4 v[4];
#pragma unroll
        for (int j = 0; j < 4; ++j) v[j] = __builtin_nontemporal_load(xr + 64 * j);
#pragma unroll
        for (int j = 0; j < 4; ++j) { u32x2 w; w.x = pk2(v[j].x, v[j].y); w.y = pk2(v[j].z, v[j].w); o[64 * j] = w; }
    }
}

__device__ __forceinline__ int crow(int r, int hi) { return (r & 3) + 8 * (r >> 2) + 4 * hi; }
constexpr int AT_KROW = 144, AT_KG = 192 * AT_KROW, AT_VROW = 400, AT_VG = 64 * AT_VROW, AT_VOFF = 2 * AT_KG;
__device__ __forceinline__ void attn_wave_unit(const LAS unsigned char* lds, const bf16x8 (&qf)[4], const float sk, bf16* CAT, int tok0, int u, int h, int lane) {
    const int r32 = lane & 31, hi = lane >> 5;
    const int t0 = tok0 % SEQ, g = h >> 2;
    const int kk0 = 32 * u;
    f32x16 p[5];
    const float NEG = -INFINITY;
    const LAS unsigned char* kl = lds + g * AT_KG + (kk0 + r32) * AT_KROW + hi * 16;
#pragma unroll
    for (int j = 0; j < 5; ++j) {
        const int kb = t0 - 128 + 32 * j;
        f32x16 s;
#pragma unroll
        for (int r = 0; r < 16; ++r) s[r] = 0.f;
        if (kb >= 0) {
#pragma unroll
            for (int d0 = 0; d0 < 4; ++d0) { const bf16x8 kf = *(const LAS bf16x8*)(kl + j * 32 * AT_KROW + d0 * 32); s = __builtin_amdgcn_mfma_f32_32x32x16_bf16(kf, qf[d0], s, 0, 0, 0); }
            if (j == 0) {
#pragma unroll
                for (int r = 0; r < 16; ++r) if (!(crow(r, hi) > r32)) s[r] = NEG;
            }
            if (j == 4) {
#pragma unroll
                for (int r = 0; r < 16; ++r) if (!(crow(r, hi) <= r32)) s[r] = NEG;
            }
        } else {
#pragma unroll
            for (int r = 0; r < 16; ++r) s[r] = NEG;
        }
        p[j] = s;
    }
    float m = sk;
#pragma unroll
    for (int j = 0; j < 5; ++j)
#pragma unroll
        for (int r = 0; r < 16; ++r) m = fmaxf(m, p[j][r]);
    m = fmaxf(m, __shfl_xor(m, 32));
    float l = 0.f;
#pragma unroll
    for (int j = 0; j < 5; ++j)
#pragma unroll
        for (int r = 0; r < 16; ++r) { const float e = __builtin_amdgcn_exp2f(p[j][r] - m); p[j][r] = e; l += e; }
    l += __shfl_xor(l, 32);
    l += __builtin_amdgcn_exp2f(sk - m);
    const float inv = 1.0f / l;
    u32x4 pb[5][2];
#pragma unroll
    for (int j = 0; j < 5; ++j)
#pragma unroll
        for (int s = 0; s < 2; ++s) { pb[j][s].x = cvt_pk_bf16(p[j][8 * s + 0], p[j][8 * s + 1]); pb[j][s].y = cvt_pk_bf16(p[j][8 * s + 2], p[j][8 * s + 3]); pb[j][s].z = cvt_pk_bf16(p[j][8 * s + 4], p[j][8 * s + 5]); pb[j][s].w = cvt_pk_bf16(p[j][8 * s + 6], p[j][8 * s + 7]); }
#pragma unroll
    for (int db = 0; db < 2; ++db) {
        f32x16 o;
#pragma unroll
        for (int r = 0; r < 16; ++r) o[r] = 0.f;
        const LAS unsigned char* vl = lds + AT_VOFF + g * AT_VG + (db * 32 + r32) * AT_VROW + (kk0 + 4 * hi) * 2;
#pragma unroll
        for (int j = 0; j < 5; ++j) {
            const int kb = t0 - 128 + 32 * j;
            if (kb >= 0) {
#pragma unroll
                for (int s = 0; s < 2; ++s) {
                    const u32x2 lo = *(const LAS u32x2*)(vl + (32 * j + 16 * s) * 2), hh = *(const LAS u32x2*)(vl + (32 * j + 16 * s + 8) * 2);
                    u32x4 av; av.x = lo.x; av.y = lo.y; av.z = hh.x; av.w = hh.y;
                    o = __builtin_amdgcn_mfma_f32_32x32x16_bf16(__builtin_bit_cast(bf16x8, av), __builtin_bit_cast(bf16x8, pb[j][s]), o, 0, 0, 0);
                }
            }
        }
        bf16* op = CAT + (size_t)(tok0 + r32) * 1024 + h * 64 + db * 32 + 4 * hi;
#pragma unroll
        for (int gq = 0; gq < 4; ++gq) { u32x2 w; w.x = cvt_pk_bf16(o[4 * gq] * inv, o[4 * gq + 1] * inv); w.y = cvt_pk_bf16(o[4 * gq + 2] * inv, o[4 * gq + 3] * inv); *(u32x2*)(op + 8 * gq) = w; }
    }
}
__device__ __forceinline__ void attn_block(const Frame& F, const bf16* QB, const bf16* KB, const bf16* VT, const float* sinks, bf16* CAT, int qq) {
    const int tokb = qq * 64, b = tokb / SEQ, tb = tokb % SEQ, kbase = tb - 128;
    u32x4 kv[6], vv[6];
    bf16x8 qf0[4], qf1[4];
    { const int r32 = F.lane & 31, hi = F.lane >> 5;
#pragma unroll
      for (int d0 = 0; d0 < 4; ++d0) { qf0[d0] = *(const bf16x8*)(QB + (size_t)(tokb + r32) * 512 + F.wave * 64 + d0 * 16 + hi * 8); qf1[d0] = *(const bf16x8*)(QB + (size_t)(tokb + 32 + r32) * 512 + F.wave * 64 + d0 * 16 + hi * 8); } }
    const float sk = sinks[F.wave] * LOG2E;
#pragma unroll
    for (int i = 0; i < 6; ++i) {
        const int c = F.tid + 512 * i, g = c / 1536, rem = c % 1536;
        { const int key = rem >> 3, ch = rem & 7, pos = kbase + key;
          kv[i] = pos >= 0 ? __builtin_nontemporal_load((const u32x4*)(KB + (size_t)(b * SEQ + pos) * 128 + g * 64 + ch * 8)) : (u32x4){0u, 0u, 0u, 0u}; }
        { const int d = rem / 24, ch = rem % 24, pos = kbase + ch * 8;
          vv[i] = pos >= 0 ? __builtin_nontemporal_load((const u32x4*)(VT + ((size_t)((b * 2 + g) * 64 + d)) * SEQ + pos)) : (u32x4){0u, 0u, 0u, 0u}; }
    }
#pragma unroll
    for (int i = 0; i < 6; ++i) {
        const int c = F.tid + 512 * i, g = c / 1536, rem = c % 1536;
        *(LAS u32x4*)(F.lds + g * AT_KG + (rem >> 3) * AT_KROW + (rem & 7) * 16) = kv[i];
        *(LAS u32x4*)(F.lds + AT_VOFF + g * AT_VG + (rem / 24) * AT_VROW + (rem % 24) * 16) = vv[i];
    }
    __syncthreads();
    attn_wave_unit(F.lds, qf0, sk, CAT, tokb, 0, F.wave, F.lane);
    attn_wave_unit(F.lds, qf1, sk, CAT, tokb + 32, 1, F.wave, F.lane);
    __syncthreads();
}
template <int CTRL> __device__ __forceinline__ float dppq(float v) { return __builtin_bit_cast(float, __builtin_amdgcn_update_dpp(0, __builtin_bit_cast(int, v), CTRL, 0xF, 0xF, true)); }
constexpr int SG_WOFF = 20480, SG_WROW = 272;
__device__ __forceinline__ void sgu_stage_w(const Frame& F, const float* w_s, int gi) {
    f32x4 w[8];
#pragma unroll
    for (int i = 0; i < 8; ++i) w[i] = *(const f32x4*)(w_s + (size_t)gi * 16384 + (size_t)(F.tid + 512 * i) * 4);
#pragma unroll
    for (int i = 0; i < 8; ++i) { const int c = F.tid + 512 * i, t = c >> 5, s0 = (c & 31) * 4;
        f32x4 v = w[i];
#pragma unroll
        for (int j = 0; j < 4; ++j) if (s0 + j > t) v[j] = 0.f;
        u32x2 o; o.x = cvt_pk_bf16(v[0], v[1]); o.y = cvt_pk_bf16(v[2], v[3]);
        *(LAS u32x2*)(F.lds + SG_WOFF + t * SG_WROW + s0 * 2) = o; }
}
__device__ __forceinline__ void sgu_unit(const Frame& F, const bf16* UB, const bf16* GB, const float* ln_g, const float* ln_b, const float* w_s, const float* b_s, bf16* CAT, int ch, int gi) {
    LAS bf16* GT = (LAS bf16*)F.lds;
    const int r32 = F.lane & 31, hi = F.lane >> 5, tb = F.wave >> 1, db = F.wave & 1, t = tb * 32 + r32;
    const int nks = 2 * (tb + 1);
    const int s = F.tid >> 2, q4 = F.tid & 3; const size_t tok = (size_t)ch * 128 + s;
    const u32x4* gp = (const u32x4*)(GB + tok * 512 + gi * 64 + q4 * 16);
    const u32x4 a = gp[0], c = gp[1];
    const size_t tokt = (size_t)ch * 128 + t;
    const bf16* up = UB + tokt * 512 + gi * 64 + db * 32 + 4 * hi;
    u32x2 uu[4];
#pragma unroll
    for (int gq = 0; gq < 4; ++gq) uu[gq] = *(const u32x2*)(up + 8 * gq);
    const float bb = b_s[gi * 128 + t];
    float lg_[16], lb_[16];
#pragma unroll
    for (int i = 0; i < 16; ++i) { lg_[i] = ln_g[gi * 64 + q4 * 16 + i]; lb_[i] = ln_b[gi * 64 + q4 * 16 + i]; }
    {
        float v[16];
        v[0] = __uint_as_float(a.x << 16); v[1] = __uint_as_float(a.x & 0xffff0000u); v[2] = __uint_as_float(a.y << 16); v[3] = __uint_as_float(a.y & 0xffff0000u);
        v[4] = __uint_as_float(a.z << 16); v[5] = __uint_as_float(a.z & 0xffff0000u); v[6] = __uint_as_float(a.w << 16); v[7] = __uint_as_float(a.w & 0xffff0000u);
        v[8] = __uint_as_float(c.x << 16); v[9] = __uint_as_float(c.x & 0xffff0000u); v[10] = __uint_as_float(c.y << 16); v[11] = __uint_as_float(c.y & 0xffff0000u);
        v[12] = __uint_as_float(c.z << 16); v[13] = __uint_as_float(c.z & 0xffff0000u); v[14] = __uint_as_float(c.w << 16); v[15] = __uint_as_float(c.w & 0xffff0000u);
        float sum = 0.f;
#pragma unroll
        for (int i = 0; i < 16; ++i) sum += v[i];
        sum += dppq<0xB1>(sum); sum += dppq<0x4E>(sum);
        const float mu = sum * (1.f / 64.f); float q = 0.f;
#pragma unroll
        for (int i = 0; i < 16; ++i) { v[i] -= mu; q += v[i] * v[i]; }
        q += dppq<0xB1>(q); q += dppq<0x4E>(q);
        const float rstd = rsqrtf(q * (1.f / 64.f) + LN_EPS);
#pragma unroll
        for (int i = 0; i < 16; ++i) { const int d = q4 * 16 + i; GT[d * 136 + s] = (bf16)f2bf(v[i] * rstd * lg_[i] + lb_[i]); }
    }
    __syncthreads();
    {
        f32x16 acc;
#pragma unroll
        for (int r = 0; r < 16; ++r) acc[r] = 0.f;
        const LAS bf16* arow = GT + (db * 32 + r32) * 136 + hi * 8;
        const LAS unsigned char* wlds = F.lds + SG_WOFF + t * SG_WROW + hi * 16;
#pragma unroll
        for (int ks = 0; ks < 8; ++ks) if (ks < nks) {
            const bf16x8 af = *(const LAS bf16x8*)(arow + ks * 16);
            const bf16x8 bw = *(const LAS bf16x8*)(wlds + ks * 32);
            acc = __builtin_amdgcn_mfma_f32_32x32x16_bf16(af, bw, acc, 0, 0, 0);
        }
        bf16* op = CAT + tokt * 1024 + 512 + gi * 64 + db * 32 + 4 * hi;
#pragma unroll
        for (int gq = 0; gq < 4; ++gq) {
            const float u0 = __uint_as_float(uu[gq].x << 16), u1 = __uint_as_float(uu[gq].x & 0xffff0000u), u2 = __uint_as_float(uu[gq].y << 16), u3 = __uint_as_float(uu[gq].y & 0xffff0000u);
            u32x2 w; w.x = cvt_pk_bf16(u0 * (acc[4 * gq] + bb), u1 * (acc[4 * gq + 1] + bb)); w.y = cvt_pk_bf16(u2 * (acc[4 * gq + 2] + bb), u3 * (acc[4 * gq + 3] + bb));
            *(u32x2*)(op + 8 * gq) = w;
        }
    }
    __syncthreads();
}
__device__ __forceinline__ void p2_mixers(const Frame& F, const Args& a) {
    unsigned char* ws = a.ws;
    const bf16 *QB = (const bf16*)(ws + WS_QB), *KB = (const bf16*)(ws + WS_KB), *VT = (const bf16*)(ws + WS_VT), *UB = (const bf16*)(ws + WS_UB), *GB = (const bf16*)(ws + WS_GB);
    bf16* CAT = (bf16*)(ws + WS_CAT);
    for (int qq = F.vcu; qq < T / 64; qq += F.G) attn_block(F, QB, KB, VT, a.in[3], CAT, qq);
    int gi_staged = -1;
    for (int u = F.vcu; u < (T / 128) * 8; u += F.G) {
        if ((u & 7) != gi_staged) { __syncthreads(); sgu_stage_w(F, a.in[6], u & 7); gi_staged = u & 7; }
        sgu_unit(F, UB, GB, a.in[4], a.in[5], a.in[6], a.in[7], CAT, u >> 3, u & 7);
    }
}

template <int CTRL> __device__ __forceinline__ float dppf(float v) { return __builtin_bit_cast(float, __builtin_amdgcn_update_dpp(0, __builtin_bit_cast(int, v), CTRL, 0xF, 0xF, true)); }
__device__ __forceinline__ float swap16_sum(float x, float y) { auto r = __builtin_amdgcn_permlane16_swap(__builtin_bit_cast(unsigned, x), __builtin_bit_cast(unsigned, y), false, false); return __builtin_bit_cast(float, r[0]) + __builtin_bit_cast(float, r[1]); }
__device__ __forceinline__ float swap32_sum(float x, float y) { auto r = __builtin_amdgcn_permlane32_swap(__builtin_bit_cast(unsigned, x), __builtin_bit_cast(unsigned, y), false, false); return __builtin_bit_cast(float, r[0]) + __builtin_bit_cast(float, r[1]); }
__device__ __forceinline__ float rdlane(float v, int l) { return __builtin_bit_cast(float, __builtin_amdgcn_readlane(__builtin_bit_cast(int, v), l)); }
__device__ __forceinline__ float xsum(float v) {
    v += dppf<0xB1>(v); v += dppf<0x4E>(v); v += dppf<0x124>(v); v += dppf<0x128>(v);
    return (rdlane(v, 0) + rdlane(v, 16)) + (rdlane(v, 32) + rdlane(v, 48));
}
__device__ __forceinline__ float xmax(float v) {
    v = fmaxf(v, dppf<0xB1>(v)); v = fmaxf(v, dppf<0x4E>(v)); v = fmaxf(v, dppf<0x124>(v)); v = fmaxf(v, dppf<0x128>(v));
    return fmaxf(fmaxf(rdlane(v, 0), rdlane(v, 16)), fmaxf(rdlane(v, 32), rdlane(v, 48)));
}
__device__ __forceinline__ void p4_router(const Frame& F, const Args& a, bool commit) {
    const float* Zin = a.out; bf16* Hout = (bf16*)(a.ws + WS_H); signed char* HB8 = (signed char*)(a.ws + WS_HB); int* meta = (int*)(a.ws + WS_META); unsigned* cnt = (unsigned*)(a.ws + WS_CTL) + CW_CNT;
    const float* ln1_g = a.in[10]; const float* ln1_b = a.in[11]; const float* w_r = a.in[12]; const float* b_r = a.in[13];
    LAS float* W = (LAS float*)F.lds;
    LAS unsigned* hist = (LAS unsigned*)(F.lds + RSCR_OFF);
    LAS unsigned* base = hist + 32;
    LAS int* tmp_e = (LAS int*)(hist + 64);
    LAS int* tmp_p = tmp_e + 256;
    LAS float* tmp_g = (LAS float*)(tmp_p + 256);
    LAS float* tmp_s = tmp_g + 256;
    int* el_tok = (int*)(a.ws + WS_ELIST); float* el_gate = (float*)(a.ws + WS_ELIST) + NEXP * T; float* el_sa = el_gate + NEXP * T;
    {
        f32x4 t[16];
#pragma unroll
        for (int k = 0; k < 16; ++k) t[k] = *(const f32x4*)(w_r + (size_t)(F.tid + 512 * k) * 4);
#pragma unroll
        for (int k = 0; k < 16; ++k) { const int i = F.tid + 512 * k, c = i >> 3, e4 = i & 7, pr = (c & ~255) + 64 * (c & 3) + ((c >> 2) & 63); *(LAS f32x4*)(W + pr * 36 + e4 * 4) = t[k]; }
    }
    const int lane = F.lane, half = lane >> 5, el = lane & 31;
    LAS float* gbl = (LAS float*)(F.lds + 151552);
    for (int i = F.tid; i < 512; i += NWAVES * 64) *(LAS f32x4*)(gbl + 4 * i) = i < 256 ? *(const f32x4*)(ln1_g + 4 * i) : *(const f32x4*)(ln1_b + 4 * (i - 256));
    for (int tb = F.vcu; tb < T / 64; tb += F.G) {
        if (F.tid < 32) hist[F.tid] = 0u;
        __syncthreads();
        float zn0[16], zn1[16];
        { const f32x4* z0 = (const f32x4*)(Zin + (size_t)(tb * 64 + 8 * F.wave) * D) + lane;
#pragma unroll
          for (int j = 0; j < 4; ++j) { const f32x4 a0 = __builtin_nontemporal_load(z0 + 64 * j), a1 = __builtin_nontemporal_load(z0 + 256 + 64 * j);
#pragma unroll
            for (int k = 0; k < 4; ++k) { zn0[4 * j + k] = a0[k]; zn1[4 * j + k] = a1[k]; } } }
        for (int pp = 0; pp < 4; ++pp) {
            const int tl0 = 8 * F.wave + 2 * pp;
            const int tok0 = tb * 64 + tl0;
            float h0[16], h1[16];
            {
                u32x2* ho0 = (u32x2*)(Hout + (size_t)tok0 * D) + lane; u32x2* ho1 = ho0 + 256;
                float s0 = 0.f, s1 = 0.f, q0 = 0.f, q1 = 0.f;
#pragma unroll
                for (int i = 0; i < 16; ++i) { h0[i] = zn0[i]; h1[i] = zn1[i]; }
                if (pp < 3) { const f32x4* zp = (const f32x4*)(Zin + (size_t)(tok0 + 2) * D) + lane;
#pragma unroll
                    for (int j = 0; j < 4; ++j) { const f32x4 a0 = __builtin_nontemporal_load(zp + 64 * j), a1 = __builtin_nontemporal_load(zp + 256 + 64 * j);
#pragma unroll
                        for (int k = 0; k < 4; ++k) { zn0[4 * j + k] = a0[k]; zn1[4 * j + k] = a1[k]; } } }
#pragma unroll
                for (int i = 0; i < 16; ++i) { s0 += h0[i]; s1 += h1[i]; q0 += h0[i] * h0[i]; q1 += h1[i] * h1[i]; }
                s0 = xsum(s0); s1 = xsum(s1); q0 = xsum(q0); q1 = xsum(q1);
                const float m0 = s0 * (1.f / D), m1 = s1 * (1.f / D);
                const float r0 = rsqrtf(fmaxf(q0 * (1.f / D) - m0 * m0, 0.f) + LN_EPS), r1 = rsqrtf(fmaxf(q1 * (1.f / D) - m1 * m1, 0.f) + LN_EPS);
                float a0 = 0.f, a1 = 0.f;
#pragma unroll
                for (int i = 0; i < 16; ++i) {
                    const float gm_ = gbl[4 * lane + 256 * (i >> 2) + (i & 3)], bt_ = gbl[1024 + 4 * lane + 256 * (i >> 2) + (i & 3)];
                    h0[i] = (h0[i] - m0) * r0 * gm_ + bt_; h1[i] = (h1[i] - m1) * r1 * gm_ + bt_;
                    a0 = fmaxf(a0, fabsf(h0[i])); a1 = fmaxf(a1, fabsf(h1[i]));
                }
                a0 = xmax(a0); a1 = xmax(a1);
                const float i0 = a0 > 0.f ? 127.0f / a0 : 0.f, i1 = a1 > 0.f ? 127.0f / a1 : 0.f;
                unsigned* hb0 = (unsigned*)(HB8 + (size_t)tok0 * D) + lane; unsigned* hb1 = hb0 + 256;
#pragma unroll
                for (int j = 0; j < 4; ++j) {
                    { u32x2 w0, w1; w0.x = cvt_pk_bf16(h0[4 * j], h0[4 * j + 1]); w0.y = cvt_pk_bf16(h0[4 * j + 2], h0[4 * j + 3]); w1.x = cvt_pk_bf16(h1[4 * j], h1[4 * j + 1]); w1.y = cvt_pk_bf16(h1[4 * j + 2], h1[4 * j + 3]); ho0[64 * j] = w0; ho1[64 * j] = w1; }
                    unsigned p0 = 0u, p1 = 0u;
#pragma unroll
                    for (int k = 0; k < 4; ++k) { p0 |= ((unsigned)(int)rintf(h0[4 * j + k] * i0) & 0xffu) << (8 * k); p1 |= ((unsigned)(int)rintf(h1[4 * j + k] * i1) & 0xffu) << (8 * k); }
                    hb0[64 * j] = p0; hb1[64 * j] = p1;
                }
                if (lane == 0) { tmp_s[tl0] = a0 * (1.0f / 127.0f); tmp_s[tl0 + 1] = a1 * (1.0f / 127.0f); }
            }
            f32x2 lp0[16], lp1[16];
#pragma unroll
            for (int e = 0; e < 16; ++e) { lp0[e] = (f32x2){0.f, 0.f}; lp1[e] = (f32x2){0.f, 0.f}; }
#pragma unroll
            for (int i = 0; i < 16; ++i) {
                const LAS f32x4* wr = (const LAS f32x4*)(W + (256 * (i >> 2) + 64 * (i & 3) + lane) * 36);
                const f32x2 hv0 = (f32x2){h0[i], h0[i]}, hv1 = (f32x2){h1[i], h1[i]};
#pragma unroll
                for (int e4 = 0; e4 < 8; ++e4) {
                    const f32x4 ww = wr[e4];
                    const f32x2 wlo = (f32x2){ww.x, ww.y}, whi = (f32x2){ww.z, ww.w};
                    lp0[2 * e4] = __builtin_elementwise_fma(hv0, wlo, lp0[2 * e4]); lp0[2 * e4 + 1] = __builtin_elementwise_fma(hv0, whi, lp0[2 * e4 + 1]);
                    lp1[2 * e4] = __builtin_elementwise_fma(hv1, wlo, lp1[2 * e4]); lp1[2 * e4 + 1] = __builtin_elementwise_fma(hv1, whi, lp1[2 * e4 + 1]);
                }
            }
            float lg0[32], lg1[32];
#pragma unroll
            for (int e = 0; e < 16; ++e) { lg0[2 * e] = lp0[e].x; lg0[2 * e + 1] = lp0[e].y; lg1[2 * e] = lp1[e].x; lg1[2 * e + 1] = lp1[e].y; }
            float v32[32];
#pragma unroll
            for (int e = 0; e < 32; ++e) { const float keep = half ? lg1[e] : lg0[e], send = half ? lg0[e] : lg1[e]; v32[e] = keep + __shfl_xor(send, 32); }
            float v16[16];
#pragma unroll
            for (int e = 0; e < 16; ++e) { const bool up = (lane & 16) != 0; const float keep = up ? v32[e + 16] : v32[e], send = up ? v32[e] : v32[e + 16]; v16[e] = keep + __shfl_xor(send, 16); }
            float v8[8];
#pragma unroll
            for (int e = 0; e < 8; ++e) { const bool up = (lane & 8) != 0; const float keep = up ? v16[e + 8] : v16[e], send = up ? v16[e] : v16[e + 8]; v8[e] = keep + dppf<0x128>(send); }
            float v4[4];
#pragma unroll
            for (int e = 0; e < 4; ++e) { const bool up = (lane & 4) != 0; const float keep = up ? v8[e + 4] : v8[e], send = up ? v8[e] : v8[e + 4]; v4[e] = keep + dppf<0x1B>(dppf<0x141>(send)); }
            float v2[2];
#pragma unroll
            for (int e = 0; e < 2; ++e) { const bool up = (lane & 2) != 0; const float keep = up ? v4[e + 2] : v4[e], send = up ? v4[e] : v4[e + 2]; v2[e] = keep + dppf<0x4E>(send); }
            float lgt;
            { const bool up = (lane & 1) != 0; const float keep = up ? v2[1] : v2[0], send = up ? v2[0] : v2[1]; lgt = keep + dppf<0xB1>(send); }
            lgt += b_r[el];
            float bv[4]; int bi[4];
            {
                float cur = lgt;
#pragma unroll
                for (int k = 0; k < 4; ++k) {
                    float mx = cur;
                    mx = fmaxf(mx, dppf<0xB1>(mx)); mx = fmaxf(mx, dppf<0x4E>(mx)); mx = fmaxf(mx, dppf<0x124>(mx)); mx = fmaxf(mx, dppf<0x128>(mx));
                    const float m0 = fmaxf(rdlane(mx, 0), rdlane(mx, 16)), m1 = fmaxf(rdlane(mx, 32), rdlane(mx, 48));
                    const float mm = half ? m1 : m0;
                    const unsigned long long mk = __ballot(cur == mm);
                    const int i0 = __builtin_ctz((unsigned)mk | 0x80000000u), i1 = __builtin_ctz((unsigned)(mk >> 32) | 0x80000000u);
                    bv[k] = mm; bi[k] = half ? i1 : i0;
                    if (el == bi[k]) cur = -INFINITY;
                }
            }
            float ex[4], es = 0.f;
#pragma unroll
            for (int k = 0; k < 4; ++k) { ex[k] = __expf(bv[k] - bv[0]); es += ex[k]; }
            if (el == 0) {
                const int tl = tl0 + half;
#pragma unroll
                for (int k = 0; k < 4; ++k) { const unsigned pl = atomicAdd((unsigned*)&hist[bi[k]], 1u); tmp_e[tl * 4 + k] = bi[k]; tmp_p[tl * 4 + k] = (int)pl; tmp_g[tl * 4 + k] = ex[k] / es; }
            }
        }
        __syncthreads();
        if (F.tid < 32) base[F.tid] = commit ? atomicAdd(&cnt[F.tid], hist[F.tid]) : 0u;
        __syncthreads();
        if (F.tid < 256) { const int i = F.tid, gi = tb * 256 + i, e = tmp_e[i];
            const int pos = (int)base[e] + tmp_p[i];
            meta[MT_SEL_E + gi] = e; meta[MT_SEL_POS + gi] = pos;
            el_tok[e * T + pos] = tb * 64 + (i >> 2); el_gate[e * T + pos] = tmp_g[i]; el_sa[e * T + pos] = tmp_s[i >> 2]; }
        __syncthreads();
    }
}
__device__ __forceinline__ void build_tables(const Frame& F, const Args& a) {
    const unsigned* cnt = (const unsigned*)(a.ws + WS_CTL) + CW_CNT;
    LAS int* tb = (LAS int*)(F.lds + RSCR_OFF);
    __syncthreads();
    if (F.tid < 32) tb[TBL_CNT + F.tid] = (int)__hip_atomic_load(cnt + F.tid, RLX_AGENT);
    __syncthreads();
    if (F.tid == 0) { int acc = 0; for (int e = 0; e < 32; ++e) { tb[TBL_TS + e] = acc; acc += (tb[TBL_CNT + e] + 255) >> 8; } tb[TBL_TS + 32] = acc; }
    __syncthreads();
    for (int t = F.tid; t < NT_MAX; t += NWAVES * 64) { int e = 0; for (int j = 1; j < 32; ++j) if (t >= tb[TBL_TS + j]) e = j; tb[TBL_TILE + t] = e; }
    __syncthreads();
}
__device__ __forceinline__ void p7_quant(const Frame& F, const Args& a) {
    const bf16* HID = (const bf16*)(a.ws + WS_HID); signed char* H8 = (signed char*)(a.ws + WS_HID8); float* row_sb = (float*)(a.ws + WS_ROWSB);
    const int nrows = __builtin_amdgcn_readfirstlane(((const LAS int*)(F.lds + RSCR_OFF))[TBL_TS + 32]) * 256;
    const int gw = F.vcu * NWAVES + F.wave, NGW = F.G * NWAVES, lane = F.lane;
    for (int r0 = gw * 4; r0 < nrows; r0 += NGW * 4) {
        u32x4 v[4][2];
#pragma unroll
        for (int i = 0; i < 4; ++i)
#pragma unroll
            for (int j = 0; j < 2; ++j) v[i][j] = __builtin_nontemporal_load((const u32x4*)(HID + (size_t)(r0 + i) * DFF + 512 * j) + lane);
#pragma unroll
        for (int i = 0; i < 4; ++i) {
            float f[16]; float am = 0.f;
#pragma unroll
            for (int j = 0; j < 2; ++j)
#pragma unroll
                for (int c = 0; c < 4; ++c) { const unsigned w = v[i][j][c]; f[8 * j + 2 * c] = __uint_as_float(w << 16); f[8 * j + 2 * c + 1] = __uint_as_float(w & 0xffff0000u); }
#pragma unroll
            for (int c = 0; c < 16; ++c) am = fmaxf(am, fabsf(f[c]));
            am = xmax(am);
            const float inv = am > 0.f ? 127.0f / am : 0.f;
#pragma unroll
            for (int j = 0; j < 2; ++j) {
                u32x2 o; o.x = 0u; o.y = 0u;
#pragma unroll
                for (int c = 0; c < 4; ++c) { o.x |= ((unsigned)(int)rintf(f[8 * j + c] * inv) & 0xffu) << (8 * c); o.y |= ((unsigned)(int)rintf(f[8 * j + 4 + c] * inv) & 0xffu) << (8 * c); }
                *((u32x2*)(H8 + (size_t)(r0 + i) * DFF + 512 * j) + lane) = o;
            }
            if (lane == 0) row_sb[r0 + i] = am * (1.0f / 127.0f);
        }
    }
}
__device__ __forceinline__ void p8_final(const Frame& F, const Args& a) {
    const bf16* Hin = (const bf16*)(a.ws + WS_H); float* HO = a.out; const unsigned char* Y = (const unsigned char*)(a.ws + WS_Y); const int* meta = (const int*)(a.ws + WS_META);
    const float* ln2_g = a.in[20]; const float* ln2_b = a.in[21]; const LAS int* tsl = (const LAS int*)(F.lds + RSCR_OFF) + TBL_TS;
    const int gw = F.vcu * NWAVES + F.wave, NGW = F.G * NWAVES, lane = F.lane;
    f32x4 g2[4], b2[4];
#pragma unroll
    for (int j = 0; j < 4; ++j) { g2[j] = *(const f32x4*)(ln2_g + 4 * lane + 256 * j); b2[j] = *(const f32x4*)(ln2_b + 4 * lane + 256 * j); }
    for (int tok = gw; tok < T; tok += NGW) {
        f32x4* hr = (f32x4*)(HO + (size_t)tok * D) + lane; const u32x2* hi_ = (const u32x2*)(Hin + (size_t)tok * D) + lane;
        f32x4 v[4]; float s = 0.f;
#pragma unroll
        for (int j = 0; j < 4; ++j) { const u32x2 hh = __builtin_nontemporal_load(hi_ + 64 * j); v[j] = (f32x4){__uint_as_float(hh.x << 16), __uint_as_float(hh.x & 0xffff0000u), __uint_as_float(hh.y << 16), __uint_as_float(hh.y & 0xffff0000u)} * ALPHA; }
#pragma unroll
        for (int k = 0; k < 4; ++k) {
            const int row = tsl[meta[MT_SEL_E + tok * 4 + k]] * 256 + meta[MT_SEL_POS + tok * 4 + k];
            const unsigned* yr = (const unsigned*)(Y + (size_t)row * D) + lane;
#pragma unroll
            for (int j = 0; j < 4; ++j) { const int y = (int)__builtin_nontemporal_load(yr + 64 * j); const f32x2 lo = __builtin_amdgcn_cvt_pk_f32_fp8(y, false), hi2 = __builtin_amdgcn_cvt_pk_f32_fp8(y, true);
                v[j].x += lo.x * (1.0f / YSCALE); v[j].y += lo.y * (1.0f / YSCALE); v[j].z += hi2.x * (1.0f / YSCALE); v[j].w += hi2.y * (1.0f / YSCALE); }
        }
#pragma unroll
        for (int j = 0; j < 4; ++j) s += (v[j].x + v[j].y) + (v[j].z + v[j].w);
        const float mean = xsum(s) * (1.f / D); float s2 = 0.f;
#pragma unroll
        for (int j = 0; j < 4; ++j) { v[j] = v[j] - mean; s2 += (v[j].x * v[j].x + v[j].y * v[j].y) + (v[j].z * v[j].z + v[j].w * v[j].w); }
        const float rstd = rsqrtf(xsum(s2) * (1.f / D) + LN_EPS);
#pragma unroll
        for (int j = 0; j < 4; ++j) hr[64 * j] = v[j] * rstd * g2[j] + b2[j];
    }
}
__global__ void __launch_bounds__(NWAVES * 64, 2) mk_fwd(Args args) {
    extern __shared__ __attribute__((aligned(16))) unsigned char lds_raw[];
    Frame F;
    F.lds = (LAS unsigned char*)lds_raw;
    F.tid = threadIdx.x; F.lane = F.tid & 63; F.wave = __builtin_amdgcn_readfirstlane(F.tid >> 6);
    F.G = gridDim.x; { const int bx = blockIdx.x; F.vcu = (F.G % 8 == 0) ? (bx % 8) * (F.G / 8) + bx / 8 : bx; }
    volatile LAS unsigned* MISC = (volatile LAS unsigned*)(F.lds + MISC_OFF);
    if (F.tid < 64) MISC[F.tid] = 0u;
    __syncthreads();
    unsigned char* ws = args.ws;
    unsigned* ctl = (unsigned*)(ws + WS_CTL);
    const int lo = args.ph_lo, hi = args.ph_hi;
    XcdBarrier bar; bar.bar = ctl + CW_BAR + args.li * XCD_BAR_WORDS; bar.x = 0; bar.st = nullptr;
    if (hi - lo > 1) bar = xcd_barrier_post(ctl + CW_BAR + args.li * XCD_BAR_WORDS, MISC + 8);
#define IN(k) (lo <= (k) && (k) < hi)
#define OPAQUE_F(Fp) Frame Fp = F; asm volatile("" : "+v"(Fp.tid)); Fp.lane = Fp.tid & 63
#define SEAM(k) do { if (IN(k) && IN((k) + 1)) xcd_barrier(bar); } while (0)
    int* meta = (int*)(ws + WS_META);
    bf16 *XB = (bf16*)(ws + WS_XB), *QB = (bf16*)(ws + WS_QB), *KB = (bf16*)(ws + WS_KB), *VT = (bf16*)(ws + WS_VT), *UB = (bf16*)(ws + WS_UB), *GB = (bf16*)(ws + WS_GB);
    bf16 *CAT = (bf16*)(ws + WS_CAT), *HB = (bf16*)(ws + WS_HB), *Y = (bf16*)(ws + WS_Y), *HID = (bf16*)(ws + WS_HID);
    bf16 *Win_t = (bf16*)(ws + WS_WIN), *Wout_t = (bf16*)(ws + WS_WOUT), *Wgu_t = (bf16*)(ws + WS_WGU), *Wd_t = (bf16*)(ws + WS_WD);
    const LAS int* rtab = (const LAS int*)(F.lds + RTAB_OFF);
    const bool par = ((blockIdx.x >> 3) & 1) != 0;

    if (IN(0)) { OPAQUE_F(Fp); p0_prologue(Fp, args); SEAM(0); }
    if (IN(1)) {
        const int c = (int)blockIdx.x, grp = (c >> 3) % 3;
        const int per_ = (3 * NEXP * 32 + F.G - 1) / F.G;
        const int it_lo = F.G == 256 ? (c < 192 ? c * 10 : 1920 + (c - 192) * 18) : c * per_, it_hi = F.G == 256 ? it_lo + (c < 192 ? 10 : 18) : it_lo + per_;
        OPAQUE_F(Fp);
        if (grp == 0) conv_items(Fp, args, it_lo, it_hi);
        { pg8::Gemm g{XB, Win_t, 2 * D, nullptr, 0u}; pg8::StaticOrder S; S.init(T / 256, INW / 256, F.G, c); S.i1 = 1;
          pg8::EpiInProj E{args.in[2], QB, KB, VT, UB, GB};
          pg8::gemm_phase<pg8::EpiInProj, false, true, 0>(F.lds, rtab, g, S, E); }
        if (grp == 1) conv_items(Fp, args, it_lo, it_hi);
        { pg8::Gemm g{XB, Win_t, 2 * D, nullptr, 0u}; pg8::StaticOrder S; S.init(T / 256, INW / 256, F.G, c); S.i0 = 1;
          pg8::EpiInProj E{args.in[2], QB, KB, VT, UB, GB};
          pg8::gemm_phase<pg8::EpiInProj, false, true, 0>(F.lds, rtab, g, S, E); }
        if (grp == 2) conv_items(Fp, args, it_lo, it_hi);
        SEAM(1);
    }
    if (IN(2)) { OPAQUE_F(Fp); p2_mixers(Fp, args); SEAM(2); }
    if (IN(3)) {
        pg8::Gemm g{CAT, Wout_t, 2 * D, nullptr, 0u}; pg8::StaticOrder S; S.init(T / 256, D / 256, F.G, (int)blockIdx.x);
        pg8::EpiOutProj E{args.in[0], args.in[9], args.out};
        pg8::gemm_phase<pg8::EpiOutProj, false, false, 0>(F.lds, rtab, g, S, E);
        SEAM(3);
    }
    if (IN(4)) { OPAQUE_F(Fp); p4_router(Fp, args, true); if (hi > 5) xcd_barrier(bar); }
    const LAS int* tbl = (const LAS int*)(F.lds + RSCR_OFF);
    if (hi > 5) { OPAQUE_F(Fp); build_tables(Fp, args); }
    if (IN(6)) {
        const int nT = __builtin_amdgcn_readfirstlane(tbl[TBL_TS + 32]);
        pg8::StaticOrder S; S.init(nT, 2 * DFF / 256, F.G, (int)blockIdx.x);
        { pg8::Unit u; LAS int* rt = (LAS int*)(F.lds + RTAB_OFF); const int* el_tok = (const int*)(ws + WS_ELIST);
          for (int i = 0; i < RTAB_UNITS && S.next(i, u); ++i) if (F.tid < 256) { const int e = tbl[TBL_TILE + u.pm], ix = (u.pm - tbl[TBL_TS + e]) * 256 + F.tid; rt[i * 256 + F.tid] = ix < tbl[TBL_CNT + e] ? el_tok[e * T + ix] : 0; }
          __syncthreads(); }
        pg8::Gemm g{HB, Wgu_t, D, tbl + TBL_TILE, 2048u * 1024u};
        pg8::EpiSwiglu E{tbl, args.in[15], args.in[17], (const float*)(ws + WS_SWGU), (const float*)(ws + WS_ELIST) + 2 * NEXP * T, ws + WS_HID8};
        pg8::gemm_phase<pg8::EpiSwiglu, true, true, 1>(F.lds, rtab, g, S, E);
        if (IN(8)) xcd_barrier(bar);
    }
    if (IN(8)) {
        const int nT = __builtin_amdgcn_readfirstlane(tbl[TBL_TS + 32]);
        pg8::StaticOrder S; S.init(nT, D / 256, F.G, (int)blockIdx.x);
        pg8::Gemm g{ws + WS_HID8, Wd_t, DFF, tbl + TBL_TILE, 1024u * 1024u};
        pg8::EpiDown E{tbl, args.in[19], (const float*)(ws + WS_SWD), (const float*)(ws + WS_ELIST) + NEXP * T, (unsigned char*)Y};
        pg8::gemm_phase<pg8::EpiDown, false, true, 2>(F.lds, rtab, g, S, E);
        SEAM(8);
    }
    if (IN(9)) { OPAQUE_F(Fp); p8_final(Fp, args); }
#undef IN
#undef SEAM
}

extern "C" void kernel_launch(void* const* d_in, const int* in_sizes, int n_in, void* d_out, int out_size, void* d_ws, size_t ws_size, hipStream_t stream) {
    static int grid = 0;
    if (grid == 0) {
        if (n_in != 22 || in_sizes[0] != T * D || out_size != T * D || ws_size < WS_END) { fprintf(stderr, "kernel_launch: unexpected shapes (n_in %d, in0 %d, out %d, ws %zu, need %zu)\n", n_in, n_in > 0 ? in_sizes[0] : -1, out_size, ws_size, (size_t)WS_END); grid = -1; return; }
        int dev = 0, cus = 0;
        if (hipGetDevice(&dev) != hipSuccess || hipDeviceGetAttribute(&cus, hipDeviceAttributeMultiprocessorCount, dev) != hipSuccess) { grid = -1; return; }
        if (hipFuncSetAttribute((const void*)mk_fwd, hipFuncAttributeMaxDynamicSharedMemorySize, LDS_BYTES) != hipSuccess) { fprintf(stderr, "kernel_launch: hipFuncSetAttribute failed\n"); grid = -1; return; }
        int per_cu = 0;
        if (hipOccupancyMaxActiveBlocksPerMultiprocessor(&per_cu, (const void*)mk_fwd, NWAVES * 64, LDS_BYTES) != hipSuccess || per_cu < 1) fprintf(stderr, "kernel_launch: occupancy query reports %d\n", per_cu);
        (void)hipGetLastError();
        grid = cus;
    }
    if (grid < 0) return;
    unsigned char* ws = (unsigned char*)d_ws; float* out = (float*)d_out;
    (void)hipMemsetAsync(ws + WS_CTL, 0, 64 * 1024, stream);
    Args a{};
    for (int i = 0; i < 22; ++i) a.in[i] = (const float*)d_in[i];
    a.out = out; a.ws = ws;
    a.ph_lo = 0; a.ph_hi = NPHASES; a.li = 0;
    hipLaunchKernelGGL(mk_fwd, dim3(grid), dim3(NWAVES * 64), LDS_BYTES, stream, a);
}
```
